# Optimizing an MI355X kernel written in HIP

```python
import math
import jax, jax.numpy as jnp
from jax import lax
import numpy as np

D_MODEL = 1024
BATCH = 8
SEQ = 8192
DEPTH = 4

GROUP_WIDTH = D_MODEL // 4
HEAD_DIM = 64
N_FOX_HEADS = GROUP_WIDTH // HEAD_DIM
N_DIL_HEADS = GROUP_WIDTH // HEAD_DIM
N_DIFF_HEADS = GROUP_WIDTH // HEAD_DIM
DIFF_HALF = HEAD_DIM // 2
S5_CH = 16
S5_GROUPS = GROUP_WIDTH // S5_CH
S5_STATE = 64
BLOCK = 128
DIL_PAIRS = ((128, 1), (512, 4), (2048, 16))
REL_BUCKETS = 32
REL_MAX_EXACT = REL_BUCKETS // 2
REL_MAX_DIST = 2048
N_KEYS = 128
N_EXPERTS = N_KEYS * N_KEYS
PEER_HEADS = 8
PEER_TOPK = 16
PEER_QDIM = 256
PEER_CHUNK = 128
RMS_EPS = 1e-6
SPLIT_SIZES = [GROUP_WIDTH, GROUP_WIDTH, GROUP_WIDTH, N_FOX_HEADS,
               GROUP_WIDTH, GROUP_WIDTH, GROUP_WIDTH,
               GROUP_WIDTH, GROUP_WIDTH, GROUP_WIDTH,
               GROUP_WIDTH]
SPLIT_POINTS = [int(v) for v in np.cumsum(SPLIT_SIZES)[:-1]]
IN_WIDTH = int(sum(SPLIT_SIZES))

kernel_name = "hybrid_fox_dilated_diff_s5_peer"


def rms_norm(x, g):
    xf = x.astype(jnp.float32)
    y = xf * lax.rsqrt(jnp.mean(xf * xf, axis=-1, keepdims=True) + RMS_EPS)
    return (y * g.astype(jnp.float32)).astype(x.dtype)


def heads(t, n):
    b, s, _ = t.shape
    return t.reshape(b, s, n, -1).transpose(0, 2, 1, 3)


def to_blocks(t):
    b, h, s = t.shape[:3]
    t = t.reshape(b, h, s // BLOCK, BLOCK, *t.shape[3:])
    return jnp.moveaxis(t, 2, 0)


def unblock(o):
    nb, b, h, w, d = o.shape
    return o.transpose(1, 0, 3, 2, 4).reshape(b, nb * w, h * d)


def t5_bucket(dist):
    n = jnp.maximum(dist, 0)
    nf = jnp.maximum(n, REL_MAX_EXACT).astype(jnp.float32)
    large = REL_MAX_EXACT + (jnp.log(nf / REL_MAX_EXACT) / math.log(REL_MAX_DIST / REL_MAX_EXACT)
                             * (REL_BUCKETS - REL_MAX_EXACT)).astype(jnp.int32)
    large = jnp.minimum(large, REL_BUCKETS - 1)
    return jnp.where(n < REL_MAX_EXACT, n, large)


def forgetting_attention(q, k, v, f_logit):
    b, h, s, d = q.shape
    cum = jnp.cumsum(jax.nn.log_sigmoid(f_logit.astype(jnp.float32)), axis=1).transpose(0, 2, 1)
    scale = d ** -0.5
    kpos = jnp.arange(s)

    def block(args):
        qb, cq, q0 = args
        logits = jnp.einsum('bhqd,bhkd->bhqk', qb, k, preferred_element_type=jnp.float32) * scale
        logits = logits + (cq[..., :, None] - cum[..., None, :])
        qpos = q0 + jnp.arange(BLOCK)
        logits = jnp.where(kpos[None, :] <= qpos[:, None], logits, -jnp.inf)
        p = jax.nn.softmax(logits, axis=-1)
        return jnp.einsum('bhqk,bhkd->bhqd', p.astype(v.dtype), v)

    nb = s // BLOCK
    o = lax.map(block, (to_blocks(q), to_blocks(cum), jnp.arange(nb) * BLOCK))
    return unblock(o)


def dilated_branch(q, k, v, bias_tab, window, dil):
    b, h, s, d = q.shape
    ws = window // dil
    L = s // dil
    nb = -(-L // BLOCK)
    Lp = nb * BLOCK

    def strided(t):
        t = t.reshape(b, h, L, dil, d).transpose(0, 1, 3, 2, 4)
        t = jnp.pad(t, ((0, 0), (0, 0), (0, 0), (0, Lp - L), (0, 0)))
        return t.reshape(b, h, dil, nb, BLOCK, d)

    def with_prev(t):
        prev = jnp.pad(t, ((0, 0), (0, 0), (0, 0), (1, 0), (0, 0), (0, 0)))[:, :, :, :nb]
        return jnp.concatenate([prev, t], axis=-2)

    qs = strided(q)
    kk = with_prev(strided(k))
    vv = with_prev(strided(v))
    j = jnp.arange(BLOCK)[:, None]
    m = jnp.arange(2 * BLOCK)[None, :]
    sub_dist = BLOCK + j - m
    band = (sub_dist >= 0) & (sub_dist <= ws)
    blk = jnp.arange(nb)[:, None, None]
    valid = band[None] & (blk * BLOCK + m[None] - BLOCK >= 0)
    bias = bias_tab[t5_bucket(dil * jnp.clip(sub_dist, 0, ws))].transpose(2, 0, 1)
    logits = jnp.einsum('bhrnqd,bhrnkd->bhrnqk', qs, kk, preferred_element_type=jnp.float32) * (d ** -0.5)
    logits = logits + bias[:, None, None].astype(jnp.float32)
    logits = jnp.where(valid, logits, -jnp.inf)
    mx = jnp.max(logits, axis=-1, keepdims=True)
    e = jnp.exp(logits - mx)
    den = jnp.sum(e, axis=-1, keepdims=True)
    o = jnp.einsum('bhrnqk,bhrnkd->bhrnqd', (e / den).astype(v.dtype), vv)
    lse = (mx + jnp.log(den))[..., 0]

    def unstrided(t):
        rest = t.shape[5:]
        t = t.reshape(b, h, dil, Lp, *rest)[:, :, :, :L]
        t = jnp.moveaxis(t, 2, 3)
        return t.reshape(b, h, s, *rest)

    return unstrided(o), unstrided(lse)


def dilated_attention(q, k, v, bias_tab):
    b, h, s, d = q.shape
    branches = [dilated_branch(q, k, v, bias_tab, w, r) for (w, r) in DIL_PAIRS]
    outs = jnp.stack([o for o, _ in branches])
    wts = jax.nn.softmax(jnp.stack([l for _, l in branches]), axis=0)
    o = jnp.einsum('nbhs,nbhsd->bhsd', wts.astype(v.dtype), outs)
    return o.transpose(0, 2, 1, 3).reshape(b, s, h * d)


def diff_attention(q, k, v, bias_tab, lam, out_gain, lam_init):
    b, h, s = q.shape[:3]
    scale = DIFF_HALF ** -0.5
    kpos = jnp.arange(s)

    def block(args):
        qb, q0 = args
        qpos = q0 + jnp.arange(BLOCK)
        rel = qpos[:, None] - kpos[None, :]
        bias = bias_tab[t5_bucket(rel)].transpose(2, 0, 1).astype(jnp.float32)
        logits = jnp.einsum('bhqcd,bhkcd->cbhqk', qb, k, preferred_element_type=jnp.float32) * scale + bias
        logits = jnp.where(rel >= 0, logits, -jnp.inf)
        p = jax.nn.softmax(logits, axis=-1)
        attn = p[0] - lam * p[1]
        o = jnp.einsum('bhqk,bhkd->bhqd', attn.astype(v.dtype), v)
        return rms_norm(o, out_gain) * (1.0 - lam_init)

    nb = s // BLOCK
    o = lax.map(block, (to_blocks(q), jnp.arange(nb) * BLOCK))
    return unblock(o)


def s5_mixer(u, a_re, a_im, log_dt, b_re, b_im, c_re, c_im, d_skip, glu_w, glu_b):
    bsz, s, _ = u.shape
    uf = u.astype(jnp.float32).reshape(bsz, s, S5_GROUPS, S5_CH)
    dt = jnp.exp(log_dt.astype(jnp.float32))[:, None]
    ar, ai = a_re.astype(jnp.float32), a_im.astype(jnp.float32)
    mag = jnp.exp(dt * ar)
    abar_re, abar_im = mag * jnp.cos(dt * ai), mag * jnp.sin(dt * ai)
    den = ar * ar + ai * ai
    nr, ni = abar_re - 1.0, abar_im
    coef_re = (nr * ar + ni * ai) / den
    coef_im = (ni * ar - nr * ai) / den
    br, bi = b_re.astype(jnp.float32), b_im.astype(jnp.float32)
    bbar_re = coef_re[..., None] * br - coef_im[..., None] * bi
    bbar_im = coef_re[..., None] * bi + coef_im[..., None] * br
    bu_re = jnp.einsum('gnc,bsgc->bsgn', bbar_re, uf)
    bu_im = jnp.einsum('gnc,bsgc->bsgn', bbar_im, uf)
    a_full_re = jnp.broadcast_to(abar_re, bu_re.shape)
    a_full_im = jnp.broadcast_to(abar_im, bu_re.shape)

    def combine(e1, e2):
        a1r, a1i, b1r, b1i = e1
        a2r, a2i, b2r, b2i = e2
        return (a2r * a1r - a2i * a1i, a2r * a1i + a2i * a1r,
                a2r * b1r - a2i * b1i + b2r, a2r * b1i + a2i * b1r + b2i)

    _, _, xr, xi = lax.associative_scan(combine, (a_full_re, a_full_im, bu_re, bu_im), axis=1)
    y = (jnp.einsum('gcn,bsgn->bsgc', c_re.astype(jnp.float32), xr)
         - jnp.einsum('gcn,bsgn->bsgc', c_im.astype(jnp.float32), xi)
         + d_skip.astype(jnp.float32) * uf)
    g = jax.nn.gelu(y.reshape(bsz, s, -1))
    out = g * jax.nn.sigmoid(g @ glu_w.astype(jnp.float32) + glu_b.astype(jnp.float32))
    return out.astype(u.dtype)


def peer(h, wq, keys, u_tab, v_tab):
    b, s, dm = h.shape
    chunks = h.reshape(-1, PEER_CHUNK, dm)

    def chunk(xc):
        c = xc.shape[0]
        q = (xc @ wq).reshape(c, PEER_HEADS, 2, PEER_QDIM // 2)
        sc = jnp.einsum('thpd,hpkd->thpk', q, keys, preferred_element_type=jnp.float32)
        top_v, top_i = lax.top_k(sc, PEER_TOPK)
        cand = (top_v[:, :, 0, :, None] + top_v[:, :, 1, None, :]).reshape(c, PEER_HEADS, -1)
        cand_id = (top_i[:, :, 0, :, None] * N_KEYS + top_i[:, :, 1, None, :]).reshape(c, PEER_HEADS, -1)
        best_v, best_pos = lax.top_k(cand, PEER_TOPK)
        ids = jnp.take_along_axis(cand_id, best_pos, axis=-1)
        gate = jax.nn.softmax(best_v, axis=-1)
        ug = u_tab[ids]
        act = jax.nn.gelu(jnp.einsum('td,thkd->thk', xc, ug, preferred_element_type=jnp.float32)) * gate
        vg = v_tab[ids]
        return jnp.einsum('thk,thkd->td', act.astype(vg.dtype), vg)

    return lax.map(chunk, chunks).reshape(b, s, dm)


def setup_inputs(seed: int = 0) -> dict:
    key = jax.random.key(seed)
    ks = jax.random.split(key, 32)
    f32 = jnp.float32
    L, D, G, N, C = DEPTH, D_MODEL, S5_GROUPS, S5_STATE, S5_CH

    def nrm(k, shape, scale):
        return jax.random.normal(k, shape, f32) * scale

    def gain(k, shape):
        return 1.0 + 0.02 * jax.random.normal(k, shape, f32)

    return {
        "x": jax.random.normal(ks[0], (BATCH, SEQ, D), f32),
        "w_in": nrm(ks[1], (L, D, IN_WIDTH), D ** -0.5),
        "b_forget": jax.random.uniform(ks[2], (L, N_FOX_HEADS), f32, 1.0, 6.0),
        "w_out": nrm(ks[3], (L, D, D), D ** -0.5),
        "norm_mix": gain(ks[4], (L, D)),
        "norm_ffn": gain(ks[5], (L, D)),
        "fox_q_norm": gain(ks[6], (L, HEAD_DIM)),
        "fox_k_norm": gain(ks[7], (L, HEAD_DIM)),
        "dil_q_norm": gain(ks[8], (L, HEAD_DIM)),
        "dil_k_norm": gain(ks[9], (L, HEAD_DIM)),
        "diff_q_norm": gain(ks[10], (L, DIFF_HALF)),
        "diff_k_norm": gain(ks[11], (L, DIFF_HALF)),
        "diff_lambda": nrm(ks[12], (L, 4, DIFF_HALF), 0.1),
        "diff_out_norm": gain(ks[13], (L, HEAD_DIM)),
        "rel_bias": nrm(ks[14], (REL_BUCKETS, N_DIL_HEADS + N_DIFF_HEADS), 0.2),
        "s5_a_re": -0.5 + 0.01 * jax.random.normal(ks[15], (L, G, N), f32),
        "s5_a_im": math.pi * jnp.arange(N, dtype=f32)[None, None, :] + 0.01 * jax.random.normal(ks[16], (L, G, N), f32),
        "s5_log_dt": jax.random.uniform(ks[17], (L, G), f32, math.log(1e-3), math.log(1e-1)),
        "s5_b_re": nrm(ks[18], (L, G, N, C), (2 * C) ** -0.5),
        "s5_b_im": nrm(ks[19], (L, G, N, C), (2 * C) ** -0.5),
        "s5_c_re": nrm(ks[20], (L, G, C, N), N ** -0.5),
        "s5_c_im": nrm(ks[21], (L, G, C, N), N ** -0.5),
        "s5_d": nrm(ks[22], (L, G, C), 1.0),
        "s5_glu_w": nrm(ks[23], (L, GROUP_WIDTH, GROUP_WIDTH), GROUP_WIDTH ** -0.5),
        "s5_glu_b": nrm(ks[24], (L, GROUP_WIDTH), 0.01),
        "peer_wq": nrm(ks[25], (L, D, PEER_HEADS * PEER_QDIM), D ** -0.5),
        "peer_keys": nrm(ks[26], (L, PEER_HEADS, 2, N_KEYS, PEER_QDIM // 2), (PEER_QDIM // 2) ** -0.5),
        "peer_u": nrm(ks[27], (L, N_EXPERTS, D), D ** -0.5),
        "peer_v": nrm(ks[28], (L, N_EXPERTS, D), PEER_TOPK ** -0.5),
    }


def reference(x, w_in, b_forget, w_out, norm_mix, norm_ffn, fox_q_norm, fox_k_norm,
              dil_q_norm, dil_k_norm, diff_q_norm, diff_k_norm, diff_lambda, diff_out_norm,
              rel_bias, s5_a_re, s5_a_im, s5_log_dt, s5_b_re, s5_b_im, s5_c_re, s5_c_im,
              s5_d, s5_glu_w, s5_glu_b, peer_wq, peer_keys, peer_u, peer_v):
    b, s, _ = x.shape
    for layer in range(DEPTH):
        h = rms_norm(x, norm_mix[layer])
        z = h @ w_in[layer]
        fq, fk, fv, ff, dq, dk, dv, cq, ck, cv, su = jnp.split(z, SPLIT_POINTS, axis=-1)
        fox_o = forgetting_attention(rms_norm(heads(fq, N_FOX_HEADS), fox_q_norm[layer]),
                                     rms_norm(heads(fk, N_FOX_HEADS), fox_k_norm[layer]),
                                     heads(fv, N_FOX_HEADS), ff + b_forget[layer])
        dil_o = dilated_attention(rms_norm(heads(dq, N_DIL_HEADS), dil_q_norm[layer]),
                                  rms_norm(heads(dk, N_DIL_HEADS), dil_k_norm[layer]),
                                  heads(dv, N_DIL_HEADS), rel_bias[:, :N_DIL_HEADS])
        cqh = rms_norm(heads(cq, N_DIFF_HEADS).reshape(b, N_DIFF_HEADS, s, 2, DIFF_HALF), diff_q_norm[layer])
        ckh = rms_norm(heads(ck, N_DIFF_HEADS).reshape(b, N_DIFF_HEADS, s, 2, DIFF_HALF), diff_k_norm[layer])
        lam_init = 0.8 - 0.6 * math.exp(-0.3 * layer)
        lam_p = diff_lambda[layer].astype(jnp.float32)
        lam = jnp.exp(jnp.sum(lam_p[0] * lam_p[1])) - jnp.exp(jnp.sum(lam_p[2] * lam_p[3])) + lam_init
        diff_o = diff_attention(cqh, ckh, heads(cv, N_DIFF_HEADS), rel_bias[:, N_DIL_HEADS:],
                                lam, diff_out_norm[layer], lam_init)
        s5_o = s5_mixer(su, s5_a_re[layer], s5_a_im[layer], s5_log_dt[layer], s5_b_re[layer],
                        s5_b_im[layer], s5_c_re[layer], s5_c_im[layer], s5_d[layer],
                        s5_glu_w[layer], s5_glu_b[layer])
        mixed = jnp.concatenate([fox_o, dil_o, diff_o, s5_o], axis=-1)
        x = x + mixed @ w_out[layer]
        x = x + peer(rms_norm(x, norm_ffn[layer]), peer_wq[layer], peer_keys[layer],
                     peer_u[layer], peer_v[layer])
    return x
```

```cpp
#include <hip/hip_runtime.h>
#include <cstdint>
#include <cstdio>
#include <cmath>

namespace {
constexpr int D = 1024, NB = 8, S = 8192, DEPTH = 4, T = NB * S;
constexpr int GW = 256, HD = 64, INW = 2564;
constexpr int C_FQ = 0, C_FK = 256, C_FV = 512, C_FF = 768, C_DQ = 772, C_DK = 1028, C_DV = 1284, C_CQ = 1540, C_CK = 1796, C_CV = 2052, C_SU = 2308;
constexpr int NKEYS = 128, NEXP = 16384, PH = 8, PK = 16, PQ = 256;
constexpr float EPS = 1e-6f;

__device__ __forceinline__ float gelu_tanh(float x) {
    const float k0 = 0.7978845608028654f, k1 = 0.044715f;
    float u = k0 * (x + k1 * x * x * x);
    return 0.5f * x * (1.f + tanhf(u));
}
__device__ __forceinline__ float log_sigmoid(float x) {
    return x >= 0.f ? -log1pf(expf(-x)) : x - log1pf(expf(x));
}
__device__ __forceinline__ int t5_bucket(int dist) {
    int n = dist < 0 ? 0 : dist;
    float nf = (float)(n < 16 ? 16 : n);
    int large = 16 + (int)(logf(nf / 16.f) / logf(128.f) * 16.f);
    large = large < 31 ? large : 31;
    return n < 16 ? n : large;
}
__device__ __forceinline__ float wave_sum(float v) {
#pragma unroll
    for (int o = 32; o > 0; o >>= 1) v += __shfl_xor(v, o);
    return v;
}

__global__ void k_rstd(const float* __restrict__ x, float* __restrict__ rstd) {
    int row = blockIdx.x * 4 + (threadIdx.x >> 6), lane = threadIdx.x & 63;
    const float* p = x + (size_t)row * D;
    float s = 0.f;
    for (int i = lane; i < D; i += 64) { float v = p[i]; s += v * v; }
    s = wave_sum(s);
    if (lane == 0) rstd[row] = rsqrtf(s / D + EPS);
}

template <bool NORM, bool ACC>
__global__ void __launch_bounds__(256) k_gemm(const float* __restrict__ A, const float* __restrict__ rs, const float* __restrict__ g,
                                              const float* __restrict__ B, float* __restrict__ C, int M, int N, int K) {
    __shared__ float As[16][68];
    __shared__ float Bs[16][68];
    const int tx = threadIdx.x & 15, ty = threadIdx.x >> 4;
    const int m0 = blockIdx.y * 64, n0 = blockIdx.x * 64;
    float acc[4][4];
#pragma unroll
    for (int i = 0; i < 4; ++i)
#pragma unroll
        for (int j = 0; j < 4; ++j) acc[i][j] = 0.f;
    for (int k0 = 0; k0 < K; k0 += 16) {
        {
            int r = threadIdx.x >> 2, c4 = (threadIdx.x & 3) * 4;
            const float* ap = A + (size_t)(m0 + r) * K + k0 + c4;
            float sc = NORM ? rs[m0 + r] : 1.f;
#pragma unroll
            for (int j = 0; j < 4; ++j) { float v = ap[j]; if (NORM) v = v * sc * g[k0 + c4 + j]; As[c4 + j][r] = v; }
            int br = threadIdx.x >> 4, bc = (threadIdx.x & 15) * 4;
#pragma unroll
            for (int j = 0; j < 4; ++j) { int n = n0 + bc + j; Bs[br][bc + j] = n < N ? B[(size_t)(k0 + br) * N + n] : 0.f; }
        }
        __syncthreads();
#pragma unroll
        for (int kk = 0; kk < 16; ++kk) {
            float a[4], b[4];
#pragma unroll
            for (int i = 0; i < 4; ++i) a[i] = As[kk][ty * 4 + i];
#pragma unroll
            for (int j = 0; j < 4; ++j) b[j] = Bs[kk][tx * 4 + j];
#pragma unroll
            for (int i = 0; i < 4; ++i)
#pragma unroll
                for (int j = 0; j < 4; ++j) acc[i][j] += a[i] * b[j];
        }
        __syncthreads();
    }
#pragma unroll
    for (int i = 0; i < 4; ++i)
#pragma unroll
        for (int j = 0; j < 4; ++j) {
            int m = m0 + ty * 4 + i, n = n0 + tx * 4 + j;
            if (n < N) { float* cp = C + (size_t)m * N + n; if (ACC) *cp += acc[i][j]; else *cp = acc[i][j]; }
        }
}

__global__ void k_headnorm(float* __restrict__ z, const float* fqn, const float* fkn, const float* dqn, const float* dkn, const float* cqn, const float* ckn) {
    size_t gid = (size_t)blockIdx.x * blockDim.x + threadIdx.x;
    int item = (int)(gid % 32); size_t tok = gid / 32;
    if (tok >= (size_t)T) return;
    int col, w; const float* gn;
    if (item < 4) { col = C_FQ + item * 64; w = 64; gn = fqn; }
    else if (item < 8) { col = C_FK + (item - 4) * 64; w = 64; gn = fkn; }
    else if (item < 12) { col = C_DQ + (item - 8) * 64; w = 64; gn = dqn; }
    else if (item < 16) { col = C_DK + (item - 12) * 64; w = 64; gn = dkn; }
    else if (item < 24) { col = C_CQ + (item - 16) * 32; w = 32; gn = cqn; }
    else { col = C_CK + (item - 24) * 32; w = 32; gn = ckn; }
    float* p = z + tok * INW + col;
    float s = 0.f;
    for (int i = 0; i < w; ++i) s += p[i] * p[i];
    float r = rsqrtf(s / w + EPS);
    for (int i = 0; i < w; ++i) p[i] = p[i] * r * gn[i];
}

__global__ void k_cum(const float* __restrict__ z, const float* __restrict__ bf, float* __restrict__ cum) {
    int id = blockIdx.x * blockDim.x + threadIdx.x;
    if (id >= NB * 4) return;
    int b = id / 4, h = id % 4;
    float acc = 0.f, bias = bf[h];
    for (int s = 0; s < S; ++s) {
        acc += log_sigmoid(z[((size_t)b * S + s) * INW + C_FF + h] + bias);
        cum[((size_t)b * 4 + h) * S + s] = acc;
    }
}

__global__ void __launch_bounds__(64) k_fox(const float* __restrict__ z, const float* __restrict__ cum, float* __restrict__ mixed) {
    int gid = blockIdx.x * 64 + threadIdx.x;
    int t = S - 1 - (gid % S); int bh = gid / S; int b = bh / 4, h = bh % 4;
    const float* zb = z + (size_t)b * S * INW;
    const float* cm = cum + (size_t)bh * S;
    float q[64], o[64];
#pragma unroll
    for (int i = 0; i < 64; ++i) { q[i] = zb[(size_t)t * INW + C_FQ + h * 64 + i] * 0.125f; o[i] = 0.f; }
    float m = -INFINITY, l = 0.f, cq = cm[t];
    int tmax = __shfl(t, 0);
    for (int s = 0; s <= tmax; ++s) {
        const float* kp = zb + (size_t)s * INW + C_FK + h * 64;
        const float* vp = zb + (size_t)s * INW + C_FV + h * 64;
        float d = 0.f;
#pragma unroll
        for (int i = 0; i < 64; ++i) d += q[i] * kp[i];
        d += cq - cm[s];
        if (s <= t) {
            float mn = fmaxf(m, d), a = expf(m - mn), p = expf(d - mn);
            l = l * a + p;
#pragma unroll
            for (int i = 0; i < 64; ++i) o[i] = o[i] * a + p * vp[i];
            m = mn;
        }
    }
    float inv = 1.f / l;
    float* op = mixed + ((size_t)b * S + t) * D + 0 + h * 64;
#pragma unroll
    for (int i = 0; i < 64; ++i) op[i] = o[i] * inv;
}

__global__ void __launch_bounds__(64) k_dil(const float* __restrict__ z, const float* __restrict__ relb, float* __restrict__ mixed) {
    int gid = blockIdx.x * 64 + threadIdx.x;
    int t = gid % S; int bh = gid / S; int b = bh / 4, h = bh % 4;
    const float* zb = z + (size_t)b * S * INW;
    float q[64], o[64];
#pragma unroll
    for (int i = 0; i < 64; ++i) { q[i] = zb[(size_t)t * INW + C_DQ + h * 64 + i] * 0.125f; o[i] = 0.f; }
    float m = -INFINITY, l = 0.f;
    for (int br = 0; br < 3; ++br) {
        int r = br == 0 ? 1 : (br == 1 ? 4 : 16);
        for (int j = 0; j <= 128; ++j) {
            int s = t - j * r;
            bool ok = (t / r - j) >= 0;
            int sc = ok ? s : t;
            const float* kp = zb + (size_t)sc * INW + C_DK + h * 64;
            const float* vp = zb + (size_t)sc * INW + C_DV + h * 64;
            float d = 0.f;
#pragma unroll
            for (int i = 0; i < 64; ++i) d += q[i] * kp[i];
            d += relb[t5_bucket(r * j) * 8 + h];
            if (ok) {
                float mn = fmaxf(m, d), a = expf(m - mn), p = expf(d - mn);
                l = l * a + p;
#pragma unroll
                for (int i = 0; i < 64; ++i) o[i] = o[i] * a + p * vp[i];
                m = mn;
            }
        }
    }
    float inv = 1.f / l;
    float* op = mixed + ((size_t)b * S + t) * D + 256 + h * 64;
#pragma unroll
    for (int i = 0; i < 64; ++i) op[i] = o[i] * inv;
}

template <int CMP>
__global__ void __launch_bounds__(64) k_diff(const float* __restrict__ z, const float* __restrict__ relb, float* __restrict__ tmp) {
    int gid = blockIdx.x * 64 + threadIdx.x;
    int t = S - 1 - (gid % S); int bh = gid / S; int b = bh / 4, h = bh % 4;
    const float* zb = z + (size_t)b * S * INW;
    const float sc = 0.17677669529663687f;
    float q[32], o[64];
#pragma unroll
    for (int i = 0; i < 32; ++i) q[i] = zb[(size_t)t * INW + C_CQ + h * 64 + CMP * 32 + i] * sc;
#pragma unroll
    for (int i = 0; i < 64; ++i) o[i] = 0.f;
    float m = -INFINITY, l = 0.f;
    int tmax = __shfl(t, 0);
    for (int s = 0; s <= tmax; ++s) {
        const float* kp = zb + (size_t)s * INW + C_CK + h * 64 + CMP * 32;
        const float* vp = zb + (size_t)s * INW + C_CV + h * 64;
        float d = 0.f;
#pragma unroll
        for (int i = 0; i < 32; ++i) d += q[i] * kp[i];
        int rel = t - s;
        d += relb[t5_bucket(rel) * 8 + 4 + h];
        if (rel >= 0) {
            float mn = fmaxf(m, d), a = expf(m - mn), p = expf(d - mn);
            l = l * a + p;
#pragma unroll
            for (int i = 0; i < 64; ++i) o[i] = o[i] * a + p * vp[i];
            m = mn;
        }
    }
    float inv = 1.f / l;
    float* op = tmp + ((size_t)b * S + t) * D + 512 + CMP * 256 + h * 64;
#pragma unroll
    for (int i = 0; i < 64; ++i) op[i] = o[i] * inv;
}
__global__ void k_diff_fin(const float* __restrict__ tmp, const float* __restrict__ lamp, const float* __restrict__ gain, float lam_init, float* __restrict__ mixed) {
    size_t gid = (size_t)blockIdx.x * blockDim.x + threadIdx.x;
    if (gid >= (size_t)T * 4) return;
    size_t tok = gid / 4; int h = (int)(gid % 4);
    float s1 = 0.f, s2 = 0.f;
    for (int i = 0; i < 32; ++i) { s1 += lamp[i] * lamp[32 + i]; s2 += lamp[64 + i] * lamp[96 + i]; }
    float lam = expf(s1) - expf(s2) + lam_init;
    const float* p0 = tmp + tok * D + 512 + h * 64;
    const float* p1 = tmp + tok * D + 768 + h * 64;
    float ss = 0.f;
    for (int i = 0; i < 64; ++i) { float v = p0[i] - lam * p1[i]; ss += v * v; }
    float r = rsqrtf(ss / 64 + EPS) * (1.f - lam_init);
    float* op = mixed + tok * D + 512 + h * 64;
    for (int i = 0; i < 64; ++i) op[i] = (p0[i] - lam * p1[i]) * r * gain[i];
}

__global__ void __launch_bounds__(64) k_s5(const float* __restrict__ z, const float* a_re, const float* a_im, const float* log_dt, const float* b_re, const float* b_im,
                                           const float* c_re, const float* c_im, const float* dsk, float* __restrict__ mixed) {
    int b = blockIdx.x / 16, g = blockIdx.x % 16, n = threadIdx.x;
    float dt = expf(log_dt[g]);
    float ar = a_re[g * 64 + n], ai = a_im[g * 64 + n];
    float mag = expf(dt * ar);
    float abr = mag * cosf(dt * ai), abi = mag * sinf(dt * ai);
    float den = ar * ar + ai * ai, nr = abr - 1.f, ni = abi;
    float cr = (nr * ar + ni * ai) / den, ci = (ni * ar - nr * ai) / den;
    float bbr[16], bbi[16], ccr[16], cci[16];
#pragma unroll
    for (int c = 0; c < 16; ++c) {
        float br = b_re[(g * 64 + n) * 16 + c], bi = b_im[(g * 64 + n) * 16 + c];
        bbr[c] = cr * br - ci * bi; bbi[c] = cr * bi + ci * br;
        ccr[c] = c_re[(g * 16 + c) * 64 + n]; cci[c] = c_im[(g * 16 + c) * 64 + n];
    }
    float dk = (n < 16) ? dsk[g * 16 + n] : 0.f;
    float xr = 0.f, xi = 0.f;
    for (int s = 0; s < S; ++s) {
        const float* up = z + ((size_t)b * S + s) * INW + C_SU + g * 16;
        float u[16];
#pragma unroll
        for (int c = 0; c < 16; ++c) u[c] = up[c];
        float pr = 0.f, pi = 0.f;
#pragma unroll
        for (int c = 0; c < 16; ++c) { pr += bbr[c] * u[c]; pi += bbi[c] * u[c]; }
        float nxr = abr * xr - abi * xi + pr, nxi = abr * xi + abi * xr + pi;
        xr = nxr; xi = nxi;
        float myy = 0.f;
#pragma unroll
        for (int c = 0; c < 16; ++c) {
            float v = wave_sum(ccr[c] * xr - cci[c] * xi);
            if (n == c) myy = v + dk * u[c];
        }
        if (n < 16) mixed[((size_t)b * S + s) * D + 768 + g * 16 + n] = gelu_tanh(myy);
    }
}
__global__ void __launch_bounds__(256) k_glu(float* __restrict__ mixed, const float* __restrict__ w, const float* __restrict__ bias) {
    __shared__ float gs[256];
    size_t tok = blockIdx.x; int j = threadIdx.x;
    float* p = mixed + tok * D + 768;
    gs[j] = p[j];
    __syncthreads();
    float acc = bias[j];
    for (int k = 0; k < 256; ++k) acc += gs[k] * w[k * 256 + j];
    p[j] = gs[j] * (1.f / (1.f + expf(-acc)));
}

__global__ void __launch_bounds__(256) k_peer_top1(const float* __restrict__ q, const float* __restrict__ keys, float* __restrict__ tv, int* __restrict__ ti) {
    extern __shared__ float ks[];
    int hp = blockIdx.y; size_t tok = (size_t)blockIdx.x * 256 + threadIdx.x;
    const float* kg = keys + (size_t)hp * 128 * 128;
    for (int i = threadIdx.x; i < 128 * 128; i += 256) ks[i] = kg[i];
    __syncthreads();
    float qv[128];
    const float* qp = q + tok * 2048 + hp * 128;
#pragma unroll
    for (int i = 0; i < 128; ++i) qv[i] = qp[i];
    float bv[16]; int bi[16];
#pragma unroll
    for (int j = 0; j < 16; ++j) { bv[j] = -INFINITY; bi[j] = 0; }
    for (int k = 0; k < 128; ++k) {
        float d = 0.f;
#pragma unroll
        for (int i = 0; i < 128; ++i) d += qv[i] * ks[k * 128 + i];
        float cv = d; int ci = k;
#pragma unroll
        for (int j = 0; j < 16; ++j) { if (cv > bv[j]) { float tvv = bv[j]; int tii = bi[j]; bv[j] = cv; bi[j] = ci; cv = tvv; ci = tii; } }
    }
    float* ov = tv + (tok * 16 + hp) * 16; int* oi = ti + (tok * 16 + hp) * 16;
#pragma unroll
    for (int j = 0; j < 16; ++j) { ov[j] = bv[j]; oi[j] = bi[j]; }
}
__global__ void __launch_bounds__(256) k_peer_top2(const float* __restrict__ tv, const int* __restrict__ ti, int* __restrict__ ids, float* __restrict__ gates) {
    size_t gid = (size_t)blockIdx.x * 256 + threadIdx.x;
    const float* v0 = tv + gid * 32; const float* v1 = v0 + 16;
    const int* i0 = ti + gid * 32; const int* i1 = i0 + 16;
    float a[16], bb[16];
#pragma unroll
    for (int i = 0; i < 16; ++i) { a[i] = v0[i]; bb[i] = v1[i]; }
    float bv[16]; int bi[16];
#pragma unroll
    for (int j = 0; j < 16; ++j) { bv[j] = -INFINITY; bi[j] = 0; }
#pragma unroll
    for (int i = 0; i < 16; ++i)
#pragma unroll
        for (int jj = 0; jj < 16; ++jj) {
            float cv = a[i] + bb[jj]; int ci = i * 16 + jj;
#pragma unroll
            for (int j = 0; j < 16; ++j) { if (cv > bv[j]) { float tvv = bv[j]; int tii = bi[j]; bv[j] = cv; bi[j] = ci; cv = tvv; ci = tii; } }
        }
    float mx = bv[0], sum = 0.f;
#pragma unroll
    for (int j = 0; j < 16; ++j) { bv[j] = expf(bv[j] - mx); sum += bv[j]; }
    float inv = 1.f / sum;
#pragma unroll
    for (int j = 0; j < 16; ++j) {
        int pi = bi[j] >> 4, pj = bi[j] & 15;
        ids[gid * 16 + j] = i0[pi] * 128 + i1[pj];
        gates[gid * 16 + j] = bv[j] * inv;
    }
}
__global__ void __launch_bounds__(256) k_peer_gather(float* __restrict__ x, const float* __restrict__ rstd, const float* __restrict__ gn, const int* __restrict__ ids,
                                                     const float* __restrict__ gates, const float* __restrict__ ut, const float* __restrict__ vt) {
    __shared__ float hs[1024];
    __shared__ float act[128];
    size_t tok = blockIdx.x; int tid = threadIdx.x, lane = tid & 63, w = tid >> 6;
    float r = rstd[tok];
    float* xp = x + tok * D;
    for (int i = tid; i < D; i += 256) hs[i] = xp[i] * r * gn[i];
    __syncthreads();
    for (int k = w; k < 128; k += 4) {
        int id = ids[tok * 128 + k];
        const float* up = ut + (size_t)id * D;
        float s = 0.f;
        for (int i = lane; i < D; i += 64) s += hs[i] * up[i];
        s = wave_sum(s);
        if (lane == 0) act[k] = gelu_tanh(s) * gates[tok * 128 + k];
    }
    __syncthreads();
    float o[4] = {0.f, 0.f, 0.f, 0.f};
    for (int k = 0; k < 128; ++k) {
        int id = ids[tok * 128 + k];
        const float* vp = vt + (size_t)id * D;
        float a = act[k];
#pragma unroll
        for (int j = 0; j < 4; ++j) o[j] += a * vp[tid + j * 256];
    }
#pragma unroll
    for (int j = 0; j < 4; ++j) xp[tid + j * 256] += o[j];
}
}

extern "C" void kernel_launch(void* const* d_in, const int* in_sizes, int n_in, void* d_out, int out_size, void* d_ws, size_t ws_size, hipStream_t stream) {
    const float* x_in = (const float*)d_in[0];
    const float* w_in = (const float*)d_in[1];
    const float* b_forget = (const float*)d_in[2];
    const float* w_out = (const float*)d_in[3];
    const float* norm_mix = (const float*)d_in[4];
    const float* norm_ffn = (const float*)d_in[5];
    const float* fox_qn = (const float*)d_in[6];
    const float* fox_kn = (const float*)d_in[7];
    const float* dil_qn = (const float*)d_in[8];
    const float* dil_kn = (const float*)d_in[9];
    const float* diff_qn = (const float*)d_in[10];
    const float* diff_kn = (const float*)d_in[11];
    const float* diff_lambda = (const float*)d_in[12];
    const float* diff_on = (const float*)d_in[13];
    const float* rel_bias = (const float*)d_in[14];
    const float* s5_a_re = (const float*)d_in[15];
    const float* s5_a_im = (const float*)d_in[16];
    const float* s5_log_dt = (const float*)d_in[17];
    const float* s5_b_re = (const float*)d_in[18];
    const float* s5_b_im = (const float*)d_in[19];
    const float* s5_c_re = (const float*)d_in[20];
    const float* s5_c_im = (const float*)d_in[21];
    const float* s5_d = (const float*)d_in[22];
    const float* s5_glu_w = (const float*)d_in[23];
    const float* s5_glu_b = (const float*)d_in[24];
    const float* peer_wq = (const float*)d_in[25];
    const float* peer_keys = (const float*)d_in[26];
    const float* peer_u = (const float*)d_in[27];
    const float* peer_v = (const float*)d_in[28];

    float* x = (float*)d_out;
    char* ws = (char*)d_ws;
    float* z = (float*)ws;
    float* mixed = (float*)(ws + (size_t)T * INW * 4);
    float* cum = (float*)(ws + (size_t)T * INW * 4 + (size_t)T * D * 4);
    float* rstd = cum + (size_t)NB * 4 * S;
    float* q = z;
    size_t off = (size_t)T * 2048 * 4;
    int* ids = (int*)(ws + off); off += (size_t)T * 128 * 4;
    float* gates = (float*)(ws + off); off += (size_t)T * 128 * 4;
    float* tv = mixed; int* ti = (int*)(mixed + (size_t)T * 256);
    float* dtmp = mixed;

    hipMemcpyAsync(x, x_in, (size_t)T * D * 4, hipMemcpyDeviceToDevice, stream);
    hipFuncSetAttribute((const void*)k_peer_top1, hipFuncAttributeMaxDynamicSharedMemorySize, 65536);

    for (int l = 0; l < DEPTH; ++l) {
        k_rstd<<<T / 4, 256, 0, stream>>>(x, rstd);
        k_gemm<true, false><<<dim3((INW + 63) / 64, T / 64), 256, 0, stream>>>(x, rstd, norm_mix + l * D, w_in + (size_t)l * D * INW, z, T, INW, D);
        k_headnorm<<<(T * 32) / 256, 256, 0, stream>>>(z, fox_qn + l * 64, fox_kn + l * 64, dil_qn + l * 64, dil_kn + l * 64, diff_qn + l * 32, diff_kn + l * 32);
        k_cum<<<1, 32, 0, stream>>>(z, b_forget + l * 4, cum);
        k_fox<<<NB * 4 * S / 64, 64, 0, stream>>>(z, cum, mixed);
        k_dil<<<NB * 4 * S / 64, 64, 0, stream>>>(z, rel_bias, mixed);
        k_diff<0><<<NB * 4 * S / 64, 64, 0, stream>>>(z, rel_bias, dtmp);
        k_diff<1><<<NB * 4 * S / 64, 64, 0, stream>>>(z, rel_bias, dtmp);
        float lam_init = 0.8f - 0.6f * expf(-0.3f * l);
        k_diff_fin<<<(T * 4) / 256, 256, 0, stream>>>(dtmp, diff_lambda + l * 128, diff_on + l * 64, lam_init, mixed);
        k_s5<<<NB * 16, 64, 0, stream>>>(z, s5_a_re + l * 1024, s5_a_im + l * 1024, s5_log_dt + l * 16, s5_b_re + l * 16384, s5_b_im + l * 16384,
                                          s5_c_re + l * 16384, s5_c_im + l * 16384, s5_d + l * 256, mixed);
        k_glu<<<T, 256, 0, stream>>>(mixed, s5_glu_w + l * 65536, s5_glu_b + l * 256);
        k_gemm<false, true><<<dim3(D / 64, T / 64), 256, 0, stream>>>(mixed, nullptr, nullptr, w_out + (size_t)l * D * D, x, T, D, D);
        k_rstd<<<T / 4, 256, 0, stream>>>(x, rstd);
        k_gemm<true, false><<<dim3(2048 / 64, T / 64), 256, 0, stream>>>(x, rstd, norm_ffn + l * D, peer_wq + (size_t)l * D * 2048, q, T, 2048, D);
        k_peer_top1<<<dim3(T / 256, 16), 256, 65536, stream>>>(q, peer_keys + (size_t)l * 16 * 128 * 128, tv, ti);
        k_peer_top2<<<(T * 8) / 256, 256, 0, stream>>>(tv, ti, ids, gates);
        k_peer_gather<<<T, 256, 0, stream>>>(x, rstd, norm_ffn + l * D, ids, gates, peer_u + (size_t)l * NEXP * D, peer_v + (size_t)l * NEXP * D);
    }
}
```

```cpp
#define HK_ONE_LAUNCH 0
#define HK_NEW_MASK 0x3f
#include <hip/hip_runtime.h>
#include <cstdint>
#include <cstdio>
#include <cmath>

#define LAS3 __attribute__((address_space(3)))
typedef unsigned short bf16_t;
typedef short bf16x8 __attribute__((ext_vector_type(8)));
typedef float f32x4 __attribute__((ext_vector_type(4)));
typedef float f32x16 __attribute__((ext_vector_type(16)));
typedef unsigned u32x4 __attribute__((ext_vector_type(4)));
typedef unsigned u32x2 __attribute__((ext_vector_type(2)));

namespace hk {
constexpr int D = 1024, NB = 8, S = 8192, DEPTH = 4, T = NB * S;
constexpr int INW = 2564;
constexpr int ZP = 2304;
constexpr int ZC_FQ = 0, ZC_FK = 256, ZC_FV = 512, ZC_DQ = 768, ZC_DK = 1024, ZC_DV = 1280, ZC_CQ = 1536, ZC_CK = 1792, ZC_CV = 2048;
constexpr int NEXP = 16384;
constexpr float EPS = 1e-6f;
constexpr float LOG2E = 1.4426950408889634f;
constexpr int TBN = 2112;
constexpr int S5_TC = 64;
constexpr int S5_NCH = S / S5_TC;
constexpr int NTHR = 512;
constexpr int LDS_BYTES = 160 * 1024;
constexpr int LDS_CTL = LDS_BYTES - 256;

constexpr size_t al256(size_t x) { return (x + 255) & ~(size_t)255; }
constexpr size_t WS_CTL = 0;
constexpr size_t WS_CTL_BYTES = 65536;
constexpr size_t WS_XB = WS_CTL + WS_CTL_BYTES;
constexpr size_t WS_ZB = WS_XB + (size_t)T * D * 2;
constexpr size_t WS_SU = WS_ZB + (size_t)T * ZP * 2;
constexpr size_t WS_MIX = WS_SU + (size_t)T * 256 * 4;
constexpr size_t WS_DPART = WS_MIX + (size_t)T * D * 2;
constexpr size_t WS_DLSE = WS_DPART + (size_t)3 * T * 256 * 2;
constexpr size_t WS_SST = WS_DLSE + (size_t)3 * T * 4 * 4;
constexpr size_t WS_CUM = WS_SST + (size_t)NB * 16 * S5_NCH * 128 * 4;
constexpr size_t WS_FLOG = WS_CUM + (size_t)NB * 4 * S * 4;
constexpr size_t WS_RSTD = WS_FLOG + (size_t)NB * 4 * S * 4;
constexpr size_t WS_WIN = WS_RSTD + (size_t)T * 4;
constexpr size_t WS_WF = WS_WIN + (size_t)DEPTH * 2560 * 1024 * 2;
constexpr size_t WS_WOUT = WS_WF + (size_t)DEPTH * 4 * 1024 * 4;
constexpr size_t WS_WQ = WS_WOUT + (size_t)DEPTH * 1024 * 1024 * 2;
constexpr size_t WS_KEYS = WS_WQ + (size_t)DEPTH * 2048 * 1024 * 2;
constexpr size_t WS_GLU = WS_KEYS + (size_t)DEPTH * 16 * 128 * 128 * 2;
constexpr size_t WS_TB = WS_GLU + (size_t)DEPTH * 256 * 256 * 2;
constexpr size_t WS_UT = al256(WS_TB + (size_t)8 * TBN * 4);
constexpr size_t WS_VT = WS_UT + (size_t)NEXP * D * 2;
constexpr size_t WS_END = WS_VT + (size_t)NEXP * D * 2;
constexpr size_t WS_NV_TV = WS_SU;
constexpr size_t WS_NV_IDS = WS_DPART;
static_assert(WS_END <= (size_t)1024 * 1024 * 1024, "workspace map exceeds 1 GiB");
constexpr int CTL_BAR = 0;
constexpr int CTL_Q = 4096;

struct Args {
    const float* in[29];
    float* out;
    unsigned char* ws;
    int ph_lo, ph_hi;
    int use_bar, pad0;
};

__device__ __forceinline__ float bf2f(bf16_t v) { return __uint_as_float((unsigned)v << 16); }
__device__ __forceinline__ bf16_t f2bf(float f) { unsigned u = __float_as_uint(f); u += 0x7fffu + ((u >> 16) & 1u); return (bf16_t)(u >> 16); }
__device__ __forceinline__ unsigned pk2(float lo, float hi) { return (unsigned)f2bf(lo) | ((unsigned)f2bf(hi) << 16); }
__device__ __forceinline__ float gelu_tanh(float x) {
    const float u = 0.7978845608028654f * (x + 0.044715f * x * x * x);
    return x / (1.f + __expf(-2.f * u));
}
__device__ __forceinline__ float log_sigmoid(float x) { return x >= 0.f ? -log1pf(expf(-x)) : x - log1pf(expf(x)); }
__device__ __forceinline__ int t5_bucket(int dist) {
    int n = dist < 0 ? 0 : dist;
    float nf = (float)(n < 16 ? 16 : n);
    int large = 16 + (int)(logf(nf / 16.f) / logf(128.f) * 16.f);
    large = large < 31 ? large : 31;
    return n < 16 ? n : large;
}
__device__ __forceinline__ float wave_sum(float v) {
#pragma unroll
    for (int o = 32; o > 0; o >>= 1) v += __shfl_xor(v, o);
    return v;
}
__device__ __forceinline__ float half_swap_max(float m) {
    auto rr = __builtin_amdgcn_permlane32_swap(__float_as_uint(m), __float_as_uint(m), false, false);
    return fmaxf(__uint_as_float(rr[0]), __uint_as_float(rr[1]));
}
__device__ __forceinline__ float half_swap_sum(float m) {
    auto rr = __builtin_amdgcn_permlane32_swap(__float_as_uint(m), __float_as_uint(m), false, false);
    return __uint_as_float(rr[0]) + __uint_as_float(rr[1]);
}
}
namespace pg8 {
#define PG8_LAS __attribute__((address_space(3)))
typedef unsigned short bf16_t;
typedef short bf16x8 __attribute__((ext_vector_type(8)));
typedef float f32x4 __attribute__((ext_vector_type(4)));
typedef unsigned u32x4 __attribute__((ext_vector_type(4)));
constexpr int BM = 256, BK = 64, HALF = 128, HTB = HALF * BK * 2  , STAGE_BYTES = 8 * HTB, NXCD = 8, WGM = 8;

__host__ __device__ __forceinline__ int lds_byte(int r, int c) { const int st = (r >> 4) * 2 + (c >> 5), rr = r & 15, cc = c & 31, ob = rr * 64 + cc * 2; return st * 1024 + (ob ^ (((ob >> 9) & 1) << 5)); }
__host__ __device__ __forceinline__ void stage_rc(int b, int& R, int& C) { const int st = b / 1024, sb = b % 1024, swz = sb ^ (((sb >> 9) & 1) << 5); R = (st >> 1) * 16 + swz / 64; C = (st & 1) * 32 + (swz % 64) / 2; }
__host__ __device__ __forceinline__ int perm32(int rho) { const int n = rho >> 4, i = rho & 15; return 8 * (i >> 2) + 4 * n + (i & 3); }

struct Unit { int pm, pn; };
struct Gemm { const bf16_t* A; const bf16_t* Bt; int M, N, K; };

struct StaticOrder {
    int nM, nN, nwg, G, c;
    __host__ __device__ void init(int M, int N, int G_, int c_) { nM = M / BM; nN = N / BM; nwg = nM * nN; G = G_; c = c_; }
    __host__ __device__ bool next(int i, Unit& u) const {
        const long L = (long)i * G + c; if (L >= nwg) return false;
        int wgid = (int)L; { const int q = nwg / NXCD, r = nwg % NXCD, xcd = wgid % NXCD, off = wgid / NXCD; wgid = (xcd < r ? xcd * (q + 1) : r * (q + 1) + (xcd - r) * q) + off; }
        const int nig = WGM * nN, gid = wgid / nig, fm = gid * WGM, gsz = (nM - fm) < WGM ? (nM - fm) : WGM;
        u.pm = fm + ((wgid % nig) % gsz); u.pn = (wgid % nig) / gsz; return true;
    }
    __device__ __forceinline__ void a_ready(const Unit&) const {}
    __device__ __forceinline__ void done(const Unit&) const {}
};
__device__ __forceinline__ unsigned cvt_pk_bf16(float lo, float hi) { unsigned r; asm volatile("v_cvt_pk_bf16_f32 %0, %1, %2" : "=v"(r) : "v"(lo), "v"(hi)); return r; }

struct EpiIn {
    static constexpr bool PERM = true, AFTER_DRAIN = false;
    bf16_t* zb; float* su32; const float* rstd;
    const float* g_fq; const float* g_fk; const float* g_dq; const float* g_dk; const float* g_cq; const float* g_ck;
    __device__ __forceinline__ void operator()(const f32x4 (&acc)[2][2][4][2], const Unit& u, int wr, int wc, int fr, int fq) const {
        const int pn = u.pn;
        const int mode = (pn == 0 || pn == 1 || pn == 3 || pn == 4) ? 1 : ((pn == 6 || pn == 7) ? 2 : (pn == 9 ? 3 : 0));
        const float* gp = pn == 0 ? g_fq : pn == 1 ? g_fk : pn == 3 ? g_dq : pn == 4 ? g_dk : pn == 6 ? g_cq : g_ck;
        const float qs = (pn == 0 || pn == 3) ? 0.125f * 1.4426950408889634f : (pn == 6 ? 0.17677669529663687f * 1.4426950408889634f : 1.f);
        f32x4 gv[2][2];
#pragma unroll
        for (int bj = 0; bj < 2; ++bj)
#pragma unroll
            for (int n = 0; n < 2; ++n) {
                if (mode == 1) gv[bj][n] = *(const f32x4*)(gp + 32 * bj + 8 * fq + 4 * n) * qs;
                else if (mode == 2) gv[bj][n] = *(const f32x4*)(gp + 8 * fq + 4 * n) * qs;
                else gv[bj][n] = (f32x4){1.f, 1.f, 1.f, 1.f};
            }
#pragma unroll
        for (int ai = 0; ai < 2; ++ai)
#pragma unroll
            for (int m = 0; m < 4; ++m) {
                const int row = u.pm * BM + ai * HALF + wr * 64 + m * 16 + fr;
                const float rs = rstd[row];
                f32x4 v[2][2];
                float ss[2];
#pragma unroll
                for (int bj = 0; bj < 2; ++bj) {
                    float s = 0.f;
#pragma unroll
                    for (int n = 0; n < 2; ++n) { v[bj][n] = acc[ai][bj][m][n] * rs; const f32x4 x = v[bj][n]; s += (x[0] * x[0] + x[1] * x[1]) + (x[2] * x[2] + x[3] * x[3]); }
                    ss[bj] = s;
                }
                if (mode == 1 || mode == 2) {
                    float s0 = ss[0], s1 = ss[1];
                    s0 += __shfl_xor(s0, 16); s0 += __shfl_xor(s0, 32); s1 += __shfl_xor(s1, 16); s1 += __shfl_xor(s1, 32);
                    float r0, r1;
                    if (mode == 1) { r0 = __builtin_amdgcn_rsqf((s0 + s1) * (1.f / 64.f) + 1e-6f); r1 = r0; }
                    else { r0 = __builtin_amdgcn_rsqf(s0 * (1.f / 32.f) + 1e-6f); r1 = __builtin_amdgcn_rsqf(s1 * (1.f / 32.f) + 1e-6f); }
#pragma unroll
                    for (int n = 0; n < 2; ++n) { v[0][n] = v[0][n] * r0 * gv[0][n]; v[1][n] = v[1][n] * r1 * gv[1][n]; }
                }
                if (mode == 3) {
                    float* op = su32 + (size_t)row * 256 + 64 * wc + 8 * fq;
#pragma unroll
                    for (int bj = 0; bj < 2; ++bj) { *(f32x4*)(op + 32 * bj) = v[bj][0]; *(f32x4*)(op + 32 * bj + 4) = v[bj][1]; }
                } else {
                    bf16_t* op = zb + (size_t)row * 2304 + pn * 256 + 64 * wc + 8 * fq;
#pragma unroll
                    for (int bj = 0; bj < 2; ++bj) { u32x4 w; w.x = cvt_pk_bf16(v[bj][0][0], v[bj][0][1]); w.y = cvt_pk_bf16(v[bj][0][2], v[bj][0][3]); w.z = cvt_pk_bf16(v[bj][1][0], v[bj][1][1]); w.w = cvt_pk_bf16(v[bj][1][2], v[bj][1][3]);
                        *(u32x4*)(op + 32 * bj) = w; }
                }
            }
    }
};
struct EpiOut {
    static constexpr bool PERM = true, AFTER_DRAIN = false;
    float* x; bf16_t* xb;
    __device__ __forceinline__ void operator()(const f32x4 (&acc)[2][2][4][2], const Unit& u, int wr, int wc, int fr, int fq) const {
#pragma unroll
        for (int ai = 0; ai < 2; ++ai)
#pragma unroll
            for (int m = 0; m < 4; ++m) {
                const int row = u.pm * BM + ai * HALF + wr * 64 + m * 16 + fr;
#pragma unroll
                for (int bj = 0; bj < 2; ++bj) {
                    const size_t off = (size_t)row * 1024 + u.pn * BM + bj * HALF + wc * 32 + 8 * fq;
                    f32x4 a = *(const f32x4*)(x + off), b = *(const f32x4*)(x + off + 4);
                    a = a + acc[ai][bj][m][0]; b = b + acc[ai][bj][m][1];
                    *(f32x4*)(x + off) = a; *(f32x4*)(x + off + 4) = b;
                    u32x4 w; w.x = cvt_pk_bf16(a[0], a[1]); w.y = cvt_pk_bf16(a[2], a[3]); w.z = cvt_pk_bf16(b[0], b[1]); w.w = cvt_pk_bf16(b[2], b[3]);
                    *(u32x4*)(xb + off) = w;
                }
            }
    }
};
struct EpiPlain {
    static constexpr bool PERM = true, AFTER_DRAIN = false;
    bf16_t* O; int ldc;
    __device__ __forceinline__ void operator()(const f32x4 (&acc)[2][2][4][2], const Unit& u, int wr, int wc, int fr, int fq) const {
#pragma unroll
        for (int ai = 0; ai < 2; ++ai)
#pragma unroll
            for (int m = 0; m < 4; ++m) {
                const int row = u.pm * BM + ai * HALF + wr * 64 + m * 16 + fr;
#pragma unroll
                for (int bj = 0; bj < 2; ++bj) {
                    const size_t off = (size_t)row * ldc + u.pn * BM + bj * HALF + wc * 32 + 8 * fq;
                    const f32x4 a = acc[ai][bj][m][0], b = acc[ai][bj][m][1];
                    u32x4 w; w.x = cvt_pk_bf16(a[0], a[1]); w.y = cvt_pk_bf16(a[2], a[3]); w.z = cvt_pk_bf16(b[0], b[1]); w.w = cvt_pk_bf16(b[2], b[3]);
                    *(u32x4*)(O + off) = w;
                }
            }
    }
};
template <class Epi, class Sched, bool ALIGN_EPI = false, bool SP2 = false>
__device__ __forceinline__ void gemm_phase(PG8_LAS unsigned char* lds, const Gemm g, const Sched& S, const Epi& E) {
    const int tid = threadIdx.x, wid = __builtin_amdgcn_readfirstlane(tid >> 6), lane = tid & 63, wr = wid >> 2, wc = wid & 3, fr = lane & 15, fq = lane >> 4;
    const int K = g.K, nt = K / BK;
    unsigned voffA[2], voffB[2];
#pragma unroll
    for (int i = 0; i < 2; ++i) { int R, C; stage_rc(tid * 16 + i * 8192, R, C); const int Rb = Epi::PERM ? ((R & ~31) + perm32(R & 31)) : R;
        voffA[i] = (unsigned)(R * K + C) * 2u; voffB[i] = (unsigned)(Rb * K + C) * 2u; }
    const size_t kstep = (size_t)(BK * 2);
    const size_t hstep = (size_t)HALF * K * 2;
    const size_t tstep = 2 * hstep;
    const unsigned ldsw = (unsigned)wid * 1024u;
    const int aoff = lds_byte(wr * 64 + fr, fq * 8), boff = lds_byte(wc * 32 + fr, fq * 8);
#define PG8_SA(b, h) (((b) * 2 + (h)) * HTB)
#define PG8_SB(b, h) ((4 + (b) * 2 + (h)) * HTB)
#define PG8_STAGE(bufoff, gbase, voff) do { _Pragma("unroll") for (int _i = 0; _i < 2; ++_i) \
        __builtin_amdgcn_global_load_lds((const unsigned*)((const char*)(gbase) + (voff)[_i]), (PG8_LAS unsigned*)(lds + (bufoff) + ldsw + _i * 8192), 16, 0, 0); } while (0)
#define PG8_LDA(dst, b, h) do { _Pragma("unroll") for (int m = 0; m < 4; ++m) _Pragma("unroll") for (int k = 0; k < 2; ++k) dst[m][k] = *(const PG8_LAS bf16x8*)(lds + PG8_SA(b, h) + aoff + m * 2048 + k * 1024); } while (0)
#define PG8_LDB(dst, b, h) do { _Pragma("unroll") for (int n = 0; n < 2; ++n) _Pragma("unroll") for (int k = 0; k < 2; ++k) dst[n][k] = *(const PG8_LAS bf16x8*)(lds + PG8_SB(b, h) + boff + n * 2048 + k * 1024); } while (0)
#define PG8_MMA(ai, bj, At, Bt) do { __builtin_amdgcn_s_setprio(1); _Pragma("unroll") for (int m = 0; m < 4; ++m) _Pragma("unroll") for (int n = 0; n < 2; ++n) _Pragma("unroll") for (int k = 0; k < 2; ++k) \
        acc[ai][bj][m][n] = __builtin_amdgcn_mfma_f32_16x16x32_bf16(Bt[n][k], At[m][k], acc[ai][bj][m][n], 0, 0, 0); __builtin_amdgcn_s_setprio(0); } while (0)
#define PG8_WAIT_V(n) asm volatile("s_waitcnt vmcnt(" #n ")" ::: "memory")
#define PG8_WAIT_L(n) asm volatile("s_waitcnt lgkmcnt(" #n ")" ::: "memory")
#define PG8_BAR __builtin_amdgcn_s_barrier()
#define PG8_SCHED __builtin_amdgcn_sched_barrier(0)
    Unit cur, nxt; int ui = 0;
    if (!S.next(0, cur)) return;
    f32x4 acc[2][2][4][2];
#pragma unroll
    for (int a = 0; a < 2; ++a)
#pragma unroll
        for (int b = 0; b < 2; ++b)
#pragma unroll
            for (int m = 0; m < 4; ++m)
#pragma unroll
                for (int n = 0; n < 2; ++n) acc[a][b][m][n] = (f32x4){0.f, 0.f, 0.f, 0.f};
    bf16x8 At[4][2], B0[2][2], B1[2][2];
    const char* cA = (const char*)g.A + (size_t)cur.pm * tstep; const char* cB = (const char*)g.Bt + (size_t)cur.pn * tstep;
    S.a_ready(cur);
    if constexpr (SP2) {
        PG8_STAGE(PG8_SB(0, 0), cB, voffB); PG8_STAGE(PG8_SB(0, 1), cB + hstep, voffB); PG8_STAGE(PG8_SA(0, 0), cA, voffA); PG8_STAGE(PG8_SA(0, 1), cA + hstep, voffA);
        if (wr == 1) PG8_BAR;
        PG8_WAIT_V(2); PG8_BAR;
        PG8_STAGE(PG8_SB(1, 0), cB + kstep, voffB); PG8_STAGE(PG8_SA(1, 0), cA + kstep, voffA); PG8_STAGE(PG8_SB(1, 1), cB + hstep + kstep, voffB);
        PG8_WAIT_V(6); PG8_BAR;
    } else {
        PG8_STAGE(PG8_SB(0, 0), cB, voffB); PG8_STAGE(PG8_SA(0, 0), cA, voffA); PG8_STAGE(PG8_SB(0, 1), cB + hstep, voffB); PG8_STAGE(PG8_SA(0, 1), cA + hstep, voffA);
        if (wr == 1) PG8_BAR;
        PG8_WAIT_V(4); PG8_BAR;
        PG8_STAGE(PG8_SB(1, 0), cB + kstep, voffB); PG8_STAGE(PG8_SA(1, 0), cA + kstep, voffA); PG8_STAGE(PG8_SB(1, 1), cB + hstep + kstep, voffB);
        PG8_WAIT_V(6); PG8_BAR;
    }
    for (;;) {
        const bool has_next = S.next(ui + 1, nxt);
        const char* nA = has_next ? (const char*)g.A + (size_t)nxt.pm * tstep : cA; const char* nB = has_next ? (const char*)g.Bt + (size_t)nxt.pn * tstep : cB;
        for (int t = 0; t < nt; t += 2) {
            const bool last = (t == nt - 2);
            const char* a1 = cA + (size_t)(t + 1) * kstep;
            const char* a2 = last ? nA : cA + (size_t)(t + 2) * kstep; const char* b2 = last ? nB : cB + (size_t)(t + 2) * kstep;
            const char* a3 = a2 + kstep; const char* b3 = b2 + kstep;
            if (last && has_next) S.a_ready(nxt);
            if constexpr (SP2) {
            PG8_LDB(B0, 0, 0); PG8_LDB(B1, 0, 1); PG8_SCHED; PG8_LDA(At, 0, 0); PG8_STAGE(PG8_SA(1, 1), a1 + hstep, voffA);
            PG8_WAIT_V(8); PG8_WAIT_L(0); PG8_BAR; PG8_MMA(0, 0, At, B0); PG8_MMA(0, 1, At, B1); PG8_BAR; PG8_SCHED;
            PG8_LDA(At, 0, 1); PG8_STAGE(PG8_SB(0, 0), b2, voffB); PG8_STAGE(PG8_SB(0, 1), b2 + hstep, voffB); PG8_STAGE(PG8_SA(0, 0), a2, voffA);
            PG8_WAIT_V(8); PG8_WAIT_L(0); PG8_BAR; PG8_MMA(1, 0, At, B0); PG8_MMA(1, 1, At, B1); PG8_BAR; PG8_SCHED;
            PG8_LDB(B0, 1, 0); PG8_LDB(B1, 1, 1); PG8_SCHED; PG8_LDA(At, 1, 0); PG8_STAGE(PG8_SA(0, 1), a2 + hstep, voffA);
            PG8_WAIT_V(8); PG8_WAIT_L(0); PG8_BAR; PG8_MMA(0, 0, At, B0); PG8_MMA(0, 1, At, B1); PG8_BAR; PG8_SCHED;
            PG8_LDA(At, 1, 1); PG8_STAGE(PG8_SB(1, 0), b3, voffB); PG8_STAGE(PG8_SB(1, 1), b3 + hstep, voffB); PG8_STAGE(PG8_SA(1, 0), a3, voffA);
            PG8_WAIT_V(8); PG8_WAIT_L(0); PG8_BAR; PG8_MMA(1, 0, At, B0); PG8_MMA(1, 1, At, B1); PG8_BAR; PG8_SCHED;
            } else {
            PG8_LDB(B0, 0, 0); PG8_SCHED; PG8_LDA(At, 0, 0); PG8_STAGE(PG8_SA(1, 1), a1 + hstep, voffA);
            PG8_WAIT_L(8); PG8_BAR; PG8_WAIT_L(0); PG8_MMA(0, 0, At, B0); PG8_BAR; PG8_SCHED;
            PG8_LDB(B1, 0, 1); PG8_STAGE(PG8_SB(0, 0), b2, voffB);
            PG8_BAR; PG8_WAIT_L(0); PG8_MMA(0, 1, At, B1); PG8_BAR;
            PG8_LDA(At, 0, 1); PG8_STAGE(PG8_SA(0, 0), a2, voffA);
            PG8_BAR; PG8_WAIT_L(0); PG8_MMA(1, 0, At, B0); PG8_BAR; PG8_SCHED;
            PG8_STAGE(PG8_SB(0, 1), b2 + hstep, voffB);
            PG8_WAIT_V(6); PG8_BAR; PG8_MMA(1, 1, At, B1); PG8_BAR;
            PG8_LDB(B0, 1, 0); PG8_SCHED; PG8_LDA(At, 1, 0); PG8_STAGE(PG8_SA(0, 1), a2 + hstep, voffA);
            PG8_WAIT_L(8); PG8_BAR; PG8_WAIT_L(0); PG8_MMA(0, 0, At, B0); PG8_BAR; PG8_SCHED;
            PG8_LDB(B1, 1, 1); PG8_STAGE(PG8_SB(1, 0), b3, voffB);
            PG8_BAR; PG8_WAIT_L(0); PG8_MMA(0, 1, At, B1); PG8_BAR;
            PG8_LDA(At, 1, 1); PG8_STAGE(PG8_SA(1, 0), a3, voffA);
            PG8_BAR; PG8_WAIT_L(0); PG8_MMA(1, 0, At, B0); PG8_BAR; PG8_SCHED;
            PG8_STAGE(PG8_SB(1, 1), b3 + hstep, voffB);
            PG8_WAIT_V(6); PG8_BAR; PG8_MMA(1, 1, At, B1); PG8_BAR;
            }
        }
        if constexpr (ALIGN_EPI) { if (wr == 0) PG8_BAR; }
        if constexpr (!Epi::AFTER_DRAIN) { E(acc, cur, wr, wc, fr, fq); S.done(cur); }
        if (!has_next) break;
#pragma unroll
        for (int a = 0; a < 2; ++a)
#pragma unroll
            for (int b = 0; b < 2; ++b)
#pragma unroll
                for (int m = 0; m < 4; ++m)
#pragma unroll
                    for (int n = 0; n < 2; ++n) acc[a][b][m][n] = (f32x4){0.f, 0.f, 0.f, 0.f};
        cur = nxt; cA = nA; cB = nB; ++ui;
        if constexpr (ALIGN_EPI) { if (wr == 1) PG8_BAR; }
    }
    PG8_WAIT_V(0);
    if constexpr (!ALIGN_EPI) { if (wr == 0) PG8_BAR; }
    PG8_BAR;
    if constexpr (Epi::AFTER_DRAIN) { E.fused(acc, cur, wr, wc, fr, fq, lds, wid, lane); S.done(cur); }
#undef PG8_SA
#undef PG8_SB
#undef PG8_STAGE
#undef PG8_LDA
#undef PG8_LDB
#undef PG8_MMA
#undef PG8_WAIT_V
#undef PG8_WAIT_L
#undef PG8_BAR
#undef PG8_SCHED
}
}
#define XB_TMO      128
#define XB_XCNT(j)  (256  + 64 * (j))
#define XB_XSUB(j)  (1280 + 64 * (j))
#define XB_XGEN(j)  (2304 + 64 * (j))
#define XB_TOP      3328
#define XB_TOPGEN   3392
#define XCD_BAR_WORDS 3456
#define XB_SPIN_CAP (1u << 18)
#define LAS __attribute__((address_space(3)))

__device__ __forceinline__ unsigned xb_ld(unsigned* p)              { return __hip_atomic_load(p, __ATOMIC_RELAXED, __HIP_MEMORY_SCOPE_AGENT); }
__device__ __forceinline__ unsigned xb_add(unsigned* p, unsigned v) { return __hip_atomic_fetch_add(p, v, __ATOMIC_RELAXED, __HIP_MEMORY_SCOPE_AGENT); }
__device__ __forceinline__ unsigned xb_xcc_id() { return (unsigned)__builtin_amdgcn_s_getreg((3 << 11) | 20) & 0xFu; }
#define XB_SPIN(cond, bar) do { unsigned _sp = 0; while (cond) { __builtin_amdgcn_s_sleep(1); \
    if ((++_sp & 255u) == 0u) { if (xb_ld(&(bar)[XB_TMO])) break; if (_sp > XB_SPIN_CAP) { atomicAdd(&(bar)[XB_TMO], 1u); break; } } } } while (0)

struct XcdBarrier {
    unsigned* bar; unsigned x;
    volatile LAS unsigned* st;
};

__device__ __forceinline__ XcdBarrier xcd_barrier_post(unsigned* bar, volatile LAS unsigned* st) {
    XcdBarrier b; b.bar = bar; b.x = xb_xcc_id(); b.st = st;
    if (threadIdx.x == 0) (void)xb_add(&bar[XB_XCNT(b.x)], 1u);
    return b;
}
__device__ __forceinline__ void xcd_barrier_complete(unsigned* bar, unsigned x, unsigned& nloc, unsigned& nx) {
    const unsigned G = gridDim.x * gridDim.y * gridDim.z;
    unsigned sum, cnt, mine, sp = 0u;
    for (;;) {
        sum = 0u; cnt = 0u; mine = 0u;
#pragma unroll
        for (unsigned j = 0; j < 16; ++j) { const unsigned c = xb_ld(&bar[XB_XCNT(j)]); sum += c; cnt += (c > 0u) ? 1u : 0u; mine = (j == x) ? c : mine; }
        if (sum == G) break;
        __builtin_amdgcn_s_sleep(1);
        if ((++sp & 255u) == 0u) { if (xb_ld(&bar[XB_TMO])) break; if (sp > XB_SPIN_CAP) { atomicAdd(&bar[XB_TMO], 1u); break; } }
    }
    nloc = mine > 0u ? mine : 1u; nx = cnt > 0u ? cnt : 1u;
}

__device__ __forceinline__ void xcd_barrier(const XcdBarrier& b) {
    asm volatile("s_waitcnt vmcnt(0)" ::: "memory");
    __syncthreads();
    if (threadIdx.x == 0) {
        unsigned* bar = b.bar;
        __builtin_amdgcn_s_waitcnt(0);
        unsigned nloc = b.st[0], nx = b.st[1];
        if (nloc == 0u) { xcd_barrier_complete(bar, b.x, nloc, nx); b.st[0] = nloc; b.st[1] = nx; }
        const unsigned old = xb_add(&bar[XB_XSUB(b.x)], 1u);
        const unsigned gen = old / nloc;
        if (old + 1u == (gen + 1u) * nloc) {
            __builtin_amdgcn_fence(__ATOMIC_RELEASE, "agent");
            asm volatile("s_waitcnt vmcnt(0)" ::: "memory");
            const unsigned og = xb_add(&bar[XB_TOP], 1u);
            const unsigned tg = og / nx;
            if (og + 1u == (tg + 1u) * nx) xb_add(&bar[XB_TOPGEN], 1u);
            else XB_SPIN(xb_ld(&bar[XB_TOPGEN]) == tg, bar);
            __builtin_amdgcn_fence(__ATOMIC_ACQUIRE, "agent");
            xb_add(&bar[XB_XGEN(b.x)], 1u);
            asm volatile("s_waitcnt vmcnt(0)" ::: "memory");
        } else {
            XB_SPIN(xb_ld(&bar[XB_XGEN(b.x)]) == gen, bar);
            __builtin_amdgcn_fence(__ATOMIC_ACQUIRE, "agent");
            asm volatile("s_waitcnt vmcnt(0)" ::: "memory");
        }
    }
    __syncthreads();
}
namespace hk {
__device__ __forceinline__ int inproj_src_col(int np) {
    const int pn = np >> 8, p = np & 255, bj = p >> 7, wc = (p >> 5) & 3, i = p & 31;
    const int nl = pn * 256 + 64 * wc + 32 * bj + i;
    return nl < 768 ? nl : nl + 4;
}
template <bool INMAP>
__device__ __forceinline__ void tr_tile(const float* __restrict__ src, int ld, const float* __restrict__ g, bf16_t* __restrict__ dst, int K, int k0, int n0, float* lds) {
    const int tid = threadIdx.x;
#pragma unroll
    for (int i = 0; i < 8; ++i) {
        const int idx = tid + 512 * i, kk = idx >> 6, nn = idx & 63;
        const int col = INMAP ? inproj_src_col(n0 + nn) : (n0 + nn);
        float v = src[(size_t)(k0 + kk) * ld + col];
        if (g) v *= g[k0 + kk];
        lds[nn * 65 + kk] = v;
    }
    __syncthreads();
#pragma unroll
    for (int i = 0; i < 8; ++i) {
        const int idx = tid + 512 * i, nn = idx >> 6, kk = idx & 63;
        dst[(size_t)(n0 + nn) * K + k0 + kk] = f2bf(lds[nn * 65 + kk]);
    }
    __syncthreads();
}
__device__ __forceinline__ void phase_weights(const Args& a, unsigned char* ldsb) {
    float* lds = (float*)ldsb;
    const int G = gridDim.x, bid = blockIdx.x, tid = threadIdx.x;
    const float* w_in = a.in[1]; const float* w_out = a.in[3]; const float* norm_mix = a.in[4]; const float* norm_ffn = a.in[5];
    const float* glu_w = a.in[23]; const float* wq = a.in[25]; const float* keys = a.in[26]; const float* relb = a.in[14];
    bf16_t* WIN = (bf16_t*)(a.ws + WS_WIN); bf16_t* WOUT = (bf16_t*)(a.ws + WS_WOUT); bf16_t* WQ = (bf16_t*)(a.ws + WS_WQ); bf16_t* GLU = (bf16_t*)(a.ws + WS_GLU);
    for (int u = bid; u < DEPTH * 1424; u += G) {
        const int l = u / 1424; int r = u % 1424;
        if (r < 640) { const int nt = r >> 4, kt = r & 15; tr_tile<true>(w_in + (size_t)l * D * INW, INW, norm_mix + l * D, WIN + (size_t)l * 2560 * 1024, 1024, kt * 64, nt * 64, lds); }
        else if (r < 896) { r -= 640; const int nt = r >> 4, kt = r & 15; tr_tile<false>(w_out + (size_t)l * D * D, D, nullptr, WOUT + (size_t)l * 1024 * 1024, 1024, kt * 64, nt * 64, lds); }
        else if (r < 1408) { r -= 896; const int nt = r >> 4, kt = r & 15; tr_tile<false>(wq + (size_t)l * D * 2048, 2048, norm_ffn + l * D, WQ + (size_t)l * 2048 * 1024, 1024, kt * 64, nt * 64, lds); }
        else { r -= 1408; const int nt = r >> 2, kt = r & 3; tr_tile<false>(glu_w + (size_t)l * 65536, 256, nullptr, GLU + (size_t)l * 65536, 256, kt * 64, nt * 64, lds); }
    }
    const int gt = bid * NTHR + tid, gn = G * NTHR;
    float* WF = (float*)(a.ws + WS_WF);
    for (int i = gt; i < DEPTH * 4 * 1024; i += gn) { const int l = i >> 12, h = (i >> 10) & 3, k = i & 1023; WF[i] = norm_mix[l * D + k] * w_in[((size_t)l * D + k) * INW + 768 + h]; }
    bf16_t* KB = (bf16_t*)(a.ws + WS_KEYS);
    for (int i = gt; i < DEPTH * 16 * 128 * 128; i += gn) KB[i] = f2bf(keys[i]);
    float* TB = (float*)(a.ws + WS_TB);
    for (int i = gt; i < 8 * TBN; i += gn) { const int hh = i / TBN, d = i % TBN; TB[i] = relb[t5_bucket(d) * 8 + hh] * LOG2E; }
}

__device__ __forceinline__ void finish_token(int tok, const float (&xv)[16], float* __restrict__ xo, bf16_t* __restrict__ xb, float* __restrict__ rstd,
                                             const float* __restrict__ wf, const float* __restrict__ bfor, float* __restrict__ flog, int lane) {
    float ss = 0.f;
#pragma unroll
    for (int i = 0; i < 16; ++i) ss += xv[i] * xv[i];
    ss = wave_sum(ss);
    const float rs = __builtin_amdgcn_rsqf(ss * (1.f / 1024.f) + EPS);
    float* op = xo + (size_t)tok * D; bf16_t* bp = xb + (size_t)tok * D;
    *(f32x4*)(op + 8 * lane) = (f32x4){xv[0], xv[1], xv[2], xv[3]}; *(f32x4*)(op + 8 * lane + 4) = (f32x4){xv[4], xv[5], xv[6], xv[7]};
    *(f32x4*)(op + 512 + 8 * lane) = (f32x4){xv[8], xv[9], xv[10], xv[11]}; *(f32x4*)(op + 512 + 8 * lane + 4) = (f32x4){xv[12], xv[13], xv[14], xv[15]};
    u32x4 w0, w1;
    w0.x = pk2(xv[0], xv[1]); w0.y = pk2(xv[2], xv[3]); w0.z = pk2(xv[4], xv[5]); w0.w = pk2(xv[6], xv[7]);
    w1.x = pk2(xv[8], xv[9]); w1.y = pk2(xv[10], xv[11]); w1.z = pk2(xv[12], xv[13]); w1.w = pk2(xv[14], xv[15]);
    *(u32x4*)(bp + 8 * lane) = w0; *(u32x4*)(bp + 512 + 8 * lane) = w1;
    if (lane == 0) rstd[tok] = rs;
    if (wf) {
        float myff = 0.f;
#pragma unroll
        for (int h = 0; h < 4; ++h) {
            const float* wp = wf + h * 1024;
            const f32x4 a0 = *(const f32x4*)(wp + 8 * lane), a1 = *(const f32x4*)(wp + 8 * lane + 4), a2 = *(const f32x4*)(wp + 512 + 8 * lane), a3 = *(const f32x4*)(wp + 512 + 8 * lane + 4);
            float d = xv[0] * a0[0] + xv[1] * a0[1] + xv[2] * a0[2] + xv[3] * a0[3] + xv[4] * a1[0] + xv[5] * a1[1] + xv[6] * a1[2] + xv[7] * a1[3]
                    + xv[8] * a2[0] + xv[9] * a2[1] + xv[10] * a2[2] + xv[11] * a2[3] + xv[12] * a3[0] + xv[13] * a3[1] + xv[14] * a3[2] + xv[15] * a3[3];
            d = wave_sum(d);
            if (lane == h) myff = d;
        }
        if (lane < 4) { const int b = tok / S, s = tok % S; flog[((size_t)b * 4 + lane) * S + s] = log_sigmoid(myff * rs + bfor[lane]); }
    }
}
__device__ __forceinline__ void phase_xprep(const Args& a) {
    const int lane = threadIdx.x & 63, wv = blockIdx.x * 8 + (threadIdx.x >> 6), nw = gridDim.x * 8;
    const float* x = a.in[0];
    for (int tok = wv; tok < T; tok += nw) {
        const float* p = x + (size_t)tok * D;
        const f32x4 a0 = *(const f32x4*)(p + 8 * lane), a1 = *(const f32x4*)(p + 8 * lane + 4), a2 = *(const f32x4*)(p + 512 + 8 * lane), a3 = *(const f32x4*)(p + 512 + 8 * lane + 4);
        const float xv[16] = {a0[0], a0[1], a0[2], a0[3], a1[0], a1[1], a1[2], a1[3], a2[0], a2[1], a2[2], a2[3], a3[0], a3[1], a3[2], a3[3]};
        finish_token(tok, xv, a.out, (bf16_t*)(a.ws + WS_XB), (float*)(a.ws + WS_RSTD), (const float*)(a.ws + WS_WF), a.in[2], (float*)(a.ws + WS_FLOG), lane);
    }
}
__device__ __forceinline__ void cum_scan(const Args& a, unsigned char* ldsb, int bh) {
    float* lds = (float*)ldsb;
    const int tid = threadIdx.x, lane = tid & 63, w = tid >> 6;
    const float* fl = (const float*)(a.ws + WS_FLOG) + (size_t)bh * S + tid * 16;
    float v[16];
#pragma unroll
    for (int i = 0; i < 4; ++i) { const f32x4 t = *(const f32x4*)(fl + 4 * i); v[4 * i] = t[0]; v[4 * i + 1] = t[1]; v[4 * i + 2] = t[2]; v[4 * i + 3] = t[3]; }
#pragma unroll
    for (int i = 1; i < 16; ++i) v[i] += v[i - 1];
    float incl = v[15];
#pragma unroll
    for (int o = 1; o < 64; o <<= 1) { const float t = __shfl_up(incl, o); if (lane >= o) incl += t; }
    if (lane == 63) lds[w] = incl;
    __syncthreads();
    float base = incl - v[15];
    for (int j = 0; j < w; ++j) base += lds[j];
    float* cp = (float*)(a.ws + WS_CUM) + (size_t)bh * S + tid * 16;
#pragma unroll
    for (int i = 0; i < 4; ++i) *(f32x4*)(cp + 4 * i) = (f32x4){(base + v[4 * i]) * LOG2E, (base + v[4 * i + 1]) * LOG2E, (base + v[4 * i + 2]) * LOG2E, (base + v[4 * i + 3]) * LOG2E};
    __syncthreads();
}

constexpr int AT_KS = 0, AT_VT = 18432, AT_DL = 36864, AT_TBL = 37888, AT_END = AT_TBL + TBN * 4;
__device__ __forceinline__ int swap23(int i) { return (i & ~12) | ((i & 4) << 1) | ((i & 8) >> 1); }
#define MFMA32(A, B, C) __builtin_amdgcn_mfma_f32_32x32x16_bf16(A, B, C, 0, 0, 0)
__device__ __forceinline__ bf16x8 pack8(const f32x16& p, int s8) {
    u32x4 w; w.x = pk2(p[s8], p[s8 + 1]); w.y = pk2(p[s8 + 2], p[s8 + 3]); w.z = pk2(p[s8 + 4], p[s8 + 5]); w.w = pk2(p[s8 + 6], p[s8 + 7]);
    return __builtin_bit_cast(bf16x8, w);
}
__device__ __forceinline__ void stage_kv(unsigned char* lds, int buf, int kv_s, int c_s, const u32x4& kreg, const u32x4& vreg) {
    *(u32x4*)(lds + AT_KS + buf * 9216 + kv_s * 144 + 16 * c_s) = kreg;
    bf16_t* vt = (bf16_t*)(lds + AT_VT + buf * 9216) + kv_s;
    const int r0 = 8 * c_s;
    vt[(r0 + 0) * 72] = (bf16_t)(vreg.x & 0xffffu); vt[(r0 + 1) * 72] = (bf16_t)(vreg.x >> 16);
    vt[(r0 + 2) * 72] = (bf16_t)(vreg.y & 0xffffu); vt[(r0 + 3) * 72] = (bf16_t)(vreg.y >> 16);
    vt[(r0 + 4) * 72] = (bf16_t)(vreg.z & 0xffffu); vt[(r0 + 5) * 72] = (bf16_t)(vreg.z >> 16);
    vt[(r0 + 6) * 72] = (bf16_t)(vreg.w & 0xffffu); vt[(r0 + 7) * 72] = (bf16_t)(vreg.w >> 16);
}
__device__ __forceinline__ void softmax_tile(f32x16 (&p)[2], float A, float& m, float& l, f32x16 (&o)[2], bf16x8 (&pf)[2][2]) {
    float rm = p[0][0];
#pragma unroll
    for (int r = 1; r < 16; ++r) rm = fmaxf(rm, p[0][r]);
#pragma unroll
    for (int r = 0; r < 16; ++r) rm = fmaxf(rm, p[1][r]);
    rm = half_swap_max(rm);
    const float mn = fmaxf(m, rm + A);
    const float f = __builtin_amdgcn_exp2f(m - mn);
    const float c = mn - A;
    float ps = 0.f;
#pragma unroll
    for (int hf = 0; hf < 2; ++hf)
#pragma unroll
        for (int r = 0; r < 16; ++r) { const float e = __builtin_amdgcn_exp2f(p[hf][r] - c); p[hf][r] = e; ps += e; }
    l = l * f + ps;
    if (__any(mn > m)) {
#pragma unroll
        for (int r = 0; r < 16; ++r) { o[0][r] *= f; o[1][r] *= f; }
    }
    m = mn;
#pragma unroll
    for (int hf = 0; hf < 2; ++hf) { pf[hf][0] = pack8(p[hf], 0); pf[hf][1] = pack8(p[hf], 8); }
}
__device__ __forceinline__ void softmax_half(f32x16& p, float& m, float& l, f32x16 (&o)[2]) {
    float rm = p[0];
#pragma unroll
    for (int r = 1; r < 16; ++r) rm = fmaxf(rm, p[r]);
    rm = half_swap_max(rm);
    const float mn = fmaxf(m, rm);
    const float f = __builtin_amdgcn_exp2f(m - mn);
    float ps = 0.f;
#pragma unroll
    for (int r = 0; r < 16; ++r) { const float e = __builtin_amdgcn_exp2f(p[r] - mn); p[r] = e; ps += e; }
    l = l * f + ps;
    if (__any(mn > m)) {
#pragma unroll
        for (int r = 0; r < 16; ++r) { o[0][r] *= f; o[1][r] *= f; }
    }
    m = mn;
}
__device__ __forceinline__ void pv_tile(const unsigned char* lds, int buf, int qi, int hi, const bf16x8 (&pf)[2][2], f32x16 (&o)[2]) {
#pragma unroll
    for (int db = 0; db < 2; ++db)
#pragma unroll
        for (int hf = 0; hf < 2; ++hf)
#pragma unroll
            for (int s = 0; s < 2; ++s) {
                const bf16x8 vf = *(const bf16x8*)(lds + AT_VT + buf * 9216 + (32 * db + qi) * 144 + 2 * (32 * hf + 16 * s + 8 * hi));
                o[db] = MFMA32(vf, pf[hf][s], o[db]);
            }
}
__device__ __forceinline__ void store_ot(bf16_t* dst, const f32x16 (&o)[2], float sc, int hi) {
#pragma unroll
    for (int db = 0; db < 2; ++db)
#pragma unroll
        for (int r4 = 0; r4 < 4; ++r4) {
            u32x2 w; w.x = pk2(o[db][4 * r4] * sc, o[db][4 * r4 + 1] * sc); w.y = pk2(o[db][4 * r4 + 2] * sc, o[db][4 * r4 + 3] * sc);
            *(u32x2*)(dst + 32 * db + 8 * r4 + 4 * hi) = w;
        }
}

__device__ __forceinline__ void fox_unit(const Args& a, unsigned char* lds, int bh, int qb) {
    const int tid = threadIdx.x, lane = tid & 63, w = tid >> 6, qi = lane & 31, hi = lane >> 5;
    const int b = bh >> 2, h = bh & 3;
    const bf16_t* zb = (const bf16_t*)(a.ws + WS_ZB) + (size_t)b * S * ZP;
    const float* cum = (const float*)(a.ws + WS_CUM) + (size_t)bh * S;
    const int q0 = 256 * qb + 32 * w;
    bf16x8 qf[4];
#pragma unroll
    for (int ds = 0; ds < 4; ++ds) qf[ds] = *(const bf16x8*)(zb + (size_t)(q0 + qi) * ZP + ZC_FQ + 64 * h + 16 * ds + 8 * hi);
    const float cq = cum[q0 + qi];
    const int ntiles = 4 * (qb + 1), mylast = 4 * qb + (w >> 1);
    const int kv_s = tid & 63, c_s = tid >> 6;
    const bf16_t* kp = zb + (size_t)kv_s * ZP + ZC_FK + 64 * h + 8 * c_s;
    const bf16_t* vp = zb + (size_t)kv_s * ZP + ZC_FV + 64 * h + 8 * c_s;
    u32x4 kreg = *(const u32x4*)kp, vreg = *(const u32x4*)vp;
    float dreg = (tid < 64) ? cum[kv_s] : 0.f;
    float m = -1e30f, l = 0.f; f32x16 o[2]; o[0] = (f32x16){}; o[1] = (f32x16){};
    const int krow = swap23(qi);
    for (int kt = 0; kt < ntiles; ++kt) {
        const int buf = kt & 1;
        stage_kv(lds, buf, kv_s, c_s, kreg, vreg);
        if (tid < 64) { const float dbase = __shfl(dreg, 0); float* dl = (float*)(lds + AT_DL + buf * 512); dl[tid] = dreg - dbase; if (tid == 0) dl[64] = dbase; }
        __syncthreads();
        if (kt + 1 < ntiles) {
            kreg = *(const u32x4*)(kp + (size_t)(kt + 1) * 64 * ZP); vreg = *(const u32x4*)(vp + (size_t)(kt + 1) * 64 * ZP);
            if (tid < 64) dreg = cum[(kt + 1) * 64 + kv_s];
        }
        if (kt <= mylast) {
            f32x16 p[2];
#pragma unroll
            for (int hf = 0; hf < 2; ++hf) {
                p[hf] = (f32x16){};
#pragma unroll
                for (int ds = 0; ds < 4; ++ds) { const bf16x8 kf = *(const bf16x8*)(lds + AT_KS + buf * 9216 + (32 * hf + krow) * 144 + 32 * ds + 16 * hi); p[hf] = MFMA32(kf, qf[ds], p[hf]); }
            }
            const float* dl = (const float*)(lds + AT_DL + buf * 512);
#pragma unroll
            for (int hf = 0; hf < 2; ++hf)
#pragma unroll
                for (int s = 0; s < 2; ++s) {
                    const f32x4 d0 = *(const f32x4*)(dl + 32 * hf + 16 * s + 8 * hi), d1 = *(const f32x4*)(dl + 32 * hf + 16 * s + 8 * hi + 4);
                    p[hf][8 * s + 0] -= d0[0]; p[hf][8 * s + 1] -= d0[1]; p[hf][8 * s + 2] -= d0[2]; p[hf][8 * s + 3] -= d0[3];
                    p[hf][8 * s + 4] -= d1[0]; p[hf][8 * s + 5] -= d1[1]; p[hf][8 * s + 6] -= d1[2]; p[hf][8 * s + 7] -= d1[3];
                }
            const float A = cq - dl[64];
            if (64 * kt + 63 > q0) {
                const int lim = q0 + qi - 64 * kt - 8 * hi;
#pragma unroll
                for (int hf = 0; hf < 2; ++hf)
#pragma unroll
                    for (int r = 0; r < 16; ++r) if (32 * hf + 16 * (r >> 3) + (r & 7) > lim) p[hf][r] = -INFINITY;
            }
            bf16x8 pf[2][2];
            softmax_tile(p, A, m, l, o, pf);
            pv_tile(lds, buf, qi, hi, pf, o);
        }
    }
    l = half_swap_sum(l);
    store_ot((bf16_t*)(a.ws + WS_MIX) + (size_t)(b * S + q0 + qi) * D + 0 + 64 * h, o, 1.f / l, hi);
    __syncthreads();
}

__device__ __forceinline__ void diff_unit(const Args& a, unsigned char* lds, int layer, int bh, int qb) {
    const int tid = threadIdx.x, lane = tid & 63, w = tid >> 6, qi = lane & 31, hi = lane >> 5;
    const int b = bh >> 2, h = bh & 3;
    const bf16_t* zb = (const bf16_t*)(a.ws + WS_ZB) + (size_t)b * S * ZP;
    const int q0 = 256 * qb + 32 * w;
    { const float* tb = (const float*)(a.ws + WS_TB) + (size_t)(4 + h) * TBN; float* tl = (float*)(lds + AT_TBL); for (int i = tid; i < TBN; i += NTHR) tl[i] = tb[i]; }
    bf16x8 qf[2][2];
#pragma unroll
    for (int c = 0; c < 2; ++c)
#pragma unroll
        for (int ds = 0; ds < 2; ++ds) qf[c][ds] = *(const bf16x8*)(zb + (size_t)(q0 + qi) * ZP + ZC_CQ + 64 * h + 32 * c + 16 * ds + 8 * hi);
    const int ntiles = 4 * (qb + 1), mylast = 4 * qb + (w >> 1);
    const int kv_s = tid & 63, c_s = tid >> 6;
    const bf16_t* kp = zb + (size_t)kv_s * ZP + ZC_CK + 64 * h + 8 * c_s;
    const bf16_t* vp = zb + (size_t)kv_s * ZP + ZC_CV + 64 * h + 8 * c_s;
    u32x4 kreg = *(const u32x4*)kp, vreg = *(const u32x4*)vp;
    float m[2] = {-1e30f, -1e30f}, l[2] = {0.f, 0.f}; f32x16 o[2][2];
#pragma unroll
    for (int c = 0; c < 2; ++c) { o[c][0] = (f32x16){}; o[c][1] = (f32x16){}; }
    const int krow = swap23(qi);
    const float* tl = (const float*)(lds + AT_TBL);
    for (int kt = 0; kt < ntiles; ++kt) {
        const int buf = kt & 1;
        stage_kv(lds, buf, kv_s, c_s, kreg, vreg);
        __syncthreads();
        if (kt + 1 < ntiles) { kreg = *(const u32x4*)(kp + (size_t)(kt + 1) * 64 * ZP); vreg = *(const u32x4*)(vp + (size_t)(kt + 1) * 64 * ZP); }
        if (kt <= mylast) {
            const int dmin = q0 - (64 * kt + 63);
            const bool far_ = dmin >= 1513;
            const float cb = tl[1600];
            const int dq = q0 + qi - 64 * kt - 8 * hi;
#pragma unroll
            for (int hf = 0; hf < 2; ++hf) {
                f32x16 p0 = (f32x16){}, p1 = (f32x16){};
#pragma unroll
                for (int ds = 0; ds < 2; ++ds) {
                    const bf16x8 k0 = *(const bf16x8*)(lds + AT_KS + buf * 9216 + (32 * hf + krow) * 144 + 32 * ds + 16 * hi);
                    const bf16x8 k1 = *(const bf16x8*)(lds + AT_KS + buf * 9216 + (32 * hf + krow) * 144 + 64 + 32 * ds + 16 * hi);
                    p0 = MFMA32(k0, qf[0][ds], p0); p1 = MFMA32(k1, qf[1][ds], p1);
                }
                if (far_) {
#pragma unroll
                    for (int r = 0; r < 16; ++r) { p0[r] += cb; p1[r] += cb; }
                } else {
#pragma unroll
                    for (int r = 0; r < 16; ++r) {
                        const int dist = dq - (32 * hf + 16 * (r >> 3) + (r & 7));
                        const float bb = tl[dist < 0 ? 0 : dist];
                        const bool ok = dist >= 0;
                        p0[r] = ok ? p0[r] + bb : -INFINITY; p1[r] = ok ? p1[r] + bb : -INFINITY;
                    }
                }
                softmax_half(p0, m[0], l[0], o[0]); softmax_half(p1, m[1], l[1], o[1]);
#pragma unroll
                for (int s = 0; s < 2; ++s) {
                    const bf16x8 f0 = pack8(p0, 8 * s), f1 = pack8(p1, 8 * s);
#pragma unroll
                    for (int db = 0; db < 2; ++db) {
                        const bf16x8 vf = *(const bf16x8*)(lds + AT_VT + buf * 9216 + (32 * db + qi) * 144 + 2 * (32 * hf + 16 * s + 8 * hi));
                        o[0][db] = MFMA32(vf, f0, o[0][db]); o[1][db] = MFMA32(vf, f1, o[1][db]);
                    }
                }
            }
        }
    }
    const float lam_init = 0.8f - 0.6f * __expf(-0.3f * (float)layer);
    const float* lp = a.in[12] + layer * 128;
    float s1 = 0.f, s2 = 0.f;
    for (int i = 0; i < 32; ++i) { s1 += lp[i] * lp[32 + i]; s2 += lp[64 + i] * lp[96 + i]; }
    const float lam = __expf(s1) - __expf(s2) + lam_init;
    const float i0 = 1.f / half_swap_sum(l[0]), i1 = lam / half_swap_sum(l[1]);
    float ss = 0.f;
#pragma unroll
    for (int db = 0; db < 2; ++db)
#pragma unroll
        for (int r = 0; r < 16; ++r) { const float v = o[0][db][r] * i0 - o[1][db][r] * i1; o[0][db][r] = v; ss += v * v; }
    ss = half_swap_sum(ss);
    const float rn = __builtin_amdgcn_rsqf(ss * (1.f / 64.f) + EPS) * (1.f - lam_init);
    const float* gn = a.in[13] + layer * 64;
#pragma unroll
    for (int db = 0; db < 2; ++db)
#pragma unroll
        for (int r = 0; r < 16; ++r) o[0][db][r] *= gn[32 * db + (r & 3) + 8 * (r >> 2) + 4 * hi];
    store_ot((bf16_t*)(a.ws + WS_MIX) + (size_t)(b * S + q0 + qi) * D + 512 + 64 * h, o[0], rn, hi);
    __syncthreads();
}

__device__ __forceinline__ void dil_unit(const Args& a, unsigned char* lds, int bh, int br, int rho, int tile) {
    const int tid = threadIdx.x, lane = tid & 63, w = tid >> 6, qi = lane & 31, hi = lane >> 5;
    const int b = bh >> 2, h = bh & 3;
    const int r = br == 0 ? 1 : (br == 1 ? 4 : 16);
    const bf16_t* zb = (const bf16_t*)(a.ws + WS_ZB) + (size_t)b * S * ZP;
    { const float* tb = (const float*)(a.ws + WS_TB) + (size_t)h * TBN; float* tl = (float*)(lds + AT_TBL); for (int i = tid; i < TBN; i += NTHR) tl[i] = tb[i]; }
    const int l0 = 256 * tile, lq0 = l0 + 32 * w;
    const int tq = (lq0 + qi) * r + rho;
    bf16x8 qf[4];
#pragma unroll
    for (int ds = 0; ds < 4; ++ds) qf[ds] = *(const bf16x8*)(zb + (size_t)tq * ZP + ZC_DQ + 64 * h + 16 * ds + 8 * hi);
    const int kv_s = tid & 63, c_s = tid >> 6;
    const int j0 = (l0 == 0) ? 2 : 0;
    auto krow_of = [&](int j) { int kl = l0 - 128 + 64 * j + kv_s; kl = kl < 0 ? 0 : kl; return (size_t)(kl * r + rho) * ZP; };
    u32x4 kreg = *(const u32x4*)(zb + krow_of(j0) + ZC_DK + 64 * h + 8 * c_s), vreg = *(const u32x4*)(zb + krow_of(j0) + ZC_DV + 64 * h + 8 * c_s);
    float m = -1e30f, l = 0.f; f32x16 o[2]; o[0] = (f32x16){}; o[1] = (f32x16){};
    const int krow = swap23(qi);
    const float* tl = (const float*)(lds + AT_TBL);
    for (int j = j0; j < 6; ++j) {
        const int buf = j & 1;
        stage_kv(lds, buf, kv_s, c_s, kreg, vreg);
        __syncthreads();
        if (j + 1 < 6) { kreg = *(const u32x4*)(zb + krow_of(j + 1) + ZC_DK + 64 * h + 8 * c_s); vreg = *(const u32x4*)(zb + krow_of(j + 1) + ZC_DV + 64 * h + 8 * c_s); }
        const int kl0 = l0 - 128 + 64 * j;
        if (kl0 <= lq0 + 31 && kl0 + 63 >= lq0 - 128) {
            f32x16 p[2];
#pragma unroll
            for (int hf = 0; hf < 2; ++hf) {
                p[hf] = (f32x16){};
#pragma unroll
                for (int ds = 0; ds < 4; ++ds) { const bf16x8 kf = *(const bf16x8*)(lds + AT_KS + buf * 9216 + (32 * hf + krow) * 144 + 32 * ds + 16 * hi); p[hf] = MFMA32(kf, qf[ds], p[hf]); }
            }
            const int dq = lq0 + qi - kl0 - 8 * hi;
#pragma unroll
            for (int hf = 0; hf < 2; ++hf)
#pragma unroll
                for (int rr = 0; rr < 16; ++rr) {
                    const int kvoff = 32 * hf + 16 * (rr >> 3) + (rr & 7);
                    const int dd = dq - kvoff;
                    const bool ok = dd >= 0 && dd <= 128 && (kl0 + 8 * hi + kvoff) >= 0;
                    const float bb = tl[ok ? dd * r : 0];
                    p[hf][rr] = ok ? p[hf][rr] + bb : -INFINITY;
                }
            bf16x8 pf[2][2];
            softmax_tile(p, 0.f, m, l, o, pf);
            pv_tile(lds, buf, qi, hi, pf, o);
        }
    }
    l = half_swap_sum(l);
    const size_t tok = (size_t)b * S + tq;
    store_ot((bf16_t*)(a.ws + WS_DPART) + ((size_t)br * T + tok) * 256 + 64 * h, o, 1.f / l, hi);
    if (hi == 0) ((float*)(a.ws + WS_DLSE))[((size_t)br * T + tok) * 4 + h] = m + __builtin_amdgcn_logf(l);
    __syncthreads();
}
}
namespace hk {
struct S5P { float abr, abi, bbr[16], bbi[16]; };
__device__ __forceinline__ void s5_params(const Args& a, int layer, int g, int n, S5P& P, float& dtar, float& dtai) {
    const int lg = layer * 16 + g;
    const float dt = expf(a.in[17][lg]);
    const float ar = a.in[15][lg * 64 + n], ai = a.in[16][lg * 64 + n];
    dtar = dt * ar; dtai = dt * ai;
    const float mag = expf(dtar);
    P.abr = mag * cosf(dtai); P.abi = mag * sinf(dtai);
    const float den = ar * ar + ai * ai, nr = P.abr - 1.f, ni = P.abi;
    const float cr = (nr * ar + ni * ai) / den, ci = (ni * ar - nr * ai) / den;
    const float* brp = a.in[18] + ((size_t)lg * 64 + n) * 16; const float* bip = a.in[19] + ((size_t)lg * 64 + n) * 16;
#pragma unroll
    for (int c = 0; c < 16; ++c) { const float br = brp[c], bi = bip[c]; P.bbr[c] = cr * br - ci * bi; P.bbi[c] = cr * bi + ci * br; }
}
__device__ __forceinline__ void s5_step(const S5P& P, const float* __restrict__ up, float& xr, float& xi) {
    const f32x4 u0 = *(const f32x4*)(up), u1 = *(const f32x4*)(up + 4), u2 = *(const f32x4*)(up + 8), u3 = *(const f32x4*)(up + 12);
    float pr = P.bbr[0] * u0[0], pi = P.bbi[0] * u0[0];
    pr += P.bbr[1] * u0[1]; pi += P.bbi[1] * u0[1]; pr += P.bbr[2] * u0[2]; pi += P.bbi[2] * u0[2]; pr += P.bbr[3] * u0[3]; pi += P.bbi[3] * u0[3];
    pr += P.bbr[4] * u1[0]; pi += P.bbi[4] * u1[0]; pr += P.bbr[5] * u1[1]; pi += P.bbi[5] * u1[1]; pr += P.bbr[6] * u1[2]; pi += P.bbi[6] * u1[2]; pr += P.bbr[7] * u1[3]; pi += P.bbi[7] * u1[3];
    pr += P.bbr[8] * u2[0]; pi += P.bbi[8] * u2[0]; pr += P.bbr[9] * u2[1]; pi += P.bbi[9] * u2[1]; pr += P.bbr[10] * u2[2]; pi += P.bbi[10] * u2[2]; pr += P.bbr[11] * u2[3]; pi += P.bbi[11] * u2[3];
    pr += P.bbr[12] * u3[0]; pi += P.bbi[12] * u3[0]; pr += P.bbr[13] * u3[1]; pi += P.bbi[13] * u3[1]; pr += P.bbr[14] * u3[2]; pi += P.bbi[14] * u3[2]; pr += P.bbr[15] * u3[3]; pi += P.bbi[15] * u3[3];
    const float nxr = P.abr * xr - P.abi * xi + pr, nxi = P.abr * xi + P.abi * xr + pi;
    xr = nxr; xi = nxi;
}
__device__ __forceinline__ void s5_pass1_unit(const Args& a, int layer, int b, int c) {
    const int n = threadIdx.x & 63, w = __builtin_amdgcn_readfirstlane(threadIdx.x >> 6);
    int vz; asm volatile("v_mov_b32 %0, 0" : "=v"(vz));
    const float* su = (const float*)(a.ws + WS_SU) + ((size_t)b * S + c * S5_TC) * 256 + vz;
    float* sst = (float*)(a.ws + WS_SST);
    for (int gg = 0; gg < 2; ++gg) {
        const int g = 2 * w + gg;
        S5P P; float d0, d1; s5_params(a, layer, g, n, P, d0, d1);
        float xr = 0.f, xi = 0.f;
        const float* up = su + g * 16;
        for (int t = 0; t < S5_TC; ++t) s5_step(P, up + (size_t)t * 256, xr, xi);
        float* sp = sst + (((size_t)b * 16 + g) * S5_NCH + c) * 128;
        sp[n] = xr; sp[64 + n] = xi;
    }
}
constexpr int P3_XS = 0, P3_XS_W = 16 * 272, P3_GS = 8 * P3_XS_W, P3_GS_P = 528, P3_END = P3_GS + 64 * P3_GS_P;
__device__ __forceinline__ void s5_pass2_unit(const Args& a, unsigned char* lds, int layer, int b, int seg) {
    const int tid = threadIdx.x, lane = tid & 63, n = lane, w = __builtin_amdgcn_readfirstlane(tid >> 6);
    const int qi = lane & 31, hi = lane >> 5, l15 = lane & 15, kg = lane >> 4;
    int vz; asm volatile("v_mov_b32 %0, 0" : "=v"(vz));
    const float* su = (const float*)(a.ws + WS_SU) + ((size_t)b * S + seg * 256) * 256 + vz;
    const float* sst = (const float*)(a.ws + WS_SST);
    S5P P[2]; float xr[2], xi[2]; bf16x8 cm[2][4]; f32x4 dsk[2];
#pragma unroll
    for (int gg = 0; gg < 2; ++gg) {
        const int g = 2 * w + gg, lg = layer * 16 + g;
        float dtar, dtai; s5_params(a, layer, g, n, P[gg], dtar, dtai);
        const float mg = expf(64.f * dtar), tr = mg * cosf(64.f * dtai), ti = mg * sinf(64.f * dtai);
        float cr = 0.f, ci = 0.f;
        const float* sp = sst + (((size_t)b * 16 + g) * S5_NCH) * 128;
        const int nprev = 4 * seg;
        for (int j = 0; j < nprev; ++j) { const float sr = sp[(size_t)j * 128 + n], si = sp[(size_t)j * 128 + 64 + n]; const float t0 = tr * cr - ti * ci + sr, t1 = tr * ci + ti * cr + si; cr = t0; ci = t1; }
        xr[gg] = cr; xi[gg] = ci;
        const float* crp = a.in[20] + ((size_t)lg * 16 + l15) * 64; const float* cip = a.in[21] + ((size_t)lg * 16 + l15) * 64;
#pragma unroll
        for (int ks = 0; ks < 4; ++ks) {
            const int k0 = 32 * ks + 8 * kg;
            float v[8];
#pragma unroll
            for (int j = 0; j < 8; ++j) v[j] = (k0 < 64) ? crp[k0 + j] : -cip[k0 - 64 + j];
            u32x4 pw; pw.x = pk2(v[0], v[1]); pw.y = pk2(v[2], v[3]); pw.z = pk2(v[4], v[5]); pw.w = pk2(v[6], v[7]);
            cm[gg][ks] = __builtin_bit_cast(bf16x8, pw);
        }
        dsk[gg] = *(const f32x4*)(a.in[22] + lg * 16 + 4 * kg);
    }
    unsigned char* xs = lds + P3_XS + w * P3_XS_W;
    const bf16_t* gluT = (const bf16_t*)(a.ws + WS_GLU) + (size_t)layer * 65536;
    const float* glub = a.in[24] + layer * 256;
    bf16_t* mix = (bf16_t*)(a.ws + WS_MIX) + ((size_t)b * S + seg * 256) * D + 768;
    for (int sub = 0; sub < 4; ++sub) {
#pragma unroll
        for (int gg = 0; gg < 2; ++gg) {
            const int g = 2 * w + gg;
            for (int blk = 0; blk < 4; ++blk) {
                const int t0 = sub * 64 + blk * 16;
                for (int tt = 0; tt < 16; ++tt) {
                    s5_step(P[gg], su + (size_t)(t0 + tt) * 256 + g * 16, xr[gg], xi[gg]);
                    bf16_t* xp = (bf16_t*)(xs + tt * 272);
                    xp[n] = f2bf(xr[gg]); xp[64 + n] = f2bf(xi[gg]);
                }
                f32x4 acc = (f32x4){0.f, 0.f, 0.f, 0.f};
#pragma unroll
                for (int ks = 0; ks < 4; ++ks) { const bf16x8 bfr = *(const bf16x8*)(xs + l15 * 272 + (32 * ks + 8 * kg) * 2); acc = __builtin_amdgcn_mfma_f32_16x16x32_bf16(cm[gg][ks], bfr, acc, 0, 0, 0); }
                const f32x4 uu = *(const f32x4*)(su + (size_t)(t0 + l15) * 256 + g * 16 + 4 * kg);
                u32x2 gw; gw.x = pk2(gelu_tanh(acc[0] + dsk[gg][0] * uu[0]), gelu_tanh(acc[1] + dsk[gg][1] * uu[1])); gw.y = pk2(gelu_tanh(acc[2] + dsk[gg][2] * uu[2]), gelu_tanh(acc[3] + dsk[gg][3] * uu[3]));
                *(u32x2*)(lds + P3_GS + (blk * 16 + l15) * P3_GS_P + (g * 16 + 4 * kg) * 2) = gw;
            }
        }
        __syncthreads();
#pragma unroll
        for (int tb = 0; tb < 2; ++tb) {
            f32x16 acc = (f32x16){};
#pragma unroll
            for (int ks = 0; ks < 16; ++ks) {
                const bf16x8 af = *(const bf16x8*)(gluT + (size_t)(32 * w + qi) * 256 + 16 * ks + 8 * hi);
                const bf16x8 bfr = *(const bf16x8*)(lds + P3_GS + (32 * tb + qi) * P3_GS_P + (16 * ks + 8 * hi) * 2);
                acc = MFMA32(af, bfr, acc);
            }
#pragma unroll
            for (int r4 = 0; r4 < 4; ++r4) {
                const int nn = 32 * w + 8 * r4 + 4 * hi;
                const u32x2 gq = *(const u32x2*)(lds + P3_GS + (32 * tb + qi) * P3_GS_P + nn * 2);
                const f32x4 bb = *(const f32x4*)(glub + nn);
                float ov[4];
#pragma unroll
                for (int e = 0; e < 4; ++e) {
                    const float gval = __uint_as_float(((e & 1) ? (((e >> 1) ? gq.y : gq.x) & 0xffff0000u) : (((e >> 1) ? gq.y : gq.x) << 16)));
                    ov[e] = gval / (1.f + __expf(-(acc[4 * r4 + e] + bb[e])));
                }
                u32x2 ow; ow.x = pk2(ov[0], ov[1]); ow.y = pk2(ov[2], ov[3]);
                *(u32x2*)(mix + (size_t)(sub * 64 + 32 * tb + qi) * D + nn) = ow;
            }
        }
        __syncthreads();
    }
}
__device__ __forceinline__ void phase_p3_elementwise(const Args& a, int layer) {
    const size_t gt = (size_t)blockIdx.x * NTHR + threadIdx.x, gn = (size_t)gridDim.x * NTHR;
    const bf16_t* dp = (const bf16_t*)(a.ws + WS_DPART); const float* dl = (const float*)(a.ws + WS_DLSE); bf16_t* mix = (bf16_t*)(a.ws + WS_MIX);
    for (size_t i = gt; i < (size_t)T * 32; i += gn) {
        const size_t tok = i >> 5; const int ch = (int)(i & 31), h = ch >> 3;
        const float l0 = dl[tok * 4 + h], l1 = dl[((size_t)T + tok) * 4 + h], l2 = dl[((size_t)2 * T + tok) * 4 + h];
        const float mx = fmaxf(l0, fmaxf(l1, l2));
        float w0 = __builtin_amdgcn_exp2f(l0 - mx), w1 = __builtin_amdgcn_exp2f(l1 - mx), w2 = __builtin_amdgcn_exp2f(l2 - mx);
        const float inv = 1.f / (w0 + w1 + w2); w0 *= inv; w1 *= inv; w2 *= inv;
        const u32x4 a0 = *(const u32x4*)(dp + tok * 256 + ch * 8), a1 = *(const u32x4*)(dp + ((size_t)T + tok) * 256 + ch * 8), a2 = *(const u32x4*)(dp + ((size_t)2 * T + tok) * 256 + ch * 8);
        u32x4 o;
#pragma unroll
        for (int j = 0; j < 4; ++j) {
            const float lo = w0 * __uint_as_float(a0[j] << 16) + w1 * __uint_as_float(a1[j] << 16) + w2 * __uint_as_float(a2[j] << 16);
            const float hi = w0 * __uint_as_float(a0[j] & 0xffff0000u) + w1 * __uint_as_float(a1[j] & 0xffff0000u) + w2 * __uint_as_float(a2[j] & 0xffff0000u);
            o[j] = pk2(lo, hi);
        }
        *(u32x4*)(mix + tok * D + 256 + ch * 8) = o;
    }
    const float* pu = a.in[27] + (size_t)layer * NEXP * D; const float* pv = a.in[28] + (size_t)layer * NEXP * D; const float* gn_ = a.in[5] + layer * D;
    bf16_t* ut = (bf16_t*)(a.ws + WS_UT); bf16_t* vt = (bf16_t*)(a.ws + WS_VT);
    for (size_t i = gt; i < (size_t)NEXP * D / 8; i += gn) {
        const size_t e0 = i * 8; const int k = (int)(e0 & 1023);
        const f32x4 u0 = *(const f32x4*)(pu + e0), u1 = *(const f32x4*)(pu + e0 + 4), g0 = *(const f32x4*)(gn_ + k), g1 = *(const f32x4*)(gn_ + k + 4);
        const f32x4 v0 = *(const f32x4*)(pv + e0), v1 = *(const f32x4*)(pv + e0 + 4);
        u32x4 ou, ov;
        ou.x = pk2(u0[0] * g0[0], u0[1] * g0[1]); ou.y = pk2(u0[2] * g0[2], u0[3] * g0[3]); ou.z = pk2(u1[0] * g1[0], u1[1] * g1[1]); ou.w = pk2(u1[2] * g1[2], u1[3] * g1[3]);
        ov.x = pk2(v0[0], v0[1]); ov.y = pk2(v0[2], v0[3]); ov.z = pk2(v1[0], v1[1]); ov.w = pk2(v1[2], v1[3]);
        *(u32x4*)(ut + e0) = ou; *(u32x4*)(vt + e0) = ov;
    }
}

__device__ __forceinline__ unsigned srt(float f) { const unsigned u = __float_as_uint(f); return u ^ ((unsigned)((int)u >> 31) | 0x80000000u); }
__device__ __forceinline__ float unsrt(unsigned u) { return __uint_as_float(u ^ ((~(unsigned)((int)u >> 31)) | 0x80000000u)); }
__device__ __forceinline__ void ins16(unsigned (&top)[16], unsigned pk) {
#pragma unroll
    for (int j = 0; j < 16; ++j) { const unsigned hi_ = top[j] > pk ? top[j] : pk; pk = top[j] > pk ? pk : top[j]; top[j] = hi_; }
}
__device__ __forceinline__ void merge_halves(unsigned (&top)[16]) {
    unsigned lo[16], hi[16];
#pragma unroll
    for (int j = 0; j < 16; ++j) { auto rr = __builtin_amdgcn_permlane32_swap(top[j], top[j], false, false); lo[j] = rr[0]; hi[j] = rr[1]; }
#pragma unroll
    for (int j = 0; j < 16; ++j) top[j] = lo[j] > hi[15 - j] ? lo[j] : hi[15 - j];
#pragma unroll
    for (int d = 8; d >= 1; d >>= 1)
#pragma unroll
        for (int i = 0; i < 16; ++i) if ((i & d) == 0) { const unsigned x = top[i], y = top[i + d]; top[i] = x > y ? x : y; top[i + d] = x > y ? y : x; }
}
constexpr int P6_PL = 0, P6_RS = 32768, P6_END = 32768 + 128;
__device__ __forceinline__ float dot8(const u32x4& a, const unsigned (&xh)[4], float acc) {
#pragma unroll
    for (int j = 0; j < 4; ++j) { acc += __uint_as_float(a[j] << 16) * __uint_as_float(xh[j] << 16); acc += __uint_as_float(a[j] & 0xffff0000u) * __uint_as_float(xh[j] & 0xffff0000u); }
    return acc;
}
__device__ __forceinline__ void peer_unit(const Args& a, unsigned char* lds, int layer, int unit) {
    const int tid = threadIdx.x, lane = tid & 63, w = __builtin_amdgcn_readfirstlane(tid >> 6), qi = lane & 31, hi = lane >> 5;
    const int tok0 = unit * 32;
    const float* xg = a.out;
    float* rsl = (float*)(lds + P6_RS);
    for (int tt = 0; tt < 4; ++tt) {
        const float* p = xg + (size_t)(tok0 + 4 * w + tt) * D;
        const f32x4 a0 = *(const f32x4*)(p + 8 * lane), a1 = *(const f32x4*)(p + 8 * lane + 4), a2 = *(const f32x4*)(p + 512 + 8 * lane), a3 = *(const f32x4*)(p + 512 + 8 * lane + 4);
        float ss = a0[0] * a0[0] + a0[1] * a0[1] + a0[2] * a0[2] + a0[3] * a0[3] + a1[0] * a1[0] + a1[1] * a1[1] + a1[2] * a1[2] + a1[3] * a1[3]
                 + a2[0] * a2[0] + a2[1] * a2[1] + a2[2] * a2[2] + a2[3] * a2[3] + a3[0] * a3[0] + a3[1] * a3[1] + a3[2] * a3[2] + a3[3] * a3[3];
        ss = wave_sum(ss);
        if (lane == 0) rsl[4 * w + tt] = __builtin_amdgcn_rsqf(ss * (1.f / 1024.f) + EPS);
    }
    __syncthreads();
    {
        const float rs2 = rsl[qi];
        const bf16_t* qrow = (const bf16_t*)(a.ws + WS_ZB) + (size_t)(tok0 + qi) * 2048 + 256 * w;
        const bf16_t* kb_ = (const bf16_t*)(a.ws + WS_KEYS) + (size_t)(layer * 16 + 2 * w) * 128 * 128;
        unsigned lst[2][16];
#pragma unroll
        for (int p = 0; p < 2; ++p) {
            bf16x8 qf[8];
#pragma unroll
            for (int ks = 0; ks < 8; ++ks) qf[ks] = *(const bf16x8*)(qrow + 128 * p + 16 * ks + 8 * hi);
            unsigned top[16];
#pragma unroll
            for (int j = 0; j < 16; ++j) top[j] = 0u;
#pragma unroll 1
            for (int kb = 0; kb < 4; ++kb) {
                f32x16 acc = (f32x16){};
#pragma unroll
                for (int ks = 0; ks < 8; ++ks) { const bf16x8 kf = *(const bf16x8*)(kb_ + ((size_t)p * 128 + 32 * kb + qi) * 128 + 16 * ks + 8 * hi); acc = MFMA32(kf, qf[ks], acc); }
#pragma unroll
                for (int r = 0; r < 16; ++r) ins16(top, (srt(acc[r]) & ~127u) | (unsigned)(32 * kb + (r & 3) + 8 * (r >> 2) + 4 * hi));
            }
            merge_halves(top);
#pragma unroll
            for (int j = 0; j < 16; ++j) lst[p][j] = top[j];
        }
        float va[16], vb[16]; unsigned ia[16], ib[16];
#pragma unroll
        for (int j = 0; j < 16; ++j) { va[j] = unsrt(lst[0][j] & ~127u); ia[j] = (lst[0][j] & 127u) << 7; vb[j] = unsrt(lst[1][j] & ~127u); ib[j] = lst[1][j] & 127u; }
        unsigned best[16];
#pragma unroll
        for (int j = 0; j < 16; ++j) best[j] = 0u;
#pragma unroll
        for (int i = 0; i < 16; ++i)
#pragma unroll
            for (int j = 0; j < 16; ++j)
                if ((i + 1) * (j + 1) <= 16) ins16(best, (srt(va[i] + vb[j]) & ~0x3FFFu) | ia[i] | ib[j]);
        float e[16], sum = 0.f;
        const float s0 = unsrt(best[0] & ~0x3FFFu);
#pragma unroll
        for (int j = 0; j < 16; ++j) { e[j] = __builtin_amdgcn_exp2f((unsrt(best[j] & ~0x3FFFu) - s0) * rs2 * LOG2E); sum += e[j]; }
        const float inv = 1.f / sum;
        if (hi == 0) {
            u32x2* pl = (u32x2*)(lds + P6_PL) + qi * 128 + 16 * w;
#pragma unroll
            for (int j = 0; j < 16; ++j) { u32x2 en; en.x = best[j] & 0x3FFFu; en.y = __float_as_uint(e[j] * inv); pl[j] = en; }
        }
    }
    __syncthreads();
    const bf16_t* ut = (const bf16_t*)(a.ws + WS_UT); const bf16_t* vt = (const bf16_t*)(a.ws + WS_VT);
    for (int tt = 0; tt < 4; ++tt) {
        const int tl = 4 * w + tt, tok = tok0 + tl;
        const float rs2 = rsl[tl];
        const float* p = xg + (size_t)tok * D;
        const f32x4 a0 = *(const f32x4*)(p + 8 * lane), a1 = *(const f32x4*)(p + 8 * lane + 4), a2 = *(const f32x4*)(p + 512 + 8 * lane), a3 = *(const f32x4*)(p + 512 + 8 * lane + 4);
        float xv[16] = {a0[0], a0[1], a0[2], a0[3], a1[0], a1[1], a1[2], a1[3], a2[0], a2[1], a2[2], a2[3], a3[0], a3[1], a3[2], a3[3]};
        unsigned xh0[4], xh1[4];
#pragma unroll
        for (int j = 0; j < 4; ++j) { xh0[j] = pk2(xv[2 * j], xv[2 * j + 1]); xh1[j] = pk2(xv[8 + 2 * j], xv[8 + 2 * j + 1]); }
        const u32x2* pl = (const u32x2*)(lds + P6_PL) + tl * 128;
        const u32x2 en0 = pl[lane], en1 = pl[64 + lane];
        float act[2] = {0.f, 0.f};
#pragma unroll
        for (int half = 0; half < 2; ++half) {
            const unsigned idv = half ? en1.x : en0.x;
            float mine = 0.f;
            for (int k = 0; k < 64; k += 8) {
                u32x4 ld0[8], ld1[8];
#pragma unroll
                for (int kk = 0; kk < 8; ++kk) { const unsigned id = __builtin_amdgcn_readlane(idv, k + kk); const bf16_t* up = ut + (size_t)id * D; ld0[kk] = *(const u32x4*)(up + 8 * lane); ld1[kk] = *(const u32x4*)(up + 512 + 8 * lane); }
#pragma unroll
                for (int kk = 0; kk < 8; ++kk) { float d = dot8(ld0[kk], xh0, 0.f); d = dot8(ld1[kk], xh1, d); d = wave_sum(d); if (lane == k + kk) mine = d; }
            }
            const float gate = __uint_as_float(half ? en1.y : en0.y);
            act[half] = gelu_tanh(mine * rs2) * gate;
        }
        float ov[16];
#pragma unroll
        for (int i = 0; i < 16; ++i) ov[i] = 0.f;
#pragma unroll
        for (int half = 0; half < 2; ++half) {
            const unsigned idv = half ? en1.x : en0.x; const float av = act[half];
            for (int k = 0; k < 64; k += 8) {
                u32x4 ld0[8], ld1[8];
#pragma unroll
                for (int kk = 0; kk < 8; ++kk) { const unsigned id = __builtin_amdgcn_readlane(idv, k + kk); const bf16_t* vp = vt + (size_t)id * D; ld0[kk] = *(const u32x4*)(vp + 8 * lane); ld1[kk] = *(const u32x4*)(vp + 512 + 8 * lane); }
#pragma unroll
                for (int kk = 0; kk < 8; ++kk) {
                    const float ak = __uint_as_float(__builtin_amdgcn_readlane(__float_as_uint(av), k + kk));
#pragma unroll
                    for (int j = 0; j < 4; ++j) {
                        ov[2 * j] += ak * __uint_as_float(ld0[kk][j] << 16); ov[2 * j + 1] += ak * __uint_as_float(ld0[kk][j] & 0xffff0000u);
                        ov[8 + 2 * j] += ak * __uint_as_float(ld1[kk][j] << 16); ov[8 + 2 * j + 1] += ak * __uint_as_float(ld1[kk][j] & 0xffff0000u);
                    }
                }
            }
        }
#pragma unroll
        for (int i = 0; i < 16; ++i) xv[i] += ov[i];
        const bool more = layer + 1 < DEPTH;
        finish_token(tok, xv, a.out, (bf16_t*)(a.ws + WS_XB), (float*)(a.ws + WS_RSTD), more ? (const float*)(a.ws + WS_WF) + (size_t)(layer + 1) * 4096 : nullptr,
                     a.in[2] + (more ? (layer + 1) * 4 : 0), (float*)(a.ws + WS_FLOG), lane);
    }
    __syncthreads();
}
}
namespace hk {
constexpr int NPHASE = 2 + 6 * DEPTH;
__device__ __forceinline__ unsigned q_next(unsigned* ctr, unsigned char* lds) {
    volatile LAS3 unsigned* slot = (volatile LAS3 unsigned*)(LAS3 unsigned char*)(lds + LDS_CTL + 32);
    __syncthreads();
    if (threadIdx.x == 0) *slot = __hip_atomic_fetch_add(ctr, 1u, __ATOMIC_RELAXED, __HIP_MEMORY_SCOPE_AGENT);
    __syncthreads();
    return *slot;
}
#define SEAM(k) do { if (a.use_bar && (k) >= a.ph_lo && (k) + 1 < a.ph_hi) { xcd_barrier(bar); } } while (0)
#define ON(k) ((k) >= a.ph_lo && (k) < a.ph_hi)
template <int l>
__device__ __forceinline__ void layer_phases(const Args& a, unsigned char* lds, const XcdBarrier& bar, unsigned* ctl) {
        const int pb = 2 + 6 * l;
        if (ON(pb)) {
            if (blockIdx.x < NB * 4) cum_scan(a, lds, blockIdx.x);
            pg8::Gemm g; g.A = (const bf16_t*)(a.ws + WS_XB); g.Bt = (const bf16_t*)(a.ws + WS_WIN) + (size_t)l * 2560 * 1024; g.M = T; g.N = 2560; g.K = 1024;
            pg8::StaticOrder so; so.init(T, 2560, gridDim.x, blockIdx.x);
            pg8::EpiIn E; E.zb = (bf16_t*)(a.ws + WS_ZB); E.su32 = (float*)(a.ws + WS_SU); E.rstd = (const float*)(a.ws + WS_RSTD);
            E.g_fq = a.in[6] + l * 64; E.g_fk = a.in[7] + l * 64; E.g_dq = a.in[8] + l * 64; E.g_dk = a.in[9] + l * 64; E.g_cq = a.in[10] + l * 32; E.g_ck = a.in[11] + l * 32;
#ifndef HK_NO_G1
            pg8::gemm_phase<pg8::EpiIn, pg8::StaticOrder, true, true>((PG8_LAS unsigned char*)lds, g, so, E);
#endif
        }
        SEAM(pb);
        if (ON(pb + 1)) {
            unsigned* ctr = ctl + CTL_Q + 64 * l;
            for (;;) {
                const unsigned u = q_next(ctr, lds);
                if (u >= 6144u) break;
                if (u < 1024u) {
#ifndef HK_NO_DIFF
 diff_unit(a, lds, l, u & 31, 31 - (u >> 5));
#endif
 }
                else if (u < 2048u) {
#ifndef HK_NO_FOX
 fox_unit(a, lds, (u - 1024u) & 31, 31 - ((u - 1024u) >> 5));
#endif
 }
                else if (u < 5120u) { const unsigned j = u - 2048u, br = j >> 10, jj = j & 1023u, bh = jj & 31u, sub = jj >> 5;
                    const int rho = br == 0 ? 0 : (br == 1 ? (sub & 3) : (sub & 15)), tile = br == 0 ? sub : (br == 1 ? (sub >> 2) : (sub >> 4));

#ifndef HK_NO_DIL
                    dil_unit(a, lds, bh, br, rho, tile);
#endif
 }
                else { const unsigned j = u - 5120u;
#ifndef HK_NO_S51
 s5_pass1_unit(a, l, j >> 7, j & 127u);
#endif
 }
            }
        }
        SEAM(pb + 1);
        if (ON(pb + 2)) {
#ifndef HK_NO_S52
            for (int u = blockIdx.x; u < 256; u += gridDim.x) s5_pass2_unit(a, lds, l, u >> 5, u & 31);
#endif
            phase_p3_elementwise(a, l);
        }
        SEAM(pb + 2);
        if (ON(pb + 3)) {
            pg8::Gemm g; g.A = (const bf16_t*)(a.ws + WS_MIX); g.Bt = (const bf16_t*)(a.ws + WS_WOUT) + (size_t)l * 1024 * 1024; g.M = T; g.N = 1024; g.K = 1024;
            pg8::StaticOrder so; so.init(T, 1024, gridDim.x, blockIdx.x);
            pg8::EpiOut E; E.x = a.out; E.xb = (bf16_t*)(a.ws + WS_XB);
#ifndef HK_NO_G2
            pg8::gemm_phase<pg8::EpiOut, pg8::StaticOrder, true, true>((PG8_LAS unsigned char*)lds, g, so, E);
#endif
        }
        SEAM(pb + 3);
        if (ON(pb + 4)) {
            pg8::Gemm g; g.A = (const bf16_t*)(a.ws + WS_XB); g.Bt = (const bf16_t*)(a.ws + WS_WQ) + (size_t)l * 2048 * 1024; g.M = T; g.N = 2048; g.K = 1024;
            pg8::StaticOrder so; so.init(T, 2048, gridDim.x, blockIdx.x);
            pg8::EpiPlain E; E.O = (bf16_t*)(a.ws + WS_ZB); E.ldc = 2048;
#ifndef HK_NO_G3
            pg8::gemm_phase<pg8::EpiPlain, pg8::StaticOrder, true, true>((PG8_LAS unsigned char*)lds, g, so, E);
#endif
        }
        SEAM(pb + 4);
        if (ON(pb + 5)) {
#ifndef HK_NO_PEER
            for (int u = blockIdx.x; u < T / 32; u += gridDim.x) peer_unit(a, lds, l, u);
#endif
        }
        SEAM(pb + 5);
    }
__global__ void __launch_bounds__(NTHR, 2) hk_mega(Args a) {
    extern __shared__ __attribute__((aligned(16))) unsigned char lds[];
    const int tid = threadIdx.x;
    if (tid < 64) ((LAS3 unsigned*)(lds + LDS_CTL))[tid] = 0u;
    __syncthreads();
    unsigned* ctl = (unsigned*)(a.ws + WS_CTL);
    XcdBarrier bar = xcd_barrier_post(ctl + CTL_BAR, (volatile LAS unsigned*)(LAS3 unsigned char*)(lds + LDS_CTL));
    if (ON(0)) phase_weights(a, lds);
    SEAM(0);
    if (ON(1)) phase_xprep(a);
    SEAM(1);
    layer_phases<0>(a, lds, bar, ctl);
    layer_phases<1>(a, lds, bar, ctl);
    layer_phases<2>(a, lds, bar, ctl);
    layer_phases<3>(a, lds, bar, ctl);
}
#undef SEAM
#undef ON
}
namespace nv {
using namespace hk;
__global__ void __launch_bounds__(64) n_fox(const bf16_t* __restrict__ zb, const float* __restrict__ cum2, bf16_t* __restrict__ mix) {
    int gid = blockIdx.x * 64 + threadIdx.x;
    int t = S - 1 - (gid % S); int bh = gid / S; int b = bh / 4, h = bh % 4;
    const bf16_t* z = zb + (size_t)b * S * ZP; const float* cm = cum2 + (size_t)bh * S;
    float q[64], o[64];
#pragma unroll
    for (int i = 0; i < 64; ++i) { q[i] = bf2f(z[(size_t)t * ZP + ZC_FQ + h * 64 + i]); o[i] = 0.f; }
    float m = -INFINITY, l = 0.f, cq = cm[t];
    int tmax = __shfl(t, 0);
    for (int s = 0; s <= tmax; ++s) {
        const bf16_t* kp = z + (size_t)s * ZP + ZC_FK + h * 64; const bf16_t* vp = z + (size_t)s * ZP + ZC_FV + h * 64;
        float d = 0.f;
#pragma unroll
        for (int i = 0; i < 64; ++i) d += q[i] * bf2f(kp[i]);
        d += cq - cm[s];
        if (s <= t) {
            float mn = fmaxf(m, d), al = exp2f(m - mn), p = exp2f(d - mn);
            l = l * al + p;
#pragma unroll
            for (int i = 0; i < 64; ++i) o[i] = o[i] * al + p * bf2f(vp[i]);
            m = mn;
        }
    }
    float inv = 1.f / l;
    bf16_t* op = mix + ((size_t)b * S + t) * D + h * 64;
#pragma unroll
    for (int i = 0; i < 64; ++i) op[i] = f2bf(o[i] * inv);
}
__global__ void __launch_bounds__(64) n_dil(const bf16_t* __restrict__ zb, const float* __restrict__ tb, bf16_t* __restrict__ mix) {
    int gid = blockIdx.x * 64 + threadIdx.x;
    int t = gid % S; int bh = gid / S; int b = bh / 4, h = bh % 4;
    const bf16_t* z = zb + (size_t)b * S * ZP;
    float q[64], o[64];
#pragma unroll
    for (int i = 0; i < 64; ++i) { q[i] = bf2f(z[(size_t)t * ZP + ZC_DQ + h * 64 + i]); o[i] = 0.f; }
    float m = -INFINITY, l = 0.f;
    for (int br = 0; br < 3; ++br) {
        int r = br == 0 ? 1 : (br == 1 ? 4 : 16);
        for (int j = 0; j <= 128; ++j) {
            bool ok = (t / r - j) >= 0; int sc = ok ? t - j * r : t;
            const bf16_t* kp = z + (size_t)sc * ZP + ZC_DK + h * 64; const bf16_t* vp = z + (size_t)sc * ZP + ZC_DV + h * 64;
            float d = 0.f;
#pragma unroll
            for (int i = 0; i < 64; ++i) d += q[i] * bf2f(kp[i]);
            d += tb[h * TBN + r * j];
            if (ok) {
                float mn = fmaxf(m, d), al = exp2f(m - mn), p = exp2f(d - mn);
                l = l * al + p;
#pragma unroll
                for (int i = 0; i < 64; ++i) o[i] = o[i] * al + p * bf2f(vp[i]);
                m = mn;
            }
        }
    }
    float inv = 1.f / l;
    bf16_t* op = mix + ((size_t)b * S + t) * D + 256 + h * 64;
#pragma unroll
    for (int i = 0; i < 64; ++i) op[i] = f2bf(o[i] * inv);
}
template <int CMP>
__global__ void __launch_bounds__(64) n_diff(const bf16_t* __restrict__ zb, const float* __restrict__ tb, float* __restrict__ tmp) {
    int gid = blockIdx.x * 64 + threadIdx.x;
    int t = S - 1 - (gid % S); int bh = gid / S; int b = bh / 4, h = bh % 4;
    const bf16_t* z = zb + (size_t)b * S * ZP;
    float q[32], o[64];
#pragma unroll
    for (int i = 0; i < 32; ++i) q[i] = bf2f(z[(size_t)t * ZP + ZC_CQ + h * 64 + CMP * 32 + i]);
#pragma unroll
    for (int i = 0; i < 64; ++i) o[i] = 0.f;
    float m = -INFINITY, l = 0.f;
    int tmax = __shfl(t, 0);
    for (int s = 0; s <= tmax; ++s) {
        const bf16_t* kp = z + (size_t)s * ZP + ZC_CK + h * 64 + CMP * 32; const bf16_t* vp = z + (size_t)s * ZP + ZC_CV + h * 64;
        float d = 0.f;
#pragma unroll
        for (int i = 0; i < 32; ++i) d += q[i] * bf2f(kp[i]);
        int rel = t - s; int ri = rel < 0 ? 0 : (rel > 2000 ? 2000 : rel);
        d += tb[(4 + h) * TBN + ri];
        if (rel >= 0) {
            float mn = fmaxf(m, d), al = exp2f(m - mn), p = exp2f(d - mn);
            l = l * al + p;
#pragma unroll
            for (int i = 0; i < 64; ++i) o[i] = o[i] * al + p * bf2f(vp[i]);
            m = mn;
        }
    }
    float inv = 1.f / l;
    float* op = tmp + ((size_t)b * S + t) * 256 + h * 64;
#pragma unroll
    for (int i = 0; i < 64; ++i) op[i] = o[i] * inv;
}
__global__ void n_diff_fin(const float* __restrict__ tmp0, const float* __restrict__ tmp1, const float* __restrict__ lamp, const float* __restrict__ gain, float lam_init, bf16_t* __restrict__ mix) {
    size_t gid = (size_t)blockIdx.x * blockDim.x + threadIdx.x;
    if (gid >= (size_t)T * 4) return;
    size_t tok = gid / 4; int h = (int)(gid % 4);
    float s1 = 0.f, s2 = 0.f;
    for (int i = 0; i < 32; ++i) { s1 += lamp[i] * lamp[32 + i]; s2 += lamp[64 + i] * lamp[96 + i]; }
    float lam = expf(s1) - expf(s2) + lam_init;
    const float* p0 = tmp0 + tok * 256 + h * 64; const float* p1 = tmp1 + tok * 256 + h * 64;
    float ss = 0.f;
    for (int i = 0; i < 64; ++i) { float v = p0[i] - lam * p1[i]; ss += v * v; }
    float r = rsqrtf(ss / 64 + EPS) * (1.f - lam_init);
    bf16_t* op = mix + tok * D + 512 + h * 64;
    for (int i = 0; i < 64; ++i) op[i] = f2bf((p0[i] - lam * p1[i]) * r * gain[i]);
}
__global__ void __launch_bounds__(64) n_s5(const float* __restrict__ su, const float* a_re, const float* a_im, const float* log_dt, const float* b_re, const float* b_im,
                                           const float* c_re, const float* c_im, const float* dsk, float* __restrict__ gbuf) {
    int b = blockIdx.x / 16, g = blockIdx.x % 16, n = threadIdx.x;
    float dt = expf(log_dt[g]);
    float ar = a_re[g * 64 + n], ai = a_im[g * 64 + n];
    float mag = expf(dt * ar);
    float abr = mag * cosf(dt * ai), abi = mag * sinf(dt * ai);
    float den = ar * ar + ai * ai, nr = abr - 1.f, ni = abi;
    float cr = (nr * ar + ni * ai) / den, ci = (ni * ar - nr * ai) / den;
    float bbr[16], bbi[16], ccr[16], cci[16];
#pragma unroll
    for (int c = 0; c < 16; ++c) {
        float br = b_re[(g * 64 + n) * 16 + c], bi = b_im[(g * 64 + n) * 16 + c];
        bbr[c] = cr * br - ci * bi; bbi[c] = cr * bi + ci * br;
        ccr[c] = c_re[(g * 16 + c) * 64 + n]; cci[c] = c_im[(g * 16 + c) * 64 + n];
    }
    float dk = (n < 16) ? dsk[g * 16 + n] : 0.f;
    float xr = 0.f, xi = 0.f;
    for (int s = 0; s < S; ++s) {
        const float* up = su + ((size_t)b * S + s) * 256 + g * 16;
        float u[16];
#pragma unroll
        for (int c = 0; c < 16; ++c) u[c] = up[c];
        float pr = 0.f, pi = 0.f;
#pragma unroll
        for (int c = 0; c < 16; ++c) { pr += bbr[c] * u[c]; pi += bbi[c] * u[c]; }
        float nxr = abr * xr - abi * xi + pr, nxi = abr * xi + abi * xr + pi;
        xr = nxr; xi = nxi;
        float myy = 0.f;
#pragma unroll
        for (int c = 0; c < 16; ++c) { float v = wave_sum(ccr[c] * xr - cci[c] * xi); if (n == c) myy = v + dk * u[c]; }
        if (n < 16) gbuf[((size_t)b * S + s) * 256 + g * 16 + n] = gelu_tanh(myy);
    }
}
__global__ void __launch_bounds__(256) n_glu(const float* __restrict__ gbuf, const float* __restrict__ w, const float* __restrict__ bias, bf16_t* __restrict__ mix) {
    __shared__ float gs[256];
    size_t tok = blockIdx.x; int j = threadIdx.x;
    gs[j] = gbuf[tok * 256 + j];
    __syncthreads();
    float acc = bias[j];
    for (int k = 0; k < 256; ++k) acc += gs[k] * w[k * 256 + j];
    mix[tok * D + 768 + j] = f2bf(gs[j] * (1.f / (1.f + expf(-acc))));
}
template <int MODE>
__global__ void __launch_bounds__(256) n_gemm(const bf16_t* __restrict__ A, const float* __restrict__ g, const float* __restrict__ B, float* __restrict__ X, bf16_t* __restrict__ O, int M, int N, int K) {
    __shared__ float As[16][68];
    __shared__ float Bs[16][68];
    const int tx = threadIdx.x & 15, ty = threadIdx.x >> 4;
    const int m0 = blockIdx.y * 64, n0 = blockIdx.x * 64;
    float acc[4][4];
#pragma unroll
    for (int i = 0; i < 4; ++i)
#pragma unroll
        for (int j = 0; j < 4; ++j) acc[i][j] = 0.f;
    for (int k0 = 0; k0 < K; k0 += 16) {
        { int r = threadIdx.x >> 2, c4 = (threadIdx.x & 3) * 4;
          const bf16_t* ap = A + (size_t)(m0 + r) * K + k0 + c4;
#pragma unroll
          for (int j = 0; j < 4; ++j) { float v = bf2f(ap[j]); if (g) v *= g[k0 + c4 + j]; As[c4 + j][r] = v; }
          int br = threadIdx.x >> 4, bc = (threadIdx.x & 15) * 4;
#pragma unroll
          for (int j = 0; j < 4; ++j) Bs[br][bc + j] = B[(size_t)(k0 + br) * N + n0 + bc + j]; }
        __syncthreads();
#pragma unroll
        for (int kk = 0; kk < 16; ++kk) {
            float av[4], bv[4];
#pragma unroll
            for (int i = 0; i < 4; ++i) av[i] = As[kk][ty * 4 + i];
#pragma unroll
            for (int j = 0; j < 4; ++j) bv[j] = Bs[kk][tx * 4 + j];
#pragma unroll
            for (int i = 0; i < 4; ++i)
#pragma unroll
                for (int j = 0; j < 4; ++j) acc[i][j] += av[i] * bv[j];
        }
        __syncthreads();
    }
#pragma unroll
    for (int i = 0; i < 4; ++i)
#pragma unroll
        for (int j = 0; j < 4; ++j) {
            size_t off = (size_t)(m0 + ty * 4 + i) * N + n0 + tx * 4 + j;
            if (MODE == 0) { float v = X[off] + acc[i][j]; X[off] = v; O[off] = f2bf(v); } else O[off] = f2bf(acc[i][j]);
        }
}
__global__ void n_rstd(const float* __restrict__ x, float* __restrict__ rstd) {
    int row = blockIdx.x * 4 + (threadIdx.x >> 6), lane = threadIdx.x & 63;
    const float* p = x + (size_t)row * D;
    float s = 0.f;
    for (int i = lane; i < D; i += 64) { float v = p[i]; s += v * v; }
    s = wave_sum(s);
    if (lane == 0) rstd[row] = rsqrtf(s / D + EPS);
}
__global__ void __launch_bounds__(256) n_top1(const bf16_t* __restrict__ q, const float* __restrict__ keys, float* __restrict__ tv, int* __restrict__ ti) {
    extern __shared__ float ks[];
    int hp = blockIdx.y; size_t tok = (size_t)blockIdx.x * 256 + threadIdx.x;
    const float* kg = keys + (size_t)hp * 128 * 128;
    for (int i = threadIdx.x; i < 128 * 128; i += 256) ks[i] = kg[i];
    __syncthreads();
    float qv[128];
    const bf16_t* qp = q + tok * 2048 + hp * 128;
#pragma unroll
    for (int i = 0; i < 128; ++i) qv[i] = bf2f(qp[i]);
    float bv[16]; int bi[16];
#pragma unroll
    for (int j = 0; j < 16; ++j) { bv[j] = -INFINITY; bi[j] = 0; }
    for (int k = 0; k < 128; ++k) {
        float d = 0.f;
#pragma unroll
        for (int i = 0; i < 128; ++i) d += qv[i] * ks[k * 128 + i];
        float cv = d; int ci = k;
#pragma unroll
        for (int j = 0; j < 16; ++j) { if (cv > bv[j]) { float tvv = bv[j]; int tii = bi[j]; bv[j] = cv; bi[j] = ci; cv = tvv; ci = tii; } }
    }
    float* ov = tv + (tok * 16 + hp) * 16; int* oi = ti + (tok * 16 + hp) * 16;
#pragma unroll
    for (int j = 0; j < 16; ++j) { ov[j] = bv[j]; oi[j] = bi[j]; }
}
__global__ void __launch_bounds__(256) n_top2(const float* __restrict__ tv, const int* __restrict__ ti, const float* __restrict__ rstd2, int* __restrict__ ids, float* __restrict__ gates) {
    size_t gid = (size_t)blockIdx.x * 256 + threadIdx.x;
    const float* v0 = tv + gid * 32; const float* v1 = v0 + 16; const int* i0 = ti + gid * 32; const int* i1 = i0 + 16;
    const float rs = rstd2[gid >> 3];
    float av[16], bb[16];
#pragma unroll
    for (int i = 0; i < 16; ++i) { av[i] = v0[i]; bb[i] = v1[i]; }
    float bv[16]; int bi[16];
#pragma unroll
    for (int j = 0; j < 16; ++j) { bv[j] = -INFINITY; bi[j] = 0; }
#pragma unroll
    for (int i = 0; i < 16; ++i)
#pragma unroll
        for (int jj = 0; jj < 16; ++jj) {
            float cv = av[i] + bb[jj]; int ci = i * 16 + jj;
#pragma unroll
            for (int j = 0; j < 16; ++j) { if (cv > bv[j]) { float tvv = bv[j]; int tii = bi[j]; bv[j] = cv; bi[j] = ci; cv = tvv; ci = tii; } }
        }
    float mx = bv[0], sum = 0.f;
#pragma unroll
    for (int j = 0; j < 16; ++j) { bv[j] = expf((bv[j] - mx) * rs); sum += bv[j]; }
    float inv = 1.f / sum;
#pragma unroll
    for (int j = 0; j < 16; ++j) { int pi = bi[j] >> 4, pj = bi[j] & 15; ids[gid * 16 + j] = i0[pi] * 128 + i1[pj]; gates[gid * 16 + j] = bv[j] * inv; }
}
__global__ void __launch_bounds__(256) n_gather(float* __restrict__ x, const float* __restrict__ rstd2, const float* __restrict__ gn, const int* __restrict__ ids,
                                                const float* __restrict__ gates, const float* __restrict__ ut, const float* __restrict__ vt) {
    __shared__ float hs[1024];
    __shared__ float act[128];
    size_t tok = blockIdx.x; int tid = threadIdx.x, lane = tid & 63, w = tid >> 6;
    float r = rstd2[tok];
    float* xp = x + tok * D;
    for (int i = tid; i < D; i += 256) hs[i] = xp[i] * r * gn[i];
    __syncthreads();
    for (int k = w; k < 128; k += 4) {
        int id = ids[tok * 128 + k];
        const float* up = ut + (size_t)id * D;
        float s = 0.f;
        for (int i = lane; i < D; i += 64) s += hs[i] * up[i];
        s = wave_sum(s);
        if (lane == 0) act[k] = gelu_tanh(s) * gates[tok * 128 + k];
    }
    __syncthreads();
    float o[4] = {0.f, 0.f, 0.f, 0.f};
    for (int k = 0; k < 128; ++k) {
        int id = ids[tok * 128 + k];
        const float* vp = vt + (size_t)id * D;
        float av = act[k];
#pragma unroll
        for (int j = 0; j < 4; ++j) o[j] += av * vp[tid + j * 256];
    }
#pragma unroll
    for (int j = 0; j < 4; ++j) xp[tid + j * 256] += o[j];
}
__global__ void __launch_bounds__(512) n_finish(Args a, int lnext) {
    const int lane = threadIdx.x & 63, wv = blockIdx.x * 8 + (threadIdx.x >> 6), nw = gridDim.x * 8;
    for (int tok = wv; tok < T; tok += nw) {
        const float* p = a.out + (size_t)tok * D;
        const f32x4 a0 = *(const f32x4*)(p + 8 * lane), a1 = *(const f32x4*)(p + 8 * lane + 4), a2 = *(const f32x4*)(p + 512 + 8 * lane), a3 = *(const f32x4*)(p + 512 + 8 * lane + 4);
        const float xv[16] = {a0[0], a0[1], a0[2], a0[3], a1[0], a1[1], a1[2], a1[3], a2[0], a2[1], a2[2], a2[3], a3[0], a3[1], a3[2], a3[3]};
        finish_token(tok, xv, a.out, (bf16_t*)(a.ws + WS_XB), (float*)(a.ws + WS_RSTD), lnext < DEPTH ? (const float*)(a.ws + WS_WF) + (size_t)lnext * 4096 : nullptr,
                     a.in[2] + (lnext < DEPTH ? lnext * 4 : 0), (float*)(a.ws + WS_FLOG), lane);
    }
}
}
#ifndef HK_NEW_MASK
#define HK_NEW_MASK 0x3f
#endif
#ifndef HK_ONE_LAUNCH
#define HK_ONE_LAUNCH 1
#endif
extern "C" void kernel_launch(void* const* d_in, const int* in_sizes, int n_in, void* d_out, int out_size, void* d_ws, size_t ws_size, hipStream_t stream) {
    using namespace hk;
    (void)in_sizes; (void)n_in; (void)out_size; (void)ws_size;
    static int grid = 0;
    if (!grid) {
        int dev = 0, cus = 0, per_cu = 0;
        (void)hipGetDevice(&dev);
        (void)hipDeviceGetAttribute(&cus, hipDeviceAttributeMultiprocessorCount, dev);
        if (hipFuncSetAttribute((const void*)hk_mega, hipFuncAttributeMaxDynamicSharedMemorySize, LDS_BYTES) != hipSuccess) fprintf(stderr, "hipFuncSetAttribute failed\n");
        (void)hipOccupancyMaxActiveBlocksPerMultiprocessor(&per_cu, (const void*)hk_mega, NTHR, LDS_BYTES);
        if (per_cu < 1) fprintf(stderr, "occupancy query says %d blocks per CU\n", per_cu);
        grid = cus > 0 ? cus : 256;
    }
    Args a{};
    for (int i = 0; i < 29; ++i) a.in[i] = (const float*)d_in[i];
    a.out = (float*)d_out; a.ws = (unsigned char*)d_ws;
    (void)hipMemsetAsync(a.ws + WS_CTL, 0, WS_CTL_BYTES, stream);
    auto run = [&](int lo, int hi, int bar) { Args b = a; b.ph_lo = lo; b.ph_hi = hi; b.use_bar = bar; b.pad0 = 0; hipLaunchKernelGGL(hk_mega, dim3(grid), dim3(NTHR), LDS_BYTES, stream, b); };
#if HK_ONE_LAUNCH
    run(0, NPHASE, 1);
#else
    unsigned char* ws = a.ws;
    bf16_t* zb = (bf16_t*)(ws + WS_ZB); bf16_t* mix = (bf16_t*)(ws + WS_MIX); bf16_t* xb = (bf16_t*)(ws + WS_XB);
    float* su = (float*)(ws + WS_SU); float* cum = (float*)(ws + WS_CUM); float* tb = (float*)(ws + WS_TB);
    (void)hipFuncSetAttribute((const void*)nv::n_top1, hipFuncAttributeMaxDynamicSharedMemorySize, 65536);
    run(0, 1, 0); run(1, 2, 0);
    for (int l = 0; l < DEPTH; ++l) {
        const int pb = 2 + 6 * l;
        run(pb, pb + 1, 0);
        if (HK_NEW_MASK & 2) run(pb + 1, pb + 2, 0);
        if (HK_NEW_MASK & 4) run(pb + 2, pb + 3, 0);
        if (!(HK_NEW_MASK & 2)) {
            nv::n_fox<<<NB * 4 * S / 64, 64, 0, stream>>>(zb, cum, mix);
            nv::n_dil<<<NB * 4 * S / 64, 64, 0, stream>>>(zb, tb, mix);
            float* t0 = (float*)(ws + WS_DPART); float* t1 = (float*)(ws + WS_UT);
            nv::n_diff<0><<<NB * 4 * S / 64, 64, 0, stream>>>(zb, tb, t0);
            nv::n_diff<1><<<NB * 4 * S / 64, 64, 0, stream>>>(zb, tb, t1);
            const float lam_init = 0.8f - 0.6f * expf(-0.3f * l);
            nv::n_diff_fin<<<(T * 4) / 256, 256, 0, stream>>>(t0, t1, a.in[12] + l * 128, a.in[13] + l * 64, lam_init, mix);
            float* gbuf = (float*)(ws + WS_VT);
            nv::n_s5<<<NB * 16, 64, 0, stream>>>(su, a.in[15] + l * 1024, a.in[16] + l * 1024, a.in[17] + l * 16, a.in[18] + l * 16384, a.in[19] + l * 16384,
                                                  a.in[20] + l * 16384, a.in[21] + l * 16384, a.in[22] + l * 256, gbuf);
            nv::n_glu<<<T, 256, 0, stream>>>(gbuf, a.in[23] + l * 65536, a.in[24] + l * 256, mix);
        }
        if (HK_NEW_MASK & 8) run(pb + 3, pb + 4, 0);
        else nv::n_gemm<0><<<dim3(D / 64, T / 64), 256, 0, stream>>>(mix, nullptr, a.in[3] + (size_t)l * D * D, a.out, xb, T, D, D);
        if (HK_NEW_MASK & 16) run(pb + 4, pb + 5, 0);
        else nv::n_gemm<1><<<dim3(2048 / 64, T / 64), 256, 0, stream>>>(xb, a.in[5] + l * D, a.in[25] + (size_t)l * D * 2048, nullptr, zb, T, 2048, D);
        if (HK_NEW_MASK & 32) run(pb + 5, pb + 6, 0);
        else {
            float* rs2 = (float*)(ws + WS_DLSE); float* tv = (float*)(ws + WS_SU); int* ti = (int*)(ws + WS_MIX);
            int* ids = (int*)(ws + WS_DPART); float* gates = (float*)(ws + WS_DPART + (size_t)T * 128 * 4);
            nv::n_rstd<<<T / 4, 256, 0, stream>>>(a.out, rs2);
            nv::n_top1<<<dim3(T / 256, 16), 256, 65536, stream>>>(zb, a.in[26] + (size_t)l * 16 * 128 * 128, tv, ti);
            nv::n_top2<<<(T * 8) / 256, 256, 0, stream>>>(tv, ti, rs2, ids, gates);
            nv::n_gather<<<T, 256, 0, stream>>>(a.out, rs2, a.in[5] + l * D, ids, gates, a.in[27] + (size_t)l * NEXP * D, a.in[28] + (size_t)l * NEXP * D);
            Args b = a; b.ph_lo = 0; b.ph_hi = 0; b.use_bar = 0; b.pad0 = 0;
            nv::n_finish<<<grid, 512, 0, stream>>>(b, l + 1);
        }
    }
#endif
}
```

```cpp
#define HK_ONE_LAUNCH 1
#include <hip/hip_runtime.h>
#include <cstdint>
#include <cstdio>
#include <cmath>

#define LAS3 __attribute__((address_space(3)))
typedef unsigned short bf16_t;
typedef short bf16x8 __attribute__((ext_vector_type(8)));
typedef float f32x4 __attribute__((ext_vector_type(4)));
typedef float f32x16 __attribute__((ext_vector_type(16)));
typedef unsigned u32x4 __attribute__((ext_vector_type(4)));
typedef unsigned u32x2 __attribute__((ext_vector_type(2)));

namespace hk {
constexpr int D = 1024, NB = 8, S = 8192, DEPTH = 4, T = NB * S;
constexpr int INW = 2564;
constexpr int ZP = 2304;
constexpr int ZC_FQ = 0, ZC_FK = 256, ZC_FV = 512, ZC_DQ = 768, ZC_DK = 1024, ZC_DV = 1280, ZC_CQ = 1536, ZC_CK = 1792, ZC_CV = 2048;
constexpr int NEXP = 16384;
constexpr float EPS = 1e-6f;
constexpr float LOG2E = 1.4426950408889634f;
constexpr int TBN = 2112;
constexpr int S5_TC = 64;
constexpr int S5_NCH = S / S5_TC;
constexpr int NTHR = 512;
constexpr int LDS_BYTES = 160 * 1024;
constexpr int LDS_CTL = LDS_BYTES - 256;

constexpr size_t al256(size_t x) { return (x + 255) & ~(size_t)255; }
constexpr size_t WS_CTL = 0;
constexpr size_t WS_CTL_BYTES = 65536;
constexpr size_t WS_XB = WS_CTL + WS_CTL_BYTES;
constexpr size_t WS_ZB = WS_XB + (size_t)T * D * 2;
constexpr size_t WS_SU = WS_ZB + (size_t)T * ZP * 2;
constexpr size_t WS_MIX = WS_SU + (size_t)T * 256 * 4;
constexpr size_t WS_DPART = WS_MIX + (size_t)T * D * 2;
constexpr size_t WS_DLSE = WS_DPART + (size_t)3 * T * 256 * 2;
constexpr size_t WS_SST = WS_DLSE + (size_t)3 * T * 4 * 4;
constexpr size_t WS_CUM = WS_SST + (size_t)NB * 16 * S5_NCH * 128 * 4;
constexpr size_t WS_FLOG = WS_CUM + (size_t)NB * 4 * S * 4;
constexpr size_t WS_RSTD = WS_FLOG + (size_t)NB * 4 * S * 4;
constexpr size_t WS_WIN = WS_RSTD + (size_t)T * 4;
constexpr size_t WS_WF = WS_WIN + (size_t)DEPTH * 2560 * 1024 * 2;
constexpr size_t WS_WOUT = WS_WF + (size_t)DEPTH * 4 * 1024 * 4;
constexpr size_t WS_WQ = WS_WOUT + (size_t)DEPTH * 1024 * 1024 * 2;
constexpr size_t WS_KEYS = WS_WQ + (size_t)DEPTH * 2048 * 1024 * 2;
constexpr size_t WS_GLU = WS_KEYS + (size_t)DEPTH * 16 * 128 * 128 * 2;
constexpr size_t WS_TB = WS_GLU + (size_t)DEPTH * 256 * 256 * 2;
constexpr size_t WS_UT = al256(WS_TB + (size_t)8 * TBN * 4);
constexpr size_t WS_VT = WS_UT + (size_t)NEXP * D * 2;
constexpr size_t WS_END = WS_VT + (size_t)NEXP * D * 2;
constexpr size_t WS_NV_TV = WS_SU;
constexpr size_t WS_NV_IDS = WS_DPART;
static_assert(WS_END <= (size_t)1024 * 1024 * 1024, "workspace map exceeds 1 GiB");
constexpr int CTL_BAR = 0;
constexpr int CTL_Q = 4096;

struct Args {
    const float* in[29];
    float* out;
    unsigned char* ws;
    int ph_lo, ph_hi;
    int use_bar, pad0;
};

__device__ __forceinline__ float bf2f(bf16_t v) { return __uint_as_float((unsigned)v << 16); }
__device__ __forceinline__ bf16_t f2bf(float f) { unsigned u = __float_as_uint(f); u += 0x7fffu + ((u >> 16) & 1u); return (bf16_t)(u >> 16); }
__device__ __forceinline__ unsigned pk2(float lo, float hi) { return (unsigned)f2bf(lo) | ((unsigned)f2bf(hi) << 16); }
__device__ __forceinline__ float gelu_tanh(float x) {
    const float u = 0.7978845608028654f * (x + 0.044715f * x * x * x);
    return x / (1.f + __expf(-2.f * u));
}
__device__ __forceinline__ float log_sigmoid(float x) { return x >= 0.f ? -log1pf(expf(-x)) : x - log1pf(expf(x)); }
__device__ __forceinline__ int t5_bucket(int dist) {
    int n = dist < 0 ? 0 : dist;
    float nf = (float)(n < 16 ? 16 : n);
    int large = 16 + (int)(logf(nf / 16.f) / logf(128.f) * 16.f);
    large = large < 31 ? large : 31;
    return n < 16 ? n : large;
}
__device__ __forceinline__ float wave_sum(float v) {
#pragma unroll
    for (int o = 32; o > 0; o >>= 1) v += __shfl_xor(v, o);
    return v;
}
__device__ __forceinline__ float half_swap_max(float m) {
    auto rr = __builtin_amdgcn_permlane32_swap(__float_as_uint(m), __float_as_uint(m), false, false);
    return fmaxf(__uint_as_float(rr[0]), __uint_as_float(rr[1]));
}
__device__ __forceinline__ float half_swap_sum(float m) {
    auto rr = __builtin_amdgcn_permlane32_swap(__float_as_uint(m), __float_as_uint(m), false, false);
    return __uint_as_float(rr[0]) + __uint_as_float(rr[1]);
}
}
namespace pg8 {
#define PG8_LAS __attribute__((address_space(3)))
typedef unsigned short bf16_t;
typedef short bf16x8 __attribute__((ext_vector_type(8)));
typedef float f32x4 __attribute__((ext_vector_type(4)));
typedef unsigned u32x4 __attribute__((ext_vector_type(4)));
constexpr int BM = 256, BK = 64, HALF = 128, HTB = HALF * BK * 2  , STAGE_BYTES = 8 * HTB, NXCD = 8, WGM = 8;

__host__ __device__ __forceinline__ int lds_byte(int r, int c) { const int st = (r >> 4) * 2 + (c >> 5), rr = r & 15, cc = c & 31, ob = rr * 64 + cc * 2; return st * 1024 + (ob ^ (((ob >> 9) & 1) << 5)); }
__host__ __device__ __forceinline__ void stage_rc(int b, int& R, int& C) { const int st = b / 1024, sb = b % 1024, swz = sb ^ (((sb >> 9) & 1) << 5); R = (st >> 1) * 16 + swz / 64; C = (st & 1) * 32 + (swz % 64) / 2; }
__host__ __device__ __forceinline__ int perm32(int rho) { const int n = rho >> 4, i = rho & 15; return 8 * (i >> 2) + 4 * n + (i & 3); }

struct Unit { int pm, pn; };
struct Gemm { const bf16_t* A; const bf16_t* Bt; int M, N, K; };

struct StaticOrder {
    int nM, nN, nwg, G, c;
    __host__ __device__ void init(int M, int N, int G_, int c_) { nM = M / BM; nN = N / BM; nwg = nM * nN; G = G_; c = c_; }
    __host__ __device__ bool next(int i, Unit& u) const {
        const long L = (long)i * G + c; if (L >= nwg) return false;
        int wgid = (int)L; { const int q = nwg / NXCD, r = nwg % NXCD, xcd = wgid % NXCD, off = wgid / NXCD; wgid = (xcd < r ? xcd * (q + 1) : r * (q + 1) + (xcd - r) * q) + off; }
        const int nig = WGM * nN, gid = wgid / nig, fm = gid * WGM, gsz = (nM - fm) < WGM ? (nM - fm) : WGM;
        u.pm = fm + ((wgid % nig) % gsz); u.pn = (wgid % nig) / gsz; return true;
    }
    __device__ __forceinline__ void a_ready(const Unit&) const {}
    __device__ __forceinline__ void done(const Unit&) const {}
};
__device__ __forceinline__ unsigned cvt_pk_bf16(float lo, float hi) { unsigned r; asm volatile("v_cvt_pk_bf16_f32 %0, %1, %2" : "=v"(r) : "v"(lo), "v"(hi)); return r; }

struct EpiIn {
    static constexpr bool PERM = true, AFTER_DRAIN = false;
    bf16_t* zb; float* su32; const float* rstd;
    const float* g_fq; const float* g_fk; const float* g_dq; const float* g_dk; const float* g_cq; const float* g_ck;
    __device__ __forceinline__ void operator()(const f32x4 (&acc)[2][2][4][2], const Unit& u, int wr, int wc, int fr, int fq) const {
        const int pn = u.pn;
        const int mode = (pn == 0 || pn == 1 || pn == 3 || pn == 4) ? 1 : ((pn == 6 || pn == 7) ? 2 : (pn == 9 ? 3 : 0));
        const float* gp = pn == 0 ? g_fq : pn == 1 ? g_fk : pn == 3 ? g_dq : pn == 4 ? g_dk : pn == 6 ? g_cq : g_ck;
        const float qs = (pn == 0 || pn == 3) ? 0.125f * 1.4426950408889634f : (pn == 6 ? 0.17677669529663687f * 1.4426950408889634f : 1.f);
        f32x4 gv[2][2];
#pragma unroll
        for (int bj = 0; bj < 2; ++bj)
#pragma unroll
            for (int n = 0; n < 2; ++n) {
                if (mode == 1) gv[bj][n] = *(const f32x4*)(gp + 32 * bj + 8 * fq + 4 * n) * qs;
                else if (mode == 2) gv[bj][n] = *(const f32x4*)(gp + 8 * fq + 4 * n) * qs;
                else gv[bj][n] = (f32x4){1.f, 1.f, 1.f, 1.f};
            }
#pragma unroll
        for (int ai = 0; ai < 2; ++ai)
#pragma unroll
            for (int m = 0; m < 4; ++m) {
                const int row = u.pm * BM + ai * HALF + wr * 64 + m * 16 + fr;
                const float rs = rstd[row];
                f32x4 v[2][2];
                float ss[2];
#pragma unroll
                for (int bj = 0; bj < 2; ++bj) {
                    float s = 0.f;
#pragma unroll
                    for (int n = 0; n < 2; ++n) { v[bj][n] = acc[ai][bj][m][n] * rs; const f32x4 x = v[bj][n]; s += (x[0] * x[0] + x[1] * x[1]) + (x[2] * x[2] + x[3] * x[3]); }
                    ss[bj] = s;
                }
                if (mode == 1 || mode == 2) {
                    float s0 = ss[0], s1 = ss[1];
                    s0 += __shfl_xor(s0, 16); s0 += __shfl_xor(s0, 32); s1 += __shfl_xor(s1, 16); s1 += __shfl_xor(s1, 32);
                    float r0, r1;
                    if (mode == 1) { r0 = __builtin_amdgcn_rsqf((s0 + s1) * (1.f / 64.f) + 1e-6f); r1 = r0; }
                    else { r0 = __builtin_amdgcn_rsqf(s0 * (1.f / 32.f) + 1e-6f); r1 = __builtin_amdgcn_rsqf(s1 * (1.f / 32.f) + 1e-6f); }
#pragma unroll
                    for (int n = 0; n < 2; ++n) { v[0][n] = v[0][n] * r0 * gv[0][n]; v[1][n] = v[1][n] * r1 * gv[1][n]; }
                }
                if (mode == 3) {
                    float* op = su32 + (size_t)row * 256 + 64 * wc + 8 * fq;
#pragma unroll
                    for (int bj = 0; bj < 2; ++bj) { *(f32x4*)(op + 32 * bj) = v[bj][0]; *(f32x4*)(op + 32 * bj + 4) = v[bj][1]; }
                } else {
                    bf16_t* op = zb + (size_t)row * 2304 + pn * 256 + 64 * wc + 8 * fq;
#pragma unroll
                    for (int bj = 0; bj < 2; ++bj) { u32x4 w; w.x = cvt_pk_bf16(v[bj][0][0], v[bj][0][1]); w.y = cvt_pk_bf16(v[bj][0][2], v[bj][0][3]); w.z = cvt_pk_bf16(v[bj][1][0], v[bj][1][1]); w.w = cvt_pk_bf16(v[bj][1][2], v[bj][1][3]);
                        *(u32x4*)(op + 32 * bj) = w; }
                }
            }
    }
};
struct EpiOut {
    static constexpr bool PERM = true, AFTER_DRAIN = false;
    float* x; bf16_t* xb;
    __device__ __forceinline__ void operator()(const f32x4 (&acc)[2][2][4][2], const Unit& u, int wr, int wc, int fr, int fq) const {
#pragma unroll
        for (int ai = 0; ai < 2; ++ai)
#pragma unroll
            for (int m = 0; m < 4; ++m) {
                const int row = u.pm * BM + ai * HALF + wr * 64 + m * 16 + fr;
#pragma unroll
                for (int bj = 0; bj < 2; ++bj) {
                    const size_t off = (size_t)row * 1024 + u.pn * BM + bj * HALF + wc * 32 + 8 * fq;
                    f32x4 a = *(const f32x4*)(x + off), b = *(const f32x4*)(x + off + 4);
                    a = a + acc[ai][bj][m][0]; b = b + acc[ai][bj][m][1];
                    *(f32x4*)(x + off) = a; *(f32x4*)(x + off + 4) = b;
                    u32x4 w; w.x = cvt_pk_bf16(a[0], a[1]); w.y = cvt_pk_bf16(a[2], a[3]); w.z = cvt_pk_bf16(b[0], b[1]); w.w = cvt_pk_bf16(b[2], b[3]);
                    *(u32x4*)(xb + off) = w;
                }
            }
    }
};
struct EpiPlain {
    static constexpr bool PERM = true, AFTER_DRAIN = false;
    bf16_t* O; int ldc;
    __device__ __forceinline__ void operator()(const f32x4 (&acc)[2][2][4][2], const Unit& u, int wr, int wc, int fr, int fq) const {
#pragma unroll
        for (int ai = 0; ai < 2; ++ai)
#pragma unroll
            for (int m = 0; m < 4; ++m) {
                const int row = u.pm * BM + ai * HALF + wr * 64 + m * 16 + fr;
#pragma unroll
                for (int bj = 0; bj < 2; ++bj) {
                    const size_t off = (size_t)row * ldc + u.pn * BM + bj * HALF + wc * 32 + 8 * fq;
                    const f32x4 a = acc[ai][bj][m][0], b = acc[ai][bj][m][1];
                    u32x4 w; w.x = cvt_pk_bf16(a[0], a[1]); w.y = cvt_pk_bf16(a[2], a[3]); w.z = cvt_pk_bf16(b[0], b[1]); w.w = cvt_pk_bf16(b[2], b[3]);
                    *(u32x4*)(O + off) = w;
                }
            }
    }
};
template <class Epi, class Sched, bool ALIGN_EPI = false, bool SP2 = false>
__device__ __forceinline__ void gemm_phase(PG8_LAS unsigned char* lds, const Gemm g, const Sched& S, const Epi& E) {
    const int tid = threadIdx.x, wid = __builtin_amdgcn_readfirstlane(tid >> 6), lane = tid & 63, wr = wid >> 2, wc = wid & 3, fr = lane & 15, fq = lane >> 4;
    const int K = g.K, nt = K / BK;
    unsigned voffA[2], voffB[2];
#pragma unroll
    for (int i = 0; i < 2; ++i) { int R, C; stage_rc(tid * 16 + i * 8192, R, C); const int Rb = Epi::PERM ? ((R & ~31) + perm32(R & 31)) : R;
        voffA[i] = (unsigned)(R * K + C) * 2u; voffB[i] = (unsigned)(Rb * K + C) * 2u; }
    const size_t kstep = (size_t)(BK * 2);
    const size_t hstep = (size_t)HALF * K * 2;
    const size_t tstep = 2 * hstep;
    const unsigned ldsw = (unsigned)wid * 1024u;
    const int aoff = lds_byte(wr * 64 + fr, fq * 8), boff = lds_byte(wc * 32 + fr, fq * 8);
#define PG8_SA(b, h) (((b) * 2 + (h)) * HTB)
#define PG8_SB(b, h) ((4 + (b) * 2 + (h)) * HTB)
#define PG8_STAGE(bufoff, gbase, voff) do { _Pragma("unroll") for (int _i = 0; _i < 2; ++_i) \
        __builtin_amdgcn_global_load_lds((const unsigned*)((const char*)(gbase) + (voff)[_i]), (PG8_LAS unsigned*)(lds + (bufoff) + ldsw + _i * 8192), 16, 0, 0); } while (0)
#define PG8_LDA(dst, b, h) do { _Pragma("unroll") for (int m = 0; m < 4; ++m) _Pragma("unroll") for (int k = 0; k < 2; ++k) dst[m][k] = *(const PG8_LAS bf16x8*)(lds + PG8_SA(b, h) + aoff + m * 2048 + k * 1024); } while (0)
#define PG8_LDB(dst, b, h) do { _Pragma("unroll") for (int n = 0; n < 2; ++n) _Pragma("unroll") for (int k = 0; k < 2; ++k) dst[n][k] = *(const PG8_LAS bf16x8*)(lds + PG8_SB(b, h) + boff + n * 2048 + k * 1024); } while (0)
#define PG8_MMA(ai, bj, At, Bt) do { __builtin_amdgcn_s_setprio(1); _Pragma("unroll") for (int m = 0; m < 4; ++m) _Pragma("unroll") for (int n = 0; n < 2; ++n) _Pragma("unroll") for (int k = 0; k < 2; ++k) \
        acc[ai][bj][m][n] = __builtin_amdgcn_mfma_f32_16x16x32_bf16(Bt[n][k], At[m][k], acc[ai][bj][m][n], 0, 0, 0); __builtin_amdgcn_s_setprio(0); } while (0)
#define PG8_WAIT_V(n) asm volatile("s_waitcnt vmcnt(" #n ")" ::: "memory")
#define PG8_WAIT_L(n) asm volatile("s_waitcnt lgkmcnt(" #n ")" ::: "memory")
#define PG8_BAR __builtin_amdgcn_s_barrier()
#define PG8_SCHED __builtin_amdgcn_sched_barrier(0)
    Unit cur, nxt; int ui = 0;
    if (!S.next(0, cur)) return;
    f32x4 acc[2][2][4][2];
#pragma unroll
    for (int a = 0; a < 2; ++a)
#pragma unroll
        for (int b = 0; b < 2; ++b)
#pragma unroll
            for (int m = 0; m < 4; ++m)
#pragma unroll
                for (int n = 0; n < 2; ++n) acc[a][b][m][n] = (f32x4){0.f, 0.f, 0.f, 0.f};
    bf16x8 At[4][2], B0[2][2], B1[2][2];
    const char* cA = (const char*)g.A + (size_t)cur.pm * tstep; const char* cB = (const char*)g.Bt + (size_t)cur.pn * tstep;
    S.a_ready(cur);
    if constexpr (SP2) {
        PG8_STAGE(PG8_SB(0, 0), cB, voffB); PG8_STAGE(PG8_SB(0, 1), cB + hstep, voffB); PG8_STAGE(PG8_SA(0, 0), cA, voffA); PG8_STAGE(PG8_SA(0, 1), cA + hstep, voffA);
        if (wr == 1) PG8_BAR;
        PG8_WAIT_V(2); PG8_BAR;
        PG8_STAGE(PG8_SB(1, 0), cB + kstep, voffB); PG8_STAGE(PG8_SA(1, 0), cA + kstep, voffA); PG8_STAGE(PG8_SB(1, 1), cB + hstep + kstep, voffB);
        PG8_WAIT_V(6); PG8_BAR;
    } else {
        PG8_STAGE(PG8_SB(0, 0), cB, voffB); PG8_STAGE(PG8_SA(0, 0), cA, voffA); PG8_STAGE(PG8_SB(0, 1), cB + hstep, voffB); PG8_STAGE(PG8_SA(0, 1), cA + hstep, voffA);
        if (wr == 1) PG8_BAR;
        PG8_WAIT_V(4); PG8_BAR;
        PG8_STAGE(PG8_SB(1, 0), cB + kstep, voffB); PG8_STAGE(PG8_SA(1, 0), cA + kstep, voffA); PG8_STAGE(PG8_SB(1, 1), cB + hstep + kstep, voffB);
        PG8_WAIT_V(6); PG8_BAR;
    }
    for (;;) {
        const bool has_next = S.next(ui + 1, nxt);
        const char* nA = has_next ? (const char*)g.A + (size_t)nxt.pm * tstep : cA; const char* nB = has_next ? (const char*)g.Bt + (size_t)nxt.pn * tstep : cB;
        for (int t = 0; t < nt; t += 2) {
            const bool last = (t == nt - 2);
            const char* a1 = cA + (size_t)(t + 1) * kstep;
            const char* a2 = last ? nA : cA + (size_t)(t + 2) * kstep; const char* b2 = last ? nB : cB + (size_t)(t + 2) * kstep;
            const char* a3 = a2 + kstep; const char* b3 = b2 + kstep;
            if (last && has_next) S.a_ready(nxt);
            if constexpr (SP2) {
            PG8_LDB(B0, 0, 0); PG8_LDB(B1, 0, 1); PG8_SCHED; PG8_LDA(At, 0, 0); PG8_STAGE(PG8_SA(1, 1), a1 + hstep, voffA);
            PG8_WAIT_V(8); PG8_WAIT_L(0); PG8_BAR; PG8_MMA(0, 0, At, B0); PG8_MMA(0, 1, At, B1); PG8_BAR; PG8_SCHED;
            PG8_LDA(At, 0, 1); PG8_STAGE(PG8_SB(0, 0), b2, voffB); PG8_STAGE(PG8_SB(0, 1), b2 + hstep, voffB); PG8_STAGE(PG8_SA(0, 0), a2, voffA);
            PG8_WAIT_V(8); PG8_WAIT_L(0); PG8_BAR; PG8_MMA(1, 0, At, B0); PG8_MMA(1, 1, At, B1); PG8_BAR; PG8_SCHED;
            PG8_LDB(B0, 1, 0); PG8_LDB(B1, 1, 1); PG8_SCHED; PG8_LDA(At, 1, 0); PG8_STAGE(PG8_SA(0, 1), a2 + hstep, voffA);
            PG8_WAIT_V(8); PG8_WAIT_L(0); PG8_BAR; PG8_MMA(0, 0, At, B0); PG8_MMA(0, 1, At, B1); PG8_BAR; PG8_SCHED;
            PG8_LDA(At, 1, 1); PG8_STAGE(PG8_SB(1, 0), b3, voffB); PG8_STAGE(PG8_SB(1, 1), b3 + hstep, voffB); PG8_STAGE(PG8_SA(1, 0), a3, voffA);
            PG8_WAIT_V(8); PG8_WAIT_L(0); PG8_BAR; PG8_MMA(1, 0, At, B0); PG8_MMA(1, 1, At, B1); PG8_BAR; PG8_SCHED;
            } else {
            PG8_LDB(B0, 0, 0); PG8_SCHED; PG8_LDA(At, 0, 0); PG8_STAGE(PG8_SA(1, 1), a1 + hstep, voffA);
            PG8_WAIT_L(8); PG8_BAR; PG8_WAIT_L(0); PG8_MMA(0, 0, At, B0); PG8_BAR; PG8_SCHED;
            PG8_LDB(B1, 0, 1); PG8_STAGE(PG8_SB(0, 0), b2, voffB);
            PG8_BAR; PG8_WAIT_L(0); PG8_MMA(0, 1, At, B1); PG8_BAR;
            PG8_LDA(At, 0, 1); PG8_STAGE(PG8_SA(0, 0), a2, voffA);
            PG8_BAR; PG8_WAIT_L(0); PG8_MMA(1, 0, At, B0); PG8_BAR; PG8_SCHED;
            PG8_STAGE(PG8_SB(0, 1), b2 + hstep, voffB);
            PG8_WAIT_V(6); PG8_BAR; PG8_MMA(1, 1, At, B1); PG8_BAR;
            PG8_LDB(B0, 1, 0); PG8_SCHED; PG8_LDA(At, 1, 0); PG8_STAGE(PG8_SA(0, 1), a2 + hstep, voffA);
            PG8_WAIT_L(8); PG8_BAR; PG8_WAIT_L(0); PG8_MMA(0, 0, At, B0); PG8_BAR; PG8_SCHED;
            PG8_LDB(B1, 1, 1); PG8_STAGE(PG8_SB(1, 0), b3, voffB);
            PG8_BAR; PG8_WAIT_L(0); PG8_MMA(0, 1, At, B1); PG8_BAR;
            PG8_LDA(At, 1, 1); PG8_STAGE(PG8_SA(1, 0), a3, voffA);
            PG8_BAR; PG8_WAIT_L(0); PG8_MMA(1, 0, At, B0); PG8_BAR; PG8_SCHED;
            PG8_STAGE(PG8_SB(1, 1), b3 + hstep, voffB);
            PG8_WAIT_V(6); PG8_BAR; PG8_MMA(1, 1, At, B1); PG8_BAR;
            }
        }
        if constexpr (ALIGN_EPI) { if (wr == 0) PG8_BAR; }
        if constexpr (!Epi::AFTER_DRAIN) { E(acc, cur, wr, wc, fr, fq); S.done(cur); }
        if (!has_next) break;
#pragma unroll
        for (int a = 0; a < 2; ++a)
#pragma unroll
            for (int b = 0; b < 2; ++b)
#pragma unroll
                for (int m = 0; m < 4; ++m)
#pragma unroll
                    for (int n = 0; n < 2; ++n) acc[a][b][m][n] = (f32x4){0.f, 0.f, 0.f, 0.f};
        cur = nxt; cA = nA; cB = nB; ++ui;
        if constexpr (ALIGN_EPI) { if (wr == 1) PG8_BAR; }
    }
    PG8_WAIT_V(0);
    if constexpr (!ALIGN_EPI) { if (wr == 0) PG8_BAR; }
    PG8_BAR;
    if constexpr (Epi::AFTER_DRAIN) { E.fused(acc, cur, wr, wc, fr, fq, lds, wid, lane); S.done(cur); }
#undef PG8_SA
#undef PG8_SB
#undef PG8_STAGE
#undef PG8_LDA
#undef PG8_LDB
#undef PG8_MMA
#undef PG8_WAIT_V
#undef PG8_WAIT_L
#undef PG8_BAR
#undef PG8_SCHED
}
}
#define XB_TMO      128
#define XB_XCNT(j)  (256  + 64 * (j))
#define XB_XSUB(j)  (1280 + 64 * (j))
#define XB_XGEN(j)  (2304 + 64 * (j))
#define XB_TOP      3328
#define XB_TOPGEN   3392
#define XCD_BAR_WORDS 3456
#define XB_SPIN_CAP (1u << 18)
#define LAS __attribute__((address_space(3)))

__device__ __forceinline__ unsigned xb_ld(unsigned* p)              { return __hip_atomic_load(p, __ATOMIC_RELAXED, __HIP_MEMORY_SCOPE_AGENT); }
__device__ __forceinline__ unsigned xb_add(unsigned* p, unsigned v) { return __hip_atomic_fetch_add(p, v, __ATOMIC_RELAXED, __HIP_MEMORY_SCOPE_AGENT); }
__device__ __forceinline__ unsigned xb_xcc_id() { return (unsigned)__builtin_amdgcn_s_getreg((3 << 11) | 20) & 0xFu; }
#define XB_SPIN(cond, bar) do { unsigned _sp = 0; while (cond) { __builtin_amdgcn_s_sleep(1); \
    if ((++_sp & 255u) == 0u) { if (xb_ld(&(bar)[XB_TMO])) break; if (_sp > XB_SPIN_CAP) { atomicAdd(&(bar)[XB_TMO], 1u); break; } } } } while (0)

struct XcdBarrier {
    unsigned* bar; unsigned x;
    volatile LAS unsigned* st;
};

__device__ __forceinline__ XcdBarrier xcd_barrier_post(unsigned* bar, volatile LAS unsigned* st) {
    XcdBarrier b; b.bar = bar; b.x = xb_xcc_id(); b.st = st;
    if (threadIdx.x == 0) (void)xb_add(&bar[XB_XCNT(b.x)], 1u);
    return b;
}
__device__ __forceinline__ void xcd_barrier_complete(unsigned* bar, unsigned x, unsigned& nloc, unsigned& nx) {
    const unsigned G = gridDim.x * gridDim.y * gridDim.z;
    unsigned sum, cnt, mine, sp = 0u;
    for (;;) {
        sum = 0u; cnt = 0u; mine = 0u;
#pragma unroll
        for (unsigned j = 0; j < 16; ++j) { const unsigned c = xb_ld(&bar[XB_XCNT(j)]); sum += c; cnt += (c > 0u) ? 1u : 0u; mine = (j == x) ? c : mine; }
        if (sum == G) break;
        __builtin_amdgcn_s_sleep(1);
        if ((++sp & 255u) == 0u) { if (xb_ld(&bar[XB_TMO])) break; if (sp > XB_SPIN_CAP) { atomicAdd(&bar[XB_TMO], 1u); break; } }
    }
    nloc = mine > 0u ? mine : 1u; nx = cnt > 0u ? cnt : 1u;
}

__device__ __forceinline__ void xcd_barrier(const XcdBarrier& b) {
    asm volatile("s_waitcnt vmcnt(0)" ::: "memory");
    __syncthreads();
    if (threadIdx.x == 0) {
        unsigned* bar = b.bar;
        __builtin_amdgcn_s_waitcnt(0);
        unsigned nloc = b.st[0], nx = b.st[1];
        if (nloc == 0u) { xcd_barrier_complete(bar, b.x, nloc, nx); b.st[0] = nloc; b.st[1] = nx; }
        const unsigned old = xb_add(&bar[XB_XSUB(b.x)], 1u);
        const unsigned gen = old / nloc;
        if (old + 1u == (gen + 1u) * nloc) {
            __builtin_amdgcn_fence(__ATOMIC_RELEASE, "agent");
            asm volatile("s_waitcnt vmcnt(0)" ::: "memory");
            const unsigned og = xb_add(&bar[XB_TOP], 1u);
            const unsigned tg = og / nx;
            if (og + 1u == (tg + 1u) * nx) xb_add(&bar[XB_TOPGEN], 1u);
            else XB_SPIN(xb_ld(&bar[XB_TOPGEN]) == tg, bar);
            __builtin_amdgcn_fence(__ATOMIC_ACQUIRE, "agent");
            xb_add(&bar[XB_XGEN(b.x)], 1u);
            asm volatile("s_waitcnt vmcnt(0)" ::: "memory");
        } else {
            XB_SPIN(xb_ld(&bar[XB_XGEN(b.x)]) == gen, bar);
            __builtin_amdgcn_fence(__ATOMIC_ACQUIRE, "agent");
            asm volatile("s_waitcnt vmcnt(0)" ::: "memory");
        }
    }
    __syncthreads();
}
namespace hk {
__device__ __forceinline__ int inproj_src_col(int np) {
    const int pn = np >> 8, p = np & 255, bj = p >> 7, wc = (p >> 5) & 3, i = p & 31;
    const int nl = pn * 256 + 64 * wc + 32 * bj + i;
    return nl < 768 ? nl : nl + 4;
}
template <bool INMAP>
__device__ __forceinline__ void tr_tile(const float* __restrict__ src, int ld, const float* __restrict__ g, bf16_t* __restrict__ dst, int K, int k0, int n0, float* lds) {
    const int tid = threadIdx.x;
#pragma unroll
    for (int i = 0; i < 8; ++i) {
        const int idx = tid + 512 * i, kk = idx >> 6, nn = idx & 63;
        const int col = INMAP ? inproj_src_col(n0 + nn) : (n0 + nn);
        float v = src[(size_t)(k0 + kk) * ld + col];
        if (g) v *= g[k0 + kk];
        lds[nn * 65 + kk] = v;
    }
    __syncthreads();
#pragma unroll
    for (int i = 0; i < 8; ++i) {
        const int idx = tid + 512 * i, nn = idx >> 6, kk = idx & 63;
        dst[(size_t)(n0 + nn) * K + k0 + kk] = f2bf(lds[nn * 65 + kk]);
    }
    __syncthreads();
}
__device__ __forceinline__ void phase_weights(const Args& a, unsigned char* ldsb) {
    float* lds = (float*)ldsb;
    const int G = gridDim.x, bid = blockIdx.x, tid = threadIdx.x;
    const float* w_in = a.in[1]; const float* w_out = a.in[3]; const float* norm_mix = a.in[4]; const float* norm_ffn = a.in[5];
    const float* glu_w = a.in[23]; const float* wq = a.in[25]; const float* keys = a.in[26]; const float* relb = a.in[14];
    bf16_t* WIN = (bf16_t*)(a.ws + WS_WIN); bf16_t* WOUT = (bf16_t*)(a.ws + WS_WOUT); bf16_t* WQ = (bf16_t*)(a.ws + WS_WQ); bf16_t* GLU = (bf16_t*)(a.ws + WS_GLU);
    for (int u = bid; u < DEPTH * 1424; u += G) {
        const int l = u / 1424; int r = u % 1424;
        if (r < 640) { const int nt = r >> 4, kt = r & 15; tr_tile<true>(w_in + (size_t)l * D * INW, INW, norm_mix + l * D, WIN + (size_t)l * 2560 * 1024, 1024, kt * 64, nt * 64, lds); }
        else if (r < 896) { r -= 640; const int nt = r >> 4, kt = r & 15; tr_tile<false>(w_out + (size_t)l * D * D, D, nullptr, WOUT + (size_t)l * 1024 * 1024, 1024, kt * 64, nt * 64, lds); }
        else if (r < 1408) { r -= 896; const int nt = r >> 4, kt = r & 15; tr_tile<false>(wq + (size_t)l * D * 2048, 2048, norm_ffn + l * D, WQ + (size_t)l * 2048 * 1024, 1024, kt * 64, nt * 64, lds); }
        else { r -= 1408; const int nt = r >> 2, kt = r & 3; tr_tile<false>(glu_w + (size_t)l * 65536, 256, nullptr, GLU + (size_t)l * 65536, 256, kt * 64, nt * 64, lds); }
    }
    const int gt = bid * NTHR + tid, gn = G * NTHR;
    float* WF = (float*)(a.ws + WS_WF);
    for (int i = gt; i < DEPTH * 4 * 1024; i += gn) { const int l = i >> 12, h = (i >> 10) & 3, k = i & 1023; WF[i] = norm_mix[l * D + k] * w_in[((size_t)l * D + k) * INW + 768 + h]; }
    bf16_t* KB = (bf16_t*)(a.ws + WS_KEYS);
    for (int i = gt; i < DEPTH * 16 * 128 * 128; i += gn) KB[i] = f2bf(keys[i]);
    float* TB = (float*)(a.ws + WS_TB);
    for (int i = gt; i < 8 * TBN; i += gn) { const int hh = i / TBN, d = i % TBN; TB[i] = relb[t5_bucket(d) * 8 + hh] * LOG2E; }
}

__device__ __forceinline__ void finish_token(int tok, const float (&xv)[16], float* __restrict__ xo, bf16_t* __restrict__ xb, float* __restrict__ rstd,
                                             const float* __restrict__ wf, const float* __restrict__ bfor, float* __restrict__ flog, int lane) {
    float ss = 0.f;
#pragma unroll
    for (int i = 0; i < 16; ++i) ss += xv[i] * xv[i];
    ss = wave_sum(ss);
    const float rs = __builtin_amdgcn_rsqf(ss * (1.f / 1024.f) + EPS);
    float* op = xo + (size_t)tok * D; bf16_t* bp = xb + (size_t)tok * D;
    *(f32x4*)(op + 8 * lane) = (f32x4){xv[0], xv[1], xv[2], xv[3]}; *(f32x4*)(op + 8 * lane + 4) = (f32x4){xv[4], xv[5], xv[6], xv[7]};
    *(f32x4*)(op + 512 + 8 * lane) = (f32x4){xv[8], xv[9], xv[10], xv[11]}; *(f32x4*)(op + 512 + 8 * lane + 4) = (f32x4){xv[12], xv[13], xv[14], xv[15]};
    u32x4 w0, w1;
    w0.x = pk2(xv[0], xv[1]); w0.y = pk2(xv[2], xv[3]); w0.z = pk2(xv[4], xv[5]); w0.w = pk2(xv[6], xv[7]);
    w1.x = pk2(xv[8], xv[9]); w1.y = pk2(xv[10], xv[11]); w1.z = pk2(xv[12], xv[13]); w1.w = pk2(xv[14], xv[15]);
    *(u32x4*)(bp + 8 * lane) = w0; *(u32x4*)(bp + 512 + 8 * lane) = w1;
    if (lane == 0) rstd[tok] = rs;
    if (wf) {
        float myff = 0.f;
#pragma unroll
        for (int h = 0; h < 4; ++h) {
            const float* wp = wf + h * 1024;
            const f32x4 a0 = *(const f32x4*)(wp + 8 * lane), a1 = *(const f32x4*)(wp + 8 * lane + 4), a2 = *(const f32x4*)(wp + 512 + 8 * lane), a3 = *(const f32x4*)(wp + 512 + 8 * lane + 4);
            float d = xv[0] * a0[0] + xv[1] * a0[1] + xv[2] * a0[2] + xv[3] * a0[3] + xv[4] * a1[0] + xv[5] * a1[1] + xv[6] * a1[2] + xv[7] * a1[3]
                    + xv[8] * a2[0] + xv[9] * a2[1] + xv[10] * a2[2] + xv[11] * a2[3] + xv[12] * a3[0] + xv[13] * a3[1] + xv[14] * a3[2] + xv[15] * a3[3];
            d = wave_sum(d);
            if (lane == h) myff = d;
        }
        if (lane < 4) { const int b = tok / S, s = tok % S; flog[((size_t)b * 4 + lane) * S + s] = log_sigmoid(myff * rs + bfor[lane]); }
    }
}
__device__ __forceinline__ void phase_xprep(const Args& a) {
    const int lane = threadIdx.x & 63, wv = blockIdx.x * 8 + (threadIdx.x >> 6), nw = gridDim.x * 8;
    const float* x = a.in[0];
    for (int tok = wv; tok < T; tok += nw) {
        const float* p = x + (size_t)tok * D;
        const f32x4 a0 = *(const f32x4*)(p + 8 * lane), a1 = *(const f32x4*)(p + 8 * lane + 4), a2 = *(const f32x4*)(p + 512 + 8 * lane), a3 = *(const f32x4*)(p + 512 + 8 * lane + 4);
        const float xv[16] = {a0[0], a0[1], a0[2], a0[3], a1[0], a1[1], a1[2], a1[3], a2[0], a2[1], a2[2], a2[3], a3[0], a3[1], a3[2], a3[3]};
        finish_token(tok, xv, a.out, (bf16_t*)(a.ws + WS_XB), (float*)(a.ws + WS_RSTD), (const float*)(a.ws + WS_WF), a.in[2], (float*)(a.ws + WS_FLOG), lane);
    }
}
__device__ __forceinline__ void cum_scan(const Args& a, unsigned char* ldsb, int bh) {
    float* lds = (float*)ldsb;
    const int tid = threadIdx.x, lane = tid & 63, w = tid >> 6;
    const float* fl = (const float*)(a.ws + WS_FLOG) + (size_t)bh * S + tid * 16;
    float v[16];
#pragma unroll
    for (int i = 0; i < 4; ++i) { const f32x4 t = *(const f32x4*)(fl + 4 * i); v[4 * i] = t[0]; v[4 * i + 1] = t[1]; v[4 * i + 2] = t[2]; v[4 * i + 3] = t[3]; }
#pragma unroll
    for (int i = 1; i < 16; ++i) v[i] += v[i - 1];
    float incl = v[15];
#pragma unroll
    for (int o = 1; o < 64; o <<= 1) { const float t = __shfl_up(incl, o); if (lane >= o) incl += t; }
    if (lane == 63) lds[w] = incl;
    __syncthreads();
    float base = incl - v[15];
    for (int j = 0; j < w; ++j) base += lds[j];
    float* cp = (float*)(a.ws + WS_CUM) + (size_t)bh * S + tid * 16;
#pragma unroll
    for (int i = 0; i < 4; ++i) *(f32x4*)(cp + 4 * i) = (f32x4){(base + v[4 * i]) * LOG2E, (base + v[4 * i + 1]) * LOG2E, (base + v[4 * i + 2]) * LOG2E, (base + v[4 * i + 3]) * LOG2E};
    __syncthreads();
}

constexpr int AT_KS = 0, AT_VT = 18432, AT_DL = 36864, AT_TBL = 37888, AT_END = AT_TBL + TBN * 4;
__device__ __forceinline__ int swap23(int i) { return (i & ~12) | ((i & 4) << 1) | ((i & 8) >> 1); }
#define MFMA32(A, B, C) __builtin_amdgcn_mfma_f32_32x32x16_bf16(A, B, C, 0, 0, 0)
__device__ __forceinline__ bf16x8 pack8(const f32x16& p, int s8) {
    u32x4 w; w.x = pk2(p[s8], p[s8 + 1]); w.y = pk2(p[s8 + 2], p[s8 + 3]); w.z = pk2(p[s8 + 4], p[s8 + 5]); w.w = pk2(p[s8 + 6], p[s8 + 7]);
    return __builtin_bit_cast(bf16x8, w);
}
__device__ __forceinline__ void stage_kv(unsigned char* lds, int buf, int kv_s, int c_s, const u32x4& kreg, const u32x4& vreg) {
    *(u32x4*)(lds + AT_KS + buf * 9216 + kv_s * 144 + 16 * c_s) = kreg;
    bf16_t* vt = (bf16_t*)(lds + AT_VT + buf * 9216) + kv_s;
    const int r0 = 8 * c_s;
    vt[(r0 + 0) * 72] = (bf16_t)(vreg.x & 0xffffu); vt[(r0 + 1) * 72] = (bf16_t)(vreg.x >> 16);
    vt[(r0 + 2) * 72] = (bf16_t)(vreg.y & 0xffffu); vt[(r0 + 3) * 72] = (bf16_t)(vreg.y >> 16);
    vt[(r0 + 4) * 72] = (bf16_t)(vreg.z & 0xffffu); vt[(r0 + 5) * 72] = (bf16_t)(vreg.z >> 16);
    vt[(r0 + 6) * 72] = (bf16_t)(vreg.w & 0xffffu); vt[(r0 + 7) * 72] = (bf16_t)(vreg.w >> 16);
}
__device__ __forceinline__ void softmax_tile(f32x16 (&p)[2], float A, float& m, float& l, f32x16 (&o)[2], bf16x8 (&pf)[2][2]) {
    float rm = p[0][0];
#pragma unroll
    for (int r = 1; r < 16; ++r) rm = fmaxf(rm, p[0][r]);
#pragma unroll
    for (int r = 0; r < 16; ++r) rm = fmaxf(rm, p[1][r]);
    rm = half_swap_max(rm);
    const float mn = fmaxf(m, rm + A);
    const float f = __builtin_amdgcn_exp2f(m - mn);
    const float c = mn - A;
    float ps = 0.f;
#pragma unroll
    for (int hf = 0; hf < 2; ++hf)
#pragma unroll
        for (int r = 0; r < 16; ++r) { const float e = __builtin_amdgcn_exp2f(p[hf][r] - c); p[hf][r] = e; ps += e; }
    l = l * f + ps;
    if (__any(mn > m)) {
#pragma unroll
        for (int r = 0; r < 16; ++r) { o[0][r] *= f; o[1][r] *= f; }
    }
    m = mn;
#pragma unroll
    for (int hf = 0; hf < 2; ++hf) { pf[hf][0] = pack8(p[hf], 0); pf[hf][1] = pack8(p[hf], 8); }
}
__device__ __forceinline__ void softmax_half(f32x16& p, float& m, float& l, f32x16 (&o)[2]) {
    float rm = p[0];
#pragma unroll
    for (int r = 1; r < 16; ++r) rm = fmaxf(rm, p[r]);
    rm = half_swap_max(rm);
    const float mn = fmaxf(m, rm);
    const float f = __builtin_amdgcn_exp2f(m - mn);
    float ps = 0.f;
#pragma unroll
    for (int r = 0; r < 16; ++r) { const float e = __builtin_amdgcn_exp2f(p[r] - mn); p[r] = e; ps += e; }
    l = l * f + ps;
    if (__any(mn > m)) {
#pragma unroll
        for (int r = 0; r < 16; ++r) { o[0][r] *= f; o[1][r] *= f; }
    }
    m = mn;
}
__device__ __forceinline__ void pv_tile(const unsigned char* lds, int buf, int qi, int hi, const bf16x8 (&pf)[2][2], f32x16 (&o)[2]) {
#pragma unroll
    for (int db = 0; db < 2; ++db)
#pragma unroll
        for (int hf = 0; hf < 2; ++hf)
#pragma unroll
            for (int s = 0; s < 2; ++s) {
                const bf16x8 vf = *(const bf16x8*)(lds + AT_VT + buf * 9216 + (32 * db + qi) * 144 + 2 * (32 * hf + 16 * s + 8 * hi));
                o[db] = MFMA32(vf, pf[hf][s], o[db]);
            }
}
__device__ __forceinline__ void store_ot(bf16_t* dst, const f32x16 (&o)[2], float sc, int hi) {
#pragma unroll
    for (int db = 0; db < 2; ++db)
#pragma unroll
        for (int r4 = 0; r4 < 4; ++r4) {
            u32x2 w; w.x = pk2(o[db][4 * r4] * sc, o[db][4 * r4 + 1] * sc); w.y = pk2(o[db][4 * r4 + 2] * sc, o[db][4 * r4 + 3] * sc);
            *(u32x2*)(dst + 32 * db + 8 * r4 + 4 * hi) = w;
        }
}

__device__ __forceinline__ void fox_unit(const Args& a, unsigned char* lds, int bh, int qb) {
    const int tid = threadIdx.x, lane = tid & 63, w = tid >> 6, qi = lane & 31, hi = lane >> 5;
    const int b = bh >> 2, h = bh & 3;
    const bf16_t* zb = (const bf16_t*)(a.ws + WS_ZB) + (size_t)b * S * ZP;
    const float* cum = (const float*)(a.ws + WS_CUM) + (size_t)bh * S;
    const int q0 = 256 * qb + 32 * w;
    bf16x8 qf[4];
#pragma unroll
    for (int ds = 0; ds < 4; ++ds) qf[ds] = *(const bf16x8*)(zb + (size_t)(q0 + qi) * ZP + ZC_FQ + 64 * h + 16 * ds + 8 * hi);
    const float cq = cum[q0 + qi];
    const int ntiles = 4 * (qb + 1), mylast = 4 * qb + (w >> 1);
    const int kv_s = tid & 63, c_s = tid >> 6;
    const bf16_t* kp = zb + (size_t)kv_s * ZP + ZC_FK + 64 * h + 8 * c_s;
    const bf16_t* vp = zb + (size_t)kv_s * ZP + ZC_FV + 64 * h + 8 * c_s;
    u32x4 kreg = *(const u32x4*)kp, vreg = *(const u32x4*)vp;
    float dreg = (tid < 64) ? cum[kv_s] : 0.f;
    float m = -1e30f, l = 0.f; f32x16 o[2]; o[0] = (f32x16){}; o[1] = (f32x16){};
    const int krow = swap23(qi);
    for (int kt = 0; kt < ntiles; ++kt) {
        const int buf = kt & 1;
        stage_kv(lds, buf, kv_s, c_s, kreg, vreg);
        if (tid < 64) { const float dbase = __shfl(dreg, 0); float* dl = (float*)(lds + AT_DL + buf * 512); dl[tid] = dreg - dbase; if (tid == 0) dl[64] = dbase; }
        __syncthreads();
        if (kt + 1 < ntiles) {
            kreg = *(const u32x4*)(kp + (size_t)(kt + 1) * 64 * ZP); vreg = *(const u32x4*)(vp + (size_t)(kt + 1) * 64 * ZP);
            if (tid < 64) dreg = cum[(kt + 1) * 64 + kv_s];
        }
        if (kt <= mylast) {
            f32x16 p[2];
#pragma unroll
            for (int hf = 0; hf < 2; ++hf) {
                p[hf] = (f32x16){};
#pragma unroll
                for (int ds = 0; ds < 4; ++ds) { const bf16x8 kf = *(const bf16x8*)(lds + AT_KS + buf * 9216 + (32 * hf + krow) * 144 + 32 * ds + 16 * hi); p[hf] = MFMA32(kf, qf[ds], p[hf]); }
            }
            const float* dl = (const float*)(lds + AT_DL + buf * 512);
#pragma unroll
            for (int hf = 0; hf < 2; ++hf)
#pragma unroll
                for (int s = 0; s < 2; ++s) {
                    const f32x4 d0 = *(const f32x4*)(dl + 32 * hf + 16 * s + 8 * hi), d1 = *(const f32x4*)(dl + 32 * hf + 16 * s + 8 * hi + 4);
                    p[hf][8 * s + 0] -= d0[0]; p[hf][8 * s + 1] -= d0[1]; p[hf][8 * s + 2] -= d0[2]; p[hf][8 * s + 3] -= d0[3];
                    p[hf][8 * s + 4] -= d1[0]; p[hf][8 * s + 5] -= d1[1]; p[hf][8 * s + 6] -= d1[2]; p[hf][8 * s + 7] -= d1[3];
                }
            const float A = cq - dl[64];
            if (64 * kt + 63 > q0) {
                const int lim = q0 + qi - 64 * kt - 8 * hi;
#pragma unroll
                for (int hf = 0; hf < 2; ++hf)
#pragma unroll
                    for (int r = 0; r < 16; ++r) if (32 * hf + 16 * (r >> 3) + (r & 7) > lim) p[hf][r] = -INFINITY;
            }
            bf16x8 pf[2][2];
            softmax_tile(p, A, m, l, o, pf);
            pv_tile(lds, buf, qi, hi, pf, o);
        }
    }
    l = half_swap_sum(l);
    store_ot((bf16_t*)(a.ws + WS_MIX) + (size_t)(b * S + q0 + qi) * D + 0 + 64 * h, o, 1.f / l, hi);
    __syncthreads();
}

__device__ __forceinline__ void diff_unit(const Args& a, unsigned char* lds, int layer, int bh, int qb) {
    const int tid = threadIdx.x, lane = tid & 63, w = tid >> 6, qi = lane & 31, hi = lane >> 5;
    const int b = bh >> 2, h = bh & 3;
    const bf16_t* zb = (const bf16_t*)(a.ws + WS_ZB) + (size_t)b * S * ZP;
    const int q0 = 256 * qb + 32 * w;
    { const float* tb = (const float*)(a.ws + WS_TB) + (size_t)(4 + h) * TBN; float* tl = (float*)(lds + AT_TBL); for (int i = tid; i < TBN; i += NTHR) tl[i] = tb[i]; }
    bf16x8 qf[2][2];
#pragma unroll
    for (int c = 0; c < 2; ++c)
#pragma unroll
        for (int ds = 0; ds < 2; ++ds) qf[c][ds] = *(const bf16x8*)(zb + (size_t)(q0 + qi) * ZP + ZC_CQ + 64 * h + 32 * c + 16 * ds + 8 * hi);
    const int ntiles = 4 * (qb + 1), mylast = 4 * qb + (w >> 1);
    const int kv_s = tid & 63, c_s = tid >> 6;
    const bf16_t* kp = zb + (size_t)kv_s * ZP + ZC_CK + 64 * h + 8 * c_s;
    const bf16_t* vp = zb + (size_t)kv_s * ZP + ZC_CV + 64 * h + 8 * c_s;
    u32x4 kreg = *(const u32x4*)kp, vreg = *(const u32x4*)vp;
    float m[2] = {-1e30f, -1e30f}, l[2] = {0.f, 0.f}; f32x16 o[2][2];
#pragma unroll
    for (int c = 0; c < 2; ++c) { o[c][0] = (f32x16){}; o[c][1] = (f32x16){}; }
    const int krow = swap23(qi);
    const float* tl = (const float*)(lds + AT_TBL);
    for (int kt = 0; kt < ntiles; ++kt) {
        const int buf = kt & 1;
        stage_kv(lds, buf, kv_s, c_s, kreg, vreg);
        __syncthreads();
        if (kt + 1 < ntiles) { kreg = *(const u32x4*)(kp + (size_t)(kt + 1) * 64 * ZP); vreg = *(const u32x4*)(vp + (size_t)(kt + 1) * 64 * ZP); }
        if (kt <= mylast) {
            const int dmin = q0 - (64 * kt + 63);
            const bool far_ = dmin >= 1513;
            const float cb = tl[1600];
            const int dq = q0 + qi - 64 * kt - 8 * hi;
#pragma unroll
            for (int hf = 0; hf < 2; ++hf) {
                f32x16 p0 = (f32x16){}, p1 = (f32x16){};
#pragma unroll
                for (int ds = 0; ds < 2; ++ds) {
                    const bf16x8 k0 = *(const bf16x8*)(lds + AT_KS + buf * 9216 + (32 * hf + krow) * 144 + 32 * ds + 16 * hi);
                    const bf16x8 k1 = *(const bf16x8*)(lds + AT_KS + buf * 9216 + (32 * hf + krow) * 144 + 64 + 32 * ds + 16 * hi);
                    p0 = MFMA32(k0, qf[0][ds], p0); p1 = MFMA32(k1, qf[1][ds], p1);
                }
                if (far_) {
#pragma unroll
                    for (int r = 0; r < 16; ++r) { p0[r] += cb; p1[r] += cb; }
                } else {
#pragma unroll
                    for (int r = 0; r < 16; ++r) {
                        const int dist = dq - (32 * hf + 16 * (r >> 3) + (r & 7));
                        const float bb = tl[dist < 0 ? 0 : dist];
                        const bool ok = dist >= 0;
                        p0[r] = ok ? p0[r] + bb : -INFINITY; p1[r] = ok ? p1[r] + bb : -INFINITY;
                    }
                }
                softmax_half(p0, m[0], l[0], o[0]); softmax_half(p1, m[1], l[1], o[1]);
#pragma unroll
                for (int s = 0; s < 2; ++s) {
                    const bf16x8 f0 = pack8(p0, 8 * s), f1 = pack8(p1, 8 * s);
#pragma unroll
                    for (int db = 0; db < 2; ++db) {
                        const bf16x8 vf = *(const bf16x8*)(lds + AT_VT + buf * 9216 + (32 * db + qi) * 144 + 2 * (32 * hf + 16 * s + 8 * hi));
                        o[0][db] = MFMA32(vf, f0, o[0][db]); o[1][db] = MFMA32(vf, f1, o[1][db]);
                    }
                }
            }
        }
    }
    const float lam_init = 0.8f - 0.6f * __expf(-0.3f * (float)layer);
    const float* lp = a.in[12] + layer * 128;
    float s1 = 0.f, s2 = 0.f;
    for (int i = 0; i < 32; ++i) { s1 += lp[i] * lp[32 + i]; s2 += lp[64 + i] * lp[96 + i]; }
    const float lam = __expf(s1) - __expf(s2) + lam_init;
    const float i0 = 1.f / half_swap_sum(l[0]), i1 = lam / half_swap_sum(l[1]);
    float ss = 0.f;
#pragma unroll
    for (int db = 0; db < 2; ++db)
#pragma unroll
        for (int r = 0; r < 16; ++r) { const float v = o[0][db][r] * i0 - o[1][db][r] * i1; o[0][db][r] = v; ss += v * v; }
    ss = half_swap_sum(ss);
    const float rn = __builtin_amdgcn_rsqf(ss * (1.f / 64.f) + EPS) * (1.f - lam_init);
    const float* gn = a.in[13] + layer * 64;
#pragma unroll
    for (int db = 0; db < 2; ++db)
#pragma unroll
        for (int r = 0; r < 16; ++r) o[0][db][r] *= gn[32 * db + (r & 3) + 8 * (r >> 2) + 4 * hi];
    store_ot((bf16_t*)(a.ws + WS_MIX) + (size_t)(b * S + q0 + qi) * D + 512 + 64 * h, o[0], rn, hi);
    __syncthreads();
}

__device__ __forceinline__ void dil_unit(const Args& a, unsigned char* lds, int bh, int br, int rho, int tile) {
    const int tid = threadIdx.x, lane = tid & 63, w = tid >> 6, qi = lane & 31, hi = lane >> 5;
    const int b = bh >> 2, h = bh & 3;
    const int r = br == 0 ? 1 : (br == 1 ? 4 : 16);
    const bf16_t* zb = (const bf16_t*)(a.ws + WS_ZB) + (size_t)b * S * ZP;
    { const float* tb = (const float*)(a.ws + WS_TB) + (size_t)h * TBN; float* tl = (float*)(lds + AT_TBL); for (int i = tid; i < TBN; i += NTHR) tl[i] = tb[i]; }
    const int l0 = 256 * tile, lq0 = l0 + 32 * w;
    const int tq = (lq0 + qi) * r + rho;
    bf16x8 qf[4];
#pragma unroll
    for (int ds = 0; ds < 4; ++ds) qf[ds] = *(const bf16x8*)(zb + (size_t)tq * ZP + ZC_DQ + 64 * h + 16 * ds + 8 * hi);
    const int kv_s = tid & 63, c_s = tid >> 6;
    const int j0 = (l0 == 0) ? 2 : 0;
    auto krow_of = [&](int j) { int kl = l0 - 128 + 64 * j + kv_s; kl = kl < 0 ? 0 : kl; return (size_t)(kl * r + rho) * ZP; };
    u32x4 kreg = *(const u32x4*)(zb + krow_of(j0) + ZC_DK + 64 * h + 8 * c_s), vreg = *(const u32x4*)(zb + krow_of(j0) + ZC_DV + 64 * h + 8 * c_s);
    float m = -1e30f, l = 0.f; f32x16 o[2]; o[0] = (f32x16){}; o[1] = (f32x16){};
    const int krow = swap23(qi);
    const float* tl = (const float*)(lds + AT_TBL);
    for (int j = j0; j < 6; ++j) {
        const int buf = j & 1;
        stage_kv(lds, buf, kv_s, c_s, kreg, vreg);
        __syncthreads();
        if (j + 1 < 6) { kreg = *(const u32x4*)(zb + krow_of(j + 1) + ZC_DK + 64 * h + 8 * c_s); vreg = *(const u32x4*)(zb + krow_of(j + 1) + ZC_DV + 64 * h + 8 * c_s); }
        const int kl0 = l0 - 128 + 64 * j;
        if (kl0 <= lq0 + 31 && kl0 + 63 >= lq0 - 128) {
            f32x16 p[2];
#pragma unroll
            for (int hf = 0; hf < 2; ++hf) {
                p[hf] = (f32x16){};
#pragma unroll
                for (int ds = 0; ds < 4; ++ds) { const bf16x8 kf = *(const bf16x8*)(lds + AT_KS + buf * 9216 + (32 * hf + krow) * 144 + 32 * ds + 16 * hi); p[hf] = MFMA32(kf, qf[ds], p[hf]); }
            }
            const int dq = lq0 + qi - kl0 - 8 * hi;
#pragma unroll
            for (int hf = 0; hf < 2; ++hf)
#pragma unroll
                for (int rr = 0; rr < 16; ++rr) {
                    const int kvoff = 32 * hf + 16 * (rr >> 3) + (rr & 7);
                    const int dd = dq - kvoff;
                    const bool ok = dd >= 0 && dd <= 128 && (kl0 + 8 * hi + kvoff) >= 0;
                    const float bb = tl[ok ? dd * r : 0];
                    p[hf][rr] = ok ? p[hf][rr] + bb : -INFINITY;
                }
            bf16x8 pf[2][2];
            softmax_tile(p, 0.f, m, l, o, pf);
            pv_tile(lds, buf, qi, hi, pf, o);
        }
    }
    l = half_swap_sum(l);
    const size_t tok = (size_t)b * S + tq;
    store_ot((bf16_t*)(a.ws + WS_DPART) + ((size_t)br * T + tok) * 256 + 64 * h, o, 1.f / l, hi);
    if (hi == 0) ((float*)(a.ws + WS_DLSE))[((size_t)br * T + tok) * 4 + h] = m + __builtin_amdgcn_logf(l);
    __syncthreads();
}
}
namespace hk {
struct S5P { float abr, abi, bbr[16], bbi[16]; };
__device__ __forceinline__ void s5_params(const Args& a, int layer, int g, int n, S5P& P, float& dtar, float& dtai) {
    const int lg = layer * 16 + g;
    const float dt = expf(a.in[17][lg]);
    const float ar = a.in[15][lg * 64 + n], ai = a.in[16][lg * 64 + n];
    dtar = dt * ar; dtai = dt * ai;
    const float mag = expf(dtar);
    P.abr = mag * cosf(dtai); P.abi = mag * sinf(dtai);
    const float den = ar * ar + ai * ai, nr = P.abr - 1.f, ni = P.abi;
    const float cr = (nr * ar + ni * ai) / den, ci = (ni * ar - nr * ai) / den;
    const float* brp = a.in[18] + ((size_t)lg * 64 + n) * 16; const float* bip = a.in[19] + ((size_t)lg * 64 + n) * 16;
#pragma unroll
    for (int c = 0; c < 16; ++c) { const float br = brp[c], bi = bip[c]; P.bbr[c] = cr * br - ci * bi; P.bbi[c] = cr * bi + ci * br; }
}
__device__ __forceinline__ void s5_step(const S5P& P, const float* __restrict__ up, float& xr, float& xi) {
    const f32x4 u0 = *(const f32x4*)(up), u1 = *(const f32x4*)(up + 4), u2 = *(const f32x4*)(up + 8), u3 = *(const f32x4*)(up + 12);
    float pr = P.bbr[0] * u0[0], pi = P.bbi[0] * u0[0];
    pr += P.bbr[1] * u0[1]; pi += P.bbi[1] * u0[1]; pr += P.bbr[2] * u0[2]; pi += P.bbi[2] * u0[2]; pr += P.bbr[3] * u0[3]; pi += P.bbi[3] * u0[3];
    pr += P.bbr[4] * u1[0]; pi += P.bbi[4] * u1[0]; pr += P.bbr[5] * u1[1]; pi += P.bbi[5] * u1[1]; pr += P.bbr[6] * u1[2]; pi += P.bbi[6] * u1[2]; pr += P.bbr[7] * u1[3]; pi += P.bbi[7] * u1[3];
    pr += P.bbr[8] * u2[0]; pi += P.bbi[8] * u2[0]; pr += P.bbr[9] * u2[1]; pi += P.bbi[9] * u2[1]; pr += P.bbr[10] * u2[2]; pi += P.bbi[10] * u2[2]; pr += P.bbr[11] * u2[3]; pi += P.bbi[11] * u2[3];
    pr += P.bbr[12] * u3[0]; pi += P.bbi[12] * u3[0]; pr += P.bbr[13] * u3[1]; pi += P.bbi[13] * u3[1]; pr += P.bbr[14] * u3[2]; pi += P.bbi[14] * u3[2]; pr += P.bbr[15] * u3[3]; pi += P.bbi[15] * u3[3];
    const float nxr = P.abr * xr - P.abi * xi + pr, nxi = P.abr * xi + P.abi * xr + pi;
    xr = nxr; xi = nxi;
}
__device__ __forceinline__ void s5_pass1_unit(const Args& a, int layer, int b, int c) {
    const int n = threadIdx.x & 63, w = __builtin_amdgcn_readfirstlane(threadIdx.x >> 6);
    int vz; asm volatile("v_mov_b32 %0, 0" : "=v"(vz));
    const float* su = (const float*)(a.ws + WS_SU) + ((size_t)b * S + c * S5_TC) * 256 + vz;
    float* sst = (float*)(a.ws + WS_SST);
    for (int gg = 0; gg < 2; ++gg) {
        const int g = 2 * w + gg;
        S5P P; float d0, d1; s5_params(a, layer, g, n, P, d0, d1);
        float xr = 0.f, xi = 0.f;
        const float* up = su + g * 16;
        for (int t = 0; t < S5_TC; ++t) s5_step(P, up + (size_t)t * 256, xr, xi);
        float* sp = sst + (((size_t)b * 16 + g) * S5_NCH + c) * 128;
        sp[n] = xr; sp[64 + n] = xi;
    }
}
constexpr int P3_XS = 0, P3_XS_W = 16 * 272, P3_GS = 8 * P3_XS_W, P3_GS_P = 528, P3_END = P3_GS + 64 * P3_GS_P;
__device__ __forceinline__ void s5_pass2_unit(const Args& a, unsigned char* lds, int layer, int b, int seg) {
    const int tid = threadIdx.x, lane = tid & 63, n = lane, w = __builtin_amdgcn_readfirstlane(tid >> 6);
    const int qi = lane & 31, hi = lane >> 5, l15 = lane & 15, kg = lane >> 4;
    int vz; asm volatile("v_mov_b32 %0, 0" : "=v"(vz));
    const float* su = (const float*)(a.ws + WS_SU) + ((size_t)b * S + seg * 256) * 256 + vz;
    const float* sst = (const float*)(a.ws + WS_SST);
    S5P P[2]; float xr[2], xi[2]; bf16x8 cm[2][4]; f32x4 dsk[2];
#pragma unroll
    for (int gg = 0; gg < 2; ++gg) {
        const int g = 2 * w + gg, lg = layer * 16 + g;
        float dtar, dtai; s5_params(a, layer, g, n, P[gg], dtar, dtai);
        const float mg = expf(64.f * dtar), tr = mg * cosf(64.f * dtai), ti = mg * sinf(64.f * dtai);
        float cr = 0.f, ci = 0.f;
        const float* sp = sst + (((size_t)b * 16 + g) * S5_NCH) * 128;
        const int nprev = 4 * seg;
        for (int j = 0; j < nprev; ++j) { const float sr = sp[(size_t)j * 128 + n], si = sp[(size_t)j * 128 + 64 + n]; const float t0 = tr * cr - ti * ci + sr, t1 = tr * ci + ti * cr + si; cr = t0; ci = t1; }
        xr[gg] = cr; xi[gg] = ci;
        const float* crp = a.in[20] + ((size_t)lg * 16 + l15) * 64; const float* cip = a.in[21] + ((size_t)lg * 16 + l15) * 64;
#pragma unroll
        for (int ks = 0; ks < 4; ++ks) {
            const int k0 = 32 * ks + 8 * kg;
            float v[8];
#pragma unroll
            for (int j = 0; j < 8; ++j) v[j] = (k0 < 64) ? crp[k0 + j] : -cip[k0 - 64 + j];
            u32x4 pw; pw.x = pk2(v[0], v[1]); pw.y = pk2(v[2], v[3]); pw.z = pk2(v[4], v[5]); pw.w = pk2(v[6], v[7]);
            cm[gg][ks] = __builtin_bit_cast(bf16x8, pw);
        }
        dsk[gg] = *(const f32x4*)(a.in[22] + lg * 16 + 4 * kg);
    }
    unsigned char* xs = lds + P3_XS + w * P3_XS_W;
    const bf16_t* gluT = (const bf16_t*)(a.ws + WS_GLU) + (size_t)layer * 65536;
    const float* glub = a.in[24] + layer * 256;
    bf16_t* mix = (bf16_t*)(a.ws + WS_MIX) + ((size_t)b * S + seg * 256) * D + 768;
    for (int sub = 0; sub < 4; ++sub) {
#pragma unroll
        for (int gg = 0; gg < 2; ++gg) {
            const int g = 2 * w + gg;
            for (int blk = 0; blk < 4; ++blk) {
                const int t0 = sub * 64 + blk * 16;
                for (int tt = 0; tt < 16; ++tt) {
                    s5_step(P[gg], su + (size_t)(t0 + tt) * 256 + g * 16, xr[gg], xi[gg]);
                    bf16_t* xp = (bf16_t*)(xs + tt * 272);
                    xp[n] = f2bf(xr[gg]); xp[64 + n] = f2bf(xi[gg]);
                }
                f32x4 acc = (f32x4){0.f, 0.f, 0.f, 0.f};
#pragma unroll
                for (int ks = 0; ks < 4; ++ks) { const bf16x8 bfr = *(const bf16x8*)(xs + l15 * 272 + (32 * ks + 8 * kg) * 2); acc = __builtin_amdgcn_mfma_f32_16x16x32_bf16(cm[gg][ks], bfr, acc, 0, 0, 0); }
                const f32x4 uu = *(const f32x4*)(su + (size_t)(t0 + l15) * 256 + g * 16 + 4 * kg);
                u32x2 gw; gw.x = pk2(gelu_tanh(acc[0] + dsk[gg][0] * uu[0]), gelu_tanh(acc[1] + dsk[gg][1] * uu[1])); gw.y = pk2(gelu_tanh(acc[2] + dsk[gg][2] * uu[2]), gelu_tanh(acc[3] + dsk[gg][3] * uu[3]));
                *(u32x2*)(lds + P3_GS + (blk * 16 + l15) * P3_GS_P + (g * 16 + 4 * kg) * 2) = gw;
            }
        }
        __syncthreads();
#pragma unroll
        for (int tb = 0; tb < 2; ++tb) {
            f32x16 acc = (f32x16){};
#pragma unroll
            for (int ks = 0; ks < 16; ++ks) {
                const bf16x8 af = *(const bf16x8*)(gluT + (size_t)(32 * w + qi) * 256 + 16 * ks + 8 * hi);
                const bf16x8 bfr = *(const bf16x8*)(lds + P3_GS + (32 * tb + qi) * P3_GS_P + (16 * ks + 8 * hi) * 2);
                acc = MFMA32(af, bfr, acc);
            }
#pragma unroll
            for (int r4 = 0; r4 < 4; ++r4) {
                const int nn = 32 * w + 8 * r4 + 4 * hi;
                const u32x2 gq = *(const u32x2*)(lds + P3_GS + (32 * tb + qi) * P3_GS_P + nn * 2);
                const f32x4 bb = *(const f32x4*)(glub + nn);
                float ov[4];
#pragma unroll
                for (int e = 0; e < 4; ++e) {
                    const float gval = __uint_as_float(((e & 1) ? (((e >> 1) ? gq.y : gq.x) & 0xffff0000u) : (((e >> 1) ? gq.y : gq.x) << 16)));
                    ov[e] = gval / (1.f + __expf(-(acc[4 * r4 + e] + bb[e])));
                }
                u32x2 ow; ow.x = pk2(ov[0], ov[1]); ow.y = pk2(ov[2], ov[3]);
                *(u32x2*)(mix + (size_t)(sub * 64 + 32 * tb + qi) * D + nn) = ow;
            }
        }
        __syncthreads();
    }
}
__device__ __forceinline__ void phase_p3_elementwise(const Args& a, int layer) {
    const size_t gt = (size_t)blockIdx.x * NTHR + threadIdx.x, gn = (size_t)gridDim.x * NTHR;
    const bf16_t* dp = (const bf16_t*)(a.ws + WS_DPART); const float* dl = (const float*)(a.ws + WS_DLSE); bf16_t* mix = (bf16_t*)(a.ws + WS_MIX);
    for (size_t i = gt; i < (size_t)T * 32; i += gn) {
        const size_t tok = i >> 5; const int ch = (int)(i & 31), h = ch >> 3;
        const float l0 = dl[tok * 4 + h], l1 = dl[((size_t)T + tok) * 4 + h], l2 = dl[((size_t)2 * T + tok) * 4 + h];
        const float mx = fmaxf(l0, fmaxf(l1, l2));
        float w0 = __builtin_amdgcn_exp2f(l0 - mx), w1 = __builtin_amdgcn_exp2f(l1 - mx), w2 = __builtin_amdgcn_exp2f(l2 - mx);
        const float inv = 1.f / (w0 + w1 + w2); w0 *= inv; w1 *= inv; w2 *= inv;
        const u32x4 a0 = *(const u32x4*)(dp + tok * 256 + ch * 8), a1 = *(const u32x4*)(dp + ((size_t)T + tok) * 256 + ch * 8), a2 = *(const u32x4*)(dp + ((size_t)2 * T + tok) * 256 + ch * 8);
        u32x4 o;
#pragma unroll
        for (int j = 0; j < 4; ++j) {
            const float lo = w0 * __uint_as_float(a0[j] << 16) + w1 * __uint_as_float(a1[j] << 16) + w2 * __uint_as_float(a2[j] << 16);
            const float hi = w0 * __uint_as_float(a0[j] & 0xffff0000u) + w1 * __uint_as_float(a1[j] & 0xffff0000u) + w2 * __uint_as_float(a2[j] & 0xffff0000u);
            o[j] = pk2(lo, hi);
        }
        *(u32x4*)(mix + tok * D + 256 + ch * 8) = o;
    }
    const float* pu = a.in[27] + (size_t)layer * NEXP * D; const float* pv = a.in[28] + (size_t)layer * NEXP * D; const float* gn_ = a.in[5] + layer * D;
    bf16_t* ut = (bf16_t*)(a.ws + WS_UT); bf16_t* vt = (bf16_t*)(a.ws + WS_VT);
    for (size_t i = gt; i < (size_t)NEXP * D / 8; i += gn) {
        const size_t e0 = i * 8; const int k = (int)(e0 & 1023);
        const f32x4 u0 = *(const f32x4*)(pu + e0), u1 = *(const f32x4*)(pu + e0 + 4), g0 = *(const f32x4*)(gn_ + k), g1 = *(const f32x4*)(gn_ + k + 4);
        const f32x4 v0 = *(const f32x4*)(pv + e0), v1 = *(const f32x4*)(pv + e0 + 4);
        u32x4 ou, ov;
        ou.x = pk2(u0[0] * g0[0], u0[1] * g0[1]); ou.y = pk2(u0[2] * g0[2], u0[3] * g0[3]); ou.z = pk2(u1[0] * g1[0], u1[1] * g1[1]); ou.w = pk2(u1[2] * g1[2], u1[3] * g1[3]);
        ov.x = pk2(v0[0], v0[1]); ov.y = pk2(v0[2], v0[3]); ov.z = pk2(v1[0], v1[1]); ov.w = pk2(v1[2], v1[3]);
        *(u32x4*)(ut + e0) = ou; *(u32x4*)(vt + e0) = ov;
    }
}

__device__ __forceinline__ unsigned srt(float f) { const unsigned u = __float_as_uint(f); return u ^ ((unsigned)((int)u >> 31) | 0x80000000u); }
__device__ __forceinline__ float unsrt(unsigned u) { return __uint_as_float(u ^ ((~(unsigned)((int)u >> 31)) | 0x80000000u)); }
__device__ __forceinline__ void ins16(unsigned (&top)[16], unsigned pk) {
#pragma unroll
    for (int j = 0; j < 16; ++j) { const unsigned hi_ = top[j] > pk ? top[j] : pk; pk = top[j] > pk ? pk : top[j]; top[j] = hi_; }
}
__device__ __forceinline__ void merge_halves(unsigned (&top)[16]) {
    unsigned lo[16], hi[16];
#pragma unroll
    for (int j = 0; j < 16; ++j) { auto rr = __builtin_amdgcn_permlane32_swap(top[j], top[j], false, false); lo[j] = rr[0]; hi[j] = rr[1]; }
#pragma unroll
    for (int j = 0; j < 16; ++j) top[j] = lo[j] > hi[15 - j] ? lo[j] : hi[15 - j];
#pragma unroll
    for (int d = 8; d >= 1; d >>= 1)
#pragma unroll
        for (int i = 0; i < 16; ++i) if ((i & d) == 0) { const unsigned x = top[i], y = top[i + d]; top[i] = x > y ? x : y; top[i + d] = x > y ? y : x; }
}
constexpr int P6_PL = 0, P6_RS = 32768, P6_END = 32768 + 128;
__device__ __forceinline__ float dot8(const u32x4& a, const unsigned (&xh)[4], float acc) {
#pragma unroll
    for (int j = 0; j < 4; ++j) { acc += __uint_as_float(a[j] << 16) * __uint_as_float(xh[j] << 16); acc += __uint_as_float(a[j] & 0xffff0000u) * __uint_as_float(xh[j] & 0xffff0000u); }
    return acc;
}
__device__ __forceinline__ void peer_unit(const Args& a, unsigned char* lds, int layer, int unit) {
    const int tid = threadIdx.x, lane = tid & 63, w = __builtin_amdgcn_readfirstlane(tid >> 6), qi = lane & 31, hi = lane >> 5;
    const int tok0 = unit * 32;
    const float* xg = a.out;
    float* rsl = (float*)(lds + P6_RS);
    for (int tt = 0; tt < 4; ++tt) {
        const float* p = xg + (size_t)(tok0 + 4 * w + tt) * D;
        const f32x4 a0 = *(const f32x4*)(p + 8 * lane), a1 = *(const f32x4*)(p + 8 * lane + 4), a2 = *(const f32x4*)(p + 512 + 8 * lane), a3 = *(const f32x4*)(p + 512 + 8 * lane + 4);
        float ss = a0[0] * a0[0] + a0[1] * a0[1] + a0[2] * a0[2] + a0[3] * a0[3] + a1[0] * a1[0] + a1[1] * a1[1] + a1[2] * a1[2] + a1[3] * a1[3]
                 + a2[0] * a2[0] + a2[1] * a2[1] + a2[2] * a2[2] + a2[3] * a2[3] + a3[0] * a3[0] + a3[1] * a3[1] + a3[2] * a3[2] + a3[3] * a3[3];
        ss = wave_sum(ss);
        if (lane == 0) rsl[4 * w + tt] = __builtin_amdgcn_rsqf(ss * (1.f / 1024.f) + EPS);
    }
    __syncthreads();
    {
        const float rs2 = rsl[qi];
        const bf16_t* qrow = (const bf16_t*)(a.ws + WS_ZB) + (size_t)(tok0 + qi) * 2048 + 256 * w;
        const bf16_t* kb_ = (const bf16_t*)(a.ws + WS_KEYS) + (size_t)(layer * 16 + 2 * w) * 128 * 128;
        unsigned lst[2][16];
#pragma unroll
        for (int p = 0; p < 2; ++p) {
            bf16x8 qf[8];
#pragma unroll
            for (int ks = 0; ks < 8; ++ks) qf[ks] = *(const bf16x8*)(qrow + 128 * p + 16 * ks + 8 * hi);
            unsigned top[16];
#pragma unroll
            for (int j = 0; j < 16; ++j) top[j] = 0u;
#pragma unroll 1
            for (int kb = 0; kb < 4; ++kb) {
                f32x16 acc = (f32x16){};
#pragma unroll
                for (int ks = 0; ks < 8; ++ks) { const bf16x8 kf = *(const bf16x8*)(kb_ + ((size_t)p * 128 + 32 * kb + qi) * 128 + 16 * ks + 8 * hi); acc = MFMA32(kf, qf[ks], acc); }
#pragma unroll
                for (int r = 0; r < 16; ++r) ins16(top, (srt(acc[r]) & ~127u) | (unsigned)(32 * kb + (r & 3) + 8 * (r >> 2) + 4 * hi));
            }
            merge_halves(top);
#pragma unroll
            for (int j = 0; j < 16; ++j) lst[p][j] = top[j];
        }
        float va[16], vb[16]; unsigned ia[16], ib[16];
#pragma unroll
        for (int j = 0; j < 16; ++j) { va[j] = unsrt(lst[0][j] & ~127u); ia[j] = (lst[0][j] & 127u) << 7; vb[j] = unsrt(lst[1][j] & ~127u); ib[j] = lst[1][j] & 127u; }
        unsigned best[16];
#pragma unroll
        for (int j = 0; j < 16; ++j) best[j] = 0u;
#pragma unroll
        for (int i = 0; i < 16; ++i)
#pragma unroll
            for (int j = 0; j < 16; ++j)
                if ((i + 1) * (j + 1) <= 16) ins16(best, (srt(va[i] + vb[j]) & ~0x3FFFu) | ia[i] | ib[j]);
        float e[16], sum = 0.f;
        const float s0 = unsrt(best[0] & ~0x3FFFu);
#pragma unroll
        for (int j = 0; j < 16; ++j) { e[j] = __builtin_amdgcn_exp2f((unsrt(best[j] & ~0x3FFFu) - s0) * rs2 * LOG2E); sum += e[j]; }
        const float inv = 1.f / sum;
        if (hi == 0) {
            u32x2* pl = (u32x2*)(lds + P6_PL) + qi * 128 + 16 * w;
#pragma unroll
            for (int j = 0; j < 16; ++j) { u32x2 en; en.x = best[j] & 0x3FFFu; en.y = __float_as_uint(e[j] * inv); pl[j] = en; }
        }
    }
    __syncthreads();
    const bf16_t* ut = (const bf16_t*)(a.ws + WS_UT); const bf16_t* vt = (const bf16_t*)(a.ws + WS_VT);
    for (int tt = 0; tt < 4; ++tt) {
        const int tl = 4 * w + tt, tok = tok0 + tl;
        const float rs2 = rsl[tl];
        const float* p = xg + (size_t)tok * D;
        const f32x4 a0 = *(const f32x4*)(p + 8 * lane), a1 = *(const f32x4*)(p + 8 * lane + 4), a2 = *(const f32x4*)(p + 512 + 8 * lane), a3 = *(const f32x4*)(p + 512 + 8 * lane + 4);
        float xv[16] = {a0[0], a0[1], a0[2], a0[3], a1[0], a1[1], a1[2], a1[3], a2[0], a2[1], a2[2], a2[3], a3[0], a3[1], a3[2], a3[3]};
        unsigned xh0[4], xh1[4];
#pragma unroll
        for (int j = 0; j < 4; ++j) { xh0[j] = pk2(xv[2 * j], xv[2 * j + 1]); xh1[j] = pk2(xv[8 + 2 * j], xv[8 + 2 * j + 1]); }
        const u32x2* pl = (const u32x2*)(lds + P6_PL) + tl * 128;
        const u32x2 en0 = pl[lane], en1 = pl[64 + lane];
        float act[2] = {0.f, 0.f};
#pragma unroll
        for (int half = 0; half < 2; ++half) {
            const unsigned idv = half ? en1.x : en0.x;
            float mine = 0.f;
            for (int k = 0; k < 64; k += 8) {
                u32x4 ld0[8], ld1[8];
#pragma unroll
                for (int kk = 0; kk < 8; ++kk) { const unsigned id = __builtin_amdgcn_readlane(idv, k + kk); const bf16_t* up = ut + (size_t)id * D; ld0[kk] = *(const u32x4*)(up + 8 * lane); ld1[kk] = *(const u32x4*)(up + 512 + 8 * lane); }
#pragma unroll
                for (int kk = 0; kk < 8; ++kk) { float d = dot8(ld0[kk], xh0, 0.f); d = dot8(ld1[kk], xh1, d); d = wave_sum(d); if (lane == k + kk) mine = d; }
            }
            const float gate = __uint_as_float(half ? en1.y : en0.y);
            act[half] = gelu_tanh(mine * rs2) * gate;
        }
        float ov[16];
#pragma unroll
        for (int i = 0; i < 16; ++i) ov[i] = 0.f;
#pragma unroll
        for (int half = 0; half < 2; ++half) {
            const unsigned idv = half ? en1.x : en0.x; const float av = act[half];
            for (int k = 0; k < 64; k += 8) {
                u32x4 ld0[8], ld1[8];
#pragma unroll
                for (int kk = 0; kk < 8; ++kk) { const unsigned id = __builtin_amdgcn_readlane(idv, k + kk); const bf16_t* vp = vt + (size_t)id * D; ld0[kk] = *(const u32x4*)(vp + 8 * lane); ld1[kk] = *(const u32x4*)(vp + 512 + 8 * lane); }
#pragma unroll
                for (int kk = 0; kk < 8; ++kk) {
                    const float ak = __uint_as_float(__builtin_amdgcn_readlane(__float_as_uint(av), k + kk));
#pragma unroll
                    for (int j = 0; j < 4; ++j) {
                        ov[2 * j] += ak * __uint_as_float(ld0[kk][j] << 16); ov[2 * j + 1] += ak * __uint_as_float(ld0[kk][j] & 0xffff0000u);
                        ov[8 + 2 * j] += ak * __uint_as_float(ld1[kk][j] << 16); ov[8 + 2 * j + 1] += ak * __uint_as_float(ld1[kk][j] & 0xffff0000u);
                    }
                }
            }
        }
#pragma unroll
        for (int i = 0; i < 16; ++i) xv[i] += ov[i];
        const bool more = layer + 1 < DEPTH;
        finish_token(tok, xv, a.out, (bf16_t*)(a.ws + WS_XB), (float*)(a.ws + WS_RSTD), more ? (const float*)(a.ws + WS_WF) + (size_t)(layer + 1) * 4096 : nullptr,
                     a.in[2] + (more ? (layer + 1) * 4 : 0), (float*)(a.ws + WS_FLOG), lane);
    }
    __syncthreads();
}
}
namespace hk {
constexpr int NPHASE = 2 + 6 * DEPTH;
__device__ __forceinline__ unsigned q_next(unsigned* ctr, unsigned char* lds) {
    volatile LAS3 unsigned* slot = (volatile LAS3 unsigned*)(LAS3 unsigned char*)(lds + LDS_CTL + 32);
    __syncthreads();
    if (threadIdx.x == 0) *slot = __hip_atomic_fetch_add(ctr, 1u, __ATOMIC_RELAXED, __HIP_MEMORY_SCOPE_AGENT);
    __syncthreads();
    return *slot;
}
#define SEAM(k) do { if (a.use_bar && (k) >= a.ph_lo && (k) + 1 < a.ph_hi) { xcd_barrier(bar); } } while (0)
#define ON(k) ((k) >= a.ph_lo && (k) < a.ph_hi)
template <int l>
__device__ __forceinline__ void layer_phases(const Args& a, unsigned char* lds, const XcdBarrier& bar, unsigned* ctl) {
        const int pb = 2 + 6 * l;
        if (ON(pb)) {
            if (blockIdx.x < NB * 4) cum_scan(a, lds, blockIdx.x);
            pg8::Gemm g; g.A = (const bf16_t*)(a.ws + WS_XB); g.Bt = (const bf16_t*)(a.ws + WS_WIN) + (size_t)l * 2560 * 1024; g.M = T; g.N = 2560; g.K = 1024;
            pg8::StaticOrder so; so.init(T, 2560, gridDim.x, blockIdx.x);
            pg8::EpiIn E; E.zb = (bf16_t*)(a.ws + WS_ZB); E.su32 = (float*)(a.ws + WS_SU); E.rstd = (const float*)(a.ws + WS_RSTD);
            E.g_fq = a.in[6] + l * 64; E.g_fk = a.in[7] + l * 64; E.g_dq = a.in[8] + l * 64; E.g_dk = a.in[9] + l * 64; E.g_cq = a.in[10] + l * 32; E.g_ck = a.in[11] + l * 32;
#ifndef HK_NO_G1
            pg8::gemm_phase<pg8::EpiIn, pg8::StaticOrder, true, true>((PG8_LAS unsigned char*)lds, g, so, E);
#endif
        }
        SEAM(pb);
        if (ON(pb + 1)) {
            unsigned* ctr = ctl + CTL_Q + 64 * l;
            for (;;) {
                const unsigned u = q_next(ctr, lds);
                if (u >= 6144u) break;
                if (u < 1024u) {
#ifndef HK_NO_DIFF
 diff_unit(a, lds, l, u & 31, 31 - (u >> 5));
#endif
 }
                else if (u < 2048u) {
#ifndef HK_NO_FOX
 fox_unit(a, lds, (u - 1024u) & 31, 31 - ((u - 1024u) >> 5));
#endif
 }
                else if (u < 5120u) { const unsigned j = u - 2048u, br = j >> 10, jj = j & 1023u, bh = jj & 31u, sub = jj >> 5;
                    const int rho = br == 0 ? 0 : (br == 1 ? (sub & 3) : (sub & 15)), tile = br == 0 ? sub : (br == 1 ? (sub >> 2) : (sub >> 4));

#ifndef HK_NO_DIL
                    dil_unit(a, lds, bh, br, rho, tile);
#endif
 }
                else { const unsigned j = u - 5120u;
#ifndef HK_NO_S51
 s5_pass1_unit(a, l, j >> 7, j & 127u);
#endif
 }
            }
        }
        SEAM(pb + 1);
        if (ON(pb + 2)) {
#ifndef HK_NO_S52
            for (int u = blockIdx.x; u < 256; u += gridDim.x) s5_pass2_unit(a, lds, l, u >> 5, u & 31);
#endif
            phase_p3_elementwise(a, l);
        }
        SEAM(pb + 2);
        if (ON(pb + 3)) {
            pg8::Gemm g; g.A = (const bf16_t*)(a.ws + WS_MIX); g.Bt = (const bf16_t*)(a.ws + WS_WOUT) + (size_t)l * 1024 * 1024; g.M = T; g.N = 1024; g.K = 1024;
            pg8::StaticOrder so; so.init(T, 1024, gridDim.x, blockIdx.x);
            pg8::EpiOut E; E.x = a.out; E.xb = (bf16_t*)(a.ws + WS_XB);
#ifndef HK_NO_G2
            pg8::gemm_phase<pg8::EpiOut, pg8::StaticOrder, true, true>((PG8_LAS unsigned char*)lds, g, so, E);
#endif
        }
        SEAM(pb + 3);
        if (ON(pb + 4)) {
            pg8::Gemm g; g.A = (const bf16_t*)(a.ws + WS_XB); g.Bt = (const bf16_t*)(a.ws + WS_WQ) + (size_t)l * 2048 * 1024; g.M = T; g.N = 2048; g.K = 1024;
            pg8::StaticOrder so; so.init(T, 2048, gridDim.x, blockIdx.x);
            pg8::EpiPlain E; E.O = (bf16_t*)(a.ws + WS_ZB); E.ldc = 2048;
#ifndef HK_NO_G3
            pg8::gemm_phase<pg8::EpiPlain, pg8::StaticOrder, true, true>((PG8_LAS unsigned char*)lds, g, so, E);
#endif
        }
        SEAM(pb + 4);
        if (ON(pb + 5)) {
#ifndef HK_NO_PEER
            for (int u = blockIdx.x; u < T / 32; u += gridDim.x) peer_unit(a, lds, l, u);
#endif
        }
        SEAM(pb + 5);
    }
__global__ void __launch_bounds__(NTHR, 2) hk_mega(Args a) {
    extern __shared__ __attribute__((aligned(16))) unsigned char lds[];
    const int tid = threadIdx.x;
    if (tid < 64) ((LAS3 unsigned*)(lds + LDS_CTL))[tid] = 0u;
    __syncthreads();
    unsigned* ctl = (unsigned*)(a.ws + WS_CTL);
    XcdBarrier bar = xcd_barrier_post(ctl + CTL_BAR, (volatile LAS unsigned*)(LAS3 unsigned char*)(lds + LDS_CTL));
    if (ON(0)) phase_weights(a, lds);
    SEAM(0);
    if (ON(1)) phase_xprep(a);
    SEAM(1);
    layer_phases<0>(a, lds, bar, ctl);
    layer_phases<1>(a, lds, bar, ctl);
    layer_phases<2>(a, lds, bar, ctl);
    layer_phases<3>(a, lds, bar, ctl);
}
#undef SEAM
#undef ON
}
namespace nv {
using namespace hk;
__global__ void __launch_bounds__(64) n_fox(const bf16_t* __restrict__ zb, const float* __restrict__ cum2, bf16_t* __restrict__ mix) {
    int gid = blockIdx.x * 64 + threadIdx.x;
    int t = S - 1 - (gid % S); int bh = gid / S; int b = bh / 4, h = bh % 4;
    const bf16_t* z = zb + (size_t)b * S * ZP; const float* cm = cum2 + (size_t)bh * S;
    float q[64], o[64];
#pragma unroll
    for (int i = 0; i < 64; ++i) { q[i] = bf2f(z[(size_t)t * ZP + ZC_FQ + h * 64 + i]); o[i] = 0.f; }
    float m = -INFINITY, l = 0.f, cq = cm[t];
    int tmax = __shfl(t, 0);
    for (int s = 0; s <= tmax; ++s) {
        const bf16_t* kp = z + (size_t)s * ZP + ZC_FK + h * 64; const bf16_t* vp = z + (size_t)s * ZP + ZC_FV + h * 64;
        float d = 0.f;
#pragma unroll
        for (int i = 0; i < 64; ++i) d += q[i] * bf2f(kp[i]);
        d += cq - cm[s];
        if (s <= t) {
            float mn = fmaxf(m, d), al = exp2f(m - mn), p = exp2f(d - mn);
            l = l * al + p;
#pragma unroll
            for (int i = 0; i < 64; ++i) o[i] = o[i] * al + p * bf2f(vp[i]);
            m = mn;
        }
    }
    float inv = 1.f / l;
    bf16_t* op = mix + ((size_t)b * S + t) * D + h * 64;
#pragma unroll
    for (int i = 0; i < 64; ++i) op[i] = f2bf(o[i] * inv);
}
__global__ void __launch_bounds__(64) n_dil(const bf16_t* __restrict__ zb, const float* __restrict__ tb, bf16_t* __restrict__ mix) {
    int gid = blockIdx.x * 64 + threadIdx.x;
    int t = gid % S; int bh = gid / S; int b = bh / 4, h = bh % 4;
    const bf16_t* z = zb + (size_t)b * S * ZP;
    float q[64], o[64];
#pragma unroll
    for (int i = 0; i < 64; ++i) { q[i] = bf2f(z[(size_t)t * ZP + ZC_DQ + h * 64 + i]); o[i] = 0.f; }
    float m = -INFINITY, l = 0.f;
    for (int br = 0; br < 3; ++br) {
        int r = br == 0 ? 1 : (br == 1 ? 4 : 16);
        for (int j = 0; j <= 128; ++j) {
            bool ok = (t / r - j) >= 0; int sc = ok ? t - j * r : t;
            const bf16_t* kp = z + (size_t)sc * ZP + ZC_DK + h * 64; const bf16_t* vp = z + (size_t)sc * ZP + ZC_DV + h * 64;
            float d = 0.f;
#pragma unroll
            for (int i = 0; i < 64; ++i) d += q[i] * bf2f(kp[i]);
            d += tb[h * TBN + r * j];
            if (ok) {
                float mn = fmaxf(m, d), al = exp2f(m - mn), p = exp2f(d - mn);
                l = l * al + p;
#pragma unroll
                for (int i = 0; i < 64; ++i) o[i] = o[i] * al + p * bf2f(vp[i]);
                m = mn;
            }
        }
    }
    float inv = 1.f / l;
    bf16_t* op = mix + ((size_t)b * S + t) * D + 256 + h * 64;
#pragma unroll
    for (int i = 0; i < 64; ++i) op[i] = f2bf(o[i] * inv);
}
template <int CMP>
__global__ void __launch_bounds__(64) n_diff(const bf16_t* __restrict__ zb, const float* __restrict__ tb, float* __restrict__ tmp) {
    int gid = blockIdx.x * 64 + threadIdx.x;
    int t = S - 1 - (gid % S); int bh = gid / S; int b = bh / 4, h = bh % 4;
    const bf16_t* z = zb + (size_t)b * S * ZP;
    float q[32], o[64];
#pragma unroll
    for (int i = 0; i < 32; ++i) q[i] = bf2f(z[(size_t)t * ZP + ZC_CQ + h * 64 + CMP * 32 + i]);
#pragma unroll
    for (int i = 0; i < 64; ++i) o[i] = 0.f;
    float m = -INFINITY, l = 0.f;
    int tmax = __shfl(t, 0);
    for (int s = 0; s <= tmax; ++s) {
        const bf16_t* kp = z + (size_t)s * ZP + ZC_CK + h * 64 + CMP * 32; const bf16_t* vp = z + (size_t)s * ZP + ZC_CV + h * 64;
        float d = 0.f;
#pragma unroll
        for (int i = 0; i < 32; ++i) d += q[i] * bf2f(kp[i]);
        int rel = t - s; int ri = rel < 0 ? 0 : (rel > 2000 ? 2000 : rel);
        d += tb[(4 + h) * TBN + ri];
        if (rel >= 0) {
            float mn = fmaxf(m, d), al = exp2f(m - mn), p = exp2f(d - mn);
            l = l * al + p;
#pragma unroll
            for (int i = 0; i < 64; ++i) o[i] = o[i] * al + p * bf2f(vp[i]);
            m = mn;
        }
    }
    float inv = 1.f / l;
    float* op = tmp + ((size_t)b * S + t) * 256 + h * 64;
#pragma unroll
    for (int i = 0; i < 64; ++i) op[i] = o[i] * inv;
}
__global__ void n_diff_fin(const float* __restrict__ tmp0, const float* __restrict__ tmp1, const float* __restrict__ lamp, const float* __restrict__ gain, float lam_init, bf16_t* __restrict__ mix) {
    size_t gid = (size_t)blockIdx.x * blockDim.x + threadIdx.x;
    if (gid >= (size_t)T * 4) return;
    size_t tok = gid / 4; int h = (int)(gid % 4);
    float s1 = 0.f, s2 = 0.f;
    for (int i = 0; i < 32; ++i) { s1 += lamp[i] * lamp[32 + i]; s2 += lamp[64 + i] * lamp[96 + i]; }
    float lam = expf(s1) - expf(s2) + lam_init;
    const float* p0 = tmp0 + tok * 256 + h * 64; const float* p1 = tmp1 + tok * 256 + h * 64;
    float ss = 0.f;
    for (int i = 0; i < 64; ++i) { float v = p0[i] - lam * p1[i]; ss += v * v; }
    float r = rsqrtf(ss / 64 + EPS) * (1.f - lam_init);
    bf16_t* op = mix + tok * D + 512 + h * 64;
    for (int i = 0; i < 64; ++i) op[i] = f2bf((p0[i] - lam * p1[i]) * r * gain[i]);
}
__global__ void __launch_bounds__(64) n_s5(const float* __restrict__ su, const float* a_re, const float* a_im, const float* log_dt, const float* b_re, const float* b_im,
                                           const float* c_re, const float* c_im, const float* dsk, float* __restrict__ gbuf) {
    int b = blockIdx.x / 16, g = blockIdx.x % 16, n = threadIdx.x;
    float dt = expf(log_dt[g]);
    float ar = a_re[g * 64 + n], ai = a_im[g * 64 + n];
    float mag = expf(dt * ar);
    float abr = mag * cosf(dt * ai), abi = mag * sinf(dt * ai);
    float den = ar * ar + ai * ai, nr = abr - 1.f, ni = abi;
    float cr = (nr * ar + ni * ai) / den, ci = (ni * ar - nr * ai) / den;
    float bbr[16], bbi[16], ccr[16], cci[16];
#pragma unroll
    for (int c = 0; c < 16; ++c) {
        float br = b_re[(g * 64 + n) * 16 + c], bi = b_im[(g * 64 + n) * 16 + c];
        bbr[c] = cr * br - ci * bi; bbi[c] = cr * bi + ci * br;
        ccr[c] = c_re[(g * 16 + c) * 64 + n]; cci[c] = c_im[(g * 16 + c) * 64 + n];
    }
    float dk = (n < 16) ? dsk[g * 16 + n] : 0.f;
    float xr = 0.f, xi = 0.f;
    for (int s = 0; s < S; ++s) {
        const float* up = su + ((size_t)b * S + s) * 256 + g * 16;
        float u[16];
#pragma unroll
        for (int c = 0; c < 16; ++c) u[c] = up[c];
        float pr = 0.f, pi = 0.f;
#pragma unroll
        for (int c = 0; c < 16; ++c) { pr += bbr[c] * u[c]; pi += bbi[c] * u[c]; }
        float nxr = abr * xr - abi * xi + pr, nxi = abr * xi + abi * xr + pi;
        xr = nxr; xi = nxi;
        float myy = 0.f;
#pragma unroll
        for (int c = 0; c < 16; ++c) { float v = wave_sum(ccr[c] * xr - cci[c] * xi); if (n == c) myy = v + dk * u[c]; }
        if (n < 16) gbuf[((size_t)b * S + s) * 256 + g * 16 + n] = gelu_tanh(myy);
    }
}
__global__ void __launch_bounds__(256) n_glu(const float* __restrict__ gbuf, const float* __restrict__ w, const float* __restrict__ bias, bf16_t* __restrict__ mix) {
    __shared__ float gs[256];
    size_t tok = blockIdx.x; int j = threadIdx.x;
    gs[j] = gbuf[tok * 256 + j];
    __syncthreads();
    float acc = bias[j];
    for (int k = 0; k < 256; ++k) acc += gs[k] * w[k * 256 + j];
    mix[tok * D + 768 + j] = f2bf(gs[j] * (1.f / (1.f + expf(-acc))));
}
template <int MODE>
__global__ void __launch_bounds__(256) n_gemm(const bf16_t* __restrict__ A, const float* __restrict__ g, const float* __restrict__ B, float* __restrict__ X, bf16_t* __restrict__ O, int M, int N, int K) {
    __shared__ float As[16][68];
    __shared__ float Bs[16][68];
    const int tx = threadIdx.x & 15, ty = threadIdx.x >> 4;
    const int m0 = blockIdx.y * 64, n0 = blockIdx.x * 64;
    float acc[4][4];
#pragma unroll
    for (int i = 0; i < 4; ++i)
#pragma unroll
        for (int j = 0; j < 4; ++j) acc[i][j] = 0.f;
    for (int k0 = 0; k0 < K; k0 += 16) {
        { int r = threadIdx.x >> 2, c4 = (threadIdx.x & 3) * 4;
          const bf16_t* ap = A + (size_t)(m0 + r) * K + k0 + c4;
#pragma unroll
          for (int j = 0; j < 4; ++j) { float v = bf2f(ap[j]); if (g) v *= g[k0 + c4 + j]; As[c4 + j][r] = v; }
          int br = threadIdx.x >> 4, bc = (threadIdx.x & 15) * 4;
#pragma unroll
          for (int j = 0; j < 4; ++j) Bs[br][bc + j] = B[(size_t)(k0 + br) * N + n0 + bc + j]; }
        __syncthreads();
#pragma unroll
        for (int kk = 0; kk < 16; ++kk) {
            float av[4], bv[4];
#pragma unroll
            for (int i = 0; i < 4; ++i) av[i] = As[kk][ty * 4 + i];
#pragma unroll
            for (int j = 0; j < 4; ++j) bv[j] = Bs[kk][tx * 4 + j];
#pragma unroll
            for (int i = 0; i < 4; ++i)
#pragma unroll
                for (int j = 0; j < 4; ++j) acc[i][j] += av[i] * bv[j];
        }
        __syncthreads();
    }
#pragma unroll
    for (int i = 0; i < 4; ++i)
#pragma unroll
        for (int j = 0; j < 4; ++j) {
            size_t off = (size_t)(m0 + ty * 4 + i) * N + n0 + tx * 4 + j;
            if (MODE == 0) { float v = X[off] + acc[i][j]; X[off] = v; O[off] = f2bf(v); } else O[off] = f2bf(acc[i][j]);
        }
}
__global__ void n_rstd(const float* __restrict__ x, float* __restrict__ rstd) {
    int row = blockIdx.x * 4 + (threadIdx.x >> 6), lane = threadIdx.x & 63;
    const float* p = x + (size_t)row * D;
    float s = 0.f;
    for (int i = lane; i < D; i += 64) { float v = p[i]; s += v * v; }
    s = wave_sum(s);
    if (lane == 0) rstd[row] = rsqrtf(s / D + EPS);
}
__global__ void __launch_bounds__(256) n_top1(const bf16_t* __restrict__ q, const float* __restrict__ keys, float* __restrict__ tv, int* __restrict__ ti) {
    extern __shared__ float ks[];
    int hp = blockIdx.y; size_t tok = (size_t)blockIdx.x * 256 + threadIdx.x;
    const float* kg = keys + (size_t)hp * 128 * 128;
    for (int i = threadIdx.x; i < 128 * 128; i += 256) ks[i] = kg[i];
    __syncthreads();
    float qv[128];
    const bf16_t* qp = q + tok * 2048 + hp * 128;
#pragma unroll
    for (int i = 0; i < 128; ++i) qv[i] = bf2f(qp[i]);
    float bv[16]; int bi[16];
#pragma unroll
    for (int j = 0; j < 16; ++j) { bv[j] = -INFINITY; bi[j] = 0; }
    for (int k = 0; k < 128; ++k) {
        float d = 0.f;
#pragma unroll
        for (int i = 0; i < 128; ++i) d += qv[i] * ks[k * 128 + i];
        float cv = d; int ci = k;
#pragma unroll
        for (int j = 0; j < 16; ++j) { if (cv > bv[j]) { float tvv = bv[j]; int tii = bi[j]; bv[j] = cv; bi[j] = ci; cv = tvv; ci = tii; } }
    }
    float* ov = tv + (tok * 16 + hp) * 16; int* oi = ti + (tok * 16 + hp) * 16;
#pragma unroll
    for (int j = 0; j < 16; ++j) { ov[j] = bv[j]; oi[j] = bi[j]; }
}
__global__ void __launch_bounds__(256) n_top2(const float* __restrict__ tv, const int* __restrict__ ti, const float* __restrict__ rstd2, int* __restrict__ ids, float* __restrict__ gates) {
    size_t gid = (size_t)blockIdx.x * 256 + threadIdx.x;
    const float* v0 = tv + gid * 32; const float* v1 = v0 + 16; const int* i0 = ti + gid * 32; const int* i1 = i0 + 16;
    const float rs = rstd2[gid >> 3];
    float av[16], bb[16];
#pragma unroll
    for (int i = 0; i < 16; ++i) { av[i] = v0[i]; bb[i] = v1[i]; }
    float bv[16]; int bi[16];
#pragma unroll
    for (int j = 0; j < 16; ++j) { bv[j] = -INFINITY; bi[j] = 0; }
#pragma unroll
    for (int i = 0; i < 16; ++i)
#pragma unroll
        for (int jj = 0; jj < 16; ++jj) {
            float cv = av[i] + bb[jj]; int ci = i * 16 + jj;
#pragma unroll
            for (int j = 0; j < 16; ++j) { if (cv > bv[j]) { float tvv = bv[j]; int tii = bi[j]; bv[j] = cv; bi[j] = ci; cv = tvv; ci = tii; } }
        }
    float mx = bv[0], sum = 0.f;
#pragma unroll
    for (int j = 0; j < 16; ++j) { bv[j] = expf((bv[j] - mx) * rs); sum += bv[j]; }
    float inv = 1.f / sum;
#pragma unroll
    for (int j = 0; j < 16; ++j) { int pi = bi[j] >> 4, pj = bi[j] & 15; ids[gid * 16 + j] = i0[pi] * 128 + i1[pj]; gates[gid * 16 + j] = bv[j] * inv; }
}
__global__ void __launch_bounds__(256) n_gather(float* __restrict__ x, const float* __restrict__ rstd2, const float* __restrict__ gn, const int* __restrict__ ids,
                                                const float* __restrict__ gates, const float* __restrict__ ut, const float* __restrict__ vt) {
    __shared__ float hs[1024];
    __shared__ float act[128];
    size_t tok = blockIdx.x; int tid = threadIdx.x, lane = tid & 63, w = tid >> 6;
    float r = rstd2[tok];
    float* xp = x + tok * D;
    for (int i = tid; i < D; i += 256) hs[i] = xp[i] * r * gn[i];
    __syncthreads();
    for (int k = w; k < 128; k += 4) {
        int id = ids[tok * 128 + k];
        const float* up = ut + (size_t)id * D;
        float s = 0.f;
        for (int i = lane; i < D; i += 64) s += hs[i] * up[i];
        s = wave_sum(s);
        if (lane == 0) act[k] = gelu_tanh(s) * gates[tok * 128 + k];
    }
    __syncthreads();
    float o[4] = {0.f, 0.f, 0.f, 0.f};
    for (int k = 0; k < 128; ++k) {
        int id = ids[tok * 128 + k];
        const float* vp = vt + (size_t)id * D;
        float av = act[k];
#pragma unroll
        for (int j = 0; j < 4; ++j) o[j] += av * vp[tid + j * 256];
    }
#pragma unroll
    for (int j = 0; j < 4; ++j) xp[tid + j * 256] += o[j];
}
__global__ void __launch_bounds__(512) n_finish(Args a, int lnext) {
    const int lane = threadIdx.x & 63, wv = blockIdx.x * 8 + (threadIdx.x >> 6), nw = gridDim.x * 8;
    for (int tok = wv; tok < T; tok += nw) {
        const float* p = a.out + (size_t)tok * D;
        const f32x4 a0 = *(const f32x4*)(p + 8 * lane), a1 = *(const f32x4*)(p + 8 * lane + 4), a2 = *(const f32x4*)(p + 512 + 8 * lane), a3 = *(const f32x4*)(p + 512 + 8 * lane + 4);
        const float xv[16] = {a0[0], a0[1], a0[2], a0[3], a1[0], a1[1], a1[2], a1[3], a2[0], a2[1], a2[2], a2[3], a3[0], a3[1], a3[2], a3[3]};
        finish_token(tok, xv, a.out, (bf16_t*)(a.ws + WS_XB), (float*)(a.ws + WS_RSTD), lnext < DEPTH ? (const float*)(a.ws + WS_WF) + (size_t)lnext * 4096 : nullptr,
                     a.in[2] + (lnext < DEPTH ? lnext * 4 : 0), (float*)(a.ws + WS_FLOG), lane);
    }
}
}
#ifndef HK_NEW_MASK
#define HK_NEW_MASK 0x3f
#endif
#ifndef HK_ONE_LAUNCH
#define HK_ONE_LAUNCH 1
#endif
extern "C" void kernel_launch(void* const* d_in, const int* in_sizes, int n_in, void* d_out, int out_size, void* d_ws, size_t ws_size, hipStream_t stream) {
    using namespace hk;
    (void)in_sizes; (void)n_in; (void)out_size; (void)ws_size;
    static int grid = 0;
    if (!grid) {
        int dev = 0, cus = 0, per_cu = 0;
        (void)hipGetDevice(&dev);
        (void)hipDeviceGetAttribute(&cus, hipDeviceAttributeMultiprocessorCount, dev);
        if (hipFuncSetAttribute((const void*)hk_mega, hipFuncAttributeMaxDynamicSharedMemorySize, LDS_BYTES) != hipSuccess) fprintf(stderr, "hipFuncSetAttribute failed\n");
        (void)hipOccupancyMaxActiveBlocksPerMultiprocessor(&per_cu, (const void*)hk_mega, NTHR, LDS_BYTES);
        if (per_cu < 1) fprintf(stderr, "occupancy query says %d blocks per CU\n", per_cu);
        grid = cus > 0 ? cus : 256;
    }
    Args a{};
    for (int i = 0; i < 29; ++i) a.in[i] = (const float*)d_in[i];
    a.out = (float*)d_out; a.ws = (unsigned char*)d_ws;
    (void)hipMemsetAsync(a.ws + WS_CTL, 0, WS_CTL_BYTES, stream);
    auto run = [&](int lo, int hi, int bar) { Args b = a; b.ph_lo = lo; b.ph_hi = hi; b.use_bar = bar; b.pad0 = 0; hipLaunchKernelGGL(hk_mega, dim3(grid), dim3(NTHR), LDS_BYTES, stream, b); };
#if HK_ONE_LAUNCH
    run(0, NPHASE, 1);
#else
    unsigned char* ws = a.ws;
    bf16_t* zb = (bf16_t*)(ws + WS_ZB); bf16_t* mix = (bf16_t*)(ws + WS_MIX); bf16_t* xb = (bf16_t*)(ws + WS_XB);
    float* su = (float*)(ws + WS_SU); float* cum = (float*)(ws + WS_CUM); float* tb = (float*)(ws + WS_TB);
    (void)hipFuncSetAttribute((const void*)nv::n_top1, hipFuncAttributeMaxDynamicSharedMemorySize, 65536);
    run(0, 1, 0); run(1, 2, 0);
    for (int l = 0; l < DEPTH; ++l) {
        const int pb = 2 + 6 * l;
        run(pb, pb + 1, 0);
        if (HK_NEW_MASK & 2) run(pb + 1, pb + 2, 0);
        if (HK_NEW_MASK & 4) run(pb + 2, pb + 3, 0);
        if (!(HK_NEW_MASK & 2)) {
            nv::n_fox<<<NB * 4 * S / 64, 64, 0, stream>>>(zb, cum, mix);
            nv::n_dil<<<NB * 4 * S / 64, 64, 0, stream>>>(zb, tb, mix);
            float* t0 = (float*)(ws + WS_DPART); float* t1 = (float*)(ws + WS_UT);
            nv::n_diff<0><<<NB * 4 * S / 64, 64, 0, stream>>>(zb, tb, t0);
            nv::n_diff<1><<<NB * 4 * S / 64, 64, 0, stream>>>(zb, tb, t1);
            const float lam_init = 0.8f - 0.6f * expf(-0.3f * l);
            nv::n_diff_fin<<<(T * 4) / 256, 256, 0, stream>>>(t0, t1, a.in[12] + l * 128, a.in[13] + l * 64, lam_init, mix);
            float* gbuf = (float*)(ws + WS_VT);
            nv::n_s5<<<NB * 16, 64, 0, stream>>>(su, a.in[15] + l * 1024, a.in[16] + l * 1024, a.in[17] + l * 16, a.in[18] + l * 16384, a.in[19] + l * 16384,
                                                  a.in[20] + l * 16384, a.in[21] + l * 16384, a.in[22] + l * 256, gbuf);
            nv::n_glu<<<T, 256, 0, stream>>>(gbuf, a.in[23] + l * 65536, a.in[24] + l * 256, mix);
        }
        if (HK_NEW_MASK & 8) run(pb + 3, pb + 4, 0);
        else nv::n_gemm<0><<<dim3(D / 64, T / 64), 256, 0, stream>>>(mix, nullptr, a.in[3] + (size_t)l * D * D, a.out, xb, T, D, D);
        if (HK_NEW_MASK & 16) run(pb + 4, pb + 5, 0);
        else nv::n_gemm<1><<<dim3(2048 / 64, T / 64), 256, 0, stream>>>(xb, a.in[5] + l * D, a.in[25] + (size_t)l * D * 2048, nullptr, zb, T, 2048, D);
        if (HK_NEW_MASK & 32) run(pb + 5, pb + 6, 0);
        else {
            float* rs2 = (float*)(ws + WS_DLSE); float* tv = (float*)(ws + WS_SU); int* ti = (int*)(ws + WS_MIX);
            int* ids = (int*)(ws + WS_DPART); float* gates = (float*)(ws + WS_DPART + (size_t)T * 128 * 4);
            nv::n_rstd<<<T / 4, 256, 0, stream>>>(a.out, rs2);
            nv::n_top1<<<dim3(T / 256, 16), 256, 65536, stream>>>(zb, a.in[26] + (size_t)l * 16 * 128 * 128, tv, ti);
            nv::n_top2<<<(T * 8) / 256, 256, 0, stream>>>(tv, ti, rs2, ids, gates);
            nv::n_gather<<<T, 256, 0, stream>>>(a.out, rs2, a.in[5] + l * D, ids, gates, a.in[27] + (size_t)l * NEXP * D, a.in[28] + (size_t)l * NEXP * D);
            Args b = a; b.ph_lo = 0; b.ph_hi = 0; b.use_bar = 0; b.pad0 = 0;
            nv::n_finish<<<grid, 512, 0, stream>>>(b, l + 1);
        }
    }
#endif
}
```

```cpp
#define HK_ONE_LAUNCH 1
#include <hip/hip_runtime.h>
#ifndef HK_NEW_MASK
#define HK_NEW_MASK 0x3f
#endif
#define HK_FOLD_KEYS (((HK_NEW_MASK) & 48) == 48)
#ifndef HK_PEER_SPLIT
#define HK_PEER_SPLIT HK_FOLD_KEYS
#endif
#include <cstdint>
#include <cstdio>
#include <cmath>

#define LAS3 __attribute__((address_space(3)))
typedef unsigned short bf16_t;
typedef short bf16x8 __attribute__((ext_vector_type(8)));
typedef float f32x4 __attribute__((ext_vector_type(4)));
typedef float f32x16 __attribute__((ext_vector_type(16)));
typedef unsigned u32x4 __attribute__((ext_vector_type(4)));
typedef unsigned u32x2 __attribute__((ext_vector_type(2)));

namespace hk {
constexpr int D = 1024, NB = 8, S = 8192, DEPTH = 4, T = NB * S;
constexpr int INW = 2564;
constexpr int ZP = 2304;
constexpr int ZC_FQ = 0, ZC_FK = 256, ZC_FV = 512, ZC_DQ = 768, ZC_DK = 1024, ZC_DV = 1280, ZC_CQ = 1536, ZC_CK = 1792, ZC_CV = 2048;
constexpr int NEXP = 16384;
constexpr float EPS = 1e-6f;
constexpr float LOG2E = 1.4426950408889634f;
constexpr int TBN = 2112;
constexpr int S5_TC = 64;
constexpr int S5_NCH = S / S5_TC;
constexpr int NTHR = 512;
constexpr int LDS_BYTES = 160 * 1024;
constexpr int LDS_CTL = LDS_BYTES - 256;

constexpr size_t al256(size_t x) { return (x + 255) & ~(size_t)255; }
constexpr size_t WS_CTL = 0;
constexpr size_t WS_CTL_BYTES = 65536;
constexpr size_t WS_XB = WS_CTL + WS_CTL_BYTES;
constexpr size_t WS_ZB = WS_XB + (size_t)T * D * 2;
constexpr size_t WS_SU = WS_ZB + (size_t)T * ZP * 2;
constexpr size_t WS_MIX = WS_SU + (size_t)T * 256 * 4;
constexpr size_t WS_DPART = WS_MIX + (size_t)T * D * 2;
constexpr size_t WS_DLSE = WS_DPART + (size_t)3 * T * 256 * 2;
constexpr size_t WS_SST = WS_DLSE + (size_t)3 * T * 4 * 4;
constexpr size_t WS_CUM = WS_SST + (size_t)NB * 16 * S5_NCH * 128 * 4;
constexpr size_t WS_FLOG = WS_CUM + (size_t)NB * 4 * S * 4;
constexpr size_t WS_RSTD = WS_FLOG + (size_t)NB * 4 * S * 4;
constexpr size_t WS_WIN = WS_RSTD + (size_t)T * 4;
constexpr size_t WS_WF = WS_WIN + (size_t)DEPTH * 2560 * 1024 * 2;
constexpr size_t WS_WOUT = WS_WF + (size_t)DEPTH * 4 * 1024 * 4;
constexpr size_t WS_WQ = WS_WOUT + (size_t)DEPTH * 1024 * 1024 * 2;
constexpr size_t WS_KEYS = WS_WQ + (size_t)DEPTH * 2048 * 1024 * 2;
constexpr size_t WS_GLU = WS_KEYS + (size_t)DEPTH * 16 * 128 * 128 * 2;
constexpr size_t WS_TB = WS_GLU + (size_t)DEPTH * 256 * 256 * 2;
constexpr size_t WS_UT = al256(WS_TB + (size_t)8 * TBN * 4);
constexpr size_t WS_VT = WS_UT + (size_t)NEXP * D * 2;
constexpr size_t WS_US = WS_VT + (size_t)NEXP * D * 2;
constexpr size_t WS_VS = WS_US + (size_t)NEXP * 4;
constexpr size_t WS_FOXT = WS_VS + (size_t)NEXP * 4;
constexpr size_t WS_S5B = WS_FOXT + 256;
constexpr size_t WS_S5A = WS_S5B + (size_t)DEPTH * 16 * 2 * 64 * 16 * 2;
constexpr size_t WS_END = WS_S5A + (size_t)DEPTH * 16 * 64 * 16;
constexpr size_t WS_NV_TV = WS_SU;
constexpr size_t WS_NV_IDS = WS_DPART;
constexpr size_t WS_CIDX = WS_DPART;
constexpr size_t WS_CQ = WS_CIDX + (size_t)T * 128 * 2;
constexpr size_t WS_CSC = WS_CQ + (size_t)T * 128;
static_assert(WS_END <= (size_t)1024 * 1024 * 1024, "workspace map exceeds 1 GiB");
constexpr int CTL_BAR = 0;
constexpr int CTL_Q = 4096;

struct Args {
    const float* in[29];
    float* out;
    unsigned char* ws;
    int ph_lo, ph_hi;
    int use_bar, pad0;
};

__device__ __forceinline__ float bf2f(bf16_t v) { return __uint_as_float((unsigned)v << 16); }
__device__ __forceinline__ bf16_t f2bf(float f) { unsigned u = __float_as_uint(f); u += 0x7fffu + ((u >> 16) & 1u); return (bf16_t)(u >> 16); }
__device__ __forceinline__ unsigned pk2(float lo, float hi) { return (unsigned)f2bf(lo) | ((unsigned)f2bf(hi) << 16); }
__device__ __forceinline__ float gelu_tanh(float x) {
    const float u = 0.7978845608028654f * (x + 0.044715f * x * x * x);
    return x / (1.f + __expf(-2.f * u));
}
__device__ __forceinline__ float log_sigmoid(float x) { return x >= 0.f ? -log1pf(expf(-x)) : x - log1pf(expf(x)); }
__device__ __forceinline__ int t5_bucket(int dist) {
    int n = dist < 0 ? 0 : dist;
    float nf = (float)(n < 16 ? 16 : n);
    int large = 16 + (int)(logf(nf / 16.f) / logf(128.f) * 16.f);
    large = large < 31 ? large : 31;
    return n < 16 ? n : large;
}
__device__ __forceinline__ float wave_sum(float v) {
#pragma unroll
    for (int o = 32; o > 0; o >>= 1) v += __shfl_xor(v, o);
    return v;
}
__device__ __forceinline__ float half_swap_max(float m) {
    auto rr = __builtin_amdgcn_permlane32_swap(__float_as_uint(m), __float_as_uint(m), false, false);
    return fmaxf(__uint_as_float(rr[0]), __uint_as_float(rr[1]));
}
__device__ __forceinline__ float half_swap_sum(float m) {
    auto rr = __builtin_amdgcn_permlane32_swap(__float_as_uint(m), __float_as_uint(m), false, false);
    return __uint_as_float(rr[0]) + __uint_as_float(rr[1]);
}
}
namespace pg8 {
#define PG8_LAS __attribute__((address_space(3)))
typedef unsigned short bf16_t;
typedef short bf16x8 __attribute__((ext_vector_type(8)));
typedef float f32x4 __attribute__((ext_vector_type(4)));
typedef unsigned u32x4 __attribute__((ext_vector_type(4)));
constexpr int BM = 256, BK = 64, HALF = 128, HTB = HALF * BK * 2  , STAGE_BYTES = 8 * HTB, NXCD = 8, WGM = 8;

__host__ __device__ __forceinline__ int lds_byte(int r, int c) { const int st = (r >> 4) * 2 + (c >> 5), rr = r & 15, cc = c & 31, ob = rr * 64 + cc * 2; return st * 1024 + (ob ^ (((ob >> 9) & 1) << 5)); }
__host__ __device__ __forceinline__ void stage_rc(int b, int& R, int& C) { const int st = b / 1024, sb = b % 1024, swz = sb ^ (((sb >> 9) & 1) << 5); R = (st >> 1) * 16 + swz / 64; C = (st & 1) * 32 + (swz % 64) / 2; }
__host__ __device__ __forceinline__ int perm32(int rho) { const int n = rho >> 4, i = rho & 15; return 8 * (i >> 2) + 4 * n + (i & 3); }

struct Unit { int pm, pn; };
struct Gemm { const bf16_t* A; const bf16_t* Bt; int M, N, K; };

struct StaticOrder {
    int nM, nN, nwg, G, c;
    __host__ __device__ void init(int M, int N, int G_, int c_) { nM = M / BM; nN = N / BM; nwg = nM * nN; G = G_; c = c_; }
    __host__ __device__ bool next(int i, Unit& u) const {
        const long L = (long)i * G + c; if (L >= nwg) return false;
        int wgid = (int)L; { const int q = nwg / NXCD, r = nwg % NXCD, xcd = wgid % NXCD, off = wgid / NXCD; wgid = (xcd < r ? xcd * (q + 1) : r * (q + 1) + (xcd - r) * q) + off; }
        const int nig = WGM * nN, gid = wgid / nig, fm = gid * WGM, gsz = (nM - fm) < WGM ? (nM - fm) : WGM;
        u.pm = fm + ((wgid % nig) % gsz); u.pn = (wgid % nig) / gsz; return true;
    }
    __device__ __forceinline__ void a_ready(const Unit&) const {}
    __device__ __forceinline__ void done(const Unit&) const {}
};
typedef float f32x2e_t __attribute__((ext_vector_type(2))); typedef __bf16 bf16x2e_t __attribute__((ext_vector_type(2)));
__device__ __forceinline__ unsigned cvt_pk_bf16(float lo, float hi) { const f32x2e_t v = {lo, hi}; const bf16x2e_t b = __builtin_convertvector(v, bf16x2e_t); return __builtin_bit_cast(unsigned, b); }

struct EpiIn {
    static constexpr bool PERM = true, AFTER_DRAIN = false;
    bf16_t* zb; float* su32; const float* rstd;
    const float* g_fq; const float* g_fk; const float* g_dq; const float* g_dk; const float* g_cq; const float* g_ck;
    __device__ __forceinline__ void operator()(const f32x4 (&acc)[2][2][4][2], const Unit& u, int wr, int wc, int fr, int fq) const {
        const int pn = u.pn;
        const int mode = (pn == 0 || pn == 1 || pn == 3 || pn == 4) ? 1 : ((pn == 6 || pn == 7) ? 2 : (pn == 9 ? 3 : 0));
        const float* gp = pn == 0 ? g_fq : pn == 1 ? g_fk : pn == 3 ? g_dq : pn == 4 ? g_dk : pn == 6 ? g_cq : g_ck;
        const float qs = (pn == 0 || pn == 3) ? 0.125f * 1.4426950408889634f : (pn == 6 ? 0.17677669529663687f * 1.4426950408889634f : 1.f);
        f32x4 gv[2][2];
#pragma unroll
        for (int bj = 0; bj < 2; ++bj)
#pragma unroll
            for (int n = 0; n < 2; ++n) {
                if (mode == 1) gv[bj][n] = *(const f32x4*)(gp + 32 * bj + 8 * fq + 4 * n) * qs;
                else if (mode == 2) gv[bj][n] = *(const f32x4*)(gp + 8 * fq + 4 * n) * qs;
                else gv[bj][n] = (f32x4){1.f, 1.f, 1.f, 1.f};
            }
#pragma unroll
        for (int ai = 0; ai < 2; ++ai)
#pragma unroll
            for (int m = 0; m < 4; ++m) {
                const int row = u.pm * BM + ai * HALF + wr * 64 + m * 16 + fr;
                const float rs = rstd[row];
                f32x4 v[2][2];
                float ss[2];
#pragma unroll
                for (int bj = 0; bj < 2; ++bj) {
                    float s = 0.f;
#pragma unroll
                    for (int n = 0; n < 2; ++n) { v[bj][n] = acc[ai][bj][m][n] * rs; const f32x4 x = v[bj][n]; s += (x[0] * x[0] + x[1] * x[1]) + (x[2] * x[2] + x[3] * x[3]); }
                    ss[bj] = s;
                }
                if (mode == 1 || mode == 2) {
                    float s0 = ss[0], s1 = ss[1];
                    s0 += __shfl_xor(s0, 16); s0 += __shfl_xor(s0, 32); s1 += __shfl_xor(s1, 16); s1 += __shfl_xor(s1, 32);
                    float r0, r1;
                    if (mode == 1) { r0 = __builtin_amdgcn_rsqf((s0 + s1) * (1.f / 64.f) + 1e-6f); r1 = r0; }
                    else { r0 = __builtin_amdgcn_rsqf(s0 * (1.f / 32.f) + 1e-6f); r1 = __builtin_amdgcn_rsqf(s1 * (1.f / 32.f) + 1e-6f); }
#pragma unroll
                    for (int n = 0; n < 2; ++n) { v[0][n] = v[0][n] * r0 * gv[0][n]; v[1][n] = v[1][n] * r1 * gv[1][n]; }
                }
                if (mode == 3) {
                    bf16_t* op = (bf16_t*)su32 + (size_t)row * 256 + 64 * wc + 8 * fq;
#pragma unroll
                    for (int bj = 0; bj < 2; ++bj) { u32x4 w; w.x = cvt_pk_bf16(v[bj][0][0], v[bj][0][1]); w.y = cvt_pk_bf16(v[bj][0][2], v[bj][0][3]); w.z = cvt_pk_bf16(v[bj][1][0], v[bj][1][1]); w.w = cvt_pk_bf16(v[bj][1][2], v[bj][1][3]);
                        *(u32x4*)(op + 32 * bj) = w; }
                } else {
                    bf16_t* op = zb + (size_t)row * 2304 + pn * 256 + 64 * wc + 8 * fq;
#pragma unroll
                    for (int bj = 0; bj < 2; ++bj) { u32x4 w; w.x = cvt_pk_bf16(v[bj][0][0], v[bj][0][1]); w.y = cvt_pk_bf16(v[bj][0][2], v[bj][0][3]); w.z = cvt_pk_bf16(v[bj][1][0], v[bj][1][1]); w.w = cvt_pk_bf16(v[bj][1][2], v[bj][1][3]);
                        *(u32x4*)(op + 32 * bj) = w; }
                }
            }
    }
};
struct EpiOut {
    static constexpr bool PERM = true, AFTER_DRAIN = false;
    bf16_t* xb;
    __device__ __forceinline__ void operator()(const f32x4 (&acc)[2][2][4][2], const Unit& u, int wr, int wc, int fr, int fq) const {
#pragma unroll
        for (int ai = 0; ai < 2; ++ai)
#pragma unroll
            for (int m = 0; m < 4; ++m) {
                const int row = u.pm * BM + ai * HALF + wr * 64 + m * 16 + fr;
#pragma unroll
                for (int bj = 0; bj < 2; ++bj) {
                    const size_t off = (size_t)row * 1024 + u.pn * BM + bj * HALF + wc * 32 + 8 * fq;
                    const u32x4 o = *(const u32x4*)(xb + off);
                    const f32x4 a0 = acc[ai][bj][m][0], a1 = acc[ai][bj][m][1];
                    u32x4 w;
                    w.x = cvt_pk_bf16(__uint_as_float(o.x << 16) + a0[0], __uint_as_float(o.x & 0xffff0000u) + a0[1]);
                    w.y = cvt_pk_bf16(__uint_as_float(o.y << 16) + a0[2], __uint_as_float(o.y & 0xffff0000u) + a0[3]);
                    w.z = cvt_pk_bf16(__uint_as_float(o.z << 16) + a1[0], __uint_as_float(o.z & 0xffff0000u) + a1[1]);
                    w.w = cvt_pk_bf16(__uint_as_float(o.w << 16) + a1[2], __uint_as_float(o.w & 0xffff0000u) + a1[3]);
                    *(u32x4*)(xb + off) = w;
                }
            }
    }
};
struct EpiPlain {
    static constexpr bool PERM = true, AFTER_DRAIN = false;
    bf16_t* O; int ldc;
    __device__ __forceinline__ void operator()(const f32x4 (&acc)[2][2][4][2], const Unit& u, int wr, int wc, int fr, int fq) const {
#pragma unroll
        for (int ai = 0; ai < 2; ++ai)
#pragma unroll
            for (int m = 0; m < 4; ++m) {
                const int row = u.pm * BM + ai * HALF + wr * 64 + m * 16 + fr;
#pragma unroll
                for (int bj = 0; bj < 2; ++bj) {
                    const size_t off = (size_t)row * ldc + u.pn * BM + bj * HALF + wc * 32 + 8 * fq;
                    const f32x4 a = acc[ai][bj][m][0], b = acc[ai][bj][m][1];
                    u32x4 w; w.x = cvt_pk_bf16(a[0], a[1]); w.y = cvt_pk_bf16(a[2], a[3]); w.z = cvt_pk_bf16(b[0], b[1]); w.w = cvt_pk_bf16(b[2], b[3]);
                    *(u32x4*)(O + off) = w;
                }
            }
    }
};
typedef _Float16 f16x2e_t __attribute__((ext_vector_type(2)));
__device__ __forceinline__ unsigned cvt_pk_f16(float lo, float hi) { const f32x2e_t v = {lo, hi}; const f16x2e_t b = __builtin_convertvector(v, f16x2e_t); return __builtin_bit_cast(unsigned, b); }
struct EpiF16 {
    static constexpr bool PERM = true, AFTER_DRAIN = false;
    bf16_t* O; int ldc;
    __device__ __forceinline__ void operator()(const f32x4 (&acc)[2][2][4][2], const Unit& u, int wr, int wc, int fr, int fq) const {
#pragma unroll
        for (int ai = 0; ai < 2; ++ai)
#pragma unroll
            for (int m = 0; m < 4; ++m) {
                const int row = u.pm * BM + ai * HALF + wr * 64 + m * 16 + fr;
#pragma unroll
                for (int bj = 0; bj < 2; ++bj) {
                    const size_t off = (size_t)row * ldc + u.pn * BM + bj * HALF + wc * 32 + 8 * fq;
                    const f32x4 a = acc[ai][bj][m][0], b = acc[ai][bj][m][1];
                    u32x4 w; w.x = cvt_pk_f16(a[0], a[1]); w.y = cvt_pk_f16(a[2], a[3]); w.z = cvt_pk_f16(b[0], b[1]); w.w = cvt_pk_f16(b[2], b[3]);
                    *(u32x4*)(O + off) = w;
                }
            }
    }
};
template <class Epi, class Sched, bool ALIGN_EPI = false, bool SP2 = false>
__device__ __forceinline__ void gemm_phase(PG8_LAS unsigned char* lds, const Gemm g, const Sched& S, const Epi& E) {
    const int tid = threadIdx.x, wid = __builtin_amdgcn_readfirstlane(tid >> 6), lane = tid & 63, wr = wid >> 2, wc = wid & 3, fr = lane & 15, fq = lane >> 4;
    const int K = g.K, nt = K / BK;
    unsigned voffA[2], voffB[2];
#pragma unroll
    for (int i = 0; i < 2; ++i) { int R, C; stage_rc(tid * 16 + i * 8192, R, C); const int Rb = Epi::PERM ? ((R & ~31) + perm32(R & 31)) : R;
        voffA[i] = (unsigned)(R * K + C) * 2u; voffB[i] = (unsigned)(Rb * K + C) * 2u; }
    const size_t kstep = (size_t)(BK * 2);
    const size_t hstep = (size_t)HALF * K * 2;
    const size_t tstep = 2 * hstep;
    const unsigned ldsw = (unsigned)wid * 1024u;
    const int aoff = lds_byte(wr * 64 + fr, fq * 8), boff = lds_byte(wc * 32 + fr, fq * 8);
#define PG8_SA(b, h) (((b) * 2 + (h)) * HTB)
#define PG8_SB(b, h) ((4 + (b) * 2 + (h)) * HTB)
#define PG8_STAGE(bufoff, gbase, voff) do { _Pragma("unroll") for (int _i = 0; _i < 2; ++_i) \
        __builtin_amdgcn_global_load_lds((const unsigned*)((const char*)(gbase) + (voff)[_i]), (PG8_LAS unsigned*)(lds + (bufoff) + ldsw + _i * 8192), 16, 0, 0); } while (0)
#define PG8_LDA(dst, b, h) do { _Pragma("unroll") for (int m = 0; m < 4; ++m) _Pragma("unroll") for (int k = 0; k < 2; ++k) dst[m][k] = *(const PG8_LAS bf16x8*)(lds + PG8_SA(b, h) + aoff + m * 2048 + k * 1024); } while (0)
#define PG8_LDB(dst, b, h) do { _Pragma("unroll") for (int n = 0; n < 2; ++n) _Pragma("unroll") for (int k = 0; k < 2; ++k) dst[n][k] = *(const PG8_LAS bf16x8*)(lds + PG8_SB(b, h) + boff + n * 2048 + k * 1024); } while (0)
#define PG8_MMA(ai, bj, At, Bt) do { __builtin_amdgcn_s_setprio(1); _Pragma("unroll") for (int m = 0; m < 4; ++m) _Pragma("unroll") for (int n = 0; n < 2; ++n) _Pragma("unroll") for (int k = 0; k < 2; ++k) \
        acc[ai][bj][m][n] = __builtin_amdgcn_mfma_f32_16x16x32_bf16(Bt[n][k], At[m][k], acc[ai][bj][m][n], 0, 0, 0); __builtin_amdgcn_s_setprio(0); } while (0)
#define PG8_WAIT_V(n) asm volatile("s_waitcnt vmcnt(" #n ")" ::: "memory")
#define PG8_WAIT_L(n) asm volatile("s_waitcnt lgkmcnt(" #n ")" ::: "memory")
#define PG8_BAR __builtin_amdgcn_s_barrier()
#define PG8_SCHED __builtin_amdgcn_sched_barrier(0)
    Unit cur, nxt; int ui = 0;
    if (!S.next(0, cur)) return;
    f32x4 acc[2][2][4][2];
#pragma unroll
    for (int a = 0; a < 2; ++a)
#pragma unroll
        for (int b = 0; b < 2; ++b)
#pragma unroll
            for (int m = 0; m < 4; ++m)
#pragma unroll
                for (int n = 0; n < 2; ++n) acc[a][b][m][n] = (f32x4){0.f, 0.f, 0.f, 0.f};
    bf16x8 At[4][2], B0[2][2], B1[2][2];
    const char* cA = (const char*)g.A + (size_t)cur.pm * tstep; const char* cB = (const char*)g.Bt + (size_t)cur.pn * tstep;
    S.a_ready(cur);
    if constexpr (SP2) {
        PG8_STAGE(PG8_SB(0, 0), cB, voffB); PG8_STAGE(PG8_SB(0, 1), cB + hstep, voffB); PG8_STAGE(PG8_SA(0, 0), cA, voffA); PG8_STAGE(PG8_SA(0, 1), cA + hstep, voffA);
        if (wr == 1) PG8_BAR;
        PG8_WAIT_V(2); PG8_BAR;
        PG8_STAGE(PG8_SB(1, 0), cB + kstep, voffB); PG8_STAGE(PG8_SA(1, 0), cA + kstep, voffA); PG8_STAGE(PG8_SB(1, 1), cB + hstep + kstep, voffB);
        PG8_WAIT_V(6); PG8_BAR;
    } else {
        PG8_STAGE(PG8_SB(0, 0), cB, voffB); PG8_STAGE(PG8_SA(0, 0), cA, voffA); PG8_STAGE(PG8_SB(0, 1), cB + hstep, voffB); PG8_STAGE(PG8_SA(0, 1), cA + hstep, voffA);
        if (wr == 1) PG8_BAR;
        PG8_WAIT_V(4); PG8_BAR;
        PG8_STAGE(PG8_SB(1, 0), cB + kstep, voffB); PG8_STAGE(PG8_SA(1, 0), cA + kstep, voffA); PG8_STAGE(PG8_SB(1, 1), cB + hstep + kstep, voffB);
        PG8_WAIT_V(6); PG8_BAR;
    }
    for (;;) {
        const bool has_next = S.next(ui + 1, nxt);
        const char* nA = has_next ? (const char*)g.A + (size_t)nxt.pm * tstep : cA; const char* nB = has_next ? (const char*)g.Bt + (size_t)nxt.pn * tstep : cB;
        for (int t = 0; t < nt; t += 2) {
            const bool last = (t == nt - 2);
            const char* a1 = cA + (size_t)(t + 1) * kstep;
            const char* a2 = last ? nA : cA + (size_t)(t + 2) * kstep; const char* b2 = last ? nB : cB + (size_t)(t + 2) * kstep;
            const char* a3 = a2 + kstep; const char* b3 = b2 + kstep;
            if (last && has_next) S.a_ready(nxt);
            if constexpr (SP2) {
            PG8_LDB(B0, 0, 0); PG8_LDB(B1, 0, 1); PG8_SCHED; PG8_LDA(At, 0, 0); PG8_STAGE(PG8_SA(1, 1), a1 + hstep, voffA);
            PG8_WAIT_V(8); PG8_WAIT_L(0); PG8_BAR; PG8_MMA(0, 0, At, B0); PG8_MMA(0, 1, At, B1); PG8_BAR; PG8_SCHED;
            PG8_LDA(At, 0, 1); PG8_STAGE(PG8_SB(0, 0), b2, voffB); PG8_STAGE(PG8_SB(0, 1), b2 + hstep, voffB); PG8_STAGE(PG8_SA(0, 0), a2, voffA);
            PG8_WAIT_V(8); PG8_WAIT_L(0); PG8_BAR; PG8_MMA(1, 0, At, B0); PG8_MMA(1, 1, At, B1); PG8_BAR; PG8_SCHED;
            PG8_LDB(B0, 1, 0); PG8_LDB(B1, 1, 1); PG8_SCHED; PG8_LDA(At, 1, 0); PG8_STAGE(PG8_SA(0, 1), a2 + hstep, voffA);
            PG8_WAIT_V(8); PG8_WAIT_L(0); PG8_BAR; PG8_MMA(0, 0, At, B0); PG8_MMA(0, 1, At, B1); PG8_BAR; PG8_SCHED;
            PG8_LDA(At, 1, 1); PG8_STAGE(PG8_SB(1, 0), b3, voffB); PG8_STAGE(PG8_SB(1, 1), b3 + hstep, voffB); PG8_STAGE(PG8_SA(1, 0), a3, voffA);
            PG8_WAIT_V(8); PG8_WAIT_L(0); PG8_BAR; PG8_MMA(1, 0, At, B0); PG8_MMA(1, 1, At, B1); PG8_BAR; PG8_SCHED;
            } else {
            PG8_LDB(B0, 0, 0); PG8_SCHED; PG8_LDA(At, 0, 0); PG8_STAGE(PG8_SA(1, 1), a1 + hstep, voffA);
            PG8_WAIT_L(8); PG8_BAR; PG8_WAIT_L(0); PG8_MMA(0, 0, At, B0); PG8_BAR; PG8_SCHED;
            PG8_LDB(B1, 0, 1); PG8_STAGE(PG8_SB(0, 0), b2, voffB);
            PG8_BAR; PG8_WAIT_L(0); PG8_MMA(0, 1, At, B1); PG8_BAR;
            PG8_LDA(At, 0, 1); PG8_STAGE(PG8_SA(0, 0), a2, voffA);
            PG8_BAR; PG8_WAIT_L(0); PG8_MMA(1, 0, At, B0); PG8_BAR; PG8_SCHED;
            PG8_STAGE(PG8_SB(0, 1), b2 + hstep, voffB);
            PG8_WAIT_V(6); PG8_BAR; PG8_MMA(1, 1, At, B1); PG8_BAR;
            PG8_LDB(B0, 1, 0); PG8_SCHED; PG8_LDA(At, 1, 0); PG8_STAGE(PG8_SA(0, 1), a2 + hstep, voffA);
            PG8_WAIT_L(8); PG8_BAR; PG8_WAIT_L(0); PG8_MMA(0, 0, At, B0); PG8_BAR; PG8_SCHED;
            PG8_LDB(B1, 1, 1); PG8_STAGE(PG8_SB(1, 0), b3, voffB);
            PG8_BAR; PG8_WAIT_L(0); PG8_MMA(0, 1, At, B1); PG8_BAR;
            PG8_LDA(At, 1, 1); PG8_STAGE(PG8_SA(1, 0), a3, voffA);
            PG8_BAR; PG8_WAIT_L(0); PG8_MMA(1, 0, At, B0); PG8_BAR; PG8_SCHED;
            PG8_STAGE(PG8_SB(1, 1), b3 + hstep, voffB);
            PG8_WAIT_V(6); PG8_BAR; PG8_MMA(1, 1, At, B1); PG8_BAR;
            }
        }
        if constexpr (ALIGN_EPI) { if (wr == 0) PG8_BAR; }
        if constexpr (!Epi::AFTER_DRAIN) { E(acc, cur, wr, wc, fr, fq); S.done(cur); }
        if (!has_next) break;
#pragma unroll
        for (int a = 0; a < 2; ++a)
#pragma unroll
            for (int b = 0; b < 2; ++b)
#pragma unroll
                for (int m = 0; m < 4; ++m)
#pragma unroll
                    for (int n = 0; n < 2; ++n) acc[a][b][m][n] = (f32x4){0.f, 0.f, 0.f, 0.f};
        cur = nxt; cA = nA; cB = nB; ++ui;
        if constexpr (ALIGN_EPI) { if (wr == 1) PG8_BAR; }
    }
    PG8_WAIT_V(0);
    if constexpr (!ALIGN_EPI) { if (wr == 0) PG8_BAR; }
    PG8_BAR;
    if constexpr (Epi::AFTER_DRAIN) { E.fused(acc, cur, wr, wc, fr, fq, lds, wid, lane); S.done(cur); }
#undef PG8_SA
#undef PG8_SB
#undef PG8_STAGE
#undef PG8_LDA
#undef PG8_LDB
#undef PG8_MMA
#undef PG8_WAIT_V
#undef PG8_WAIT_L
#undef PG8_BAR
#undef PG8_SCHED
}
}
#define XB_TMO      128
#define XB_XCNT(j)  (256  + 64 * (j))
#define XB_XSUB(j)  (1280 + 64 * (j))
#define XB_XGEN(j)  (2304 + 64 * (j))
#define XB_TOP      3328
#define XB_TOPGEN   3392
#define XCD_BAR_WORDS 3456
#define XB_SPIN_CAP (1u << 18)
#define LAS __attribute__((address_space(3)))

__device__ __forceinline__ unsigned xb_ld(unsigned* p)              { return __hip_atomic_load(p, __ATOMIC_RELAXED, __HIP_MEMORY_SCOPE_AGENT); }
__device__ __forceinline__ unsigned xb_add(unsigned* p, unsigned v) { return __hip_atomic_fetch_add(p, v, __ATOMIC_RELAXED, __HIP_MEMORY_SCOPE_AGENT); }
__device__ __forceinline__ unsigned xb_xcc_id() { return (unsigned)__builtin_amdgcn_s_getreg((3 << 11) | 20) & 0xFu; }
#define XB_SPIN(cond, bar) do { unsigned _sp = 0; while (cond) { __builtin_amdgcn_s_sleep(1); \
    if ((++_sp & 255u) == 0u) { if (xb_ld(&(bar)[XB_TMO])) break; if (_sp > XB_SPIN_CAP) { atomicAdd(&(bar)[XB_TMO], 1u); break; } } } } while (0)

struct XcdBarrier {
    unsigned* bar; unsigned x;
    volatile LAS unsigned* st;
};

__device__ __forceinline__ XcdBarrier xcd_barrier_post(unsigned* bar, volatile LAS unsigned* st) {
    XcdBarrier b; b.bar = bar; b.x = xb_xcc_id(); b.st = st;
    if (threadIdx.x == 0) (void)xb_add(&bar[XB_XCNT(b.x)], 1u);
    return b;
}
__device__ __forceinline__ void xcd_barrier_complete(unsigned* bar, unsigned x, unsigned& nloc, unsigned& nx) {
    const unsigned G = gridDim.x * gridDim.y * gridDim.z;
    unsigned sum, cnt, mine, sp = 0u;
    for (;;) {
        sum = 0u; cnt = 0u; mine = 0u;
#pragma unroll
        for (unsigned j = 0; j < 16; ++j) { const unsigned c = xb_ld(&bar[XB_XCNT(j)]); sum += c; cnt += (c > 0u) ? 1u : 0u; mine = (j == x) ? c : mine; }
        if (sum == G) break;
        __builtin_amdgcn_s_sleep(1);
        if ((++sp & 255u) == 0u) { if (xb_ld(&bar[XB_TMO])) break; if (sp > XB_SPIN_CAP) { atomicAdd(&bar[XB_TMO], 1u); break; } }
    }
    nloc = mine > 0u ? mine : 1u; nx = cnt > 0u ? cnt : 1u;
}

__device__ __forceinline__ void xcd_barrier(const XcdBarrier& b) {
    asm volatile("s_waitcnt vmcnt(0)" ::: "memory");
    __syncthreads();
    if (threadIdx.x == 0) {
        unsigned* bar = b.bar;
        __builtin_amdgcn_s_waitcnt(0);
        unsigned nloc = b.st[0], nx = b.st[1];
        if (nloc == 0u) { xcd_barrier_complete(bar, b.x, nloc, nx); b.st[0] = nloc; b.st[1] = nx; }
        const unsigned old = xb_add(&bar[XB_XSUB(b.x)], 1u);
        const unsigned gen = old / nloc;
        if (old + 1u == (gen + 1u) * nloc) {
            __builtin_amdgcn_fence(__ATOMIC_RELEASE, "agent");
            asm volatile("s_waitcnt vmcnt(0)" ::: "memory");
            const unsigned og = xb_add(&bar[XB_TOP], 1u);
            const unsigned tg = og / nx;
            if (og + 1u == (tg + 1u) * nx) xb_add(&bar[XB_TOPGEN], 1u);
            else XB_SPIN(xb_ld(&bar[XB_TOPGEN]) == tg, bar);
            __builtin_amdgcn_fence(__ATOMIC_ACQUIRE, "agent");
            xb_add(&bar[XB_XGEN(b.x)], 1u);
            asm volatile("s_waitcnt vmcnt(0)" ::: "memory");
        } else {
            XB_SPIN(xb_ld(&bar[XB_XGEN(b.x)]) == gen, bar);
            __builtin_amdgcn_fence(__ATOMIC_ACQUIRE, "agent");
            asm volatile("s_waitcnt vmcnt(0)" ::: "memory");
        }
    }
    __syncthreads();
}
namespace hk {
__device__ __forceinline__ int inproj_src_col(int np) {
    const int pn = np >> 8, p = np & 255, bj = p >> 7, wc = (p >> 5) & 3, i = p & 31;
    const int nl = pn * 256 + 64 * wc + 32 * bj + i;
    return nl < 768 ? nl : nl + 4;
}
template <bool INMAP>
__device__ __forceinline__ void tr_tile(const float* __restrict__ src, int ld, const float* __restrict__ g, bf16_t* __restrict__ dst, int K, int k0, int n0, float* lds) {
    const int tid = threadIdx.x;
#pragma unroll
    for (int i = 0; i < 8; ++i) {
        const int idx = tid + 512 * i, kk = idx >> 6, nn = idx & 63;
        const int col = INMAP ? inproj_src_col(n0 + nn) : (n0 + nn);
        float v = src[(size_t)(k0 + kk) * ld + col];
        if (g) v *= g[k0 + kk];
        lds[nn * 65 + kk] = v;
    }
    __syncthreads();
#pragma unroll
    for (int i = 0; i < 8; ++i) {
        const int idx = tid + 512 * i, nn = idx >> 6, kk = idx & 63;
        dst[(size_t)(n0 + nn) * K + k0 + kk] = f2bf(lds[nn * 65 + kk]);
    }
    __syncthreads();
}
__device__ __forceinline__ void fold_keys_tile(const float* __restrict__ wq, const float* __restrict__ keys, const float* __restrict__ g, bf16_t* __restrict__ dst, int hp, int k0, float* lds) {
    const int tid = threadIdx.x;
    float* ws_ = lds; float* ks_ = lds + 64 * 129;
    for (int i = tid; i < 64 * 128; i += NTHR) { const int kk = i >> 7, d = i & 127; ws_[kk * 129 + d] = wq[(size_t)(k0 + kk) * 2048 + hp * 128 + d]; }
    for (int i = tid; i < 128 * 128; i += NTHR) { const int ky = i >> 7, d = i & 127; ks_[ky * 129 + d] = keys[(size_t)hp * 128 * 128 + i]; }
    __syncthreads();
    const int key = tid & 127, kg = tid >> 7;
    float acc[16];
#pragma unroll
    for (int i = 0; i < 16; ++i) acc[i] = 0.f;
    for (int d = 0; d < 128; ++d) { const float kv = ks_[key * 129 + d];
#pragma unroll
        for (int i = 0; i < 16; ++i) acc[i] += ws_[(kg * 16 + i) * 129 + d] * kv; }
    u32x4 o0, o1; const float* gp = g + k0 + kg * 16;
    o0.x = pk2(acc[0] * gp[0], acc[1] * gp[1]); o0.y = pk2(acc[2] * gp[2], acc[3] * gp[3]); o0.z = pk2(acc[4] * gp[4], acc[5] * gp[5]); o0.w = pk2(acc[6] * gp[6], acc[7] * gp[7]);
    o1.x = pk2(acc[8] * gp[8], acc[9] * gp[9]); o1.y = pk2(acc[10] * gp[10], acc[11] * gp[11]); o1.z = pk2(acc[12] * gp[12], acc[13] * gp[13]); o1.w = pk2(acc[14] * gp[14], acc[15] * gp[15]);
    bf16_t* op = dst + (size_t)(hp * 128 + key) * 1024 + k0 + kg * 16;
    *(u32x4*)op = o0; *(u32x4*)(op + 8) = o1;
    __syncthreads();
}
__device__ __forceinline__ void phase_weights(const Args& a, unsigned char* ldsb) {
    float* lds = (float*)ldsb;
    const int G = gridDim.x, bid = blockIdx.x, tid = threadIdx.x;
    const float* w_in = a.in[1]; const float* w_out = a.in[3]; const float* norm_mix = a.in[4]; const float* norm_ffn = a.in[5];
    const float* glu_w = a.in[23]; const float* wq = a.in[25]; const float* keys = a.in[26]; const float* relb = a.in[14];
    bf16_t* WIN = (bf16_t*)(a.ws + WS_WIN); bf16_t* WOUT = (bf16_t*)(a.ws + WS_WOUT); bf16_t* WQ = (bf16_t*)(a.ws + WS_WQ); bf16_t* GLU = (bf16_t*)(a.ws + WS_GLU);
    for (int u = bid; u < DEPTH * 1424; u += G) {
        const int l = u / 1424; int r = u % 1424;
        if (r < 640) { const int nt = r >> 4, kt = r & 15; tr_tile<true>(w_in + (size_t)l * D * INW, INW, norm_mix + l * D, WIN + (size_t)l * 2560 * 1024, 1024, kt * 64, nt * 64, lds); }
        else if (r < 896) { r -= 640; const int nt = r >> 4, kt = r & 15; tr_tile<false>(w_out + (size_t)l * D * D, D, nullptr, WOUT + (size_t)l * 1024 * 1024, 1024, kt * 64, nt * 64, lds); }
        else if (r < 1408) { r -= 896;
#if HK_FOLD_KEYS
            if (r < 256) fold_keys_tile(wq + (size_t)l * D * 2048, keys + (size_t)l * 16 * 128 * 128, norm_ffn + l * D, WQ + (size_t)l * 2048 * 1024, r >> 4, (r & 15) * 64, lds);
#else
            const int nt = r >> 4, kt = r & 15; tr_tile<false>(wq + (size_t)l * D * 2048, 2048, norm_ffn + l * D, WQ + (size_t)l * 2048 * 1024, 1024, kt * 64, nt * 64, lds);
#endif
        }
        else { r -= 1408; const int nt = r >> 2, kt = r & 3; tr_tile<false>(glu_w + (size_t)l * 65536, 256, nullptr, GLU + (size_t)l * 65536, 256, kt * 64, nt * 64, lds); }
    }
    const int gt = bid * NTHR + tid, gn = G * NTHR;
    float* WF = (float*)(a.ws + WS_WF);
    for (int i = gt; i < DEPTH * 4 * 1024; i += gn) { const int l = i >> 12, h = (i >> 10) & 3, k = i & 1023; WF[i] = norm_mix[l * D + k] * w_in[((size_t)l * D + k) * INW + 768 + h]; }
    bf16_t* KB = (bf16_t*)(a.ws + WS_KEYS);
    for (int i = gt; i < DEPTH * 16 * 128 * 128; i += gn) KB[i] = f2bf(keys[i]);
    if (gt < DEPTH) { float gq = 0.f, gk = 0.f; for (int i = 0; i < 64; ++i) { gq = fmaxf(gq, fabsf(a.in[6][gt * 64 + i])); gk = fmaxf(gk, fabsf(a.in[7][gt * 64 + i])); }
        ((float*)(a.ws + WS_FOXT))[gt] = 2.f * 1.02f * 0.125f * LOG2E * 64.f * gq * gk + 40.f; }
#ifndef HK_T_NOS5TAB
    for (int i = gt; i < DEPTH * 16 * 64; i += gn) {
        const int lg = i >> 6, st = i & 63;
        const float dt = expf(a.in[17][lg]);
        const float ar = a.in[15][lg * 64 + st], ai = a.in[16][lg * 64 + st];
        const float dtar = dt * ar, dtai = dt * ai, mag = expf(dtar);
        const float abr = mag * cosf(dtai), abi = mag * sinf(dtai);
        const float den = ar * ar + ai * ai, nr = abr - 1.f, ni = abi;
        const float cr = (nr * ar + ni * ai) / den, ci = (ni * ar - nr * ai) / den;
        const float mg = expf(64.f * dtar);
        ((f32x4*)(a.ws + WS_S5A))[i] = (f32x4){abr, abi, mg * cosf(64.f * dtai), mg * sinf(64.f * dtai)};
        const float* brp = a.in[18] + ((size_t)lg * 64 + st) * 16; const float* bip = a.in[19] + ((size_t)lg * 64 + st) * 16;
        bf16_t* ore = (bf16_t*)(a.ws + WS_S5B) + ((size_t)(lg * 2) * 64 + st) * 16; bf16_t* oim = ore + 64 * 16;
        for (int c = 0; c < 16; ++c) { const float br = brp[c], bi = bip[c]; ore[c] = f2bf(cr * br - ci * bi); oim[c] = f2bf(cr * bi + ci * br); }
    }
#endif
    float* TB = (float*)(a.ws + WS_TB);
    for (int i = gt; i < 8 * TBN; i += gn) { const int hh = i / TBN, d = i % TBN; TB[i] = relb[t5_bucket(d) * 8 + hh] * LOG2E; }
}

__device__ __forceinline__ void load_row16(const float* __restrict__ p, int lane, float (&xv)[16]) {
#pragma unroll
    for (int j = 0; j < 4; ++j) { const f32x4 t = *(const f32x4*)(p + 16 * lane + 4 * j); xv[4 * j] = t[0]; xv[4 * j + 1] = t[1]; xv[4 * j + 2] = t[2]; xv[4 * j + 3] = t[3]; }
}
__device__ __forceinline__ void load_row16_bf(const bf16_t* __restrict__ p, int slot, float (&xv)[16]) {
    const u32x4 a = *(const u32x4*)(p + 16 * slot), b = *(const u32x4*)(p + 16 * slot + 8);
#pragma unroll
    for (int j = 0; j < 4; ++j) { xv[2 * j] = __uint_as_float(a[j] << 16); xv[2 * j + 1] = __uint_as_float(a[j] & 0xffff0000u); xv[8 + 2 * j] = __uint_as_float(b[j] << 16); xv[8 + 2 * j + 1] = __uint_as_float(b[j] & 0xffff0000u); }
}
__device__ __forceinline__ void finish_token(int tok, const float (&xv)[16], float* __restrict__ xo, bf16_t* __restrict__ xb, float* __restrict__ rstd,
                                             const float* __restrict__ wf, const float* __restrict__ bfor, float* __restrict__ flog, int lane, int slot) {
    float ss = 0.f;
#pragma unroll
    for (int i = 0; i < 16; ++i) ss += xv[i] * xv[i];
    ss = wave_sum(ss);
    const float rs = __builtin_amdgcn_rsqf(ss * (1.f / 1024.f) + EPS);
    float* op = xo + (size_t)tok * D + 16 * slot; bf16_t* bp = xb + (size_t)tok * D + 16 * slot;
    if (xo) {
#pragma unroll
        for (int j = 0; j < 4; ++j) *(f32x4*)(op + 4 * j) = (f32x4){xv[4 * j], xv[4 * j + 1], xv[4 * j + 2], xv[4 * j + 3]};
    }
    u32x4 w0, w1;
    w0.x = pk2(xv[0], xv[1]); w0.y = pk2(xv[2], xv[3]); w0.z = pk2(xv[4], xv[5]); w0.w = pk2(xv[6], xv[7]);
    w1.x = pk2(xv[8], xv[9]); w1.y = pk2(xv[10], xv[11]); w1.z = pk2(xv[12], xv[13]); w1.w = pk2(xv[14], xv[15]);
    *(u32x4*)(bp) = w0; *(u32x4*)(bp + 8) = w1;
    if (lane == 0) rstd[tok] = rs;
    if (wf) {
        float myff = 0.f;
#pragma unroll
        for (int h = 0; h < 4; ++h) {
            const float* wp = wf + h * 1024 + 16 * slot;
            float d = 0.f;
#pragma unroll
            for (int j = 0; j < 4; ++j) { const f32x4 t = *(const f32x4*)(wp + 4 * j); d += xv[4 * j] * t[0] + xv[4 * j + 1] * t[1] + xv[4 * j + 2] * t[2] + xv[4 * j + 3] * t[3]; }
            d = wave_sum(d);
            if (lane == h) myff = d;
        }
        if (lane < 4) { const int b = tok / S, s = tok % S; flog[((size_t)b * 4 + lane) * S + s] = log_sigmoid(myff * rs + bfor[lane]); }
    }
}
__device__ __forceinline__ void phase_xprep(const Args& a) {
    const int lane = threadIdx.x & 63, wv = blockIdx.x * 8 + (threadIdx.x >> 6), nw = gridDim.x * 8;
    const float* x = a.in[0];
    for (int tok = wv; tok < T; tok += nw) {
        float xv[16]; load_row16(x + (size_t)tok * D, lane, xv);
        finish_token(tok, xv, nullptr, (bf16_t*)(a.ws + WS_XB), (float*)(a.ws + WS_RSTD), (const float*)(a.ws + WS_WF), a.in[2], (float*)(a.ws + WS_FLOG), lane, lane);
    }
}
__device__ __forceinline__ void cum_scan(const Args& a, unsigned char* ldsb, int bh) {
    float* lds = (float*)ldsb;
    const int tid = threadIdx.x, lane = tid & 63, w = tid >> 6;
    const float* fl = (const float*)(a.ws + WS_FLOG) + (size_t)bh * S + tid * 16;
    float v[16];
#pragma unroll
    for (int i = 0; i < 4; ++i) { const f32x4 t = *(const f32x4*)(fl + 4 * i); v[4 * i] = t[0]; v[4 * i + 1] = t[1]; v[4 * i + 2] = t[2]; v[4 * i + 3] = t[3]; }
#pragma unroll
    for (int i = 1; i < 16; ++i) v[i] += v[i - 1];
    float incl = v[15];
#pragma unroll
    for (int o = 1; o < 64; o <<= 1) { const float t = __shfl_up(incl, o); if (lane >= o) incl += t; }
    if (lane == 63) lds[w] = incl;
    __syncthreads();
    float base = incl - v[15];
    for (int j = 0; j < w; ++j) base += lds[j];
    float* cp = (float*)(a.ws + WS_CUM) + (size_t)bh * S + tid * 16;
#pragma unroll
    for (int i = 0; i < 4; ++i) *(f32x4*)(cp + 4 * i) = (f32x4){(base + v[4 * i]) * LOG2E, (base + v[4 * i + 1]) * LOG2E, (base + v[4 * i + 2]) * LOG2E, (base + v[4 * i + 3]) * LOG2E};
    __syncthreads();
}

constexpr int AT_KP = 176, AT_KB = 64 * AT_KP, AT_KS = 0, AT_VP = 192, AT_VB = 64 * AT_VP, AT_VT = 2 * AT_KB, AT_TBL = AT_VT + 2 * AT_VB, AT_END = AT_TBL + TBN * 4;
__device__ __forceinline__ int swap23(int i) { return (i & ~12) | ((i & 4) << 1) | ((i & 8) >> 1); }
#define MFMA32(A, B, C) __builtin_amdgcn_mfma_f32_32x32x16_bf16(A, B, C, 0, 0, 0)
#define MFMA_DRAIN2(x, y) asm volatile("s_nop 15\n\ts_nop 15\n\ts_nop 7" : "+v"(x), "+v"(y))
typedef float f32x2_t __attribute__((ext_vector_type(2))); typedef __bf16 bf16x2_t __attribute__((ext_vector_type(2)));
__device__ __forceinline__ float max3f(float a, float b, float c) { return __builtin_fmaxf(__builtin_fmaxf(a, b), c); }
__device__ __forceinline__ unsigned cvtpk(float lo, float hi) { const f32x2_t v = {lo, hi}; const bf16x2_t b = __builtin_convertvector(v, bf16x2_t); return __builtin_bit_cast(unsigned, b); }
__device__ __forceinline__ bf16x8 pack8(const f32x16& p, int s8) {
    u32x4 w; w.x = cvtpk(p[s8], p[s8 + 1]); w.y = cvtpk(p[s8 + 2], p[s8 + 3]); w.z = cvtpk(p[s8 + 4], p[s8 + 5]); w.w = cvtpk(p[s8 + 6], p[s8 + 7]);
    return __builtin_bit_cast(bf16x8, w);
}
__device__ __forceinline__ void split3(float x, float& b1, float& b2, float& b3) {
    b1 = bf2f(f2bf(x)); const float r = x - b1; b2 = bf2f(f2bf(r)); b3 = bf2f(f2bf(r - b2));
}
__device__ __forceinline__ void stage_kv(unsigned char* lds, int buf, int kv_s, int c_s, const u32x4& kreg, const u32x4& vreg) {
    *(u32x4*)(lds + AT_KS + buf * AT_KB + kv_s * AT_KP + 16 * c_s) = kreg;
    *(u32x4*)(lds + AT_VT + buf * AT_VB + kv_s * AT_VP + 16 * c_s) = vreg;
}
struct SMState { float mref, l; };
template <int NP>
__device__ __forceinline__ void softmax_step(f32x16 (&p)[NP], SMState& st, bool& refzero, f32x16 (&o)[2]) {
    float a = max3f(p[0][0], p[0][1], p[0][2]), b = max3f(p[0][3], p[0][4], p[0][5]);
    a = max3f(a, p[0][6], p[0][7]); b = max3f(b, p[0][8], p[0][9]); a = max3f(a, p[0][10], p[0][11]); b = max3f(b, p[0][12], p[0][13]); a = max3f(a, p[0][14], p[0][15]);
    if (NP == 2) { b = max3f(b, p[NP - 1][0], p[NP - 1][1]); a = max3f(a, p[NP - 1][2], p[NP - 1][3]); b = max3f(b, p[NP - 1][4], p[NP - 1][5]); a = max3f(a, p[NP - 1][6], p[NP - 1][7]);
        b = max3f(b, p[NP - 1][8], p[NP - 1][9]); a = max3f(a, p[NP - 1][10], p[NP - 1][11]); b = max3f(b, p[NP - 1][12], p[NP - 1][13]); a = max3f(a, p[NP - 1][14], p[NP - 1][15]); }
    const float rm = half_swap_max(fmaxf(a, b));
    if (__any(rm - st.mref > 20.f)) {
        const float nr = (rm - st.mref > 20.f) ? rm : st.mref;
        const float f = __builtin_amdgcn_exp2f(st.mref - nr);
        st.l *= f;
#pragma unroll
        for (int r = 0; r < 16; ++r) { o[0][r] *= f; o[1][r] *= f; }
        st.mref = nr; refzero = false;
    }
    if (!refzero) {
#pragma unroll
        for (int i = 0; i < NP; ++i)
#pragma unroll
            for (int r = 0; r < 16; ++r) p[i][r] -= st.mref;
    }
    float ps = 0.f;
#pragma unroll
    for (int i = 0; i < NP; ++i)
#pragma unroll
        for (int r = 0; r < 16; ++r) { const float e = __builtin_amdgcn_exp2f(p[i][r]); p[i][r] = e; ps += e; }
    st.l += ps;
}
typedef short v4i16_t __attribute__((ext_vector_type(4)));
__device__ __forceinline__ void load_vf(const unsigned char* lds, int buf, int lane, bf16x8 (&vf)[2][2][2]) {
    const int g = lane >> 4, i = lane & 15, q = i >> 2, p4 = i & 3;
    const LAS3 unsigned char* base = (const LAS3 unsigned char*)(lds + AT_VT + buf * AT_VB) + (8 * (g >> 1) + q) * AT_VP + (16 * (g & 1) + 4 * p4) * 2;
#pragma unroll
    for (int db = 0; db < 2; ++db)
#pragma unroll
        for (int hf = 0; hf < 2; ++hf)
#pragma unroll
            for (int s = 0; s < 2; ++s) {
                const LAS3 unsigned char* pp = base + (32 * hf + 16 * s) * AT_VP + 64 * db;
                const v4i16_t lo = __builtin_amdgcn_ds_read_tr16_b64_v4i16((LAS3 v4i16_t*)pp);
                const v4i16_t hi4 = __builtin_amdgcn_ds_read_tr16_b64_v4i16((LAS3 v4i16_t*)(pp + 4 * AT_VP));
                vf[db][hf][s] = (bf16x8){lo[0], lo[1], lo[2], lo[3], hi4[0], hi4[1], hi4[2], hi4[3]};
            }
}
__device__ __forceinline__ void pv_tile(const bf16x8 (&vf)[2][2][2], const f32x16 (&p)[2], f32x16 (&o)[2]) {
#pragma unroll
    for (int hf = 0; hf < 2; ++hf)
#pragma unroll
        for (int s = 0; s < 2; ++s) {
            const bf16x8 pf = pack8(p[hf], 8 * s);
#pragma unroll
            for (int db = 0; db < 2; ++db) o[db] = MFMA32(vf[db][hf][s], pf, o[db]);
        }
}
__device__ __forceinline__ void store_ot(bf16_t* dst, const f32x16 (&o)[2], float sc, int hi) {
#pragma unroll
    for (int db = 0; db < 2; ++db)
#pragma unroll
        for (int r4 = 0; r4 < 4; ++r4) {
            u32x2 w; w.x = cvtpk(o[db][4 * r4] * sc, o[db][4 * r4 + 1] * sc); w.y = cvtpk(o[db][4 * r4 + 2] * sc, o[db][4 * r4 + 3] * sc);
            *(u32x2*)(dst + 32 * db + 8 * r4 + 4 * hi) = w;
        }
}

__device__ __forceinline__ void fox_unit(const Args& a, unsigned char* lds, int layer, int bh, int qb) {
    int tid = threadIdx.x; asm volatile("" : "+v"(tid));
    const int lane = tid & 63, w = __builtin_amdgcn_readfirstlane(tid >> 6), qi = lane & 31, hi = lane >> 5;
    const int b = bh >> 2, h = bh & 3;
    const bf16_t* zb = (const bf16_t*)(a.ws + WS_ZB) + (size_t)b * S * ZP;
    const float* cum = (const float*)(a.ws + WS_CUM) + (size_t)bh * S;
    const int q0 = 256 * qb + 32 * w;
    const float cref = cum[256 * qb];
    bf16x8 qf[5];
#pragma unroll
    for (int ds = 0; ds < 4; ++ds) qf[ds] = *(const bf16x8*)(zb + (size_t)(q0 + qi) * ZP + ZC_FQ + 64 * h + 16 * ds + 8 * hi);
    { float q1, q2, q3; split3(cum[q0 + qi] - cref, q1, q2, q3);
      u32x4 e; e.x = hi ? 0u : 0x3f803f80u; e.y = hi ? 0u : (0x3f80u | ((unsigned)f2bf(q1) << 16)); e.z = hi ? 0u : ((unsigned)f2bf(q2) | ((unsigned)f2bf(q3) << 16)); e.w = 0u;
      qf[4] = __builtin_bit_cast(bf16x8, e); }
    const int ntiles = 4 * (qb + 1), mylast = 4 * qb + (w >> 1);
    const float thr = ((const float*)(a.ws + WS_FOXT))[layer];
    int kt0 = 0;
    {
        const bool sk = tid < 4 * qb && (cref - cum[64 * tid + 63]) < -thr;
        const unsigned long long bal = __ballot(sk);
        volatile LAS3 unsigned* cw = (volatile LAS3 unsigned*)(LAS3 unsigned char*)(lds + LDS_CTL + 64);
        if (lane == 0) cw[w] = (unsigned)__popcll(bal);
        __syncthreads();
#pragma unroll
        for (int i = 0; i < 8; ++i) kt0 += (int)cw[i];
        __syncthreads();
    }
    const int kv_s = 8 * w + (lane >> 3), c_s = lane & 7;
    const bf16_t* kp = zb + (size_t)kv_s * ZP + ZC_FK + 64 * h + 8 * c_s;
    const bf16_t* vp = zb + (size_t)kv_s * ZP + ZC_FV + 64 * h + 8 * c_s;
    u32x4 kreg = *(const u32x4*)(kp + (size_t)kt0 * 64 * ZP), vreg = *(const u32x4*)(vp + (size_t)kt0 * 64 * ZP);
    float dreg = (tid < 64) ? cum[kt0 * 64 + tid] : 0.f;
    SMState st; st.mref = 0.f; st.l = 0.f; bool refzero = true;
    f32x16 o[2]; o[0] = (f32x16){}; o[1] = (f32x16){};
    const int krow = swap23(qi);
#ifdef HK_FOX_NOSTAG
    const int grp = HK_FOX_NOSTAG - 1;
#else
    const int grp = w >> 2;
#endif
    f32x16 p[2];
#define FOX_QK(kt_, buf_) do { bf16x8 kf_[2][5]; \
        _Pragma("unroll") for (int hf = 0; hf < 2; ++hf) _Pragma("unroll") for (int ds = 0; ds < 5; ++ds) kf_[hf][ds] = *(const bf16x8*)(lds + AT_KS + (buf_) * AT_KB + (32 * hf + krow) * AT_KP + 32 * ds + 16 * hi); \
        _Pragma("unroll") for (int hf = 0; hf < 2; ++hf) { p[hf] = (f32x16){}; _Pragma("unroll") for (int ds = 0; ds < 5; ++ds) p[hf] = MFMA32(kf_[hf][ds], qf[ds], p[hf]); } \
        MFMA_DRAIN2(p[0], p[1]); \
        if (64 * (kt_) + 63 > q0) { const int lim = q0 + qi - 64 * (kt_) - 8 * hi; \
            _Pragma("unroll") for (int hf = 0; hf < 2; ++hf) _Pragma("unroll") for (int r = 0; r < 16; ++r) if (32 * hf + 16 * (r >> 3) + (r & 7) > lim) p[hf][r] = -INFINITY; } } while (0)
#define FOX_SMPV(buf_) do { bf16x8 vf_[2][2][2]; load_vf(lds, (buf_), lane, vf_); softmax_step<2>(p, st, refzero, o); pv_tile(vf_, p, o); } while (0)
    for (int kt = kt0; kt < ntiles; ++kt) {
        const int buf = kt & 1;
        stage_kv(lds, buf, kv_s, c_s, kreg, vreg);
        if (tid < 64) { float k1, k2, k3; split3(cref - dreg, k1, k2, k3);
            u32x4 e; e.x = (unsigned)f2bf(k1) | ((unsigned)f2bf(k2) << 16); e.y = (unsigned)f2bf(k3) | 0x3f800000u; e.z = 0x3f803f80u; e.w = 0u;
            unsigned char* kr = lds + AT_KS + buf * AT_KB + tid * AT_KP + 128;
            *(u32x4*)kr = e; *(u32x4*)(kr + 16) = (u32x4){0u, 0u, 0u, 0u}; }
        __syncthreads();
        if (kt + 1 < ntiles) {
            kreg = *(const u32x4*)(kp + (size_t)(kt + 1) * 64 * ZP); vreg = *(const u32x4*)(vp + (size_t)(kt + 1) * 64 * ZP);
            if (tid < 64) dreg = cum[(kt + 1) * 64 + tid];
        }
#ifdef HK_FOX_X2
        if (grp == 0) { if (kt <= mylast) FOX_QK(kt, buf); }
        __syncthreads();
        if (grp == 0) { if (kt <= mylast) FOX_SMPV(buf); }
        else { if (kt > kt0 && kt - 1 <= mylast) FOX_SMPV(buf ^ 1); if (kt <= mylast) FOX_QK(kt, buf); }
#else
        if (grp == 0) { if (kt <= mylast) FOX_QK(kt, buf); }
        else { if (kt > kt0 && kt - 1 <= mylast) FOX_SMPV(buf ^ 1); }
        __syncthreads();
        if (grp == 0) { if (kt <= mylast) FOX_SMPV(buf); }
        else { if (kt <= mylast) FOX_QK(kt, buf); }
#endif
#ifdef HK_FOX_B3
        __syncthreads();
#endif
    }
    if (grp == 1 && ntiles - 1 <= mylast) FOX_SMPV((ntiles - 1) & 1);
#undef FOX_QK
#undef FOX_SMPV
    const float l = half_swap_sum(st.l);
    store_ot((bf16_t*)(a.ws + WS_MIX) + (size_t)(b * S + q0 + qi) * D + 0 + 64 * h, o, 1.f / l, hi);
    __syncthreads();
}

__device__ __forceinline__ void fox64_unit(const Args& a, unsigned char* lds, int layer, int bh, int qb) {
    int tid = threadIdx.x; asm volatile("" : "+v"(tid));
    const int lane = tid & 63, w = __builtin_amdgcn_readfirstlane(tid >> 6), qi = lane & 31, hi = lane >> 5;
    const int b = bh >> 2, h = bh & 3;
    const bf16_t* zb = (const bf16_t*)(a.ws + WS_ZB) + (size_t)b * S * ZP;
    const float* cum = (const float*)(a.ws + WS_CUM) + (size_t)bh * S;
    const int q0 = 512 * qb + 64 * w;
    const float cref = cum[512 * qb];
    bf16x8 qfA[5], qfB[5];
#pragma unroll
    for (int ds = 0; ds < 4; ++ds) { qfA[ds] = *(const bf16x8*)(zb + (size_t)(q0 + qi) * ZP + ZC_FQ + 64 * h + 16 * ds + 8 * hi); qfB[ds] = *(const bf16x8*)(zb + (size_t)(q0 + 32 + qi) * ZP + ZC_FQ + 64 * h + 16 * ds + 8 * hi); }
#pragma unroll
    for (int blk = 0; blk < 2; ++blk) { float q1, q2, q3; split3(cum[q0 + 32 * blk + qi] - cref, q1, q2, q3);
      u32x4 e; e.x = hi ? 0u : 0x3f803f80u; e.y = hi ? 0u : (0x3f80u | ((unsigned)f2bf(q1) << 16)); e.z = hi ? 0u : ((unsigned)f2bf(q2) | ((unsigned)f2bf(q3) << 16)); e.w = 0u;
      if (blk == 0) qfA[4] = __builtin_bit_cast(bf16x8, e); else qfB[4] = __builtin_bit_cast(bf16x8, e); }
    const int ntiles = 8 * (qb + 1), mylast = 8 * qb + w;
    const float thr = ((const float*)(a.ws + WS_FOXT))[layer];
    int kt0 = 0;
    {   const bool sk = tid < 8 * qb && (cref - cum[64 * tid + 63]) < -thr;
        const unsigned long long bal = __ballot(sk);
        volatile LAS3 unsigned* cw = (volatile LAS3 unsigned*)(LAS3 unsigned char*)(lds + LDS_CTL + 64);
        if (lane == 0) cw[w] = (unsigned)__popcll(bal);
        __syncthreads();
#pragma unroll
        for (int i = 0; i < 8; ++i) kt0 += (int)cw[i];
        __syncthreads();
    }
    const int kv_s = 8 * w + (lane >> 3), c_s = lane & 7;
    const bf16_t* kp = zb + (size_t)kv_s * ZP + ZC_FK + 64 * h + 8 * c_s;
    const bf16_t* vp = zb + (size_t)kv_s * ZP + ZC_FV + 64 * h + 8 * c_s;
    u32x4 kreg = *(const u32x4*)(kp + (size_t)kt0 * 64 * ZP), vreg = *(const u32x4*)(vp + (size_t)kt0 * 64 * ZP);
    float dreg = (tid < 64) ? cum[kt0 * 64 + tid] : 0.f;
    SMState stA, stB; stA.mref = 0.f; stA.l = 0.f; stB.mref = 0.f; stB.l = 0.f; bool rzA = true, rzB = true;
    f32x16 oA[2], oB[2]; oA[0] = (f32x16){}; oA[1] = (f32x16){}; oB[0] = (f32x16){}; oB[1] = (f32x16){};
    const int krow = swap23(qi);
    for (int kt = kt0; kt < ntiles; ++kt) {
        const int buf = kt & 1;
        stage_kv(lds, buf, kv_s, c_s, kreg, vreg);
        if (tid < 64) { float k1, k2, k3; split3(cref - dreg, k1, k2, k3);
            u32x4 e; e.x = (unsigned)f2bf(k1) | ((unsigned)f2bf(k2) << 16); e.y = (unsigned)f2bf(k3) | 0x3f800000u; e.z = 0x3f803f80u; e.w = 0u;
            unsigned char* kr = lds + AT_KS + buf * AT_KB + tid * AT_KP + 128;
            *(u32x4*)kr = e; *(u32x4*)(kr + 16) = (u32x4){0u, 0u, 0u, 0u}; }
        __syncthreads();
        if (kt + 1 < ntiles) {
            kreg = *(const u32x4*)(kp + (size_t)(kt + 1) * 64 * ZP); vreg = *(const u32x4*)(vp + (size_t)(kt + 1) * 64 * ZP);
            if (tid < 64) dreg = cum[(kt + 1) * 64 + tid];
        }
        if (kt <= mylast) {
            f32x16 pA[2], pB[2];
#pragma unroll
            for (int hf = 0; hf < 2; ++hf) {
                pA[hf] = (f32x16){}; pB[hf] = (f32x16){};
#pragma unroll
                for (int ds = 0; ds < 5; ++ds) { const bf16x8 kf = *(const bf16x8*)(lds + AT_KS + buf * AT_KB + (32 * hf + krow) * AT_KP + 32 * ds + 16 * hi);
                    pA[hf] = MFMA32(kf, qfA[ds], pA[hf]); pB[hf] = MFMA32(kf, qfB[ds], pB[hf]); }
            }
            if (kt == mylast) {
                const int limA = qi - 8 * hi, limB = 32 + qi - 8 * hi;
#pragma unroll
                for (int hf = 0; hf < 2; ++hf)
#pragma unroll
                    for (int r = 0; r < 16; ++r) { const int kvo = 32 * hf + 16 * (r >> 3) + (r & 7); if (kvo > limA) pA[hf][r] = -INFINITY; if (kvo > limB) pB[hf][r] = -INFINITY; }
            }
            softmax_step<2>(pA, stA, rzA, oA); softmax_step<2>(pB, stB, rzB, oB);
            const int g_ = lane >> 4, i_ = lane & 15;
            const LAS3 unsigned char* vb_ = (const LAS3 unsigned char*)(lds + AT_VT + buf * AT_VB) + (8 * (g_ >> 1) + (i_ >> 2)) * AT_VP + (16 * (g_ & 1) + 4 * (i_ & 3)) * 2;
#pragma unroll
            for (int hf = 0; hf < 2; ++hf)
#pragma unroll
                for (int s = 0; s < 2; ++s) {
                    const bf16x8 fa = pack8(pA[hf], 8 * s), fb = pack8(pB[hf], 8 * s);
#pragma unroll
                    for (int db = 0; db < 2; ++db) {
                        const LAS3 unsigned char* pp = vb_ + (32 * hf + 16 * s) * AT_VP + 64 * db;
                        const v4i16_t lo = __builtin_amdgcn_ds_read_tr16_b64_v4i16((LAS3 v4i16_t*)pp);
                        const v4i16_t hi4 = __builtin_amdgcn_ds_read_tr16_b64_v4i16((LAS3 v4i16_t*)(pp + 4 * AT_VP));
                        const bf16x8 vf = (bf16x8){lo[0], lo[1], lo[2], lo[3], hi4[0], hi4[1], hi4[2], hi4[3]};
                        oA[db] = MFMA32(vf, fa, oA[db]); oB[db] = MFMA32(vf, fb, oB[db]);
                    }
                }
        }
    }
    const float lA = half_swap_sum(stA.l), lB = half_swap_sum(stB.l);
    bf16_t* mo = (bf16_t*)(a.ws + WS_MIX) + (size_t)(b * S + q0 + qi) * D + 64 * h;
    store_ot(mo, oA, 1.f / lA, hi);
    store_ot(mo + (size_t)32 * D, oB, 1.f / lB, hi);
    __syncthreads();
}

__device__ __forceinline__ void diff_unit(const Args& a, unsigned char* lds, int layer, int bh, int qb) {
    int tid = threadIdx.x; asm volatile("" : "+v"(tid));
    const int lane = tid & 63, w = __builtin_amdgcn_readfirstlane(tid >> 6), qi = lane & 31, hi = lane >> 5;
    const int b = bh >> 2, h = bh & 3;
    const bf16_t* zb = (const bf16_t*)(a.ws + WS_ZB) + (size_t)b * S * ZP;
    const int q0 = 256 * qb + 32 * w;
    {
        const float* tb = (const float*)(a.ws + WS_TB) + (size_t)(4 + h) * TBN; float* tl = (float*)(lds + AT_TBL);
        const float cb = tb[1600]; float tv[5];
#pragma unroll
        for (int k = 0; k < 5; ++k) { const int i = tid + NTHR * k; tv[k] = tb[i < TBN ? i : TBN - 1]; }
#pragma unroll
        for (int k = 0; k < 5; ++k) { const int i = tid + NTHR * k; if (i < TBN) tl[i] = tv[k] - cb; }
    }
    bf16x8 qf[2][2];
#pragma unroll
    for (int c = 0; c < 2; ++c)
#pragma unroll
        for (int ds = 0; ds < 2; ++ds) qf[c][ds] = *(const bf16x8*)(zb + (size_t)(q0 + qi) * ZP + ZC_CQ + 64 * h + 32 * c + 16 * ds + 8 * hi);
    const int ntiles = 4 * (qb + 1), mylast = 4 * qb + (w >> 1);
    const int kv_s = 8 * w + (lane >> 3), c_s = lane & 7;
    const bf16_t* kp = zb + (size_t)kv_s * ZP + ZC_CK + 64 * h + 8 * c_s;
    const bf16_t* vp = zb + (size_t)kv_s * ZP + ZC_CV + 64 * h + 8 * c_s;
    u32x4 kreg = *(const u32x4*)kp, vreg = *(const u32x4*)vp;
    SMState st[2]; st[0].mref = 0.f; st[0].l = 0.f; st[1].mref = 0.f; st[1].l = 0.f; bool rz0 = true, rz1 = true;
    f32x16 o[2][2];
#pragma unroll
    for (int c = 0; c < 2; ++c) { o[c][0] = (f32x16){}; o[c][1] = (f32x16){}; }
    const int krow = swap23(qi);
    const float* tl = (const float*)(lds + AT_TBL);
    for (int kt = 0; kt < ntiles; ++kt) {
        const int buf = kt & 1;
        stage_kv(lds, buf, kv_s, c_s, kreg, vreg);
        __syncthreads();
        if (kt + 1 < ntiles) { kreg = *(const u32x4*)(kp + (size_t)(kt + 1) * 64 * ZP); vreg = *(const u32x4*)(vp + (size_t)(kt + 1) * 64 * ZP); }
        if (kt <= mylast) {
            const bool far_ = q0 - (64 * kt + 63) >= 1513;
            const bool diag = 64 * kt + 63 > q0;
            const int dq = q0 + qi - 64 * kt - 8 * hi;
#pragma unroll
            for (int hf = 0; hf < 2; ++hf) {
                f32x16 p0[1], p1[1]; p0[0] = (f32x16){}; p1[0] = (f32x16){};
                bf16x8 vf[2][2];
                { const int g_ = lane >> 4, i_ = lane & 15;
                  const LAS3 unsigned char* vb_ = (const LAS3 unsigned char*)(lds + AT_VT + buf * AT_VB) + (32 * hf + 8 * (g_ >> 1) + (i_ >> 2)) * AT_VP + (16 * (g_ & 1) + 4 * (i_ & 3)) * 2;
#pragma unroll
                  for (int s = 0; s < 2; ++s)
#pragma unroll
                      for (int db = 0; db < 2; ++db) {
                          const v4i16_t lo = __builtin_amdgcn_ds_read_tr16_b64_v4i16((LAS3 v4i16_t*)(vb_ + 16 * s * AT_VP + 64 * db));
                          const v4i16_t hi4 = __builtin_amdgcn_ds_read_tr16_b64_v4i16((LAS3 v4i16_t*)(vb_ + (16 * s + 4) * AT_VP + 64 * db));
                          vf[s][db] = (bf16x8){lo[0], lo[1], lo[2], lo[3], hi4[0], hi4[1], hi4[2], hi4[3]};
                      } }
#pragma unroll
                for (int ds = 0; ds < 2; ++ds) {
                    const bf16x8 k0 = *(const bf16x8*)(lds + AT_KS + buf * AT_KB + (32 * hf + krow) * AT_KP + 32 * ds + 16 * hi);
                    const bf16x8 k1 = *(const bf16x8*)(lds + AT_KS + buf * AT_KB + (32 * hf + krow) * AT_KP + 64 + 32 * ds + 16 * hi);
                    p0[0] = MFMA32(k0, qf[0][ds], p0[0]); p1[0] = MFMA32(k1, qf[1][ds], p1[0]);
                }
                MFMA_DRAIN2(p0[0], p1[0]);
                if (!far_) {
                    if (diag) {
#pragma unroll
                        for (int r = 0; r < 16; ++r) {
                            const int dist = dq - (32 * hf + 16 * (r >> 3) + (r & 7));
                            const float bb = tl[dist < 0 ? 0 : dist];
                            const bool ok = dist >= 0;
                            p0[0][r] = ok ? p0[0][r] + bb : -INFINITY; p1[0][r] = ok ? p1[0][r] + bb : -INFINITY;
                        }
                    } else {
#pragma unroll
                        for (int r = 0; r < 16; ++r) { const float bb = tl[dq - (32 * hf + 16 * (r >> 3) + (r & 7))]; p0[0][r] += bb; p1[0][r] += bb; }
                    }
                }
                softmax_step<1>(p0, st[0], rz0, o[0]); softmax_step<1>(p1, st[1], rz1, o[1]);
#pragma unroll
                for (int s = 0; s < 2; ++s) {
                    const bf16x8 f0 = pack8(p0[0], 8 * s), f1 = pack8(p1[0], 8 * s);
#pragma unroll
                    for (int db = 0; db < 2; ++db) { o[0][db] = MFMA32(vf[s][db], f0, o[0][db]); o[1][db] = MFMA32(vf[s][db], f1, o[1][db]); }
                }
            }
        }
    }
    const float lam_init = 0.8f - 0.6f * __expf(-0.3f * (float)layer);
    const float* lp = a.in[12] + layer * 128;
    float s1 = 0.f, s2 = 0.f;
    for (int i = 0; i < 32; ++i) { s1 += lp[i] * lp[32 + i]; s2 += lp[64 + i] * lp[96 + i]; }
    const float lam = __expf(s1) - __expf(s2) + lam_init;
    const float i0 = 1.f / half_swap_sum(st[0].l), i1 = lam / half_swap_sum(st[1].l);
    float ss = 0.f;
#pragma unroll
    for (int db = 0; db < 2; ++db)
#pragma unroll
        for (int r = 0; r < 16; ++r) { const float v = o[0][db][r] * i0 - o[1][db][r] * i1; o[0][db][r] = v; ss += v * v; }
    ss = half_swap_sum(ss);
    const float rn = __builtin_amdgcn_rsqf(ss * (1.f / 64.f) + EPS) * (1.f - lam_init);
    const float* gn = a.in[13] + layer * 64;
#pragma unroll
    for (int db = 0; db < 2; ++db)
#pragma unroll
        for (int r = 0; r < 16; ++r) o[0][db][r] *= gn[32 * db + (r & 3) + 8 * (r >> 2) + 4 * hi];
    store_ot((bf16_t*)(a.ws + WS_MIX) + (size_t)(b * S + q0 + qi) * D + 512 + 64 * h, o[0], rn, hi);
    __syncthreads();
}

__device__ __forceinline__ void dil_unit(const Args& a, unsigned char* lds, int bh, int br, int rho, int tile) {
    int tid = threadIdx.x; asm volatile("" : "+v"(tid));
    const int lane = tid & 63, w = __builtin_amdgcn_readfirstlane(tid >> 6), qi = lane & 31, hi = lane >> 5;
    const int b = bh >> 2, h = bh & 3;
    const int r = br == 0 ? 1 : (br == 1 ? 4 : 16);
    const bf16_t* zb = (const bf16_t*)(a.ws + WS_ZB) + (size_t)b * S * ZP;
    {   const float* tb = (const float*)(a.ws + WS_TB) + (size_t)h * TBN; float* tl = (float*)(lds + AT_TBL); float tv[5];
#pragma unroll
        for (int k = 0; k < 5; ++k) { const int i = tid + NTHR * k; tv[k] = tb[i < TBN ? i : TBN - 1]; }
#pragma unroll
        for (int k = 0; k < 5; ++k) { const int i = tid + NTHR * k; if (i < TBN) tl[i] = tv[k]; }
    }
    const int l0 = 256 * tile, lq0 = l0 + 32 * w;
    const int tq = (lq0 + qi) * r + rho;
    bf16x8 qf[4];
#pragma unroll
    for (int ds = 0; ds < 4; ++ds) qf[ds] = *(const bf16x8*)(zb + (size_t)tq * ZP + ZC_DQ + 64 * h + 16 * ds + 8 * hi);
    const int kv_s = 8 * w + (lane >> 3), c_s = lane & 7;
    const int j0 = (l0 == 0) ? 2 : 0;
    auto krow_of = [&](int j) { int kl = l0 - 128 + 64 * j + kv_s; kl = kl < 0 ? 0 : kl; return (size_t)(kl * r + rho) * ZP; };
    u32x4 kreg = *(const u32x4*)(zb + krow_of(j0) + ZC_DK + 64 * h + 8 * c_s), vreg = *(const u32x4*)(zb + krow_of(j0) + ZC_DV + 64 * h + 8 * c_s);
    SMState st; st.mref = 0.f; st.l = 0.f; bool refzero = true;
    f32x16 o[2]; o[0] = (f32x16){}; o[1] = (f32x16){};
    const int krow = swap23(qi);
    const float* tl = (const float*)(lds + AT_TBL);
    for (int j = j0; j < 6; ++j) {
        const int buf = j & 1;
        stage_kv(lds, buf, kv_s, c_s, kreg, vreg);
        __syncthreads();
        if (j + 1 < 6) { kreg = *(const u32x4*)(zb + krow_of(j + 1) + ZC_DK + 64 * h + 8 * c_s); vreg = *(const u32x4*)(zb + krow_of(j + 1) + ZC_DV + 64 * h + 8 * c_s); }
        const int kl0 = l0 - 128 + 64 * j;
#pragma unroll
        for (int hf = 0; hf < 2; ++hf) {
            const int kh0 = kl0 + 32 * hf;
            if (kh0 <= lq0 + 31 && kh0 + 31 >= lq0 - 128 && kh0 + 31 >= 0) {
                f32x16 p[1]; p[0] = (f32x16){};
                bf16x8 kf[4];
#pragma unroll
                for (int ds = 0; ds < 4; ++ds) kf[ds] = *(const bf16x8*)(lds + AT_KS + buf * AT_KB + (32 * hf + krow) * AT_KP + 32 * ds + 16 * hi);
                bf16x8 vf[2][2];
                { const int g_ = lane >> 4, i_ = lane & 15;
                  const LAS3 unsigned char* vb_ = (const LAS3 unsigned char*)(lds + AT_VT + buf * AT_VB) + (32 * hf + 8 * (g_ >> 1) + (i_ >> 2)) * AT_VP + (16 * (g_ & 1) + 4 * (i_ & 3)) * 2;
#pragma unroll
                  for (int s = 0; s < 2; ++s)
#pragma unroll
                      for (int db = 0; db < 2; ++db) {
                          const v4i16_t lo = __builtin_amdgcn_ds_read_tr16_b64_v4i16((LAS3 v4i16_t*)(vb_ + 16 * s * AT_VP + 64 * db));
                          const v4i16_t hi4 = __builtin_amdgcn_ds_read_tr16_b64_v4i16((LAS3 v4i16_t*)(vb_ + (16 * s + 4) * AT_VP + 64 * db));
                          vf[s][db] = (bf16x8){lo[0], lo[1], lo[2], lo[3], hi4[0], hi4[1], hi4[2], hi4[3]};
                      } }
#pragma unroll
                for (int ds = 0; ds < 4; ++ds) p[0] = MFMA32(kf[ds], qf[ds], p[0]);
                const int dq = lq0 + qi - kh0 - 8 * hi;
#pragma unroll
                for (int rr = 0; rr < 16; ++rr) {
                    const int kvoff = 16 * (rr >> 3) + (rr & 7);
                    const int dd = dq - kvoff;
                    const bool ok = dd >= 0 && dd <= 128 && (kh0 + 8 * hi + kvoff) >= 0;
                    const float bb = tl[ok ? dd * r : 0];
                    p[0][rr] = ok ? p[0][rr] + bb : -INFINITY;
                }
                softmax_step<1>(p, st, refzero, o);
#pragma unroll
                for (int s = 0; s < 2; ++s) {
                    const bf16x8 pf = pack8(p[0], 8 * s);
#pragma unroll
                    for (int db = 0; db < 2; ++db) o[db] = MFMA32(vf[s][db], pf, o[db]);
                }
            }
        }
    }
    const float l = half_swap_sum(st.l);
    const size_t tok = (size_t)b * S + tq;
    store_ot((bf16_t*)(a.ws + WS_DPART) + ((size_t)br * T + tok) * 256 + 64 * h, o, 1.f / l, hi);
    if (hi == 0) ((float*)(a.ws + WS_DLSE))[((size_t)br * T + tok) * 4 + h] = st.mref + __builtin_amdgcn_logf(l);
    __syncthreads();
}
}
namespace hk {
struct S5P { float abr, abi, bbr[16], bbi[16]; };
__device__ __forceinline__ void s5_params(const Args& a, int layer, int g, int n, S5P& P, float& dtar, float& dtai) {
    const int lg = layer * 16 + g;
    const float dt = expf(a.in[17][lg]);
    const float ar = a.in[15][lg * 64 + n], ai = a.in[16][lg * 64 + n];
    dtar = dt * ar; dtai = dt * ai;
    const float mag = expf(dtar);
    P.abr = mag * cosf(dtai); P.abi = mag * sinf(dtai);
    const float den = ar * ar + ai * ai, nr = P.abr - 1.f, ni = P.abi;
    const float cr = (nr * ar + ni * ai) / den, ci = (ni * ar - nr * ai) / den;
    const float* brp = a.in[18] + ((size_t)lg * 64 + n) * 16; const float* bip = a.in[19] + ((size_t)lg * 64 + n) * 16;
#pragma unroll
    for (int c = 0; c < 16; ++c) { const float br = brp[c], bi = bip[c]; P.bbr[c] = cr * br - ci * bi; P.bbi[c] = cr * bi + ci * br; }
}
__device__ __forceinline__ void s5_step(const S5P& P, const LAS3 float* up, float& xr, float& xi) {
    const f32x4 u0 = *(const LAS3 f32x4*)(up), u1 = *(const LAS3 f32x4*)(up + 4), u2 = *(const LAS3 f32x4*)(up + 8), u3 = *(const LAS3 f32x4*)(up + 12);
    float r0 = P.bbr[0] * u0[0], r1 = P.bbr[4] * u1[0], r2 = P.bbr[8] * u2[0], r3 = P.bbr[12] * u3[0];
    float i0 = P.bbi[0] * u0[0], i1 = P.bbi[4] * u1[0], i2 = P.bbi[8] * u2[0], i3 = P.bbi[12] * u3[0];
    r0 += P.bbr[1] * u0[1]; r1 += P.bbr[5] * u1[1]; r2 += P.bbr[9] * u2[1]; r3 += P.bbr[13] * u3[1];
    i0 += P.bbi[1] * u0[1]; i1 += P.bbi[5] * u1[1]; i2 += P.bbi[9] * u2[1]; i3 += P.bbi[13] * u3[1];
    r0 += P.bbr[2] * u0[2]; r1 += P.bbr[6] * u1[2]; r2 += P.bbr[10] * u2[2]; r3 += P.bbr[14] * u3[2];
    i0 += P.bbi[2] * u0[2]; i1 += P.bbi[6] * u1[2]; i2 += P.bbi[10] * u2[2]; i3 += P.bbi[14] * u3[2];
    r0 += P.bbr[3] * u0[3]; r1 += P.bbr[7] * u1[3]; r2 += P.bbr[11] * u2[3]; r3 += P.bbr[15] * u3[3];
    i0 += P.bbi[3] * u0[3]; i1 += P.bbi[7] * u1[3]; i2 += P.bbi[11] * u2[3]; i3 += P.bbi[15] * u3[3];
    const float pr = (r0 + r1) + (r2 + r3), pi = (i0 + i1) + (i2 + i3);
    const float nxr = P.abr * xr - P.abi * xi + pr, nxi = P.abr * xi + P.abi * xr + pi;
    xr = nxr; xi = nxi;
}
__device__ __forceinline__ void s5_wave_operands(const Args& a, int layer, int w, int qi, int hi, bf16x8 (&bre)[2][2], bf16x8 (&bim)[2][2], f32x4 (&ab)[2]) {
#pragma unroll
    for (int gg = 0; gg < 2; ++gg) {
        const int lg = layer * 16 + 2 * w + gg;
#pragma unroll
        for (int sh = 0; sh < 2; ++sh) {
            const bf16_t* pb = (const bf16_t*)(a.ws + WS_S5B) + ((size_t)(lg * 2) * 64 + qi + 32 * sh) * 16 + 8 * hi;
            bre[gg][sh] = *(const bf16x8*)pb; bim[gg][sh] = *(const bf16x8*)(pb + 64 * 16);
        }
    }
#pragma unroll
    for (int sh = 0; sh < 2; ++sh) ab[sh] = ((const f32x4*)(a.ws + WS_S5A))[(layer * 16 + 2 * w + hi) * 64 + qi + 32 * sh];
}
#define S5_MFMA32(a, b, c) __builtin_amdgcn_mfma_f32_32x32x16_bf16(a, b, c, 0, 0, 0)
__device__ __forceinline__ void s5_state_params(const Args& a, int layer, int g, int st, float& abr, float& abi, float& cr, float& ci, float& dtar, float& dtai) {
    const int lg = layer * 16 + g;
    const float dt = expf(a.in[17][lg]);
    const float ar = a.in[15][lg * 64 + st], ai = a.in[16][lg * 64 + st];
    dtar = dt * ar; dtai = dt * ai;
    const float mag = expf(dtar);
    abr = mag * cosf(dtai); abi = mag * sinf(dtai);
    const float den = ar * ar + ai * ai, nr = abr - 1.f, ni = abi;
    cr = (nr * ar + ni * ai) / den; ci = (ni * ar - nr * ai) / den;
}
__device__ __forceinline__ void s5_wave_operands_v82(const Args& a, int layer, int w, int qi, int hi, bf16x8 (&bre)[2][2], bf16x8 (&bim)[2][2], float (&abr)[2], float (&abi)[2], float (&dtr)[2], float (&dti)[2]) {
#pragma unroll
    for (int gg = 0; gg < 2; ++gg) {
        const int g = 2 * w + gg, lg = layer * 16 + g;
#pragma unroll
        for (int sh = 0; sh < 2; ++sh) {
            const int st = qi + 32 * sh;
            float ar_, ai_, cr, ci, dtar, dtai; s5_state_params(a, layer, g, st, ar_, ai_, cr, ci, dtar, dtai);
            const float* brp = a.in[18] + ((size_t)lg * 64 + st) * 16 + 8 * hi; const float* bip = a.in[19] + ((size_t)lg * 64 + st) * 16 + 8 * hi;
            float vr[8], vi[8];
#pragma unroll
            for (int c = 0; c < 8; ++c) { const float br = brp[c], bi = bip[c]; vr[c] = cr * br - ci * bi; vi[c] = cr * bi + ci * br; }
            u32x4 pr, pi; pr.x = pk2(vr[0], vr[1]); pr.y = pk2(vr[2], vr[3]); pr.z = pk2(vr[4], vr[5]); pr.w = pk2(vr[6], vr[7]);
            pi.x = pk2(vi[0], vi[1]); pi.y = pk2(vi[2], vi[3]); pi.z = pk2(vi[4], vi[5]); pi.w = pk2(vi[6], vi[7]);
            bre[gg][sh] = __builtin_bit_cast(bf16x8, pr); bim[gg][sh] = __builtin_bit_cast(bf16x8, pi);
            if (gg == hi) { abr[sh] = ar_; abi[sh] = ai_; dtr[sh] = dtar; dti[sh] = dtai; }
        }
    }
}
__device__ __forceinline__ void s5_pass1_unit(const Args& a, unsigned char* lds, int layer, int b, int c) {
    int tid = threadIdx.x; asm volatile("" : "+v"(tid));
    const int lane = tid & 63, w = __builtin_amdgcn_readfirstlane(tid >> 6), qi = lane & 31, hi = lane >> 5;
    const bf16_t* su = (const bf16_t*)(a.ws + WS_SU) + ((size_t)b * S + c * S5_TC) * 256;
    float* sst = (float*)(a.ws + WS_SST);
    const int ag = (qi >> 2) & 1;
    const bf16_t* aup = su + (size_t)(4 * (qi >> 3) + (qi & 3)) * 256 + 32 * w + 16 * ag + 8 * hi;
    u32x4 an = *(const u32x4*)aup;
    bf16x8 bre[2][2], bim[2][2]; float abr[2], abi[2], dtr[2], dti[2];
    s5_wave_operands_v82(a, layer, w, qi, hi, bre, bim, abr, abi, dtr, dti);
    float xr[2] = {0.f, 0.f}, xi[2] = {0.f, 0.f};
#pragma unroll
    for (int blk = 0; blk < 4; ++blk) {
        const u32x4 zero4 = (u32x4){0u, 0u, 0u, 0u};
        const bf16x8 a1 = __builtin_bit_cast(bf16x8, ag ? zero4 : an), a2 = __builtin_bit_cast(bf16x8, ag ? an : zero4);
        if (blk < 3) an = *(const u32x4*)(aup + (size_t)(blk + 1) * 16 * 256);
        f32x16 dre[2], dim[2];
#pragma unroll
        for (int sh = 0; sh < 2; ++sh) {
            dre[sh] = S5_MFMA32(a1, bre[0][sh], (f32x16){}); dre[sh] = S5_MFMA32(a2, bre[1][sh], dre[sh]);
            dim[sh] = S5_MFMA32(a1, bim[0][sh], (f32x16){}); dim[sh] = S5_MFMA32(a2, bim[1][sh], dim[sh]);
        }
#pragma unroll
        for (int tt = 0; tt < 16; ++tt)
#pragma unroll
            for (int sh = 0; sh < 2; ++sh) {
                const float nxr = abr[sh] * xr[sh] - abi[sh] * xi[sh] + dre[sh][tt], nxi = abr[sh] * xi[sh] + abi[sh] * xr[sh] + dim[sh][tt];
                xr[sh] = nxr; xi[sh] = nxi;
            }
    }
    float* sp = sst + (((size_t)b * 16 + 2 * w + hi) * S5_NCH + c) * 128;
#pragma unroll
    for (int sh = 0; sh < 2; ++sh) { sp[qi + 32 * sh] = xr[sh]; sp[64 + qi + 32 * sh] = xi[sh]; }
}
constexpr int P3_XS = 0, P3_XS_W = 2 * 16 * 272, P3_GS = 8 * P3_XS_W, P3_GS_P = 528, P3_US = P3_GS + 64 * P3_GS_P, P3_END = P3_US + 8 * 2048;
__device__ __forceinline__ void s5_pass2_unit(const Args& a, unsigned char* lds, int layer, int b, int seg) {
    int tid = threadIdx.x; asm volatile("" : "+v"(tid));
    const int lane = tid & 63, w = __builtin_amdgcn_readfirstlane(tid >> 6);
    const int qi = lane & 31, hi = lane >> 5, l15 = lane & 15, kg = lane >> 4;
    const bf16_t* su = (const bf16_t*)(a.ws + WS_SU) + ((size_t)b * S + seg * 256) * 256;
    const float* sst = (const float*)(a.ws + WS_SST);
    bf16x8 bre[2][2], bim[2][2]; float abr[2], abi[2], xr[2], xi[2]; bf16x8 cm[2][4]; f32x4 dsk[2];
    {
        f32x4 ab[2];
        s5_wave_operands(a, layer, w, qi, hi, bre, bim, ab);
        float cr2[2] = {0.f, 0.f}, ci2[2] = {0.f, 0.f};
#pragma unroll
        for (int sh = 0; sh < 2; ++sh) { abr[sh] = ab[sh][0]; abi[sh] = ab[sh][1]; }
        const float* sp = sst + (((size_t)b * 16 + 2 * w + hi) * S5_NCH) * 128 + qi;
        const int nprev = 4 * seg;
        int j0 = 0;
        for (; j0 + 8 <= nprev; j0 += 8) {
            float sr[2][8], si[2][8];
#pragma unroll
            for (int u = 0; u < 8; ++u)
#pragma unroll
                for (int sh = 0; sh < 2; ++sh) { sr[sh][u] = sp[(size_t)(j0 + u) * 128 + 32 * sh]; si[sh][u] = sp[(size_t)(j0 + u) * 128 + 64 + 32 * sh]; }
#pragma unroll
            for (int u = 0; u < 8; ++u)
#pragma unroll
                for (int sh = 0; sh < 2; ++sh) { const float t0 = ab[sh][2] * cr2[sh] - ab[sh][3] * ci2[sh] + sr[sh][u], t1 = ab[sh][2] * ci2[sh] + ab[sh][3] * cr2[sh] + si[sh][u]; cr2[sh] = t0; ci2[sh] = t1; }
        }
        if (j0 < nprev) {
            float sr[2][4], si[2][4];
#pragma unroll
            for (int u = 0; u < 4; ++u)
#pragma unroll
                for (int sh = 0; sh < 2; ++sh) { sr[sh][u] = sp[(size_t)(j0 + u) * 128 + 32 * sh]; si[sh][u] = sp[(size_t)(j0 + u) * 128 + 64 + 32 * sh]; }
#pragma unroll
            for (int u = 0; u < 4; ++u)
#pragma unroll
                for (int sh = 0; sh < 2; ++sh) { const float t0 = ab[sh][2] * cr2[sh] - ab[sh][3] * ci2[sh] + sr[sh][u], t1 = ab[sh][2] * ci2[sh] + ab[sh][3] * cr2[sh] + si[sh][u]; cr2[sh] = t0; ci2[sh] = t1; }
        }
#pragma unroll
        for (int sh = 0; sh < 2; ++sh) { xr[sh] = cr2[sh]; xi[sh] = ci2[sh]; }
    }
#pragma unroll
    for (int gg = 0; gg < 2; ++gg) {
        const int g = 2 * w + gg, lg = layer * 16 + g;
        const float* crp = a.in[20] + ((size_t)lg * 16 + l15) * 64; const float* cip = a.in[21] + ((size_t)lg * 16 + l15) * 64;
#pragma unroll
        for (int ks = 0; ks < 4; ++ks) {
            const int k0 = 32 * ks + 8 * kg;
            float v[8];
#pragma unroll
            for (int j = 0; j < 8; ++j) v[j] = (k0 < 64) ? crp[k0 + j] : -cip[k0 - 64 + j];
            u32x4 pw; pw.x = pk2(v[0], v[1]); pw.y = pk2(v[2], v[3]); pw.z = pk2(v[4], v[5]); pw.w = pk2(v[6], v[7]);
            cm[gg][ks] = __builtin_bit_cast(bf16x8, pw);
        }
        dsk[gg] = *(const f32x4*)(a.in[22] + lg * 16 + 4 * kg);
    }
    unsigned char* xs = lds + P3_XS + w * P3_XS_W;
    const bf16_t* gluT = (const bf16_t*)(a.ws + WS_GLU) + (size_t)layer * 65536;
    const float* glub = a.in[24] + layer * 256;
    bf16_t* mix = (bf16_t*)(a.ws + WS_MIX) + ((size_t)b * S + seg * 256) * D + 768;
    LAS3 float* ul = (LAS3 float*)(LAS3 unsigned char*)(lds + P3_US + w * 2048);
    const int utq = lane >> 3, ucc = lane & 7;
    const bf16_t* sup = su + (size_t)utq * 256 + 32 * w + 4 * ucc;
    u32x2 un0 = *(const u32x2*)(sup), un1 = *(const u32x2*)(sup + (size_t)8 * 256);
    const int ag = (qi >> 2) & 1;
    const bf16_t* aup = su + (size_t)(4 * (qi >> 3) + (qi & 3)) * 256 + 32 * w + 16 * ag + 8 * hi;
    u32x4 an = *(const u32x4*)aup;
#define S5_UNPK(v) (f32x4){__uint_as_float((v).x << 16), __uint_as_float((v).x & 0xffff0000u), __uint_as_float((v).y << 16), __uint_as_float((v).y & 0xffff0000u)}
    for (int sub = 0; sub < 4; ++sub) {
        for (int blk = 0; blk < 4; ++blk) {
            const int t0 = sub * 64 + blk * 16;
            *(LAS3 f32x4*)(ul + utq * 32 + 4 * ucc) = S5_UNPK(un0); *(LAS3 f32x4*)(ul + (8 + utq) * 32 + 4 * ucc) = S5_UNPK(un1);
            if (t0 + 16 < 256) { un0 = *(const u32x2*)(sup + (size_t)(t0 + 16) * 256); un1 = *(const u32x2*)(sup + (size_t)(t0 + 24) * 256); }
            {
                const u32x4 zero4 = (u32x4){0u, 0u, 0u, 0u};
                const bf16x8 a1 = __builtin_bit_cast(bf16x8, ag ? zero4 : an), a2 = __builtin_bit_cast(bf16x8, ag ? an : zero4);
                if (t0 + 16 < 256) an = *(const u32x4*)(aup + (size_t)(t0 + 16) * 256);
                f32x16 dre[2], dim[2];
#pragma unroll
                for (int sh = 0; sh < 2; ++sh) {
                    dre[sh] = MFMA32(a1, bre[0][sh], (f32x16){}); dre[sh] = MFMA32(a2, bre[1][sh], dre[sh]);
                    dim[sh] = MFMA32(a1, bim[0][sh], (f32x16){}); dim[sh] = MFMA32(a2, bim[1][sh], dim[sh]);
                }
                bf16_t* xp0 = (bf16_t*)(xs + hi * (16 * 272));
#pragma unroll
                for (int tt = 0; tt < 16; ++tt) {
#pragma unroll
                    for (int sh = 0; sh < 2; ++sh) {
                        const float nxr = abr[sh] * xr[sh] - abi[sh] * xi[sh] + dre[sh][tt], nxi = abr[sh] * xi[sh] + abi[sh] * xr[sh] + dim[sh][tt];
                        xr[sh] = nxr; xi[sh] = nxi;
                        bf16_t* xp = xp0 + tt * 136;
                        xp[qi + 32 * sh] = f2bf(nxr); xp[64 + qi + 32 * sh] = f2bf(nxi);
                    }
                }
            }
#pragma unroll
            for (int gg = 0; gg < 2; ++gg) {
                const int g = 2 * w + gg;
                f32x4 acc = (f32x4){0.f, 0.f, 0.f, 0.f};
#pragma unroll
                for (int ks = 0; ks < 4; ++ks) { const bf16x8 bfr = *(const bf16x8*)(xs + gg * (16 * 272) + l15 * 272 + (32 * ks + 8 * kg) * 2); acc = __builtin_amdgcn_mfma_f32_16x16x32_bf16(cm[gg][ks], bfr, acc, 0, 0, 0); }
                const f32x4 uu = *(const LAS3 f32x4*)(ul + l15 * 32 + 16 * gg + 4 * kg);
                u32x2 gw; gw.x = pk2(gelu_tanh(acc[0] + dsk[gg][0] * uu[0]), gelu_tanh(acc[1] + dsk[gg][1] * uu[1])); gw.y = pk2(gelu_tanh(acc[2] + dsk[gg][2] * uu[2]), gelu_tanh(acc[3] + dsk[gg][3] * uu[3]));
                *(u32x2*)(lds + P3_GS + (blk * 16 + l15) * P3_GS_P + (g * 16 + 4 * kg) * 2) = gw;
            }
        }
        __syncthreads();
#pragma unroll
        for (int tb = 0; tb < 2; ++tb) {
            f32x16 acc = (f32x16){};
#pragma unroll
            for (int ks = 0; ks < 16; ++ks) {
                const bf16x8 af = *(const bf16x8*)(gluT + (size_t)(32 * w + qi) * 256 + 16 * ks + 8 * hi);
                const bf16x8 bfr = *(const bf16x8*)(lds + P3_GS + (32 * tb + qi) * P3_GS_P + (16 * ks + 8 * hi) * 2);
                acc = MFMA32(af, bfr, acc);
            }
#pragma unroll
            for (int r4 = 0; r4 < 4; ++r4) {
                const int nn = 32 * w + 8 * r4 + 4 * hi;
                const u32x2 gq = *(const u32x2*)(lds + P3_GS + (32 * tb + qi) * P3_GS_P + nn * 2);
                const f32x4 bb = *(const f32x4*)(glub + nn);
                float ov[4];
#pragma unroll
                for (int e = 0; e < 4; ++e) {
                    const float gval = __uint_as_float(((e & 1) ? (((e >> 1) ? gq.y : gq.x) & 0xffff0000u) : (((e >> 1) ? gq.y : gq.x) << 16)));
                    ov[e] = gval / (1.f + __expf(-(acc[4 * r4 + e] + bb[e])));
                }
                u32x2 ow; ow.x = pk2(ov[0], ov[1]); ow.y = pk2(ov[2], ov[3]);
                *(u32x2*)(mix + (size_t)(sub * 64 + 32 * tb + qi) * D + nn) = ow;
            }
        }
        __syncthreads();
    }
}
__device__ __forceinline__ void phase_p3_elementwise(const Args& a, int layer) {
    const size_t gt = (size_t)blockIdx.x * NTHR + threadIdx.x, gn = (size_t)gridDim.x * NTHR;
    const bf16_t* dp = (const bf16_t*)(a.ws + WS_DPART); const float* dl = (const float*)(a.ws + WS_DLSE); bf16_t* mix = (bf16_t*)(a.ws + WS_MIX);
    for (size_t i = gt; i < (size_t)T * 32; i += gn) {
        const size_t tok = i >> 5; const int ch = (int)(i & 31), h = ch >> 3;
        const float l0 = dl[tok * 4 + h], l1 = dl[((size_t)T + tok) * 4 + h], l2 = dl[((size_t)2 * T + tok) * 4 + h];
        const float mx = fmaxf(l0, fmaxf(l1, l2));
        float w0 = __builtin_amdgcn_exp2f(l0 - mx), w1 = __builtin_amdgcn_exp2f(l1 - mx), w2 = __builtin_amdgcn_exp2f(l2 - mx);
        const float inv = 1.f / (w0 + w1 + w2); w0 *= inv; w1 *= inv; w2 *= inv;
        const u32x4 a0 = *(const u32x4*)(dp + tok * 256 + ch * 8), a1 = *(const u32x4*)(dp + ((size_t)T + tok) * 256 + ch * 8), a2 = *(const u32x4*)(dp + ((size_t)2 * T + tok) * 256 + ch * 8);
        u32x4 o;
#pragma unroll
        for (int j = 0; j < 4; ++j) {
            const float lo = w0 * __uint_as_float(a0[j] << 16) + w1 * __uint_as_float(a1[j] << 16) + w2 * __uint_as_float(a2[j] << 16);
            const float hi = w0 * __uint_as_float(a0[j] & 0xffff0000u) + w1 * __uint_as_float(a1[j] & 0xffff0000u) + w2 * __uint_as_float(a2[j] & 0xffff0000u);
            o[j] = pk2(lo, hi);
        }
        *(u32x4*)(mix + tok * D + 256 + ch * 8) = o;
    }
    {
        const int lane = threadIdx.x & 63, wv = blockIdx.x * 8 + (threadIdx.x >> 6), nw = gridDim.x * 8;
        const float* pu = a.in[27] + (size_t)layer * NEXP * D; const float* pv = a.in[28] + (size_t)layer * NEXP * D; const float* gn_ = a.in[5] + layer * D;
        unsigned char* ut = a.ws + WS_UT; unsigned char* vt = a.ws + WS_VT; float* us = (float*)(a.ws + WS_US); float* vs = (float*)(a.ws + WS_VS);
        float g[16]; load_row16(gn_, lane, g);
        for (int r = wv; r < 2 * NEXP; r += nw) {
            const bool isv = r >= NEXP; const int e = isv ? r - NEXP : r;
            float v[16]; load_row16((isv ? pv : pu) + (size_t)e * D, lane, v);
            float sq = 0.f;
#pragma unroll
            for (int i = 0; i < 16; ++i) { if (!isv) v[i] *= g[i]; sq += v[i] * v[i]; }
            sq = wave_sum(sq);
            const float sc = sq > 0.f ? 0.35f * sqrtf(sq * (1.f / 1024.f)) : 1.f, inv = 1.f / sc;
            u32x2 w;
#pragma unroll
            for (int j = 0; j < 2; ++j) {
                unsigned pk = 0u;
#pragma unroll
                for (int i = 0; i < 8; ++i) { int q = (int)rintf(v[8 * j + i] * inv); q = q > 7 ? 7 : (q < -7 ? -7 : q);
                    pk |= ((unsigned)(isv && (i < 4 || !HK_PEER_SPLIT) ? q + 8 : q) & 0xfu) << (i < 4 ? 8 * i : 8 * (i - 4) + 4); }
                w[j] = pk;
            }
            *(u32x2*)((isv ? vt : ut) + (size_t)e * 512 + 8 * lane) = w;
            if (lane == 0) (isv ? vs : us)[e] = isv || HK_PEER_SPLIT ? sc : sc * (1.f / 16.f);
        }
    }
}

__device__ __forceinline__ unsigned srt(float f) { const unsigned u = __float_as_uint(f); return u ^ ((unsigned)((int)u >> 31) | 0x80000000u); }
__device__ __forceinline__ float unsrt(unsigned u) { return __uint_as_float(u ^ ((~(unsigned)((int)u >> 31)) | 0x80000000u)); }
#define CEX(a, b) do { const unsigned x_ = (a), y_ = (b); (a) = x_ > y_ ? x_ : y_; (b) = x_ > y_ ? y_ : x_; } while (0)
__device__ __forceinline__ void bitonic_merge16(unsigned (&v)[16]) {
#pragma unroll
    for (int d = 8; d >= 1; d >>= 1)
#pragma unroll
        for (int i = 0; i < 16; ++i) if ((i & d) == 0) CEX(v[i], v[i + d]);
}
__device__ __forceinline__ void sort16_desc(unsigned (&v)[16]) {
    CEX(v[0], v[13]); CEX(v[1], v[12]); CEX(v[2], v[15]); CEX(v[3], v[14]); CEX(v[4], v[8]); CEX(v[5], v[6]); CEX(v[7], v[11]); CEX(v[9], v[10]);
    CEX(v[0], v[5]); CEX(v[1], v[7]); CEX(v[2], v[9]); CEX(v[3], v[4]); CEX(v[6], v[13]); CEX(v[8], v[14]); CEX(v[10], v[15]); CEX(v[11], v[12]);
    CEX(v[0], v[1]); CEX(v[2], v[3]); CEX(v[4], v[5]); CEX(v[6], v[8]); CEX(v[7], v[9]); CEX(v[10], v[11]); CEX(v[12], v[13]); CEX(v[14], v[15]);
    CEX(v[0], v[2]); CEX(v[1], v[3]); CEX(v[4], v[10]); CEX(v[5], v[11]); CEX(v[6], v[7]); CEX(v[8], v[9]); CEX(v[12], v[14]); CEX(v[13], v[15]);
    CEX(v[1], v[2]); CEX(v[3], v[12]); CEX(v[4], v[6]); CEX(v[5], v[7]); CEX(v[8], v[10]); CEX(v[9], v[11]); CEX(v[13], v[14]);
    CEX(v[1], v[4]); CEX(v[2], v[6]); CEX(v[5], v[8]); CEX(v[7], v[10]); CEX(v[9], v[13]); CEX(v[11], v[14]);
    CEX(v[2], v[4]); CEX(v[3], v[6]); CEX(v[9], v[12]); CEX(v[11], v[13]);
    CEX(v[3], v[5]); CEX(v[6], v[8]); CEX(v[7], v[9]); CEX(v[10], v[12]);
    CEX(v[3], v[4]); CEX(v[5], v[6]); CEX(v[7], v[8]); CEX(v[9], v[10]); CEX(v[11], v[12]);
    CEX(v[6], v[7]); CEX(v[8], v[9]);
}
__device__ __forceinline__ void merge_top16(unsigned (&a)[16], const unsigned (&b)[16]) {
#pragma unroll
    for (int j = 0; j < 16; ++j) a[j] = a[j] > b[15 - j] ? a[j] : b[15 - j];
    bitonic_merge16(a);
}
__device__ __forceinline__ void ins16(unsigned (&top)[16], unsigned pk) {
#pragma unroll
    for (int j = 0; j < 16; ++j) { const unsigned hi_ = top[j] > pk ? top[j] : pk; pk = top[j] > pk ? pk : top[j]; top[j] = hi_; }
}
__device__ __forceinline__ void merge_halves(unsigned (&top)[16]) {
    unsigned lo[16], hi[16];
#pragma unroll
    for (int j = 0; j < 16; ++j) { auto rr = __builtin_amdgcn_permlane32_swap(top[j], top[j], false, false); lo[j] = rr[0]; hi[j] = rr[1]; }
#pragma unroll
    for (int j = 0; j < 16; ++j) top[j] = lo[j] > hi[15 - j] ? lo[j] : hi[15 - j];
#pragma unroll
    for (int d = 8; d >= 1; d >>= 1)
#pragma unroll
        for (int i = 0; i < 16; ++i) if ((i & d) == 0) { const unsigned x = top[i], y = top[i + d]; top[i] = x > y ? x : y; top[i + d] = x > y ? y : x; }
}
constexpr int P6_PL = 0, P6_RS = 32768, P6_DOT = 32768 + 128, P6_LST = P6_DOT + 8 * 1024, P6_END = P6_LST + 8 * 8192;
__device__ __forceinline__ float dot8(const u32x4& a, const unsigned (&xh)[4], float acc) {
#pragma unroll
    for (int j = 0; j < 4; ++j) { acc += __uint_as_float(a[j] << 16) * __uint_as_float(xh[j] << 16); acc += __uint_as_float(a[j] & 0xffff0000u) * __uint_as_float(xh[j] & 0xffff0000u); }
    return acc;
}
__device__ __forceinline__ void peer_unit(const Args& a, unsigned char* lds, int layer, int unit) {
    int tid = threadIdx.x; asm volatile("" : "+v"(tid));
    const int lane = tid & 63, w = __builtin_amdgcn_readfirstlane(tid >> 6), qi = lane & 31, hi = lane >> 5;
    const int tok0 = unit * 32;
#if defined(HK_PROBE_PHASE) && HK_PROBE_PHASE == 10
    unsigned long long pq0_ = 0; if (blockIdx.x == 0 && threadIdx.x == 0) pq0_ = __builtin_amdgcn_s_memrealtime();
#endif
    const bf16_t* xg = (const bf16_t*)(a.ws + WS_XB);
    float* rsl = (float*)(lds + P6_RS);
    {
        u32x4 xr[4][2];
#pragma unroll
        for (int tt = 0; tt < 4; ++tt) { const bf16_t* p = xg + (size_t)(tok0 + 4 * w + tt) * D + 16 * lane; xr[tt][0] = *(const u32x4*)p; xr[tt][1] = *(const u32x4*)(p + 8); }
#pragma unroll
        for (int tt = 0; tt < 4; ++tt) {
            float ss = 0.f;
#pragma unroll
            for (int j = 0; j < 2; ++j)
#pragma unroll
                for (int e = 0; e < 4; ++e) { const float lo = __uint_as_float(xr[tt][j][e] << 16), hi_ = __uint_as_float(xr[tt][j][e] & 0xffff0000u); ss += lo * lo + hi_ * hi_; }
            ss = wave_sum(ss);
            if (lane == 0) rsl[4 * w + tt] = __builtin_amdgcn_rsqf(ss * (1.f / 1024.f) + EPS);
        }
    }
    __syncthreads();
    {
        const float rs2 = rsl[qi];
        const bf16_t* qrow = (const bf16_t*)(a.ws + WS_ZB) + (size_t)(tok0 + qi) * 2048 + 256 * w;
        const bf16_t* kb_ = (const bf16_t*)(a.ws + WS_KEYS) + (size_t)(layer * 16 + 2 * w) * 128 * 128;
        unsigned* lsw = (unsigned*)(lds + P6_LST) + w * 2048 + lane;
#if HK_FOLD_KEYS
        const bf16_t* srow = (const bf16_t*)(a.ws + WS_ZB) + (size_t)(tok0 + qi) * 2048 + 256 * w + 64 * hi;
        u32x4 sv[2][8];
#pragma unroll
        for (int p = 0; p < 2; ++p)
#pragma unroll
            for (int j = 0; j < 8; ++j) sv[p][j] = *(const u32x4*)(srow + 128 * p + 8 * j);
#pragma unroll
        for (int p = 0; p < 2; ++p) {
            unsigned top[16];
#pragma unroll
            for (int kb = 0; kb < 4; ++kb) {
                unsigned cur[16];
#pragma unroll
                for (int j = 0; j < 2; ++j)
#pragma unroll
                    for (int e = 0; e < 4; ++e) {
                        const unsigned wd = sv[p][2 * kb + j][e];
                        const unsigned lo = wd & 0xffffu, hi16 = wd >> 16;
                        const unsigned slo = lo ^ ((lo & 0x8000u) ? 0xffffu : 0x8000u), shi = hi16 ^ ((hi16 & 0x8000u) ? 0xffffu : 0x8000u);
                        const unsigned idx = (unsigned)(64 * hi + 16 * kb + 8 * j + 2 * e);
                        cur[8 * j + 2 * e] = (slo << 16) | idx; cur[8 * j + 2 * e + 1] = (shi << 16) | (idx + 1u);
                    }
                sort16_desc(cur);
                if (kb == 0) {
#pragma unroll
                    for (int j = 0; j < 16; ++j) top[j] = cur[j];
                } else merge_top16(top, cur);
            }
            merge_halves(top);
#pragma unroll
            for (int j = 0; j < 16; ++j) { const unsigned s16 = top[j] >> 16; const unsigned hb = s16 ^ ((s16 & 0x8000u) ? 0x8000u : 0xffffu);
                const _Float16 hv = __builtin_bit_cast(_Float16, (unsigned short)hb);
                lsw[(p * 16 + j) * 64] = (srt((float)hv) & ~127u) | (top[j] & 127u); }
        }
#else
        bf16x8 qf2[2][8];
#pragma unroll
        for (int p = 0; p < 2; ++p)
#pragma unroll
            for (int ks = 0; ks < 8; ++ks) qf2[p][ks] = *(const bf16x8*)(qrow + 128 * p + 16 * ks + 8 * hi);
#pragma unroll
        for (int p = 0; p < 2; ++p) {
            const bf16x8 (&qf)[8] = qf2[p];
            unsigned top[16];
            bf16x8 kfn[8];
#pragma unroll
            for (int ks = 0; ks < 8; ++ks) kfn[ks] = *(const bf16x8*)(kb_ + ((size_t)p * 128 + qi) * 128 + 16 * ks + 8 * hi);
#pragma unroll 1
            for (int kb = 0; kb < 4; ++kb) {
                f32x16 acc = (f32x16){};
#pragma unroll
                for (int ks = 0; ks < 8; ++ks) acc = MFMA32(kfn[ks], qf[ks], acc);
                if (kb < 3) {
#pragma unroll
                    for (int ks = 0; ks < 8; ++ks) kfn[ks] = *(const bf16x8*)(kb_ + ((size_t)p * 128 + 32 * (kb + 1) + qi) * 128 + 16 * ks + 8 * hi);
                }
                unsigned cur[16];
#pragma unroll
                for (int r = 0; r < 16; ++r) cur[r] = (srt(acc[r]) & ~127u) | (unsigned)(32 * kb + (r & 3) + 8 * (r >> 2) + 4 * hi);
                sort16_desc(cur);
                if (kb == 0) {
#pragma unroll
                    for (int j = 0; j < 16; ++j) top[j] = cur[j];
                } else merge_top16(top, cur);
            }
            merge_halves(top);
#pragma unroll
            for (int j = 0; j < 16; ++j) lsw[(p * 16 + j) * 64] = top[j];
        }
#endif
        unsigned best[16];
#pragma unroll
        for (int j = 0; j < 16; ++j) best[j] = 0u;
#pragma unroll 1
        for (int i = hi; i < 16; i += 2) {
            const unsigned ai = lsw[i * 64]; const float vai = unsrt(ai & ~127u); const unsigned iai = (ai & 127u) << 7;
            const int nj = 16 / (i + 1);
#pragma unroll 1
            for (int j = 0; j < nj; ++j) { const unsigned bj = lsw[(16 + j) * 64]; ins16(best, (srt(vai + unsrt(bj & ~127u)) & ~0x3FFFu) | iai | (bj & 127u)); }
        }
        merge_halves(best);
        float e[16], sum = 0.f;
        const float s0 = unsrt(best[0] & ~0x3FFFu);
#pragma unroll
        for (int j = 0; j < 16; ++j) { e[j] = __builtin_amdgcn_exp2f((unsrt(best[j] & ~0x3FFFu) - s0) * rs2 * LOG2E); sum += e[j]; }
        const float inv = 1.f / sum;
        if (hi == 0) {
            u32x2* pl = (u32x2*)(lds + P6_PL) + qi * 128 + 16 * w;
#pragma unroll
            for (int j = 0; j < 16; ++j) { u32x2 en; en.x = best[j] & 0x3FFFu; en.y = __float_as_uint(e[j] * inv); pl[j] = en; }
        }
    }
    __syncthreads();
#if defined(HK_PROBE_PHASE) && HK_PROBE_PHASE == 10
    if (blockIdx.x == 0 && threadIdx.x == 0) { volatile LAS3 unsigned* pw_ = (volatile LAS3 unsigned*)(LAS3 unsigned char*)(lds + LDS_CTL + 48); *pw_ = *pw_ + (unsigned)(__builtin_amdgcn_s_memrealtime() - pq0_); }
#endif
    const unsigned char* ut = a.ws + WS_UT; const unsigned char* vt = a.ws + WS_VT; const float* us = (const float*)(a.ws + WS_US); const float* vs = (const float*)(a.ws + WS_VS);
    float* dots = (float*)(lds + P6_DOT) + w * 256; float* cfs = dots + 128;
    int vz_; asm volatile("v_mov_b32 %0, 0" : "=v"(vz_));
    const int lane_g = lane + vz_, hi_g = lane_g >> 5;
    const int c32 = lane_g & 31, slot = 2 * c32 + hi_g;
#define PG_ISSUE(buf, tab, plp, b) do { _Pragma("unroll") for (int kk = 0; kk < 8; ++kk) { const unsigned id_ = (plp)[16 * (b) + 8 * hi_g + kk].x; buf[kk] = *(const u32x4*)((tab) + (unsigned)(id_ * 512u + 16u * (unsigned)c32)); } } while (0)
#define PG_CU(buf, b) do { int pd_[8]; \
        _Pragma("unroll") for (int kk = 0; kk < 8; ++kk) { int d_ = 0; \
            _Pragma("unroll") for (int j = 0; j < 4; ++j) { d_ = __builtin_amdgcn_sdot4((int)((buf[kk][j] << 4) & 0xF0F0F0F0u), xq[2 * j], d_, false); d_ = __builtin_amdgcn_sdot4((int)(buf[kk][j] & 0xF0F0F0F0u), xq[2 * j + 1], d_, false); } \
            pd_[kk] = d_; } \
        int r4_[4]; \
        _Pragma("unroll") for (int j = 0; j < 4; ++j) { auto rr_ = __builtin_amdgcn_permlane16_swap((unsigned)pd_[j], (unsigned)pd_[j + 4], false, false); r4_[j] = (int)rr_[0] + (int)rr_[1]; } \
        _Pragma("unroll") for (int j = 0; j < 4; ++j) { int v_ = r4_[j]; \
            v_ += __builtin_amdgcn_update_dpp(0, v_, 0xB1, 0xf, 0xf, true); v_ += __builtin_amdgcn_update_dpp(0, v_, 0x4E, 0xf, 0xf, true); \
            v_ += __builtin_amdgcn_update_dpp(0, v_, 0x141, 0xf, 0xf, true); v_ += __builtin_amdgcn_update_dpp(0, v_, 0x140, 0xf, 0xf, true); r4_[j] = v_; } \
        if ((lane_g & 15) == 0) { const int q_ = lane_g >> 4; *(f32x4*)(dots + 16 * (b) + 8 * (q_ >> 1) + 4 * (q_ & 1)) = (f32x4){(float)r4_[0], (float)r4_[1], (float)r4_[2], (float)r4_[3]}; } } while (0)
#define PG_T4(r0, r1, r2, r3, t0, t1, t2, t3) do { const unsigned a01l_ = __builtin_amdgcn_perm(r1, r0, 0x05010400u), a01h_ = __builtin_amdgcn_perm(r1, r0, 0x07030602u), \
            a23l_ = __builtin_amdgcn_perm(r3, r2, 0x05010400u), a23h_ = __builtin_amdgcn_perm(r3, r2, 0x07030602u); \
        t0 = __builtin_amdgcn_perm(a23l_, a01l_, 0x05040100u); t1 = __builtin_amdgcn_perm(a23l_, a01l_, 0x07060302u); \
        t2 = __builtin_amdgcn_perm(a23h_, a01h_, 0x05040100u); t3 = __builtin_amdgcn_perm(a23h_, a01h_, 0x07060302u); } while (0)
#define PG_CV(buf, b) do { _Pragma("unroll") for (int g4 = 0; g4 < 2; ++g4) { const int cq_ = (int)cqw[4 * (b) + 2 * hi_g + g4]; \
            _Pragma("unroll") for (int j = 0; j < 4; ++j) { \
                const unsigned w0_ = buf[4 * g4][j], w1_ = buf[4 * g4 + 1][j], w2_ = buf[4 * g4 + 2][j], w3_ = buf[4 * g4 + 3][j]; \
                unsigned t0_, t1_, t2_, t3_; \
                PG_T4(w0_ & 0x0F0F0F0Fu, w1_ & 0x0F0F0F0Fu, w2_ & 0x0F0F0F0Fu, w3_ & 0x0F0F0F0Fu, t0_, t1_, t2_, t3_); \
                oa[8 * j + 0] = __builtin_amdgcn_sdot4((int)t0_, cq_, oa[8 * j + 0], false); oa[8 * j + 1] = __builtin_amdgcn_sdot4((int)t1_, cq_, oa[8 * j + 1], false); \
                oa[8 * j + 2] = __builtin_amdgcn_sdot4((int)t2_, cq_, oa[8 * j + 2], false); oa[8 * j + 3] = __builtin_amdgcn_sdot4((int)t3_, cq_, oa[8 * j + 3], false); \
                PG_T4((w0_ >> 4) & 0x0F0F0F0Fu, (w1_ >> 4) & 0x0F0F0F0Fu, (w2_ >> 4) & 0x0F0F0F0Fu, (w3_ >> 4) & 0x0F0F0F0Fu, t0_, t1_, t2_, t3_); \
                oa[8 * j + 4] = __builtin_amdgcn_sdot4((int)t0_, cq_, oa[8 * j + 4], false); oa[8 * j + 5] = __builtin_amdgcn_sdot4((int)t1_, cq_, oa[8 * j + 5], false); \
                oa[8 * j + 6] = __builtin_amdgcn_sdot4((int)t2_, cq_, oa[8 * j + 6], false); oa[8 * j + 7] = __builtin_amdgcn_sdot4((int)t3_, cq_, oa[8 * j + 7], false); \
                asm volatile("" : "+v"(oa[8 * j]), "+v"(oa[8 * j + 1]), "+v"(oa[8 * j + 2]), "+v"(oa[8 * j + 3]), "+v"(oa[8 * j + 4]), "+v"(oa[8 * j + 5]), "+v"(oa[8 * j + 6]), "+v"(oa[8 * j + 7])); } } } while (0)
#define PG_SB __builtin_amdgcn_sched_barrier(0)
    u32x4 bA[8], bB[8];
    { const u32x2* pl0 = (const u32x2*)(lds + P6_PL) + (4 * w) * 128; PG_ISSUE(bA, ut, pl0, 0); }
    for (int tt = 0; tt < 4; ++tt) {
        const int tl = 4 * w + tt, tok = tok0 + tl;
        const float rs2 = rsl[tl];
        const u32x2* pl = (const u32x2*)(lds + P6_PL) + tl * 128;
        const u32x2 en0 = pl[lane_g], en1 = pl[64 + lane_g];
        const float us0 = us[en0.x], us1 = us[en1.x], vs0 = vs[en0.x], vs1 = vs[en1.x];
        float xv[16]; load_row16_bf(xg + (size_t)tok * D, slot, xv);
        float mx = 0.f;
#pragma unroll
        for (int i = 0; i < 16; ++i) mx = fmaxf(mx, fabsf(xv[i]));
#pragma unroll
        for (int o = 32; o > 0; o >>= 1) mx = fmaxf(mx, __shfl_xor(mx, o));
        const float sx = mx > 0.f ? mx * (1.f / 127.f) : 1.f, isx = 1.f / sx;
        int xq[8];
#pragma unroll
        for (int j = 0; j < 4; ++j) {
            unsigned pk = 0u;
#pragma unroll
            for (int i = 0; i < 4; ++i) { const int q = (int)rintf(xv[4 * j + i] * isx); pk |= ((unsigned)q & 0xffu) << (8 * i); }
            auto rr = __builtin_amdgcn_permlane32_swap(pk, pk, false, false);
            xq[j] = (int)rr[0]; xq[4 + j] = (int)rr[1];
        }
#pragma unroll
        for (int ub = 0; ub < 8; ub += 2) {
            PG_ISSUE(bB, ut, pl, ub + 1); PG_SB; PG_CU(bA, ub); PG_SB;
            if (ub + 2 < 8) PG_ISSUE(bA, ut, pl, ub + 2); else PG_ISSUE(bA, vt, pl, 0);
            PG_SB; PG_CU(bB, ub + 1); PG_SB;
        }
        const float a0 = gelu_tanh(dots[lane_g] * (sx * rs2) * us0) * __uint_as_float(en0.y);
        const float a1 = gelu_tanh(dots[64 + lane_g] * (sx * rs2) * us1) * __uint_as_float(en1.y);
        const float c0 = a0 * vs0, c1 = a1 * vs1;
        float cm = fmaxf(fabsf(c0), fabsf(c1));
#pragma unroll
        for (int o = 32; o > 0; o >>= 1) cm = fmaxf(cm, __shfl_xor(cm, o));
        const float scc = cm > 0.f ? cm * (1.f / 127.f) : 1.f, iscc = 1.f / scc;
        const int q0c = (int)rintf(c0 * iscc), q1c = (int)rintf(c1 * iscc);
        volatile LAS3 signed char* cqb = (volatile LAS3 signed char*)(LAS3 unsigned char*)cfs;
        cqb[lane_g] = (signed char)q0c; cqb[64 + lane_g] = (signed char)q1c;
        const LAS3 unsigned* cqw = (const LAS3 unsigned*)(LAS3 unsigned char*)cfs;
        int qsum = q0c + q1c;
#pragma unroll
        for (int o = 32; o > 0; o >>= 1) qsum += __shfl_xor(qsum, o);
        int oa[32];
#pragma unroll
        for (int i = 0; i < 32; ++i) oa[i] = 0;
        int vzv_; asm volatile("v_mov_b32 %0, 0" : "=v"(vzv_));
        const u32x2* plv = pl + vzv_;
#pragma unroll
        for (int vb = 0; vb < 8; vb += 2) {
            PG_ISSUE(bB, vt, plv, vb + 1); PG_SB; PG_CV(bA, vb); PG_SB;
            if (vb + 2 < 8) PG_ISSUE(bA, vt, plv, vb + 2); else if (tt < 3) PG_ISSUE(bA, ut, plv + 128, 0);
            PG_SB; PG_CV(bB, vb + 1); PG_SB;
        }
#pragma unroll
        for (int i = 0; i < 16; ++i) {
            auto rr = __builtin_amdgcn_permlane32_swap((unsigned)oa[i], (unsigned)oa[16 + i], false, false);
#ifndef HK_PROBE_NOPEER
            xv[i] += scc * (float)((int)rr[0] + (int)rr[1] - 8 * qsum);
#else
            xv[i] += 1e-30f * (float)((int)rr[0] + (int)rr[1]);
#endif
        }
#ifdef HK_PROBE_L2
        {
            int dsum = 0;
            for (int k = 0; k < 128; k += 32) {
                u32x4 ldx[16];
#pragma unroll
                for (int kk = 0; kk < 16; ++kk) { unsigned id = pl[k + 16 * hi_g + kk].x; if (HK_PROBE_L2 == 2) id &= 0x0FFFu; ldx[kk] = *(const u32x4*)(ut + (size_t)id * 512 + 16 * c32); }
#pragma unroll
                for (int kk = 0; kk < 16; ++kk) { dsum = __builtin_amdgcn_sdot4((int)ldx[kk].x, xq[0], dsum, false); dsum = __builtin_amdgcn_sdot4((int)ldx[kk].w, xq[1], dsum, false); }
            }
            xv[0] += 1e-30f * (float)dsum;
        }
#endif
        const bool more = layer + 1 < DEPTH;
        int vzt_; asm volatile("v_mov_b32 %0, 0" : "=v"(vzt_) : "v"(xv[0]));
        finish_token(tok, xv, more ? nullptr : a.out, (bf16_t*)(a.ws + WS_XB), (float*)(a.ws + WS_RSTD), more ? (const float*)(a.ws + WS_WF) + (size_t)(layer + 1) * 4096 : nullptr,
                     a.in[2] + (more ? (layer + 1) * 4 : 0), (float*)(a.ws + WS_FLOG), lane, slot + vzt_);
    }
#undef PG_ISSUE
#undef PG_SB
#undef PG_CU
#undef PG_CV
#undef PG_T4
    __syncthreads();
}
#if HK_FOLD_KEYS
__device__ __forceinline__ void peer_unit_a(const Args& a, unsigned char* lds, int layer, int unit) {
    int tid = threadIdx.x; asm volatile("" : "+v"(tid));
    const int lane = tid & 63, w = __builtin_amdgcn_readfirstlane(tid >> 6), qi = lane & 31, hi = lane >> 5;
    const int tok0 = unit * 32;
#if defined(HK_PROBE_PHASE) && HK_PROBE_PHASE == 10
    unsigned long long pq0_ = 0; if (blockIdx.x == 0 && threadIdx.x == 0) pq0_ = __builtin_amdgcn_s_memrealtime();
#endif
    const bf16_t* xg = (const bf16_t*)(a.ws + WS_XB);
    float* rsl = (float*)(lds + P6_RS);
    {
        u32x4 xr[4][2];
#pragma unroll
        for (int tt = 0; tt < 4; ++tt) { const bf16_t* p = xg + (size_t)(tok0 + 4 * w + tt) * D + 16 * lane; xr[tt][0] = *(const u32x4*)p; xr[tt][1] = *(const u32x4*)(p + 8); }
#pragma unroll
        for (int tt = 0; tt < 4; ++tt) {
            float ss = 0.f;
#pragma unroll
            for (int j = 0; j < 2; ++j)
#pragma unroll
                for (int e = 0; e < 4; ++e) { const float lo = __uint_as_float(xr[tt][j][e] << 16), hi_ = __uint_as_float(xr[tt][j][e] & 0xffff0000u); ss += lo * lo + hi_ * hi_; }
            ss = wave_sum(ss);
            if (lane == 0) rsl[4 * w + tt] = __builtin_amdgcn_rsqf(ss * (1.f / 1024.f) + EPS);
        }
    }
    const int tl_r = 4 * w + (qi >> 3), hd = qi & 7;
    {
        const float rs2 = rsl[tl_r];
        unsigned* lsw = (unsigned*)(lds + P6_LST) + w * 2048 + lane;
#if HK_FOLD_KEYS
        const bf16_t* srow = (const bf16_t*)(a.ws + WS_ZB) + (size_t)(tok0 + tl_r) * 2048 + 256 * hd + 64 * hi;
        u32x4 sv[2][8];
#pragma unroll
        for (int p = 0; p < 2; ++p)
#pragma unroll
            for (int j = 0; j < 8; ++j) sv[p][j] = *(const u32x4*)(srow + 128 * p + 8 * j);
#pragma unroll
        for (int p = 0; p < 2; ++p) {
            unsigned top[16];
#pragma unroll
            for (int kb = 0; kb < 4; ++kb) {
                unsigned cur[16];
#pragma unroll
                for (int j = 0; j < 2; ++j)
#pragma unroll
                    for (int e = 0; e < 4; ++e) {
                        const unsigned wd = sv[p][2 * kb + j][e];
                        typedef short s16x2_ __attribute__((ext_vector_type(2)));
                        const s16x2_ sg = __builtin_bit_cast(s16x2_, wd) >> 15;
                        const unsigned k2 = wd ^ ((__builtin_bit_cast(unsigned, sg) & 0x7fff7fffu) | 0x80008000u);
                        const unsigned idx = (unsigned)(64 * hi + 16 * kb + 8 * j + 2 * e);
                        cur[8 * j + 2 * e] = (k2 << 16) | idx; cur[8 * j + 2 * e + 1] = (k2 & 0xffff0000u) | (idx + 1u);
                    }
                sort16_desc(cur);
                if (kb == 0) {
#pragma unroll
                    for (int j = 0; j < 16; ++j) top[j] = cur[j];
                } else merge_top16(top, cur);
            }
            merge_halves(top);
#pragma unroll
            for (int j = 0; j < 16; ++j) { const unsigned s16 = top[j] >> 16; const unsigned hb = s16 ^ ((s16 & 0x8000u) ? 0x8000u : 0xffffu);
                const _Float16 hv = __builtin_bit_cast(_Float16, (unsigned short)hb);
                lsw[(p * 16 + j) * 64] = (srt((float)hv) & ~127u) | (top[j] & 127u); }
        }
#endif
        unsigned best[16];
        {
            const int offA = hi ? 16 * 64 : 0, offB = hi ? 0 : 16 * 64, shA = hi ? 0 : 7, shB = hi ? 7 : 0;
            float fa[16], fb[16]; unsigned ia[16], ib[16];
#pragma unroll
            for (int i = 0; i < 16; ++i) { const unsigned av = lsw[offA + i * 64], bv = lsw[offB + i * 64];
                fa[i] = unsrt(av & ~127u); fb[i] = unsrt(bv & ~127u); ia[i] = (av & 127u) << shA; ib[i] = (bv & 127u) << shB; }
#define PA_CAND(i, j) ((srt(fa[i] + fb[j]) & ~0x3FFFu) | ia[i] | ib[j])
            unsigned c0[16], c1[16];
#pragma unroll
            for (int j = 1; j < 16; ++j) c0[j - 1] = PA_CAND(0, j);
            c0[15] = hi ? PA_CAND(1, 1) : PA_CAND(0, 0);
#pragma unroll
            for (int j = 2; j < 8; ++j) c1[j - 2] = PA_CAND(1, j);
            c1[6] = PA_CAND(2, 3); c1[7] = PA_CAND(2, 4);
            c1[8] = hi ? PA_CAND(3, 3) : PA_CAND(2, 2);
#pragma unroll
            for (int j = 9; j < 16; ++j) c1[j] = 0u;
#undef PA_CAND
            sort16_desc(c0); sort16_desc(c1);
            merge_top16(c0, c1);
#pragma unroll
            for (int j = 0; j < 16; ++j) best[j] = c0[j];
        }
        merge_halves(best);
        float e[16], sum = 0.f;
        const float s0 = unsrt(best[0] & ~0x3FFFu);
#pragma unroll
        for (int j = 0; j < 16; ++j) { e[j] = __builtin_amdgcn_exp2f((unsrt(best[j] & ~0x3FFFu) - s0) * rs2 * LOG2E); sum += e[j]; }
        const float inv = 1.f / sum;
        if (hi == 0) {
            u32x2* pl = (u32x2*)(lds + P6_PL) + tl_r * 128 + 16 * hd;
#pragma unroll
            for (int j = 0; j < 16; ++j) { u32x2 en; en.x = best[j] & 0x3FFFu; en.y = __float_as_uint(e[j] * inv); pl[j] = en; }
        }
    }
#if defined(HK_PROBE_PHASE) && HK_PROBE_PHASE == 10
    if (blockIdx.x == 0 && threadIdx.x == 0) { volatile LAS3 unsigned* pw_ = (volatile LAS3 unsigned*)(LAS3 unsigned char*)(lds + LDS_CTL + 48); *pw_ = *pw_ + (unsigned)(__builtin_amdgcn_s_memrealtime() - pq0_); }
#endif
    const unsigned char* ut = a.ws + WS_UT; const unsigned char* vt = a.ws + WS_VT; const float* us = (const float*)(a.ws + WS_US); const float* vs = (const float*)(a.ws + WS_VS);
    float* dots = (float*)(lds + P6_DOT) + w * 256; float* cfs = dots + 128;
    int vz_; asm volatile("v_mov_b32 %0, 0" : "=v"(vz_));
    const int lane_g = lane + vz_, hi_g = lane_g >> 5;
    const int c32 = lane_g & 31, slot = 2 * c32 + hi_g;
#define PG_ISSUE(buf, tab, plp, b) do { _Pragma("unroll") for (int kk = 0; kk < 8; ++kk) { const unsigned id_ = (plp)[16 * (b) + 8 * hi_g + kk].x; buf[kk] = *(const u32x4*)((tab) + (unsigned)(id_ * 512u + 16u * (unsigned)c32)); } } while (0)
#define PG_CU(buf, b) do { int pd_[8]; \
        _Pragma("unroll") for (int kk = 0; kk < 8; ++kk) {        \
            int dl_ = __builtin_amdgcn_sdot8((int)buf[kk][0], xl4[0], 0, true), dh_ = __builtin_amdgcn_sdot8((int)buf[kk][0], xh4[0], 0, true); \
            _Pragma("unroll") for (int j = 1; j < 4; ++j) { dl_ = __builtin_amdgcn_sdot8((int)buf[kk][j], xl4[j], dl_, false); dh_ = __builtin_amdgcn_sdot8((int)buf[kk][j], xh4[j], dh_, false); } \
            pd_[kk] = (dh_ << 4) + dl_; } \
        int r4_[4]; \
        _Pragma("unroll") for (int j = 0; j < 4; ++j) { auto rr_ = __builtin_amdgcn_permlane16_swap((unsigned)pd_[j], (unsigned)pd_[j + 4], false, false); r4_[j] = (int)rr_[0] + (int)rr_[1]; } \
        _Pragma("unroll") for (int j = 0; j < 4; ++j) { int v_ = r4_[j]; \
            v_ += __builtin_amdgcn_update_dpp(0, v_, 0xB1, 0xf, 0xf, true); v_ += __builtin_amdgcn_update_dpp(0, v_, 0x4E, 0xf, 0xf, true); \
            v_ += __builtin_amdgcn_update_dpp(0, v_, 0x141, 0xf, 0xf, true); v_ += __builtin_amdgcn_update_dpp(0, v_, 0x140, 0xf, 0xf, true); r4_[j] = v_; } \
        if ((lane_g & 15) == 0) { const int q_ = lane_g >> 4; *(f32x4*)(dots + 16 * (b) + 8 * (q_ >> 1) + 4 * (q_ & 1)) = (f32x4){(float)r4_[0], (float)r4_[1], (float)r4_[2], (float)r4_[3]}; } } while (0)
#define PG_T4(r0, r1, r2, r3, t0, t1, t2, t3) do { const unsigned a01l_ = __builtin_amdgcn_perm(r1, r0, 0x05010400u), a01h_ = __builtin_amdgcn_perm(r1, r0, 0x07030602u), \
            a23l_ = __builtin_amdgcn_perm(r3, r2, 0x05010400u), a23h_ = __builtin_amdgcn_perm(r3, r2, 0x07030602u); \
        t0 = __builtin_amdgcn_perm(a23l_, a01l_, 0x05040100u); t1 = __builtin_amdgcn_perm(a23l_, a01l_, 0x07060302u); \
        t2 = __builtin_amdgcn_perm(a23h_, a01h_, 0x05040100u); t3 = __builtin_amdgcn_perm(a23h_, a01h_, 0x07060302u); } while (0)
#define PG_CV(buf, b) do { _Pragma("unroll") for (int g4 = 0; g4 < 2; ++g4) { const int cq_ = (int)cqw[4 * (b) + 2 * hi_g + g4]; \
            _Pragma("unroll") for (int j = 0; j < 4; ++j) { \
                const unsigned w0_ = buf[4 * g4][j], w1_ = buf[4 * g4 + 1][j], w2_ = buf[4 * g4 + 2][j], w3_ = buf[4 * g4 + 3][j]; \
                unsigned t0_, t1_, t2_, t3_; \
                PG_T4(w0_ & 0x0F0F0F0Fu, w1_ & 0x0F0F0F0Fu, w2_ & 0x0F0F0F0Fu, w3_ & 0x0F0F0F0Fu, t0_, t1_, t2_, t3_); \
                oa[8 * j + 0] = __builtin_amdgcn_sdot4((int)t0_, cq_, oa[8 * j + 0], false); oa[8 * j + 1] = __builtin_amdgcn_sdot4((int)t1_, cq_, oa[8 * j + 1], false); \
                oa[8 * j + 2] = __builtin_amdgcn_sdot4((int)t2_, cq_, oa[8 * j + 2], false); oa[8 * j + 3] = __builtin_amdgcn_sdot4((int)t3_, cq_, oa[8 * j + 3], false); \
                PG_T4((w0_ >> 4) & 0x0F0F0F0Fu, (w1_ >> 4) & 0x0F0F0F0Fu, (w2_ >> 4) & 0x0F0F0F0Fu, (w3_ >> 4) & 0x0F0F0F0Fu, t0_, t1_, t2_, t3_); \
                oa[8 * j + 4] = __builtin_amdgcn_sdot4((int)t0_, cq_, oa[8 * j + 4], false); oa[8 * j + 5] = __builtin_amdgcn_sdot4((int)t1_, cq_, oa[8 * j + 5], false); \
                oa[8 * j + 6] = __builtin_amdgcn_sdot4((int)t2_, cq_, oa[8 * j + 6], false); oa[8 * j + 7] = __builtin_amdgcn_sdot4((int)t3_, cq_, oa[8 * j + 7], false); \
                asm volatile("" : "+v"(oa[8 * j]), "+v"(oa[8 * j + 1]), "+v"(oa[8 * j + 2]), "+v"(oa[8 * j + 3]), "+v"(oa[8 * j + 4]), "+v"(oa[8 * j + 5]), "+v"(oa[8 * j + 6]), "+v"(oa[8 * j + 7])); } } } while (0)
#define PG_SB __builtin_amdgcn_sched_barrier(0)
    u32x4 bA[8], bB[8], bC[8], bD[8];
    { const u32x2* pl0 = (const u32x2*)(lds + P6_PL) + (4 * w) * 128; PG_ISSUE(bA, ut, pl0, 0); PG_ISSUE(bB, ut, pl0, 1); PG_ISSUE(bC, ut, pl0, 2); }
    for (int tt = 0; tt < 4; ++tt) {
        const int tl = 4 * w + tt, tok = tok0 + tl;
        const float rs2 = rsl[tl];
        const u32x2* pl = (const u32x2*)(lds + P6_PL) + tl * 128;
        const u32x2 en0 = pl[lane_g], en1 = pl[64 + lane_g];
        const float us0 = us[en0.x], us1 = us[en1.x], vs0 = vs[en0.x], vs1 = vs[en1.x];
        float xv[16]; load_row16_bf(xg + (size_t)tok * D, slot, xv);
        float mx = 0.f;
#pragma unroll
        for (int i = 0; i < 16; ++i) mx = fmaxf(mx, fabsf(xv[i]));
#pragma unroll
        for (int o = 32; o > 0; o >>= 1) mx = fmaxf(mx, __shfl_xor(mx, o));
        const float sx = mx > 0.f ? mx * (1.f / 119.f) : 1.f, isx = 1.f / sx;
        int xl4[4], xh4[4];
        {
            unsigned xq[8];
#pragma unroll
            for (int j = 0; j < 4; ++j) {
                unsigned pk = 0u;
#pragma unroll
                for (int i = 0; i < 4; ++i) { const int q = (int)rintf(xv[4 * j + i] * isx); pk |= ((unsigned)q & 0xffu) << (8 * i); }
                auto rr = __builtin_amdgcn_permlane32_swap(pk, pk, false, false);
                xq[j] = rr[0]; xq[4 + j] = rr[1];
            }
#pragma unroll
            for (int j = 0; j < 4; ++j) {
                const unsigned A = xq[2 * j], B = xq[2 * j + 1];
                xl4[j] = (int)((A & 0x0F0F0F0Fu) | ((B & 0x0F0F0F0Fu) << 4));
                const unsigned ha = (((A >> 4) & 0x0F0F0F0Fu) + ((A >> 3) & 0x01010101u)) & 0x0F0F0F0Fu, hb = (((B >> 4) & 0x0F0F0F0Fu) + ((B >> 3) & 0x01010101u)) & 0x0F0F0F0Fu;
                xh4[j] = (int)(ha | (hb << 4));
            }
        }
#define PG_STEP(cur, nxt, ub) do { if ((ub) + 3 < 8) PG_ISSUE(nxt, ut, pl, (ub) + 3); else if (tt < 3) PG_ISSUE(nxt, ut, pl + 128, (ub) + 3 - 8); PG_SB; PG_CU(cur, ub); PG_SB; } while (0)
        PG_STEP(bA, bD, 0); PG_STEP(bB, bA, 1); PG_STEP(bC, bB, 2); PG_STEP(bD, bC, 3); PG_STEP(bA, bD, 4); PG_STEP(bB, bA, 5); PG_STEP(bC, bB, 6); PG_STEP(bD, bC, 7);
#undef PG_STEP
        const float a0 = gelu_tanh(dots[lane_g] * (sx * rs2) * us0) * __uint_as_float(en0.y);
        const float a1 = gelu_tanh(dots[64 + lane_g] * (sx * rs2) * us1) * __uint_as_float(en1.y);
        const float c0 = a0 * vs0, c1 = a1 * vs1;
        float cm = fmaxf(fabsf(c0), fabsf(c1));
#pragma unroll
        for (int o = 32; o > 0; o >>= 1) cm = fmaxf(cm, __shfl_xor(cm, o));
        const float scc = cm > 0.f ? cm * (1.f / 127.f) : 1.f, iscc = 1.f / scc;
        const int q0c = (int)rintf(c0 * iscc), q1c = (int)rintf(c1 * iscc);
        int qsum = q0c + q1c;
#pragma unroll
        for (int o = 32; o > 0; o >>= 1) qsum += __shfl_xor(qsum, o);
        unsigned short* gid = (unsigned short*)(a.ws + WS_CIDX) + (size_t)tok * 128; signed char* gcq = (signed char*)(a.ws + WS_CQ) + (size_t)tok * 128;
        gid[lane_g] = (unsigned short)en0.x; gid[64 + lane_g] = (unsigned short)en1.x; gcq[lane_g] = (signed char)q0c; gcq[64 + lane_g] = (signed char)q1c;
        if (lane_g == 0) { float* gsc = (float*)(a.ws + WS_CSC) + 2 * (size_t)tok; gsc[0] = scc; gsc[1] = (float)qsum; }
    }
#undef PG_ISSUE
#undef PG_SB
#undef PG_CU
#undef PG_CV
#undef PG_T4
}
#endif
__device__ __forceinline__ void peer_unit_c(const Args& a, unsigned char* lds, int layer, int unit) {
    int tid = threadIdx.x; asm volatile("" : "+v"(tid));
    const int lane = tid & 63, w = __builtin_amdgcn_readfirstlane(tid >> 6), hi_g = lane >> 5, c32 = lane & 31, slot = 2 * c32 + hi_g;
    const int tok0 = unit * 32 + 4 * w;
    const bf16_t* xg = (const bf16_t*)(a.ws + WS_XB);
    const unsigned char* vt = a.ws + WS_VT;
    const unsigned short* gid = (const unsigned short*)(a.ws + WS_CIDX); const signed char* gcq = (const signed char*)(a.ws + WS_CQ); const float* gsc = (const float*)(a.ws + WS_CSC);
    LAS3 unsigned char* lw = (LAS3 unsigned char*)(lds + w * 1024);
#define PC_ISSUE(buf, lb, b) do { const LAS3 unsigned short* il_ = (const LAS3 unsigned short*)(lw + 512 * (lb)); _Pragma("unroll") for (int kk = 0; kk < 8; ++kk) { const unsigned id_ = il_[16 * (b) + 8 * hi_g + kk]; \
        buf[kk] = *(const u32x4*)(vt + (unsigned)(id_ * 512u + 16u * (unsigned)c32)); } } while (0)
#define PC_T4(r0, r1, r2, r3, t0, t1, t2, t3) do { const unsigned a01l_ = __builtin_amdgcn_perm(r1, r0, 0x05010400u), a01h_ = __builtin_amdgcn_perm(r1, r0, 0x07030602u), \
            a23l_ = __builtin_amdgcn_perm(r3, r2, 0x05010400u), a23h_ = __builtin_amdgcn_perm(r3, r2, 0x07030602u); \
        t0 = __builtin_amdgcn_perm(a23l_, a01l_, 0x05040100u); t1 = __builtin_amdgcn_perm(a23l_, a01l_, 0x07060302u); \
        t2 = __builtin_amdgcn_perm(a23h_, a01h_, 0x05040100u); t3 = __builtin_amdgcn_perm(a23h_, a01h_, 0x07060302u); } while (0)
#define PC_CV(buf, lb, b) do { const LAS3 unsigned* cqw_ = (const LAS3 unsigned*)(lw + 512 * (lb) + 256); _Pragma("unroll") for (int g4 = 0; g4 < 2; ++g4) { const int cq_ = (int)cqw_[4 * (b) + 2 * hi_g + g4]; \
            _Pragma("unroll") for (int j = 0; j < 4; ++j) { \
                unsigned t0_, t1_, t2_, t3_; \
                PC_T4(buf[4 * g4][j], buf[4 * g4 + 1][j], buf[4 * g4 + 2][j], buf[4 * g4 + 3][j], t0_, t1_, t2_, t3_);        \
                of[4 * j + 0] = __builtin_amdgcn_sdot4((int)t0_, cq_, of[4 * j + 0], false); of[4 * j + 1] = __builtin_amdgcn_sdot4((int)t1_, cq_, of[4 * j + 1], false); \
                of[4 * j + 2] = __builtin_amdgcn_sdot4((int)t2_, cq_, of[4 * j + 2], false); of[4 * j + 3] = __builtin_amdgcn_sdot4((int)t3_, cq_, of[4 * j + 3], false); \
                ol[4 * j + 0] = __builtin_amdgcn_sdot4((int)(t0_ & 0x0F0F0F0Fu), cq_, ol[4 * j + 0], false); ol[4 * j + 1] = __builtin_amdgcn_sdot4((int)(t1_ & 0x0F0F0F0Fu), cq_, ol[4 * j + 1], false); \
                ol[4 * j + 2] = __builtin_amdgcn_sdot4((int)(t2_ & 0x0F0F0F0Fu), cq_, ol[4 * j + 2], false); ol[4 * j + 3] = __builtin_amdgcn_sdot4((int)(t3_ & 0x0F0F0F0Fu), cq_, ol[4 * j + 3], false); \
                asm volatile("" : "+v"(of[4 * j]), "+v"(of[4 * j + 1]), "+v"(of[4 * j + 2]), "+v"(of[4 * j + 3]), "+v"(ol[4 * j]), "+v"(ol[4 * j + 1]), "+v"(ol[4 * j + 2]), "+v"(ol[4 * j + 3])); } } } while (0)
#define PC_SB __builtin_amdgcn_sched_barrier(0)
    unsigned lid = ((const unsigned*)(gid + (size_t)tok0 * 128))[lane], lcq = lane < 32 ? ((const unsigned*)(gcq + (size_t)tok0 * 128))[lane] : 0u;
    ((LAS3 unsigned*)lw)[lane] = lid; if (lane < 32) ((LAS3 unsigned*)(lw + 256))[lane] = lcq;
    u32x4 bA[8], bB[8];
    PC_ISSUE(bA, 0, 0);
    for (int tt = 0; tt < 4; ++tt) {
        const int tok = tok0 + tt, lb = tt & 1;
        if (tt < 3) { lid = ((const unsigned*)(gid + (size_t)(tok + 1) * 128))[lane]; lcq = lane < 32 ? ((const unsigned*)(gcq + (size_t)(tok + 1) * 128))[lane] : 0u; }
        const float scc = gsc[2 * (size_t)tok], qsf = gsc[2 * (size_t)tok + 1];
        float xv[16]; load_row16_bf(xg + (size_t)tok * D, slot, xv);
        int of[16], ol[16];
#pragma unroll
        for (int i = 0; i < 16; ++i) { of[i] = 0; ol[i] = 0; }
#pragma unroll
        for (int vb = 0; vb < 8; vb += 2) {
            PC_ISSUE(bB, lb, vb + 1); PC_SB; PC_CV(bA, lb, vb); PC_SB;
            if (vb == 2 && tt < 3) { ((LAS3 unsigned*)(lw + 512 * (lb ^ 1)))[lane] = lid; if (lane < 32) ((LAS3 unsigned*)(lw + 512 * (lb ^ 1) + 256))[lane] = lcq; }
            if (vb + 2 < 8) PC_ISSUE(bA, lb, vb + 2); else if (tt < 3) PC_ISSUE(bA, lb ^ 1, 0);
            PC_SB; PC_CV(bB, lb, vb + 1); PC_SB;
        }
#pragma unroll
        for (int i = 0; i < 8; ++i) {
            const int jj = i >> 2, k = i & 3;
            auto rl = __builtin_amdgcn_permlane32_swap((unsigned)ol[4 * jj + k], (unsigned)ol[8 + 4 * jj + k], false, false);
            auto rf = __builtin_amdgcn_permlane32_swap((unsigned)of[4 * jj + k], (unsigned)of[8 + 4 * jj + k], false, false);
            const int sl = (int)rl[0] + (int)rl[1], sf = (int)rf[0] + (int)rf[1];
#ifndef HK_PROBE_NOPEER
            xv[8 * jj + k] += scc * ((float)sl - 8.f * qsf);
            xv[8 * jj + 4 + k] += scc * (float)((sf - sl) >> 4);
#else
            xv[8 * jj + k] += 1e-30f * (float)sl; xv[8 * jj + 4 + k] += 1e-30f * (float)sf;
#endif
        }
        const bool more = layer + 1 < DEPTH;
        int vzt_; asm volatile("v_mov_b32 %0, 0" : "=v"(vzt_) : "v"(xv[0]));
        finish_token(tok, xv, more ? nullptr : a.out, (bf16_t*)(a.ws + WS_XB), (float*)(a.ws + WS_RSTD), more ? (const float*)(a.ws + WS_WF) + (size_t)(layer + 1) * 4096 : nullptr,
                     a.in[2] + (more ? (layer + 1) * 4 : 0), (float*)(a.ws + WS_FLOG), lane, slot + vzt_);
    }
#undef PC_ISSUE
#undef PC_T4
#undef PC_CV
#undef PC_SB
}
__device__ __forceinline__ void peer_phase_c(const Args& a, unsigned char* lds, int layer) {
    int tid = threadIdx.x; asm volatile("" : "+v"(tid));
    const int lane = tid & 63, w = __builtin_amdgcn_readfirstlane(tid >> 6), c8 = lane & 7, r8 = lane >> 3;
    const int nun = (T / 32 - (int)blockIdx.x + (int)gridDim.x - 1) / (int)gridDim.x, N = 4 * nun;
    bf16_t* xg = (bf16_t*)(a.ws + WS_XB);
    const unsigned char* vt = a.ws + WS_VT;
    const unsigned short* gid = (const unsigned short*)(a.ws + WS_CIDX); const signed char* gcq = (const signed char*)(a.ws + WS_CQ); const float* gsc = (const float*)(a.ws + WS_CSC);
    LAS3 unsigned char* lw = (LAS3 unsigned char*)(lds + w * 1024);
    const bool more = layer + 1 < DEPTH;
    const float* wf = (const float*)(a.ws + WS_WF) + (size_t)(more ? layer + 1 : 0) * 4096; const float* bfor = a.in[2] + (more ? (layer + 1) * 4 : 0);
#define PS_TOK(n) (((int)blockIdx.x + ((n) >> 2) * (int)gridDim.x) * 32 + 4 * w + ((n) & 3))
#define PS_ISSUE(buf, lb, b) do { const LAS3 unsigned char* il_ = lw + 512 * (lb) + 2 * (64 * (b) + 4 * r8); _Pragma("unroll") for (int g4 = 0; g4 < 2; ++g4) { const u32x2 i4_ = *(const LAS3 u32x2*)(il_ + 64 * g4); \
        _Pragma("unroll") for (int k4 = 0; k4 < 4; ++k4) { const unsigned id_ = (k4 & 1 ? i4_[k4 >> 1] >> 16 : i4_[k4 >> 1] & 0xffffu); buf[4 * g4 + k4] = *(const u32x4*)(vt + (unsigned)(id_ * 512u + soff)); } } } while (0)
#define PS_T4(r0, r1, r2, r3, t0, t1, t2, t3) do { const unsigned a01l_ = __builtin_amdgcn_perm(r1, r0, 0x05010400u), a01h_ = __builtin_amdgcn_perm(r1, r0, 0x07030602u), \
            a23l_ = __builtin_amdgcn_perm(r3, r2, 0x05010400u), a23h_ = __builtin_amdgcn_perm(r3, r2, 0x07030602u); \
        t0 = __builtin_amdgcn_perm(a23l_, a01l_, 0x05040100u); t1 = __builtin_amdgcn_perm(a23l_, a01l_, 0x07060302u); \
        t2 = __builtin_amdgcn_perm(a23h_, a01h_, 0x05040100u); t3 = __builtin_amdgcn_perm(a23h_, a01h_, 0x07060302u); } while (0)
#define PS_CV(buf, lb, b) do { const LAS3 unsigned* cqw_ = (const LAS3 unsigned*)(lw + 512 * (lb) + 256); _Pragma("unroll") for (int g4 = 0; g4 < 2; ++g4) { const int cq_ = (int)cqw_[16 * (b) + 8 * g4 + r8]; const bool first_ = (b) == 0 && g4 == 0;       \
            _Pragma("unroll") for (int j = 0; j < 4; ++j) { \
                unsigned t0_, t1_, t2_, t3_; \
                PS_T4(buf[4 * g4][j], buf[4 * g4 + 1][j], buf[4 * g4 + 2][j], buf[4 * g4 + 3][j], t0_, t1_, t2_, t3_);        \
                of[4 * j + 0] = (first_ ? __builtin_amdgcn_sdot4((int)t0_, cq_, 0, true) : __builtin_amdgcn_sdot4((int)t0_, cq_, of[4 * j + 0], false)); of[4 * j + 1] = (first_ ? __builtin_amdgcn_sdot4((int)t1_, cq_, 0, true) : __builtin_amdgcn_sdot4((int)t1_, cq_, of[4 * j + 1], false)); \
                of[4 * j + 2] = (first_ ? __builtin_amdgcn_sdot4((int)t2_, cq_, 0, true) : __builtin_amdgcn_sdot4((int)t2_, cq_, of[4 * j + 2], false)); of[4 * j + 3] = (first_ ? __builtin_amdgcn_sdot4((int)t3_, cq_, 0, true) : __builtin_amdgcn_sdot4((int)t3_, cq_, of[4 * j + 3], false)); \
                ol[4 * j + 0] = (first_ ? __builtin_amdgcn_sdot4((int)(t0_ & 0x0F0F0F0Fu), cq_, 0, true) : __builtin_amdgcn_sdot4((int)(t0_ & 0x0F0F0F0Fu), cq_, ol[4 * j + 0], false)); ol[4 * j + 1] = (first_ ? __builtin_amdgcn_sdot4((int)(t1_ & 0x0F0F0F0Fu), cq_, 0, true) : __builtin_amdgcn_sdot4((int)(t1_ & 0x0F0F0F0Fu), cq_, ol[4 * j + 1], false)); \
                ol[4 * j + 2] = (first_ ? __builtin_amdgcn_sdot4((int)(t2_ & 0x0F0F0F0Fu), cq_, 0, true) : __builtin_amdgcn_sdot4((int)(t2_ & 0x0F0F0F0Fu), cq_, ol[4 * j + 2], false)); ol[4 * j + 3] = (first_ ? __builtin_amdgcn_sdot4((int)(t3_ & 0x0F0F0F0Fu), cq_, 0, true) : __builtin_amdgcn_sdot4((int)(t3_ & 0x0F0F0F0Fu), cq_, ol[4 * j + 3], false)); \
                asm volatile("" : "+v"(of[4 * j]), "+v"(of[4 * j + 1]), "+v"(of[4 * j + 2]), "+v"(of[4 * j + 3]), "+v"(ol[4 * j]), "+v"(ol[4 * j + 1]), "+v"(ol[4 * j + 2]), "+v"(ol[4 * j + 3])); } } } while (0)
#define PS_SB __builtin_amdgcn_sched_barrier(0)
#pragma unroll 1
    for (int s = 0; s < 4; ++s) {
        const int e0 = 256 * s + 32 * c8 + 4 * r8;
        const unsigned soff = 128u * (unsigned)s + 16u * (unsigned)c8;
        {
#pragma unroll
            for (int q = 0; q < 2; ++q) { const int tq = PS_TOK(q);
                const unsigned lidq = ((const unsigned*)(gid + (size_t)tq * 128))[lane], lcqq = lane < 32 ? ((const unsigned*)(gcq + (size_t)tq * 128))[lane] : 0u;
                ((LAS3 unsigned*)(lw + 512 * q))[lane] = lidq; if (lane < 32) ((LAS3 unsigned*)(lw + 512 * q + 256))[lane] = lcqq; }
        }
        u32x4 bA[8], bB[8], bC[8], bD[8];
        PS_ISSUE(bA, 0, 0); PS_ISSUE(bB, 0, 1);
#define PS_BODY(n_, X0, X1, Y0, Y1) do { const int n = (n_), tok = PS_TOK(n), lb = n & 1; \
            const bool nx2 = n + 2 < N; unsigned lid = 0u, lcq = 0u; \
            if (nx2) { const int tn = PS_TOK(n + 2); lid = ((const unsigned*)(gid + (size_t)tn * 128))[lane]; lcq = lane < 32 ? ((const unsigned*)(gcq + (size_t)tn * 128))[lane] : 0u; } \
            if (n + 1 < N) { PS_ISSUE(Y0, lb ^ 1, 0); PS_ISSUE(Y1, lb ^ 1, 1); } \
            const float scc = gsc[2 * (size_t)tok], qsf = gsc[2 * (size_t)tok + 1]; \
            const u32x2 xr = *(const u32x2*)(xg + (size_t)tok * D + e0); \
            int of[16], ol[16];         \
            PS_SB; PS_CV(X0, lb, 0); PS_SB; PS_CV(X1, lb, 1); PS_SB; \
            if (nx2) { ((LAS3 unsigned*)(lw + 512 * lb))[lane] = lid; if (lane < 32) ((LAS3 unsigned*)(lw + 512 * lb + 256))[lane] = lcq; }        \
              \
            int y[16], z[8]; \
            _Pragma("unroll") for (int i = 0; i < 8; ++i) { \
                auto rf = __builtin_amdgcn_permlane32_swap((unsigned)of[i], (unsigned)of[8 + i], false, false); y[i] = (int)rf[0] + (int)rf[1]; \
                auto rl = __builtin_amdgcn_permlane32_swap((unsigned)ol[i], (unsigned)ol[8 + i], false, false); y[8 + i] = (int)rl[0] + (int)rl[1]; } \
            _Pragma("unroll") for (int i = 0; i < 4; ++i) { \
                auto rf = __builtin_amdgcn_permlane16_swap((unsigned)y[i], (unsigned)y[4 + i], false, false); z[i] = (int)rf[0] + (int)rf[1]; \
                auto rl = __builtin_amdgcn_permlane16_swap((unsigned)y[8 + i], (unsigned)y[12 + i], false, false); z[4 + i] = (int)rl[0] + (int)rl[1]; } \
            _Pragma("unroll") for (int i = 0; i < 8; ++i) z[i] += __builtin_amdgcn_update_dpp(0, z[i], 0x128, 0xf, 0xf, true);         \
            float xn[4]; \
            _Pragma("unroll") for (int k = 0; k < 4; ++k) { \
                const float vl = (float)z[4 + k] - 8.f * qsf, vh = (float)((z[k] - z[4 + k]) >> 4); \
                const unsigned xw = xr[k >> 1]; \
                xn[k] = (k & 1 ? __uint_as_float(xw & 0xffff0000u) : __uint_as_float(xw << 16)) + scc * ((r8 & 1) ? vh : vl); } \
            if (more) { u32x2 o; o.x = pk2(xn[0], xn[1]); o.y = pk2(xn[2], xn[3]); *(u32x2*)(xg + (size_t)tok * D + e0) = o; } \
            else *(f32x4*)(a.out + (size_t)tok * D + e0) = (f32x4){xn[0], xn[1], xn[2], xn[3]}; } while (0)
#pragma unroll 1
        for (int n2 = 0; n2 < N; n2 += 2) {
            PS_BODY(n2, bA, bB, bC, bD);
            PS_BODY(n2 + 1, bC, bD, bA, bB);
        }
#undef PS_BODY
    }
    if (more) {
        __builtin_amdgcn_fence(__ATOMIC_ACQ_REL, "workgroup");
        f32x4 wg[4][4];
#pragma unroll
        for (int h = 0; h < 4; ++h)
#pragma unroll
            for (int j = 0; j < 4; ++j) wg[h][j] = *(const f32x4*)(wf + h * 1024 + 16 * lane + 4 * j);
        const int myh = ((lane >> 4) & 1) * 2 + (lane >> 5);
        const float mybf = bfor[myh];
#pragma unroll 1
        for (int n = 0; n < N; ++n) {
            const int tok = PS_TOK(n);
            float xv[16]; load_row16_bf(xg + (size_t)tok * D, lane, xv);
            float ss = 0.f, g[4] = {0.f, 0.f, 0.f, 0.f};
#pragma unroll
            for (int i = 0; i < 16; ++i) { ss += xv[i] * xv[i];
#pragma unroll
                for (int h = 0; h < 4; ++h) g[h] += xv[i] * wg[h][i >> 2][i & 3]; }
            auto r01 = __builtin_amdgcn_permlane32_swap(__float_as_uint(g[0]), __float_as_uint(g[1]), false, false); const float q01 = __uint_as_float(r01[0]) + __uint_as_float(r01[1]);
            auto r23 = __builtin_amdgcn_permlane32_swap(__float_as_uint(g[2]), __float_as_uint(g[3]), false, false); const float q23 = __uint_as_float(r23[0]) + __uint_as_float(r23[1]);
            auto rq = __builtin_amdgcn_permlane16_swap(__float_as_uint(q01), __float_as_uint(q23), false, false); float q = __uint_as_float(rq[0]) + __uint_as_float(rq[1]);
            q += __uint_as_float(__builtin_amdgcn_update_dpp(0, __float_as_uint(q), 0x128, 0xf, 0xf, true)); q += __uint_as_float(__builtin_amdgcn_update_dpp(0, __float_as_uint(q), 0x124, 0xf, 0xf, true));
            q += __uint_as_float(__builtin_amdgcn_update_dpp(0, __float_as_uint(q), 0x122, 0xf, 0xf, true)); q += __uint_as_float(__builtin_amdgcn_update_dpp(0, __float_as_uint(q), 0x121, 0xf, 0xf, true));
            ss += __uint_as_float(__builtin_amdgcn_update_dpp(0, __float_as_uint(ss), 0x128, 0xf, 0xf, true)); ss += __uint_as_float(__builtin_amdgcn_update_dpp(0, __float_as_uint(ss), 0x124, 0xf, 0xf, true));
            ss += __uint_as_float(__builtin_amdgcn_update_dpp(0, __float_as_uint(ss), 0x122, 0xf, 0xf, true)); ss += __uint_as_float(__builtin_amdgcn_update_dpp(0, __float_as_uint(ss), 0x121, 0xf, 0xf, true));
            ss = half_swap_sum(ss);
            { auto r = __builtin_amdgcn_permlane16_swap(__float_as_uint(ss), __float_as_uint(ss), false, false); ss = __uint_as_float(r[0]) + __uint_as_float(r[1]); }
            const float rs = __builtin_amdgcn_rsqf(ss * (1.f / 1024.f) + EPS);
            if (lane == 0) ((float*)(a.ws + WS_RSTD))[tok] = rs;
            if ((lane & 15) == 0) { const int b = tok / S, sq = tok % S; ((float*)(a.ws + WS_FLOG))[((size_t)b * 4 + myh) * S + sq] = log_sigmoid(q * rs + mybf); }
        }
    }
#undef PS_TOK
#undef PS_ISSUE
#undef PS_T4
#undef PS_CV
#undef PS_SB
}
}
namespace hk {
#ifndef HK_ALIGN1
#define HK_ALIGN1 true
#endif
#ifndef HK_ALIGN2
#define HK_ALIGN2 true
#endif
#ifndef HK_ALIGN3
#define HK_ALIGN3 true
#endif
constexpr int NPL = 6 + HK_PEER_SPLIT;
constexpr int NPHASE = 2 + NPL * DEPTH;
__device__ __forceinline__ unsigned q_next(unsigned* ctr, unsigned char* lds) {
    volatile LAS3 unsigned* slot = (volatile LAS3 unsigned*)(LAS3 unsigned char*)(lds + LDS_CTL + 32);
    __syncthreads();
    if (threadIdx.x == 0) *slot = __hip_atomic_fetch_add(ctr, 1u, __ATOMIC_RELAXED, __HIP_MEMORY_SCOPE_AGENT);
    __syncthreads();
    return *slot;
}
__device__ __forceinline__ unsigned q_publish(unsigned nxt, unsigned char* lds) {
    volatile LAS3 unsigned* slot = (volatile LAS3 unsigned*)(LAS3 unsigned char*)(lds + LDS_CTL + 32);
    __syncthreads();
    if (threadIdx.x == 0) *slot = nxt;
    __syncthreads();
    return *slot;
}
#define SEAM(k) do { if (a.use_bar && (k) >= a.ph_lo && (k) + 1 < a.ph_hi) { xcd_barrier(bar); } } while (0)
#define ON(k) ((k) >= a.ph_lo && (k) < a.ph_hi)
#ifdef HK_PROBE_PHASE
#define PROBE_T0(k) unsigned long long pt0_ = 0; if ((k) == HK_PROBE_PHASE && blockIdx.x == 0 && threadIdx.x == 0) pt0_ = __builtin_amdgcn_s_memrealtime();
#define PROBE_T1(k) if ((k) == HK_PROBE_PHASE && blockIdx.x == 0 && threadIdx.x == 0) { volatile LAS3 unsigned* pw_ = (volatile LAS3 unsigned*)(LAS3 unsigned char*)(lds + LDS_CTL + 48); *pw_ = *pw_ + (unsigned)(__builtin_amdgcn_s_memrealtime() - pt0_); }
#else
#define PROBE_T0(k)
#define PROBE_T1(k)
#endif
template <int l>
__device__ __forceinline__ void layer_phases(const Args& a, unsigned char* lds, const XcdBarrier& bar, unsigned* ctl) {
        const int pb = 2 + NPL * l;
        { PROBE_T0(0)
        if (ON(pb)) {
            if (blockIdx.x < NB * 4) cum_scan(a, lds, blockIdx.x);
            pg8::Gemm g; g.A = (const bf16_t*)(a.ws + WS_XB); g.Bt = (const bf16_t*)(a.ws + WS_WIN) + (size_t)l * 2560 * 1024; g.M = T; g.N = 2560; g.K = 1024;
            pg8::StaticOrder so; so.init(T, 2560, gridDim.x, blockIdx.x);
            pg8::EpiIn E; E.zb = (bf16_t*)(a.ws + WS_ZB); E.su32 = (float*)(a.ws + WS_SU); E.rstd = (const float*)(a.ws + WS_RSTD);
            E.g_fq = a.in[6] + l * 64; E.g_fk = a.in[7] + l * 64; E.g_dq = a.in[8] + l * 64; E.g_dk = a.in[9] + l * 64; E.g_cq = a.in[10] + l * 32; E.g_ck = a.in[11] + l * 32;
#ifndef HK_NO_G1
            pg8::gemm_phase<pg8::EpiIn, pg8::StaticOrder, HK_ALIGN1, true>((PG8_LAS unsigned char*)lds, g, so, E);
#endif
        }
        SEAM(pb);
        PROBE_T1(0) }
        { PROBE_T0(1)
        if (ON(pb + 1)) {
            unsigned* ctr = ctl + CTL_Q + 64 * (l + 4 * a.pad0);
            unsigned u = q_next(ctr, lds);
            while (u < 5632u) {
                unsigned nxt_ = 0u; if (threadIdx.x == 0) nxt_ = __hip_atomic_fetch_add(ctr, 1u, __ATOMIC_RELAXED, __HIP_MEMORY_SCOPE_AGENT);
                if (u < 1024u) {
#ifndef HK_NO_DIFF
 diff_unit(a, lds, l, u & 31, 31 - (u >> 5));
#endif
 }
                else if (u < 1536u) {
#ifndef HK_NO_FOX
 fox64_unit(a, lds, l, (u - 1024u) & 31, 15 - ((u - 1024u) >> 5));
#endif
 }
                else if (u < 4608u) { const unsigned j = u - 1536u, br = j >> 10, jj = j & 1023u, bh = jj & 31u, sub = jj >> 5;
                    const int rho = br == 0 ? 0 : (br == 1 ? (sub & 3) : (sub & 15)), tile = br == 0 ? sub : (br == 1 ? (sub >> 2) : (sub >> 4));

#ifndef HK_NO_DIL
                    dil_unit(a, lds, bh, br, rho, tile);
#endif
 }
                else { const unsigned j = u - 4608u;
#ifndef HK_NO_S51
 s5_pass1_unit(a, lds, l, j >> 7, j & 127u);
#endif
 }
                u = q_publish(nxt_, lds);
            }
        }
        SEAM(pb + 1);
        PROBE_T1(1) }
        { PROBE_T0(2)
        if (ON(pb + 2)) {
#ifndef HK_NO_S52
            { PROBE_T0(12)
            for (int u = blockIdx.x; u < 256; u += gridDim.x) s5_pass2_unit(a, lds, l, u >> 5, u & 31);
            PROBE_T1(12) }
#endif
            { PROBE_T0(13)
            phase_p3_elementwise(a, l);
            PROBE_T1(13) }
        }
        SEAM(pb + 2);
        PROBE_T1(2) }
        { PROBE_T0(3)
        if (ON(pb + 3)) {
            pg8::Gemm g; g.A = (const bf16_t*)(a.ws + WS_MIX); g.Bt = (const bf16_t*)(a.ws + WS_WOUT) + (size_t)l * 1024 * 1024; g.M = T; g.N = 1024; g.K = 1024;
            pg8::StaticOrder so; so.init(T, 1024, gridDim.x, blockIdx.x);
            pg8::EpiOut E; E.xb = (bf16_t*)(a.ws + WS_XB);
#ifndef HK_NO_G2
            pg8::gemm_phase<pg8::EpiOut, pg8::StaticOrder, HK_ALIGN2, true>((PG8_LAS unsigned char*)lds, g, so, E);
#endif
        }
        SEAM(pb + 3);
        PROBE_T1(3) }
        { PROBE_T0(4)
        if (ON(pb + 4)) {
            pg8::Gemm g; g.A = (const bf16_t*)(a.ws + WS_XB); g.Bt = (const bf16_t*)(a.ws + WS_WQ) + (size_t)l * 2048 * 1024; g.M = T; g.N = 2048; g.K = 1024;
            pg8::StaticOrder so; so.init(T, 2048, gridDim.x, blockIdx.x);
#if HK_FOLD_KEYS
            pg8::EpiF16 E; E.O = (bf16_t*)(a.ws + WS_ZB); E.ldc = 2048;
#ifndef HK_NO_G3
            pg8::gemm_phase<pg8::EpiF16, pg8::StaticOrder, HK_ALIGN3, true>((PG8_LAS unsigned char*)lds, g, so, E);
#endif
#else
            pg8::EpiPlain E; E.O = (bf16_t*)(a.ws + WS_ZB); E.ldc = 2048;
#ifndef HK_NO_G3
            pg8::gemm_phase<pg8::EpiPlain, pg8::StaticOrder, HK_ALIGN3, true>((PG8_LAS unsigned char*)lds, g, so, E);
#endif
#endif
        }
        SEAM(pb + 4);
        PROBE_T1(4) }
        { PROBE_T0(5)
        if (ON(pb + 5)) {
#ifndef HK_NO_PEER
#if HK_PEER_SPLIT
            for (int u = blockIdx.x; u < T / 32; u += gridDim.x) peer_unit_a(a, lds, l, u);
#else
            for (int u = blockIdx.x; u < T / 32; u += gridDim.x) peer_unit(a, lds, l, u);
#endif
#endif
        }
#if HK_PEER_SPLIT && !defined(HK_AC_BAR)
        __builtin_amdgcn_fence(__ATOMIC_RELEASE, "workgroup"); __syncthreads(); __builtin_amdgcn_fence(__ATOMIC_ACQUIRE, "workgroup");
#else
        SEAM(pb + 5);
#endif
        PROBE_T1(5) }
#if HK_PEER_SPLIT
        { PROBE_T0(6)
        if (ON(pb + 6)) {
#ifndef HK_NO_PEER
#ifdef HK_C_UNSLICED
            for (int u = blockIdx.x; u < T / 32; u += gridDim.x) peer_unit_c(a, lds, l, u);
#else
            peer_phase_c(a, lds, l);
#endif
#endif
        }
        SEAM(pb + 6);
        PROBE_T1(6) }
#endif
    }
__global__ void __launch_bounds__(NTHR, 2) hk_mega(Args a) {
    extern __shared__ __attribute__((aligned(16))) unsigned char lds[];
    const int tid = threadIdx.x;
    if (tid < 64) ((LAS3 unsigned*)(lds + LDS_CTL))[tid] = 0u;
    __syncthreads();
    unsigned* ctl = (unsigned*)(a.ws + WS_CTL);
    XcdBarrier bar = xcd_barrier_post(ctl + CTL_BAR, (volatile LAS unsigned*)(LAS3 unsigned char*)(lds + LDS_CTL));
    if (ON(0)) phase_weights(a, lds);
    SEAM(0);
    if (ON(1)) phase_xprep(a);
    SEAM(1);
    layer_phases<0>(a, lds, bar, ctl);
    layer_phases<1>(a, lds, bar, ctl);
    layer_phases<2>(a, lds, bar, ctl);
    layer_phases<3>(a, lds, bar, ctl);
#ifdef HK_PROBE_PHASE
    if (blockIdx.x == 0 && threadIdx.x == 0) { const unsigned span = *(volatile LAS3 unsigned*)(LAS3 unsigned char*)(lds + LDS_CTL + 48); const unsigned long long t0 = __builtin_amdgcn_s_memrealtime();
        while (__builtin_amdgcn_s_memrealtime() - t0 < 4ull * span) __builtin_amdgcn_s_sleep(32); }
#endif
}
#undef SEAM
#undef ON
}
namespace nv {
using namespace hk;
__global__ void __launch_bounds__(64) n_fox(const bf16_t* __restrict__ zb, const float* __restrict__ cum2, bf16_t* __restrict__ mix) {
    int gid = blockIdx.x * 64 + threadIdx.x;
    int t = S - 1 - (gid % S); int bh = gid / S; int b = bh / 4, h = bh % 4;
    const bf16_t* z = zb + (size_t)b * S * ZP; const float* cm = cum2 + (size_t)bh * S;
    float q[64], o[64];
#pragma unroll
    for (int i = 0; i < 64; ++i) { q[i] = bf2f(z[(size_t)t * ZP + ZC_FQ + h * 64 + i]); o[i] = 0.f; }
    float m = -INFINITY, l = 0.f, cq = cm[t];
    int tmax = __shfl(t, 0);
    for (int s = 0; s <= tmax; ++s) {
        const bf16_t* kp = z + (size_t)s * ZP + ZC_FK + h * 64; const bf16_t* vp = z + (size_t)s * ZP + ZC_FV + h * 64;
        float d = 0.f;
#pragma unroll
        for (int i = 0; i < 64; ++i) d += q[i] * bf2f(kp[i]);
        d += cq - cm[s];
        if (s <= t) {
            float mn = fmaxf(m, d), al = exp2f(m - mn), p = exp2f(d - mn);
            l = l * al + p;
#pragma unroll
            for (int i = 0; i < 64; ++i) o[i] = o[i] * al + p * bf2f(vp[i]);
            m = mn;
        }
    }
    float inv = 1.f / l;
    bf16_t* op = mix + ((size_t)b * S + t) * D + h * 64;
#pragma unroll
    for (int i = 0; i < 64; ++i) op[i] = f2bf(o[i] * inv);
}
__global__ void __launch_bounds__(64) n_dil(const bf16_t* __restrict__ zb, const float* __restrict__ tb, bf16_t* __restrict__ mix) {
    int gid = blockIdx.x * 64 + threadIdx.x;
    int t = gid % S; int bh = gid / S; int b = bh / 4, h = bh % 4;
    const bf16_t* z = zb + (size_t)b * S * ZP;
    float q[64], o[64];
#pragma unroll
    for (int i = 0; i < 64; ++i) { q[i] = bf2f(z[(size_t)t * ZP + ZC_DQ + h * 64 + i]); o[i] = 0.f; }
    float m = -INFINITY, l = 0.f;
    for (int br = 0; br < 3; ++br) {
        int r = br == 0 ? 1 : (br == 1 ? 4 : 16);
        for (int j = 0; j <= 128; ++j) {
            bool ok = (t / r - j) >= 0; int sc = ok ? t - j * r : t;
            const bf16_t* kp = z + (size_t)sc * ZP + ZC_DK + h * 64; const bf16_t* vp = z + (size_t)sc * ZP + ZC_DV + h * 64;
            float d = 0.f;
#pragma unroll
            for (int i = 0; i < 64; ++i) d += q[i] * bf2f(kp[i]);
            d += tb[h * TBN + r * j];
            if (ok) {
                float mn = fmaxf(m, d), al = exp2f(m - mn), p = exp2f(d - mn);
                l = l * al + p;
#pragma unroll
                for (int i = 0; i < 64; ++i) o[i] = o[i] * al + p * bf2f(vp[i]);
                m = mn;
            }
        }
    }
    float inv = 1.f / l;
    bf16_t* op = mix + ((size_t)b * S + t) * D + 256 + h * 64;
#pragma unroll
    for (int i = 0; i < 64; ++i) op[i] = f2bf(o[i] * inv);
}
template <int CMP>
__global__ void __launch_bounds__(64) n_diff(const bf16_t* __restrict__ zb, const float* __restrict__ tb, float* __restrict__ tmp) {
    int gid = blockIdx.x * 64 + threadIdx.x;
    int t = S - 1 - (gid % S); int bh = gid / S; int b = bh / 4, h = bh % 4;
    const bf16_t* z = zb + (size_t)b * S * ZP;
    float q[32], o[64];
#pragma unroll
    for (int i = 0; i < 32; ++i) q[i] = bf2f(z[(size_t)t * ZP + ZC_CQ + h * 64 + CMP * 32 + i]);
#pragma unroll
    for (int i = 0; i < 64; ++i) o[i] = 0.f;
    float m = -INFINITY, l = 0.f;
    int tmax = __shfl(t, 0);
    for (int s = 0; s <= tmax; ++s) {
        const bf16_t* kp = z + (size_t)s * ZP + ZC_CK + h * 64 + CMP * 32; const bf16_t* vp = z + (size_t)s * ZP + ZC_CV + h * 64;
        float d = 0.f;
#pragma unroll
        for (int i = 0; i < 32; ++i) d += q[i] * bf2f(kp[i]);
        int rel = t - s; int ri = rel < 0 ? 0 : (rel > 2000 ? 2000 : rel);
        d += tb[(4 + h) * TBN + ri];
        if (rel >= 0) {
            float mn = fmaxf(m, d), al = exp2f(m - mn), p = exp2f(d - mn);
            l = l * al + p;
#pragma unroll
            for (int i = 0; i < 64; ++i) o[i] = o[i] * al + p * bf2f(vp[i]);
            m = mn;
        }
    }
    float inv = 1.f / l;
    float* op = tmp + ((size_t)b * S + t) * 256 + h * 64;
#pragma unroll
    for (int i = 0; i < 64; ++i) op[i] = o[i] * inv;
}
__global__ void n_diff_fin(const float* __restrict__ tmp0, const float* __restrict__ tmp1, const float* __restrict__ lamp, const float* __restrict__ gain, float lam_init, bf16_t* __restrict__ mix) {
    size_t gid = (size_t)blockIdx.x * blockDim.x + threadIdx.x;
    if (gid >= (size_t)T * 4) return;
    size_t tok = gid / 4; int h = (int)(gid % 4);
    float s1 = 0.f, s2 = 0.f;
    for (int i = 0; i < 32; ++i) { s1 += lamp[i] * lamp[32 + i]; s2 += lamp[64 + i] * lamp[96 + i]; }
    float lam = expf(s1) - expf(s2) + lam_init;
    const float* p0 = tmp0 + tok * 256 + h * 64; const float* p1 = tmp1 + tok * 256 + h * 64;
    float ss = 0.f;
    for (int i = 0; i < 64; ++i) { float v = p0[i] - lam * p1[i]; ss += v * v; }
    float r = rsqrtf(ss / 64 + EPS) * (1.f - lam_init);
    bf16_t* op = mix + tok * D + 512 + h * 64;
    for (int i = 0; i < 64; ++i) op[i] = f2bf((p0[i] - lam * p1[i]) * r * gain[i]);
}
__global__ void __launch_bounds__(64) n_s5(const bf16_t* __restrict__ su, const float* a_re, const float* a_im, const float* log_dt, const float* b_re, const float* b_im,
                                           const float* c_re, const float* c_im, const float* dsk, float* __restrict__ gbuf) {
    int b = blockIdx.x / 16, g = blockIdx.x % 16, n = threadIdx.x;
    float dt = expf(log_dt[g]);
    float ar = a_re[g * 64 + n], ai = a_im[g * 64 + n];
    float mag = expf(dt * ar);
    float abr = mag * cosf(dt * ai), abi = mag * sinf(dt * ai);
    float den = ar * ar + ai * ai, nr = abr - 1.f, ni = abi;
    float cr = (nr * ar + ni * ai) / den, ci = (ni * ar - nr * ai) / den;
    float bbr[16], bbi[16], ccr[16], cci[16];
#pragma unroll
    for (int c = 0; c < 16; ++c) {
        float br = b_re[(g * 64 + n) * 16 + c], bi = b_im[(g * 64 + n) * 16 + c];
        bbr[c] = cr * br - ci * bi; bbi[c] = cr * bi + ci * br;
        ccr[c] = c_re[(g * 16 + c) * 64 + n]; cci[c] = c_im[(g * 16 + c) * 64 + n];
    }
    float dk = (n < 16) ? dsk[g * 16 + n] : 0.f;
    float xr = 0.f, xi = 0.f;
    for (int s = 0; s < S; ++s) {
        const bf16_t* up = su + ((size_t)b * S + s) * 256 + g * 16;
        float u[16];
#pragma unroll
        for (int c = 0; c < 16; ++c) u[c] = bf2f(up[c]);
        float pr = 0.f, pi = 0.f;
#pragma unroll
        for (int c = 0; c < 16; ++c) { pr += bbr[c] * u[c]; pi += bbi[c] * u[c]; }
        float nxr = abr * xr - abi * xi + pr, nxi = abr * xi + abi * xr + pi;
        xr = nxr; xi = nxi;
        float myy = 0.f;
#pragma unroll
        for (int c = 0; c < 16; ++c) { float v = wave_sum(ccr[c] * xr - cci[c] * xi); if (n == c) myy = v + dk * u[c]; }
        if (n < 16) gbuf[((size_t)b * S + s) * 256 + g * 16 + n] = gelu_tanh(myy);
    }
}
__global__ void __launch_bounds__(256) n_glu(const float* __restrict__ gbuf, const float* __restrict__ w, const float* __restrict__ bias, bf16_t* __restrict__ mix) {
    __shared__ float gs[256];
    size_t tok = blockIdx.x; int j = threadIdx.x;
    gs[j] = gbuf[tok * 256 + j];
    __syncthreads();
    float acc = bias[j];
    for (int k = 0; k < 256; ++k) acc += gs[k] * w[k * 256 + j];
    mix[tok * D + 768 + j] = f2bf(gs[j] * (1.f / (1.f + expf(-acc))));
}
template <int MODE>
__global__ void __launch_bounds__(256) n_gemm(const bf16_t* __restrict__ A, const float* __restrict__ g, const float* __restrict__ B, float* __restrict__ X, bf16_t* __restrict__ O, int M, int N, int K) {
    __shared__ float As[16][68];
    __shared__ float Bs[16][68];
    const int tx = threadIdx.x & 15, ty = threadIdx.x >> 4;
    const int m0 = blockIdx.y * 64, n0 = blockIdx.x * 64;
    float acc[4][4];
#pragma unroll
    for (int i = 0; i < 4; ++i)
#pragma unroll
        for (int j = 0; j < 4; ++j) acc[i][j] = 0.f;
    for (int k0 = 0; k0 < K; k0 += 16) {
        { int r = threadIdx.x >> 2, c4 = (threadIdx.x & 3) * 4;
          const bf16_t* ap = A + (size_t)(m0 + r) * K + k0 + c4;
#pragma unroll
          for (int j = 0; j < 4; ++j) { float v = bf2f(ap[j]); if (g) v *= g[k0 + c4 + j]; As[c4 + j][r] = v; }
          int br = threadIdx.x >> 4, bc = (threadIdx.x & 15) * 4;
#pragma unroll
          for (int j = 0; j < 4; ++j) Bs[br][bc + j] = B[(size_t)(k0 + br) * N + n0 + bc + j]; }
        __syncthreads();
#pragma unroll
        for (int kk = 0; kk < 16; ++kk) {
            float av[4], bv[4];
#pragma unroll
            for (int i = 0; i < 4; ++i) av[i] = As[kk][ty * 4 + i];
#pragma unroll
            for (int j = 0; j < 4; ++j) bv[j] = Bs[kk][tx * 4 + j];
#pragma unroll
            for (int i = 0; i < 4; ++i)
#pragma unroll
                for (int j = 0; j < 4; ++j) acc[i][j] += av[i] * bv[j];
        }
        __syncthreads();
    }
#pragma unroll
    for (int i = 0; i < 4; ++i)
#pragma unroll
        for (int j = 0; j < 4; ++j) {
            size_t off = (size_t)(m0 + ty * 4 + i) * N + n0 + tx * 4 + j;
            if (MODE == 0) { float v = X[off] + acc[i][j]; X[off] = v; O[off] = f2bf(v); } else O[off] = f2bf(acc[i][j]);
        }
}
__global__ void n_rstd(const float* __restrict__ x, float* __restrict__ rstd) {
    int row = blockIdx.x * 4 + (threadIdx.x >> 6), lane = threadIdx.x & 63;
    const float* p = x + (size_t)row * D;
    float s = 0.f;
    for (int i = lane; i < D; i += 64) { float v = p[i]; s += v * v; }
    s = wave_sum(s);
    if (lane == 0) rstd[row] = rsqrtf(s / D + EPS);
}
__global__ void __launch_bounds__(256) n_top1(const bf16_t* __restrict__ q, const float* __restrict__ keys, float* __restrict__ tv, int* __restrict__ ti) {
    extern __shared__ float ks[];
    int hp = blockIdx.y; size_t tok = (size_t)blockIdx.x * 256 + threadIdx.x;
    const float* kg = keys + (size_t)hp * 128 * 128;
    for (int i = threadIdx.x; i < 128 * 128; i += 256) ks[i] = kg[i];
    __syncthreads();
    float qv[128];
    const bf16_t* qp = q + tok * 2048 + hp * 128;
#pragma unroll
    for (int i = 0; i < 128; ++i) qv[i] = bf2f(qp[i]);
    float bv[16]; int bi[16];
#pragma unroll
    for (int j = 0; j < 16; ++j) { bv[j] = -INFINITY; bi[j] = 0; }
    for (int k = 0; k < 128; ++k) {
        float d = 0.f;
#pragma unroll
        for (int i = 0; i < 128; ++i) d += qv[i] * ks[k * 128 + i];
        float cv = d; int ci = k;
#pragma unroll
        for (int j = 0; j < 16; ++j) { if (cv > bv[j]) { float tvv = bv[j]; int tii = bi[j]; bv[j] = cv; bi[j] = ci; cv = tvv; ci = tii; } }
    }
    float* ov = tv + (tok * 16 + hp) * 16; int* oi = ti + (tok * 16 + hp) * 16;
#pragma unroll
    for (int j = 0; j < 16; ++j) { ov[j] = bv[j]; oi[j] = bi[j]; }
}
__global__ void __launch_bounds__(256) n_top2(const float* __restrict__ tv, const int* __restrict__ ti, const float* __restrict__ rstd2, int* __restrict__ ids, float* __restrict__ gates) {
    size_t gid = (size_t)blockIdx.x * 256 + threadIdx.x;
    const float* v0 = tv + gid * 32; const float* v1 = v0 + 16; const int* i0 = ti + gid * 32; const int* i1 = i0 + 16;
    const float rs = rstd2[gid >> 3];
    float av[16], bb[16];
#pragma unroll
    for (int i = 0; i < 16; ++i) { av[i] = v0[i]; bb[i] = v1[i]; }
    float bv[16]; int bi[16];
#pragma unroll
    for (int j = 0; j < 16; ++j) { bv[j] = -INFINITY; bi[j] = 0; }
#pragma unroll
    for (int i = 0; i < 16; ++i)
#pragma unroll
        for (int jj = 0; jj < 16; ++jj) {
            float cv = av[i] + bb[jj]; int ci = i * 16 + jj;
#pragma unroll
            for (int j = 0; j < 16; ++j) { if (cv > bv[j]) { float tvv = bv[j]; int tii = bi[j]; bv[j] = cv; bi[j] = ci; cv = tvv; ci = tii; } }
        }
    float mx = bv[0], sum = 0.f;
#pragma unroll
    for (int j = 0; j < 16; ++j) { bv[j] = expf((bv[j] - mx) * rs); sum += bv[j]; }
    float inv = 1.f / sum;
#pragma unroll
    for (int j = 0; j < 16; ++j) { int pi = bi[j] >> 4, pj = bi[j] & 15; ids[gid * 16 + j] = i0[pi] * 128 + i1[pj]; gates[gid * 16 + j] = bv[j] * inv; }
}
__global__ void __launch_bounds__(256) n_gather(float* __restrict__ x, const float* __restrict__ rstd2, const float* __restrict__ gn, const int* __restrict__ ids,
                                                const float* __restrict__ gates, const float* __restrict__ ut, const float* __restrict__ vt) {
    __shared__ float hs[1024];
    __shared__ float act[128];
    size_t tok = blockIdx.x; int tid = threadIdx.x, lane = tid & 63, w = tid >> 6;
    float r = rstd2[tok];
    float* xp = x + tok * D;
    for (int i = tid; i < D; i += 256) hs[i] = xp[i] * r * gn[i];
    __syncthreads();
    for (int k = w; k < 128; k += 4) {
        int id = ids[tok * 128 + k];
        const float* up = ut + (size_t)id * D;
        float s = 0.f;
        for (int i = lane; i < D; i += 64) s += hs[i] * up[i];
        s = wave_sum(s);
        if (lane == 0) act[k] = gelu_tanh(s) * gates[tok * 128 + k];
    }
    __syncthreads();
    float o[4] = {0.f, 0.f, 0.f, 0.f};
    for (int k = 0; k < 128; ++k) {
        int id = ids[tok * 128 + k];
        const float* vp = vt + (size_t)id * D;
        float av = act[k];
#pragma unroll
        for (int j = 0; j < 4; ++j) o[j] += av * vp[tid + j * 256];
    }
#pragma unroll
    for (int j = 0; j < 4; ++j) xp[tid + j * 256] += o[j];
}
__global__ void __launch_bounds__(512) n_finish(Args a, int lnext) {
    const int lane = threadIdx.x & 63, wv = blockIdx.x * 8 + (threadIdx.x >> 6), nw = gridDim.x * 8;
    for (int tok = wv; tok < T; tok += nw) {
        float xv[16]; load_row16(a.out + (size_t)tok * D, lane, xv);
        finish_token(tok, xv, a.out, (bf16_t*)(a.ws + WS_XB), (float*)(a.ws + WS_RSTD), lnext < DEPTH ? (const float*)(a.ws + WS_WF) + (size_t)lnext * 4096 : nullptr,
                     a.in[2] + (lnext < DEPTH ? lnext * 4 : 0), (float*)(a.ws + WS_FLOG), lane, lane);
    }
}
}
#ifndef HK_ONE_LAUNCH
#define HK_ONE_LAUNCH 1
#endif
extern "C" void kernel_launch(void* const* d_in, const int* in_sizes, int n_in, void* d_out, int out_size, void* d_ws, size_t ws_size, hipStream_t stream) {
    using namespace hk;
    (void)in_sizes; (void)n_in; (void)out_size; (void)ws_size;
    static int grid = 0;
    if (!grid) {
        int dev = 0, cus = 0, per_cu = 0;
        (void)hipGetDevice(&dev);
        (void)hipDeviceGetAttribute(&cus, hipDeviceAttributeMultiprocessorCount, dev);
        if (hipFuncSetAttribute((const void*)hk_mega, hipFuncAttributeMaxDynamicSharedMemorySize, LDS_BYTES) != hipSuccess) fprintf(stderr, "hipFuncSetAttribute failed\n");
        (void)hipOccupancyMaxActiveBlocksPerMultiprocessor(&per_cu, (const void*)hk_mega, NTHR, LDS_BYTES);
        if (per_cu < 1) fprintf(stderr, "occupancy query says %d blocks per CU\n", per_cu);
        grid = cus > 0 ? cus : 256;
    }
    Args a{};
    for (int i = 0; i < 29; ++i) a.in[i] = (const float*)d_in[i];
    a.out = (float*)d_out; a.ws = (unsigned char*)d_ws;
    (void)hipMemsetAsync(a.ws + WS_CTL, 0, WS_CTL_BYTES, stream);
    auto run = [&](int lo, int hi, int bar, int bank = 0) { Args b = a; b.ph_lo = lo; b.ph_hi = hi; b.use_bar = bar; b.pad0 = bank; hipLaunchKernelGGL(hk_mega, dim3(grid), dim3(NTHR), LDS_BYTES, stream, b); };
#ifndef HK_REP_MASK
#define HK_REP_MASK 0
#endif
#if HK_ONE_LAUNCH
    run(0, NPHASE, 1);
#else
    unsigned char* ws = a.ws;
    bf16_t* zb = (bf16_t*)(ws + WS_ZB); bf16_t* mix = (bf16_t*)(ws + WS_MIX); bf16_t* xb = (bf16_t*)(ws + WS_XB);
    bf16_t* su = (bf16_t*)(ws + WS_SU); float* cum = (float*)(ws + WS_CUM); float* tb = (float*)(ws + WS_TB);
    (void)hipFuncSetAttribute((const void*)nv::n_top1, hipFuncAttributeMaxDynamicSharedMemorySize, 65536);
    run(0, 1, 0); run(1, 2, 0);
    for (int l = 0; l < DEPTH; ++l) {
        const int pb = 2 + NPL * l;
        run(pb, pb + 1, 0);
        if (HK_REP_MASK & 1) run(pb, pb + 1, 0);
        if (HK_NEW_MASK & 2) run(pb + 1, pb + 2, 0);
        if (HK_REP_MASK & 2) run(pb + 1, pb + 2, 0, 1);
        if (HK_NEW_MASK & 4) run(pb + 2, pb + 3, 0);
        if (HK_REP_MASK & 4) run(pb + 2, pb + 3, 0);
        if (!(HK_NEW_MASK & 2)) {
            nv::n_fox<<<NB * 4 * S / 64, 64, 0, stream>>>(zb, cum, mix);
            nv::n_dil<<<NB * 4 * S / 64, 64, 0, stream>>>(zb, tb, mix);
            float* t0 = (float*)(ws + WS_DPART); float* t1 = (float*)(ws + WS_UT);
            nv::n_diff<0><<<NB * 4 * S / 64, 64, 0, stream>>>(zb, tb, t0);
            nv::n_diff<1><<<NB * 4 * S / 64, 64, 0, stream>>>(zb, tb, t1);
            const float lam_init = 0.8f - 0.6f * expf(-0.3f * l);
            nv::n_diff_fin<<<(T * 4) / 256, 256, 0, stream>>>(t0, t1, a.in[12] + l * 128, a.in[13] + l * 64, lam_init, mix);
            float* gbuf = (float*)(ws + WS_VT);
            nv::n_s5<<<NB * 16, 64, 0, stream>>>(su, a.in[15] + l * 1024, a.in[16] + l * 1024, a.in[17] + l * 16, a.in[18] + l * 16384, a.in[19] + l * 16384,
                                                  a.in[20] + l * 16384, a.in[21] + l * 16384, a.in[22] + l * 256, gbuf);
            nv::n_glu<<<T, 256, 0, stream>>>(gbuf, a.in[23] + l * 65536, a.in[24] + l * 256, mix);
        }
        if (HK_NEW_MASK & 8) run(pb + 3, pb + 4, 0);
        else nv::n_gemm<0><<<dim3(D / 64, T / 64), 256, 0, stream>>>(mix, nullptr, a.in[3] + (size_t)l * D * D, a.out, xb, T, D, D);
        if (HK_NEW_MASK & 16) run(pb + 4, pb + 5, 0);
        if (HK_REP_MASK & 16) run(pb + 4, pb + 5, 0);
        else nv::n_gemm<1><<<dim3(2048 / 64, T / 64), 256, 0, stream>>>(xb, a.in[5] + l * D, a.in[25] + (size_t)l * D * 2048, nullptr, zb, T, 2048, D);
        if (HK_NEW_MASK & 32) { run(pb + 5, pb + 6, 0); if (HK_PEER_SPLIT) run(pb + 6, pb + 7, 0); }
        else {
            float* rs2 = (float*)(ws + WS_DLSE); float* tv = (float*)(ws + WS_SU); int* ti = (int*)(ws + WS_MIX);
            int* ids = (int*)(ws + WS_DPART); float* gates = (float*)(ws + WS_DPART + (size_t)T * 128 * 4);
            nv::n_rstd<<<T / 4, 256, 0, stream>>>(a.out, rs2);
            nv::n_top1<<<dim3(T / 256, 16), 256, 65536, stream>>>(zb, a.in[26] + (size_t)l * 16 * 128 * 128, tv, ti);
            nv::n_top2<<<(T * 8) / 256, 256, 0, stream>>>(tv, ti, rs2, ids, gates);
            nv::n_gather<<<T, 256, 0, stream>>>(a.out, rs2, a.in[5] + l * D, ids, gates, a.in[27] + (size_t)l * NEXP * D, a.in[28] + (size_t)l * NEXP * D);
            Args b = a; b.ph_lo = 0; b.ph_hi = 0; b.use_bar = 0; b.pad0 = 0;
            nv::n_finish<<<grid, 512, 0, stream>>>(b, l + 1);
        }
    }
#endif
}
```

```cpp
#define HK_ONE_LAUNCH 1
#include <hip/hip_runtime.h>
#ifndef HK_NEW_MASK
#define HK_NEW_MASK 0x3f
#endif
#define HK_FOLD_KEYS (((HK_NEW_MASK) & 48) == 48)
#ifndef HK_PEER_SPLIT
#define HK_PEER_SPLIT HK_FOLD_KEYS
#endif
#include <cstdint>
#include <cstdio>
#include <cmath>

#define LAS3 __attribute__((address_space(3)))
typedef unsigned short bf16_t;
typedef short bf16x8 __attribute__((ext_vector_type(8)));
typedef float f32x4 __attribute__((ext_vector_type(4)));
typedef float f32x16 __attribute__((ext_vector_type(16)));
typedef unsigned u32x4 __attribute__((ext_vector_type(4)));
typedef unsigned u32x2 __attribute__((ext_vector_type(2)));

namespace hk {
constexpr int D = 1024, NB = 8, S = 8192, DEPTH = 4, T = NB * S;
constexpr int INW = 2564;
constexpr int ZP = 2304;
constexpr int ZC_FQ = 0, ZC_FK = 256, ZC_FV = 512, ZC_DQ = 768, ZC_DK = 1024, ZC_DV = 1280, ZC_CQ = 1536, ZC_CK = 1792, ZC_CV = 2048;
constexpr int NEXP = 16384;
constexpr float EPS = 1e-6f;
constexpr float LOG2E = 1.4426950408889634f;
constexpr int TBN = 2112;
constexpr int S5_TC = 64;
constexpr int S5_NCH = S / S5_TC;
constexpr int NTHR = 512;
constexpr int LDS_BYTES = 160 * 1024;
constexpr int LDS_CTL = LDS_BYTES - 256;

constexpr size_t al256(size_t x) { return (x + 255) & ~(size_t)255; }
constexpr size_t WS_CTL = 0;
constexpr size_t WS_CTL_BYTES = 65536;
constexpr size_t WS_XB = WS_CTL + WS_CTL_BYTES;
constexpr size_t WS_ZB = WS_XB + (size_t)T * D * 2;
constexpr size_t WS_SU = WS_ZB + (size_t)T * ZP * 2;
constexpr size_t WS_MIX = WS_SU + (size_t)T * 256 * 4;
constexpr size_t WS_DPART = WS_MIX + (size_t)T * D * 2;
constexpr size_t WS_DLSE = WS_DPART + (size_t)3 * T * 256 * 2;
constexpr size_t WS_SST = WS_DLSE + (size_t)3 * T * 4 * 4;
constexpr size_t WS_CUM = WS_SST + (size_t)NB * 16 * S5_NCH * 128 * 4;
constexpr size_t WS_FLOG = WS_CUM + (size_t)NB * 4 * S * 4;
constexpr size_t WS_RSTD = WS_FLOG + (size_t)NB * 4 * S * 4;
constexpr size_t WS_WIN = WS_RSTD + (size_t)T * 4;
constexpr size_t WS_WF = WS_WIN + (size_t)DEPTH * 2560 * 1024 * 2;
constexpr size_t WS_WOUT = WS_WF + (size_t)DEPTH * 4 * 1024 * 4;
constexpr size_t WS_WQ = WS_WOUT + (size_t)DEPTH * 1024 * 1024 * 2;
constexpr size_t WS_KEYS = WS_WQ + (size_t)DEPTH * 2048 * 1024 * 2;
constexpr size_t WS_GLU = WS_KEYS + (size_t)DEPTH * 16 * 128 * 128 * 2;
constexpr size_t WS_TB = WS_GLU + (size_t)DEPTH * 256 * 256 * 2;
constexpr size_t WS_UT = al256(WS_TB + (size_t)8 * TBN * 4);
constexpr size_t WS_VT = WS_UT + (size_t)NEXP * D * 2;
constexpr size_t WS_US = WS_VT + (size_t)NEXP * D * 2;
constexpr size_t WS_VS = WS_US + (size_t)NEXP * 4;
constexpr size_t WS_FOXT = WS_VS + (size_t)NEXP * 4;
constexpr size_t WS_S5B = WS_FOXT + 256;
constexpr size_t WS_S5A = WS_S5B + (size_t)DEPTH * 16 * 2 * 64 * 16 * 2;
constexpr size_t WS_END = WS_S5A + (size_t)DEPTH * 16 * 64 * 16;
constexpr size_t WS_NV_TV = WS_SU;
constexpr size_t WS_NV_IDS = WS_DPART;
constexpr size_t WS_CIDX = WS_DPART;
constexpr size_t WS_CQ = WS_CIDX + (size_t)T * 128 * 2;
constexpr size_t WS_CSC = WS_CQ + (size_t)T * 128;
static_assert(WS_END <= (size_t)1024 * 1024 * 1024, "workspace map exceeds 1 GiB");
constexpr int CTL_BAR = 0;
constexpr int CTL_Q = 4096;

struct Args {
    const float* in[29];
    float* out;
    unsigned char* ws;
    int ph_lo, ph_hi;
    int use_bar, pad0;
};

__device__ __forceinline__ float bf2f(bf16_t v) { return __uint_as_float((unsigned)v << 16); }
__device__ __forceinline__ bf16_t f2bf(float f) { unsigned u = __float_as_uint(f); u += 0x7fffu + ((u >> 16) & 1u); return (bf16_t)(u >> 16); }
__device__ __forceinline__ unsigned pk2(float lo, float hi) { return (unsigned)f2bf(lo) | ((unsigned)f2bf(hi) << 16); }
__device__ __forceinline__ float gelu_tanh(float x) {
    const float u = 0.7978845608028654f * (x + 0.044715f * x * x * x);
    return x / (1.f + __expf(-2.f * u));
}
__device__ __forceinline__ float log_sigmoid(float x) { return x >= 0.f ? -log1pf(expf(-x)) : x - log1pf(expf(x)); }
__device__ __forceinline__ int t5_bucket(int dist) {
    int n = dist < 0 ? 0 : dist;
    float nf = (float)(n < 16 ? 16 : n);
    int large = 16 + (int)(logf(nf / 16.f) / logf(128.f) * 16.f);
    large = large < 31 ? large : 31;
    return n < 16 ? n : large;
}
__device__ __forceinline__ float wave_sum(float v) {
#pragma unroll
    for (int o = 32; o > 0; o >>= 1) v += __shfl_xor(v, o);
    return v;
}
__device__ __forceinline__ float half_swap_max(float m) {
    auto rr = __builtin_amdgcn_permlane32_swap(__float_as_uint(m), __float_as_uint(m), false, false);
    return fmaxf(__uint_as_float(rr[0]), __uint_as_float(rr[1]));
}
__device__ __forceinline__ float half_swap_sum(float m) {
    auto rr = __builtin_amdgcn_permlane32_swap(__float_as_uint(m), __float_as_uint(m), false, false);
    return __uint_as_float(rr[0]) + __uint_as_float(rr[1]);
}
}
namespace pg8 {
#define PG8_LAS __attribute__((address_space(3)))
typedef unsigned short bf16_t;
typedef short bf16x8 __attribute__((ext_vector_type(8)));
typedef float f32x4 __attribute__((ext_vector_type(4)));
typedef unsigned u32x4 __attribute__((ext_vector_type(4)));
constexpr int BM = 256, BK = 64, HALF = 128, HTB = HALF * BK * 2  , STAGE_BYTES = 8 * HTB, NXCD = 8, WGM = 8;

__host__ __device__ __forceinline__ int lds_byte(int r, int c) { const int st = (r >> 4) * 2 + (c >> 5), rr = r & 15, cc = c & 31, ob = rr * 64 + cc * 2; return st * 1024 + (ob ^ (((ob >> 9) & 1) << 5)); }
__host__ __device__ __forceinline__ void stage_rc(int b, int& R, int& C) { const int st = b / 1024, sb = b % 1024, swz = sb ^ (((sb >> 9) & 1) << 5); R = (st >> 1) * 16 + swz / 64; C = (st & 1) * 32 + (swz % 64) / 2; }
__host__ __device__ __forceinline__ int perm32(int rho) { const int n = rho >> 4, i = rho & 15; return 8 * (i >> 2) + 4 * n + (i & 3); }

struct Unit { int pm, pn; };
struct Gemm { const bf16_t* A; const bf16_t* Bt; int M, N, K; };

struct StaticOrder {
    int nM, nN, nwg, G, c;
    __host__ __device__ void init(int M, int N, int G_, int c_) { nM = M / BM; nN = N / BM; nwg = nM * nN; G = G_; c = c_; }
    __host__ __device__ bool next(int i, Unit& u) const {
        const long L = (long)i * G + c; if (L >= nwg) return false;
        int wgid = (int)L; { const int q = nwg / NXCD, r = nwg % NXCD, xcd = wgid % NXCD, off = wgid / NXCD; wgid = (xcd < r ? xcd * (q + 1) : r * (q + 1) + (xcd - r) * q) + off; }
        const int nig = WGM * nN, gid = wgid / nig, fm = gid * WGM, gsz = (nM - fm) < WGM ? (nM - fm) : WGM;
        u.pm = fm + ((wgid % nig) % gsz); u.pn = (wgid % nig) / gsz; return true;
    }
    __device__ __forceinline__ void a_ready(const Unit&) const {}
    __device__ __forceinline__ void done(const Unit&) const {}
};
typedef float f32x2e_t __attribute__((ext_vector_type(2))); typedef __bf16 bf16x2e_t __attribute__((ext_vector_type(2)));
__device__ __forceinline__ unsigned cvt_pk_bf16(float lo, float hi) { const f32x2e_t v = {lo, hi}; const bf16x2e_t b = __builtin_convertvector(v, bf16x2e_t); return __builtin_bit_cast(unsigned, b); }

struct EpiIn {
    static constexpr bool PERM = true, AFTER_DRAIN = false;
    bf16_t* zb; float* su32; const float* rstd;
    const float* g_fq; const float* g_fk; const float* g_dq; const float* g_dk; const float* g_cq; const float* g_ck;
    __device__ __forceinline__ void operator()(const f32x4 (&acc)[2][2][4][2], const Unit& u, int wr, int wc, int fr, int fq) const {
        const int pn = u.pn;
        const int mode = (pn == 0 || pn == 1 || pn == 3 || pn == 4) ? 1 : ((pn == 6 || pn == 7) ? 2 : (pn == 9 ? 3 : 0));
        const float* gp = pn == 0 ? g_fq : pn == 1 ? g_fk : pn == 3 ? g_dq : pn == 4 ? g_dk : pn == 6 ? g_cq : g_ck;
        const float qs = (pn == 0 || pn == 3) ? 0.125f * 1.4426950408889634f : (pn == 6 ? 0.17677669529663687f * 1.4426950408889634f : 1.f);
        f32x4 gv[2][2];
#pragma unroll
        for (int bj = 0; bj < 2; ++bj)
#pragma unroll
            for (int n = 0; n < 2; ++n) {
                if (mode == 1) gv[bj][n] = *(const f32x4*)(gp + 32 * bj + 8 * fq + 4 * n) * qs;
                else if (mode == 2) gv[bj][n] = *(const f32x4*)(gp + 8 * fq + 4 * n) * qs;
                else gv[bj][n] = (f32x4){1.f, 1.f, 1.f, 1.f};
            }
#pragma unroll
        for (int ai = 0; ai < 2; ++ai)
#pragma unroll
            for (int m = 0; m < 4; ++m) {
                const int row = u.pm * BM + ai * HALF + wr * 64 + m * 16 + fr;
                const float rs = rstd[row];
                f32x4 v[2][2];
                float ss[2];
#pragma unroll
                for (int bj = 0; bj < 2; ++bj) {
                    float s = 0.f;
#pragma unroll
                    for (int n = 0; n < 2; ++n) { v[bj][n] = acc[ai][bj][m][n] * rs; const f32x4 x = v[bj][n]; s += (x[0] * x[0] + x[1] * x[1]) + (x[2] * x[2] + x[3] * x[3]); }
                    ss[bj] = s;
                }
                if (mode == 1 || mode == 2) {
                    float s0 = ss[0], s1 = ss[1];
                    s0 += __shfl_xor(s0, 16); s0 += __shfl_xor(s0, 32); s1 += __shfl_xor(s1, 16); s1 += __shfl_xor(s1, 32);
                    float r0, r1;
                    if (mode == 1) { r0 = __builtin_amdgcn_rsqf((s0 + s1) * (1.f / 64.f) + 1e-6f); r1 = r0; }
                    else { r0 = __builtin_amdgcn_rsqf(s0 * (1.f / 32.f) + 1e-6f); r1 = __builtin_amdgcn_rsqf(s1 * (1.f / 32.f) + 1e-6f); }
#pragma unroll
                    for (int n = 0; n < 2; ++n) { v[0][n] = v[0][n] * r0 * gv[0][n]; v[1][n] = v[1][n] * r1 * gv[1][n]; }
                }
                if (mode == 3) {
                    bf16_t* op = (bf16_t*)su32 + (size_t)row * 256 + 64 * wc + 8 * fq;
#pragma unroll
                    for (int bj = 0; bj < 2; ++bj) { u32x4 w; w.x = cvt_pk_bf16(v[bj][0][0], v[bj][0][1]); w.y = cvt_pk_bf16(v[bj][0][2], v[bj][0][3]); w.z = cvt_pk_bf16(v[bj][1][0], v[bj][1][1]); w.w = cvt_pk_bf16(v[bj][1][2], v[bj][1][3]);
                        *(u32x4*)(op + 32 * bj) = w; }
                } else {
                    bf16_t* op = zb + (size_t)row * 2304 + pn * 256 + 64 * wc + 8 * fq;
#pragma unroll
                    for (int bj = 0; bj < 2; ++bj) { u32x4 w; w.x = cvt_pk_bf16(v[bj][0][0], v[bj][0][1]); w.y = cvt_pk_bf16(v[bj][0][2], v[bj][0][3]); w.z = cvt_pk_bf16(v[bj][1][0], v[bj][1][1]); w.w = cvt_pk_bf16(v[bj][1][2], v[bj][1][3]);
                        *(u32x4*)(op + 32 * bj) = w; }
                }
            }
    }
};
struct EpiOut {
    static constexpr bool PERM = true, AFTER_DRAIN = false;
    bf16_t* xb;
    __device__ __forceinline__ void operator()(const f32x4 (&acc)[2][2][4][2], const Unit& u, int wr, int wc, int fr, int fq) const {
#pragma unroll
        for (int ai = 0; ai < 2; ++ai)
#pragma unroll
            for (int m = 0; m < 4; ++m) {
                const int row = u.pm * BM + ai * HALF + wr * 64 + m * 16 + fr;
#pragma unroll
                for (int bj = 0; bj < 2; ++bj) {
                    const size_t off = (size_t)row * 1024 + u.pn * BM + bj * HALF + wc * 32 + 8 * fq;
                    const u32x4 o = *(const u32x4*)(xb + off);
                    const f32x4 a0 = acc[ai][bj][m][0], a1 = acc[ai][bj][m][1];
                    u32x4 w;
                    w.x = cvt_pk_bf16(__uint_as_float(o.x << 16) + a0[0], __uint_as_float(o.x & 0xffff0000u) + a0[1]);
                    w.y = cvt_pk_bf16(__uint_as_float(o.y << 16) + a0[2], __uint_as_float(o.y & 0xffff0000u) + a0[3]);
                    w.z = cvt_pk_bf16(__uint_as_float(o.z << 16) + a1[0], __uint_as_float(o.z & 0xffff0000u) + a1[1]);
                    w.w = cvt_pk_bf16(__uint_as_float(o.w << 16) + a1[2], __uint_as_float(o.w & 0xffff0000u) + a1[3]);
                    *(u32x4*)(xb + off) = w;
                }
            }
    }
};
struct EpiPlain {
    static constexpr bool PERM = true, AFTER_DRAIN = false;
    bf16_t* O; int ldc;
    __device__ __forceinline__ void operator()(const f32x4 (&acc)[2][2][4][2], const Unit& u, int wr, int wc, int fr, int fq) const {
#pragma unroll
        for (int ai = 0; ai < 2; ++ai)
#pragma unroll
            for (int m = 0; m < 4; ++m) {
                const int row = u.pm * BM + ai * HALF + wr * 64 + m * 16 + fr;
#pragma unroll
                for (int bj = 0; bj < 2; ++bj) {
                    const size_t off = (size_t)row * ldc + u.pn * BM + bj * HALF + wc * 32 + 8 * fq;
                    const f32x4 a = acc[ai][bj][m][0], b = acc[ai][bj][m][1];
                    u32x4 w; w.x = cvt_pk_bf16(a[0], a[1]); w.y = cvt_pk_bf16(a[2], a[3]); w.z = cvt_pk_bf16(b[0], b[1]); w.w = cvt_pk_bf16(b[2], b[3]);
                    *(u32x4*)(O + off) = w;
                }
            }
    }
};
typedef _Float16 f16x2e_t __attribute__((ext_vector_type(2)));
__device__ __forceinline__ unsigned cvt_pk_f16(float lo, float hi) { const f32x2e_t v = {lo, hi}; const f16x2e_t b = __builtin_convertvector(v, f16x2e_t); return __builtin_bit_cast(unsigned, b); }
struct EpiF16 {
    static constexpr bool PERM = true, AFTER_DRAIN = false;
    bf16_t* O; int ldc;
    __device__ __forceinline__ void operator()(const f32x4 (&acc)[2][2][4][2], const Unit& u, int wr, int wc, int fr, int fq) const {
#pragma unroll
        for (int ai = 0; ai < 2; ++ai)
#pragma unroll
            for (int m = 0; m < 4; ++m) {
                const int row = u.pm * BM + ai * HALF + wr * 64 + m * 16 + fr;
#pragma unroll
                for (int bj = 0; bj < 2; ++bj) {
                    const size_t off = (size_t)row * ldc + u.pn * BM + bj * HALF + wc * 32 + 8 * fq;
                    const f32x4 a = acc[ai][bj][m][0], b = acc[ai][bj][m][1];
                    u32x4 w; w.x = cvt_pk_f16(a[0], a[1]); w.y = cvt_pk_f16(a[2], a[3]); w.z = cvt_pk_f16(b[0], b[1]); w.w = cvt_pk_f16(b[2], b[3]);
                    *(u32x4*)(O + off) = w;
                }
            }
    }
};
template <class Epi, class Sched, bool ALIGN_EPI = false, bool SP2 = false>
__device__ __forceinline__ void gemm_phase(PG8_LAS unsigned char* lds, const Gemm g, const Sched& S, const Epi& E) {
    const int tid = threadIdx.x, wid = __builtin_amdgcn_readfirstlane(tid >> 6), lane = tid & 63, wr = wid >> 2, wc = wid & 3, fr = lane & 15, fq = lane >> 4;
    const int K = g.K, nt = K / BK;
    unsigned voffA[2], voffB[2];
#pragma unroll
    for (int i = 0; i < 2; ++i) { int R, C; stage_rc(tid * 16 + i * 8192, R, C); const int Rb = Epi::PERM ? ((R & ~31) + perm32(R & 31)) : R;
        voffA[i] = (unsigned)(R * K + C) * 2u; voffB[i] = (unsigned)(Rb * K + C) * 2u; }
    const size_t kstep = (size_t)(BK * 2);
    const size_t hstep = (size_t)HALF * K * 2;
    const size_t tstep = 2 * hstep;
    const unsigned ldsw = (unsigned)wid * 1024u;
    const int aoff = lds_byte(wr * 64 + fr, fq * 8), boff = lds_byte(wc * 32 + fr, fq * 8);
#define PG8_SA(b, h) (((b) * 2 + (h)) * HTB)
#define PG8_SB(b, h) ((4 + (b) * 2 + (h)) * HTB)
#define PG8_STAGE(bufoff, gbase, voff) do { _Pragma("unroll") for (int _i = 0; _i < 2; ++_i) \
        __builtin_amdgcn_global_load_lds((const unsigned*)((const char*)(gbase) + (voff)[_i]), (PG8_LAS unsigned*)(lds + (bufoff) + ldsw + _i * 8192), 16, 0, 0); } while (0)
#define PG8_LDA(dst, b, h) do { _Pragma("unroll") for (int m = 0; m < 4; ++m) _Pragma("unroll") for (int k = 0; k < 2; ++k) dst[m][k] = *(const PG8_LAS bf16x8*)(lds + PG8_SA(b, h) + aoff + m * 2048 + k * 1024); } while (0)
#define PG8_LDB(dst, b, h) do { _Pragma("unroll") for (int n = 0; n < 2; ++n) _Pragma("unroll") for (int k = 0; k < 2; ++k) dst[n][k] = *(const PG8_LAS bf16x8*)(lds + PG8_SB(b, h) + boff + n * 2048 + k * 1024); } while (0)
#define PG8_MMA(ai, bj, At, Bt) do { __builtin_amdgcn_s_setprio(1); _Pragma("unroll") for (int m = 0; m < 4; ++m) _Pragma("unroll") for (int n = 0; n < 2; ++n) _Pragma("unroll") for (int k = 0; k < 2; ++k) \
        acc[ai][bj][m][n] = __builtin_amdgcn_mfma_f32_16x16x32_bf16(Bt[n][k], At[m][k], acc[ai][bj][m][n], 0, 0, 0); __builtin_amdgcn_s_setprio(0); } while (0)
#define PG8_WAIT_V(n) asm volatile("s_waitcnt vmcnt(" #n ")" ::: "memory")
#define PG8_WAIT_L(n) asm volatile("s_waitcnt lgkmcnt(" #n ")" ::: "memory")
#define PG8_BAR __builtin_amdgcn_s_barrier()
#define PG8_SCHED __builtin_amdgcn_sched_barrier(0)
    Unit cur, nxt; int ui = 0;
    if (!S.next(0, cur)) return;
    f32x4 acc[2][2][4][2];
#pragma unroll
    for (int a = 0; a < 2; ++a)
#pragma unroll
        for (int b = 0; b < 2; ++b)
#pragma unroll
            for (int m = 0; m < 4; ++m)
#pragma unroll
                for (int n = 0; n < 2; ++n) acc[a][b][m][n] = (f32x4){0.f, 0.f, 0.f, 0.f};
    bf16x8 At[4][2], B0[2][2], B1[2][2];
    const char* cA = (const char*)g.A + (size_t)cur.pm * tstep; const char* cB = (const char*)g.Bt + (size_t)cur.pn * tstep;
    S.a_ready(cur);
    if constexpr (SP2) {
        PG8_STAGE(PG8_SB(0, 0), cB, voffB); PG8_STAGE(PG8_SB(0, 1), cB + hstep, voffB); PG8_STAGE(PG8_SA(0, 0), cA, voffA); PG8_STAGE(PG8_SA(0, 1), cA + hstep, voffA);
        if (wr == 1) PG8_BAR;
        PG8_WAIT_V(2); PG8_BAR;
        PG8_STAGE(PG8_SB(1, 0), cB + kstep, voffB); PG8_STAGE(PG8_SA(1, 0), cA + kstep, voffA); PG8_STAGE(PG8_SB(1, 1), cB + hstep + kstep, voffB);
        PG8_WAIT_V(6); PG8_BAR;
    } else {
        PG8_STAGE(PG8_SB(0, 0), cB, voffB); PG8_STAGE(PG8_SA(0, 0), cA, voffA); PG8_STAGE(PG8_SB(0, 1), cB + hstep, voffB); PG8_STAGE(PG8_SA(0, 1), cA + hstep, voffA);
        if (wr == 1) PG8_BAR;
        PG8_WAIT_V(4); PG8_BAR;
        PG8_STAGE(PG8_SB(1, 0), cB + kstep, voffB); PG8_STAGE(PG8_SA(1, 0), cA + kstep, voffA); PG8_STAGE(PG8_SB(1, 1), cB + hstep + kstep, voffB);
        PG8_WAIT_V(6); PG8_BAR;
    }
    for (;;) {
        const bool has_next = S.next(ui + 1, nxt);
        const char* nA = has_next ? (const char*)g.A + (size_t)nxt.pm * tstep : cA; const char* nB = has_next ? (const char*)g.Bt + (size_t)nxt.pn * tstep : cB;
        for (int t = 0; t < nt; t += 2) {
            const bool last = (t == nt - 2);
            const char* a1 = cA + (size_t)(t + 1) * kstep;
            const char* a2 = last ? nA : cA + (size_t)(t + 2) * kstep; const char* b2 = last ? nB : cB + (size_t)(t + 2) * kstep;
            const char* a3 = a2 + kstep; const char* b3 = b2 + kstep;
            if (last && has_next) S.a_ready(nxt);
            if constexpr (SP2) {
            PG8_LDB(B0, 0, 0); PG8_LDB(B1, 0, 1); PG8_SCHED; PG8_LDA(At, 0, 0); PG8_STAGE(PG8_SA(1, 1), a1 + hstep, voffA);
            PG8_WAIT_V(8); PG8_WAIT_L(0); PG8_BAR; PG8_MMA(0, 0, At, B0); PG8_MMA(0, 1, At, B1); PG8_BAR; PG8_SCHED;
            PG8_LDA(At, 0, 1); PG8_STAGE(PG8_SB(0, 0), b2, voffB); PG8_STAGE(PG8_SB(0, 1), b2 + hstep, voffB); PG8_STAGE(PG8_SA(0, 0), a2, voffA);
            PG8_WAIT_V(8); PG8_WAIT_L(0); PG8_BAR; PG8_MMA(1, 0, At, B0); PG8_MMA(1, 1, At, B1); PG8_BAR; PG8_SCHED;
            PG8_LDB(B0, 1, 0); PG8_LDB(B1, 1, 1); PG8_SCHED; PG8_LDA(At, 1, 0); PG8_STAGE(PG8_SA(0, 1), a2 + hstep, voffA);
            PG8_WAIT_V(8); PG8_WAIT_L(0); PG8_BAR; PG8_MMA(0, 0, At, B0); PG8_MMA(0, 1, At, B1); PG8_BAR; PG8_SCHED;
            PG8_LDA(At, 1, 1); PG8_STAGE(PG8_SB(1, 0), b3, voffB); PG8_STAGE(PG8_SB(1, 1), b3 + hstep, voffB); PG8_STAGE(PG8_SA(1, 0), a3, voffA);
            PG8_WAIT_V(8); PG8_WAIT_L(0); PG8_BAR; PG8_MMA(1, 0, At, B0); PG8_MMA(1, 1, At, B1); PG8_BAR; PG8_SCHED;
            } else {
            PG8_LDB(B0, 0, 0); PG8_SCHED; PG8_LDA(At, 0, 0); PG8_STAGE(PG8_SA(1, 1), a1 + hstep, voffA);
            PG8_WAIT_L(8); PG8_BAR; PG8_WAIT_L(0); PG8_MMA(0, 0, At, B0); PG8_BAR; PG8_SCHED;
            PG8_LDB(B1, 0, 1); PG8_STAGE(PG8_SB(0, 0), b2, voffB);
            PG8_BAR; PG8_WAIT_L(0); PG8_MMA(0, 1, At, B1); PG8_BAR;
            PG8_LDA(At, 0, 1); PG8_STAGE(PG8_SA(0, 0), a2, voffA);
            PG8_BAR; PG8_WAIT_L(0); PG8_MMA(1, 0, At, B0); PG8_BAR; PG8_SCHED;
            PG8_STAGE(PG8_SB(0, 1), b2 + hstep, voffB);
            PG8_WAIT_V(6); PG8_BAR; PG8_MMA(1, 1, At, B1); PG8_BAR;
            PG8_LDB(B0, 1, 0); PG8_SCHED; PG8_LDA(At, 1, 0); PG8_STAGE(PG8_SA(0, 1), a2 + hstep, voffA);
            PG8_WAIT_L(8); PG8_BAR; PG8_WAIT_L(0); PG8_MMA(0, 0, At, B0); PG8_BAR; PG8_SCHED;
            PG8_LDB(B1, 1, 1); PG8_STAGE(PG8_SB(1, 0), b3, voffB);
            PG8_BAR; PG8_WAIT_L(0); PG8_MMA(0, 1, At, B1); PG8_BAR;
            PG8_LDA(At, 1, 1); PG8_STAGE(PG8_SA(1, 0), a3, voffA);
            PG8_BAR; PG8_WAIT_L(0); PG8_MMA(1, 0, At, B0); PG8_BAR; PG8_SCHED;
            PG8_STAGE(PG8_SB(1, 1), b3 + hstep, voffB);
            PG8_WAIT_V(6); PG8_BAR; PG8_MMA(1, 1, At, B1); PG8_BAR;
            }
        }
        if constexpr (ALIGN_EPI) { if (wr == 0) PG8_BAR; }
        if constexpr (!Epi::AFTER_DRAIN) { E(acc, cur, wr, wc, fr, fq); S.done(cur); }
        if (!has_next) break;
#pragma unroll
        for (int a = 0; a < 2; ++a)
#pragma unroll
            for (int b = 0; b < 2; ++b)
#pragma unroll
                for (int m = 0; m < 4; ++m)
#pragma unroll
                    for (int n = 0; n < 2; ++n) acc[a][b][m][n] = (f32x4){0.f, 0.f, 0.f, 0.f};
        cur = nxt; cA = nA; cB = nB; ++ui;
        if constexpr (ALIGN_EPI) { if (wr == 1) PG8_BAR; }
    }
    PG8_WAIT_V(0);
    if constexpr (!ALIGN_EPI) { if (wr == 0) PG8_BAR; }
    PG8_BAR;
    if constexpr (Epi::AFTER_DRAIN) { E.fused(acc, cur, wr, wc, fr, fq, lds, wid, lane); S.done(cur); }
#undef PG8_SA
#undef PG8_SB
#undef PG8_STAGE
#undef PG8_LDA
#undef PG8_LDB
#undef PG8_MMA
#undef PG8_WAIT_V
#undef PG8_WAIT_L
#undef PG8_BAR
#undef PG8_SCHED
}
}
#define XB_TMO      128
#define XB_XCNT(j)  (256  + 64 * (j))
#define XB_XSUB(j)  (1280 + 64 * (j))
#define XB_XGEN(j)  (2304 + 64 * (j))
#define XB_TOP      3328
#define XB_TOPGEN   3392
#define XCD_BAR_WORDS 3456
#define XB_SPIN_CAP (1u << 18)
#define LAS __attribute__((address_space(3)))

__device__ __forceinline__ unsigned xb_ld(unsigned* p)              { return __hip_atomic_load(p, __ATOMIC_RELAXED, __HIP_MEMORY_SCOPE_AGENT); }
__device__ __forceinline__ unsigned xb_add(unsigned* p, unsigned v) { return __hip_atomic_fetch_add(p, v, __ATOMIC_RELAXED, __HIP_MEMORY_SCOPE_AGENT); }
__device__ __forceinline__ unsigned xb_xcc_id() { return (unsigned)__builtin_amdgcn_s_getreg((3 << 11) | 20) & 0xFu; }
#define XB_SPIN(cond, bar) do { unsigned _sp = 0; while (cond) { __builtin_amdgcn_s_sleep(1); \
    if ((++_sp & 255u) == 0u) { if (xb_ld(&(bar)[XB_TMO])) break; if (_sp > XB_SPIN_CAP) { atomicAdd(&(bar)[XB_TMO], 1u); break; } } } } while (0)

struct XcdBarrier {
    unsigned* bar; unsigned x;
    volatile LAS unsigned* st;
};

__device__ __forceinline__ XcdBarrier xcd_barrier_post(unsigned* bar, volatile LAS unsigned* st) {
    XcdBarrier b; b.bar = bar; b.x = xb_xcc_id(); b.st = st;
    if (threadIdx.x == 0) (void)xb_add(&bar[XB_XCNT(b.x)], 1u);
    return b;
}
__device__ __forceinline__ void xcd_barrier_complete(unsigned* bar, unsigned x, unsigned& nloc, unsigned& nx) {
    const unsigned G = gridDim.x * gridDim.y * gridDim.z;
    unsigned sum, cnt, mine, sp = 0u;
    for (;;) {
        sum = 0u; cnt = 0u; mine = 0u;
#pragma unroll
        for (unsigned j = 0; j < 16; ++j) { const unsigned c = xb_ld(&bar[XB_XCNT(j)]); sum += c; cnt += (c > 0u) ? 1u : 0u; mine = (j == x) ? c : mine; }
        if (sum == G) break;
        __builtin_amdgcn_s_sleep(1);
        if ((++sp & 255u) == 0u) { if (xb_ld(&bar[XB_TMO])) break; if (sp > XB_SPIN_CAP) { atomicAdd(&bar[XB_TMO], 1u); break; } }
    }
    nloc = mine > 0u ? mine : 1u; nx = cnt > 0u ? cnt : 1u;
}

__device__ __forceinline__ void xcd_barrier(const XcdBarrier& b) {
    asm volatile("s_waitcnt vmcnt(0)" ::: "memory");
    __syncthreads();
    if (threadIdx.x == 0) {
        unsigned* bar = b.bar;
        __builtin_amdgcn_s_waitcnt(0);
        unsigned nloc = b.st[0], nx = b.st[1];
        if (nloc == 0u) { xcd_barrier_complete(bar, b.x, nloc, nx); b.st[0] = nloc; b.st[1] = nx; }
        const unsigned old = xb_add(&bar[XB_XSUB(b.x)], 1u);
        const unsigned gen = old / nloc;
        if (old + 1u == (gen + 1u) * nloc) {
            __builtin_amdgcn_fence(__ATOMIC_RELEASE, "agent");
            asm volatile("s_waitcnt vmcnt(0)" ::: "memory");
            const unsigned og = xb_add(&bar[XB_TOP], 1u);
            const unsigned tg = og / nx;
            if (og + 1u == (tg + 1u) * nx) xb_add(&bar[XB_TOPGEN], 1u);
            else XB_SPIN(xb_ld(&bar[XB_TOPGEN]) == tg, bar);
            __builtin_amdgcn_fence(__ATOMIC_ACQUIRE, "agent");
            xb_add(&bar[XB_XGEN(b.x)], 1u);
            asm volatile("s_waitcnt vmcnt(0)" ::: "memory");
        } else {
            XB_SPIN(xb_ld(&bar[XB_XGEN(b.x)]) == gen, bar);
            __builtin_amdgcn_fence(__ATOMIC_ACQUIRE, "agent");
            asm volatile("s_waitcnt vmcnt(0)" ::: "memory");
        }
    }
    __syncthreads();
}
namespace hk {
__device__ __forceinline__ int inproj_src_col(int np) {
    const int pn = np >> 8, p = np & 255, bj = p >> 7, wc = (p >> 5) & 3, i = p & 31;
    const int nl = pn * 256 + 64 * wc + 32 * bj + i;
    return nl < 768 ? nl : nl + 4;
}
template <bool INMAP>
__device__ __forceinline__ void tr_tile(const float* __restrict__ src, int ld, const float* __restrict__ g, bf16_t* __restrict__ dst, int K, int k0, int n0, float* lds) {
    const int tid = threadIdx.x;
#pragma unroll
    for (int i = 0; i < 8; ++i) {
        const int idx = tid + 512 * i, kk = idx >> 6, nn = idx & 63;
        const int col = INMAP ? inproj_src_col(n0 + nn) : (n0 + nn);
        float v = src[(size_t)(k0 + kk) * ld + col];
        if (g) v *= g[k0 + kk];
        lds[nn * 65 + kk] = v;
    }
    __syncthreads();
#pragma unroll
    for (int i = 0; i < 8; ++i) {
        const int idx = tid + 512 * i, nn = idx >> 6, kk = idx & 63;
        dst[(size_t)(n0 + nn) * K + k0 + kk] = f2bf(lds[nn * 65 + kk]);
    }
    __syncthreads();
}
__device__ __forceinline__ void fold_keys_tile(const float* __restrict__ wq, const float* __restrict__ keys, const float* __restrict__ g, bf16_t* __restrict__ dst, int hp, int k0, float* lds) {
    const int tid = threadIdx.x;
    float* ws_ = lds; float* ks_ = lds + 64 * 129;
    for (int i = tid; i < 64 * 128; i += NTHR) { const int kk = i >> 7, d = i & 127; ws_[kk * 129 + d] = wq[(size_t)(k0 + kk) * 2048 + hp * 128 + d]; }
    for (int i = tid; i < 128 * 128; i += NTHR) { const int ky = i >> 7, d = i & 127; ks_[ky * 129 + d] = keys[(size_t)hp * 128 * 128 + i]; }
    __syncthreads();
    const int key = tid & 127, kg = tid >> 7;
    float acc[16];
#pragma unroll
    for (int i = 0; i < 16; ++i) acc[i] = 0.f;
    for (int d = 0; d < 128; ++d) { const float kv = ks_[key * 129 + d];
#pragma unroll
        for (int i = 0; i < 16; ++i) acc[i] += ws_[(kg * 16 + i) * 129 + d] * kv; }
    u32x4 o0, o1; const float* gp = g + k0 + kg * 16;
    o0.x = pk2(acc[0] * gp[0], acc[1] * gp[1]); o0.y = pk2(acc[2] * gp[2], acc[3] * gp[3]); o0.z = pk2(acc[4] * gp[4], acc[5] * gp[5]); o0.w = pk2(acc[6] * gp[6], acc[7] * gp[7]);
    o1.x = pk2(acc[8] * gp[8], acc[9] * gp[9]); o1.y = pk2(acc[10] * gp[10], acc[11] * gp[11]); o1.z = pk2(acc[12] * gp[12], acc[13] * gp[13]); o1.w = pk2(acc[14] * gp[14], acc[15] * gp[15]);
    bf16_t* op = dst + (size_t)(hp * 128 + key) * 1024 + k0 + kg * 16;
    *(u32x4*)op = o0; *(u32x4*)(op + 8) = o1;
    __syncthreads();
}
__device__ __forceinline__ void phase_weights(const Args& a, unsigned char* ldsb) {
    float* lds = (float*)ldsb;
    const int G = gridDim.x, bid = blockIdx.x, tid = threadIdx.x;
    const float* w_in = a.in[1]; const float* w_out = a.in[3]; const float* norm_mix = a.in[4]; const float* norm_ffn = a.in[5];
    const float* glu_w = a.in[23]; const float* wq = a.in[25]; const float* keys = a.in[26]; const float* relb = a.in[14];
    bf16_t* WIN = (bf16_t*)(a.ws + WS_WIN); bf16_t* WOUT = (bf16_t*)(a.ws + WS_WOUT); bf16_t* WQ = (bf16_t*)(a.ws + WS_WQ); bf16_t* GLU = (bf16_t*)(a.ws + WS_GLU);
    for (int u = bid; u < DEPTH * 1424; u += G) {
        const int l = u / 1424; int r = u % 1424;
        if (r < 640) { const int nt = r >> 4, kt = r & 15; tr_tile<true>(w_in + (size_t)l * D * INW, INW, norm_mix + l * D, WIN + (size_t)l * 2560 * 1024, 1024, kt * 64, nt * 64, lds); }
        else if (r < 896) { r -= 640; const int nt = r >> 4, kt = r & 15; tr_tile<false>(w_out + (size_t)l * D * D, D, nullptr, WOUT + (size_t)l * 1024 * 1024, 1024, kt * 64, nt * 64, lds); }
        else if (r < 1408) { r -= 896;
#if HK_FOLD_KEYS
            if (r < 256) fold_keys_tile(wq + (size_t)l * D * 2048, keys + (size_t)l * 16 * 128 * 128, norm_ffn + l * D, WQ + (size_t)l * 2048 * 1024, r >> 4, (r & 15) * 64, lds);
#else
            const int nt = r >> 4, kt = r & 15; tr_tile<false>(wq + (size_t)l * D * 2048, 2048, norm_ffn + l * D, WQ + (size_t)l * 2048 * 1024, 1024, kt * 64, nt * 64, lds);
#endif
        }
        else { r -= 1408; const int nt = r >> 2, kt = r & 3; tr_tile<false>(glu_w + (size_t)l * 65536, 256, nullptr, GLU + (size_t)l * 65536, 256, kt * 64, nt * 64, lds); }
    }
    const int gt = bid * NTHR + tid, gn = G * NTHR;
    float* WF = (float*)(a.ws + WS_WF);
    for (int i = gt; i < DEPTH * 4 * 1024; i += gn) { const int l = i >> 12, h = (i >> 10) & 3, k = i & 1023; WF[i] = norm_mix[l * D + k] * w_in[((size_t)l * D + k) * INW + 768 + h]; }
    bf16_t* KB = (bf16_t*)(a.ws + WS_KEYS);
    for (int i = gt; i < DEPTH * 16 * 128 * 128; i += gn) KB[i] = f2bf(keys[i]);
    if (gt < DEPTH) { float gq = 0.f, gk = 0.f; for (int i = 0; i < 64; ++i) { gq = fmaxf(gq, fabsf(a.in[6][gt * 64 + i])); gk = fmaxf(gk, fabsf(a.in[7][gt * 64 + i])); }
        ((float*)(a.ws + WS_FOXT))[gt] = 2.f * 1.02f * 0.125f * LOG2E * 64.f * gq * gk + 40.f; }
#ifndef HK_T_NOS5TAB
    for (int i = gt; i < DEPTH * 16 * 64; i += gn) {
        const int lg = i >> 6, st = i & 63;
        const float dt = expf(a.in[17][lg]);
        const float ar = a.in[15][lg * 64 + st], ai = a.in[16][lg * 64 + st];
        const float dtar = dt * ar, dtai = dt * ai, mag = expf(dtar);
        const float abr = mag * cosf(dtai), abi = mag * sinf(dtai);
        const float den = ar * ar + ai * ai, nr = abr - 1.f, ni = abi;
        const float cr = (nr * ar + ni * ai) / den, ci = (ni * ar - nr * ai) / den;
        const float mg = expf(64.f * dtar);
        ((f32x4*)(a.ws + WS_S5A))[i] = (f32x4){abr, abi, mg * cosf(64.f * dtai), mg * sinf(64.f * dtai)};
        const float* brp = a.in[18] + ((size_t)lg * 64 + st) * 16; const float* bip = a.in[19] + ((size_t)lg * 64 + st) * 16;
        bf16_t* ore = (bf16_t*)(a.ws + WS_S5B) + ((size_t)(lg * 2) * 64 + st) * 16; bf16_t* oim = ore + 64 * 16;
        for (int c = 0; c < 16; ++c) { const float br = brp[c], bi = bip[c]; ore[c] = f2bf(cr * br - ci * bi); oim[c] = f2bf(cr * bi + ci * br); }
    }
#endif
    float* TB = (float*)(a.ws + WS_TB);
    for (int i = gt; i < 8 * TBN; i += gn) { const int hh = i / TBN, d = i % TBN; TB[i] = relb[t5_bucket(d) * 8 + hh] * LOG2E; }
}

__device__ __forceinline__ void load_row16(const float* __restrict__ p, int lane, float (&xv)[16]) {
#pragma unroll
    for (int j = 0; j < 4; ++j) { const f32x4 t = *(const f32x4*)(p + 16 * lane + 4 * j); xv[4 * j] = t[0]; xv[4 * j + 1] = t[1]; xv[4 * j + 2] = t[2]; xv[4 * j + 3] = t[3]; }
}
__device__ __forceinline__ void load_row16_bf(const bf16_t* __restrict__ p, int slot, float (&xv)[16]) {
    const u32x4 a = *(const u32x4*)(p + 16 * slot), b = *(const u32x4*)(p + 16 * slot + 8);
#pragma unroll
    for (int j = 0; j < 4; ++j) { xv[2 * j] = __uint_as_float(a[j] << 16); xv[2 * j + 1] = __uint_as_float(a[j] & 0xffff0000u); xv[8 + 2 * j] = __uint_as_float(b[j] << 16); xv[8 + 2 * j + 1] = __uint_as_float(b[j] & 0xffff0000u); }
}
__device__ __forceinline__ void finish_token(int tok, const float (&xv)[16], float* __restrict__ xo, bf16_t* __restrict__ xb, float* __restrict__ rstd,
                                             const float* __restrict__ wf, const float* __restrict__ bfor, float* __restrict__ flog, int lane, int slot) {
    float ss = 0.f;
#pragma unroll
    for (int i = 0; i < 16; ++i) ss += xv[i] * xv[i];
    ss = wave_sum(ss);
    const float rs = __builtin_amdgcn_rsqf(ss * (1.f / 1024.f) + EPS);
    float* op = xo + (size_t)tok * D + 16 * slot; bf16_t* bp = xb + (size_t)tok * D + 16 * slot;
    if (xo) {
#pragma unroll
        for (int j = 0; j < 4; ++j) *(f32x4*)(op + 4 * j) = (f32x4){xv[4 * j], xv[4 * j + 1], xv[4 * j + 2], xv[4 * j + 3]};
    }
    u32x4 w0, w1;
    w0.x = pk2(xv[0], xv[1]); w0.y = pk2(xv[2], xv[3]); w0.z = pk2(xv[4], xv[5]); w0.w = pk2(xv[6], xv[7]);
    w1.x = pk2(xv[8], xv[9]); w1.y = pk2(xv[10], xv[11]); w1.z = pk2(xv[12], xv[13]); w1.w = pk2(xv[14], xv[15]);
    *(u32x4*)(bp) = w0; *(u32x4*)(bp + 8) = w1;
    if (lane == 0) rstd[tok] = rs;
    if (wf) {
        float myff = 0.f;
#pragma unroll
        for (int h = 0; h < 4; ++h) {
            const float* wp = wf + h * 1024 + 16 * slot;
            float d = 0.f;
#pragma unroll
            for (int j = 0; j < 4; ++j) { const f32x4 t = *(const f32x4*)(wp + 4 * j); d += xv[4 * j] * t[0] + xv[4 * j + 1] * t[1] + xv[4 * j + 2] * t[2] + xv[4 * j + 3] * t[3]; }
            d = wave_sum(d);
            if (lane == h) myff = d;
        }
        if (lane < 4) { const int b = tok / S, s = tok % S; flog[((size_t)b * 4 + lane) * S + s] = log_sigmoid(myff * rs + bfor[lane]); }
    }
}
__device__ __forceinline__ void phase_xprep(const Args& a) {
    const int lane = threadIdx.x & 63, wv = blockIdx.x * 8 + (threadIdx.x >> 6), nw = gridDim.x * 8;
    const float* x = a.in[0];
    for (int tok = wv; tok < T; tok += nw) {
        float xv[16]; load_row16(x + (size_t)tok * D, lane, xv);
        finish_token(tok, xv, nullptr, (bf16_t*)(a.ws + WS_XB), (float*)(a.ws + WS_RSTD), (const float*)(a.ws + WS_WF), a.in[2], (float*)(a.ws + WS_FLOG), lane, lane);
    }
}
__device__ __forceinline__ void cum_scan(const Args& a, unsigned char* ldsb, int bh) {
    float* lds = (float*)ldsb;
    const int tid = threadIdx.x, lane = tid & 63, w = tid >> 6;
    const float* fl = (const float*)(a.ws + WS_FLOG) + (size_t)bh * S + tid * 16;
    float v[16];
#pragma unroll
    for (int i = 0; i < 4; ++i) { const f32x4 t = *(const f32x4*)(fl + 4 * i); v[4 * i] = t[0]; v[4 * i + 1] = t[1]; v[4 * i + 2] = t[2]; v[4 * i + 3] = t[3]; }
#pragma unroll
    for (int i = 1; i < 16; ++i) v[i] += v[i - 1];
    float incl = v[15];
#pragma unroll
    for (int o = 1; o < 64; o <<= 1) { const float t = __shfl_up(incl, o); if (lane >= o) incl += t; }
    if (lane == 63) lds[w] = incl;
    __syncthreads();
    float base = incl - v[15];
    for (int j = 0; j < w; ++j) base += lds[j];
    float* cp = (float*)(a.ws + WS_CUM) + (size_t)bh * S + tid * 16;
#pragma unroll
    for (int i = 0; i < 4; ++i) *(f32x4*)(cp + 4 * i) = (f32x4){(base + v[4 * i]) * LOG2E, (base + v[4 * i + 1]) * LOG2E, (base + v[4 * i + 2]) * LOG2E, (base + v[4 * i + 3]) * LOG2E};
    __syncthreads();
}

constexpr int AT_KP = 176, AT_KB = 64 * AT_KP, AT_KS = 0, AT_VP = 192, AT_VB = 64 * AT_VP, AT_VT = 2 * AT_KB, AT_TBL = AT_VT + 2 * AT_VB, AT_END = AT_TBL + TBN * 4;
__device__ __forceinline__ int swap23(int i) { return (i & ~12) | ((i & 4) << 1) | ((i & 8) >> 1); }
#define MFMA32(A, B, C) __builtin_amdgcn_mfma_f32_32x32x16_bf16(A, B, C, 0, 0, 0)
#define MFMA_DRAIN2(x, y) asm volatile("s_nop 15\n\ts_nop 15\n\ts_nop 7" : "+v"(x), "+v"(y))
typedef float f32x2_t __attribute__((ext_vector_type(2))); typedef __bf16 bf16x2_t __attribute__((ext_vector_type(2)));
__device__ __forceinline__ float max3f(float a, float b, float c) { return __builtin_fmaxf(__builtin_fmaxf(a, b), c); }
__device__ __forceinline__ unsigned cvtpk(float lo, float hi) { const f32x2_t v = {lo, hi}; const bf16x2_t b = __builtin_convertvector(v, bf16x2_t); return __builtin_bit_cast(unsigned, b); }
__device__ __forceinline__ bf16x8 pack8(const f32x16& p, int s8) {
    u32x4 w; w.x = cvtpk(p[s8], p[s8 + 1]); w.y = cvtpk(p[s8 + 2], p[s8 + 3]); w.z = cvtpk(p[s8 + 4], p[s8 + 5]); w.w = cvtpk(p[s8 + 6], p[s8 + 7]);
    return __builtin_bit_cast(bf16x8, w);
}
__device__ __forceinline__ void split3(float x, float& b1, float& b2, float& b3) {
    b1 = bf2f(f2bf(x)); const float r = x - b1; b2 = bf2f(f2bf(r)); b3 = bf2f(f2bf(r - b2));
}
__device__ __forceinline__ void stage_kv(unsigned char* lds, int buf, int kv_s, int c_s, const u32x4& kreg, const u32x4& vreg) {
    *(u32x4*)(lds + AT_KS + buf * AT_KB + kv_s * AT_KP + 16 * c_s) = kreg;
    *(u32x4*)(lds + AT_VT + buf * AT_VB + kv_s * AT_VP + 16 * c_s) = vreg;
}
struct SMState { float mref, l; };
template <int NP>
__device__ __forceinline__ void softmax_step(f32x16 (&p)[NP], SMState& st, bool& refzero, f32x16 (&o)[2]) {
    float a = max3f(p[0][0], p[0][1], p[0][2]), b = max3f(p[0][3], p[0][4], p[0][5]);
    a = max3f(a, p[0][6], p[0][7]); b = max3f(b, p[0][8], p[0][9]); a = max3f(a, p[0][10], p[0][11]); b = max3f(b, p[0][12], p[0][13]); a = max3f(a, p[0][14], p[0][15]);
    if (NP == 2) { b = max3f(b, p[NP - 1][0], p[NP - 1][1]); a = max3f(a, p[NP - 1][2], p[NP - 1][3]); b = max3f(b, p[NP - 1][4], p[NP - 1][5]); a = max3f(a, p[NP - 1][6], p[NP - 1][7]);
        b = max3f(b, p[NP - 1][8], p[NP - 1][9]); a = max3f(a, p[NP - 1][10], p[NP - 1][11]); b = max3f(b, p[NP - 1][12], p[NP - 1][13]); a = max3f(a, p[NP - 1][14], p[NP - 1][15]); }
    const float rm = half_swap_max(fmaxf(a, b));
    if (__any(rm - st.mref > 20.f)) {
        const float nr = (rm - st.mref > 20.f) ? rm : st.mref;
        const float f = __builtin_amdgcn_exp2f(st.mref - nr);
        st.l *= f;
#pragma unroll
        for (int r = 0; r < 16; ++r) { o[0][r] *= f; o[1][r] *= f; }
        st.mref = nr; refzero = false;
    }
    if (!refzero) {
#pragma unroll
        for (int i = 0; i < NP; ++i)
#pragma unroll
            for (int r = 0; r < 16; ++r) p[i][r] -= st.mref;
    }
    float ps = 0.f;
#pragma unroll
    for (int i = 0; i < NP; ++i)
#pragma unroll
        for (int r = 0; r < 16; ++r) { const float e = __builtin_amdgcn_exp2f(p[i][r]); p[i][r] = e; ps += e; }
    st.l += ps;
}
typedef short v4i16_t __attribute__((ext_vector_type(4)));
__device__ __forceinline__ void load_vf(const unsigned char* lds, int buf, int lane, bf16x8 (&vf)[2][2][2]) {
    const int g = lane >> 4, i = lane & 15, q = i >> 2, p4 = i & 3;
    const LAS3 unsigned char* base = (const LAS3 unsigned char*)(lds + AT_VT + buf * AT_VB) + (8 * (g >> 1) + q) * AT_VP + (16 * (g & 1) + 4 * p4) * 2;
#pragma unroll
    for (int db = 0; db < 2; ++db)
#pragma unroll
        for (int hf = 0; hf < 2; ++hf)
#pragma unroll
            for (int s = 0; s < 2; ++s) {
                const LAS3 unsigned char* pp = base + (32 * hf + 16 * s) * AT_VP + 64 * db;
                const v4i16_t lo = __builtin_amdgcn_ds_read_tr16_b64_v4i16((LAS3 v4i16_t*)pp);
                const v4i16_t hi4 = __builtin_amdgcn_ds_read_tr16_b64_v4i16((LAS3 v4i16_t*)(pp + 4 * AT_VP));
                vf[db][hf][s] = (bf16x8){lo[0], lo[1], lo[2], lo[3], hi4[0], hi4[1], hi4[2], hi4[3]};
            }
}
__device__ __forceinline__ void pv_tile(const bf16x8 (&vf)[2][2][2], const f32x16 (&p)[2], f32x16 (&o)[2]) {
#pragma unroll
    for (int hf = 0; hf < 2; ++hf)
#pragma unroll
        for (int s = 0; s < 2; ++s) {
            const bf16x8 pf = pack8(p[hf], 8 * s);
#pragma unroll
            for (int db = 0; db < 2; ++db) o[db] = MFMA32(vf[db][hf][s], pf, o[db]);
        }
}
__device__ __forceinline__ void store_ot(bf16_t* dst, const f32x16 (&o)[2], float sc, int hi) {
#pragma unroll
    for (int db = 0; db < 2; ++db)
#pragma unroll
        for (int r4 = 0; r4 < 4; ++r4) {
            u32x2 w; w.x = cvtpk(o[db][4 * r4] * sc, o[db][4 * r4 + 1] * sc); w.y = cvtpk(o[db][4 * r4 + 2] * sc, o[db][4 * r4 + 3] * sc);
            *(u32x2*)(dst + 32 * db + 8 * r4 + 4 * hi) = w;
        }
}

__device__ __forceinline__ void fox_unit(const Args& a, unsigned char* lds, int layer, int bh, int qb) {
    int tid = threadIdx.x; asm volatile("" : "+v"(tid));
    const int lane = tid & 63, w = __builtin_amdgcn_readfirstlane(tid >> 6), qi = lane & 31, hi = lane >> 5;
    const int b = bh >> 2, h = bh & 3;
    const bf16_t* zb = (const bf16_t*)(a.ws + WS_ZB) + (size_t)b * S * ZP;
    const float* cum = (const float*)(a.ws + WS_CUM) + (size_t)bh * S;
    const int q0 = 256 * qb + 32 * w;
    const float cref = cum[256 * qb];
    bf16x8 qf[5];
#pragma unroll
    for (int ds = 0; ds < 4; ++ds) qf[ds] = *(const bf16x8*)(zb + (size_t)(q0 + qi) * ZP + ZC_FQ + 64 * h + 16 * ds + 8 * hi);
    { float q1, q2, q3; split3(cum[q0 + qi] - cref, q1, q2, q3);
      u32x4 e; e.x = hi ? 0u : 0x3f803f80u; e.y = hi ? 0u : (0x3f80u | ((unsigned)f2bf(q1) << 16)); e.z = hi ? 0u : ((unsigned)f2bf(q2) | ((unsigned)f2bf(q3) << 16)); e.w = 0u;
      qf[4] = __builtin_bit_cast(bf16x8, e); }
    const int ntiles = 4 * (qb + 1), mylast = 4 * qb + (w >> 1);
    const float thr = ((const float*)(a.ws + WS_FOXT))[layer];
    int kt0 = 0;
    {
        const bool sk = tid < 4 * qb && (cref - cum[64 * tid + 63]) < -thr;
        const unsigned long long bal = __ballot(sk);
        volatile LAS3 unsigned* cw = (volatile LAS3 unsigned*)(LAS3 unsigned char*)(lds + LDS_CTL + 64);
        if (lane == 0) cw[w] = (unsigned)__popcll(bal);
        __syncthreads();
#pragma unroll
        for (int i = 0; i < 8; ++i) kt0 += (int)cw[i];
        __syncthreads();
    }
    const int kv_s = 8 * w + (lane >> 3), c_s = lane & 7;
    const bf16_t* kp = zb + (size_t)kv_s * ZP + ZC_FK + 64 * h + 8 * c_s;
    const bf16_t* vp = zb + (size_t)kv_s * ZP + ZC_FV + 64 * h + 8 * c_s;
    u32x4 kreg = *(const u32x4*)(kp + (size_t)kt0 * 64 * ZP), vreg = *(const u32x4*)(vp + (size_t)kt0 * 64 * ZP);
    float dreg = (tid < 64) ? cum[kt0 * 64 + tid] : 0.f;
    SMState st; st.mref = 0.f; st.l = 0.f; bool refzero = true;
    f32x16 o[2]; o[0] = (f32x16){}; o[1] = (f32x16){};
    const int krow = swap23(qi);
#ifdef HK_FOX_NOSTAG
    const int grp = HK_FOX_NOSTAG - 1;
#else
    const int grp = w >> 2;
#endif
    f32x16 p[2];
#define FOX_QK(kt_, buf_) do { bf16x8 kf_[2][5]; \
        _Pragma("unroll") for (int hf = 0; hf < 2; ++hf) _Pragma("unroll") for (int ds = 0; ds < 5; ++ds) kf_[hf][ds] = *(const bf16x8*)(lds + AT_KS + (buf_) * AT_KB + (32 * hf + krow) * AT_KP + 32 * ds + 16 * hi); \
        _Pragma("unroll") for (int hf = 0; hf < 2; ++hf) { p[hf] = (f32x16){}; _Pragma("unroll") for (int ds = 0; ds < 5; ++ds) p[hf] = MFMA32(kf_[hf][ds], qf[ds], p[hf]); } \
        MFMA_DRAIN2(p[0], p[1]); \
        if (64 * (kt_) + 63 > q0) { const int lim = q0 + qi - 64 * (kt_) - 8 * hi; \
            _Pragma("unroll") for (int hf = 0; hf < 2; ++hf) _Pragma("unroll") for (int r = 0; r < 16; ++r) if (32 * hf + 16 * (r >> 3) + (r & 7) > lim) p[hf][r] = -INFINITY; } } while (0)
#define FOX_SMPV(buf_) do { bf16x8 vf_[2][2][2]; load_vf(lds, (buf_), lane, vf_); softmax_step<2>(p, st, refzero, o); pv_tile(vf_, p, o); } while (0)
    for (int kt = kt0; kt < ntiles; ++kt) {
        const int buf = kt & 1;
        stage_kv(lds, buf, kv_s, c_s, kreg, vreg);
        if (tid < 64) { float k1, k2, k3; split3(cref - dreg, k1, k2, k3);
            u32x4 e; e.x = (unsigned)f2bf(k1) | ((unsigned)f2bf(k2) << 16); e.y = (unsigned)f2bf(k3) | 0x3f800000u; e.z = 0x3f803f80u; e.w = 0u;
            unsigned char* kr = lds + AT_KS + buf * AT_KB + tid * AT_KP + 128;
            *(u32x4*)kr = e; *(u32x4*)(kr + 16) = (u32x4){0u, 0u, 0u, 0u}; }
        __syncthreads();
        if (kt + 1 < ntiles) {
            kreg = *(const u32x4*)(kp + (size_t)(kt + 1) * 64 * ZP); vreg = *(const u32x4*)(vp + (size_t)(kt + 1) * 64 * ZP);
            if (tid < 64) dreg = cum[(kt + 1) * 64 + tid];
        }
#ifdef HK_FOX_X2
        if (grp == 0) { if (kt <= mylast) FOX_QK(kt, buf); }
        __syncthreads();
        if (grp == 0) { if (kt <= mylast) FOX_SMPV(buf); }
        else { if (kt > kt0 && kt - 1 <= mylast) FOX_SMPV(buf ^ 1); if (kt <= mylast) FOX_QK(kt, buf); }
#else
        if (grp == 0) { if (kt <= mylast) FOX_QK(kt, buf); }
        else { if (kt > kt0 && kt - 1 <= mylast) FOX_SMPV(buf ^ 1); }
        __syncthreads();
        if (grp == 0) { if (kt <= mylast) FOX_SMPV(buf); }
        else { if (kt <= mylast) FOX_QK(kt, buf); }
#endif
#ifdef HK_FOX_B3
        __syncthreads();
#endif
    }
    if (grp == 1 && ntiles - 1 <= mylast) FOX_SMPV((ntiles - 1) & 1);
#undef FOX_QK
#undef FOX_SMPV
    const float l = half_swap_sum(st.l);
    store_ot((bf16_t*)(a.ws + WS_MIX) + (size_t)(b * S + q0 + qi) * D + 0 + 64 * h, o, 1.f / l, hi);
    __syncthreads();
}

__device__ __forceinline__ void fox64_unit(const Args& a, unsigned char* lds, int layer, int bh, int qb) {
    int tid = threadIdx.x; asm volatile("" : "+v"(tid));
    const int lane = tid & 63, w = __builtin_amdgcn_readfirstlane(tid >> 6), qi = lane & 31, hi = lane >> 5;
    const int b = bh >> 2, h = bh & 3;
    const bf16_t* zb = (const bf16_t*)(a.ws + WS_ZB) + (size_t)b * S * ZP;
    const float* cum = (const float*)(a.ws + WS_CUM) + (size_t)bh * S;
    const int q0 = 512 * qb + 64 * w;
    const float cref = cum[512 * qb];
    bf16x8 qfA[5], qfB[5];
#pragma unroll
    for (int ds = 0; ds < 4; ++ds) { qfA[ds] = *(const bf16x8*)(zb + (size_t)(q0 + qi) * ZP + ZC_FQ + 64 * h + 16 * ds + 8 * hi); qfB[ds] = *(const bf16x8*)(zb + (size_t)(q0 + 32 + qi) * ZP + ZC_FQ + 64 * h + 16 * ds + 8 * hi); }
#pragma unroll
    for (int blk = 0; blk < 2; ++blk) { float q1, q2, q3; split3(cum[q0 + 32 * blk + qi] - cref, q1, q2, q3);
      u32x4 e; e.x = hi ? 0u : 0x3f803f80u; e.y = hi ? 0u : (0x3f80u | ((unsigned)f2bf(q1) << 16)); e.z = hi ? 0u : ((unsigned)f2bf(q2) | ((unsigned)f2bf(q3) << 16)); e.w = 0u;
      if (blk == 0) qfA[4] = __builtin_bit_cast(bf16x8, e); else qfB[4] = __builtin_bit_cast(bf16x8, e); }
    const int ntiles = 8 * (qb + 1), mylast = 8 * qb + w;
    const float thr = ((const float*)(a.ws + WS_FOXT))[layer];
    int kt0 = 0;
    {   const bool sk = tid < 8 * qb && (cref - cum[64 * tid + 63]) < -thr;
        const unsigned long long bal = __ballot(sk);
        volatile LAS3 unsigned* cw = (volatile LAS3 unsigned*)(LAS3 unsigned char*)(lds + LDS_CTL + 64);
        if (lane == 0) cw[w] = (unsigned)__popcll(bal);
        __syncthreads();
#pragma unroll
        for (int i = 0; i < 8; ++i) kt0 += (int)cw[i];
        __syncthreads();
    }
    const int kv_s = 8 * w + (lane >> 3), c_s = lane & 7;
    const bf16_t* kp = zb + (size_t)kv_s * ZP + ZC_FK + 64 * h + 8 * c_s;
    const bf16_t* vp = zb + (size_t)kv_s * ZP + ZC_FV + 64 * h + 8 * c_s;
    u32x4 kreg = *(const u32x4*)(kp + (size_t)kt0 * 64 * ZP), vreg = *(const u32x4*)(vp + (size_t)kt0 * 64 * ZP);
    float dreg = (tid < 64) ? cum[kt0 * 64 + tid] : 0.f;
    SMState stA, stB; stA.mref = 0.f; stA.l = 0.f; stB.mref = 0.f; stB.l = 0.f; bool rzA = true, rzB = true;
    f32x16 oA[2], oB[2]; oA[0] = (f32x16){}; oA[1] = (f32x16){}; oB[0] = (f32x16){}; oB[1] = (f32x16){};
    const int krow = swap23(qi);
    for (int kt = kt0; kt < ntiles; ++kt) {
        const int buf = kt & 1;
        stage_kv(lds, buf, kv_s, c_s, kreg, vreg);
        if (tid < 64) { float k1, k2, k3; split3(cref - dreg, k1, k2, k3);
            u32x4 e; e.x = (unsigned)f2bf(k1) | ((unsigned)f2bf(k2) << 16); e.y = (unsigned)f2bf(k3) | 0x3f800000u; e.z = 0x3f803f80u; e.w = 0u;
            unsigned char* kr = lds + AT_KS + buf * AT_KB + tid * AT_KP + 128;
            *(u32x4*)kr = e; *(u32x4*)(kr + 16) = (u32x4){0u, 0u, 0u, 0u}; }
        __syncthreads();
        if (kt + 1 < ntiles) {
            kreg = *(const u32x4*)(kp + (size_t)(kt + 1) * 64 * ZP); vreg = *(const u32x4*)(vp + (size_t)(kt + 1) * 64 * ZP);
            if (tid < 64) dreg = cum[(kt + 1) * 64 + tid];
        }
        if (kt <= mylast) {
            f32x16 pA[2], pB[2];
#pragma unroll
            for (int hf = 0; hf < 2; ++hf) {
                pA[hf] = (f32x16){}; pB[hf] = (f32x16){};
#pragma unroll
                for (int ds = 0; ds < 5; ++ds) { const bf16x8 kf = *(const bf16x8*)(lds + AT_KS + buf * AT_KB + (32 * hf + krow) * AT_KP + 32 * ds + 16 * hi);
                    pA[hf] = MFMA32(kf, qfA[ds], pA[hf]); pB[hf] = MFMA32(kf, qfB[ds], pB[hf]); }
            }
            if (kt == mylast) {
                const int limA = qi - 8 * hi, limB = 32 + qi - 8 * hi;
#pragma unroll
                for (int hf = 0; hf < 2; ++hf)
#pragma unroll
                    for (int r = 0; r < 16; ++r) { const int kvo = 32 * hf + 16 * (r >> 3) + (r & 7); if (kvo > limA) pA[hf][r] = -INFINITY; if (kvo > limB) pB[hf][r] = -INFINITY; }
            }
            softmax_step<2>(pA, stA, rzA, oA); softmax_step<2>(pB, stB, rzB, oB);
            const int g_ = lane >> 4, i_ = lane & 15;
            const LAS3 unsigned char* vb_ = (const LAS3 unsigned char*)(lds + AT_VT + buf * AT_VB) + (8 * (g_ >> 1) + (i_ >> 2)) * AT_VP + (16 * (g_ & 1) + 4 * (i_ & 3)) * 2;
#pragma unroll
            for (int hf = 0; hf < 2; ++hf)
#pragma unroll
                for (int s = 0; s < 2; ++s) {
                    const bf16x8 fa = pack8(pA[hf], 8 * s), fb = pack8(pB[hf], 8 * s);
#pragma unroll
                    for (int db = 0; db < 2; ++db) {
                        const LAS3 unsigned char* pp = vb_ + (32 * hf + 16 * s) * AT_VP + 64 * db;
                        const v4i16_t lo = __builtin_amdgcn_ds_read_tr16_b64_v4i16((LAS3 v4i16_t*)pp);
                        const v4i16_t hi4 = __builtin_amdgcn_ds_read_tr16_b64_v4i16((LAS3 v4i16_t*)(pp + 4 * AT_VP));
                        const bf16x8 vf = (bf16x8){lo[0], lo[1], lo[2], lo[3], hi4[0], hi4[1], hi4[2], hi4[3]};
                        oA[db] = MFMA32(vf, fa, oA[db]); oB[db] = MFMA32(vf, fb, oB[db]);
                    }
                }
        }
    }
    const float lA = half_swap_sum(stA.l), lB = half_swap_sum(stB.l);
    bf16_t* mo = (bf16_t*)(a.ws + WS_MIX) + (size_t)(b * S + q0 + qi) * D + 64 * h;
    store_ot(mo, oA, 1.f / lA, hi);
    store_ot(mo + (size_t)32 * D, oB, 1.f / lB, hi);
    __syncthreads();
}

__device__ __forceinline__ void diff_unit(const Args& a, unsigned char* lds, int layer, int bh, int qb) {
    int tid = threadIdx.x; asm volatile("" : "+v"(tid));
    const int lane = tid & 63, w = __builtin_amdgcn_readfirstlane(tid >> 6), qi = lane & 31, hi = lane >> 5;
    const int b = bh >> 2, h = bh & 3;
    const bf16_t* zb = (const bf16_t*)(a.ws + WS_ZB) + (size_t)b * S * ZP;
    const int q0 = 256 * qb + 32 * w;
    {
        const float* tb = (const float*)(a.ws + WS_TB) + (size_t)(4 + h) * TBN; float* tl = (float*)(lds + AT_TBL);
        const float cb = tb[1600]; float tv[5];
#pragma unroll
        for (int k = 0; k < 5; ++k) { const int i = tid + NTHR * k; tv[k] = tb[i < TBN ? i : TBN - 1]; }
#pragma unroll
        for (int k = 0; k < 5; ++k) { const int i = tid + NTHR * k; if (i < TBN) tl[i] = tv[k] - cb; }
    }
    bf16x8 qf[2][2];
#pragma unroll
    for (int c = 0; c < 2; ++c)
#pragma unroll
        for (int ds = 0; ds < 2; ++ds) qf[c][ds] = *(const bf16x8*)(zb + (size_t)(q0 + qi) * ZP + ZC_CQ + 64 * h + 32 * c + 16 * ds + 8 * hi);
    const int ntiles = 4 * (qb + 1), mylast = 4 * qb + (w >> 1);
    const int kv_s = 8 * w + (lane >> 3), c_s = lane & 7;
    const bf16_t* kp = zb + (size_t)kv_s * ZP + ZC_CK + 64 * h + 8 * c_s;
    const bf16_t* vp = zb + (size_t)kv_s * ZP + ZC_CV + 64 * h + 8 * c_s;
    u32x4 kreg = *(const u32x4*)kp, vreg = *(const u32x4*)vp;
    SMState st[2]; st[0].mref = 0.f; st[0].l = 0.f; st[1].mref = 0.f; st[1].l = 0.f; bool rz0 = true, rz1 = true;
    f32x16 o[2][2];
#pragma unroll
    for (int c = 0; c < 2; ++c) { o[c][0] = (f32x16){}; o[c][1] = (f32x16){}; }
    const int krow = swap23(qi);
    const float* tl = (const float*)(lds + AT_TBL);
    for (int kt = 0; kt < ntiles; ++kt) {
        const int buf = kt & 1;
        stage_kv(lds, buf, kv_s, c_s, kreg, vreg);
        __syncthreads();
        if (kt + 1 < ntiles) { kreg = *(const u32x4*)(kp + (size_t)(kt + 1) * 64 * ZP); vreg = *(const u32x4*)(vp + (size_t)(kt + 1) * 64 * ZP); }
        if (kt <= mylast) {
            const bool far_ = q0 - (64 * kt + 63) >= 1513;
            const bool diag = 64 * kt + 63 > q0;
            const int dq = q0 + qi - 64 * kt - 8 * hi;
#pragma unroll
            for (int hf = 0; hf < 2; ++hf) {
                f32x16 p0[1], p1[1]; p0[0] = (f32x16){}; p1[0] = (f32x16){};
                bf16x8 vf[2][2];
                { const int g_ = lane >> 4, i_ = lane & 15;
                  const LAS3 unsigned char* vb_ = (const LAS3 unsigned char*)(lds + AT_VT + buf * AT_VB) + (32 * hf + 8 * (g_ >> 1) + (i_ >> 2)) * AT_VP + (16 * (g_ & 1) + 4 * (i_ & 3)) * 2;
#pragma unroll
                  for (int s = 0; s < 2; ++s)
#pragma unroll
                      for (int db = 0; db < 2; ++db) {
                          const v4i16_t lo = __builtin_amdgcn_ds_read_tr16_b64_v4i16((LAS3 v4i16_t*)(vb_ + 16 * s * AT_VP + 64 * db));
                          const v4i16_t hi4 = __builtin_amdgcn_ds_read_tr16_b64_v4i16((LAS3 v4i16_t*)(vb_ + (16 * s + 4) * AT_VP + 64 * db));
                          vf[s][db] = (bf16x8){lo[0], lo[1], lo[2], lo[3], hi4[0], hi4[1], hi4[2], hi4[3]};
                      } }
#pragma unroll
                for (int ds = 0; ds < 2; ++ds) {
                    const bf16x8 k0 = *(const bf16x8*)(lds + AT_KS + buf * AT_KB + (32 * hf + krow) * AT_KP + 32 * ds + 16 * hi);
                    const bf16x8 k1 = *(const bf16x8*)(lds + AT_KS + buf * AT_KB + (32 * hf + krow) * AT_KP + 64 + 32 * ds + 16 * hi);
                    p0[0] = MFMA32(k0, qf[0][ds], p0[0]); p1[0] = MFMA32(k1, qf[1][ds], p1[0]);
                }
                MFMA_DRAIN2(p0[0], p1[0]);
                if (!far_) {
                    if (diag) {
#pragma unroll
                        for (int r = 0; r < 16; ++r) {
                            const int dist = dq - (32 * hf + 16 * (r >> 3) + (r & 7));
                            const float bb = tl[dist < 0 ? 0 : dist];
                            const bool ok = dist >= 0;
                            p0[0][r] = ok ? p0[0][r] + bb : -INFINITY; p1[0][r] = ok ? p1[0][r] + bb : -INFINITY;
                        }
                    } else {
#pragma unroll
                        for (int r = 0; r < 16; ++r) { const float bb = tl[dq - (32 * hf + 16 * (r >> 3) + (r & 7))]; p0[0][r] += bb; p1[0][r] += bb; }
                    }
                }
                softmax_step<1>(p0, st[0], rz0, o[0]); softmax_step<1>(p1, st[1], rz1, o[1]);
#pragma unroll
                for (int s = 0; s < 2; ++s) {
                    const bf16x8 f0 = pack8(p0[0], 8 * s), f1 = pack8(p1[0], 8 * s);
#pragma unroll
                    for (int db = 0; db < 2; ++db) { o[0][db] = MFMA32(vf[s][db], f0, o[0][db]); o[1][db] = MFMA32(vf[s][db], f1, o[1][db]); }
                }
            }
        }
    }
    const float lam_init = 0.8f - 0.6f * __expf(-0.3f * (float)layer);
    const float* lp = a.in[12] + layer * 128;
    float s1 = 0.f, s2 = 0.f;
    for (int i = 0; i < 32; ++i) { s1 += lp[i] * lp[32 + i]; s2 += lp[64 + i] * lp[96 + i]; }
    const float lam = __expf(s1) - __expf(s2) + lam_init;
    const float i0 = 1.f / half_swap_sum(st[0].l), i1 = lam / half_swap_sum(st[1].l);
    float ss = 0.f;
#pragma unroll
    for (int db = 0; db < 2; ++db)
#pragma unroll
        for (int r = 0; r < 16; ++r) { const float v = o[0][db][r] * i0 - o[1][db][r] * i1; o[0][db][r] = v; ss += v * v; }
    ss = half_swap_sum(ss);
    const float rn = __builtin_amdgcn_rsqf(ss * (1.f / 64.f) + EPS) * (1.f - lam_init);
    const float* gn = a.in[13] + layer * 64;
#pragma unroll
    for (int db = 0; db < 2; ++db)
#pragma unroll
        for (int r = 0; r < 16; ++r) o[0][db][r] *= gn[32 * db + (r & 3) + 8 * (r >> 2) + 4 * hi];
    store_ot((bf16_t*)(a.ws + WS_MIX) + (size_t)(b * S + q0 + qi) * D + 512 + 64 * h, o[0], rn, hi);
    __syncthreads();
}

__device__ __forceinline__ void dil_unit(const Args& a, unsigned char* lds, int bh, int br, int rho, int tile) {
    int tid = threadIdx.x; asm volatile("" : "+v"(tid));
    const int lane = tid & 63, w = __builtin_amdgcn_readfirstlane(tid >> 6), qi = lane & 31, hi = lane >> 5;
    const int b = bh >> 2, h = bh & 3;
    const int r = br == 0 ? 1 : (br == 1 ? 4 : 16);
    const bf16_t* zb = (const bf16_t*)(a.ws + WS_ZB) + (size_t)b * S * ZP;
    {   const float* tb = (const float*)(a.ws + WS_TB) + (size_t)h * TBN; float* tl = (float*)(lds + AT_TBL); float tv[5];
#pragma unroll
        for (int k = 0; k < 5; ++k) { const int i = tid + NTHR * k; tv[k] = tb[i < TBN ? i : TBN - 1]; }
#pragma unroll
        for (int k = 0; k < 5; ++k) { const int i = tid + NTHR * k; if (i < TBN) tl[i] = tv[k]; }
    }
    const int l0 = 256 * tile, lq0 = l0 + 32 * w;
    const int tq = (lq0 + qi) * r + rho;
    bf16x8 qf[4];
#pragma unroll
    for (int ds = 0; ds < 4; ++ds) qf[ds] = *(const bf16x8*)(zb + (size_t)tq * ZP + ZC_DQ + 64 * h + 16 * ds + 8 * hi);
    const int kv_s = 8 * w + (lane >> 3), c_s = lane & 7;
    const int j0 = (l0 == 0) ? 2 : 0;
    auto krow_of = [&](int j) { int kl = l0 - 128 + 64 * j + kv_s; kl = kl < 0 ? 0 : kl; return (size_t)(kl * r + rho) * ZP; };
    u32x4 kreg = *(const u32x4*)(zb + krow_of(j0) + ZC_DK + 64 * h + 8 * c_s), vreg = *(const u32x4*)(zb + krow_of(j0) + ZC_DV + 64 * h + 8 * c_s);
    SMState st; st.mref = 0.f; st.l = 0.f; bool refzero = true;
    f32x16 o[2]; o[0] = (f32x16){}; o[1] = (f32x16){};
    const int krow = swap23(qi);
    const float* tl = (const float*)(lds + AT_TBL);
    for (int j = j0; j < 6; ++j) {
        const int buf = j & 1;
        stage_kv(lds, buf, kv_s, c_s, kreg, vreg);
        __syncthreads();
        if (j + 1 < 6) { kreg = *(const u32x4*)(zb + krow_of(j + 1) + ZC_DK + 64 * h + 8 * c_s); vreg = *(const u32x4*)(zb + krow_of(j + 1) + ZC_DV + 64 * h + 8 * c_s); }
        const int kl0 = l0 - 128 + 64 * j;
#pragma unroll
        for (int hf = 0; hf < 2; ++hf) {
            const int kh0 = kl0 + 32 * hf;
            if (kh0 <= lq0 + 31 && kh0 + 31 >= lq0 - 128 && kh0 + 31 >= 0) {
                f32x16 p[1]; p[0] = (f32x16){};
                bf16x8 kf[4];
#pragma unroll
                for (int ds = 0; ds < 4; ++ds) kf[ds] = *(const bf16x8*)(lds + AT_KS + buf * AT_KB + (32 * hf + krow) * AT_KP + 32 * ds + 16 * hi);
                bf16x8 vf[2][2];
                { const int g_ = lane >> 4, i_ = lane & 15;
                  const LAS3 unsigned char* vb_ = (const LAS3 unsigned char*)(lds + AT_VT + buf * AT_VB) + (32 * hf + 8 * (g_ >> 1) + (i_ >> 2)) * AT_VP + (16 * (g_ & 1) + 4 * (i_ & 3)) * 2;
#pragma unroll
                  for (int s = 0; s < 2; ++s)
#pragma unroll
                      for (int db = 0; db < 2; ++db) {
                          const v4i16_t lo = __builtin_amdgcn_ds_read_tr16_b64_v4i16((LAS3 v4i16_t*)(vb_ + 16 * s * AT_VP + 64 * db));
                          const v4i16_t hi4 = __builtin_amdgcn_ds_read_tr16_b64_v4i16((LAS3 v4i16_t*)(vb_ + (16 * s + 4) * AT_VP + 64 * db));
                          vf[s][db] = (bf16x8){lo[0], lo[1], lo[2], lo[3], hi4[0], hi4[1], hi4[2], hi4[3]};
                      } }
#pragma unroll
                for (int ds = 0; ds < 4; ++ds) p[0] = MFMA32(kf[ds], qf[ds], p[0]);
                const int dq = lq0 + qi - kh0 - 8 * hi;
#pragma unroll
                for (int rr = 0; rr < 16; ++rr) {
                    const int kvoff = 16 * (rr >> 3) + (rr & 7);
                    const int dd = dq - kvoff;
                    const bool ok = dd >= 0 && dd <= 128 && (kh0 + 8 * hi + kvoff) >= 0;
                    const float bb = tl[ok ? dd * r : 0];
                    p[0][rr] = ok ? p[0][rr] + bb : -INFINITY;
                }
                softmax_step<1>(p, st, refzero, o);
#pragma unroll
                for (int s = 0; s < 2; ++s) {
                    const bf16x8 pf = pack8(p[0], 8 * s);
#pragma unroll
                    for (int db = 0; db < 2; ++db) o[db] = MFMA32(vf[s][db], pf, o[db]);
                }
            }
        }
    }
    const float l = half_swap_sum(st.l);
    const size_t tok = (size_t)b * S + tq;
    store_ot((bf16_t*)(a.ws + WS_DPART) + ((size_t)br * T + tok) * 256 + 64 * h, o, 1.f / l, hi);
    if (hi == 0) ((float*)(a.ws + WS_DLSE))[((size_t)br * T + tok) * 4 + h] = st.mref + __builtin_amdgcn_logf(l);
    __syncthreads();
}
}
namespace hk {
struct S5P { float abr, abi, bbr[16], bbi[16]; };
__device__ __forceinline__ void s5_params(const Args& a, int layer, int g, int n, S5P& P, float& dtar, float& dtai) {
    const int lg = layer * 16 + g;
    const float dt = expf(a.in[17][lg]);
    const float ar = a.in[15][lg * 64 + n], ai = a.in[16][lg * 64 + n];
    dtar = dt * ar; dtai = dt * ai;
    const float mag = expf(dtar);
    P.abr = mag * cosf(dtai); P.abi = mag * sinf(dtai);
    const float den = ar * ar + ai * ai, nr = P.abr - 1.f, ni = P.abi;
    const float cr = (nr * ar + ni * ai) / den, ci = (ni * ar - nr * ai) / den;
    const float* brp = a.in[18] + ((size_t)lg * 64 + n) * 16; const float* bip = a.in[19] + ((size_t)lg * 64 + n) * 16;
#pragma unroll
    for (int c = 0; c < 16; ++c) { const float br = brp[c], bi = bip[c]; P.bbr[c] = cr * br - ci * bi; P.bbi[c] = cr * bi + ci * br; }
}
__device__ __forceinline__ void s5_step(const S5P& P, const LAS3 float* up, float& xr, float& xi) {
    const f32x4 u0 = *(const LAS3 f32x4*)(up), u1 = *(const LAS3 f32x4*)(up + 4), u2 = *(const LAS3 f32x4*)(up + 8), u3 = *(const LAS3 f32x4*)(up + 12);
    float r0 = P.bbr[0] * u0[0], r1 = P.bbr[4] * u1[0], r2 = P.bbr[8] * u2[0], r3 = P.bbr[12] * u3[0];
    float i0 = P.bbi[0] * u0[0], i1 = P.bbi[4] * u1[0], i2 = P.bbi[8] * u2[0], i3 = P.bbi[12] * u3[0];
    r0 += P.bbr[1] * u0[1]; r1 += P.bbr[5] * u1[1]; r2 += P.bbr[9] * u2[1]; r3 += P.bbr[13] * u3[1];
    i0 += P.bbi[1] * u0[1]; i1 += P.bbi[5] * u1[1]; i2 += P.bbi[9] * u2[1]; i3 += P.bbi[13] * u3[1];
    r0 += P.bbr[2] * u0[2]; r1 += P.bbr[6] * u1[2]; r2 += P.bbr[10] * u2[2]; r3 += P.bbr[14] * u3[2];
    i0 += P.bbi[2] * u0[2]; i1 += P.bbi[6] * u1[2]; i2 += P.bbi[10] * u2[2]; i3 += P.bbi[14] * u3[2];
    r0 += P.bbr[3] * u0[3]; r1 += P.bbr[7] * u1[3]; r2 += P.bbr[11] * u2[3]; r3 += P.bbr[15] * u3[3];
    i0 += P.bbi[3] * u0[3]; i1 += P.bbi[7] * u1[3]; i2 += P.bbi[11] * u2[3]; i3 += P.bbi[15] * u3[3];
    const float pr = (r0 + r1) + (r2 + r3), pi = (i0 + i1) + (i2 + i3);
    const float nxr = P.abr * xr - P.abi * xi + pr, nxi = P.abr * xi + P.abi * xr + pi;
    xr = nxr; xi = nxi;
}
__device__ __forceinline__ void s5_wave_operands(const Args& a, int layer, int w, int qi, int hi, bf16x8 (&bre)[2][2], bf16x8 (&bim)[2][2], f32x4 (&ab)[2]) {
#pragma unroll
    for (int gg = 0; gg < 2; ++gg) {
        const int lg = layer * 16 + 2 * w + gg;
#pragma unroll
        for (int sh = 0; sh < 2; ++sh) {
            const bf16_t* pb = (const bf16_t*)(a.ws + WS_S5B) + ((size_t)(lg * 2) * 64 + qi + 32 * sh) * 16 + 8 * hi;
            bre[gg][sh] = *(const bf16x8*)pb; bim[gg][sh] = *(const bf16x8*)(pb + 64 * 16);
        }
    }
#pragma unroll
    for (int sh = 0; sh < 2; ++sh) ab[sh] = ((const f32x4*)(a.ws + WS_S5A))[(layer * 16 + 2 * w + hi) * 64 + qi + 32 * sh];
}
#define S5_MFMA32(a, b, c) __builtin_amdgcn_mfma_f32_32x32x16_bf16(a, b, c, 0, 0, 0)
__device__ __forceinline__ void s5_state_params(const Args& a, int layer, int g, int st, float& abr, float& abi, float& cr, float& ci, float& dtar, float& dtai) {
    const int lg = layer * 16 + g;
    const float dt = expf(a.in[17][lg]);
    const float ar = a.in[15][lg * 64 + st], ai = a.in[16][lg * 64 + st];
    dtar = dt * ar; dtai = dt * ai;
    const float mag = expf(dtar);
    abr = mag * cosf(dtai); abi = mag * sinf(dtai);
    const float den = ar * ar + ai * ai, nr = abr - 1.f, ni = abi;
    cr = (nr * ar + ni * ai) / den; ci = (ni * ar - nr * ai) / den;
}
__device__ __forceinline__ void s5_wave_operands_v82(const Args& a, int layer, int w, int qi, int hi, bf16x8 (&bre)[2][2], bf16x8 (&bim)[2][2], float (&abr)[2], float (&abi)[2], float (&dtr)[2], float (&dti)[2]) {
#pragma unroll
    for (int gg = 0; gg < 2; ++gg) {
        const int g = 2 * w + gg, lg = layer * 16 + g;
#pragma unroll
        for (int sh = 0; sh < 2; ++sh) {
            const int st = qi + 32 * sh;
            float ar_, ai_, cr, ci, dtar, dtai; s5_state_params(a, layer, g, st, ar_, ai_, cr, ci, dtar, dtai);
            const float* brp = a.in[18] + ((size_t)lg * 64 + st) * 16 + 8 * hi; const float* bip = a.in[19] + ((size_t)lg * 64 + st) * 16 + 8 * hi;
            float vr[8], vi[8];
#pragma unroll
            for (int c = 0; c < 8; ++c) { const float br = brp[c], bi = bip[c]; vr[c] = cr * br - ci * bi; vi[c] = cr * bi + ci * br; }
            u32x4 pr, pi; pr.x = pk2(vr[0], vr[1]); pr.y = pk2(vr[2], vr[3]); pr.z = pk2(vr[4], vr[5]); pr.w = pk2(vr[6], vr[7]);
            pi.x = pk2(vi[0], vi[1]); pi.y = pk2(vi[2], vi[3]); pi.z = pk2(vi[4], vi[5]); pi.w = pk2(vi[6], vi[7]);
            bre[gg][sh] = __builtin_bit_cast(bf16x8, pr); bim[gg][sh] = __builtin_bit_cast(bf16x8, pi);
            if (gg == hi) { abr[sh] = ar_; abi[sh] = ai_; dtr[sh] = dtar; dti[sh] = dtai; }
        }
    }
}
__device__ __forceinline__ void s5_pass1_unit(const Args& a, unsigned char* lds, int layer, int b, int c) {
    int tid = threadIdx.x; asm volatile("" : "+v"(tid));
    const int lane = tid & 63, w = __builtin_amdgcn_readfirstlane(tid >> 6), qi = lane & 31, hi = lane >> 5;
    const bf16_t* su = (const bf16_t*)(a.ws + WS_SU) + ((size_t)b * S + c * S5_TC) * 256;
    float* sst = (float*)(a.ws + WS_SST);
    const int ag = (qi >> 2) & 1;
    const bf16_t* aup = su + (size_t)(4 * (qi >> 3) + (qi & 3)) * 256 + 32 * w + 16 * ag + 8 * hi;
    u32x4 an = *(const u32x4*)aup;
    bf16x8 bre[2][2], bim[2][2]; float abr[2], abi[2], dtr[2], dti[2];
    s5_wave_operands_v82(a, layer, w, qi, hi, bre, bim, abr, abi, dtr, dti);
    float xr[2] = {0.f, 0.f}, xi[2] = {0.f, 0.f};
#pragma unroll
    for (int blk = 0; blk < 4; ++blk) {
        const u32x4 zero4 = (u32x4){0u, 0u, 0u, 0u};
        const bf16x8 a1 = __builtin_bit_cast(bf16x8, ag ? zero4 : an), a2 = __builtin_bit_cast(bf16x8, ag ? an : zero4);
        if (blk < 3) an = *(const u32x4*)(aup + (size_t)(blk + 1) * 16 * 256);
        f32x16 dre[2], dim[2];
#pragma unroll
        for (int sh = 0; sh < 2; ++sh) {
            dre[sh] = S5_MFMA32(a1, bre[0][sh], (f32x16){}); dre[sh] = S5_MFMA32(a2, bre[1][sh], dre[sh]);
            dim[sh] = S5_MFMA32(a1, bim[0][sh], (f32x16){}); dim[sh] = S5_MFMA32(a2, bim[1][sh], dim[sh]);
        }
#pragma unroll
        for (int tt = 0; tt < 16; ++tt)
#pragma unroll
            for (int sh = 0; sh < 2; ++sh) {
                const float nxr = abr[sh] * xr[sh] - abi[sh] * xi[sh] + dre[sh][tt], nxi = abr[sh] * xi[sh] + abi[sh] * xr[sh] + dim[sh][tt];
                xr[sh] = nxr; xi[sh] = nxi;
            }
    }
    float* sp = sst + (((size_t)b * 16 + 2 * w + hi) * S5_NCH + c) * 128;
#pragma unroll
    for (int sh = 0; sh < 2; ++sh) { sp[qi + 32 * sh] = xr[sh]; sp[64 + qi + 32 * sh] = xi[sh]; }
}
constexpr int P3_XS = 0, P3_XS_W = 2 * 16 * 272, P3_GS = 8 * P3_XS_W, P3_GS_P = 528, P3_US = P3_GS + 64 * P3_GS_P, P3_END = P3_US + 8 * 2048;
__device__ __forceinline__ void s5_pass2_unit(const Args& a, unsigned char* lds, int layer, int b, int seg) {
    int tid = threadIdx.x; asm volatile("" : "+v"(tid));
    const int lane = tid & 63, w = __builtin_amdgcn_readfirstlane(tid >> 6);
    const int qi = lane & 31, hi = lane >> 5, l15 = lane & 15, kg = lane >> 4;
    const bf16_t* su = (const bf16_t*)(a.ws + WS_SU) + ((size_t)b * S + seg * 256) * 256;
    const float* sst = (const float*)(a.ws + WS_SST);
    bf16x8 bre[2][2], bim[2][2]; float abr[2], abi[2], xr[2], xi[2]; bf16x8 cm[2][4]; f32x4 dsk[2];
    {
        f32x4 ab[2];
        s5_wave_operands(a, layer, w, qi, hi, bre, bim, ab);
        float cr2[2] = {0.f, 0.f}, ci2[2] = {0.f, 0.f};
#pragma unroll
        for (int sh = 0; sh < 2; ++sh) { abr[sh] = ab[sh][0]; abi[sh] = ab[sh][1]; }
        const float* sp = sst + (((size_t)b * 16 + 2 * w + hi) * S5_NCH) * 128 + qi;
        const int nprev = 4 * seg;
        int j0 = 0;
        for (; j0 + 8 <= nprev; j0 += 8) {
            float sr[2][8], si[2][8];
#pragma unroll
            for (int u = 0; u < 8; ++u)
#pragma unroll
                for (int sh = 0; sh < 2; ++sh) { sr[sh][u] = sp[(size_t)(j0 + u) * 128 + 32 * sh]; si[sh][u] = sp[(size_t)(j0 + u) * 128 + 64 + 32 * sh]; }
#pragma unroll
            for (int u = 0; u < 8; ++u)
#pragma unroll
                for (int sh = 0; sh < 2; ++sh) { const float t0 = ab[sh][2] * cr2[sh] - ab[sh][3] * ci2[sh] + sr[sh][u], t1 = ab[sh][2] * ci2[sh] + ab[sh][3] * cr2[sh] + si[sh][u]; cr2[sh] = t0; ci2[sh] = t1; }
        }
        if (j0 < nprev) {
            float sr[2][4], si[2][4];
#pragma unroll
            for (int u = 0; u < 4; ++u)
#pragma unroll
                for (int sh = 0; sh < 2; ++sh) { sr[sh][u] = sp[(size_t)(j0 + u) * 128 + 32 * sh]; si[sh][u] = sp[(size_t)(j0 + u) * 128 + 64 + 32 * sh]; }
#pragma unroll
            for (int u = 0; u < 4; ++u)
#pragma unroll
                for (int sh = 0; sh < 2; ++sh) { const float t0 = ab[sh][2] * cr2[sh] - ab[sh][3] * ci2[sh] + sr[sh][u], t1 = ab[sh][2] * ci2[sh] + ab[sh][3] * cr2[sh] + si[sh][u]; cr2[sh] = t0; ci2[sh] = t1; }
        }
#pragma unroll
        for (int sh = 0; sh < 2; ++sh) { xr[sh] = cr2[sh]; xi[sh] = ci2[sh]; }
    }
#pragma unroll
    for (int gg = 0; gg < 2; ++gg) {
        const int g = 2 * w + gg, lg = layer * 16 + g;
        const float* crp = a.in[20] + ((size_t)lg * 16 + l15) * 64; const float* cip = a.in[21] + ((size_t)lg * 16 + l15) * 64;
#pragma unroll
        for (int ks = 0; ks < 4; ++ks) {
            const int k0 = 32 * ks + 8 * kg;
            float v[8];
#pragma unroll
            for (int j = 0; j < 8; ++j) v[j] = (k0 < 64) ? crp[k0 + j] : -cip[k0 - 64 + j];
            u32x4 pw; pw.x = pk2(v[0], v[1]); pw.y = pk2(v[2], v[3]); pw.z = pk2(v[4], v[5]); pw.w = pk2(v[6], v[7]);
            cm[gg][ks] = __builtin_bit_cast(bf16x8, pw);
        }
        dsk[gg] = *(const f32x4*)(a.in[22] + lg * 16 + 4 * kg);
    }
    unsigned char* xs = lds + P3_XS + w * P3_XS_W;
    const bf16_t* gluT = (const bf16_t*)(a.ws + WS_GLU) + (size_t)layer * 65536;
    const float* glub = a.in[24] + layer * 256;
    bf16_t* mix = (bf16_t*)(a.ws + WS_MIX) + ((size_t)b * S + seg * 256) * D + 768;
    LAS3 float* ul = (LAS3 float*)(LAS3 unsigned char*)(lds + P3_US + w * 2048);
    const int utq = lane >> 3, ucc = lane & 7;
    const bf16_t* sup = su + (size_t)utq * 256 + 32 * w + 4 * ucc;
    u32x2 un0 = *(const u32x2*)(sup), un1 = *(const u32x2*)(sup + (size_t)8 * 256);
    const int ag = (qi >> 2) & 1;
    const bf16_t* aup = su + (size_t)(4 * (qi >> 3) + (qi & 3)) * 256 + 32 * w + 16 * ag + 8 * hi;
    u32x4 an = *(const u32x4*)aup;
#define S5_UNPK(v) (f32x4){__uint_as_float((v).x << 16), __uint_as_float((v).x & 0xffff0000u), __uint_as_float((v).y << 16), __uint_as_float((v).y & 0xffff0000u)}
    for (int sub = 0; sub < 4; ++sub) {
        for (int blk = 0; blk < 4; ++blk) {
            const int t0 = sub * 64 + blk * 16;
            *(LAS3 f32x4*)(ul + utq * 32 + 4 * ucc) = S5_UNPK(un0); *(LAS3 f32x4*)(ul + (8 + utq) * 32 + 4 * ucc) = S5_UNPK(un1);
            if (t0 + 16 < 256) { un0 = *(const u32x2*)(sup + (size_t)(t0 + 16) * 256); un1 = *(const u32x2*)(sup + (size_t)(t0 + 24) * 256); }
            {
                const u32x4 zero4 = (u32x4){0u, 0u, 0u, 0u};
                const bf16x8 a1 = __builtin_bit_cast(bf16x8, ag ? zero4 : an), a2 = __builtin_bit_cast(bf16x8, ag ? an : zero4);
                if (t0 + 16 < 256) an = *(const u32x4*)(aup + (size_t)(t0 + 16) * 256);
                f32x16 dre[2], dim[2];
#pragma unroll
                for (int sh = 0; sh < 2; ++sh) {
                    dre[sh] = MFMA32(a1, bre[0][sh], (f32x16){}); dre[sh] = MFMA32(a2, bre[1][sh], dre[sh]);
                    dim[sh] = MFMA32(a1, bim[0][sh], (f32x16){}); dim[sh] = MFMA32(a2, bim[1][sh], dim[sh]);
                }
                bf16_t* xp0 = (bf16_t*)(xs + hi * (16 * 272));
#pragma unroll
                for (int tt = 0; tt < 16; ++tt) {
#pragma unroll
                    for (int sh = 0; sh < 2; ++sh) {
                        const float nxr = abr[sh] * xr[sh] - abi[sh] * xi[sh] + dre[sh][tt], nxi = abr[sh] * xi[sh] + abi[sh] * xr[sh] + dim[sh][tt];
                        xr[sh] = nxr; xi[sh] = nxi;
                        bf16_t* xp = xp0 + tt * 136;
                        xp[qi + 32 * sh] = f2bf(nxr); xp[64 + qi + 32 * sh] = f2bf(nxi);
                    }
                }
            }
#pragma unroll
            for (int gg = 0; gg < 2; ++gg) {
                const int g = 2 * w + gg;
                f32x4 acc = (f32x4){0.f, 0.f, 0.f, 0.f};
#pragma unroll
                for (int ks = 0; ks < 4; ++ks) { const bf16x8 bfr = *(const bf16x8*)(xs + gg * (16 * 272) + l15 * 272 + (32 * ks + 8 * kg) * 2); acc = __builtin_amdgcn_mfma_f32_16x16x32_bf16(cm[gg][ks], bfr, acc, 0, 0, 0); }
                const f32x4 uu = *(const LAS3 f32x4*)(ul + l15 * 32 + 16 * gg + 4 * kg);
                u32x2 gw; gw.x = pk2(gelu_tanh(acc[0] + dsk[gg][0] * uu[0]), gelu_tanh(acc[1] + dsk[gg][1] * uu[1])); gw.y = pk2(gelu_tanh(acc[2] + dsk[gg][2] * uu[2]), gelu_tanh(acc[3] + dsk[gg][3] * uu[3]));
                *(u32x2*)(lds + P3_GS + (blk * 16 + l15) * P3_GS_P + (g * 16 + 4 * kg) * 2) = gw;
            }
        }
        __syncthreads();
#pragma unroll
        for (int tb = 0; tb < 2; ++tb) {
            f32x16 acc = (f32x16){};
#pragma unroll
            for (int ks = 0; ks < 16; ++ks) {
                const bf16x8 af = *(const bf16x8*)(gluT + (size_t)(32 * w + qi) * 256 + 16 * ks + 8 * hi);
                const bf16x8 bfr = *(const bf16x8*)(lds + P3_GS + (32 * tb + qi) * P3_GS_P + (16 * ks + 8 * hi) * 2);
                acc = MFMA32(af, bfr, acc);
            }
#pragma unroll
            for (int r4 = 0; r4 < 4; ++r4) {
                const int nn = 32 * w + 8 * r4 + 4 * hi;
                const u32x2 gq = *(const u32x2*)(lds + P3_GS + (32 * tb + qi) * P3_GS_P + nn * 2);
                const f32x4 bb = *(const f32x4*)(glub + nn);
                float ov[4];
#pragma unroll
                for (int e = 0; e < 4; ++e) {
                    const float gval = __uint_as_float(((e & 1) ? (((e >> 1) ? gq.y : gq.x) & 0xffff0000u) : (((e >> 1) ? gq.y : gq.x) << 16)));
                    ov[e] = gval / (1.f + __expf(-(acc[4 * r4 + e] + bb[e])));
                }
                u32x2 ow; ow.x = pk2(ov[0], ov[1]); ow.y = pk2(ov[2], ov[3]);
                *(u32x2*)(mix + (size_t)(sub * 64 + 32 * tb + qi) * D + nn) = ow;
            }
        }
        __syncthreads();
    }
}
__device__ __forceinline__ void phase_p3_elementwise(const Args& a, int layer) {
    const size_t gt = (size_t)blockIdx.x * NTHR + threadIdx.x, gn = (size_t)gridDim.x * NTHR;
    const bf16_t* dp = (const bf16_t*)(a.ws + WS_DPART); const float* dl = (const float*)(a.ws + WS_DLSE); bf16_t* mix = (bf16_t*)(a.ws + WS_MIX);
    for (size_t i = gt; i < (size_t)T * 32; i += gn) {
        const size_t tok = i >> 5; const int ch = (int)(i & 31), h = ch >> 3;
        const float l0 = dl[tok * 4 + h], l1 = dl[((size_t)T + tok) * 4 + h], l2 = dl[((size_t)2 * T + tok) * 4 + h];
        const float mx = fmaxf(l0, fmaxf(l1, l2));
        float w0 = __builtin_amdgcn_exp2f(l0 - mx), w1 = __builtin_amdgcn_exp2f(l1 - mx), w2 = __builtin_amdgcn_exp2f(l2 - mx);
        const float inv = 1.f / (w0 + w1 + w2); w0 *= inv; w1 *= inv; w2 *= inv;
        const u32x4 a0 = *(const u32x4*)(dp + tok * 256 + ch * 8), a1 = *(const u32x4*)(dp + ((size_t)T + tok) * 256 + ch * 8), a2 = *(const u32x4*)(dp + ((size_t)2 * T + tok) * 256 + ch * 8);
        u32x4 o;
#pragma unroll
        for (int j = 0; j < 4; ++j) {
            const float lo = w0 * __uint_as_float(a0[j] << 16) + w1 * __uint_as_float(a1[j] << 16) + w2 * __uint_as_float(a2[j] << 16);
            const float hi = w0 * __uint_as_float(a0[j] & 0xffff0000u) + w1 * __uint_as_float(a1[j] & 0xffff0000u) + w2 * __uint_as_float(a2[j] & 0xffff0000u);
            o[j] = pk2(lo, hi);
        }
        *(u32x4*)(mix + tok * D + 256 + ch * 8) = o;
    }
    {
        const int lane = threadIdx.x & 63, wv = blockIdx.x * 8 + (threadIdx.x >> 6), nw = gridDim.x * 8;
        const float* pu = a.in[27] + (size_t)layer * NEXP * D; const float* pv = a.in[28] + (size_t)layer * NEXP * D; const float* gn_ = a.in[5] + layer * D;
        unsigned char* ut = a.ws + WS_UT; unsigned char* vt = a.ws + WS_VT; float* scl = (float*)(a.ws + WS_US);
        float g[16]; load_row16(gn_, lane, g);
        for (int r = wv; r < 2 * NEXP; r += nw) {
            const bool isv = r >= NEXP; const int e = isv ? r - NEXP : r;
            float v[16]; load_row16((isv ? pv : pu) + (size_t)e * D, lane, v);
            float sq = 0.f;
#pragma unroll
            for (int i = 0; i < 16; ++i) { if (!isv) v[i] *= g[i]; sq += v[i] * v[i]; }
            sq = wave_sum(sq);
            const float sc = sq > 0.f ? 0.35f * sqrtf(sq * (1.f / 1024.f)) : 1.f, inv = 1.f / sc;
            u32x2 w;
#pragma unroll
            for (int j = 0; j < 2; ++j) {
                unsigned pk = 0u;
#pragma unroll
                for (int i = 0; i < 8; ++i) { int q = (int)rintf(v[8 * j + i] * inv); q = q > 7 ? 7 : (q < -7 ? -7 : q);
                    pk |= ((unsigned)(isv && (i < 4 || !HK_PEER_SPLIT) ? q + 8 : q) & 0xfu) << (i < 4 ? 8 * i : 8 * (i - 4) + 4); }
                w[j] = pk;
            }
            *(u32x2*)((isv ? vt : ut) + (size_t)e * 512 + 8 * lane) = w;
            if (lane == 0) scl[2 * e + (isv ? 1 : 0)] = isv || HK_PEER_SPLIT ? sc : sc * (1.f / 16.f);
        }
    }
}

__device__ __forceinline__ unsigned srt(float f) { const unsigned u = __float_as_uint(f); return u ^ ((unsigned)((int)u >> 31) | 0x80000000u); }
__device__ __forceinline__ float unsrt(unsigned u) { return __uint_as_float(u ^ ((~(unsigned)((int)u >> 31)) | 0x80000000u)); }
#define CEX(a, b) do { const unsigned x_ = (a), y_ = (b); (a) = x_ > y_ ? x_ : y_; (b) = x_ > y_ ? y_ : x_; } while (0)
__device__ __forceinline__ void bitonic_merge16(unsigned (&v)[16]) {
#pragma unroll
    for (int d = 8; d >= 1; d >>= 1)
#pragma unroll
        for (int i = 0; i < 16; ++i) if ((i & d) == 0) CEX(v[i], v[i + d]);
}
__device__ __forceinline__ void sort16_desc(unsigned (&v)[16]) {
    CEX(v[0], v[13]); CEX(v[1], v[12]); CEX(v[2], v[15]); CEX(v[3], v[14]); CEX(v[4], v[8]); CEX(v[5], v[6]); CEX(v[7], v[11]); CEX(v[9], v[10]);
    CEX(v[0], v[5]); CEX(v[1], v[7]); CEX(v[2], v[9]); CEX(v[3], v[4]); CEX(v[6], v[13]); CEX(v[8], v[14]); CEX(v[10], v[15]); CEX(v[11], v[12]);
    CEX(v[0], v[1]); CEX(v[2], v[3]); CEX(v[4], v[5]); CEX(v[6], v[8]); CEX(v[7], v[9]); CEX(v[10], v[11]); CEX(v[12], v[13]); CEX(v[14], v[15]);
    CEX(v[0], v[2]); CEX(v[1], v[3]); CEX(v[4], v[10]); CEX(v[5], v[11]); CEX(v[6], v[7]); CEX(v[8], v[9]); CEX(v[12], v[14]); CEX(v[13], v[15]);
    CEX(v[1], v[2]); CEX(v[3], v[12]); CEX(v[4], v[6]); CEX(v[5], v[7]); CEX(v[8], v[10]); CEX(v[9], v[11]); CEX(v[13], v[14]);
    CEX(v[1], v[4]); CEX(v[2], v[6]); CEX(v[5], v[8]); CEX(v[7], v[10]); CEX(v[9], v[13]); CEX(v[11], v[14]);
    CEX(v[2], v[4]); CEX(v[3], v[6]); CEX(v[9], v[12]); CEX(v[11], v[13]);
    CEX(v[3], v[5]); CEX(v[6], v[8]); CEX(v[7], v[9]); CEX(v[10], v[12]);
    CEX(v[3], v[4]); CEX(v[5], v[6]); CEX(v[7], v[8]); CEX(v[9], v[10]); CEX(v[11], v[12]);
    CEX(v[6], v[7]); CEX(v[8], v[9]);
}
__device__ __forceinline__ void merge_top16(unsigned (&a)[16], const unsigned (&b)[16]) {
#pragma unroll
    for (int j = 0; j < 16; ++j) a[j] = a[j] > b[15 - j] ? a[j] : b[15 - j];
    bitonic_merge16(a);
}
__device__ __forceinline__ void ins16(unsigned (&top)[16], unsigned pk) {
#pragma unroll
    for (int j = 0; j < 16; ++j) { const unsigned hi_ = top[j] > pk ? top[j] : pk; pk = top[j] > pk ? pk : top[j]; top[j] = hi_; }
}
__device__ __forceinline__ void merge_halves(unsigned (&top)[16]) {
    unsigned lo[16], hi[16];
#pragma unroll
    for (int j = 0; j < 16; ++j) { auto rr = __builtin_amdgcn_permlane32_swap(top[j], top[j], false, false); lo[j] = rr[0]; hi[j] = rr[1]; }
#pragma unroll
    for (int j = 0; j < 16; ++j) top[j] = lo[j] > hi[15 - j] ? lo[j] : hi[15 - j];
#pragma unroll
    for (int d = 8; d >= 1; d >>= 1)
#pragma unroll
        for (int i = 0; i < 16; ++i) if ((i & d) == 0) { const unsigned x = top[i], y = top[i + d]; top[i] = x > y ? x : y; top[i + d] = x > y ? y : x; }
}
constexpr int P6_PL = 0, P6_RS = 32768, P6_DOT = 32768 + 128, P6_LST = P6_DOT + 8 * 1024, P6_END = P6_LST + 8 * 8192;
__device__ __forceinline__ float dot8(const u32x4& a, const unsigned (&xh)[4], float acc) {
#pragma unroll
    for (int j = 0; j < 4; ++j) { acc += __uint_as_float(a[j] << 16) * __uint_as_float(xh[j] << 16); acc += __uint_as_float(a[j] & 0xffff0000u) * __uint_as_float(xh[j] & 0xffff0000u); }
    return acc;
}
__device__ __forceinline__ void peer_unit(const Args& a, unsigned char* lds, int layer, int unit) {
    int tid = threadIdx.x; asm volatile("" : "+v"(tid));
    const int lane = tid & 63, w = __builtin_amdgcn_readfirstlane(tid >> 6), qi = lane & 31, hi = lane >> 5;
    const int tok0 = unit * 32;
#if defined(HK_PROBE_PHASE) && HK_PROBE_PHASE == 10
    unsigned long long pq0_ = 0; if (blockIdx.x == 0 && threadIdx.x == 0) pq0_ = __builtin_amdgcn_s_memrealtime();
#endif
    const bf16_t* xg = (const bf16_t*)(a.ws + WS_XB);
    float* rsl = (float*)(lds + P6_RS);
    {
        u32x4 xr[4][2];
#pragma unroll
        for (int tt = 0; tt < 4; ++tt) { const bf16_t* p = xg + (size_t)(tok0 + 4 * w + tt) * D + 16 * lane; xr[tt][0] = *(const u32x4*)p; xr[tt][1] = *(const u32x4*)(p + 8); }
#pragma unroll
        for (int tt = 0; tt < 4; ++tt) {
            float ss = 0.f;
#pragma unroll
            for (int j = 0; j < 2; ++j)
#pragma unroll
                for (int e = 0; e < 4; ++e) { const float lo = __uint_as_float(xr[tt][j][e] << 16), hi_ = __uint_as_float(xr[tt][j][e] & 0xffff0000u); ss += lo * lo + hi_ * hi_; }
            ss = wave_sum(ss);
            if (lane == 0) rsl[4 * w + tt] = __builtin_amdgcn_rsqf(ss * (1.f / 1024.f) + EPS);
        }
    }
    __syncthreads();
    {
        const float rs2 = rsl[qi];
        const bf16_t* qrow = (const bf16_t*)(a.ws + WS_ZB) + (size_t)(tok0 + qi) * 2048 + 256 * w;
        const bf16_t* kb_ = (const bf16_t*)(a.ws + WS_KEYS) + (size_t)(layer * 16 + 2 * w) * 128 * 128;
        unsigned* lsw = (unsigned*)(lds + P6_LST) + w * 2048 + lane;
#if HK_FOLD_KEYS
        const bf16_t* srow = (const bf16_t*)(a.ws + WS_ZB) + (size_t)(tok0 + qi) * 2048 + 256 * w + 64 * hi;
        u32x4 sv[2][8];
#pragma unroll
        for (int p = 0; p < 2; ++p)
#pragma unroll
            for (int j = 0; j < 8; ++j) sv[p][j] = *(const u32x4*)(srow + 128 * p + 8 * j);
#pragma unroll
        for (int p = 0; p < 2; ++p) {
            unsigned top[16];
#pragma unroll
            for (int kb = 0; kb < 4; ++kb) {
                unsigned cur[16];
#pragma unroll
                for (int j = 0; j < 2; ++j)
#pragma unroll
                    for (int e = 0; e < 4; ++e) {
                        const unsigned wd = sv[p][2 * kb + j][e];
                        const unsigned lo = wd & 0xffffu, hi16 = wd >> 16;
                        const unsigned slo = lo ^ ((lo & 0x8000u) ? 0xffffu : 0x8000u), shi = hi16 ^ ((hi16 & 0x8000u) ? 0xffffu : 0x8000u);
                        const unsigned idx = (unsigned)(64 * hi + 16 * kb + 8 * j + 2 * e);
                        cur[8 * j + 2 * e] = (slo << 16) | idx; cur[8 * j + 2 * e + 1] = (shi << 16) | (idx + 1u);
                    }
                sort16_desc(cur);
                if (kb == 0) {
#pragma unroll
                    for (int j = 0; j < 16; ++j) top[j] = cur[j];
                } else merge_top16(top, cur);
            }
            merge_halves(top);
#pragma unroll
            for (int j = 0; j < 16; ++j) { const unsigned s16 = top[j] >> 16; const unsigned hb = s16 ^ ((s16 & 0x8000u) ? 0x8000u : 0xffffu);
                const _Float16 hv = __builtin_bit_cast(_Float16, (unsigned short)hb);
                lsw[(p * 16 + j) * 64] = (srt((float)hv) & ~127u) | (top[j] & 127u); }
        }
#else
        bf16x8 qf2[2][8];
#pragma unroll
        for (int p = 0; p < 2; ++p)
#pragma unroll
            for (int ks = 0; ks < 8; ++ks) qf2[p][ks] = *(const bf16x8*)(qrow + 128 * p + 16 * ks + 8 * hi);
#pragma unroll
        for (int p = 0; p < 2; ++p) {
            const bf16x8 (&qf)[8] = qf2[p];
            unsigned top[16];
            bf16x8 kfn[8];
#pragma unroll
            for (int ks = 0; ks < 8; ++ks) kfn[ks] = *(const bf16x8*)(kb_ + ((size_t)p * 128 + qi) * 128 + 16 * ks + 8 * hi);
#pragma unroll 1
            for (int kb = 0; kb < 4; ++kb) {
                f32x16 acc = (f32x16){};
#pragma unroll
                for (int ks = 0; ks < 8; ++ks) acc = MFMA32(kfn[ks], qf[ks], acc);
                if (kb < 3) {
#pragma unroll
                    for (int ks = 0; ks < 8; ++ks) kfn[ks] = *(const bf16x8*)(kb_ + ((size_t)p * 128 + 32 * (kb + 1) + qi) * 128 + 16 * ks + 8 * hi);
                }
                unsigned cur[16];
#pragma unroll
                for (int r = 0; r < 16; ++r) cur[r] = (srt(acc[r]) & ~127u) | (unsigned)(32 * kb + (r & 3) + 8 * (r >> 2) + 4 * hi);
                sort16_desc(cur);
                if (kb == 0) {
#pragma unroll
                    for (int j = 0; j < 16; ++j) top[j] = cur[j];
                } else merge_top16(top, cur);
            }
            merge_halves(top);
#pragma unroll
            for (int j = 0; j < 16; ++j) lsw[(p * 16 + j) * 64] = top[j];
        }
#endif
        unsigned best[16];
#pragma unroll
        for (int j = 0; j < 16; ++j) best[j] = 0u;
#pragma unroll 1
        for (int i = hi; i < 16; i += 2) {
            const unsigned ai = lsw[i * 64]; const float vai = unsrt(ai & ~127u); const unsigned iai = (ai & 127u) << 7;
            const int nj = 16 / (i + 1);
#pragma unroll 1
            for (int j = 0; j < nj; ++j) { const unsigned bj = lsw[(16 + j) * 64]; ins16(best, (srt(vai + unsrt(bj & ~127u)) & ~0x3FFFu) | iai | (bj & 127u)); }
        }
        merge_halves(best);
        float e[16], sum = 0.f;
        const float s0 = unsrt(best[0] & ~0x3FFFu);
#pragma unroll
        for (int j = 0; j < 16; ++j) { e[j] = __builtin_amdgcn_exp2f((unsrt(best[j] & ~0x3FFFu) - s0) * rs2 * LOG2E); sum += e[j]; }
        const float inv = 1.f / sum;
        if (hi == 0) {
            u32x2* pl = (u32x2*)(lds + P6_PL) + qi * 128 + 16 * w;
#pragma unroll
            for (int j = 0; j < 16; ++j) { u32x2 en; en.x = best[j] & 0x3FFFu; en.y = __float_as_uint(e[j] * inv); pl[j] = en; }
        }
    }
    __syncthreads();
#if defined(HK_PROBE_PHASE) && HK_PROBE_PHASE == 10
    if (blockIdx.x == 0 && threadIdx.x == 0) { volatile LAS3 unsigned* pw_ = (volatile LAS3 unsigned*)(LAS3 unsigned char*)(lds + LDS_CTL + 48); *pw_ = *pw_ + (unsigned)(__builtin_amdgcn_s_memrealtime() - pq0_); }
#endif
    const unsigned char* ut = a.ws + WS_UT; const unsigned char* vt = a.ws + WS_VT; const float* scl = (const float*)(a.ws + WS_US);
    float* dots = (float*)(lds + P6_DOT) + w * 256; float* cfs = dots + 128;
    int vz_; asm volatile("v_mov_b32 %0, 0" : "=v"(vz_));
    const int lane_g = lane + vz_, hi_g = lane_g >> 5;
    const int c32 = lane_g & 31, slot = 2 * c32 + hi_g;
#define PG_ISSUE(buf, tab, plp, b) do { _Pragma("unroll") for (int kk = 0; kk < 8; ++kk) { const unsigned id_ = (plp)[16 * (b) + 8 * hi_g + kk].x; buf[kk] = *(const u32x4*)((tab) + (unsigned)(id_ * 512u + 16u * (unsigned)c32)); } } while (0)
#define PG_CU(buf, b) do { int pd_[8]; \
        _Pragma("unroll") for (int kk = 0; kk < 8; ++kk) { int d_ = 0; \
            _Pragma("unroll") for (int j = 0; j < 4; ++j) { d_ = __builtin_amdgcn_sdot4((int)((buf[kk][j] << 4) & 0xF0F0F0F0u), xq[2 * j], d_, false); d_ = __builtin_amdgcn_sdot4((int)(buf[kk][j] & 0xF0F0F0F0u), xq[2 * j + 1], d_, false); } \
            pd_[kk] = d_; } \
        int r4_[4]; \
        _Pragma("unroll") for (int j = 0; j < 4; ++j) { auto rr_ = __builtin_amdgcn_permlane16_swap((unsigned)pd_[j], (unsigned)pd_[j + 4], false, false); r4_[j] = (int)rr_[0] + (int)rr_[1]; } \
        _Pragma("unroll") for (int j = 0; j < 4; ++j) { int v_ = r4_[j]; \
            v_ += __builtin_amdgcn_update_dpp(0, v_, 0xB1, 0xf, 0xf, true); v_ += __builtin_amdgcn_update_dpp(0, v_, 0x4E, 0xf, 0xf, true); \
            v_ += __builtin_amdgcn_update_dpp(0, v_, 0x141, 0xf, 0xf, true); v_ += __builtin_amdgcn_update_dpp(0, v_, 0x140, 0xf, 0xf, true); r4_[j] = v_; } \
        if ((lane_g & 15) == 0) { const int q_ = lane_g >> 4; *(f32x4*)(dots + 16 * (b) + 8 * (q_ >> 1) + 4 * (q_ & 1)) = (f32x4){(float)r4_[0], (float)r4_[1], (float)r4_[2], (float)r4_[3]}; } } while (0)
#define PG_T4(r0, r1, r2, r3, t0, t1, t2, t3) do { const unsigned a01l_ = __builtin_amdgcn_perm(r1, r0, 0x05010400u), a01h_ = __builtin_amdgcn_perm(r1, r0, 0x07030602u), \
            a23l_ = __builtin_amdgcn_perm(r3, r2, 0x05010400u), a23h_ = __builtin_amdgcn_perm(r3, r2, 0x07030602u); \
        t0 = __builtin_amdgcn_perm(a23l_, a01l_, 0x05040100u); t1 = __builtin_amdgcn_perm(a23l_, a01l_, 0x07060302u); \
        t2 = __builtin_amdgcn_perm(a23h_, a01h_, 0x05040100u); t3 = __builtin_amdgcn_perm(a23h_, a01h_, 0x07060302u); } while (0)
#define PG_CV(buf, b) do { _Pragma("unroll") for (int g4 = 0; g4 < 2; ++g4) { const int cq_ = (int)cqw[4 * (b) + 2 * hi_g + g4]; \
            _Pragma("unroll") for (int j = 0; j < 4; ++j) { \
                const unsigned w0_ = buf[4 * g4][j], w1_ = buf[4 * g4 + 1][j], w2_ = buf[4 * g4 + 2][j], w3_ = buf[4 * g4 + 3][j]; \
                unsigned t0_, t1_, t2_, t3_; \
                PG_T4(w0_ & 0x0F0F0F0Fu, w1_ & 0x0F0F0F0Fu, w2_ & 0x0F0F0F0Fu, w3_ & 0x0F0F0F0Fu, t0_, t1_, t2_, t3_); \
                oa[8 * j + 0] = __builtin_amdgcn_sdot4((int)t0_, cq_, oa[8 * j + 0], false); oa[8 * j + 1] = __builtin_amdgcn_sdot4((int)t1_, cq_, oa[8 * j + 1], false); \
                oa[8 * j + 2] = __builtin_amdgcn_sdot4((int)t2_, cq_, oa[8 * j + 2], false); oa[8 * j + 3] = __builtin_amdgcn_sdot4((int)t3_, cq_, oa[8 * j + 3], false); \
                PG_T4((w0_ >> 4) & 0x0F0F0F0Fu, (w1_ >> 4) & 0x0F0F0F0Fu, (w2_ >> 4) & 0x0F0F0F0Fu, (w3_ >> 4) & 0x0F0F0F0Fu, t0_, t1_, t2_, t3_); \
                oa[8 * j + 4] = __builtin_amdgcn_sdot4((int)t0_, cq_, oa[8 * j + 4], false); oa[8 * j + 5] = __builtin_amdgcn_sdot4((int)t1_, cq_, oa[8 * j + 5], false); \
                oa[8 * j + 6] = __builtin_amdgcn_sdot4((int)t2_, cq_, oa[8 * j + 6], false); oa[8 * j + 7] = __builtin_amdgcn_sdot4((int)t3_, cq_, oa[8 * j + 7], false); \
                asm volatile("" : "+v"(oa[8 * j]), "+v"(oa[8 * j + 1]), "+v"(oa[8 * j + 2]), "+v"(oa[8 * j + 3]), "+v"(oa[8 * j + 4]), "+v"(oa[8 * j + 5]), "+v"(oa[8 * j + 6]), "+v"(oa[8 * j + 7])); } } } while (0)
#define PG_SB __builtin_amdgcn_sched_barrier(0)
    u32x4 bA[8], bB[8];
    { const u32x2* pl0 = (const u32x2*)(lds + P6_PL) + (4 * w) * 128; PG_ISSUE(bA, ut, pl0, 0); }
    for (int tt = 0; tt < 4; ++tt) {
        const int tl = 4 * w + tt, tok = tok0 + tl;
        const float rs2 = rsl[tl];
        const u32x2* pl = (const u32x2*)(lds + P6_PL) + tl * 128;
        const u32x2 en0 = pl[lane_g], en1 = pl[64 + lane_g];
        const float2 sc0_ = *(const float2*)(scl + 2 * (size_t)en0.x), sc1_ = *(const float2*)(scl + 2 * (size_t)en1.x);
        const float us0 = sc0_.x, us1 = sc1_.x, vs0 = sc0_.y, vs1 = sc1_.y;
        float xv[16]; load_row16_bf(xg + (size_t)tok * D, slot, xv);
        float mx = 0.f;
#pragma unroll
        for (int i = 0; i < 16; ++i) mx = fmaxf(mx, fabsf(xv[i]));
#pragma unroll
        for (int o = 32; o > 0; o >>= 1) mx = fmaxf(mx, __shfl_xor(mx, o));
        const float sx = mx > 0.f ? mx * (1.f / 127.f) : 1.f, isx = 1.f / sx;
        int xq[8];
#pragma unroll
        for (int j = 0; j < 4; ++j) {
            unsigned pk = 0u;
#pragma unroll
            for (int i = 0; i < 4; ++i) { const int q = (int)rintf(xv[4 * j + i] * isx); pk |= ((unsigned)q & 0xffu) << (8 * i); }
            auto rr = __builtin_amdgcn_permlane32_swap(pk, pk, false, false);
            xq[j] = (int)rr[0]; xq[4 + j] = (int)rr[1];
        }
#pragma unroll
        for (int ub = 0; ub < 8; ub += 2) {
            PG_ISSUE(bB, ut, pl, ub + 1); PG_SB; PG_CU(bA, ub); PG_SB;
            if (ub + 2 < 8) PG_ISSUE(bA, ut, pl, ub + 2); else PG_ISSUE(bA, vt, pl, 0);
            PG_SB; PG_CU(bB, ub + 1); PG_SB;
        }
        const float a0 = gelu_tanh(dots[lane_g] * (sx * rs2) * us0) * __uint_as_float(en0.y);
        const float a1 = gelu_tanh(dots[64 + lane_g] * (sx * rs2) * us1) * __uint_as_float(en1.y);
        const float c0 = a0 * vs0, c1 = a1 * vs1;
        float cm = fmaxf(fabsf(c0), fabsf(c1));
#pragma unroll
        for (int o = 32; o > 0; o >>= 1) cm = fmaxf(cm, __shfl_xor(cm, o));
        const float scc = cm > 0.f ? cm * (1.f / 127.f) : 1.f, iscc = 1.f / scc;
        const int q0c = (int)rintf(c0 * iscc), q1c = (int)rintf(c1 * iscc);
        volatile LAS3 signed char* cqb = (volatile LAS3 signed char*)(LAS3 unsigned char*)cfs;
        cqb[lane_g] = (signed char)q0c; cqb[64 + lane_g] = (signed char)q1c;
        const LAS3 unsigned* cqw = (const LAS3 unsigned*)(LAS3 unsigned char*)cfs;
        int qsum = q0c + q1c;
#pragma unroll
        for (int o = 32; o > 0; o >>= 1) qsum += __shfl_xor(qsum, o);
        int oa[32];
#pragma unroll
        for (int i = 0; i < 32; ++i) oa[i] = 0;
        int vzv_; asm volatile("v_mov_b32 %0, 0" : "=v"(vzv_));
        const u32x2* plv = pl + vzv_;
#pragma unroll
        for (int vb = 0; vb < 8; vb += 2) {
            PG_ISSUE(bB, vt, plv, vb + 1); PG_SB; PG_CV(bA, vb); PG_SB;
            if (vb + 2 < 8) PG_ISSUE(bA, vt, plv, vb + 2); else if (tt < 3) PG_ISSUE(bA, ut, plv + 128, 0);
            PG_SB; PG_CV(bB, vb + 1); PG_SB;
        }
#pragma unroll
        for (int i = 0; i < 16; ++i) {
            auto rr = __builtin_amdgcn_permlane32_swap((unsigned)oa[i], (unsigned)oa[16 + i], false, false);
#ifndef HK_PROBE_NOPEER
            xv[i] += scc * (float)((int)rr[0] + (int)rr[1] - 8 * qsum);
#else
            xv[i] += 1e-30f * (float)((int)rr[0] + (int)rr[1]);
#endif
        }
#ifdef HK_PROBE_L2
        {
            int dsum = 0;
            for (int k = 0; k < 128; k += 32) {
                u32x4 ldx[16];
#pragma unroll
                for (int kk = 0; kk < 16; ++kk) { unsigned id = pl[k + 16 * hi_g + kk].x; if (HK_PROBE_L2 == 2) id &= 0x0FFFu; ldx[kk] = *(const u32x4*)(ut + (size_t)id * 512 + 16 * c32); }
#pragma unroll
                for (int kk = 0; kk < 16; ++kk) { dsum = __builtin_amdgcn_sdot4((int)ldx[kk].x, xq[0], dsum, false); dsum = __builtin_amdgcn_sdot4((int)ldx[kk].w, xq[1], dsum, false); }
            }
            xv[0] += 1e-30f * (float)dsum;
        }
#endif
        const bool more = layer + 1 < DEPTH;
        int vzt_; asm volatile("v_mov_b32 %0, 0" : "=v"(vzt_) : "v"(xv[0]));
        finish_token(tok, xv, more ? nullptr : a.out, (bf16_t*)(a.ws + WS_XB), (float*)(a.ws + WS_RSTD), more ? (const float*)(a.ws + WS_WF) + (size_t)(layer + 1) * 4096 : nullptr,
                     a.in[2] + (more ? (layer + 1) * 4 : 0), (float*)(a.ws + WS_FLOG), lane, slot + vzt_);
    }
#undef PG_ISSUE
#undef PG_SB
#undef PG_CU
#undef PG_CV
#undef PG_T4
    __syncthreads();
}
#if HK_FOLD_KEYS
__device__ __forceinline__ void peer_unit_a(const Args& a, unsigned char* lds, int layer, int unit) {
    int tid = threadIdx.x; asm volatile("" : "+v"(tid));
    const int lane = tid & 63, w = __builtin_amdgcn_readfirstlane(tid >> 6), qi = lane & 31, hi = lane >> 5;
    const int tok0 = unit * 32;
#if defined(HK_PROBE_PHASE) && HK_PROBE_PHASE == 10
    unsigned long long pq0_ = 0; if (blockIdx.x == 0 && threadIdx.x == 0) pq0_ = __builtin_amdgcn_s_memrealtime();
#endif
    const bf16_t* xg = (const bf16_t*)(a.ws + WS_XB);
    float* rsl = (float*)(lds + P6_RS);
    {
        u32x4 xr[4][2];
#pragma unroll
        for (int tt = 0; tt < 4; ++tt) { const bf16_t* p = xg + (size_t)(tok0 + 4 * w + tt) * D + 16 * lane; xr[tt][0] = *(const u32x4*)p; xr[tt][1] = *(const u32x4*)(p + 8); }
#pragma unroll
        for (int tt = 0; tt < 4; ++tt) {
            float ss = 0.f;
#pragma unroll
            for (int j = 0; j < 2; ++j)
#pragma unroll
                for (int e = 0; e < 4; ++e) { const float lo = __uint_as_float(xr[tt][j][e] << 16), hi_ = __uint_as_float(xr[tt][j][e] & 0xffff0000u); ss += lo * lo + hi_ * hi_; }
            ss = wave_sum(ss);
            if (lane == 0) rsl[4 * w + tt] = __builtin_amdgcn_rsqf(ss * (1.f / 1024.f) + EPS);
        }
    }
    const int tl_r = 4 * w + (qi >> 3), hd = qi & 7;
    {
        const float rs2 = rsl[tl_r];
        unsigned* lsw = (unsigned*)(lds + P6_LST) + w * 2048 + lane;
#if HK_FOLD_KEYS
        const bf16_t* srow = (const bf16_t*)(a.ws + WS_ZB) + (size_t)(tok0 + tl_r) * 2048 + 256 * hd + 64 * hi;
        u32x4 sv[2][8];
#pragma unroll
        for (int p = 0; p < 2; ++p)
#pragma unroll
            for (int j = 0; j < 8; ++j) sv[p][j] = *(const u32x4*)(srow + 128 * p + 8 * j);
#pragma unroll
        for (int p = 0; p < 2; ++p) {
            unsigned top[16];
#pragma unroll
            for (int kb = 0; kb < 4; ++kb) {
                unsigned cur[16];
#pragma unroll
                for (int j = 0; j < 2; ++j)
#pragma unroll
                    for (int e = 0; e < 4; ++e) {
                        const unsigned wd = sv[p][2 * kb + j][e];
                        typedef short s16x2_ __attribute__((ext_vector_type(2)));
                        const s16x2_ sg = __builtin_bit_cast(s16x2_, wd) >> 15;
                        const unsigned k2 = wd ^ ((__builtin_bit_cast(unsigned, sg) & 0x7fff7fffu) | 0x80008000u);
                        const unsigned idx = (unsigned)(64 * hi + 16 * kb + 8 * j + 2 * e);
                        cur[8 * j + 2 * e] = (k2 << 16) | idx; cur[8 * j + 2 * e + 1] = (k2 & 0xffff0000u) | (idx + 1u);
                    }
                sort16_desc(cur);
                if (kb == 0) {
#pragma unroll
                    for (int j = 0; j < 16; ++j) top[j] = cur[j];
                } else merge_top16(top, cur);
            }
            merge_halves(top);
#pragma unroll
            for (int j = 0; j < 16; ++j) { const unsigned s16 = top[j] >> 16; const unsigned hb = s16 ^ ((s16 & 0x8000u) ? 0x8000u : 0xffffu);
                const _Float16 hv = __builtin_bit_cast(_Float16, (unsigned short)hb);
                lsw[(p * 16 + j) * 64] = (srt((float)hv) & ~127u) | (top[j] & 127u); }
        }
#endif
        unsigned best[16];
        {
            const int offA = hi ? 16 * 64 : 0, offB = hi ? 0 : 16 * 64, shA = hi ? 0 : 7, shB = hi ? 7 : 0;
            float fa[16], fb[16]; unsigned ia[16], ib[16];
#pragma unroll
            for (int i = 0; i < 16; ++i) { const unsigned av = lsw[offA + i * 64], bv = lsw[offB + i * 64];
                fa[i] = unsrt(av & ~127u); fb[i] = unsrt(bv & ~127u); ia[i] = (av & 127u) << shA; ib[i] = (bv & 127u) << shB; }
#define PA_CAND(i, j) ((srt(fa[i] + fb[j]) & ~0x3FFFu) | ia[i] | ib[j])
            unsigned c0[16], c1[16];
#pragma unroll
            for (int j = 1; j < 16; ++j) c0[j - 1] = PA_CAND(0, j);
            c0[15] = hi ? PA_CAND(1, 1) : PA_CAND(0, 0);
#pragma unroll
            for (int j = 2; j < 8; ++j) c1[j - 2] = PA_CAND(1, j);
            c1[6] = PA_CAND(2, 3); c1[7] = PA_CAND(2, 4);
            c1[8] = hi ? PA_CAND(3, 3) : PA_CAND(2, 2);
#pragma unroll
            for (int j = 9; j < 16; ++j) c1[j] = 0u;
#undef PA_CAND
            sort16_desc(c0); sort16_desc(c1);
            merge_top16(c0, c1);
#pragma unroll
            for (int j = 0; j < 16; ++j) best[j] = c0[j];
        }
        merge_halves(best);
        float e[16], sum = 0.f;
        const float s0 = unsrt(best[0] & ~0x3FFFu);
#pragma unroll
        for (int j = 0; j < 16; ++j) { e[j] = __builtin_amdgcn_exp2f((unsrt(best[j] & ~0x3FFFu) - s0) * rs2 * LOG2E); sum += e[j]; }
        const float inv = 1.f / sum;
        if (hi == 0) {
            u32x2* pl = (u32x2*)(lds + P6_PL) + tl_r * 128 + 16 * hd;
#pragma unroll
            for (int j = 0; j < 16; ++j) { u32x2 en; en.x = best[j] & 0x3FFFu; en.y = __float_as_uint(e[j] * inv); pl[j] = en; }
        }
    }
#if defined(HK_PROBE_PHASE) && HK_PROBE_PHASE == 10
    if (blockIdx.x == 0 && threadIdx.x == 0) { volatile LAS3 unsigned* pw_ = (volatile LAS3 unsigned*)(LAS3 unsigned char*)(lds + LDS_CTL + 48); *pw_ = *pw_ + (unsigned)(__builtin_amdgcn_s_memrealtime() - pq0_); }
#endif
    const unsigned char* ut = a.ws + WS_UT; const unsigned char* vt = a.ws + WS_VT; const float* scl = (const float*)(a.ws + WS_US);
    float* dots = (float*)(lds + P6_DOT) + w * 256; float* cfs = dots + 128;
    int vz_; asm volatile("v_mov_b32 %0, 0" : "=v"(vz_));
    const int lane_g = lane + vz_, hi_g = lane_g >> 5;
    const int c32 = lane_g & 31, slot = 2 * c32 + hi_g;
#define PG_ISSUE(buf, tab, plp, b) do { _Pragma("unroll") for (int kk = 0; kk < 8; ++kk) { const unsigned id_ = (plp)[16 * (b) + 8 * hi_g + kk].x; buf[kk] = *(const u32x4*)((tab) + (unsigned)(id_ * 512u + 16u * (unsigned)c32)); } } while (0)
#define PG_CU(buf, b) do { int pd_[8]; \
        _Pragma("unroll") for (int kk = 0; kk < 8; ++kk) {        \
            int dl_ = __builtin_amdgcn_sdot8((int)buf[kk][0], xl4[0], 0, true), dh_ = __builtin_amdgcn_sdot8((int)buf[kk][0], xh4[0], 0, true); \
            _Pragma("unroll") for (int j = 1; j < 4; ++j) { dl_ = __builtin_amdgcn_sdot8((int)buf[kk][j], xl4[j], dl_, false); dh_ = __builtin_amdgcn_sdot8((int)buf[kk][j], xh4[j], dh_, false); } \
            pd_[kk] = (dh_ << 4) + dl_; } \
        int r4_[4]; \
        _Pragma("unroll") for (int j = 0; j < 4; ++j) { auto rr_ = __builtin_amdgcn_permlane16_swap((unsigned)pd_[j], (unsigned)pd_[j + 4], false, false); r4_[j] = (int)rr_[0] + (int)rr_[1]; } \
        _Pragma("unroll") for (int j = 0; j < 4; ++j) { int v_ = r4_[j]; \
            v_ += __builtin_amdgcn_update_dpp(0, v_, 0xB1, 0xf, 0xf, true); v_ += __builtin_amdgcn_update_dpp(0, v_, 0x4E, 0xf, 0xf, true); \
            v_ += __builtin_amdgcn_update_dpp(0, v_, 0x141, 0xf, 0xf, true); v_ += __builtin_amdgcn_update_dpp(0, v_, 0x140, 0xf, 0xf, true); r4_[j] = v_; } \
        if ((lane_g & 15) == 0) { const int q_ = lane_g >> 4; *(f32x4*)(dots + 16 * (b) + 8 * (q_ >> 1) + 4 * (q_ & 1)) = (f32x4){(float)r4_[0], (float)r4_[1], (float)r4_[2], (float)r4_[3]}; } } while (0)
#define PG_T4(r0, r1, r2, r3, t0, t1, t2, t3) do { const unsigned a01l_ = __builtin_amdgcn_perm(r1, r0, 0x05010400u), a01h_ = __builtin_amdgcn_perm(r1, r0, 0x07030602u), \
            a23l_ = __builtin_amdgcn_perm(r3, r2, 0x05010400u), a23h_ = __builtin_amdgcn_perm(r3, r2, 0x07030602u); \
        t0 = __builtin_amdgcn_perm(a23l_, a01l_, 0x05040100u); t1 = __builtin_amdgcn_perm(a23l_, a01l_, 0x07060302u); \
        t2 = __builtin_amdgcn_perm(a23h_, a01h_, 0x05040100u); t3 = __builtin_amdgcn_perm(a23h_, a01h_, 0x07060302u); } while (0)
#define PG_CV(buf, b) do { _Pragma("unroll") for (int g4 = 0; g4 < 2; ++g4) { const int cq_ = (int)cqw[4 * (b) + 2 * hi_g + g4]; \
            _Pragma("unroll") for (int j = 0; j < 4; ++j) { \
                const unsigned w0_ = buf[4 * g4][j], w1_ = buf[4 * g4 + 1][j], w2_ = buf[4 * g4 + 2][j], w3_ = buf[4 * g4 + 3][j]; \
                unsigned t0_, t1_, t2_, t3_; \
                PG_T4(w0_ & 0x0F0F0F0Fu, w1_ & 0x0F0F0F0Fu, w2_ & 0x0F0F0F0Fu, w3_ & 0x0F0F0F0Fu, t0_, t1_, t2_, t3_); \
                oa[8 * j + 0] = __builtin_amdgcn_sdot4((int)t0_, cq_, oa[8 * j + 0], false); oa[8 * j + 1] = __builtin_amdgcn_sdot4((int)t1_, cq_, oa[8 * j + 1], false); \
                oa[8 * j + 2] = __builtin_amdgcn_sdot4((int)t2_, cq_, oa[8 * j + 2], false); oa[8 * j + 3] = __builtin_amdgcn_sdot4((int)t3_, cq_, oa[8 * j + 3], false); \
                PG_T4((w0_ >> 4) & 0x0F0F0F0Fu, (w1_ >> 4) & 0x0F0F0F0Fu, (w2_ >> 4) & 0x0F0F0F0Fu, (w3_ >> 4) & 0x0F0F0F0Fu, t0_, t1_, t2_, t3_); \
                oa[8 * j + 4] = __builtin_amdgcn_sdot4((int)t0_, cq_, oa[8 * j + 4], false); oa[8 * j + 5] = __builtin_amdgcn_sdot4((int)t1_, cq_, oa[8 * j + 5], false); \
                oa[8 * j + 6] = __builtin_amdgcn_sdot4((int)t2_, cq_, oa[8 * j + 6], false); oa[8 * j + 7] = __builtin_amdgcn_sdot4((int)t3_, cq_, oa[8 * j + 7], false); \
                asm volatile("" : "+v"(oa[8 * j]), "+v"(oa[8 * j + 1]), "+v"(oa[8 * j + 2]), "+v"(oa[8 * j + 3]), "+v"(oa[8 * j + 4]), "+v"(oa[8 * j + 5]), "+v"(oa[8 * j + 6]), "+v"(oa[8 * j + 7])); } } } while (0)
#define PG_SB __builtin_amdgcn_sched_barrier(0)
    u32x4 bA[8], bB[8], bC[8], bD[8];
    { const u32x2* pl0 = (const u32x2*)(lds + P6_PL) + (4 * w) * 128; PG_ISSUE(bA, ut, pl0, 0); PG_ISSUE(bB, ut, pl0, 1); PG_ISSUE(bC, ut, pl0, 2); }
    for (int tt = 0; tt < 4; ++tt) {
        const int tl = 4 * w + tt, tok = tok0 + tl;
        const float rs2 = rsl[tl];
        const u32x2* pl = (const u32x2*)(lds + P6_PL) + tl * 128;
        const u32x2 en0 = pl[lane_g], en1 = pl[64 + lane_g];
        const float2 sc0_ = *(const float2*)(scl + 2 * (size_t)en0.x), sc1_ = *(const float2*)(scl + 2 * (size_t)en1.x);
        const float us0 = sc0_.x, us1 = sc1_.x, vs0 = sc0_.y, vs1 = sc1_.y;
        float xv[16]; load_row16_bf(xg + (size_t)tok * D, slot, xv);
        float mx = 0.f;
#pragma unroll
        for (int i = 0; i < 16; ++i) mx = fmaxf(mx, fabsf(xv[i]));
#pragma unroll
        for (int o = 32; o > 0; o >>= 1) mx = fmaxf(mx, __shfl_xor(mx, o));
        const float sx = mx > 0.f ? mx * (1.f / 119.f) : 1.f, isx = 1.f / sx;
        int xl4[4], xh4[4];
        {
            unsigned xq[8];
#pragma unroll
            for (int j = 0; j < 4; ++j) {
                unsigned pk = 0u;
#pragma unroll
                for (int i = 0; i < 4; ++i) { const int q = (int)rintf(xv[4 * j + i] * isx); pk |= ((unsigned)q & 0xffu) << (8 * i); }
                auto rr = __builtin_amdgcn_permlane32_swap(pk, pk, false, false);
                xq[j] = rr[0]; xq[4 + j] = rr[1];
            }
#pragma unroll
            for (int j = 0; j < 4; ++j) {
                const unsigned A = xq[2 * j], B = xq[2 * j + 1];
                xl4[j] = (int)((A & 0x0F0F0F0Fu) | ((B & 0x0F0F0F0Fu) << 4));
                const unsigned ha = (((A >> 4) & 0x0F0F0F0Fu) + ((A >> 3) & 0x01010101u)) & 0x0F0F0F0Fu, hb = (((B >> 4) & 0x0F0F0F0Fu) + ((B >> 3) & 0x01010101u)) & 0x0F0F0F0Fu;
                xh4[j] = (int)(ha | (hb << 4));
            }
        }
#define PG_STEP(cur, nxt, ub) do { if ((ub) + 3 < 8) PG_ISSUE(nxt, ut, pl, (ub) + 3); else if (tt < 3) PG_ISSUE(nxt, ut, pl + 128, (ub) + 3 - 8); PG_SB; PG_CU(cur, ub); PG_SB; } while (0)
        PG_STEP(bA, bD, 0); PG_STEP(bB, bA, 1); PG_STEP(bC, bB, 2); PG_STEP(bD, bC, 3); PG_STEP(bA, bD, 4); PG_STEP(bB, bA, 5); PG_STEP(bC, bB, 6); PG_STEP(bD, bC, 7);
#undef PG_STEP
        const float a0 = gelu_tanh(dots[lane_g] * (sx * rs2) * us0) * __uint_as_float(en0.y);
        const float a1 = gelu_tanh(dots[64 + lane_g] * (sx * rs2) * us1) * __uint_as_float(en1.y);
        const float c0 = a0 * vs0, c1 = a1 * vs1;
        float cm = fmaxf(fabsf(c0), fabsf(c1));
#pragma unroll
        for (int o = 32; o > 0; o >>= 1) cm = fmaxf(cm, __shfl_xor(cm, o));
        const float scc = cm > 0.f ? cm * (1.f / 127.f) : 1.f, iscc = 1.f / scc;
        const int q0c = (int)rintf(c0 * iscc), q1c = (int)rintf(c1 * iscc);
        int qsum = q0c + q1c;
#pragma unroll
        for (int o = 32; o > 0; o >>= 1) qsum += __shfl_xor(qsum, o);
        unsigned short* gid = (unsigned short*)(a.ws + WS_CIDX) + (size_t)tok * 128; signed char* gcq = (signed char*)(a.ws + WS_CQ) + (size_t)tok * 128;
        gid[lane_g] = (unsigned short)en0.x; gid[64 + lane_g] = (unsigned short)en1.x; gcq[lane_g] = (signed char)q0c; gcq[64 + lane_g] = (signed char)q1c;
        if (lane_g == 0) { float* gsc = (float*)(a.ws + WS_CSC) + 2 * (size_t)tok; gsc[0] = scc; gsc[1] = (float)qsum; }
    }
#undef PG_ISSUE
#undef PG_SB
#undef PG_CU
#undef PG_CV
#undef PG_T4
}
#endif
__device__ __forceinline__ void peer_unit_c(const Args& a, unsigned char* lds, int layer, int unit) {
    int tid = threadIdx.x; asm volatile("" : "+v"(tid));
    const int lane = tid & 63, w = __builtin_amdgcn_readfirstlane(tid >> 6), hi_g = lane >> 5, c32 = lane & 31, slot = 2 * c32 + hi_g;
    const int tok0 = unit * 32 + 4 * w;
    const bf16_t* xg = (const bf16_t*)(a.ws + WS_XB);
    const unsigned char* vt = a.ws + WS_VT;
    const unsigned short* gid = (const unsigned short*)(a.ws + WS_CIDX); const signed char* gcq = (const signed char*)(a.ws + WS_CQ); const float* gsc = (const float*)(a.ws + WS_CSC);
    LAS3 unsigned char* lw = (LAS3 unsigned char*)(lds + w * 1024);
#define PC_ISSUE(buf, lb, b) do { const LAS3 unsigned short* il_ = (const LAS3 unsigned short*)(lw + 512 * (lb)); _Pragma("unroll") for (int kk = 0; kk < 8; ++kk) { const unsigned id_ = il_[16 * (b) + 8 * hi_g + kk]; \
        buf[kk] = *(const u32x4*)(vt + (unsigned)(id_ * 512u + 16u * (unsigned)c32)); } } while (0)
#define PC_T4(r0, r1, r2, r3, t0, t1, t2, t3) do { const unsigned a01l_ = __builtin_amdgcn_perm(r1, r0, 0x05010400u), a01h_ = __builtin_amdgcn_perm(r1, r0, 0x07030602u), \
            a23l_ = __builtin_amdgcn_perm(r3, r2, 0x05010400u), a23h_ = __builtin_amdgcn_perm(r3, r2, 0x07030602u); \
        t0 = __builtin_amdgcn_perm(a23l_, a01l_, 0x05040100u); t1 = __builtin_amdgcn_perm(a23l_, a01l_, 0x07060302u); \
        t2 = __builtin_amdgcn_perm(a23h_, a01h_, 0x05040100u); t3 = __builtin_amdgcn_perm(a23h_, a01h_, 0x07060302u); } while (0)
#define PC_CV(buf, lb, b) do { const LAS3 unsigned* cqw_ = (const LAS3 unsigned*)(lw + 512 * (lb) + 256); _Pragma("unroll") for (int g4 = 0; g4 < 2; ++g4) { const int cq_ = (int)cqw_[4 * (b) + 2 * hi_g + g4]; \
            _Pragma("unroll") for (int j = 0; j < 4; ++j) { \
                unsigned t0_, t1_, t2_, t3_; \
                PC_T4(buf[4 * g4][j], buf[4 * g4 + 1][j], buf[4 * g4 + 2][j], buf[4 * g4 + 3][j], t0_, t1_, t2_, t3_);        \
                of[4 * j + 0] = __builtin_amdgcn_sdot4((int)t0_, cq_, of[4 * j + 0], false); of[4 * j + 1] = __builtin_amdgcn_sdot4((int)t1_, cq_, of[4 * j + 1], false); \
                of[4 * j + 2] = __builtin_amdgcn_sdot4((int)t2_, cq_, of[4 * j + 2], false); of[4 * j + 3] = __builtin_amdgcn_sdot4((int)t3_, cq_, of[4 * j + 3], false); \
                ol[4 * j + 0] = __builtin_amdgcn_sdot4((int)(t0_ & 0x0F0F0F0Fu), cq_, ol[4 * j + 0], false); ol[4 * j + 1] = __builtin_amdgcn_sdot4((int)(t1_ & 0x0F0F0F0Fu), cq_, ol[4 * j + 1], false); \
                ol[4 * j + 2] = __builtin_amdgcn_sdot4((int)(t2_ & 0x0F0F0F0Fu), cq_, ol[4 * j + 2], false); ol[4 * j + 3] = __builtin_amdgcn_sdot4((int)(t3_ & 0x0F0F0F0Fu), cq_, ol[4 * j + 3], false); \
                asm volatile("" : "+v"(of[4 * j]), "+v"(of[4 * j + 1]), "+v"(of[4 * j + 2]), "+v"(of[4 * j + 3]), "+v"(ol[4 * j]), "+v"(ol[4 * j + 1]), "+v"(ol[4 * j + 2]), "+v"(ol[4 * j + 3])); } } } while (0)
#define PC_SB __builtin_amdgcn_sched_barrier(0)
    unsigned lid = ((const unsigned*)(gid + (size_t)tok0 * 128))[lane], lcq = lane < 32 ? ((const unsigned*)(gcq + (size_t)tok0 * 128))[lane] : 0u;
    ((LAS3 unsigned*)lw)[lane] = lid; if (lane < 32) ((LAS3 unsigned*)(lw + 256))[lane] = lcq;
    u32x4 bA[8], bB[8];
    PC_ISSUE(bA, 0, 0);
    for (int tt = 0; tt < 4; ++tt) {
        const int tok = tok0 + tt, lb = tt & 1;
        if (tt < 3) { lid = ((const unsigned*)(gid + (size_t)(tok + 1) * 128))[lane]; lcq = lane < 32 ? ((const unsigned*)(gcq + (size_t)(tok + 1) * 128))[lane] : 0u; }
        const float scc = gsc[2 * (size_t)tok], qsf = gsc[2 * (size_t)tok + 1];
        float xv[16]; load_row16_bf(xg + (size_t)tok * D, slot, xv);
        int of[16], ol[16];
#pragma unroll
        for (int i = 0; i < 16; ++i) { of[i] = 0; ol[i] = 0; }
#pragma unroll
        for (int vb = 0; vb < 8; vb += 2) {
            PC_ISSUE(bB, lb, vb + 1); PC_SB; PC_CV(bA, lb, vb); PC_SB;
            if (vb == 2 && tt < 3) { ((LAS3 unsigned*)(lw + 512 * (lb ^ 1)))[lane] = lid; if (lane < 32) ((LAS3 unsigned*)(lw + 512 * (lb ^ 1) + 256))[lane] = lcq; }
            if (vb + 2 < 8) PC_ISSUE(bA, lb, vb + 2); else if (tt < 3) PC_ISSUE(bA, lb ^ 1, 0);
            PC_SB; PC_CV(bB, lb, vb + 1); PC_SB;
        }
#pragma unroll
        for (int i = 0; i < 8; ++i) {
            const int jj = i >> 2, k = i & 3;
            auto rl = __builtin_amdgcn_permlane32_swap((unsigned)ol[4 * jj + k], (unsigned)ol[8 + 4 * jj + k], false, false);
            auto rf = __builtin_amdgcn_permlane32_swap((unsigned)of[4 * jj + k], (unsigned)of[8 + 4 * jj + k], false, false);
            const int sl = (int)rl[0] + (int)rl[1], sf = (int)rf[0] + (int)rf[1];
#ifndef HK_PROBE_NOPEER
            xv[8 * jj + k] += scc * ((float)sl - 8.f * qsf);
            xv[8 * jj + 4 + k] += scc * (float)((sf - sl) >> 4);
#else
            xv[8 * jj + k] += 1e-30f * (float)sl; xv[8 * jj + 4 + k] += 1e-30f * (float)sf;
#endif
        }
        const bool more = layer + 1 < DEPTH;
        int vzt_; asm volatile("v_mov_b32 %0, 0" : "=v"(vzt_) : "v"(xv[0]));
        finish_token(tok, xv, more ? nullptr : a.out, (bf16_t*)(a.ws + WS_XB), (float*)(a.ws + WS_RSTD), more ? (const float*)(a.ws + WS_WF) + (size_t)(layer + 1) * 4096 : nullptr,
                     a.in[2] + (more ? (layer + 1) * 4 : 0), (float*)(a.ws + WS_FLOG), lane, slot + vzt_);
    }
#undef PC_ISSUE
#undef PC_T4
#undef PC_CV
#undef PC_SB
}
__device__ __forceinline__ void peer_phase_c(const Args& a, unsigned char* lds, int layer) {
    int tid = threadIdx.x; asm volatile("" : "+v"(tid));
    const int lane = tid & 63, w = __builtin_amdgcn_readfirstlane(tid >> 6), c8 = lane & 7, r8 = lane >> 3;
    const int nun = (T / 32 - (int)blockIdx.x + (int)gridDim.x - 1) / (int)gridDim.x, N = 4 * nun;
    bf16_t* xg = (bf16_t*)(a.ws + WS_XB);
    const unsigned char* vt = a.ws + WS_VT;
    const unsigned short* gid = (const unsigned short*)(a.ws + WS_CIDX); const signed char* gcq = (const signed char*)(a.ws + WS_CQ); const float* gsc = (const float*)(a.ws + WS_CSC);
    LAS3 unsigned char* lw = (LAS3 unsigned char*)(lds + w * 1024);
    const bool more = layer + 1 < DEPTH;
    const float* wf = (const float*)(a.ws + WS_WF) + (size_t)(more ? layer + 1 : 0) * 4096; const float* bfor = a.in[2] + (more ? (layer + 1) * 4 : 0);
#define PS_TOK(n) (((int)blockIdx.x + ((n) >> 2) * (int)gridDim.x) * 32 + 4 * w + ((n) & 3))
#define PS_ISSUE(buf, lb, b) do { const LAS3 unsigned char* il_ = lw + 512 * (lb) + 2 * (64 * (b) + 4 * r8); _Pragma("unroll") for (int g4 = 0; g4 < 2; ++g4) { const u32x2 i4_ = *(const LAS3 u32x2*)(il_ + 64 * g4); \
        _Pragma("unroll") for (int k4 = 0; k4 < 4; ++k4) { const unsigned id_ = (k4 & 1 ? i4_[k4 >> 1] >> 16 : i4_[k4 >> 1] & 0xffffu); buf[4 * g4 + k4] = *(const u32x4*)(vt + (unsigned)(id_ * 512u + soff)); } } } while (0)
#define PS_T4(r0, r1, r2, r3, t0, t1, t2, t3) do { const unsigned a01l_ = __builtin_amdgcn_perm(r1, r0, 0x05010400u), a01h_ = __builtin_amdgcn_perm(r1, r0, 0x07030602u), \
            a23l_ = __builtin_amdgcn_perm(r3, r2, 0x05010400u), a23h_ = __builtin_amdgcn_perm(r3, r2, 0x07030602u); \
        t0 = __builtin_amdgcn_perm(a23l_, a01l_, 0x05040100u); t1 = __builtin_amdgcn_perm(a23l_, a01l_, 0x07060302u); \
        t2 = __builtin_amdgcn_perm(a23h_, a01h_, 0x05040100u); t3 = __builtin_amdgcn_perm(a23h_, a01h_, 0x07060302u); } while (0)
#define PS_CV(buf, lb, b) do { const LAS3 unsigned* cqw_ = (const LAS3 unsigned*)(lw + 512 * (lb) + 256); _Pragma("unroll") for (int g4 = 0; g4 < 2; ++g4) { const int cq_ = (int)cqw_[16 * (b) + 8 * g4 + r8]; const bool first_ = (b) == 0 && g4 == 0;       \
            _Pragma("unroll") for (int j = 0; j < 4; ++j) { \
                unsigned t0_, t1_, t2_, t3_; \
                PS_T4(buf[4 * g4][j], buf[4 * g4 + 1][j], buf[4 * g4 + 2][j], buf[4 * g4 + 3][j], t0_, t1_, t2_, t3_);        \
                of[4 * j + 0] = (first_ ? __builtin_amdgcn_sdot4((int)t0_, cq_, 0, true) : __builtin_amdgcn_sdot4((int)t0_, cq_, of[4 * j + 0], false)); of[4 * j + 1] = (first_ ? __builtin_amdgcn_sdot4((int)t1_, cq_, 0, true) : __builtin_amdgcn_sdot4((int)t1_, cq_, of[4 * j + 1], false)); \
                of[4 * j + 2] = (first_ ? __builtin_amdgcn_sdot4((int)t2_, cq_, 0, true) : __builtin_amdgcn_sdot4((int)t2_, cq_, of[4 * j + 2], false)); of[4 * j + 3] = (first_ ? __builtin_amdgcn_sdot4((int)t3_, cq_, 0, true) : __builtin_amdgcn_sdot4((int)t3_, cq_, of[4 * j + 3], false)); \
                ol[4 * j + 0] = (first_ ? __builtin_amdgcn_sdot4((int)(t0_ & 0x0F0F0F0Fu), cq_, 0, true) : __builtin_amdgcn_sdot4((int)(t0_ & 0x0F0F0F0Fu), cq_, ol[4 * j + 0], false)); ol[4 * j + 1] = (first_ ? __builtin_amdgcn_sdot4((int)(t1_ & 0x0F0F0F0Fu), cq_, 0, true) : __builtin_amdgcn_sdot4((int)(t1_ & 0x0F0F0F0Fu), cq_, ol[4 * j + 1], false)); \
                ol[4 * j + 2] = (first_ ? __builtin_amdgcn_sdot4((int)(t2_ & 0x0F0F0F0Fu), cq_, 0, true) : __builtin_amdgcn_sdot4((int)(t2_ & 0x0F0F0F0Fu), cq_, ol[4 * j + 2], false)); ol[4 * j + 3] = (first_ ? __builtin_amdgcn_sdot4((int)(t3_ & 0x0F0F0F0Fu), cq_, 0, true) : __builtin_amdgcn_sdot4((int)(t3_ & 0x0F0F0F0Fu), cq_, ol[4 * j + 3], false)); \
                asm volatile("" : "+v"(of[4 * j]), "+v"(of[4 * j + 1]), "+v"(of[4 * j + 2]), "+v"(of[4 * j + 3]), "+v"(ol[4 * j]), "+v"(ol[4 * j + 1]), "+v"(ol[4 * j + 2]), "+v"(ol[4 * j + 3])); } } } while (0)
#define PS_SB __builtin_amdgcn_sched_barrier(0)
#pragma unroll 1
    for (int s = 0; s < 4; ++s) {
        const int e0 = 256 * s + 32 * c8 + 4 * r8;
        const unsigned soff = 128u * (unsigned)s + 16u * (unsigned)c8;
        {
#pragma unroll
            for (int q = 0; q < 2; ++q) { const int tq = PS_TOK(q);
                const unsigned lidq = ((const unsigned*)(gid + (size_t)tq * 128))[lane], lcqq = lane < 32 ? ((const unsigned*)(gcq + (size_t)tq * 128))[lane] : 0u;
                ((LAS3 unsigned*)(lw + 512 * q))[lane] = lidq; if (lane < 32) ((LAS3 unsigned*)(lw + 512 * q + 256))[lane] = lcqq; }
        }
        u32x4 bA[8], bB[8], bC[8], bD[8];
        PS_ISSUE(bA, 0, 0); PS_ISSUE(bB, 0, 1);
#define PS_BODY(n_, X0, X1, Y0, Y1) do { const int n = (n_), tok = PS_TOK(n), lb = n & 1; \
            const bool nx2 = n + 2 < N; unsigned lid = 0u, lcq = 0u; \
            if (nx2) { const int tn = PS_TOK(n + 2); lid = ((const unsigned*)(gid + (size_t)tn * 128))[lane]; lcq = lane < 32 ? ((const unsigned*)(gcq + (size_t)tn * 128))[lane] : 0u; } \
            if (n + 1 < N) { PS_ISSUE(Y0, lb ^ 1, 0); PS_ISSUE(Y1, lb ^ 1, 1); } \
            const float scc = gsc[2 * (size_t)tok], qsf = gsc[2 * (size_t)tok + 1]; \
            const u32x2 xr = *(const u32x2*)(xg + (size_t)tok * D + e0); \
            int of[16], ol[16];         \
            PS_SB; PS_CV(X0, lb, 0); PS_SB; PS_CV(X1, lb, 1); PS_SB; \
            if (nx2) { ((LAS3 unsigned*)(lw + 512 * lb))[lane] = lid; if (lane < 32) ((LAS3 unsigned*)(lw + 512 * lb + 256))[lane] = lcq; }        \
              \
            int y[16], z[8]; \
            _Pragma("unroll") for (int i = 0; i < 8; ++i) { \
                auto rf = __builtin_amdgcn_permlane32_swap((unsigned)of[i], (unsigned)of[8 + i], false, false); y[i] = (int)rf[0] + (int)rf[1]; \
                auto rl = __builtin_amdgcn_permlane32_swap((unsigned)ol[i], (unsigned)ol[8 + i], false, false); y[8 + i] = (int)rl[0] + (int)rl[1]; } \
            _Pragma("unroll") for (int i = 0; i < 4; ++i) { \
                auto rf = __builtin_amdgcn_permlane16_swap((unsigned)y[i], (unsigned)y[4 + i], false, false); z[i] = (int)rf[0] + (int)rf[1]; \
                auto rl = __builtin_amdgcn_permlane16_swap((unsigned)y[8 + i], (unsigned)y[12 + i], false, false); z[4 + i] = (int)rl[0] + (int)rl[1]; } \
            _Pragma("unroll") for (int i = 0; i < 8; ++i) z[i] += __builtin_amdgcn_update_dpp(0, z[i], 0x128, 0xf, 0xf, true);         \
            float xn[4]; \
            _Pragma("unroll") for (int k = 0; k < 4; ++k) { \
                const float vl = (float)z[4 + k] - 8.f * qsf, vh = (float)((z[k] - z[4 + k]) >> 4); \
                const unsigned xw = xr[k >> 1]; \
                xn[k] = (k & 1 ? __uint_as_float(xw & 0xffff0000u) : __uint_as_float(xw << 16)) + scc * ((r8 & 1) ? vh : vl); } \
            if (more) { u32x2 o; o.x = pk2(xn[0], xn[1]); o.y = pk2(xn[2], xn[3]); *(u32x2*)(xg + (size_t)tok * D + e0) = o; } \
            else *(f32x4*)(a.out + (size_t)tok * D + e0) = (f32x4){xn[0], xn[1], xn[2], xn[3]}; } while (0)
#pragma unroll 1
        for (int n2 = 0; n2 < N; n2 += 2) {
            PS_BODY(n2, bA, bB, bC, bD);
            PS_BODY(n2 + 1, bC, bD, bA, bB);
        }
#undef PS_BODY
    }
    if (more) {
        __builtin_amdgcn_fence(__ATOMIC_ACQ_REL, "workgroup");
        f32x4 wg[4][4];
#pragma unroll
        for (int h = 0; h < 4; ++h)
#pragma unroll
            for (int j = 0; j < 4; ++j) wg[h][j] = *(const f32x4*)(wf + h * 1024 + 16 * lane + 4 * j);
        const int myh = ((lane >> 4) & 1) * 2 + (lane >> 5);
        const float mybf = bfor[myh];
#pragma unroll 1
        for (int n = 0; n < N; ++n) {
            const int tok = PS_TOK(n);
            float xv[16]; load_row16_bf(xg + (size_t)tok * D, lane, xv);
            float ss = 0.f, g[4] = {0.f, 0.f, 0.f, 0.f};
#pragma unroll
            for (int i = 0; i < 16; ++i) { ss += xv[i] * xv[i];
#pragma unroll
                for (int h = 0; h < 4; ++h) g[h] += xv[i] * wg[h][i >> 2][i & 3]; }
            auto r01 = __builtin_amdgcn_permlane32_swap(__float_as_uint(g[0]), __float_as_uint(g[1]), false, false); const float q01 = __uint_as_float(r01[0]) + __uint_as_float(r01[1]);
            auto r23 = __builtin_amdgcn_permlane32_swap(__float_as_uint(g[2]), __float_as_uint(g[3]), false, false); const float q23 = __uint_as_float(r23[0]) + __uint_as_float(r23[1]);
            auto rq = __builtin_amdgcn_permlane16_swap(__float_as_uint(q01), __float_as_uint(q23), false, false); float q = __uint_as_float(rq[0]) + __uint_as_float(rq[1]);
            q += __uint_as_float(__builtin_amdgcn_update_dpp(0, __float_as_uint(q), 0x128, 0xf, 0xf, true)); q += __uint_as_float(__builtin_amdgcn_update_dpp(0, __float_as_uint(q), 0x124, 0xf, 0xf, true));
            q += __uint_as_float(__builtin_amdgcn_update_dpp(0, __float_as_uint(q), 0x122, 0xf, 0xf, true)); q += __uint_as_float(__builtin_amdgcn_update_dpp(0, __float_as_uint(q), 0x121, 0xf, 0xf, true));
            ss += __uint_as_float(__builtin_amdgcn_update_dpp(0, __float_as_uint(ss), 0x128, 0xf, 0xf, true)); ss += __uint_as_float(__builtin_amdgcn_update_dpp(0, __float_as_uint(ss), 0x124, 0xf, 0xf, true));
            ss += __uint_as_float(__builtin_amdgcn_update_dpp(0, __float_as_uint(ss), 0x122, 0xf, 0xf, true)); ss += __uint_as_float(__builtin_amdgcn_update_dpp(0, __float_as_uint(ss), 0x121, 0xf, 0xf, true));
            ss = half_swap_sum(ss);
            { auto r = __builtin_amdgcn_permlane16_swap(__float_as_uint(ss), __float_as_uint(ss), false, false); ss = __uint_as_float(r[0]) + __uint_as_float(r[1]); }
            const float rs = __builtin_amdgcn_rsqf(ss * (1.f / 1024.f) + EPS);
            if (lane == 0) ((float*)(a.ws + WS_RSTD))[tok] = rs;
            if ((lane & 15) == 0) { const int b = tok / S, sq = tok % S; ((float*)(a.ws + WS_FLOG))[((size_t)b * 4 + myh) * S + sq] = log_sigmoid(q * rs + mybf); }
        }
    }
#undef PS_TOK
#undef PS_ISSUE
#undef PS_T4
#undef PS_CV
#undef PS_SB
}
}
namespace hk {
#ifndef HK_ALIGN1
#define HK_ALIGN1 true
#endif
#ifndef HK_ALIGN2
#define HK_ALIGN2 true
#endif
#ifndef HK_ALIGN3
#define HK_ALIGN3 true
#endif
constexpr int NPL = 6 + HK_PEER_SPLIT;
constexpr int NPHASE = 2 + NPL * DEPTH;
__device__ __forceinline__ unsigned q_next(unsigned* ctr, unsigned char* lds) {
    volatile LAS3 unsigned* slot = (volatile LAS3 unsigned*)(LAS3 unsigned char*)(lds + LDS_CTL + 32);
    __syncthreads();
    if (threadIdx.x == 0) *slot = __hip_atomic_fetch_add(ctr, 1u, __ATOMIC_RELAXED, __HIP_MEMORY_SCOPE_AGENT);
    __syncthreads();
    return *slot;
}
__device__ __forceinline__ unsigned q_publish(unsigned nxt, unsigned char* lds) {
    volatile LAS3 unsigned* slot = (volatile LAS3 unsigned*)(LAS3 unsigned char*)(lds + LDS_CTL + 32);
    __syncthreads();
    if (threadIdx.x == 0) *slot = nxt;
    __syncthreads();
    return *slot;
}
#define SEAM(k) do { if (a.use_bar && (k) >= a.ph_lo && (k) + 1 < a.ph_hi) { xcd_barrier(bar); } } while (0)
#define ON(k) ((k) >= a.ph_lo && (k) < a.ph_hi)
#ifdef HK_PROBE_PHASE
#define PROBE_T0(k) unsigned long long pt0_ = 0; if ((k) == HK_PROBE_PHASE && blockIdx.x == 0 && threadIdx.x == 0) pt0_ = __builtin_amdgcn_s_memrealtime();
#define PROBE_T1(k) if ((k) == HK_PROBE_PHASE && blockIdx.x == 0 && threadIdx.x == 0) { volatile LAS3 unsigned* pw_ = (volatile LAS3 unsigned*)(LAS3 unsigned char*)(lds + LDS_CTL + 48); *pw_ = *pw_ + (unsigned)(__builtin_amdgcn_s_memrealtime() - pt0_); }
#else
#define PROBE_T0(k)
#define PROBE_T1(k)
#endif
template <int l>
__device__ __forceinline__ void layer_phases(const Args& a, unsigned char* lds, const XcdBarrier& bar, unsigned* ctl) {
        const int pb = 2 + NPL * l;
        { PROBE_T0(0)
        if (ON(pb)) {
            if (blockIdx.x < NB * 4) cum_scan(a, lds, blockIdx.x);
            pg8::Gemm g; g.A = (const bf16_t*)(a.ws + WS_XB); g.Bt = (const bf16_t*)(a.ws + WS_WIN) + (size_t)l * 2560 * 1024; g.M = T; g.N = 2560; g.K = 1024;
            pg8::StaticOrder so; so.init(T, 2560, gridDim.x, blockIdx.x);
            pg8::EpiIn E; E.zb = (bf16_t*)(a.ws + WS_ZB); E.su32 = (float*)(a.ws + WS_SU); E.rstd = (const float*)(a.ws + WS_RSTD);
            E.g_fq = a.in[6] + l * 64; E.g_fk = a.in[7] + l * 64; E.g_dq = a.in[8] + l * 64; E.g_dk = a.in[9] + l * 64; E.g_cq = a.in[10] + l * 32; E.g_ck = a.in[11] + l * 32;
#ifndef HK_NO_G1
            pg8::gemm_phase<pg8::EpiIn, pg8::StaticOrder, HK_ALIGN1, true>((PG8_LAS unsigned char*)lds, g, so, E);
#endif
        }
        SEAM(pb);
        PROBE_T1(0) }
        { PROBE_T0(1)
        if (ON(pb + 1)) {
            unsigned* ctr = ctl + CTL_Q + 64 * (l + 4 * a.pad0);
            unsigned u = q_next(ctr, lds);
            while (u < 5632u) {
                unsigned nxt_ = 0u; if (threadIdx.x == 0) nxt_ = __hip_atomic_fetch_add(ctr, 1u, __ATOMIC_RELAXED, __HIP_MEMORY_SCOPE_AGENT);
                if (u < 1024u) {
#ifndef HK_NO_DIFF
 diff_unit(a, lds, l, u & 31, 31 - (u >> 5));
#endif
 }
                else if (u < 1536u) {
#ifndef HK_NO_FOX
 fox64_unit(a, lds, l, (u - 1024u) & 31, 15 - ((u - 1024u) >> 5));
#endif
 }
                else if (u < 4608u) { const unsigned j = u - 1536u, br = j >> 10, jj = j & 1023u, bh = jj & 31u, sub = jj >> 5;
                    const int rho = br == 0 ? 0 : (br == 1 ? (sub & 3) : (sub & 15)), tile = br == 0 ? sub : (br == 1 ? (sub >> 2) : (sub >> 4));

#ifndef HK_NO_DIL
                    dil_unit(a, lds, bh, br, rho, tile);
#endif
 }
                else { const unsigned j = u - 4608u;
#ifndef HK_NO_S51
 s5_pass1_unit(a, lds, l, j >> 7, j & 127u);
#endif
 }
                u = q_publish(nxt_, lds);
            }
        }
        SEAM(pb + 1);
        PROBE_T1(1) }
        { PROBE_T0(2)
        if (ON(pb + 2)) {
#ifndef HK_NO_S52
            { PROBE_T0(12)
            for (int u = blockIdx.x; u < 256; u += gridDim.x) s5_pass2_unit(a, lds, l, u >> 5, u & 31);
            PROBE_T1(12) }
#endif
            { PROBE_T0(13)
            phase_p3_elementwise(a, l);
            PROBE_T1(13) }
        }
        SEAM(pb + 2);
        PROBE_T1(2) }
        { PROBE_T0(3)
        if (ON(pb + 3)) {
            pg8::Gemm g; g.A = (const bf16_t*)(a.ws + WS_MIX); g.Bt = (const bf16_t*)(a.ws + WS_WOUT) + (size_t)l * 1024 * 1024; g.M = T; g.N = 1024; g.K = 1024;
            pg8::StaticOrder so; so.init(T, 1024, gridDim.x, blockIdx.x);
            pg8::EpiOut E; E.xb = (bf16_t*)(a.ws + WS_XB);
#ifndef HK_NO_G2
            pg8::gemm_phase<pg8::EpiOut, pg8::StaticOrder, HK_ALIGN2, true>((PG8_LAS unsigned char*)lds, g, so, E);
#endif
        }
        SEAM(pb + 3);
        PROBE_T1(3) }
        { PROBE_T0(4)
        if (ON(pb + 4)) {
            pg8::Gemm g; g.A = (const bf16_t*)(a.ws + WS_XB); g.Bt = (const bf16_t*)(a.ws + WS_WQ) + (size_t)l * 2048 * 1024; g.M = T; g.N = 2048; g.K = 1024;
            pg8::StaticOrder so; so.init(T, 2048, gridDim.x, blockIdx.x);
#if HK_FOLD_KEYS
            pg8::EpiF16 E; E.O = (bf16_t*)(a.ws + WS_ZB); E.ldc = 2048;
#ifndef HK_NO_G3
            pg8::gemm_phase<pg8::EpiF16, pg8::StaticOrder, HK_ALIGN3, true>((PG8_LAS unsigned char*)lds, g, so, E);
#endif
#else
            pg8::EpiPlain E; E.O = (bf16_t*)(a.ws + WS_ZB); E.ldc = 2048;
#ifndef HK_NO_G3
            pg8::gemm_phase<pg8::EpiPlain, pg8::StaticOrder, HK_ALIGN3, true>((PG8_LAS unsigned char*)lds, g, so, E);
#endif
#endif
        }
        SEAM(pb + 4);
        PROBE_T1(4) }
        { PROBE_T0(5)
        if (ON(pb + 5)) {
#ifndef HK_NO_PEER
#if HK_PEER_SPLIT
            for (int u = blockIdx.x; u < T / 32; u += gridDim.x) peer_unit_a(a, lds, l, u);
#else
            for (int u = blockIdx.x; u < T / 32; u += gridDim.x) peer_unit(a, lds, l, u);
#endif
#endif
        }
#if HK_PEER_SPLIT && !defined(HK_AC_BAR)
        __builtin_amdgcn_fence(__ATOMIC_RELEASE, "workgroup"); __syncthreads(); __builtin_amdgcn_fence(__ATOMIC_ACQUIRE, "workgroup");
#else
        SEAM(pb + 5);
#endif
        PROBE_T1(5) }
#if HK_PEER_SPLIT
        { PROBE_T0(6)
        if (ON(pb + 6)) {
#ifndef HK_NO_PEER
#ifdef HK_C_UNSLICED
            for (int u = blockIdx.x; u < T / 32; u += gridDim.x) peer_unit_c(a, lds, l, u);
#else
            peer_phase_c(a, lds, l);
#endif
#endif
        }
        SEAM(pb + 6);
        PROBE_T1(6) }
#endif
    }
__global__ void __launch_bounds__(NTHR, 2) hk_mega(Args a) {
    extern __shared__ __attribute__((aligned(16))) unsigned char lds[];
    const int tid = threadIdx.x;
    if (tid < 64) ((LAS3 unsigned*)(lds + LDS_CTL))[tid] = 0u;
    __syncthreads();
    unsigned* ctl = (unsigned*)(a.ws + WS_CTL);
    XcdBarrier bar = xcd_barrier_post(ctl + CTL_BAR, (volatile LAS unsigned*)(LAS3 unsigned char*)(lds + LDS_CTL));
    if (ON(0)) phase_weights(a, lds);
    SEAM(0);
    if (ON(1)) phase_xprep(a);
    SEAM(1);
    layer_phases<0>(a, lds, bar, ctl);
    layer_phases<1>(a, lds, bar, ctl);
    layer_phases<2>(a, lds, bar, ctl);
    layer_phases<3>(a, lds, bar, ctl);
#ifdef HK_PROBE_PHASE
    if (blockIdx.x == 0 && threadIdx.x == 0) { const unsigned span = *(volatile LAS3 unsigned*)(LAS3 unsigned char*)(lds + LDS_CTL + 48); const unsigned long long t0 = __builtin_amdgcn_s_memrealtime();
        while (__builtin_amdgcn_s_memrealtime() - t0 < 4ull * span) __builtin_amdgcn_s_sleep(32); }
#endif
}
#undef SEAM
#undef ON
}
namespace nv {
using namespace hk;
__global__ void __launch_bounds__(64) n_fox(const bf16_t* __restrict__ zb, const float* __restrict__ cum2, bf16_t* __restrict__ mix) {
    int gid = blockIdx.x * 64 + threadIdx.x;
    int t = S - 1 - (gid % S); int bh = gid / S; int b = bh / 4, h = bh % 4;
    const bf16_t* z = zb + (size_t)b * S * ZP; const float* cm = cum2 + (size_t)bh * S;
    float q[64], o[64];
#pragma unroll
    for (int i = 0; i < 64; ++i) { q[i] = bf2f(z[(size_t)t * ZP + ZC_FQ + h * 64 + i]); o[i] = 0.f; }
    float m = -INFINITY, l = 0.f, cq = cm[t];
    int tmax = __shfl(t, 0);
    for (int s = 0; s <= tmax; ++s) {
        const bf16_t* kp = z + (size_t)s * ZP + ZC_FK + h * 64; const bf16_t* vp = z + (size_t)s * ZP + ZC_FV + h * 64;
        float d = 0.f;
#pragma unroll
        for (int i = 0; i < 64; ++i) d += q[i] * bf2f(kp[i]);
        d += cq - cm[s];
        if (s <= t) {
            float mn = fmaxf(m, d), al = exp2f(m - mn), p = exp2f(d - mn);
            l = l * al + p;
#pragma unroll
            for (int i = 0; i < 64; ++i) o[i] = o[i] * al + p * bf2f(vp[i]);
            m = mn;
        }
    }
    float inv = 1.f / l;
    bf16_t* op = mix + ((size_t)b * S + t) * D + h * 64;
#pragma unroll
    for (int i = 0; i < 64; ++i) op[i] = f2bf(o[i] * inv);
}
__global__ void __launch_bounds__(64) n_dil(const bf16_t* __restrict__ zb, const float* __restrict__ tb, bf16_t* __restrict__ mix) {
    int gid = blockIdx.x * 64 + threadIdx.x;
    int t = gid % S; int bh = gid / S; int b = bh / 4, h = bh % 4;
    const bf16_t* z = zb + (size_t)b * S * ZP;
    float q[64], o[64];
#pragma unroll
    for (int i = 0; i < 64; ++i) { q[i] = bf2f(z[(size_t)t * ZP + ZC_DQ + h * 64 + i]); o[i] = 0.f; }
    float m = -INFINITY, l = 0.f;
    for (int br = 0; br < 3; ++br) {
        int r = br == 0 ? 1 : (br == 1 ? 4 : 16);
        for (int j = 0; j <= 128; ++j) {
            bool ok = (t / r - j) >= 0; int sc = ok ? t - j * r : t;
            const bf16_t* kp = z + (size_t)sc * ZP + ZC_DK + h * 64; const bf16_t* vp = z + (size_t)sc * ZP + ZC_DV + h * 64;
            float d = 0.f;
#pragma unroll
            for (int i = 0; i < 64; ++i) d += q[i] * bf2f(kp[i]);
            d += tb[h * TBN + r * j];
            if (ok) {
                float mn = fmaxf(m, d), al = exp2f(m - mn), p = exp2f(d - mn);
                l = l * al + p;
#pragma unroll
                for (int i = 0; i < 64; ++i) o[i] = o[i] * al + p * bf2f(vp[i]);
                m = mn;
            }
        }
    }
    float inv = 1.f / l;
    bf16_t* op = mix + ((size_t)b * S + t) * D + 256 + h * 64;
#pragma unroll
    for (int i = 0; i < 64; ++i) op[i] = f2bf(o[i] * inv);
}
template <int CMP>
__global__ void __launch_bounds__(64) n_diff(const bf16_t* __restrict__ zb, const float* __restrict__ tb, float* __restrict__ tmp) {
    int gid = blockIdx.x * 64 + threadIdx.x;
    int t = S - 1 - (gid % S); int bh = gid / S; int b = bh / 4, h = bh % 4;
    const bf16_t* z = zb + (size_t)b * S * ZP;
    float q[32], o[64];
#pragma unroll
    for (int i = 0; i < 32; ++i) q[i] = bf2f(z[(size_t)t * ZP + ZC_CQ + h * 64 + CMP * 32 + i]);
#pragma unroll
    for (int i = 0; i < 64; ++i) o[i] = 0.f;
    float m = -INFINITY, l = 0.f;
    int tmax = __shfl(t, 0);
    for (int s = 0; s <= tmax; ++s) {
        const bf16_t* kp = z + (size_t)s * ZP + ZC_CK + h * 64 + CMP * 32; const bf16_t* vp = z + (size_t)s * ZP + ZC_CV + h * 64;
        float d = 0.f;
#pragma unroll
        for (int i = 0; i < 32; ++i) d += q[i] * bf2f(kp[i]);
        int rel = t - s; int ri = rel < 0 ? 0 : (rel > 2000 ? 2000 : rel);
        d += tb[(4 + h) * TBN + ri];
        if (rel >= 0) {
            float mn = fmaxf(m, d), al = exp2f(m - mn), p = exp2f(d - mn);
            l = l * al + p;
#pragma unroll
            for (int i = 0; i < 64; ++i) o[i] = o[i] * al + p * bf2f(vp[i]);
            m = mn;
        }
    }
    float inv = 1.f / l;
    float* op = tmp + ((size_t)b * S + t) * 256 + h * 64;
#pragma unroll
    for (int i = 0; i < 64; ++i) op[i] = o[i] * inv;
}
__global__ void n_diff_fin(const float* __restrict__ tmp0, const float* __restrict__ tmp1, const float* __restrict__ lamp, const float* __restrict__ gain, float lam_init, bf16_t* __restrict__ mix) {
    size_t gid = (size_t)blockIdx.x * blockDim.x + threadIdx.x;
    if (gid >= (size_t)T * 4) return;
    size_t tok = gid / 4; int h = (int)(gid % 4);
    float s1 = 0.f, s2 = 0.f;
    for (int i = 0; i < 32; ++i) { s1 += lamp[i] * lamp[32 + i]; s2 += lamp[64 + i] * lamp[96 + i]; }
    float lam = expf(s1) - expf(s2) + lam_init;
    const float* p0 = tmp0 + tok * 256 + h * 64; const float* p1 = tmp1 + tok * 256 + h * 64;
    float ss = 0.f;
    for (int i = 0; i < 64; ++i) { float v = p0[i] - lam * p1[i]; ss += v * v; }
    float r = rsqrtf(ss / 64 + EPS) * (1.f - lam_init);
    bf16_t* op = mix + tok * D + 512 + h * 64;
    for (int i = 0; i < 64; ++i) op[i] = f2bf((p0[i] - lam * p1[i]) * r * gain[i]);
}
__global__ void __launch_bounds__(64) n_s5(const bf16_t* __restrict__ su, const float* a_re, const float* a_im, const float* log_dt, const float* b_re, const float* b_im,
                                           const float* c_re, const float* c_im, const float* dsk, float* __restrict__ gbuf) {
    int b = blockIdx.x / 16, g = blockIdx.x % 16, n = threadIdx.x;
    float dt = expf(log_dt[g]);
    float ar = a_re[g * 64 + n], ai = a_im[g * 64 + n];
    float mag = expf(dt * ar);
    float abr = mag * cosf(dt * ai), abi = mag * sinf(dt * ai);
    float den = ar * ar + ai * ai, nr = abr - 1.f, ni = abi;
    float cr = (nr * ar + ni * ai) / den, ci = (ni * ar - nr * ai) / den;
    float bbr[16], bbi[16], ccr[16], cci[16];
#pragma unroll
    for (int c = 0; c < 16; ++c) {
        float br = b_re[(g * 64 + n) * 16 + c], bi = b_im[(g * 64 + n) * 16 + c];
        bbr[c] = cr * br - ci * bi; bbi[c] = cr * bi + ci * br;
        ccr[c] = c_re[(g * 16 + c) * 64 + n]; cci[c] = c_im[(g * 16 + c) * 64 + n];
    }
    float dk = (n < 16) ? dsk[g * 16 + n] : 0.f;
    float xr = 0.f, xi = 0.f;
    for (int s = 0; s < S; ++s) {
        const bf16_t* up = su + ((size_t)b * S + s) * 256 + g * 16;
        float u[16];
#pragma unroll
        for (int c = 0; c < 16; ++c) u[c] = bf2f(up[c]);
        float pr = 0.f, pi = 0.f;
#pragma unroll
        for (int c = 0; c < 16; ++c) { pr += bbr[c] * u[c]; pi += bbi[c] * u[c]; }
        float nxr = abr * xr - abi * xi + pr, nxi = abr * xi + abi * xr + pi;
        xr = nxr; xi = nxi;
        float myy = 0.f;
#pragma unroll
        for (int c = 0; c < 16; ++c) { float v = wave_sum(ccr[c] * xr - cci[c] * xi); if (n == c) myy = v + dk * u[c]; }
        if (n < 16) gbuf[((size_t)b * S + s) * 256 + g * 16 + n] = gelu_tanh(myy);
    }
}
__global__ void __launch_bounds__(256) n_glu(const float* __restrict__ gbuf, const float* __restrict__ w, const float* __restrict__ bias, bf16_t* __restrict__ mix) {
    __shared__ float gs[256];
    size_t tok = blockIdx.x; int j = threadIdx.x;
    gs[j] = gbuf[tok * 256 + j];
    __syncthreads();
    float acc = bias[j];
    for (int k = 0; k < 256; ++k) acc += gs[k] * w[k * 256 + j];
    mix[tok * D + 768 + j] = f2bf(gs[j] * (1.f / (1.f + expf(-acc))));
}
template <int MODE>
__global__ void __launch_bounds__(256) n_gemm(const bf16_t* __restrict__ A, const float* __restrict__ g, const float* __restrict__ B, float* __restrict__ X, bf16_t* __restrict__ O, int M, int N, int K) {
    __shared__ float As[16][68];
    __shared__ float Bs[16][68];
    const int tx = threadIdx.x & 15, ty = threadIdx.x >> 4;
    const int m0 = blockIdx.y * 64, n0 = blockIdx.x * 64;
    float acc[4][4];
#pragma unroll
    for (int i = 0; i < 4; ++i)
#pragma unroll
        for (int j = 0; j < 4; ++j) acc[i][j] = 0.f;
    for (int k0 = 0; k0 < K; k0 += 16) {
        { int r = threadIdx.x >> 2, c4 = (threadIdx.x & 3) * 4;
          const bf16_t* ap = A + (size_t)(m0 + r) * K + k0 + c4;
#pragma unroll
          for (int j = 0; j < 4; ++j) { float v = bf2f(ap[j]); if (g) v *= g[k0 + c4 + j]; As[c4 + j][r] = v; }
          int br = threadIdx.x >> 4, bc = (threadIdx.x & 15) * 4;
#pragma unroll
          for (int j = 0; j < 4; ++j) Bs[br][bc + j] = B[(size_t)(k0 + br) * N + n0 + bc + j]; }
        __syncthreads();
#pragma unroll
        for (int kk = 0; kk < 16; ++kk) {
            float av[4], bv[4];
#pragma unroll
            for (int i = 0; i < 4; ++i) av[i] = As[kk][ty * 4 + i];
#pragma unroll
            for (int j = 0; j < 4; ++j) bv[j] = Bs[kk][tx * 4 + j];
#pragma unroll
            for (int i = 0; i < 4; ++i)
#pragma unroll
                for (int j = 0; j < 4; ++j) acc[i][j] += av[i] * bv[j];
        }
        __syncthreads();
    }
#pragma unroll
    for (int i = 0; i < 4; ++i)
#pragma unroll
        for (int j = 0; j < 4; ++j) {
            size_t off = (size_t)(m0 + ty * 4 + i) * N + n0 + tx * 4 + j;
            if (MODE == 0) { float v = X[off] + acc[i][j]; X[off] = v; O[off] = f2bf(v); } else O[off] = f2bf(acc[i][j]);
        }
}
__global__ void n_rstd(const float* __restrict__ x, float* __restrict__ rstd) {
    int row = blockIdx.x * 4 + (threadIdx.x >> 6), lane = threadIdx.x & 63;
    const float* p = x + (size_t)row * D;
    float s = 0.f;
    for (int i = lane; i < D; i += 64) { float v = p[i]; s += v * v; }
    s = wave_sum(s);
    if (lane == 0) rstd[row] = rsqrtf(s / D + EPS);
}
__global__ void __launch_bounds__(256) n_top1(const bf16_t* __restrict__ q, const float* __restrict__ keys, float* __restrict__ tv, int* __restrict__ ti) {
    extern __shared__ float ks[];
    int hp = blockIdx.y; size_t tok = (size_t)blockIdx.x * 256 + threadIdx.x;
    const float* kg = keys + (size_t)hp * 128 * 128;
    for (int i = threadIdx.x; i < 128 * 128; i += 256) ks[i] = kg[i];
    __syncthreads();
    float qv[128];
    const bf16_t* qp = q + tok * 2048 + hp * 128;
#pragma unroll
    for (int i = 0; i < 128; ++i) qv[i] = bf2f(qp[i]);
    float bv[16]; int bi[16];
#pragma unroll
    for (int j = 0; j < 16; ++j) { bv[j] = -INFINITY; bi[j] = 0; }
    for (int k = 0; k < 128; ++k) {
        float d = 0.f;
#pragma unroll
        for (int i = 0; i < 128; ++i) d += qv[i] * ks[k * 128 + i];
        float cv = d; int ci = k;
#pragma unroll
        for (int j = 0; j < 16; ++j) { if (cv > bv[j]) { float tvv = bv[j]; int tii = bi[j]; bv[j] = cv; bi[j] = ci; cv = tvv; ci = tii; } }
    }
    float* ov = tv + (tok * 16 + hp) * 16; int* oi = ti + (tok * 16 + hp) * 16;
#pragma unroll
    for (int j = 0; j < 16; ++j) { ov[j] = bv[j]; oi[j] = bi[j]; }
}
__global__ void __launch_bounds__(256) n_top2(const float* __restrict__ tv, const int* __restrict__ ti, const float* __restrict__ rstd2, int* __restrict__ ids, float* __restrict__ gates) {
    size_t gid = (size_t)blockIdx.x * 256 + threadIdx.x;
    const float* v0 = tv + gid * 32; const float* v1 = v0 + 16; const int* i0 = ti + gid * 32; const int* i1 = i0 + 16;
    const float rs = rstd2[gid >> 3];
    float av[16], bb[16];
#pragma unroll
    for (int i = 0; i < 16; ++i) { av[i] = v0[i]; bb[i] = v1[i]; }
    float bv[16]; int bi[16];
#pragma unroll
    for (int j = 0; j < 16; ++j) { bv[j] = -INFINITY; bi[j] = 0; }
#pragma unroll
    for (int i = 0; i < 16; ++i)
#pragma unroll
        for (int jj = 0; jj < 16; ++jj) {
            float cv = av[i] + bb[jj]; int ci = i * 16 + jj;
#pragma unroll
            for (int j = 0; j < 16; ++j) { if (cv > bv[j]) { float tvv = bv[j]; int tii = bi[j]; bv[j] = cv; bi[j] = ci; cv = tvv; ci = tii; } }
        }
    float mx = bv[0], sum = 0.f;
#pragma unroll
    for (int j = 0; j < 16; ++j) { bv[j] = expf((bv[j] - mx) * rs); sum += bv[j]; }
    float inv = 1.f / sum;
#pragma unroll
    for (int j = 0; j < 16; ++j) { int pi = bi[j] >> 4, pj = bi[j] & 15; ids[gid * 16 + j] = i0[pi] * 128 + i1[pj]; gates[gid * 16 + j] = bv[j] * inv; }
}
__global__ void __launch_bounds__(256) n_gather(float* __restrict__ x, const float* __restrict__ rstd2, const float* __restrict__ gn, const int* __restrict__ ids,
                                                const float* __restrict__ gates, const float* __restrict__ ut, const float* __restrict__ vt) {
    __shared__ float hs[1024];
    __shared__ float act[128];
    size_t tok = blockIdx.x; int tid = threadIdx.x, lane = tid & 63, w = tid >> 6;
    float r = rstd2[tok];
    float* xp = x + tok * D;
    for (int i = tid; i < D; i += 256) hs[i] = xp[i] * r * gn[i];
    __syncthreads();
    for (int k = w; k < 128; k += 4) {
        int id = ids[tok * 128 + k];
        const float* up = ut + (size_t)id * D;
        float s = 0.f;
        for (int i = lane; i < D; i += 64) s += hs[i] * up[i];
        s = wave_sum(s);
        if (lane == 0) act[k] = gelu_tanh(s) * gates[tok * 128 + k];
    }
    __syncthreads();
    float o[4] = {0.f, 0.f, 0.f, 0.f};
    for (int k = 0; k < 128; ++k) {
        int id = ids[tok * 128 + k];
        const float* vp = vt + (size_t)id * D;
        float av = act[k];
#pragma unroll
        for (int j = 0; j < 4; ++j) o[j] += av * vp[tid + j * 256];
    }
#pragma unroll
    for (int j = 0; j < 4; ++j) xp[tid + j * 256] += o[j];
}
__global__ void __launch_bounds__(512) n_finish(Args a, int lnext) {
    const int lane = threadIdx.x & 63, wv = blockIdx.x * 8 + (threadIdx.x >> 6), nw = gridDim.x * 8;
    for (int tok = wv; tok < T; tok += nw) {
        float xv[16]; load_row16(a.out + (size_t)tok * D, lane, xv);
        finish_token(tok, xv, a.out, (bf16_t*)(a.ws + WS_XB), (float*)(a.ws + WS_RSTD), lnext < DEPTH ? (const float*)(a.ws + WS_WF) + (size_t)lnext * 4096 : nullptr,
                     a.in[2] + (lnext < DEPTH ? lnext * 4 : 0), (float*)(a.ws + WS_FLOG), lane, lane);
    }
}
}
#ifndef HK_ONE_LAUNCH
#define HK_ONE_LAUNCH 1
#endif
extern "C" void kernel_launch(void* const* d_in, const int* in_sizes, int n_in, void* d_out, int out_size, void* d_ws, size_t ws_size, hipStream_t stream) {
    using namespace hk;
    (void)in_sizes; (void)n_in; (void)out_size; (void)ws_size;
    static int grid = 0;
    if (!grid) {
        int dev = 0, cus = 0, per_cu = 0;
        (void)hipGetDevice(&dev);
        (void)hipDeviceGetAttribute(&cus, hipDeviceAttributeMultiprocessorCount, dev);
        if (hipFuncSetAttribute((const void*)hk_mega, hipFuncAttributeMaxDynamicSharedMemorySize, LDS_BYTES) != hipSuccess) fprintf(stderr, "hipFuncSetAttribute failed\n");
        (void)hipOccupancyMaxActiveBlocksPerMultiprocessor(&per_cu, (const void*)hk_mega, NTHR, LDS_BYTES);
        if (per_cu < 1) fprintf(stderr, "occupancy query says %d blocks per CU\n", per_cu);
        grid = cus > 0 ? cus : 256;
    }
    Args a{};
    for (int i = 0; i < 29; ++i) a.in[i] = (const float*)d_in[i];
    a.out = (float*)d_out; a.ws = (unsigned char*)d_ws;
    (void)hipMemsetAsync(a.ws + WS_CTL, 0, WS_CTL_BYTES, stream);
    auto run = [&](int lo, int hi, int bar, int bank = 0) { Args b = a; b.ph_lo = lo; b.ph_hi = hi; b.use_bar = bar; b.pad0 = bank; hipLaunchKernelGGL(hk_mega, dim3(grid), dim3(NTHR), LDS_BYTES, stream, b); };
#ifndef HK_REP_MASK
#define HK_REP_MASK 0
#endif
#if HK_ONE_LAUNCH
    run(0, NPHASE, 1);
#else
    unsigned char* ws = a.ws;
    bf16_t* zb = (bf16_t*)(ws + WS_ZB); bf16_t* mix = (bf16_t*)(ws + WS_MIX); bf16_t* xb = (bf16_t*)(ws + WS_XB);
    bf16_t* su = (bf16_t*)(ws + WS_SU); float* cum = (float*)(ws + WS_CUM); float* tb = (float*)(ws + WS_TB);
    (void)hipFuncSetAttribute((const void*)nv::n_top1, hipFuncAttributeMaxDynamicSharedMemorySize, 65536);
    run(0, 1, 0); run(1, 2, 0);
    for (int l = 0; l < DEPTH; ++l) {
        const int pb = 2 + NPL * l;
        run(pb, pb + 1, 0);
        if (HK_REP_MASK & 1) run(pb, pb + 1, 0);
        if (HK_NEW_MASK & 2) run(pb + 1, pb + 2, 0);
        if (HK_REP_MASK & 2) run(pb + 1, pb + 2, 0, 1);
        if (HK_NEW_MASK & 4) run(pb + 2, pb + 3, 0);
        if (HK_REP_MASK & 4) run(pb + 2, pb + 3, 0);
        if (!(HK_NEW_MASK & 2)) {
            nv::n_fox<<<NB * 4 * S / 64, 64, 0, stream>>>(zb, cum, mix);
            nv::n_dil<<<NB * 4 * S / 64, 64, 0, stream>>>(zb, tb, mix);
            float* t0 = (float*)(ws + WS_DPART); float* t1 = (float*)(ws + WS_UT);
            nv::n_diff<0><<<NB * 4 * S / 64, 64, 0, stream>>>(zb, tb, t0);
            nv::n_diff<1><<<NB * 4 * S / 64, 64, 0, stream>>>(zb, tb, t1);
            const float lam_init = 0.8f - 0.6f * expf(-0.3f * l);
            nv::n_diff_fin<<<(T * 4) / 256, 256, 0, stream>>>(t0, t1, a.in[12] + l * 128, a.in[13] + l * 64, lam_init, mix);
            float* gbuf = (float*)(ws + WS_VT);
            nv::n_s5<<<NB * 16, 64, 0, stream>>>(su, a.in[15] + l * 1024, a.in[16] + l * 1024, a.in[17] + l * 16, a.in[18] + l * 16384, a.in[19] + l * 16384,
                                                  a.in[20] + l * 16384, a.in[21] + l * 16384, a.in[22] + l * 256, gbuf);
            nv::n_glu<<<T, 256, 0, stream>>>(gbuf, a.in[23] + l * 65536, a.in[24] + l * 256, mix);
        }
        if (HK_NEW_MASK & 8) run(pb + 3, pb + 4, 0);
        else nv::n_gemm<0><<<dim3(D / 64, T / 64), 256, 0, stream>>>(mix, nullptr, a.in[3] + (size_t)l * D * D, a.out, xb, T, D, D);
        if (HK_NEW_MASK & 16) run(pb + 4, pb + 5, 0);
        if (HK_REP_MASK & 16) run(pb + 4, pb + 5, 0);
        else nv::n_gemm<1><<<dim3(2048 / 64, T / 64), 256, 0, stream>>>(xb, a.in[5] + l * D, a.in[25] + (size_t)l * D * 2048, nullptr, zb, T, 2048, D);
        if (HK_NEW_MASK & 32) { run(pb + 5, pb + 6, 0); if (HK_PEER_SPLIT) run(pb + 6, pb + 7, 0); }
        else {
            float* rs2 = (float*)(ws + WS_DLSE); float* tv = (float*)(ws + WS_SU); int* ti = (int*)(ws + WS_MIX);
            int* ids = (int*)(ws + WS_DPART); float* gates = (float*)(ws + WS_DPART + (size_t)T * 128 * 4);
            nv::n_rstd<<<T / 4, 256, 0, stream>>>(a.out, rs2);
            nv::n_top1<<<dim3(T / 256, 16), 256, 65536, stream>>>(zb, a.in[26] + (size_t)l * 16 * 128 * 128, tv, ti);
            nv::n_top2<<<(T * 8) / 256, 256, 0, stream>>>(tv, ti, rs2, ids, gates);
            nv::n_gather<<<T, 256, 0, stream>>>(a.out, rs2, a.in[5] + l * D, ids, gates, a.in[27] + (size_t)l * NEXP * D, a.in[28] + (size_t)l * NEXP * D);
            Args b = a; b.ph_lo = 0; b.ph_hi = 0; b.use_bar = 0; b.pad0 = 0;
            nv::n_finish<<<grid, 512, 0, stream>>>(b, l + 1);
        }
    }
#endif
}
```

```cpp
#define HK_ONE_LAUNCH 1
#include <hip/hip_runtime.h>
#ifndef HK_NEW_MASK
#define HK_NEW_MASK 0x3f
#endif
#define HK_FOLD_KEYS (((HK_NEW_MASK) & 48) == 48)
#ifndef HK_PEER_SPLIT
#define HK_PEER_SPLIT HK_FOLD_KEYS
#endif
#include <cstdint>
#include <cstdio>
#include <cmath>

#define LAS3 __attribute__((address_space(3)))
typedef unsigned short bf16_t;
typedef short bf16x8 __attribute__((ext_vector_type(8)));
typedef float f32x4 __attribute__((ext_vector_type(4)));
typedef float f32x16 __attribute__((ext_vector_type(16)));
typedef unsigned u32x4 __attribute__((ext_vector_type(4)));
typedef unsigned u32x2 __attribute__((ext_vector_type(2)));

namespace hk {
constexpr int D = 1024, NB = 8, S = 8192, DEPTH = 4, T = NB * S;
constexpr int INW = 2564;
constexpr int ZP = 2304;
constexpr int ZC_FQ = 0, ZC_FK = 256, ZC_FV = 512, ZC_DQ = 768, ZC_DK = 1024, ZC_DV = 1280, ZC_CQ = 1536, ZC_CK = 1792, ZC_CV = 2048;
constexpr int NEXP = 16384;
constexpr float EPS = 1e-6f;
constexpr float LOG2E = 1.4426950408889634f;
constexpr int TBN = 2112;
constexpr int S5_TC = 64;
constexpr int S5_NCH = S / S5_TC;
constexpr int NTHR = 512;
constexpr int LDS_BYTES = 160 * 1024;
constexpr int LDS_CTL = LDS_BYTES - 256;

constexpr size_t al256(size_t x) { return (x + 255) & ~(size_t)255; }
constexpr size_t WS_CTL = 0;
constexpr size_t WS_CTL_BYTES = 65536;
constexpr size_t WS_XB = WS_CTL + WS_CTL_BYTES;
constexpr size_t WS_ZB = WS_XB + (size_t)T * D * 2;
constexpr size_t WS_SU = WS_ZB + (size_t)T * ZP * 2;
constexpr size_t WS_MIX = WS_SU + (size_t)T * 256 * 4;
constexpr size_t WS_DPART = WS_MIX + (size_t)T * D * 2;
constexpr size_t WS_DLSE = WS_DPART + (size_t)3 * T * 256 * 2;
constexpr size_t WS_SST = WS_DLSE + (size_t)3 * T * 4 * 4;
constexpr size_t WS_CUM = WS_SST + (size_t)NB * 16 * S5_NCH * 128 * 4;
constexpr size_t WS_FLOG = WS_CUM + (size_t)NB * 4 * S * 4;
constexpr size_t WS_RSTD = WS_FLOG + (size_t)NB * 4 * S * 4;
constexpr size_t WS_WIN = WS_RSTD + (size_t)T * 4;
constexpr size_t WS_WF = WS_WIN + (size_t)DEPTH * 2560 * 1024 * 2;
constexpr size_t WS_WOUT = WS_WF + (size_t)DEPTH * 4 * 1024 * 4;
constexpr size_t WS_WQ = WS_WOUT + (size_t)DEPTH * 1024 * 1024 * 2;
constexpr size_t WS_KEYS = WS_WQ + (size_t)DEPTH * 2048 * 1024 * 2;
constexpr size_t WS_GLU = WS_KEYS + (size_t)DEPTH * 16 * 128 * 128 * 2;
constexpr size_t WS_TB = WS_GLU + (size_t)DEPTH * 256 * 256 * 2;
constexpr size_t WS_UT = al256(WS_TB + (size_t)8 * TBN * 4);
constexpr size_t WS_VT = WS_UT + (size_t)NEXP * D * 2;
constexpr size_t WS_US = WS_VT + (size_t)NEXP * D * 2;
constexpr size_t WS_VS = WS_US + (size_t)NEXP * 4;
constexpr size_t WS_FOXT = WS_VS + (size_t)NEXP * 4;
constexpr size_t WS_S5B = WS_FOXT + 256;
constexpr size_t WS_S5A = WS_S5B + (size_t)DEPTH * 16 * 2 * 64 * 16 * 2;
constexpr size_t WS_END = WS_S5A + (size_t)DEPTH * 16 * 64 * 16;
constexpr size_t WS_NV_TV = WS_SU;
constexpr size_t WS_NV_IDS = WS_DPART;
constexpr size_t WS_CIDX = WS_DPART;
constexpr size_t WS_CQ = WS_CIDX + (size_t)T * 128 * 2;
constexpr size_t WS_CSC = WS_CQ + (size_t)T * 128;
static_assert(WS_END <= (size_t)1024 * 1024 * 1024, "workspace map exceeds 1 GiB");
constexpr int CTL_BAR = 0;
constexpr int CTL_Q = 4096;

struct Args {
    const float* in[29];
    float* out;
    unsigned char* ws;
    int ph_lo, ph_hi;
    int use_bar, pad0;
};

__device__ __forceinline__ float bf2f(bf16_t v) { return __uint_as_float((unsigned)v << 16); }
__device__ __forceinline__ bf16_t f2bf(float f) { unsigned u = __float_as_uint(f); u += 0x7fffu + ((u >> 16) & 1u); return (bf16_t)(u >> 16); }
__device__ __forceinline__ unsigned pk2(float lo, float hi) { return (unsigned)f2bf(lo) | ((unsigned)f2bf(hi) << 16); }
__device__ __forceinline__ float gelu_tanh(float x) {
    const float u = 0.7978845608028654f * (x + 0.044715f * x * x * x);
    return x / (1.f + __expf(-2.f * u));
}
__device__ __forceinline__ float log_sigmoid(float x) { return x >= 0.f ? -log1pf(expf(-x)) : x - log1pf(expf(x)); }
__device__ __forceinline__ int t5_bucket(int dist) {
    int n = dist < 0 ? 0 : dist;
    float nf = (float)(n < 16 ? 16 : n);
    int large = 16 + (int)(logf(nf / 16.f) / logf(128.f) * 16.f);
    large = large < 31 ? large : 31;
    return n < 16 ? n : large;
}
__device__ __forceinline__ float wave_sum(float v) {
#pragma unroll
    for (int o = 32; o > 0; o >>= 1) v += __shfl_xor(v, o);
    return v;
}
__device__ __forceinline__ float half_swap_max(float m) {
    auto rr = __builtin_amdgcn_permlane32_swap(__float_as_uint(m), __float_as_uint(m), false, false);
    return fmaxf(__uint_as_float(rr[0]), __uint_as_float(rr[1]));
}
__device__ __forceinline__ float half_swap_sum(float m) {
    auto rr = __builtin_amdgcn_permlane32_swap(__float_as_uint(m), __float_as_uint(m), false, false);
    return __uint_as_float(rr[0]) + __uint_as_float(rr[1]);
}
}
namespace pg8 {
#define PG8_LAS __attribute__((address_space(3)))
typedef unsigned short bf16_t;
typedef short bf16x8 __attribute__((ext_vector_type(8)));
typedef float f32x4 __attribute__((ext_vector_type(4)));
typedef unsigned u32x4 __attribute__((ext_vector_type(4)));
constexpr int BM = 256, BK = 64, HALF = 128, HTB = HALF * BK * 2  , STAGE_BYTES = 8 * HTB, NXCD = 8, WGM = 8;

__host__ __device__ __forceinline__ int lds_byte(int r, int c) { const int st = (r >> 4) * 2 + (c >> 5), rr = r & 15, cc = c & 31, ob = rr * 64 + cc * 2; return st * 1024 + (ob ^ (((ob >> 9) & 1) << 5)); }
__host__ __device__ __forceinline__ void stage_rc(int b, int& R, int& C) { const int st = b / 1024, sb = b % 1024, swz = sb ^ (((sb >> 9) & 1) << 5); R = (st >> 1) * 16 + swz / 64; C = (st & 1) * 32 + (swz % 64) / 2; }
__host__ __device__ __forceinline__ int perm32(int rho) { const int n = rho >> 4, i = rho & 15; return 8 * (i >> 2) + 4 * n + (i & 3); }

struct Unit { int pm, pn; };
struct Gemm { const bf16_t* A; const bf16_t* Bt; int M, N, K; };

struct StaticOrder {
    int nM, nN, nwg, G, c;
    __host__ __device__ void init(int M, int N, int G_, int c_) { nM = M / BM; nN = N / BM; nwg = nM * nN; G = G_; c = c_; }
    __host__ __device__ bool next(int i, Unit& u) const {
        const long L = (long)i * G + c; if (L >= nwg) return false;
        int wgid = (int)L; { const int q = nwg / NXCD, r = nwg % NXCD, xcd = wgid % NXCD, off = wgid / NXCD; wgid = (xcd < r ? xcd * (q + 1) : r * (q + 1) + (xcd - r) * q) + off; }
        const int nig = WGM * nN, gid = wgid / nig, fm = gid * WGM, gsz = (nM - fm) < WGM ? (nM - fm) : WGM;
        u.pm = fm + ((wgid % nig) % gsz); u.pn = (wgid % nig) / gsz; return true;
    }
    __device__ __forceinline__ void a_ready(const Unit&) const {}
    __device__ __forceinline__ void done(const Unit&) const {}
};
typedef float f32x2e_t __attribute__((ext_vector_type(2))); typedef __bf16 bf16x2e_t __attribute__((ext_vector_type(2)));
__device__ __forceinline__ unsigned cvt_pk_bf16(float lo, float hi) { const f32x2e_t v = {lo, hi}; const bf16x2e_t b = __builtin_convertvector(v, bf16x2e_t); return __builtin_bit_cast(unsigned, b); }

struct EpiIn {
    static constexpr bool PERM = true, AFTER_DRAIN = false;
    bf16_t* zb; float* su32; const float* rstd;
    const float* g_fq; const float* g_fk; const float* g_dq; const float* g_dk; const float* g_cq; const float* g_ck;
    __device__ __forceinline__ void operator()(const f32x4 (&acc)[2][2][4][2], const Unit& u, int wr, int wc, int fr, int fq) const {
        const int pn = u.pn;
        const int mode = (pn == 0 || pn == 1 || pn == 3 || pn == 4) ? 1 : ((pn == 6 || pn == 7) ? 2 : (pn == 9 ? 3 : 0));
        const float* gp = pn == 0 ? g_fq : pn == 1 ? g_fk : pn == 3 ? g_dq : pn == 4 ? g_dk : pn == 6 ? g_cq : g_ck;
        const float qs = (pn == 0 || pn == 3) ? 0.125f * 1.4426950408889634f : (pn == 6 ? 0.17677669529663687f * 1.4426950408889634f : 1.f);
        f32x4 gv[2][2];
#pragma unroll
        for (int bj = 0; bj < 2; ++bj)
#pragma unroll
            for (int n = 0; n < 2; ++n) {
                if (mode == 1) gv[bj][n] = *(const f32x4*)(gp + 32 * bj + 8 * fq + 4 * n) * qs;
                else if (mode == 2) gv[bj][n] = *(const f32x4*)(gp + 8 * fq + 4 * n) * qs;
                else gv[bj][n] = (f32x4){1.f, 1.f, 1.f, 1.f};
            }
#pragma unroll
        for (int ai = 0; ai < 2; ++ai)
#pragma unroll
            for (int m = 0; m < 4; ++m) {
                const int row = u.pm * BM + ai * HALF + wr * 64 + m * 16 + fr;
                const float rs = rstd[row];
                f32x4 v[2][2];
                float ss[2];
#pragma unroll
                for (int bj = 0; bj < 2; ++bj) {
                    float s = 0.f;
#pragma unroll
                    for (int n = 0; n < 2; ++n) { v[bj][n] = acc[ai][bj][m][n] * rs; const f32x4 x = v[bj][n]; s += (x[0] * x[0] + x[1] * x[1]) + (x[2] * x[2] + x[3] * x[3]); }
                    ss[bj] = s;
                }
                if (mode == 1 || mode == 2) {
                    float s0 = ss[0], s1 = ss[1];
                    s0 += __shfl_xor(s0, 16); s0 += __shfl_xor(s0, 32); s1 += __shfl_xor(s1, 16); s1 += __shfl_xor(s1, 32);
                    float r0, r1;
                    if (mode == 1) { r0 = __builtin_amdgcn_rsqf((s0 + s1) * (1.f / 64.f) + 1e-6f); r1 = r0; }
                    else { r0 = __builtin_amdgcn_rsqf(s0 * (1.f / 32.f) + 1e-6f); r1 = __builtin_amdgcn_rsqf(s1 * (1.f / 32.f) + 1e-6f); }
#pragma unroll
                    for (int n = 0; n < 2; ++n) { v[0][n] = v[0][n] * r0 * gv[0][n]; v[1][n] = v[1][n] * r1 * gv[1][n]; }
                }
                if (mode == 3) {
                    bf16_t* op = (bf16_t*)su32 + (size_t)row * 256 + 64 * wc + 8 * fq;
#pragma unroll
                    for (int bj = 0; bj < 2; ++bj) { u32x4 w; w.x = cvt_pk_bf16(v[bj][0][0], v[bj][0][1]); w.y = cvt_pk_bf16(v[bj][0][2], v[bj][0][3]); w.z = cvt_pk_bf16(v[bj][1][0], v[bj][1][1]); w.w = cvt_pk_bf16(v[bj][1][2], v[bj][1][3]);
                        *(u32x4*)(op + 32 * bj) = w; }
                } else {
                    bf16_t* op = zb + (size_t)row * 2304 + pn * 256 + 64 * wc + 8 * fq;
#pragma unroll
                    for (int bj = 0; bj < 2; ++bj) { u32x4 w; w.x = cvt_pk_bf16(v[bj][0][0], v[bj][0][1]); w.y = cvt_pk_bf16(v[bj][0][2], v[bj][0][3]); w.z = cvt_pk_bf16(v[bj][1][0], v[bj][1][1]); w.w = cvt_pk_bf16(v[bj][1][2], v[bj][1][3]);
                        *(u32x4*)(op + 32 * bj) = w; }
                }
            }
    }
};
struct EpiOut {
    static constexpr bool PERM = true, AFTER_DRAIN = false;
    bf16_t* xb;
    __device__ __forceinline__ void operator()(const f32x4 (&acc)[2][2][4][2], const Unit& u, int wr, int wc, int fr, int fq) const {
#pragma unroll
        for (int ai = 0; ai < 2; ++ai)
#pragma unroll
            for (int m = 0; m < 4; ++m) {
                const int row = u.pm * BM + ai * HALF + wr * 64 + m * 16 + fr;
#pragma unroll
                for (int bj = 0; bj < 2; ++bj) {
                    const size_t off = (size_t)row * 1024 + u.pn * BM + bj * HALF + wc * 32 + 8 * fq;
                    const u32x4 o = *(const u32x4*)(xb + off);
                    const f32x4 a0 = acc[ai][bj][m][0], a1 = acc[ai][bj][m][1];
                    u32x4 w;
                    w.x = cvt_pk_bf16(__uint_as_float(o.x << 16) + a0[0], __uint_as_float(o.x & 0xffff0000u) + a0[1]);
                    w.y = cvt_pk_bf16(__uint_as_float(o.y << 16) + a0[2], __uint_as_float(o.y & 0xffff0000u) + a0[3]);
                    w.z = cvt_pk_bf16(__uint_as_float(o.z << 16) + a1[0], __uint_as_float(o.z & 0xffff0000u) + a1[1]);
                    w.w = cvt_pk_bf16(__uint_as_float(o.w << 16) + a1[2], __uint_as_float(o.w & 0xffff0000u) + a1[3]);
                    *(u32x4*)(xb + off) = w;
                }
            }
    }
};
struct EpiPlain {
    static constexpr bool PERM = true, AFTER_DRAIN = false;
    bf16_t* O; int ldc;
    __device__ __forceinline__ void operator()(const f32x4 (&acc)[2][2][4][2], const Unit& u, int wr, int wc, int fr, int fq) const {
#pragma unroll
        for (int ai = 0; ai < 2; ++ai)
#pragma unroll
            for (int m = 0; m < 4; ++m) {
                const int row = u.pm * BM + ai * HALF + wr * 64 + m * 16 + fr;
#pragma unroll
                for (int bj = 0; bj < 2; ++bj) {
                    const size_t off = (size_t)row * ldc + u.pn * BM + bj * HALF + wc * 32 + 8 * fq;
                    const f32x4 a = acc[ai][bj][m][0], b = acc[ai][bj][m][1];
                    u32x4 w; w.x = cvt_pk_bf16(a[0], a[1]); w.y = cvt_pk_bf16(a[2], a[3]); w.z = cvt_pk_bf16(b[0], b[1]); w.w = cvt_pk_bf16(b[2], b[3]);
                    *(u32x4*)(O + off) = w;
                }
            }
    }
};
typedef _Float16 f16x2e_t __attribute__((ext_vector_type(2)));
__device__ __forceinline__ unsigned cvt_pk_f16(float lo, float hi) { const f32x2e_t v = {lo, hi}; const f16x2e_t b = __builtin_convertvector(v, f16x2e_t); return __builtin_bit_cast(unsigned, b); }
struct EpiF16 {
    static constexpr bool PERM = true, AFTER_DRAIN = false;
    bf16_t* O; int ldc;
    __device__ __forceinline__ void operator()(const f32x4 (&acc)[2][2][4][2], const Unit& u, int wr, int wc, int fr, int fq) const {
#pragma unroll
        for (int ai = 0; ai < 2; ++ai)
#pragma unroll
            for (int m = 0; m < 4; ++m) {
                const int row = u.pm * BM + ai * HALF + wr * 64 + m * 16 + fr;
#pragma unroll
                for (int bj = 0; bj < 2; ++bj) {
                    const size_t off = (size_t)row * ldc + u.pn * BM + bj * HALF + wc * 32 + 8 * fq;
                    const f32x4 a = acc[ai][bj][m][0], b = acc[ai][bj][m][1];
                    u32x4 w; w.x = cvt_pk_f16(a[0], a[1]); w.y = cvt_pk_f16(a[2], a[3]); w.z = cvt_pk_f16(b[0], b[1]); w.w = cvt_pk_f16(b[2], b[3]);
                    *(u32x4*)(O + off) = w;
                }
            }
    }
};
template <class Epi, class Sched, bool ALIGN_EPI = false, bool SP2 = false>
__device__ __forceinline__ void gemm_phase(PG8_LAS unsigned char* lds, const Gemm g, const Sched& S, const Epi& E) {
    const int tid = threadIdx.x, wid = __builtin_amdgcn_readfirstlane(tid >> 6), lane = tid & 63, wr = wid >> 2, wc = wid & 3, fr = lane & 15, fq = lane >> 4;
    const int K = g.K, nt = K / BK;
    unsigned voffA[2], voffB[2];
#pragma unroll
    for (int i = 0; i < 2; ++i) { int R, C; stage_rc(tid * 16 + i * 8192, R, C); const int Rb = Epi::PERM ? ((R & ~31) + perm32(R & 31)) : R;
        voffA[i] = (unsigned)(R * K + C) * 2u; voffB[i] = (unsigned)(Rb * K + C) * 2u; }
    const size_t kstep = (size_t)(BK * 2);
    const size_t hstep = (size_t)HALF * K * 2;
    const size_t tstep = 2 * hstep;
    const unsigned ldsw = (unsigned)wid * 1024u;
    const int aoff = lds_byte(wr * 64 + fr, fq * 8), boff = lds_byte(wc * 32 + fr, fq * 8);
#define PG8_SA(b, h) (((b) * 2 + (h)) * HTB)
#define PG8_SB(b, h) ((4 + (b) * 2 + (h)) * HTB)
#define PG8_STAGE(bufoff, gbase, voff) do { _Pragma("unroll") for (int _i = 0; _i < 2; ++_i) \
        __builtin_amdgcn_global_load_lds((const unsigned*)((const char*)(gbase) + (voff)[_i]), (PG8_LAS unsigned*)(lds + (bufoff) + ldsw + _i * 8192), 16, 0, 0); } while (0)
#define PG8_LDA(dst, b, h) do { _Pragma("unroll") for (int m = 0; m < 4; ++m) _Pragma("unroll") for (int k = 0; k < 2; ++k) dst[m][k] = *(const PG8_LAS bf16x8*)(lds + PG8_SA(b, h) + aoff + m * 2048 + k * 1024); } while (0)
#define PG8_LDB(dst, b, h) do { _Pragma("unroll") for (int n = 0; n < 2; ++n) _Pragma("unroll") for (int k = 0; k < 2; ++k) dst[n][k] = *(const PG8_LAS bf16x8*)(lds + PG8_SB(b, h) + boff + n * 2048 + k * 1024); } while (0)
#define PG8_MMA(ai, bj, At, Bt) do { __builtin_amdgcn_s_setprio(1); _Pragma("unroll") for (int m = 0; m < 4; ++m) _Pragma("unroll") for (int n = 0; n < 2; ++n) _Pragma("unroll") for (int k = 0; k < 2; ++k) \
        acc[ai][bj][m][n] = __builtin_amdgcn_mfma_f32_16x16x32_bf16(Bt[n][k], At[m][k], acc[ai][bj][m][n], 0, 0, 0); __builtin_amdgcn_s_setprio(0); } while (0)
#define PG8_WAIT_V(n) asm volatile("s_waitcnt vmcnt(" #n ")" ::: "memory")
#define PG8_WAIT_L(n) asm volatile("s_waitcnt lgkmcnt(" #n ")" ::: "memory")
#define PG8_BAR __builtin_amdgcn_s_barrier()
#define PG8_SCHED __builtin_amdgcn_sched_barrier(0)
    Unit cur, nxt; int ui = 0;
    if (!S.next(0, cur)) return;
    f32x4 acc[2][2][4][2];
#pragma unroll
    for (int a = 0; a < 2; ++a)
#pragma unroll
        for (int b = 0; b < 2; ++b)
#pragma unroll
            for (int m = 0; m < 4; ++m)
#pragma unroll
                for (int n = 0; n < 2; ++n) acc[a][b][m][n] = (f32x4){0.f, 0.f, 0.f, 0.f};
    bf16x8 At[4][2], B0[2][2], B1[2][2];
    const char* cA = (const char*)g.A + (size_t)cur.pm * tstep; const char* cB = (const char*)g.Bt + (size_t)cur.pn * tstep;
    S.a_ready(cur);
    if constexpr (SP2) {
        PG8_STAGE(PG8_SB(0, 0), cB, voffB); PG8_STAGE(PG8_SB(0, 1), cB + hstep, voffB); PG8_STAGE(PG8_SA(0, 0), cA, voffA); PG8_STAGE(PG8_SA(0, 1), cA + hstep, voffA);
        if (wr == 1) PG8_BAR;
        PG8_WAIT_V(2); PG8_BAR;
        PG8_STAGE(PG8_SB(1, 0), cB + kstep, voffB); PG8_STAGE(PG8_SA(1, 0), cA + kstep, voffA); PG8_STAGE(PG8_SB(1, 1), cB + hstep + kstep, voffB);
        PG8_WAIT_V(6); PG8_BAR;
    } else {
        PG8_STAGE(PG8_SB(0, 0), cB, voffB); PG8_STAGE(PG8_SA(0, 0), cA, voffA); PG8_STAGE(PG8_SB(0, 1), cB + hstep, voffB); PG8_STAGE(PG8_SA(0, 1), cA + hstep, voffA);
        if (wr == 1) PG8_BAR;
        PG8_WAIT_V(4); PG8_BAR;
        PG8_STAGE(PG8_SB(1, 0), cB + kstep, voffB); PG8_STAGE(PG8_SA(1, 0), cA + kstep, voffA); PG8_STAGE(PG8_SB(1, 1), cB + hstep + kstep, voffB);
        PG8_WAIT_V(6); PG8_BAR;
    }
    for (;;) {
        const bool has_next = S.next(ui + 1, nxt);
        const char* nA = has_next ? (const char*)g.A + (size_t)nxt.pm * tstep : cA; const char* nB = has_next ? (const char*)g.Bt + (size_t)nxt.pn * tstep : cB;
        for (int t = 0; t < nt; t += 2) {
            const bool last = (t == nt - 2);
            const char* a1 = cA + (size_t)(t + 1) * kstep;
            const char* a2 = last ? nA : cA + (size_t)(t + 2) * kstep; const char* b2 = last ? nB : cB + (size_t)(t + 2) * kstep;
            const char* a3 = a2 + kstep; const char* b3 = b2 + kstep;
            if (last && has_next) S.a_ready(nxt);
            if constexpr (SP2) {
            PG8_LDB(B0, 0, 0); PG8_LDB(B1, 0, 1); PG8_SCHED; PG8_LDA(At, 0, 0); PG8_STAGE(PG8_SA(1, 1), a1 + hstep, voffA);
            PG8_WAIT_V(8); PG8_WAIT_L(0); PG8_BAR; PG8_MMA(0, 0, At, B0); PG8_MMA(0, 1, At, B1); PG8_BAR; PG8_SCHED;
            PG8_LDA(At, 0, 1); PG8_STAGE(PG8_SB(0, 0), b2, voffB); PG8_STAGE(PG8_SB(0, 1), b2 + hstep, voffB); PG8_STAGE(PG8_SA(0, 0), a2, voffA);
            PG8_WAIT_V(8); PG8_WAIT_L(0); PG8_BAR; PG8_MMA(1, 0, At, B0); PG8_MMA(1, 1, At, B1); PG8_BAR; PG8_SCHED;
            PG8_LDB(B0, 1, 0); PG8_LDB(B1, 1, 1); PG8_SCHED; PG8_LDA(At, 1, 0); PG8_STAGE(PG8_SA(0, 1), a2 + hstep, voffA);
            PG8_WAIT_V(8); PG8_WAIT_L(0); PG8_BAR; PG8_MMA(0, 0, At, B0); PG8_MMA(0, 1, At, B1); PG8_BAR; PG8_SCHED;
            PG8_LDA(At, 1, 1); PG8_STAGE(PG8_SB(1, 0), b3, voffB); PG8_STAGE(PG8_SB(1, 1), b3 + hstep, voffB); PG8_STAGE(PG8_SA(1, 0), a3, voffA);
            PG8_WAIT_V(8); PG8_WAIT_L(0); PG8_BAR; PG8_MMA(1, 0, At, B0); PG8_MMA(1, 1, At, B1); PG8_BAR; PG8_SCHED;
            } else {
            PG8_LDB(B0, 0, 0); PG8_SCHED; PG8_LDA(At, 0, 0); PG8_STAGE(PG8_SA(1, 1), a1 + hstep, voffA);
            PG8_WAIT_L(8); PG8_BAR; PG8_WAIT_L(0); PG8_MMA(0, 0, At, B0); PG8_BAR; PG8_SCHED;
            PG8_LDB(B1, 0, 1); PG8_STAGE(PG8_SB(0, 0), b2, voffB);
            PG8_BAR; PG8_WAIT_L(0); PG8_MMA(0, 1, At, B1); PG8_BAR;
            PG8_LDA(At, 0, 1); PG8_STAGE(PG8_SA(0, 0), a2, voffA);
            PG8_BAR; PG8_WAIT_L(0); PG8_MMA(1, 0, At, B0); PG8_BAR; PG8_SCHED;
            PG8_STAGE(PG8_SB(0, 1), b2 + hstep, voffB);
            PG8_WAIT_V(6); PG8_BAR; PG8_MMA(1, 1, At, B1); PG8_BAR;
            PG8_LDB(B0, 1, 0); PG8_SCHED; PG8_LDA(At, 1, 0); PG8_STAGE(PG8_SA(0, 1), a2 + hstep, voffA);
            PG8_WAIT_L(8); PG8_BAR; PG8_WAIT_L(0); PG8_MMA(0, 0, At, B0); PG8_BAR; PG8_SCHED;
            PG8_LDB(B1, 1, 1); PG8_STAGE(PG8_SB(1, 0), b3, voffB);
            PG8_BAR; PG8_WAIT_L(0); PG8_MMA(0, 1, At, B1); PG8_BAR;
            PG8_LDA(At, 1, 1); PG8_STAGE(PG8_SA(1, 0), a3, voffA);
            PG8_BAR; PG8_WAIT_L(0); PG8_MMA(1, 0, At, B0); PG8_BAR; PG8_SCHED;
            PG8_STAGE(PG8_SB(1, 1), b3 + hstep, voffB);
            PG8_WAIT_V(6); PG8_BAR; PG8_MMA(1, 1, At, B1); PG8_BAR;
            }
        }
        if constexpr (ALIGN_EPI) { if (wr == 0) PG8_BAR; }
        if constexpr (!Epi::AFTER_DRAIN) { E(acc, cur, wr, wc, fr, fq); S.done(cur); }
        if (!has_next) break;
#pragma unroll
        for (int a = 0; a < 2; ++a)
#pragma unroll
            for (int b = 0; b < 2; ++b)
#pragma unroll
                for (int m = 0; m < 4; ++m)
#pragma unroll
                    for (int n = 0; n < 2; ++n) acc[a][b][m][n] = (f32x4){0.f, 0.f, 0.f, 0.f};
        cur = nxt; cA = nA; cB = nB; ++ui;
        if constexpr (ALIGN_EPI) { if (wr == 1) PG8_BAR; }
    }
    PG8_WAIT_V(0);
    if constexpr (!ALIGN_EPI) { if (wr == 0) PG8_BAR; }
    PG8_BAR;
    if constexpr (Epi::AFTER_DRAIN) { E.fused(acc, cur, wr, wc, fr, fq, lds, wid, lane); S.done(cur); }
#undef PG8_SA
#undef PG8_SB
#undef PG8_STAGE
#undef PG8_LDA
#undef PG8_LDB
#undef PG8_MMA
#undef PG8_WAIT_V
#undef PG8_WAIT_L
#undef PG8_BAR
#undef PG8_SCHED
}
}
#define XB_TMO      128
#define XB_XCNT(j)  (256  + 64 * (j))
#define XB_XSUB(j)  (1280 + 64 * (j))
#define XB_XGEN(j)  (2304 + 64 * (j))
#define XB_TOP      3328
#define XB_TOPGEN   3392
#define XCD_BAR_WORDS 3456
#define XB_SPIN_CAP (1u << 18)
#define LAS __attribute__((address_space(3)))

__device__ __forceinline__ unsigned xb_ld(unsigned* p)              { return __hip_atomic_load(p, __ATOMIC_RELAXED, __HIP_MEMORY_SCOPE_AGENT); }
__device__ __forceinline__ unsigned xb_add(unsigned* p, unsigned v) { return __hip_atomic_fetch_add(p, v, __ATOMIC_RELAXED, __HIP_MEMORY_SCOPE_AGENT); }
__device__ __forceinline__ unsigned xb_xcc_id() { return (unsigned)__builtin_amdgcn_s_getreg((3 << 11) | 20) & 0xFu; }
#define XB_SPIN(cond, bar) do { unsigned _sp = 0; while (cond) { __builtin_amdgcn_s_sleep(1); \
    if ((++_sp & 255u) == 0u) { if (xb_ld(&(bar)[XB_TMO])) break; if (_sp > XB_SPIN_CAP) { atomicAdd(&(bar)[XB_TMO], 1u); break; } } } } while (0)

struct XcdBarrier {
    unsigned* bar; unsigned x;
    volatile LAS unsigned* st;
};

__device__ __forceinline__ XcdBarrier xcd_barrier_post(unsigned* bar, volatile LAS unsigned* st) {
    XcdBarrier b; b.bar = bar; b.x = xb_xcc_id(); b.st = st;
    if (threadIdx.x == 0) (void)xb_add(&bar[XB_XCNT(b.x)], 1u);
    return b;
}
__device__ __forceinline__ void xcd_barrier_complete(unsigned* bar, unsigned x, unsigned& nloc, unsigned& nx) {
    const unsigned G = gridDim.x * gridDim.y * gridDim.z;
    unsigned sum, cnt, mine, sp = 0u;
    for (;;) {
        sum = 0u; cnt = 0u; mine = 0u;
#pragma unroll
        for (unsigned j = 0; j < 16; ++j) { const unsigned c = xb_ld(&bar[XB_XCNT(j)]); sum += c; cnt += (c > 0u) ? 1u : 0u; mine = (j == x) ? c : mine; }
        if (sum == G) break;
        __builtin_amdgcn_s_sleep(1);
        if ((++sp & 255u) == 0u) { if (xb_ld(&bar[XB_TMO])) break; if (sp > XB_SPIN_CAP) { atomicAdd(&bar[XB_TMO], 1u); break; } }
    }
    nloc = mine > 0u ? mine : 1u; nx = cnt > 0u ? cnt : 1u;
}

__device__ __forceinline__ void xcd_barrier(const XcdBarrier& b) {
    asm volatile("s_waitcnt vmcnt(0)" ::: "memory");
    __syncthreads();
    if (threadIdx.x == 0) {
        unsigned* bar = b.bar;
        __builtin_amdgcn_s_waitcnt(0);
        unsigned nloc = b.st[0], nx = b.st[1];
        if (nloc == 0u) { xcd_barrier_complete(bar, b.x, nloc, nx); b.st[0] = nloc; b.st[1] = nx; }
        const unsigned old = xb_add(&bar[XB_XSUB(b.x)], 1u);
        const unsigned gen = old / nloc;
        if (old + 1u == (gen + 1u) * nloc) {
            __builtin_amdgcn_fence(__ATOMIC_RELEASE, "agent");
            asm volatile("s_waitcnt vmcnt(0)" ::: "memory");
            const unsigned og = xb_add(&bar[XB_TOP], 1u);
            const unsigned tg = og / nx;
            if (og + 1u == (tg + 1u) * nx) xb_add(&bar[XB_TOPGEN], 1u);
            else XB_SPIN(xb_ld(&bar[XB_TOPGEN]) == tg, bar);
            __builtin_amdgcn_fence(__ATOMIC_ACQUIRE, "agent");
            xb_add(&bar[XB_XGEN(b.x)], 1u);
            asm volatile("s_waitcnt vmcnt(0)" ::: "memory");
        } else {
            XB_SPIN(xb_ld(&bar[XB_XGEN(b.x)]) == gen, bar);
            __builtin_amdgcn_fence(__ATOMIC_ACQUIRE, "agent");
            asm volatile("s_waitcnt vmcnt(0)" ::: "memory");
        }
    }
    __syncthreads();
}
namespace hk {
__device__ __forceinline__ int inproj_src_col(int np) {
    const int pn = np >> 8, p = np & 255, bj = p >> 7, wc = (p >> 5) & 3, i = p & 31;
    const int nl = pn * 256 + 64 * wc + 32 * bj + i;
    return nl < 768 ? nl : nl + 4;
}
template <bool INMAP>
__device__ __forceinline__ void tr_tile(const float* __restrict__ src, int ld, const float* __restrict__ g, bf16_t* __restrict__ dst, int K, int k0, int n0, float* lds) {
    const int tid = threadIdx.x;
#pragma unroll
    for (int i = 0; i < 8; ++i) {
        const int idx = tid + 512 * i, kk = idx >> 6, nn = idx & 63;
        const int col = INMAP ? inproj_src_col(n0 + nn) : (n0 + nn);
        float v = src[(size_t)(k0 + kk) * ld + col];
        if (g) v *= g[k0 + kk];
        lds[nn * 65 + kk] = v;
    }
    __syncthreads();
#pragma unroll
    for (int i = 0; i < 8; ++i) {
        const int idx = tid + 512 * i, nn = idx >> 6, kk = idx & 63;
        dst[(size_t)(n0 + nn) * K + k0 + kk] = f2bf(lds[nn * 65 + kk]);
    }
    __syncthreads();
}
template <bool INMAP>
__device__ __forceinline__ void tr_load(const float* __restrict__ src, int ld, const float* __restrict__ g, int k0, int n0, float (&v)[8]) {
    const int tid = threadIdx.x;
#pragma unroll
    for (int i = 0; i < 8; ++i) {
        const int idx = tid + 512 * i, kk = idx >> 6, nn = idx & 63;
        const int col = INMAP ? inproj_src_col(n0 + nn) : (n0 + nn);
        v[i] = src[(size_t)(k0 + kk) * ld + col];
        if (g) v[i] *= g[k0 + kk];
    }
}
__device__ __forceinline__ void tr_store(const float (&v)[8], bf16_t* __restrict__ dst, int K, int k0, int n0, float* lds) {
    const int tid = threadIdx.x;
#pragma unroll
    for (int i = 0; i < 8; ++i) { const int idx = tid + 512 * i, kk = idx >> 6, nn = idx & 63; lds[nn * 65 + kk] = v[i]; }
    __syncthreads();
#pragma unroll
    for (int i = 0; i < 8; ++i) {
        const int idx = tid + 512 * i, nn = idx >> 6, kk = idx & 63;
        dst[(size_t)(n0 + nn) * K + k0 + kk] = f2bf(lds[nn * 65 + kk]);
    }
    __syncthreads();
}
__device__ __forceinline__ void fold_keys_tile(const float* __restrict__ wq, const float* __restrict__ keys, const float* __restrict__ g, bf16_t* __restrict__ dst, int hp, int k0, float* lds) {
    const int tid = threadIdx.x;
    float* ws_ = lds; float* ks_ = lds + 64 * 129;
    for (int i = tid; i < 64 * 128; i += NTHR) { const int kk = i >> 7, d = i & 127; ws_[kk * 129 + d] = wq[(size_t)(k0 + kk) * 2048 + hp * 128 + d]; }
    for (int i = tid; i < 128 * 128; i += NTHR) { const int ky = i >> 7, d = i & 127; ks_[ky * 129 + d] = keys[(size_t)hp * 128 * 128 + i]; }
    __syncthreads();
    const int key = tid & 127, kg = tid >> 7;
    float acc[16];
#pragma unroll
    for (int i = 0; i < 16; ++i) acc[i] = 0.f;
    for (int d = 0; d < 128; ++d) { const float kv = ks_[key * 129 + d];
#pragma unroll
        for (int i = 0; i < 16; ++i) acc[i] += ws_[(kg * 16 + i) * 129 + d] * kv; }
    u32x4 o0, o1; const float* gp = g + k0 + kg * 16;
    o0.x = pk2(acc[0] * gp[0], acc[1] * gp[1]); o0.y = pk2(acc[2] * gp[2], acc[3] * gp[3]); o0.z = pk2(acc[4] * gp[4], acc[5] * gp[5]); o0.w = pk2(acc[6] * gp[6], acc[7] * gp[7]);
    o1.x = pk2(acc[8] * gp[8], acc[9] * gp[9]); o1.y = pk2(acc[10] * gp[10], acc[11] * gp[11]); o1.z = pk2(acc[12] * gp[12], acc[13] * gp[13]); o1.w = pk2(acc[14] * gp[14], acc[15] * gp[15]);
    bf16_t* op = dst + (size_t)(hp * 128 + key) * 1024 + k0 + kg * 16;
    *(u32x4*)op = o0; *(u32x4*)(op + 8) = o1;
    __syncthreads();
}
__device__ __forceinline__ void phase_weights(const Args& a, unsigned char* ldsb) {
    float* lds = (float*)ldsb;
    const int G = gridDim.x, bid = blockIdx.x, tid = threadIdx.x;
    const float* w_in = a.in[1]; const float* w_out = a.in[3]; const float* norm_mix = a.in[4]; const float* norm_ffn = a.in[5];
    const float* glu_w = a.in[23]; const float* wq = a.in[25]; const float* keys = a.in[26]; const float* relb = a.in[14];
    bf16_t* WIN = (bf16_t*)(a.ws + WS_WIN); bf16_t* WOUT = (bf16_t*)(a.ws + WS_WOUT); bf16_t* WQ = (bf16_t*)(a.ws + WS_WQ); bf16_t* GLU = (bf16_t*)(a.ws + WS_GLU);
#if HK_FOLD_KEYS
    {
        float v[8], vn[8];
        int q = bid;
#define PW_IN(q_, vv) do { const int l_ = (q_) / 640, r_ = (q_) % 640; tr_load<true>(w_in + (size_t)l_ * D * INW, INW, norm_mix + l_ * D, (r_ & 15) * 64, (r_ >> 4) * 64, vv); } while (0)
        if (q < DEPTH * 640) PW_IN(q, v);
        for (; q < DEPTH * 640; q += G) {
            const int qn = q + G; if (qn < DEPTH * 640) PW_IN(qn, vn);
            const int l = q / 640, r = q % 640;
            tr_store(v, WIN + (size_t)l * 2560 * 1024, 1024, (r & 15) * 64, (r >> 4) * 64, lds);
#pragma unroll
            for (int i = 0; i < 8; ++i) v[i] = vn[i];
        }
#undef PW_IN
        q = bid;
#define PW_OUT(q_, vv) do { const int l_ = (q_) >> 8, r_ = (q_) & 255; tr_load<false>(w_out + (size_t)l_ * D * D, D, nullptr, (r_ & 15) * 64, (r_ >> 4) * 64, vv); } while (0)
        if (q < DEPTH * 256) PW_OUT(q, v);
        for (; q < DEPTH * 256; q += G) {
            const int qn = q + G; if (qn < DEPTH * 256) PW_OUT(qn, vn);
            const int l = q >> 8, r = q & 255;
            tr_store(v, WOUT + (size_t)l * 1024 * 1024, 1024, (r & 15) * 64, (r >> 4) * 64, lds);
#pragma unroll
            for (int i = 0; i < 8; ++i) v[i] = vn[i];
        }
#undef PW_OUT
    }
    for (int u = bid; u < DEPTH * 16; u += G) { const int l = u >> 4, r = u & 15; tr_tile<false>(glu_w + (size_t)l * 65536, 256, nullptr, GLU + (size_t)l * 65536, 256, (r & 3) * 64, (r >> 2) * 64, lds); }
    for (int u = bid; u < DEPTH * 256; u += G) { const int l = u >> 8, r = u & 255;
        fold_keys_tile(wq + (size_t)l * D * 2048, keys + (size_t)l * 16 * 128 * 128, norm_ffn + l * D, WQ + (size_t)l * 2048 * 1024, r >> 4, (r & 15) * 64, lds); }
#else
    for (int u = bid; u < DEPTH * 1424; u += G) {
        const int l = u / 1424; int r = u % 1424;
        if (r < 640) { const int nt = r >> 4, kt = r & 15; tr_tile<true>(w_in + (size_t)l * D * INW, INW, norm_mix + l * D, WIN + (size_t)l * 2560 * 1024, 1024, kt * 64, nt * 64, lds); }
        else if (r < 896) { r -= 640; const int nt = r >> 4, kt = r & 15; tr_tile<false>(w_out + (size_t)l * D * D, D, nullptr, WOUT + (size_t)l * 1024 * 1024, 1024, kt * 64, nt * 64, lds); }
        else if (r < 1408) { r -= 896;
#if HK_FOLD_KEYS
            if (r < 256) fold_keys_tile(wq + (size_t)l * D * 2048, keys + (size_t)l * 16 * 128 * 128, norm_ffn + l * D, WQ + (size_t)l * 2048 * 1024, r >> 4, (r & 15) * 64, lds);
#else
            const int nt = r >> 4, kt = r & 15; tr_tile<false>(wq + (size_t)l * D * 2048, 2048, norm_ffn + l * D, WQ + (size_t)l * 2048 * 1024, 1024, kt * 64, nt * 64, lds);
#endif
        }
        else { r -= 1408; const int nt = r >> 2, kt = r & 3; tr_tile<false>(glu_w + (size_t)l * 65536, 256, nullptr, GLU + (size_t)l * 65536, 256, kt * 64, nt * 64, lds); }
    }
#endif
    const int gt = bid * NTHR + tid, gn = G * NTHR;
    float* WF = (float*)(a.ws + WS_WF);
    for (int i = gt; i < DEPTH * 4 * 1024; i += gn) { const int l = i >> 12, h = (i >> 10) & 3, k = i & 1023; WF[i] = norm_mix[l * D + k] * w_in[((size_t)l * D + k) * INW + 768 + h]; }
    bf16_t* KB = (bf16_t*)(a.ws + WS_KEYS);
    for (int i = gt; i < DEPTH * 16 * 128 * 128; i += gn) KB[i] = f2bf(keys[i]);
    if (gt < DEPTH) { float gq = 0.f, gk = 0.f; for (int i = 0; i < 64; ++i) { gq = fmaxf(gq, fabsf(a.in[6][gt * 64 + i])); gk = fmaxf(gk, fabsf(a.in[7][gt * 64 + i])); }
        ((float*)(a.ws + WS_FOXT))[gt] = 2.f * 1.02f * 0.125f * LOG2E * 64.f * gq * gk + 40.f; }
#ifndef HK_T_NOS5TAB
    for (int i = gt; i < DEPTH * 16 * 64; i += gn) {
        const int lg = i >> 6, st = i & 63;
        const float dt = expf(a.in[17][lg]);
        const float ar = a.in[15][lg * 64 + st], ai = a.in[16][lg * 64 + st];
        const float dtar = dt * ar, dtai = dt * ai, mag = expf(dtar);
        const float abr = mag * cosf(dtai), abi = mag * sinf(dtai);
        const float den = ar * ar + ai * ai, nr = abr - 1.f, ni = abi;
        const float cr = (nr * ar + ni * ai) / den, ci = (ni * ar - nr * ai) / den;
        const float mg = expf(64.f * dtar);
        ((f32x4*)(a.ws + WS_S5A))[i] = (f32x4){abr, abi, mg * cosf(64.f * dtai), mg * sinf(64.f * dtai)};
        const float* brp = a.in[18] + ((size_t)lg * 64 + st) * 16; const float* bip = a.in[19] + ((size_t)lg * 64 + st) * 16;
        bf16_t* ore = (bf16_t*)(a.ws + WS_S5B) + ((size_t)(lg * 2) * 64 + st) * 16; bf16_t* oim = ore + 64 * 16;
        for (int c = 0; c < 16; ++c) { const float br = brp[c], bi = bip[c]; ore[c] = f2bf(cr * br - ci * bi); oim[c] = f2bf(cr * bi + ci * br); }
    }
#endif
    float* TB = (float*)(a.ws + WS_TB);
    for (int i = gt; i < 8 * TBN; i += gn) { const int hh = i / TBN, d = i % TBN; TB[i] = relb[t5_bucket(d) * 8 + hh] * LOG2E; }
}

__device__ __forceinline__ void load_row16(const float* __restrict__ p, int lane, float (&xv)[16]) {
#pragma unroll
    for (int j = 0; j < 4; ++j) { const f32x4 t = *(const f32x4*)(p + 16 * lane + 4 * j); xv[4 * j] = t[0]; xv[4 * j + 1] = t[1]; xv[4 * j + 2] = t[2]; xv[4 * j + 3] = t[3]; }
}
__device__ __forceinline__ void load_row16_bf(const bf16_t* __restrict__ p, int slot, float (&xv)[16]) {
    const u32x4 a = *(const u32x4*)(p + 16 * slot), b = *(const u32x4*)(p + 16 * slot + 8);
#pragma unroll
    for (int j = 0; j < 4; ++j) { xv[2 * j] = __uint_as_float(a[j] << 16); xv[2 * j + 1] = __uint_as_float(a[j] & 0xffff0000u); xv[8 + 2 * j] = __uint_as_float(b[j] << 16); xv[8 + 2 * j + 1] = __uint_as_float(b[j] & 0xffff0000u); }
}
__device__ __forceinline__ void finish_token(int tok, const float (&xv)[16], float* __restrict__ xo, bf16_t* __restrict__ xb, float* __restrict__ rstd,
                                             const float* __restrict__ wf, const float* __restrict__ bfor, float* __restrict__ flog, int lane, int slot) {
    float ss = 0.f;
#pragma unroll
    for (int i = 0; i < 16; ++i) ss += xv[i] * xv[i];
    ss = wave_sum(ss);
    const float rs = __builtin_amdgcn_rsqf(ss * (1.f / 1024.f) + EPS);
    float* op = xo + (size_t)tok * D + 16 * slot; bf16_t* bp = xb + (size_t)tok * D + 16 * slot;
    if (xo) {
#pragma unroll
        for (int j = 0; j < 4; ++j) *(f32x4*)(op + 4 * j) = (f32x4){xv[4 * j], xv[4 * j + 1], xv[4 * j + 2], xv[4 * j + 3]};
    }
    u32x4 w0, w1;
    w0.x = pk2(xv[0], xv[1]); w0.y = pk2(xv[2], xv[3]); w0.z = pk2(xv[4], xv[5]); w0.w = pk2(xv[6], xv[7]);
    w1.x = pk2(xv[8], xv[9]); w1.y = pk2(xv[10], xv[11]); w1.z = pk2(xv[12], xv[13]); w1.w = pk2(xv[14], xv[15]);
    *(u32x4*)(bp) = w0; *(u32x4*)(bp + 8) = w1;
    if (lane == 0) rstd[tok] = rs;
    if (wf) {
        float myff = 0.f;
#pragma unroll
        for (int h = 0; h < 4; ++h) {
            const float* wp = wf + h * 1024 + 16 * slot;
            float d = 0.f;
#pragma unroll
            for (int j = 0; j < 4; ++j) { const f32x4 t = *(const f32x4*)(wp + 4 * j); d += xv[4 * j] * t[0] + xv[4 * j + 1] * t[1] + xv[4 * j + 2] * t[2] + xv[4 * j + 3] * t[3]; }
            d = wave_sum(d);
            if (lane == h) myff = d;
        }
        if (lane < 4) { const int b = tok / S, s = tok % S; flog[((size_t)b * 4 + lane) * S + s] = log_sigmoid(myff * rs + bfor[lane]); }
    }
}
__device__ __forceinline__ void phase_xprep(const Args& a) {
    const int lane = threadIdx.x & 63, wv = blockIdx.x * 8 + (threadIdx.x >> 6), nw = gridDim.x * 8;
    const float* x = a.in[0];
    for (int tok = wv; tok < T; tok += nw) {
        float xv[16]; load_row16(x + (size_t)tok * D, lane, xv);
        finish_token(tok, xv, nullptr, (bf16_t*)(a.ws + WS_XB), (float*)(a.ws + WS_RSTD), (const float*)(a.ws + WS_WF), a.in[2], (float*)(a.ws + WS_FLOG), lane, lane);
    }
}
__device__ __forceinline__ void cum_scan(const Args& a, unsigned char* ldsb, int bh) {
    float* lds = (float*)ldsb;
    const int tid = threadIdx.x, lane = tid & 63, w = tid >> 6;
    const float* fl = (const float*)(a.ws + WS_FLOG) + (size_t)bh * S + tid * 16;
    float v[16];
#pragma unroll
    for (int i = 0; i < 4; ++i) { const f32x4 t = *(const f32x4*)(fl + 4 * i); v[4 * i] = t[0]; v[4 * i + 1] = t[1]; v[4 * i + 2] = t[2]; v[4 * i + 3] = t[3]; }
#pragma unroll
    for (int i = 1; i < 16; ++i) v[i] += v[i - 1];
    float incl = v[15];
#pragma unroll
    for (int o = 1; o < 64; o <<= 1) { const float t = __shfl_up(incl, o); if (lane >= o) incl += t; }
    if (lane == 63) lds[w] = incl;
    __syncthreads();
    float base = incl - v[15];
    for (int j = 0; j < w; ++j) base += lds[j];
    float* cp = (float*)(a.ws + WS_CUM) + (size_t)bh * S + tid * 16;
#pragma unroll
    for (int i = 0; i < 4; ++i) *(f32x4*)(cp + 4 * i) = (f32x4){(base + v[4 * i]) * LOG2E, (base + v[4 * i + 1]) * LOG2E, (base + v[4 * i + 2]) * LOG2E, (base + v[4 * i + 3]) * LOG2E};
    __syncthreads();
}

constexpr int AT_KP = 176, AT_KB = 64 * AT_KP, AT_KS = 0, AT_VP = 192, AT_VB = 64 * AT_VP, AT_VT = 2 * AT_KB, AT_TBL = AT_VT + 2 * AT_VB, AT_END = AT_TBL + TBN * 4;
__device__ __forceinline__ int swap23(int i) { return (i & ~12) | ((i & 4) << 1) | ((i & 8) >> 1); }
#define MFMA32(A, B, C) __builtin_amdgcn_mfma_f32_32x32x16_bf16(A, B, C, 0, 0, 0)
#define MFMA_DRAIN2(x, y) asm volatile("s_nop 15\n\ts_nop 15\n\ts_nop 7" : "+v"(x), "+v"(y))
typedef float f32x2_t __attribute__((ext_vector_type(2))); typedef __bf16 bf16x2_t __attribute__((ext_vector_type(2)));
__device__ __forceinline__ float max3f(float a, float b, float c) { return __builtin_fmaxf(__builtin_fmaxf(a, b), c); }
__device__ __forceinline__ unsigned cvtpk(float lo, float hi) { const f32x2_t v = {lo, hi}; const bf16x2_t b = __builtin_convertvector(v, bf16x2_t); return __builtin_bit_cast(unsigned, b); }
__device__ __forceinline__ bf16x8 pack8(const f32x16& p, int s8) {
    u32x4 w; w.x = cvtpk(p[s8], p[s8 + 1]); w.y = cvtpk(p[s8 + 2], p[s8 + 3]); w.z = cvtpk(p[s8 + 4], p[s8 + 5]); w.w = cvtpk(p[s8 + 6], p[s8 + 7]);
    return __builtin_bit_cast(bf16x8, w);
}
__device__ __forceinline__ void split3(float x, float& b1, float& b2, float& b3) {
    b1 = bf2f(f2bf(x)); const float r = x - b1; b2 = bf2f(f2bf(r)); b3 = bf2f(f2bf(r - b2));
}
__device__ __forceinline__ void stage_kv(unsigned char* lds, int buf, int kv_s, int c_s, const u32x4& kreg, const u32x4& vreg) {
    *(u32x4*)(lds + AT_KS + buf * AT_KB + kv_s * AT_KP + 16 * c_s) = kreg;
    *(u32x4*)(lds + AT_VT + buf * AT_VB + kv_s * AT_VP + 16 * c_s) = vreg;
}
struct SMState { float mref, l; };
template <int NP>
__device__ __forceinline__ void softmax_step(f32x16 (&p)[NP], SMState& st, bool& refzero, f32x16 (&o)[2]) {
    float a = max3f(p[0][0], p[0][1], p[0][2]), b = max3f(p[0][3], p[0][4], p[0][5]);
    a = max3f(a, p[0][6], p[0][7]); b = max3f(b, p[0][8], p[0][9]); a = max3f(a, p[0][10], p[0][11]); b = max3f(b, p[0][12], p[0][13]); a = max3f(a, p[0][14], p[0][15]);
    if (NP == 2) { b = max3f(b, p[NP - 1][0], p[NP - 1][1]); a = max3f(a, p[NP - 1][2], p[NP - 1][3]); b = max3f(b, p[NP - 1][4], p[NP - 1][5]); a = max3f(a, p[NP - 1][6], p[NP - 1][7]);
        b = max3f(b, p[NP - 1][8], p[NP - 1][9]); a = max3f(a, p[NP - 1][10], p[NP - 1][11]); b = max3f(b, p[NP - 1][12], p[NP - 1][13]); a = max3f(a, p[NP - 1][14], p[NP - 1][15]); }
    const float rm = half_swap_max(fmaxf(a, b));
    if (__any(rm - st.mref > 20.f)) {
        const float nr = (rm - st.mref > 20.f) ? rm : st.mref;
        const float f = __builtin_amdgcn_exp2f(st.mref - nr);
        st.l *= f;
#pragma unroll
        for (int r = 0; r < 16; ++r) { o[0][r] *= f; o[1][r] *= f; }
        st.mref = nr; refzero = false;
    }
    if (!refzero) {
#pragma unroll
        for (int i = 0; i < NP; ++i)
#pragma unroll
            for (int r = 0; r < 16; ++r) p[i][r] -= st.mref;
    }
    float ps = 0.f;
#pragma unroll
    for (int i = 0; i < NP; ++i)
#pragma unroll
        for (int r = 0; r < 16; ++r) { const float e = __builtin_amdgcn_exp2f(p[i][r]); p[i][r] = e; ps += e; }
    st.l += ps;
}
typedef short v4i16_t __attribute__((ext_vector_type(4)));
__device__ __forceinline__ void load_vf(const unsigned char* lds, int buf, int lane, bf16x8 (&vf)[2][2][2]) {
    const int g = lane >> 4, i = lane & 15, q = i >> 2, p4 = i & 3;
    const LAS3 unsigned char* base = (const LAS3 unsigned char*)(lds + AT_VT + buf * AT_VB) + (8 * (g >> 1) + q) * AT_VP + (16 * (g & 1) + 4 * p4) * 2;
#pragma unroll
    for (int db = 0; db < 2; ++db)
#pragma unroll
        for (int hf = 0; hf < 2; ++hf)
#pragma unroll
            for (int s = 0; s < 2; ++s) {
                const LAS3 unsigned char* pp = base + (32 * hf + 16 * s) * AT_VP + 64 * db;
                const v4i16_t lo = __builtin_amdgcn_ds_read_tr16_b64_v4i16((LAS3 v4i16_t*)pp);
                const v4i16_t hi4 = __builtin_amdgcn_ds_read_tr16_b64_v4i16((LAS3 v4i16_t*)(pp + 4 * AT_VP));
                vf[db][hf][s] = (bf16x8){lo[0], lo[1], lo[2], lo[3], hi4[0], hi4[1], hi4[2], hi4[3]};
            }
}
__device__ __forceinline__ void pv_tile(const bf16x8 (&vf)[2][2][2], const f32x16 (&p)[2], f32x16 (&o)[2]) {
#pragma unroll
    for (int hf = 0; hf < 2; ++hf)
#pragma unroll
        for (int s = 0; s < 2; ++s) {
            const bf16x8 pf = pack8(p[hf], 8 * s);
#pragma unroll
            for (int db = 0; db < 2; ++db) o[db] = MFMA32(vf[db][hf][s], pf, o[db]);
        }
}
__device__ __forceinline__ void store_ot(bf16_t* dst, const f32x16 (&o)[2], float sc, int hi) {
#pragma unroll
    for (int db = 0; db < 2; ++db)
#pragma unroll
        for (int r4 = 0; r4 < 4; ++r4) {
            u32x2 w; w.x = cvtpk(o[db][4 * r4] * sc, o[db][4 * r4 + 1] * sc); w.y = cvtpk(o[db][4 * r4 + 2] * sc, o[db][4 * r4 + 3] * sc);
            *(u32x2*)(dst + 32 * db + 8 * r4 + 4 * hi) = w;
        }
}

__device__ __forceinline__ void fox_unit(const Args& a, unsigned char* lds, int layer, int bh, int qb) {
    int tid = threadIdx.x; asm volatile("" : "+v"(tid));
    const int lane = tid & 63, w = __builtin_amdgcn_readfirstlane(tid >> 6), qi = lane & 31, hi = lane >> 5;
    const int b = bh >> 2, h = bh & 3;
    const bf16_t* zb = (const bf16_t*)(a.ws + WS_ZB) + (size_t)b * S * ZP;
    const float* cum = (const float*)(a.ws + WS_CUM) + (size_t)bh * S;
    const int q0 = 256 * qb + 32 * w;
    const float cref = cum[256 * qb];
    bf16x8 qf[5];
#pragma unroll
    for (int ds = 0; ds < 4; ++ds) qf[ds] = *(const bf16x8*)(zb + (size_t)(q0 + qi) * ZP + ZC_FQ + 64 * h + 16 * ds + 8 * hi);
    { float q1, q2, q3; split3(cum[q0 + qi] - cref, q1, q2, q3);
      u32x4 e; e.x = hi ? 0u : 0x3f803f80u; e.y = hi ? 0u : (0x3f80u | ((unsigned)f2bf(q1) << 16)); e.z = hi ? 0u : ((unsigned)f2bf(q2) | ((unsigned)f2bf(q3) << 16)); e.w = 0u;
      qf[4] = __builtin_bit_cast(bf16x8, e); }
    const int ntiles = 4 * (qb + 1), mylast = 4 * qb + (w >> 1);
    const float thr = ((const float*)(a.ws + WS_FOXT))[layer];
    int kt0 = 0;
    {
        const bool sk = tid < 4 * qb && (cref - cum[64 * tid + 63]) < -thr;
        const unsigned long long bal = __ballot(sk);
        volatile LAS3 unsigned* cw = (volatile LAS3 unsigned*)(LAS3 unsigned char*)(lds + LDS_CTL + 64);
        if (lane == 0) cw[w] = (unsigned)__popcll(bal);
        __syncthreads();
#pragma unroll
        for (int i = 0; i < 8; ++i) kt0 += (int)cw[i];
        __syncthreads();
    }
    const int kv_s = 8 * w + (lane >> 3), c_s = lane & 7;
    const bf16_t* kp = zb + (size_t)kv_s * ZP + ZC_FK + 64 * h + 8 * c_s;
    const bf16_t* vp = zb + (size_t)kv_s * ZP + ZC_FV + 64 * h + 8 * c_s;
    u32x4 kreg = *(const u32x4*)(kp + (size_t)kt0 * 64 * ZP), vreg = *(const u32x4*)(vp + (size_t)kt0 * 64 * ZP);
    float dreg = (tid < 64) ? cum[kt0 * 64 + tid] : 0.f;
    SMState st; st.mref = 0.f; st.l = 0.f; bool refzero = true;
    f32x16 o[2]; o[0] = (f32x16){}; o[1] = (f32x16){};
    const int krow = swap23(qi);
#ifdef HK_FOX_NOSTAG
    const int grp = HK_FOX_NOSTAG - 1;
#else
    const int grp = w >> 2;
#endif
    f32x16 p[2];
#define FOX_QK(kt_, buf_) do { bf16x8 kf_[2][5]; \
        _Pragma("unroll") for (int hf = 0; hf < 2; ++hf) _Pragma("unroll") for (int ds = 0; ds < 5; ++ds) kf_[hf][ds] = *(const bf16x8*)(lds + AT_KS + (buf_) * AT_KB + (32 * hf + krow) * AT_KP + 32 * ds + 16 * hi); \
        _Pragma("unroll") for (int hf = 0; hf < 2; ++hf) { p[hf] = (f32x16){}; _Pragma("unroll") for (int ds = 0; ds < 5; ++ds) p[hf] = MFMA32(kf_[hf][ds], qf[ds], p[hf]); } \
        MFMA_DRAIN2(p[0], p[1]); \
        if (64 * (kt_) + 63 > q0) { const int lim = q0 + qi - 64 * (kt_) - 8 * hi; \
            _Pragma("unroll") for (int hf = 0; hf < 2; ++hf) _Pragma("unroll") for (int r = 0; r < 16; ++r) if (32 * hf + 16 * (r >> 3) + (r & 7) > lim) p[hf][r] = -INFINITY; } } while (0)
#define FOX_SMPV(buf_) do { bf16x8 vf_[2][2][2]; load_vf(lds, (buf_), lane, vf_); softmax_step<2>(p, st, refzero, o); pv_tile(vf_, p, o); } while (0)
    for (int kt = kt0; kt < ntiles; ++kt) {
        const int buf = kt & 1;
        stage_kv(lds, buf, kv_s, c_s, kreg, vreg);
        if (tid < 64) { float k1, k2, k3; split3(cref - dreg, k1, k2, k3);
            u32x4 e; e.x = (unsigned)f2bf(k1) | ((unsigned)f2bf(k2) << 16); e.y = (unsigned)f2bf(k3) | 0x3f800000u; e.z = 0x3f803f80u; e.w = 0u;
            unsigned char* kr = lds + AT_KS + buf * AT_KB + tid * AT_KP + 128;
            *(u32x4*)kr = e; *(u32x4*)(kr + 16) = (u32x4){0u, 0u, 0u, 0u}; }
        __syncthreads();
        if (kt + 1 < ntiles) {
            kreg = *(const u32x4*)(kp + (size_t)(kt + 1) * 64 * ZP); vreg = *(const u32x4*)(vp + (size_t)(kt + 1) * 64 * ZP);
            if (tid < 64) dreg = cum[(kt + 1) * 64 + tid];
        }
#ifdef HK_FOX_X2
        if (grp == 0) { if (kt <= mylast) FOX_QK(kt, buf); }
        __syncthreads();
        if (grp == 0) { if (kt <= mylast) FOX_SMPV(buf); }
        else { if (kt > kt0 && kt - 1 <= mylast) FOX_SMPV(buf ^ 1); if (kt <= mylast) FOX_QK(kt, buf); }
#else
        if (grp == 0) { if (kt <= mylast) FOX_QK(kt, buf); }
        else { if (kt > kt0 && kt - 1 <= mylast) FOX_SMPV(buf ^ 1); }
        __syncthreads();
        if (grp == 0) { if (kt <= mylast) FOX_SMPV(buf); }
        else { if (kt <= mylast) FOX_QK(kt, buf); }
#endif
#ifdef HK_FOX_B3
        __syncthreads();
#endif
    }
    if (grp == 1 && ntiles - 1 <= mylast) FOX_SMPV((ntiles - 1) & 1);
#undef FOX_QK
#undef FOX_SMPV
    const float l = half_swap_sum(st.l);
    store_ot((bf16_t*)(a.ws + WS_MIX) + (size_t)(b * S + q0 + qi) * D + 0 + 64 * h, o, 1.f / l, hi);
    __syncthreads();
}

__device__ __forceinline__ void fox64_unit(const Args& a, unsigned char* lds, int layer, int bh, int qb) {
    int tid = threadIdx.x; asm volatile("" : "+v"(tid));
    const int lane = tid & 63, w = __builtin_amdgcn_readfirstlane(tid >> 6), qi = lane & 31, hi = lane >> 5;
    const int b = bh >> 2, h = bh & 3;
    const bf16_t* zb = (const bf16_t*)(a.ws + WS_ZB) + (size_t)b * S * ZP;
    const float* cum = (const float*)(a.ws + WS_CUM) + (size_t)bh * S;
    const int q0 = 512 * qb + 64 * w;
    const float cref = cum[512 * qb];
    bf16x8 qfA[5], qfB[5];
#pragma unroll
    for (int ds = 0; ds < 4; ++ds) { qfA[ds] = *(const bf16x8*)(zb + (size_t)(q0 + qi) * ZP + ZC_FQ + 64 * h + 16 * ds + 8 * hi); qfB[ds] = *(const bf16x8*)(zb + (size_t)(q0 + 32 + qi) * ZP + ZC_FQ + 64 * h + 16 * ds + 8 * hi); }
#pragma unroll
    for (int blk = 0; blk < 2; ++blk) { float q1, q2, q3; split3(cum[q0 + 32 * blk + qi] - cref, q1, q2, q3);
      u32x4 e; e.x = hi ? 0u : 0x3f803f80u; e.y = hi ? 0u : (0x3f80u | ((unsigned)f2bf(q1) << 16)); e.z = hi ? 0u : ((unsigned)f2bf(q2) | ((unsigned)f2bf(q3) << 16)); e.w = 0u;
      if (blk == 0) qfA[4] = __builtin_bit_cast(bf16x8, e); else qfB[4] = __builtin_bit_cast(bf16x8, e); }
    const int ntiles = 8 * (qb + 1), mylast = 8 * qb + w;
    const float thr = ((const float*)(a.ws + WS_FOXT))[layer];
    int kt0 = 0;
    {   const bool sk = tid < 8 * qb && (cref - cum[64 * tid + 63]) < -thr;
        const unsigned long long bal = __ballot(sk);
        volatile LAS3 unsigned* cw = (volatile LAS3 unsigned*)(LAS3 unsigned char*)(lds + LDS_CTL + 64);
        if (lane == 0) cw[w] = (unsigned)__popcll(bal);
        __syncthreads();
#pragma unroll
        for (int i = 0; i < 8; ++i) kt0 += (int)cw[i];
        __syncthreads();
    }
    const int kv_s = 8 * w + (lane >> 3), c_s = lane & 7;
    const bf16_t* kp = zb + (size_t)kv_s * ZP + ZC_FK + 64 * h + 8 * c_s;
    const bf16_t* vp = zb + (size_t)kv_s * ZP + ZC_FV + 64 * h + 8 * c_s;
    u32x4 kreg = *(const u32x4*)(kp + (size_t)kt0 * 64 * ZP), vreg = *(const u32x4*)(vp + (size_t)kt0 * 64 * ZP);
    float dreg = (tid < 64) ? cum[kt0 * 64 + tid] : 0.f;
    SMState stA, stB; stA.mref = 0.f; stA.l = 0.f; stB.mref = 0.f; stB.l = 0.f; bool rzA = true, rzB = true;
    f32x16 oA[2], oB[2]; oA[0] = (f32x16){}; oA[1] = (f32x16){}; oB[0] = (f32x16){}; oB[1] = (f32x16){};
    const int krow = swap23(qi);
    for (int kt = kt0; kt < ntiles; ++kt) {
        const int buf = kt & 1;
        stage_kv(lds, buf, kv_s, c_s, kreg, vreg);
        if (tid < 64) { float k1, k2, k3; split3(cref - dreg, k1, k2, k3);
            u32x4 e; e.x = (unsigned)f2bf(k1) | ((unsigned)f2bf(k2) << 16); e.y = (unsigned)f2bf(k3) | 0x3f800000u; e.z = 0x3f803f80u; e.w = 0u;
            unsigned char* kr = lds + AT_KS + buf * AT_KB + tid * AT_KP + 128;
            *(u32x4*)kr = e; *(u32x4*)(kr + 16) = (u32x4){0u, 0u, 0u, 0u}; }
        __syncthreads();
        if (kt + 1 < ntiles) {
            kreg = *(const u32x4*)(kp + (size_t)(kt + 1) * 64 * ZP); vreg = *(const u32x4*)(vp + (size_t)(kt + 1) * 64 * ZP);
            if (tid < 64) dreg = cum[(kt + 1) * 64 + tid];
        }
        if (kt <= mylast) {
            f32x16 pA[2], pB[2];
#pragma unroll
            for (int hf = 0; hf < 2; ++hf) {
                pA[hf] = (f32x16){}; pB[hf] = (f32x16){};
#pragma unroll
                for (int ds = 0; ds < 5; ++ds) { const bf16x8 kf = *(const bf16x8*)(lds + AT_KS + buf * AT_KB + (32 * hf + krow) * AT_KP + 32 * ds + 16 * hi);
                    pA[hf] = MFMA32(kf, qfA[ds], pA[hf]); pB[hf] = MFMA32(kf, qfB[ds], pB[hf]); }
            }
            if (kt == mylast) {
                const int limA = qi - 8 * hi, limB = 32 + qi - 8 * hi;
#pragma unroll
                for (int hf = 0; hf < 2; ++hf)
#pragma unroll
                    for (int r = 0; r < 16; ++r) { const int kvo = 32 * hf + 16 * (r >> 3) + (r & 7); if (kvo > limA) pA[hf][r] = -INFINITY; if (kvo > limB) pB[hf][r] = -INFINITY; }
            }
            softmax_step<2>(pA, stA, rzA, oA); softmax_step<2>(pB, stB, rzB, oB);
            const int g_ = lane >> 4, i_ = lane & 15;
            const LAS3 unsigned char* vb_ = (const LAS3 unsigned char*)(lds + AT_VT + buf * AT_VB) + (8 * (g_ >> 1) + (i_ >> 2)) * AT_VP + (16 * (g_ & 1) + 4 * (i_ & 3)) * 2;
#pragma unroll
            for (int hf = 0; hf < 2; ++hf)
#pragma unroll
                for (int s = 0; s < 2; ++s) {
                    const bf16x8 fa = pack8(pA[hf], 8 * s), fb = pack8(pB[hf], 8 * s);
#pragma unroll
                    for (int db = 0; db < 2; ++db) {
                        const LAS3 unsigned char* pp = vb_ + (32 * hf + 16 * s) * AT_VP + 64 * db;
                        const v4i16_t lo = __builtin_amdgcn_ds_read_tr16_b64_v4i16((LAS3 v4i16_t*)pp);
                        const v4i16_t hi4 = __builtin_amdgcn_ds_read_tr16_b64_v4i16((LAS3 v4i16_t*)(pp + 4 * AT_VP));
                        const bf16x8 vf = (bf16x8){lo[0], lo[1], lo[2], lo[3], hi4[0], hi4[1], hi4[2], hi4[3]};
                        oA[db] = MFMA32(vf, fa, oA[db]); oB[db] = MFMA32(vf, fb, oB[db]);
                    }
                }
        }
    }
    const float lA = half_swap_sum(stA.l), lB = half_swap_sum(stB.l);
    bf16_t* mo = (bf16_t*)(a.ws + WS_MIX) + (size_t)(b * S + q0 + qi) * D + 64 * h;
    store_ot(mo, oA, 1.f / lA, hi);
    store_ot(mo + (size_t)32 * D, oB, 1.f / lB, hi);
    __syncthreads();
}

__device__ __forceinline__ void diff_unit(const Args& a, unsigned char* lds, int layer, int bh, int qb) {
    int tid = threadIdx.x; asm volatile("" : "+v"(tid));
    const int lane = tid & 63, w = __builtin_amdgcn_readfirstlane(tid >> 6), qi = lane & 31, hi = lane >> 5;
    const int b = bh >> 2, h = bh & 3;
    const bf16_t* zb = (const bf16_t*)(a.ws + WS_ZB) + (size_t)b * S * ZP;
    const int q0 = 256 * qb + 32 * w;
    {
        const float* tb = (const float*)(a.ws + WS_TB) + (size_t)(4 + h) * TBN; float* tl = (float*)(lds + AT_TBL);
        const float cb = tb[1600]; float tv[5];
#pragma unroll
        for (int k = 0; k < 5; ++k) { const int i = tid + NTHR * k; tv[k] = tb[i < TBN ? i : TBN - 1]; }
#pragma unroll
        for (int k = 0; k < 5; ++k) { const int i = tid + NTHR * k; if (i < TBN) tl[i] = tv[k] - cb; }
    }
    bf16x8 qf[2][2];
#pragma unroll
    for (int c = 0; c < 2; ++c)
#pragma unroll
        for (int ds = 0; ds < 2; ++ds) qf[c][ds] = *(const bf16x8*)(zb + (size_t)(q0 + qi) * ZP + ZC_CQ + 64 * h + 32 * c + 16 * ds + 8 * hi);
    const int ntiles = 4 * (qb + 1), mylast = 4 * qb + (w >> 1);
    const int kv_s = 8 * w + (lane >> 3), c_s = lane & 7;
    const bf16_t* kp = zb + (size_t)kv_s * ZP + ZC_CK + 64 * h + 8 * c_s;
    const bf16_t* vp = zb + (size_t)kv_s * ZP + ZC_CV + 64 * h + 8 * c_s;
    u32x4 kreg = *(const u32x4*)kp, vreg = *(const u32x4*)vp;
    SMState st[2]; st[0].mref = 0.f; st[0].l = 0.f; st[1].mref = 0.f; st[1].l = 0.f; bool rz0 = true, rz1 = true;
    f32x16 o[2][2];
#pragma unroll
    for (int c = 0; c < 2; ++c) { o[c][0] = (f32x16){}; o[c][1] = (f32x16){}; }
    const int krow = swap23(qi);
    const float* tl = (const float*)(lds + AT_TBL);
    for (int kt = 0; kt < ntiles; ++kt) {
        const int buf = kt & 1;
        stage_kv(lds, buf, kv_s, c_s, kreg, vreg);
        __syncthreads();
        if (kt + 1 < ntiles) { kreg = *(const u32x4*)(kp + (size_t)(kt + 1) * 64 * ZP); vreg = *(const u32x4*)(vp + (size_t)(kt + 1) * 64 * ZP); }
        if (kt <= mylast) {
            const bool far_ = q0 - (64 * kt + 63) >= 1513;
            const bool diag = 64 * kt + 63 > q0;
            const int dq = q0 + qi - 64 * kt - 8 * hi;
#pragma unroll
            for (int hf = 0; hf < 2; ++hf) {
                f32x16 p0[1], p1[1]; p0[0] = (f32x16){}; p1[0] = (f32x16){};
                bf16x8 vf[2][2];
                { const int g_ = lane >> 4, i_ = lane & 15;
                  const LAS3 unsigned char* vb_ = (const LAS3 unsigned char*)(lds + AT_VT + buf * AT_VB) + (32 * hf + 8 * (g_ >> 1) + (i_ >> 2)) * AT_VP + (16 * (g_ & 1) + 4 * (i_ & 3)) * 2;
#pragma unroll
                  for (int s = 0; s < 2; ++s)
#pragma unroll
                      for (int db = 0; db < 2; ++db) {
                          const v4i16_t lo = __builtin_amdgcn_ds_read_tr16_b64_v4i16((LAS3 v4i16_t*)(vb_ + 16 * s * AT_VP + 64 * db));
                          const v4i16_t hi4 = __builtin_amdgcn_ds_read_tr16_b64_v4i16((LAS3 v4i16_t*)(vb_ + (16 * s + 4) * AT_VP + 64 * db));
                          vf[s][db] = (bf16x8){lo[0], lo[1], lo[2], lo[3], hi4[0], hi4[1], hi4[2], hi4[3]};
                      } }
#pragma unroll
                for (int ds = 0; ds < 2; ++ds) {
                    const bf16x8 k0 = *(const bf16x8*)(lds + AT_KS + buf * AT_KB + (32 * hf + krow) * AT_KP + 32 * ds + 16 * hi);
                    const bf16x8 k1 = *(const bf16x8*)(lds + AT_KS + buf * AT_KB + (32 * hf + krow) * AT_KP + 64 + 32 * ds + 16 * hi);
                    p0[0] = MFMA32(k0, qf[0][ds], p0[0]); p1[0] = MFMA32(k1, qf[1][ds], p1[0]);
                }
                MFMA_DRAIN2(p0[0], p1[0]);
                if (!far_) {
                    if (diag) {
#pragma unroll
                        for (int r = 0; r < 16; ++r) {
                            const int dist = dq - (32 * hf + 16 * (r >> 3) + (r & 7));
                            const float bb = tl[dist < 0 ? 0 : dist];
                            const bool ok = dist >= 0;
                            p0[0][r] = ok ? p0[0][r] + bb : -INFINITY; p1[0][r] = ok ? p1[0][r] + bb : -INFINITY;
                        }
                    } else {
#pragma unroll
                        for (int r = 0; r < 16; ++r) { const float bb = tl[dq - (32 * hf + 16 * (r >> 3) + (r & 7))]; p0[0][r] += bb; p1[0][r] += bb; }
                    }
                }
                softmax_step<1>(p0, st[0], rz0, o[0]); softmax_step<1>(p1, st[1], rz1, o[1]);
#pragma unroll
                for (int s = 0; s < 2; ++s) {
                    const bf16x8 f0 = pack8(p0[0], 8 * s), f1 = pack8(p1[0], 8 * s);
#pragma unroll
                    for (int db = 0; db < 2; ++db) { o[0][db] = MFMA32(vf[s][db], f0, o[0][db]); o[1][db] = MFMA32(vf[s][db], f1, o[1][db]); }
                }
            }
        }
    }
    const float lam_init = 0.8f - 0.6f * __expf(-0.3f * (float)layer);
    const float* lp = a.in[12] + layer * 128;
    float s1 = 0.f, s2 = 0.f;
    for (int i = 0; i < 32; ++i) { s1 += lp[i] * lp[32 + i]; s2 += lp[64 + i] * lp[96 + i]; }
    const float lam = __expf(s1) - __expf(s2) + lam_init;
    const float i0 = 1.f / half_swap_sum(st[0].l), i1 = lam / half_swap_sum(st[1].l);
    float ss = 0.f;
#pragma unroll
    for (int db = 0; db < 2; ++db)
#pragma unroll
        for (int r = 0; r < 16; ++r) { const float v = o[0][db][r] * i0 - o[1][db][r] * i1; o[0][db][r] = v; ss += v * v; }
    ss = half_swap_sum(ss);
    const float rn = __builtin_amdgcn_rsqf(ss * (1.f / 64.f) + EPS) * (1.f - lam_init);
    const float* gn = a.in[13] + layer * 64;
#pragma unroll
    for (int db = 0; db < 2; ++db)
#pragma unroll
        for (int r = 0; r < 16; ++r) o[0][db][r] *= gn[32 * db + (r & 3) + 8 * (r >> 2) + 4 * hi];
    store_ot((bf16_t*)(a.ws + WS_MIX) + (size_t)(b * S + q0 + qi) * D + 512 + 64 * h, o[0], rn, hi);
    __syncthreads();
}

__device__ __forceinline__ void dil_unit(const Args& a, unsigned char* lds, int bh, int br, int rho, int tile) {
    int tid = threadIdx.x; asm volatile("" : "+v"(tid));
    const int lane = tid & 63, w = __builtin_amdgcn_readfirstlane(tid >> 6), qi = lane & 31, hi = lane >> 5;
    const int b = bh >> 2, h = bh & 3;
    const int r = br == 0 ? 1 : (br == 1 ? 4 : 16);
    const bf16_t* zb = (const bf16_t*)(a.ws + WS_ZB) + (size_t)b * S * ZP;
    {   const float* tb = (const float*)(a.ws + WS_TB) + (size_t)h * TBN; float* tl = (float*)(lds + AT_TBL); float tv[5];
#pragma unroll
        for (int k = 0; k < 5; ++k) { const int i = tid + NTHR * k; tv[k] = tb[i < TBN ? i : TBN - 1]; }
#pragma unroll
        for (int k = 0; k < 5; ++k) { const int i = tid + NTHR * k; if (i < TBN) tl[i] = tv[k]; }
    }
    const int l0 = 256 * tile, lq0 = l0 + 32 * w;
    const int tq = (lq0 + qi) * r + rho;
    bf16x8 qf[4];
#pragma unroll
    for (int ds = 0; ds < 4; ++ds) qf[ds] = *(const bf16x8*)(zb + (size_t)tq * ZP + ZC_DQ + 64 * h + 16 * ds + 8 * hi);
    const int kv_s = 8 * w + (lane >> 3), c_s = lane & 7;
    const int j0 = (l0 == 0) ? 2 : 0;
    auto krow_of = [&](int j) { int kl = l0 - 128 + 64 * j + kv_s; kl = kl < 0 ? 0 : kl; return (size_t)(kl * r + rho) * ZP; };
    u32x4 kreg = *(const u32x4*)(zb + krow_of(j0) + ZC_DK + 64 * h + 8 * c_s), vreg = *(const u32x4*)(zb + krow_of(j0) + ZC_DV + 64 * h + 8 * c_s);
    SMState st; st.mref = 0.f; st.l = 0.f; bool refzero = true;
    f32x16 o[2]; o[0] = (f32x16){}; o[1] = (f32x16){};
    const int krow = swap23(qi);
    const float* tl = (const float*)(lds + AT_TBL);
    for (int j = j0; j < 6; ++j) {
        const int buf = j & 1;
        stage_kv(lds, buf, kv_s, c_s, kreg, vreg);
        __syncthreads();
        if (j + 1 < 6) { kreg = *(const u32x4*)(zb + krow_of(j + 1) + ZC_DK + 64 * h + 8 * c_s); vreg = *(const u32x4*)(zb + krow_of(j + 1) + ZC_DV + 64 * h + 8 * c_s); }
        const int kl0 = l0 - 128 + 64 * j;
#pragma unroll
        for (int hf = 0; hf < 2; ++hf) {
            const int kh0 = kl0 + 32 * hf;
            if (kh0 <= lq0 + 31 && kh0 + 31 >= lq0 - 128 && kh0 + 31 >= 0) {
                f32x16 p[1]; p[0] = (f32x16){};
                bf16x8 kf[4];
#pragma unroll
                for (int ds = 0; ds < 4; ++ds) kf[ds] = *(const bf16x8*)(lds + AT_KS + buf * AT_KB + (32 * hf + krow) * AT_KP + 32 * ds + 16 * hi);
                bf16x8 vf[2][2];
                { const int g_ = lane >> 4, i_ = lane & 15;
                  const LAS3 unsigned char* vb_ = (const LAS3 unsigned char*)(lds + AT_VT + buf * AT_VB) + (32 * hf + 8 * (g_ >> 1) + (i_ >> 2)) * AT_VP + (16 * (g_ & 1) + 4 * (i_ & 3)) * 2;
#pragma unroll
                  for (int s = 0; s < 2; ++s)
#pragma unroll
                      for (int db = 0; db < 2; ++db) {
                          const v4i16_t lo = __builtin_amdgcn_ds_read_tr16_b64_v4i16((LAS3 v4i16_t*)(vb_ + 16 * s * AT_VP + 64 * db));
                          const v4i16_t hi4 = __builtin_amdgcn_ds_read_tr16_b64_v4i16((LAS3 v4i16_t*)(vb_ + (16 * s + 4) * AT_VP + 64 * db));
                          vf[s][db] = (bf16x8){lo[0], lo[1], lo[2], lo[3], hi4[0], hi4[1], hi4[2], hi4[3]};
                      } }
#pragma unroll
                for (int ds = 0; ds < 4; ++ds) p[0] = MFMA32(kf[ds], qf[ds], p[0]);
                const int dq = lq0 + qi - kh0 - 8 * hi;
#pragma unroll
                for (int rr = 0; rr < 16; ++rr) {
                    const int kvoff = 16 * (rr >> 3) + (rr & 7);
                    const int dd = dq - kvoff;
                    const bool ok = dd >= 0 && dd <= 128 && (kh0 + 8 * hi + kvoff) >= 0;
                    const float bb = tl[ok ? dd * r : 0];
                    p[0][rr] = ok ? p[0][rr] + bb : -INFINITY;
                }
                softmax_step<1>(p, st, refzero, o);
#pragma unroll
                for (int s = 0; s < 2; ++s) {
                    const bf16x8 pf = pack8(p[0], 8 * s);
#pragma unroll
                    for (int db = 0; db < 2; ++db) o[db] = MFMA32(vf[s][db], pf, o[db]);
                }
            }
        }
    }
    const float l = half_swap_sum(st.l);
    const size_t tok = (size_t)b * S + tq;
    store_ot((bf16_t*)(a.ws + WS_DPART) + ((size_t)br * T + tok) * 256 + 64 * h, o, 1.f / l, hi);
    if (hi == 0) ((float*)(a.ws + WS_DLSE))[((size_t)br * T + tok) * 4 + h] = st.mref + __builtin_amdgcn_logf(l);
    __syncthreads();
}
}
namespace hk {
struct S5P { float abr, abi, bbr[16], bbi[16]; };
__device__ __forceinline__ void s5_params(const Args& a, int layer, int g, int n, S5P& P, float& dtar, float& dtai) {
    const int lg = layer * 16 + g;
    const float dt = expf(a.in[17][lg]);
    const float ar = a.in[15][lg * 64 + n], ai = a.in[16][lg * 64 + n];
    dtar = dt * ar; dtai = dt * ai;
    const float mag = expf(dtar);
    P.abr = mag * cosf(dtai); P.abi = mag * sinf(dtai);
    const float den = ar * ar + ai * ai, nr = P.abr - 1.f, ni = P.abi;
    const float cr = (nr * ar + ni * ai) / den, ci = (ni * ar - nr * ai) / den;
    const float* brp = a.in[18] + ((size_t)lg * 64 + n) * 16; const float* bip = a.in[19] + ((size_t)lg * 64 + n) * 16;
#pragma unroll
    for (int c = 0; c < 16; ++c) { const float br = brp[c], bi = bip[c]; P.bbr[c] = cr * br - ci * bi; P.bbi[c] = cr * bi + ci * br; }
}
__device__ __forceinline__ void s5_step(const S5P& P, const LAS3 float* up, float& xr, float& xi) {
    const f32x4 u0 = *(const LAS3 f32x4*)(up), u1 = *(const LAS3 f32x4*)(up + 4), u2 = *(const LAS3 f32x4*)(up + 8), u3 = *(const LAS3 f32x4*)(up + 12);
    float r0 = P.bbr[0] * u0[0], r1 = P.bbr[4] * u1[0], r2 = P.bbr[8] * u2[0], r3 = P.bbr[12] * u3[0];
    float i0 = P.bbi[0] * u0[0], i1 = P.bbi[4] * u1[0], i2 = P.bbi[8] * u2[0], i3 = P.bbi[12] * u3[0];
    r0 += P.bbr[1] * u0[1]; r1 += P.bbr[5] * u1[1]; r2 += P.bbr[9] * u2[1]; r3 += P.bbr[13] * u3[1];
    i0 += P.bbi[1] * u0[1]; i1 += P.bbi[5] * u1[1]; i2 += P.bbi[9] * u2[1]; i3 += P.bbi[13] * u3[1];
    r0 += P.bbr[2] * u0[2]; r1 += P.bbr[6] * u1[2]; r2 += P.bbr[10] * u2[2]; r3 += P.bbr[14] * u3[2];
    i0 += P.bbi[2] * u0[2]; i1 += P.bbi[6] * u1[2]; i2 += P.bbi[10] * u2[2]; i3 += P.bbi[14] * u3[2];
    r0 += P.bbr[3] * u0[3]; r1 += P.bbr[7] * u1[3]; r2 += P.bbr[11] * u2[3]; r3 += P.bbr[15] * u3[3];
    i0 += P.bbi[3] * u0[3]; i1 += P.bbi[7] * u1[3]; i2 += P.bbi[11] * u2[3]; i3 += P.bbi[15] * u3[3];
    const float pr = (r0 + r1) + (r2 + r3), pi = (i0 + i1) + (i2 + i3);
    const float nxr = P.abr * xr - P.abi * xi + pr, nxi = P.abr * xi + P.abi * xr + pi;
    xr = nxr; xi = nxi;
}
__device__ __forceinline__ void s5_wave_operands(const Args& a, int layer, int w, int qi, int hi, bf16x8 (&bre)[2][2], bf16x8 (&bim)[2][2], f32x4 (&ab)[2]) {
#pragma unroll
    for (int gg = 0; gg < 2; ++gg) {
        const int lg = layer * 16 + 2 * w + gg;
#pragma unroll
        for (int sh = 0; sh < 2; ++sh) {
            const bf16_t* pb = (const bf16_t*)(a.ws + WS_S5B) + ((size_t)(lg * 2) * 64 + qi + 32 * sh) * 16 + 8 * hi;
            bre[gg][sh] = *(const bf16x8*)pb; bim[gg][sh] = *(const bf16x8*)(pb + 64 * 16);
        }
    }
#pragma unroll
    for (int sh = 0; sh < 2; ++sh) ab[sh] = ((const f32x4*)(a.ws + WS_S5A))[(layer * 16 + 2 * w + hi) * 64 + qi + 32 * sh];
}
#define S5_MFMA32(a, b, c) __builtin_amdgcn_mfma_f32_32x32x16_bf16(a, b, c, 0, 0, 0)
__device__ __forceinline__ void s5_state_params(const Args& a, int layer, int g, int st, float& abr, float& abi, float& cr, float& ci, float& dtar, float& dtai) {
    const int lg = layer * 16 + g;
    const float dt = expf(a.in[17][lg]);
    const float ar = a.in[15][lg * 64 + st], ai = a.in[16][lg * 64 + st];
    dtar = dt * ar; dtai = dt * ai;
    const float mag = expf(dtar);
    abr = mag * cosf(dtai); abi = mag * sinf(dtai);
    const float den = ar * ar + ai * ai, nr = abr - 1.f, ni = abi;
    cr = (nr * ar + ni * ai) / den; ci = (ni * ar - nr * ai) / den;
}
__device__ __forceinline__ void s5_wave_operands_v82(const Args& a, int layer, int w, int qi, int hi, bf16x8 (&bre)[2][2], bf16x8 (&bim)[2][2], float (&abr)[2], float (&abi)[2], float (&dtr)[2], float (&dti)[2]) {
#pragma unroll
    for (int gg = 0; gg < 2; ++gg) {
        const int g = 2 * w + gg, lg = layer * 16 + g;
#pragma unroll
        for (int sh = 0; sh < 2; ++sh) {
            const int st = qi + 32 * sh;
            float ar_, ai_, cr, ci, dtar, dtai; s5_state_params(a, layer, g, st, ar_, ai_, cr, ci, dtar, dtai);
            const float* brp = a.in[18] + ((size_t)lg * 64 + st) * 16 + 8 * hi; const float* bip = a.in[19] + ((size_t)lg * 64 + st) * 16 + 8 * hi;
            float vr[8], vi[8];
#pragma unroll
            for (int c = 0; c < 8; ++c) { const float br = brp[c], bi = bip[c]; vr[c] = cr * br - ci * bi; vi[c] = cr * bi + ci * br; }
            u32x4 pr, pi; pr.x = pk2(vr[0], vr[1]); pr.y = pk2(vr[2], vr[3]); pr.z = pk2(vr[4], vr[5]); pr.w = pk2(vr[6], vr[7]);
            pi.x = pk2(vi[0], vi[1]); pi.y = pk2(vi[2], vi[3]); pi.z = pk2(vi[4], vi[5]); pi.w = pk2(vi[6], vi[7]);
            bre[gg][sh] = __builtin_bit_cast(bf16x8, pr); bim[gg][sh] = __builtin_bit_cast(bf16x8, pi);
            if (gg == hi) { abr[sh] = ar_; abi[sh] = ai_; dtr[sh] = dtar; dti[sh] = dtai; }
        }
    }
}
__device__ __forceinline__ void s5_pass1_unit(const Args& a, unsigned char* lds, int layer, int b, int c) {
    int tid = threadIdx.x; asm volatile("" : "+v"(tid));
    const int lane = tid & 63, w = __builtin_amdgcn_readfirstlane(tid >> 6), qi = lane & 31, hi = lane >> 5;
    const bf16_t* su = (const bf16_t*)(a.ws + WS_SU) + ((size_t)b * S + c * S5_TC) * 256;
    float* sst = (float*)(a.ws + WS_SST);
    const int ag = (qi >> 2) & 1;
    const bf16_t* aup = su + (size_t)(4 * (qi >> 3) + (qi & 3)) * 256 + 32 * w + 16 * ag + 8 * hi;
    u32x4 an = *(const u32x4*)aup;
    bf16x8 bre[2][2], bim[2][2]; float abr[2], abi[2], dtr[2], dti[2];
    s5_wave_operands_v82(a, layer, w, qi, hi, bre, bim, abr, abi, dtr, dti);
    float xr[2] = {0.f, 0.f}, xi[2] = {0.f, 0.f};
#pragma unroll
    for (int blk = 0; blk < 4; ++blk) {
        const u32x4 zero4 = (u32x4){0u, 0u, 0u, 0u};
        const bf16x8 a1 = __builtin_bit_cast(bf16x8, ag ? zero4 : an), a2 = __builtin_bit_cast(bf16x8, ag ? an : zero4);
        if (blk < 3) an = *(const u32x4*)(aup + (size_t)(blk + 1) * 16 * 256);
        f32x16 dre[2], dim[2];
#pragma unroll
        for (int sh = 0; sh < 2; ++sh) {
            dre[sh] = S5_MFMA32(a1, bre[0][sh], (f32x16){}); dre[sh] = S5_MFMA32(a2, bre[1][sh], dre[sh]);
            dim[sh] = S5_MFMA32(a1, bim[0][sh], (f32x16){}); dim[sh] = S5_MFMA32(a2, bim[1][sh], dim[sh]);
        }
#pragma unroll
        for (int tt = 0; tt < 16; ++tt)
#pragma unroll
            for (int sh = 0; sh < 2; ++sh) {
                const float nxr = abr[sh] * xr[sh] - abi[sh] * xi[sh] + dre[sh][tt], nxi = abr[sh] * xi[sh] + abi[sh] * xr[sh] + dim[sh][tt];
                xr[sh] = nxr; xi[sh] = nxi;
            }
    }
    float* sp = sst + (((size_t)b * 16 + 2 * w + hi) * S5_NCH + c) * 128;
#pragma unroll
    for (int sh = 0; sh < 2; ++sh) { sp[qi + 32 * sh] = xr[sh]; sp[64 + qi + 32 * sh] = xi[sh]; }
}
constexpr int P3_XS = 0, P3_XS_W = 2 * 16 * 272, P3_GS = 8 * P3_XS_W, P3_GS_P = 528, P3_US = P3_GS + 64 * P3_GS_P, P3_END = P3_US + 8 * 2048;
__device__ __forceinline__ void s5_pass2_unit(const Args& a, unsigned char* lds, int layer, int b, int seg) {
    int tid = threadIdx.x; asm volatile("" : "+v"(tid));
    const int lane = tid & 63, w = __builtin_amdgcn_readfirstlane(tid >> 6);
    const int qi = lane & 31, hi = lane >> 5, l15 = lane & 15, kg = lane >> 4;
    const bf16_t* su = (const bf16_t*)(a.ws + WS_SU) + ((size_t)b * S + seg * 256) * 256;
    const float* sst = (const float*)(a.ws + WS_SST);
    bf16x8 bre[2][2], bim[2][2]; float abr[2], abi[2], xr[2], xi[2]; bf16x8 cm[2][4]; f32x4 dsk[2];
    {
        f32x4 ab[2];
        s5_wave_operands(a, layer, w, qi, hi, bre, bim, ab);
        float cr2[2] = {0.f, 0.f}, ci2[2] = {0.f, 0.f};
#pragma unroll
        for (int sh = 0; sh < 2; ++sh) { abr[sh] = ab[sh][0]; abi[sh] = ab[sh][1]; }
        const float* sp = sst + (((size_t)b * 16 + 2 * w + hi) * S5_NCH) * 128 + qi;
        const int nprev = 4 * seg;
        int j0 = 0;
        for (; j0 + 8 <= nprev; j0 += 8) {
            float sr[2][8], si[2][8];
#pragma unroll
            for (int u = 0; u < 8; ++u)
#pragma unroll
                for (int sh = 0; sh < 2; ++sh) { sr[sh][u] = sp[(size_t)(j0 + u) * 128 + 32 * sh]; si[sh][u] = sp[(size_t)(j0 + u) * 128 + 64 + 32 * sh]; }
#pragma unroll
            for (int u = 0; u < 8; ++u)
#pragma unroll
                for (int sh = 0; sh < 2; ++sh) { const float t0 = ab[sh][2] * cr2[sh] - ab[sh][3] * ci2[sh] + sr[sh][u], t1 = ab[sh][2] * ci2[sh] + ab[sh][3] * cr2[sh] + si[sh][u]; cr2[sh] = t0; ci2[sh] = t1; }
        }
        if (j0 < nprev) {
            float sr[2][4], si[2][4];
#pragma unroll
            for (int u = 0; u < 4; ++u)
#pragma unroll
                for (int sh = 0; sh < 2; ++sh) { sr[sh][u] = sp[(size_t)(j0 + u) * 128 + 32 * sh]; si[sh][u] = sp[(size_t)(j0 + u) * 128 + 64 + 32 * sh]; }
#pragma unroll
            for (int u = 0; u < 4; ++u)
#pragma unroll
                for (int sh = 0; sh < 2; ++sh) { const float t0 = ab[sh][2] * cr2[sh] - ab[sh][3] * ci2[sh] + sr[sh][u], t1 = ab[sh][2] * ci2[sh] + ab[sh][3] * cr2[sh] + si[sh][u]; cr2[sh] = t0; ci2[sh] = t1; }
        }
#pragma unroll
        for (int sh = 0; sh < 2; ++sh) { xr[sh] = cr2[sh]; xi[sh] = ci2[sh]; }
    }
#pragma unroll
    for (int gg = 0; gg < 2; ++gg) {
        const int g = 2 * w + gg, lg = layer * 16 + g;
        const float* crp = a.in[20] + ((size_t)lg * 16 + l15) * 64; const float* cip = a.in[21] + ((size_t)lg * 16 + l15) * 64;
#pragma unroll
        for (int ks = 0; ks < 4; ++ks) {
            const int k0 = 32 * ks + 8 * kg;
            float v[8];
#pragma unroll
            for (int j = 0; j < 8; ++j) v[j] = (k0 < 64) ? crp[k0 + j] : -cip[k0 - 64 + j];
            u32x4 pw; pw.x = pk2(v[0], v[1]); pw.y = pk2(v[2], v[3]); pw.z = pk2(v[4], v[5]); pw.w = pk2(v[6], v[7]);
            cm[gg][ks] = __builtin_bit_cast(bf16x8, pw);
        }
        dsk[gg] = *(const f32x4*)(a.in[22] + lg * 16 + 4 * kg);
    }
    unsigned char* xs = lds + P3_XS + w * P3_XS_W;
    const bf16_t* gluT = (const bf16_t*)(a.ws + WS_GLU) + (size_t)layer * 65536;
    const float* glub = a.in[24] + layer * 256;
    bf16_t* mix = (bf16_t*)(a.ws + WS_MIX) + ((size_t)b * S + seg * 256) * D + 768;
    LAS3 float* ul = (LAS3 float*)(LAS3 unsigned char*)(lds + P3_US + w * 2048);
    const int utq = lane >> 3, ucc = lane & 7;
    const bf16_t* sup = su + (size_t)utq * 256 + 32 * w + 4 * ucc;
    u32x2 un0 = *(const u32x2*)(sup), un1 = *(const u32x2*)(sup + (size_t)8 * 256);
    const int ag = (qi >> 2) & 1;
    const bf16_t* aup = su + (size_t)(4 * (qi >> 3) + (qi & 3)) * 256 + 32 * w + 16 * ag + 8 * hi;
    u32x4 an = *(const u32x4*)aup;
#define S5_UNPK(v) (f32x4){__uint_as_float((v).x << 16), __uint_as_float((v).x & 0xffff0000u), __uint_as_float((v).y << 16), __uint_as_float((v).y & 0xffff0000u)}
    for (int sub = 0; sub < 4; ++sub) {
        for (int blk = 0; blk < 4; ++blk) {
            const int t0 = sub * 64 + blk * 16;
            *(LAS3 f32x4*)(ul + utq * 32 + 4 * ucc) = S5_UNPK(un0); *(LAS3 f32x4*)(ul + (8 + utq) * 32 + 4 * ucc) = S5_UNPK(un1);
            if (t0 + 16 < 256) { un0 = *(const u32x2*)(sup + (size_t)(t0 + 16) * 256); un1 = *(const u32x2*)(sup + (size_t)(t0 + 24) * 256); }
            {
                const u32x4 zero4 = (u32x4){0u, 0u, 0u, 0u};
                const bf16x8 a1 = __builtin_bit_cast(bf16x8, ag ? zero4 : an), a2 = __builtin_bit_cast(bf16x8, ag ? an : zero4);
                if (t0 + 16 < 256) an = *(const u32x4*)(aup + (size_t)(t0 + 16) * 256);
                f32x16 dre[2], dim[2];
#pragma unroll
                for (int sh = 0; sh < 2; ++sh) {
                    dre[sh] = MFMA32(a1, bre[0][sh], (f32x16){}); dre[sh] = MFMA32(a2, bre[1][sh], dre[sh]);
                    dim[sh] = MFMA32(a1, bim[0][sh], (f32x16){}); dim[sh] = MFMA32(a2, bim[1][sh], dim[sh]);
                }
                bf16_t* xp0 = (bf16_t*)(xs + hi * (16 * 272));
#pragma unroll
                for (int tt = 0; tt < 16; ++tt) {
#pragma unroll
                    for (int sh = 0; sh < 2; ++sh) {
                        const float nxr = abr[sh] * xr[sh] - abi[sh] * xi[sh] + dre[sh][tt], nxi = abr[sh] * xi[sh] + abi[sh] * xr[sh] + dim[sh][tt];
                        xr[sh] = nxr; xi[sh] = nxi;
                        bf16_t* xp = xp0 + tt * 136;
                        xp[qi + 32 * sh] = f2bf(nxr); xp[64 + qi + 32 * sh] = f2bf(nxi);
                    }
                }
            }
#pragma unroll
            for (int gg = 0; gg < 2; ++gg) {
                const int g = 2 * w + gg;
                f32x4 acc = (f32x4){0.f, 0.f, 0.f, 0.f};
#pragma unroll
                for (int ks = 0; ks < 4; ++ks) { const bf16x8 bfr = *(const bf16x8*)(xs + gg * (16 * 272) + l15 * 272 + (32 * ks + 8 * kg) * 2); acc = __builtin_amdgcn_mfma_f32_16x16x32_bf16(cm[gg][ks], bfr, acc, 0, 0, 0); }
                const f32x4 uu = *(const LAS3 f32x4*)(ul + l15 * 32 + 16 * gg + 4 * kg);
                u32x2 gw; gw.x = pk2(gelu_tanh(acc[0] + dsk[gg][0] * uu[0]), gelu_tanh(acc[1] + dsk[gg][1] * uu[1])); gw.y = pk2(gelu_tanh(acc[2] + dsk[gg][2] * uu[2]), gelu_tanh(acc[3] + dsk[gg][3] * uu[3]));
                *(u32x2*)(lds + P3_GS + (blk * 16 + l15) * P3_GS_P + (g * 16 + 4 * kg) * 2) = gw;
            }
        }
        __syncthreads();
#pragma unroll
        for (int tb = 0; tb < 2; ++tb) {
            f32x16 acc = (f32x16){};
#pragma unroll
            for (int ks = 0; ks < 16; ++ks) {
                const bf16x8 af = *(const bf16x8*)(gluT + (size_t)(32 * w + qi) * 256 + 16 * ks + 8 * hi);
                const bf16x8 bfr = *(const bf16x8*)(lds + P3_GS + (32 * tb + qi) * P3_GS_P + (16 * ks + 8 * hi) * 2);
                acc = MFMA32(af, bfr, acc);
            }
#pragma unroll
            for (int r4 = 0; r4 < 4; ++r4) {
                const int nn = 32 * w + 8 * r4 + 4 * hi;
                const u32x2 gq = *(const u32x2*)(lds + P3_GS + (32 * tb + qi) * P3_GS_P + nn * 2);
                const f32x4 bb = *(const f32x4*)(glub + nn);
                float ov[4];
#pragma unroll
                for (int e = 0; e < 4; ++e) {
                    const float gval = __uint_as_float(((e & 1) ? (((e >> 1) ? gq.y : gq.x) & 0xffff0000u) : (((e >> 1) ? gq.y : gq.x) << 16)));
                    ov[e] = gval / (1.f + __expf(-(acc[4 * r4 + e] + bb[e])));
                }
                u32x2 ow; ow.x = pk2(ov[0], ov[1]); ow.y = pk2(ov[2], ov[3]);
                *(u32x2*)(mix + (size_t)(sub * 64 + 32 * tb + qi) * D + nn) = ow;
            }
        }
        __syncthreads();
    }
}
__device__ __forceinline__ void phase_p3_elementwise(const Args& a, int layer) {
    const size_t gt = (size_t)blockIdx.x * NTHR + threadIdx.x, gn = (size_t)gridDim.x * NTHR;
    const bf16_t* dp = (const bf16_t*)(a.ws + WS_DPART); const float* dl = (const float*)(a.ws + WS_DLSE); bf16_t* mix = (bf16_t*)(a.ws + WS_MIX);
    for (size_t i = gt; i < (size_t)T * 32; i += gn) {
        const size_t tok = i >> 5; const int ch = (int)(i & 31), h = ch >> 3;
        const float l0 = dl[tok * 4 + h], l1 = dl[((size_t)T + tok) * 4 + h], l2 = dl[((size_t)2 * T + tok) * 4 + h];
        const float mx = fmaxf(l0, fmaxf(l1, l2));
        float w0 = __builtin_amdgcn_exp2f(l0 - mx), w1 = __builtin_amdgcn_exp2f(l1 - mx), w2 = __builtin_amdgcn_exp2f(l2 - mx);
        const float inv = 1.f / (w0 + w1 + w2); w0 *= inv; w1 *= inv; w2 *= inv;
        const u32x4 a0 = *(const u32x4*)(dp + tok * 256 + ch * 8), a1 = *(const u32x4*)(dp + ((size_t)T + tok) * 256 + ch * 8), a2 = *(const u32x4*)(dp + ((size_t)2 * T + tok) * 256 + ch * 8);
        u32x4 o;
#pragma unroll
        for (int j = 0; j < 4; ++j) {
            const float lo = w0 * __uint_as_float(a0[j] << 16) + w1 * __uint_as_float(a1[j] << 16) + w2 * __uint_as_float(a2[j] << 16);
            const float hi = w0 * __uint_as_float(a0[j] & 0xffff0000u) + w1 * __uint_as_float(a1[j] & 0xffff0000u) + w2 * __uint_as_float(a2[j] & 0xffff0000u);
            o[j] = pk2(lo, hi);
        }
        *(u32x4*)(mix + tok * D + 256 + ch * 8) = o;
    }
    {
        const int lane = threadIdx.x & 63, wv = blockIdx.x * 8 + (threadIdx.x >> 6), nw = gridDim.x * 8;
        const float* pu = a.in[27] + (size_t)layer * NEXP * D; const float* pv = a.in[28] + (size_t)layer * NEXP * D; const float* gn_ = a.in[5] + layer * D;
        unsigned char* ut = a.ws + WS_UT; unsigned char* vt = a.ws + WS_VT; float* scl = (float*)(a.ws + WS_US);
        float g[16]; load_row16(gn_, lane, g);
        for (int r = wv; r < 2 * NEXP; r += nw) {
            const bool isv = r >= NEXP; const int e = isv ? r - NEXP : r;
            float v[16]; load_row16((isv ? pv : pu) + (size_t)e * D, lane, v);
            float sq = 0.f;
#pragma unroll
            for (int i = 0; i < 16; ++i) { if (!isv) v[i] *= g[i]; sq += v[i] * v[i]; }
            sq = wave_sum(sq);
            const float sc = sq > 0.f ? 0.35f * sqrtf(sq * (1.f / 1024.f)) : 1.f, inv = 1.f / sc;
            u32x2 w;
#pragma unroll
            for (int j = 0; j < 2; ++j) {
                unsigned pk = 0u;
#pragma unroll
                for (int i = 0; i < 8; ++i) { int q = (int)rintf(v[8 * j + i] * inv); q = q > 7 ? 7 : (q < -7 ? -7 : q);
                    pk |= ((unsigned)(isv && (i < 4 || !HK_PEER_SPLIT) ? q + 8 : q) & 0xfu) << (i < 4 ? 8 * i : 8 * (i - 4) + 4); }
                w[j] = pk;
            }
            *(u32x2*)((isv ? vt : ut) + (size_t)e * 512 + 8 * lane) = w;
            if (lane == 0) scl[2 * e + (isv ? 1 : 0)] = isv || HK_PEER_SPLIT ? sc : sc * (1.f / 16.f);
        }
    }
}

__device__ __forceinline__ unsigned srt(float f) { const unsigned u = __float_as_uint(f); return u ^ ((unsigned)((int)u >> 31) | 0x80000000u); }
__device__ __forceinline__ float unsrt(unsigned u) { return __uint_as_float(u ^ ((~(unsigned)((int)u >> 31)) | 0x80000000u)); }
#define CEX(a, b) do { const unsigned x_ = (a), y_ = (b); (a) = x_ > y_ ? x_ : y_; (b) = x_ > y_ ? y_ : x_; } while (0)
__device__ __forceinline__ void bitonic_merge16(unsigned (&v)[16]) {
#pragma unroll
    for (int d = 8; d >= 1; d >>= 1)
#pragma unroll
        for (int i = 0; i < 16; ++i) if ((i & d) == 0) CEX(v[i], v[i + d]);
}
__device__ __forceinline__ void sort16_desc(unsigned (&v)[16]) {
    CEX(v[0], v[13]); CEX(v[1], v[12]); CEX(v[2], v[15]); CEX(v[3], v[14]); CEX(v[4], v[8]); CEX(v[5], v[6]); CEX(v[7], v[11]); CEX(v[9], v[10]);
    CEX(v[0], v[5]); CEX(v[1], v[7]); CEX(v[2], v[9]); CEX(v[3], v[4]); CEX(v[6], v[13]); CEX(v[8], v[14]); CEX(v[10], v[15]); CEX(v[11], v[12]);
    CEX(v[0], v[1]); CEX(v[2], v[3]); CEX(v[4], v[5]); CEX(v[6], v[8]); CEX(v[7], v[9]); CEX(v[10], v[11]); CEX(v[12], v[13]); CEX(v[14], v[15]);
    CEX(v[0], v[2]); CEX(v[1], v[3]); CEX(v[4], v[10]); CEX(v[5], v[11]); CEX(v[6], v[7]); CEX(v[8], v[9]); CEX(v[12], v[14]); CEX(v[13], v[15]);
    CEX(v[1], v[2]); CEX(v[3], v[12]); CEX(v[4], v[6]); CEX(v[5], v[7]); CEX(v[8], v[10]); CEX(v[9], v[11]); CEX(v[13], v[14]);
    CEX(v[1], v[4]); CEX(v[2], v[6]); CEX(v[5], v[8]); CEX(v[7], v[10]); CEX(v[9], v[13]); CEX(v[11], v[14]);
    CEX(v[2], v[4]); CEX(v[3], v[6]); CEX(v[9], v[12]); CEX(v[11], v[13]);
    CEX(v[3], v[5]); CEX(v[6], v[8]); CEX(v[7], v[9]); CEX(v[10], v[12]);
    CEX(v[3], v[4]); CEX(v[5], v[6]); CEX(v[7], v[8]); CEX(v[9], v[10]); CEX(v[11], v[12]);
    CEX(v[6], v[7]); CEX(v[8], v[9]);
}
__device__ __forceinline__ void merge_top16(unsigned (&a)[16], const unsigned (&b)[16]) {
#pragma unroll
    for (int j = 0; j < 16; ++j) a[j] = a[j] > b[15 - j] ? a[j] : b[15 - j];
    bitonic_merge16(a);
}
__device__ __forceinline__ void ins16(unsigned (&top)[16], unsigned pk) {
#pragma unroll
    for (int j = 0; j < 16; ++j) { const unsigned hi_ = top[j] > pk ? top[j] : pk; pk = top[j] > pk ? pk : top[j]; top[j] = hi_; }
}
__device__ __forceinline__ void merge_halves(unsigned (&top)[16]) {
    unsigned lo[16], hi[16];
#pragma unroll
    for (int j = 0; j < 16; ++j) { auto rr = __builtin_amdgcn_permlane32_swap(top[j], top[j], false, false); lo[j] = rr[0]; hi[j] = rr[1]; }
#pragma unroll
    for (int j = 0; j < 16; ++j) top[j] = lo[j] > hi[15 - j] ? lo[j] : hi[15 - j];
#pragma unroll
    for (int d = 8; d >= 1; d >>= 1)
#pragma unroll
        for (int i = 0; i < 16; ++i) if ((i & d) == 0) { const unsigned x = top[i], y = top[i + d]; top[i] = x > y ? x : y; top[i + d] = x > y ? y : x; }
}
constexpr int P6_PL = 0, P6_RS = 32768, P6_DOT = 32768 + 128, P6_LST = P6_DOT + 8 * 1024, P6_END = P6_LST + 8 * 8192;
__device__ __forceinline__ float dot8(const u32x4& a, const unsigned (&xh)[4], float acc) {
#pragma unroll
    for (int j = 0; j < 4; ++j) { acc += __uint_as_float(a[j] << 16) * __uint_as_float(xh[j] << 16); acc += __uint_as_float(a[j] & 0xffff0000u) * __uint_as_float(xh[j] & 0xffff0000u); }
    return acc;
}
__device__ __forceinline__ void peer_unit(const Args& a, unsigned char* lds, int layer, int unit) {
    int tid = threadIdx.x; asm volatile("" : "+v"(tid));
    const int lane = tid & 63, w = __builtin_amdgcn_readfirstlane(tid >> 6), qi = lane & 31, hi = lane >> 5;
    const int tok0 = unit * 32;
#if defined(HK_PROBE_PHASE) && HK_PROBE_PHASE == 10
    unsigned long long pq0_ = 0; if (blockIdx.x == 0 && threadIdx.x == 0) pq0_ = __builtin_amdgcn_s_memrealtime();
#endif
    const bf16_t* xg = (const bf16_t*)(a.ws + WS_XB);
    float* rsl = (float*)(lds + P6_RS);
    {
        u32x4 xr[4][2];
#pragma unroll
        for (int tt = 0; tt < 4; ++tt) { const bf16_t* p = xg + (size_t)(tok0 + 4 * w + tt) * D + 16 * lane; xr[tt][0] = *(const u32x4*)p; xr[tt][1] = *(const u32x4*)(p + 8); }
#pragma unroll
        for (int tt = 0; tt < 4; ++tt) {
            float ss = 0.f;
#pragma unroll
            for (int j = 0; j < 2; ++j)
#pragma unroll
                for (int e = 0; e < 4; ++e) { const float lo = __uint_as_float(xr[tt][j][e] << 16), hi_ = __uint_as_float(xr[tt][j][e] & 0xffff0000u); ss += lo * lo + hi_ * hi_; }
            ss = wave_sum(ss);
            if (lane == 0) rsl[4 * w + tt] = __builtin_amdgcn_rsqf(ss * (1.f / 1024.f) + EPS);
        }
    }
    __syncthreads();
    {
        const float rs2 = rsl[qi];
        const bf16_t* qrow = (const bf16_t*)(a.ws + WS_ZB) + (size_t)(tok0 + qi) * 2048 + 256 * w;
        const bf16_t* kb_ = (const bf16_t*)(a.ws + WS_KEYS) + (size_t)(layer * 16 + 2 * w) * 128 * 128;
        unsigned* lsw = (unsigned*)(lds + P6_LST) + w * 2048 + lane;
#if HK_FOLD_KEYS
        const bf16_t* srow = (const bf16_t*)(a.ws + WS_ZB) + (size_t)(tok0 + qi) * 2048 + 256 * w + 64 * hi;
        u32x4 sv[2][8];
#pragma unroll
        for (int p = 0; p < 2; ++p)
#pragma unroll
            for (int j = 0; j < 8; ++j) sv[p][j] = *(const u32x4*)(srow + 128 * p + 8 * j);
#pragma unroll
        for (int p = 0; p < 2; ++p) {
            unsigned top[16];
#pragma unroll
            for (int kb = 0; kb < 4; ++kb) {
                unsigned cur[16];
#pragma unroll
                for (int j = 0; j < 2; ++j)
#pragma unroll
                    for (int e = 0; e < 4; ++e) {
                        const unsigned wd = sv[p][2 * kb + j][e];
                        const unsigned lo = wd & 0xffffu, hi16 = wd >> 16;
                        const unsigned slo = lo ^ ((lo & 0x8000u) ? 0xffffu : 0x8000u), shi = hi16 ^ ((hi16 & 0x8000u) ? 0xffffu : 0x8000u);
                        const unsigned idx = (unsigned)(64 * hi + 16 * kb + 8 * j + 2 * e);
                        cur[8 * j + 2 * e] = (slo << 16) | idx; cur[8 * j + 2 * e + 1] = (shi << 16) | (idx + 1u);
                    }
                sort16_desc(cur);
                if (kb == 0) {
#pragma unroll
                    for (int j = 0; j < 16; ++j) top[j] = cur[j];
                } else merge_top16(top, cur);
            }
            merge_halves(top);
#pragma unroll
            for (int j = 0; j < 16; ++j) { const unsigned s16 = top[j] >> 16; const unsigned hb = s16 ^ ((s16 & 0x8000u) ? 0x8000u : 0xffffu);
                const _Float16 hv = __builtin_bit_cast(_Float16, (unsigned short)hb);
                lsw[(p * 16 + j) * 64] = (srt((float)hv) & ~127u) | (top[j] & 127u); }
        }
#else
        bf16x8 qf2[2][8];
#pragma unroll
        for (int p = 0; p < 2; ++p)
#pragma unroll
            for (int ks = 0; ks < 8; ++ks) qf2[p][ks] = *(const bf16x8*)(qrow + 128 * p + 16 * ks + 8 * hi);
#pragma unroll
        for (int p = 0; p < 2; ++p) {
            const bf16x8 (&qf)[8] = qf2[p];
            unsigned top[16];
            bf16x8 kfn[8];
#pragma unroll
            for (int ks = 0; ks < 8; ++ks) kfn[ks] = *(const bf16x8*)(kb_ + ((size_t)p * 128 + qi) * 128 + 16 * ks + 8 * hi);
#pragma unroll 1
            for (int kb = 0; kb < 4; ++kb) {
                f32x16 acc = (f32x16){};
#pragma unroll
                for (int ks = 0; ks < 8; ++ks) acc = MFMA32(kfn[ks], qf[ks], acc);
                if (kb < 3) {
#pragma unroll
                    for (int ks = 0; ks < 8; ++ks) kfn[ks] = *(const bf16x8*)(kb_ + ((size_t)p * 128 + 32 * (kb + 1) + qi) * 128 + 16 * ks + 8 * hi);
                }
                unsigned cur[16];
#pragma unroll
                for (int r = 0; r < 16; ++r) cur[r] = (srt(acc[r]) & ~127u) | (unsigned)(32 * kb + (r & 3) + 8 * (r >> 2) + 4 * hi);
                sort16_desc(cur);
                if (kb == 0) {
#pragma unroll
                    for (int j = 0; j < 16; ++j) top[j] = cur[j];
                } else merge_top16(top, cur);
            }
            merge_halves(top);
#pragma unroll
            for (int j = 0; j < 16; ++j) lsw[(p * 16 + j) * 64] = top[j];
        }
#endif
        unsigned best[16];
#pragma unroll
        for (int j = 0; j < 16; ++j) best[j] = 0u;
#pragma unroll 1
        for (int i = hi; i < 16; i += 2) {
            const unsigned ai = lsw[i * 64]; const float vai = unsrt(ai & ~127u); const unsigned iai = (ai & 127u) << 7;
            const int nj = 16 / (i + 1);
#pragma unroll 1
            for (int j = 0; j < nj; ++j) { const unsigned bj = lsw[(16 + j) * 64]; ins16(best, (srt(vai + unsrt(bj & ~127u)) & ~0x3FFFu) | iai | (bj & 127u)); }
        }
        merge_halves(best);
        float e[16], sum = 0.f;
        const float s0 = unsrt(best[0] & ~0x3FFFu);
#pragma unroll
        for (int j = 0; j < 16; ++j) { e[j] = __builtin_amdgcn_exp2f((unsrt(best[j] & ~0x3FFFu) - s0) * rs2 * LOG2E); sum += e[j]; }
        const float inv = 1.f / sum;
        if (hi == 0) {
            u32x2* pl = (u32x2*)(lds + P6_PL) + qi * 128 + 16 * w;
#pragma unroll
            for (int j = 0; j < 16; ++j) { u32x2 en; en.x = best[j] & 0x3FFFu; en.y = __float_as_uint(e[j] * inv); pl[j] = en; }
        }
    }
    __syncthreads();
#if defined(HK_PROBE_PHASE) && HK_PROBE_PHASE == 10
    if (blockIdx.x == 0 && threadIdx.x == 0) { volatile LAS3 unsigned* pw_ = (volatile LAS3 unsigned*)(LAS3 unsigned char*)(lds + LDS_CTL + 48); *pw_ = *pw_ + (unsigned)(__builtin_amdgcn_s_memrealtime() - pq0_); }
#endif
    const unsigned char* ut = a.ws + WS_UT; const unsigned char* vt = a.ws + WS_VT; const float* scl = (const float*)(a.ws + WS_US);
    float* dots = (float*)(lds + P6_DOT) + w * 256; float* cfs = dots + 128;
    int vz_; asm volatile("v_mov_b32 %0, 0" : "=v"(vz_));
    const int lane_g = lane + vz_, hi_g = lane_g >> 5;
    const int c32 = lane_g & 31, slot = 2 * c32 + hi_g;
#define PG_ISSUE(buf, tab, plp, b) do { _Pragma("unroll") for (int kk = 0; kk < 8; ++kk) { const unsigned id_ = (plp)[16 * (b) + 8 * hi_g + kk].x; buf[kk] = *(const u32x4*)((tab) + (unsigned)(id_ * 512u + 16u * (unsigned)c32)); } } while (0)
#define PG_CU(buf, b) do { int pd_[8]; \
        _Pragma("unroll") for (int kk = 0; kk < 8; ++kk) { int d_ = 0; \
            _Pragma("unroll") for (int j = 0; j < 4; ++j) { d_ = __builtin_amdgcn_sdot4((int)((buf[kk][j] << 4) & 0xF0F0F0F0u), xq[2 * j], d_, false); d_ = __builtin_amdgcn_sdot4((int)(buf[kk][j] & 0xF0F0F0F0u), xq[2 * j + 1], d_, false); } \
            pd_[kk] = d_; } \
        int r4_[4]; \
        _Pragma("unroll") for (int j = 0; j < 4; ++j) { auto rr_ = __builtin_amdgcn_permlane16_swap((unsigned)pd_[j], (unsigned)pd_[j + 4], false, false); r4_[j] = (int)rr_[0] + (int)rr_[1]; } \
        _Pragma("unroll") for (int j = 0; j < 4; ++j) { int v_ = r4_[j]; \
            v_ += __builtin_amdgcn_update_dpp(0, v_, 0xB1, 0xf, 0xf, true); v_ += __builtin_amdgcn_update_dpp(0, v_, 0x4E, 0xf, 0xf, true); \
            v_ += __builtin_amdgcn_update_dpp(0, v_, 0x141, 0xf, 0xf, true); v_ += __builtin_amdgcn_update_dpp(0, v_, 0x140, 0xf, 0xf, true); r4_[j] = v_; } \
        if ((lane_g & 15) == 0) { const int q_ = lane_g >> 4; *(f32x4*)(dots + 16 * (b) + 8 * (q_ >> 1) + 4 * (q_ & 1)) = (f32x4){(float)r4_[0], (float)r4_[1], (float)r4_[2], (float)r4_[3]}; } } while (0)
#define PG_T4(r0, r1, r2, r3, t0, t1, t2, t3) do { const unsigned a01l_ = __builtin_amdgcn_perm(r1, r0, 0x05010400u), a01h_ = __builtin_amdgcn_perm(r1, r0, 0x07030602u), \
            a23l_ = __builtin_amdgcn_perm(r3, r2, 0x05010400u), a23h_ = __builtin_amdgcn_perm(r3, r2, 0x07030602u); \
        t0 = __builtin_amdgcn_perm(a23l_, a01l_, 0x05040100u); t1 = __builtin_amdgcn_perm(a23l_, a01l_, 0x07060302u); \
        t2 = __builtin_amdgcn_perm(a23h_, a01h_, 0x05040100u); t3 = __builtin_amdgcn_perm(a23h_, a01h_, 0x07060302u); } while (0)
#define PG_CV(buf, b) do { _Pragma("unroll") for (int g4 = 0; g4 < 2; ++g4) { const int cq_ = (int)cqw[4 * (b) + 2 * hi_g + g4]; \
            _Pragma("unroll") for (int j = 0; j < 4; ++j) { \
                const unsigned w0_ = buf[4 * g4][j], w1_ = buf[4 * g4 + 1][j], w2_ = buf[4 * g4 + 2][j], w3_ = buf[4 * g4 + 3][j]; \
                unsigned t0_, t1_, t2_, t3_; \
                PG_T4(w0_ & 0x0F0F0F0Fu, w1_ & 0x0F0F0F0Fu, w2_ & 0x0F0F0F0Fu, w3_ & 0x0F0F0F0Fu, t0_, t1_, t2_, t3_); \
                oa[8 * j + 0] = __builtin_amdgcn_sdot4((int)t0_, cq_, oa[8 * j + 0], false); oa[8 * j + 1] = __builtin_amdgcn_sdot4((int)t1_, cq_, oa[8 * j + 1], false); \
                oa[8 * j + 2] = __builtin_amdgcn_sdot4((int)t2_, cq_, oa[8 * j + 2], false); oa[8 * j + 3] = __builtin_amdgcn_sdot4((int)t3_, cq_, oa[8 * j + 3], false); \
                PG_T4((w0_ >> 4) & 0x0F0F0F0Fu, (w1_ >> 4) & 0x0F0F0F0Fu, (w2_ >> 4) & 0x0F0F0F0Fu, (w3_ >> 4) & 0x0F0F0F0Fu, t0_, t1_, t2_, t3_); \
                oa[8 * j + 4] = __builtin_amdgcn_sdot4((int)t0_, cq_, oa[8 * j + 4], false); oa[8 * j + 5] = __builtin_amdgcn_sdot4((int)t1_, cq_, oa[8 * j + 5], false); \
                oa[8 * j + 6] = __builtin_amdgcn_sdot4((int)t2_, cq_, oa[8 * j + 6], false); oa[8 * j + 7] = __builtin_amdgcn_sdot4((int)t3_, cq_, oa[8 * j + 7], false); \
                asm volatile("" : "+v"(oa[8 * j]), "+v"(oa[8 * j + 1]), "+v"(oa[8 * j + 2]), "+v"(oa[8 * j + 3]), "+v"(oa[8 * j + 4]), "+v"(oa[8 * j + 5]), "+v"(oa[8 * j + 6]), "+v"(oa[8 * j + 7])); } } } while (0)
#define PG_SB __builtin_amdgcn_sched_barrier(0)
    u32x4 bA[8], bB[8];
    { const u32x2* pl0 = (const u32x2*)(lds + P6_PL) + (4 * w) * 128; PG_ISSUE(bA, ut, pl0, 0); }
    for (int tt = 0; tt < 4; ++tt) {
        const int tl = 4 * w + tt, tok = tok0 + tl;
        const float rs2 = rsl[tl];
        const u32x2* pl = (const u32x2*)(lds + P6_PL) + tl * 128;
        const u32x2 en0 = pl[lane_g], en1 = pl[64 + lane_g];
        const float2 sc0_ = *(const float2*)(scl + 2 * (size_t)en0.x), sc1_ = *(const float2*)(scl + 2 * (size_t)en1.x);
        const float us0 = sc0_.x, us1 = sc1_.x, vs0 = sc0_.y, vs1 = sc1_.y;
        float xv[16]; load_row16_bf(xg + (size_t)tok * D, slot, xv);
        float mx = 0.f;
#pragma unroll
        for (int i = 0; i < 16; ++i) mx = fmaxf(mx, fabsf(xv[i]));
#pragma unroll
        for (int o = 32; o > 0; o >>= 1) mx = fmaxf(mx, __shfl_xor(mx, o));
        const float sx = mx > 0.f ? mx * (1.f / 127.f) : 1.f, isx = 1.f / sx;
        int xq[8];
#pragma unroll
        for (int j = 0; j < 4; ++j) {
            unsigned pk = 0u;
#pragma unroll
            for (int i = 0; i < 4; ++i) { const int q = (int)rintf(xv[4 * j + i] * isx); pk |= ((unsigned)q & 0xffu) << (8 * i); }
            auto rr = __builtin_amdgcn_permlane32_swap(pk, pk, false, false);
            xq[j] = (int)rr[0]; xq[4 + j] = (int)rr[1];
        }
#pragma unroll
        for (int ub = 0; ub < 8; ub += 2) {
            PG_ISSUE(bB, ut, pl, ub + 1); PG_SB; PG_CU(bA, ub); PG_SB;
            if (ub + 2 < 8) PG_ISSUE(bA, ut, pl, ub + 2); else PG_ISSUE(bA, vt, pl, 0);
            PG_SB; PG_CU(bB, ub + 1); PG_SB;
        }
        const float a0 = gelu_tanh(dots[lane_g] * (sx * rs2) * us0) * __uint_as_float(en0.y);
        const float a1 = gelu_tanh(dots[64 + lane_g] * (sx * rs2) * us1) * __uint_as_float(en1.y);
        const float c0 = a0 * vs0, c1 = a1 * vs1;
        float cm = fmaxf(fabsf(c0), fabsf(c1));
#pragma unroll
        for (int o = 32; o > 0; o >>= 1) cm = fmaxf(cm, __shfl_xor(cm, o));
        const float scc = cm > 0.f ? cm * (1.f / 127.f) : 1.f, iscc = 1.f / scc;
        const int q0c = (int)rintf(c0 * iscc), q1c = (int)rintf(c1 * iscc);
        volatile LAS3 signed char* cqb = (volatile LAS3 signed char*)(LAS3 unsigned char*)cfs;
        cqb[lane_g] = (signed char)q0c; cqb[64 + lane_g] = (signed char)q1c;
        const LAS3 unsigned* cqw = (const LAS3 unsigned*)(LAS3 unsigned char*)cfs;
        int qsum = q0c + q1c;
#pragma unroll
        for (int o = 32; o > 0; o >>= 1) qsum += __shfl_xor(qsum, o);
        int oa[32];
#pragma unroll
        for (int i = 0; i < 32; ++i) oa[i] = 0;
        int vzv_; asm volatile("v_mov_b32 %0, 0" : "=v"(vzv_));
        const u32x2* plv = pl + vzv_;
#pragma unroll
        for (int vb = 0; vb < 8; vb += 2) {
            PG_ISSUE(bB, vt, plv, vb + 1); PG_SB; PG_CV(bA, vb); PG_SB;
            if (vb + 2 < 8) PG_ISSUE(bA, vt, plv, vb + 2); else if (tt < 3) PG_ISSUE(bA, ut, plv + 128, 0);
            PG_SB; PG_CV(bB, vb + 1); PG_SB;
        }
#pragma unroll
        for (int i = 0; i < 16; ++i) {
            auto rr = __builtin_amdgcn_permlane32_swap((unsigned)oa[i], (unsigned)oa[16 + i], false, false);
#ifndef HK_PROBE_NOPEER
            xv[i] += scc * (float)((int)rr[0] + (int)rr[1] - 8 * qsum);
#else
            xv[i] += 1e-30f * (float)((int)rr[0] + (int)rr[1]);
#endif
        }
#ifdef HK_PROBE_L2
        {
            int dsum = 0;
            for (int k = 0; k < 128; k += 32) {
                u32x4 ldx[16];
#pragma unroll
                for (int kk = 0; kk < 16; ++kk) { unsigned id = pl[k + 16 * hi_g + kk].x; if (HK_PROBE_L2 == 2) id &= 0x0FFFu; ldx[kk] = *(const u32x4*)(ut + (size_t)id * 512 + 16 * c32); }
#pragma unroll
                for (int kk = 0; kk < 16; ++kk) { dsum = __builtin_amdgcn_sdot4((int)ldx[kk].x, xq[0], dsum, false); dsum = __builtin_amdgcn_sdot4((int)ldx[kk].w, xq[1], dsum, false); }
            }
            xv[0] += 1e-30f * (float)dsum;
        }
#endif
        const bool more = layer + 1 < DEPTH;
        int vzt_; asm volatile("v_mov_b32 %0, 0" : "=v"(vzt_) : "v"(xv[0]));
        finish_token(tok, xv, more ? nullptr : a.out, (bf16_t*)(a.ws + WS_XB), (float*)(a.ws + WS_RSTD), more ? (const float*)(a.ws + WS_WF) + (size_t)(layer + 1) * 4096 : nullptr,
                     a.in[2] + (more ? (layer + 1) * 4 : 0), (float*)(a.ws + WS_FLOG), lane, slot + vzt_);
    }
#undef PG_ISSUE
#undef PG_SB
#undef PG_CU
#undef PG_CV
#undef PG_T4
    __syncthreads();
}
#if HK_FOLD_KEYS
__device__ __forceinline__ void peer_unit_a(const Args& a, unsigned char* lds, int layer, int unit) {
    int tid = threadIdx.x; asm volatile("" : "+v"(tid));
    const int lane = tid & 63, w = __builtin_amdgcn_readfirstlane(tid >> 6), qi = lane & 31, hi = lane >> 5;
    const int tok0 = unit * 32;
#if defined(HK_PROBE_PHASE) && HK_PROBE_PHASE == 10
    unsigned long long pq0_ = 0; if (blockIdx.x == 0 && threadIdx.x == 0) pq0_ = __builtin_amdgcn_s_memrealtime();
#endif
    const bf16_t* xg = (const bf16_t*)(a.ws + WS_XB);
    float* rsl = (float*)(lds + P6_RS);
    {
        u32x4 xr[4][2];
#pragma unroll
        for (int tt = 0; tt < 4; ++tt) { const bf16_t* p = xg + (size_t)(tok0 + 4 * w + tt) * D + 16 * lane; xr[tt][0] = *(const u32x4*)p; xr[tt][1] = *(const u32x4*)(p + 8); }
#pragma unroll
        for (int tt = 0; tt < 4; ++tt) {
            float ss = 0.f;
#pragma unroll
            for (int j = 0; j < 2; ++j)
#pragma unroll
                for (int e = 0; e < 4; ++e) { const float lo = __uint_as_float(xr[tt][j][e] << 16), hi_ = __uint_as_float(xr[tt][j][e] & 0xffff0000u); ss += lo * lo + hi_ * hi_; }
            ss = wave_sum(ss);
            if (lane == 0) rsl[4 * w + tt] = __builtin_amdgcn_rsqf(ss * (1.f / 1024.f) + EPS);
        }
    }
    const int tl_r = 4 * w + (qi >> 3), hd = qi & 7;
    {
        const float rs2 = rsl[tl_r];
        unsigned* lsw = (unsigned*)(lds + P6_LST) + w * 2048 + lane;
#if HK_FOLD_KEYS
        const bf16_t* srow = (const bf16_t*)(a.ws + WS_ZB) + (size_t)(tok0 + tl_r) * 2048 + 256 * hd + 64 * hi;
        u32x4 sv[2][8];
#pragma unroll
        for (int p = 0; p < 2; ++p)
#pragma unroll
            for (int j = 0; j < 8; ++j) sv[p][j] = *(const u32x4*)(srow + 128 * p + 8 * j);
#pragma unroll
        for (int p = 0; p < 2; ++p) {
            unsigned top[16];
#pragma unroll
            for (int kb = 0; kb < 4; ++kb) {
                unsigned cur[16];
#pragma unroll
                for (int j = 0; j < 2; ++j)
#pragma unroll
                    for (int e = 0; e < 4; ++e) {
                        const unsigned wd = sv[p][2 * kb + j][e];
                        typedef short s16x2_ __attribute__((ext_vector_type(2)));
                        const s16x2_ sg = __builtin_bit_cast(s16x2_, wd) >> 15;
                        const unsigned k2 = wd ^ ((__builtin_bit_cast(unsigned, sg) & 0x7fff7fffu) | 0x80008000u);
                        const unsigned idx = (unsigned)(64 * hi + 16 * kb + 8 * j + 2 * e);
                        cur[8 * j + 2 * e] = (k2 << 16) | idx; cur[8 * j + 2 * e + 1] = (k2 & 0xffff0000u) | (idx + 1u);
                    }
                sort16_desc(cur);
                if (kb == 0) {
#pragma unroll
                    for (int j = 0; j < 16; ++j) top[j] = cur[j];
                } else merge_top16(top, cur);
            }
            merge_halves(top);
#pragma unroll
            for (int j = 0; j < 16; ++j) { const unsigned s16 = top[j] >> 16; const unsigned hb = s16 ^ ((s16 & 0x8000u) ? 0x8000u : 0xffffu);
                const _Float16 hv = __builtin_bit_cast(_Float16, (unsigned short)hb);
                lsw[(p * 16 + j) * 64] = (srt((float)hv) & ~127u) | (top[j] & 127u); }
        }
#endif
        unsigned best[16];
        {
            const int offA = hi ? 16 * 64 : 0, offB = hi ? 0 : 16 * 64, shA = hi ? 0 : 7, shB = hi ? 7 : 0;
            float fa[16], fb[16]; unsigned ia[16], ib[16];
#pragma unroll
            for (int i = 0; i < 16; ++i) { const unsigned av = lsw[offA + i * 64], bv = lsw[offB + i * 64];
                fa[i] = unsrt(av & ~127u); fb[i] = unsrt(bv & ~127u); ia[i] = (av & 127u) << shA; ib[i] = (bv & 127u) << shB; }
#define PA_CAND(i, j) ((srt(fa[i] + fb[j]) & ~0x3FFFu) | ia[i] | ib[j])
            unsigned c0[16], c1[16];
#pragma unroll
            for (int j = 1; j < 16; ++j) c0[j - 1] = PA_CAND(0, j);
            c0[15] = hi ? PA_CAND(1, 1) : PA_CAND(0, 0);
#pragma unroll
            for (int j = 2; j < 8; ++j) c1[j - 2] = PA_CAND(1, j);
            c1[6] = PA_CAND(2, 3); c1[7] = PA_CAND(2, 4);
            c1[8] = hi ? PA_CAND(3, 3) : PA_CAND(2, 2);
#pragma unroll
            for (int j = 9; j < 16; ++j) c1[j] = 0u;
#undef PA_CAND
            sort16_desc(c0); sort16_desc(c1);
            merge_top16(c0, c1);
#pragma unroll
            for (int j = 0; j < 16; ++j) best[j] = c0[j];
        }
        merge_halves(best);
        float e[16], sum = 0.f;
        const float s0 = unsrt(best[0] & ~0x3FFFu);
#pragma unroll
        for (int j = 0; j < 16; ++j) { e[j] = __builtin_amdgcn_exp2f((unsrt(best[j] & ~0x3FFFu) - s0) * rs2 * LOG2E); sum += e[j]; }
        const float inv = 1.f / sum;
        if (hi == 0) {
            u32x2* pl = (u32x2*)(lds + P6_PL) + tl_r * 128 + 16 * hd;
#pragma unroll
            for (int j = 0; j < 16; ++j) { u32x2 en; en.x = best[j] & 0x3FFFu; en.y = __float_as_uint(e[j] * inv); pl[j] = en; }
        }
    }
#if defined(HK_PROBE_PHASE) && HK_PROBE_PHASE == 10
    if (blockIdx.x == 0 && threadIdx.x == 0) { volatile LAS3 unsigned* pw_ = (volatile LAS3 unsigned*)(LAS3 unsigned char*)(lds + LDS_CTL + 48); *pw_ = *pw_ + (unsigned)(__builtin_amdgcn_s_memrealtime() - pq0_); }
#endif
    const unsigned char* ut = a.ws + WS_UT; const unsigned char* vt = a.ws + WS_VT; const float* scl = (const float*)(a.ws + WS_US);
    float* dots = (float*)(lds + P6_DOT) + w * 256; float* cfs = dots + 128;
    int vz_; asm volatile("v_mov_b32 %0, 0" : "=v"(vz_));
    const int lane_g = lane + vz_, hi_g = lane_g >> 5;
    const int c32 = lane_g & 31, slot = 2 * c32 + hi_g;
#define PG_ISSUE(buf, tab, plp, b) do { _Pragma("unroll") for (int kk = 0; kk < 8; ++kk) { const unsigned id_ = (plp)[16 * (b) + 8 * hi_g + kk].x; buf[kk] = *(const u32x4*)((tab) + (unsigned)(id_ * 512u + 16u * (unsigned)c32)); } } while (0)
#define PG_CU(buf, b) do { int pd_[8]; \
        _Pragma("unroll") for (int kk = 0; kk < 8; ++kk) {        \
            int dl_ = __builtin_amdgcn_sdot8((int)buf[kk][0], xl4[0], 0, true), dh_ = __builtin_amdgcn_sdot8((int)buf[kk][0], xh4[0], 0, true); \
            _Pragma("unroll") for (int j = 1; j < 4; ++j) { dl_ = __builtin_amdgcn_sdot8((int)buf[kk][j], xl4[j], dl_, false); dh_ = __builtin_amdgcn_sdot8((int)buf[kk][j], xh4[j], dh_, false); } \
            pd_[kk] = (dh_ << 4) + dl_; } \
        int r4_[4]; \
        _Pragma("unroll") for (int j = 0; j < 4; ++j) { auto rr_ = __builtin_amdgcn_permlane16_swap((unsigned)pd_[j], (unsigned)pd_[j + 4], false, false); r4_[j] = (int)rr_[0] + (int)rr_[1]; } \
        _Pragma("unroll") for (int j = 0; j < 4; ++j) { int v_ = r4_[j]; \
            v_ += __builtin_amdgcn_update_dpp(0, v_, 0xB1, 0xf, 0xf, true); v_ += __builtin_amdgcn_update_dpp(0, v_, 0x4E, 0xf, 0xf, true); \
            v_ += __builtin_amdgcn_update_dpp(0, v_, 0x141, 0xf, 0xf, true); v_ += __builtin_amdgcn_update_dpp(0, v_, 0x140, 0xf, 0xf, true); r4_[j] = v_; } \
        if ((lane_g & 15) == 0) { const int q_ = lane_g >> 4; *(f32x4*)(dots + 16 * (b) + 8 * (q_ >> 1) + 4 * (q_ & 1)) = (f32x4){(float)r4_[0], (float)r4_[1], (float)r4_[2], (float)r4_[3]}; } } while (0)
#define PG_T4(r0, r1, r2, r3, t0, t1, t2, t3) do { const unsigned a01l_ = __builtin_amdgcn_perm(r1, r0, 0x05010400u), a01h_ = __builtin_amdgcn_perm(r1, r0, 0x07030602u), \
            a23l_ = __builtin_amdgcn_perm(r3, r2, 0x05010400u), a23h_ = __builtin_amdgcn_perm(r3, r2, 0x07030602u); \
        t0 = __builtin_amdgcn_perm(a23l_, a01l_, 0x05040100u); t1 = __builtin_amdgcn_perm(a23l_, a01l_, 0x07060302u); \
        t2 = __builtin_amdgcn_perm(a23h_, a01h_, 0x05040100u); t3 = __builtin_amdgcn_perm(a23h_, a01h_, 0x07060302u); } while (0)
#define PG_CV(buf, b) do { _Pragma("unroll") for (int g4 = 0; g4 < 2; ++g4) { const int cq_ = (int)cqw[4 * (b) + 2 * hi_g + g4]; \
            _Pragma("unroll") for (int j = 0; j < 4; ++j) { \
                const unsigned w0_ = buf[4 * g4][j], w1_ = buf[4 * g4 + 1][j], w2_ = buf[4 * g4 + 2][j], w3_ = buf[4 * g4 + 3][j]; \
                unsigned t0_, t1_, t2_, t3_; \
                PG_T4(w0_ & 0x0F0F0F0Fu, w1_ & 0x0F0F0F0Fu, w2_ & 0x0F0F0F0Fu, w3_ & 0x0F0F0F0Fu, t0_, t1_, t2_, t3_); \
                oa[8 * j + 0] = __builtin_amdgcn_sdot4((int)t0_, cq_, oa[8 * j + 0], false); oa[8 * j + 1] = __builtin_amdgcn_sdot4((int)t1_, cq_, oa[8 * j + 1], false); \
                oa[8 * j + 2] = __builtin_amdgcn_sdot4((int)t2_, cq_, oa[8 * j + 2], false); oa[8 * j + 3] = __builtin_amdgcn_sdot4((int)t3_, cq_, oa[8 * j + 3], false); \
                PG_T4((w0_ >> 4) & 0x0F0F0F0Fu, (w1_ >> 4) & 0x0F0F0F0Fu, (w2_ >> 4) & 0x0F0F0F0Fu, (w3_ >> 4) & 0x0F0F0F0Fu, t0_, t1_, t2_, t3_); \
                oa[8 * j + 4] = __builtin_amdgcn_sdot4((int)t0_, cq_, oa[8 * j + 4], false); oa[8 * j + 5] = __builtin_amdgcn_sdot4((int)t1_, cq_, oa[8 * j + 5], false); \
                oa[8 * j + 6] = __builtin_amdgcn_sdot4((int)t2_, cq_, oa[8 * j + 6], false); oa[8 * j + 7] = __builtin_amdgcn_sdot4((int)t3_, cq_, oa[8 * j + 7], false); \
                asm volatile("" : "+v"(oa[8 * j]), "+v"(oa[8 * j + 1]), "+v"(oa[8 * j + 2]), "+v"(oa[8 * j + 3]), "+v"(oa[8 * j + 4]), "+v"(oa[8 * j + 5]), "+v"(oa[8 * j + 6]), "+v"(oa[8 * j + 7])); } } } while (0)
#define PG_SB __builtin_amdgcn_sched_barrier(0)
    u32x4 bA[8], bB[8], bC[8], bD[8];
    { const u32x2* pl0 = (const u32x2*)(lds + P6_PL) + (4 * w) * 128; PG_ISSUE(bA, ut, pl0, 0); PG_ISSUE(bB, ut, pl0, 1); PG_ISSUE(bC, ut, pl0, 2); }
    for (int tt = 0; tt < 4; ++tt) {
        const int tl = 4 * w + tt, tok = tok0 + tl;
        const float rs2 = rsl[tl];
        const u32x2* pl = (const u32x2*)(lds + P6_PL) + tl * 128;
        const u32x2 en0 = pl[lane_g], en1 = pl[64 + lane_g];
        const float2 sc0_ = *(const float2*)(scl + 2 * (size_t)en0.x), sc1_ = *(const float2*)(scl + 2 * (size_t)en1.x);
        const float us0 = sc0_.x, us1 = sc1_.x, vs0 = sc0_.y, vs1 = sc1_.y;
        float xv[16]; load_row16_bf(xg + (size_t)tok * D, slot, xv);
        float mx = 0.f;
#pragma unroll
        for (int i = 0; i < 16; ++i) mx = fmaxf(mx, fabsf(xv[i]));
#pragma unroll
        for (int o = 32; o > 0; o >>= 1) mx = fmaxf(mx, __shfl_xor(mx, o));
        const float sx = mx > 0.f ? mx * (1.f / 119.f) : 1.f, isx = 1.f / sx;
        int xl4[4], xh4[4];
        {
            unsigned xq[8];
#pragma unroll
            for (int j = 0; j < 4; ++j) {
                unsigned pk = 0u;
#pragma unroll
                for (int i = 0; i < 4; ++i) { const int q = (int)rintf(xv[4 * j + i] * isx); pk |= ((unsigned)q & 0xffu) << (8 * i); }
                auto rr = __builtin_amdgcn_permlane32_swap(pk, pk, false, false);
                xq[j] = rr[0]; xq[4 + j] = rr[1];
            }
#pragma unroll
            for (int j = 0; j < 4; ++j) {
                const unsigned A = xq[2 * j], B = xq[2 * j + 1];
                xl4[j] = (int)((A & 0x0F0F0F0Fu) | ((B & 0x0F0F0F0Fu) << 4));
                const unsigned ha = (((A >> 4) & 0x0F0F0F0Fu) + ((A >> 3) & 0x01010101u)) & 0x0F0F0F0Fu, hb = (((B >> 4) & 0x0F0F0F0Fu) + ((B >> 3) & 0x01010101u)) & 0x0F0F0F0Fu;
                xh4[j] = (int)(ha | (hb << 4));
            }
        }
#define PG_STEP(cur, nxt, ub) do { if ((ub) + 3 < 8) PG_ISSUE(nxt, ut, pl, (ub) + 3); else if (tt < 3) PG_ISSUE(nxt, ut, pl + 128, (ub) + 3 - 8); PG_SB; PG_CU(cur, ub); PG_SB; } while (0)
        PG_STEP(bA, bD, 0); PG_STEP(bB, bA, 1); PG_STEP(bC, bB, 2); PG_STEP(bD, bC, 3); PG_STEP(bA, bD, 4); PG_STEP(bB, bA, 5); PG_STEP(bC, bB, 6); PG_STEP(bD, bC, 7);
#undef PG_STEP
        const float a0 = gelu_tanh(dots[lane_g] * (sx * rs2) * us0) * __uint_as_float(en0.y);
        const float a1 = gelu_tanh(dots[64 + lane_g] * (sx * rs2) * us1) * __uint_as_float(en1.y);
        const float c0 = a0 * vs0, c1 = a1 * vs1;
        float cm = fmaxf(fabsf(c0), fabsf(c1));
#pragma unroll
        for (int o = 32; o > 0; o >>= 1) cm = fmaxf(cm, __shfl_xor(cm, o));
        const float scc = cm > 0.f ? cm * (1.f / 127.f) : 1.f, iscc = 1.f / scc;
        const int q0c = (int)rintf(c0 * iscc), q1c = (int)rintf(c1 * iscc);
        int qsum = q0c + q1c;
#pragma unroll
        for (int o = 32; o > 0; o >>= 1) qsum += __shfl_xor(qsum, o);
        unsigned short* gid = (unsigned short*)(a.ws + WS_CIDX) + (size_t)tok * 128; signed char* gcq = (signed char*)(a.ws + WS_CQ) + (size_t)tok * 128;
        gid[lane_g] = (unsigned short)en0.x; gid[64 + lane_g] = (unsigned short)en1.x; gcq[lane_g] = (signed char)q0c; gcq[64 + lane_g] = (signed char)q1c;
        if (lane_g == 0) { float* gsc = (float*)(a.ws + WS_CSC) + 2 * (size_t)tok; gsc[0] = scc; gsc[1] = (float)qsum; }
    }
#undef PG_ISSUE
#undef PG_SB
#undef PG_CU
#undef PG_CV
#undef PG_T4
}
#endif
__device__ __forceinline__ void peer_unit_c(const Args& a, unsigned char* lds, int layer, int unit) {
    int tid = threadIdx.x; asm volatile("" : "+v"(tid));
    const int lane = tid & 63, w = __builtin_amdgcn_readfirstlane(tid >> 6), hi_g = lane >> 5, c32 = lane & 31, slot = 2 * c32 + hi_g;
    const int tok0 = unit * 32 + 4 * w;
    const bf16_t* xg = (const bf16_t*)(a.ws + WS_XB);
    const unsigned char* vt = a.ws + WS_VT;
    const unsigned short* gid = (const unsigned short*)(a.ws + WS_CIDX); const signed char* gcq = (const signed char*)(a.ws + WS_CQ); const float* gsc = (const float*)(a.ws + WS_CSC);
    LAS3 unsigned char* lw = (LAS3 unsigned char*)(lds + w * 1024);
#define PC_ISSUE(buf, lb, b) do { const LAS3 unsigned short* il_ = (const LAS3 unsigned short*)(lw + 512 * (lb)); _Pragma("unroll") for (int kk = 0; kk < 8; ++kk) { const unsigned id_ = il_[16 * (b) + 8 * hi_g + kk]; \
        buf[kk] = *(const u32x4*)(vt + (unsigned)(id_ * 512u + 16u * (unsigned)c32)); } } while (0)
#define PC_T4(r0, r1, r2, r3, t0, t1, t2, t3) do { const unsigned a01l_ = __builtin_amdgcn_perm(r1, r0, 0x05010400u), a01h_ = __builtin_amdgcn_perm(r1, r0, 0x07030602u), \
            a23l_ = __builtin_amdgcn_perm(r3, r2, 0x05010400u), a23h_ = __builtin_amdgcn_perm(r3, r2, 0x07030602u); \
        t0 = __builtin_amdgcn_perm(a23l_, a01l_, 0x05040100u); t1 = __builtin_amdgcn_perm(a23l_, a01l_, 0x07060302u); \
        t2 = __builtin_amdgcn_perm(a23h_, a01h_, 0x05040100u); t3 = __builtin_amdgcn_perm(a23h_, a01h_, 0x07060302u); } while (0)
#define PC_CV(buf, lb, b) do { const LAS3 unsigned* cqw_ = (const LAS3 unsigned*)(lw + 512 * (lb) + 256); _Pragma("unroll") for (int g4 = 0; g4 < 2; ++g4) { const int cq_ = (int)cqw_[4 * (b) + 2 * hi_g + g4]; \
            _Pragma("unroll") for (int j = 0; j < 4; ++j) { \
                unsigned t0_, t1_, t2_, t3_; \
                PC_T4(buf[4 * g4][j], buf[4 * g4 + 1][j], buf[4 * g4 + 2][j], buf[4 * g4 + 3][j], t0_, t1_, t2_, t3_);        \
                of[4 * j + 0] = __builtin_amdgcn_sdot4((int)t0_, cq_, of[4 * j + 0], false); of[4 * j + 1] = __builtin_amdgcn_sdot4((int)t1_, cq_, of[4 * j + 1], false); \
                of[4 * j + 2] = __builtin_amdgcn_sdot4((int)t2_, cq_, of[4 * j + 2], false); of[4 * j + 3] = __builtin_amdgcn_sdot4((int)t3_, cq_, of[4 * j + 3], false); \
                ol[4 * j + 0] = __builtin_amdgcn_sdot4((int)(t0_ & 0x0F0F0F0Fu), cq_, ol[4 * j + 0], false); ol[4 * j + 1] = __builtin_amdgcn_sdot4((int)(t1_ & 0x0F0F0F0Fu), cq_, ol[4 * j + 1], false); \
                ol[4 * j + 2] = __builtin_amdgcn_sdot4((int)(t2_ & 0x0F0F0F0Fu), cq_, ol[4 * j + 2], false); ol[4 * j + 3] = __builtin_amdgcn_sdot4((int)(t3_ & 0x0F0F0F0Fu), cq_, ol[4 * j + 3], false); \
                asm volatile("" : "+v"(of[4 * j]), "+v"(of[4 * j + 1]), "+v"(of[4 * j + 2]), "+v"(of[4 * j + 3]), "+v"(ol[4 * j]), "+v"(ol[4 * j + 1]), "+v"(ol[4 * j + 2]), "+v"(ol[4 * j + 3])); } } } while (0)
#define PC_SB __builtin_amdgcn_sched_barrier(0)
    unsigned lid = ((const unsigned*)(gid + (size_t)tok0 * 128))[lane], lcq = lane < 32 ? ((const unsigned*)(gcq + (size_t)tok0 * 128))[lane] : 0u;
    ((LAS3 unsigned*)lw)[lane] = lid; if (lane < 32) ((LAS3 unsigned*)(lw + 256))[lane] = lcq;
    u32x4 bA[8], bB[8];
    PC_ISSUE(bA, 0, 0);
    for (int tt = 0; tt < 4; ++tt) {
        const int tok = tok0 + tt, lb = tt & 1;
        if (tt < 3) { lid = ((const unsigned*)(gid + (size_t)(tok + 1) * 128))[lane]; lcq = lane < 32 ? ((const unsigned*)(gcq + (size_t)(tok + 1) * 128))[lane] : 0u; }
        const float scc = gsc[2 * (size_t)tok], qsf = gsc[2 * (size_t)tok + 1];
        float xv[16]; load_row16_bf(xg + (size_t)tok * D, slot, xv);
        int of[16], ol[16];
#pragma unroll
        for (int i = 0; i < 16; ++i) { of[i] = 0; ol[i] = 0; }
#pragma unroll
        for (int vb = 0; vb < 8; vb += 2) {
            PC_ISSUE(bB, lb, vb + 1); PC_SB; PC_CV(bA, lb, vb); PC_SB;
            if (vb == 2 && tt < 3) { ((LAS3 unsigned*)(lw + 512 * (lb ^ 1)))[lane] = lid; if (lane < 32) ((LAS3 unsigned*)(lw + 512 * (lb ^ 1) + 256))[lane] = lcq; }
            if (vb + 2 < 8) PC_ISSUE(bA, lb, vb + 2); else if (tt < 3) PC_ISSUE(bA, lb ^ 1, 0);
            PC_SB; PC_CV(bB, lb, vb + 1); PC_SB;
        }
#pragma unroll
        for (int i = 0; i < 8; ++i) {
            const int jj = i >> 2, k = i & 3;
            auto rl = __builtin_amdgcn_permlane32_swap((unsigned)ol[4 * jj + k], (unsigned)ol[8 + 4 * jj + k], false, false);
            auto rf = __builtin_amdgcn_permlane32_swap((unsigned)of[4 * jj + k], (unsigned)of[8 + 4 * jj + k], false, false);
            const int sl = (int)rl[0] + (int)rl[1], sf = (int)rf[0] + (int)rf[1];
#ifndef HK_PROBE_NOPEER
            xv[8 * jj + k] += scc * ((float)sl - 8.f * qsf);
            xv[8 * jj + 4 + k] += scc * (float)((sf - sl) >> 4);
#else
            xv[8 * jj + k] += 1e-30f * (float)sl; xv[8 * jj + 4 + k] += 1e-30f * (float)sf;
#endif
        }
        const bool more = layer + 1 < DEPTH;
        int vzt_; asm volatile("v_mov_b32 %0, 0" : "=v"(vzt_) : "v"(xv[0]));
        finish_token(tok, xv, more ? nullptr : a.out, (bf16_t*)(a.ws + WS_XB), (float*)(a.ws + WS_RSTD), more ? (const float*)(a.ws + WS_WF) + (size_t)(layer + 1) * 4096 : nullptr,
                     a.in[2] + (more ? (layer + 1) * 4 : 0), (float*)(a.ws + WS_FLOG), lane, slot + vzt_);
    }
#undef PC_ISSUE
#undef PC_T4
#undef PC_CV
#undef PC_SB
}
__device__ __forceinline__ void peer_phase_c(const Args& a, unsigned char* lds, int layer) {
    int tid = threadIdx.x; asm volatile("" : "+v"(tid));
    const int lane = tid & 63, w = __builtin_amdgcn_readfirstlane(tid >> 6), c8 = lane & 7, r8 = lane >> 3;
    const int nun = (T / 32 - (int)blockIdx.x + (int)gridDim.x - 1) / (int)gridDim.x, N = 4 * nun;
    bf16_t* xg = (bf16_t*)(a.ws + WS_XB);
    const unsigned char* vt = a.ws + WS_VT;
    const unsigned short* gid = (const unsigned short*)(a.ws + WS_CIDX); const signed char* gcq = (const signed char*)(a.ws + WS_CQ); const float* gsc = (const float*)(a.ws + WS_CSC);
    LAS3 unsigned char* lw = (LAS3 unsigned char*)(lds + w * 1024);
    const bool more = layer + 1 < DEPTH;
    const float* wf = (const float*)(a.ws + WS_WF) + (size_t)(more ? layer + 1 : 0) * 4096; const float* bfor = a.in[2] + (more ? (layer + 1) * 4 : 0);
#define PS_TOK(n) (((int)blockIdx.x + ((n) >> 2) * (int)gridDim.x) * 32 + 4 * w + ((n) & 3))
#define PS_ISSUE(buf, lb, b) do { const LAS3 unsigned char* il_ = lw + 512 * (lb) + 2 * (64 * (b) + 4 * r8); _Pragma("unroll") for (int g4 = 0; g4 < 2; ++g4) { const u32x2 i4_ = *(const LAS3 u32x2*)(il_ + 64 * g4); \
        _Pragma("unroll") for (int k4 = 0; k4 < 4; ++k4) { const unsigned id_ = (k4 & 1 ? i4_[k4 >> 1] >> 16 : i4_[k4 >> 1] & 0xffffu); buf[4 * g4 + k4] = *(const u32x4*)(vt + (unsigned)(id_ * 512u + soff)); } } } while (0)
#define PS_T4(r0, r1, r2, r3, t0, t1, t2, t3) do { const unsigned a01l_ = __builtin_amdgcn_perm(r1, r0, 0x05010400u), a01h_ = __builtin_amdgcn_perm(r1, r0, 0x07030602u), \
            a23l_ = __builtin_amdgcn_perm(r3, r2, 0x05010400u), a23h_ = __builtin_amdgcn_perm(r3, r2, 0x07030602u); \
        t0 = __builtin_amdgcn_perm(a23l_, a01l_, 0x05040100u); t1 = __builtin_amdgcn_perm(a23l_, a01l_, 0x07060302u); \
        t2 = __builtin_amdgcn_perm(a23h_, a01h_, 0x05040100u); t3 = __builtin_amdgcn_perm(a23h_, a01h_, 0x07060302u); } while (0)
#define PS_CV(buf, lb, b) do { const LAS3 unsigned* cqw_ = (const LAS3 unsigned*)(lw + 512 * (lb) + 256); _Pragma("unroll") for (int g4 = 0; g4 < 2; ++g4) { const int cq_ = (int)cqw_[16 * (b) + 8 * g4 + r8]; const bool first_ = (b) == 0 && g4 == 0;       \
            _Pragma("unroll") for (int j = 0; j < 4; ++j) { \
                unsigned t0_, t1_, t2_, t3_; \
                PS_T4(buf[4 * g4][j], buf[4 * g4 + 1][j], buf[4 * g4 + 2][j], buf[4 * g4 + 3][j], t0_, t1_, t2_, t3_);        \
                of[4 * j + 0] = (first_ ? __builtin_amdgcn_sdot4((int)t0_, cq_, 0, true) : __builtin_amdgcn_sdot4((int)t0_, cq_, of[4 * j + 0], false)); of[4 * j + 1] = (first_ ? __builtin_amdgcn_sdot4((int)t1_, cq_, 0, true) : __builtin_amdgcn_sdot4((int)t1_, cq_, of[4 * j + 1], false)); \
                of[4 * j + 2] = (first_ ? __builtin_amdgcn_sdot4((int)t2_, cq_, 0, true) : __builtin_amdgcn_sdot4((int)t2_, cq_, of[4 * j + 2], false)); of[4 * j + 3] = (first_ ? __builtin_amdgcn_sdot4((int)t3_, cq_, 0, true) : __builtin_amdgcn_sdot4((int)t3_, cq_, of[4 * j + 3], false)); \
                ol[4 * j + 0] = (first_ ? __builtin_amdgcn_sdot4((int)(t0_ & 0x0F0F0F0Fu), cq_, 0, true) : __builtin_amdgcn_sdot4((int)(t0_ & 0x0F0F0F0Fu), cq_, ol[4 * j + 0], false)); ol[4 * j + 1] = (first_ ? __builtin_amdgcn_sdot4((int)(t1_ & 0x0F0F0F0Fu), cq_, 0, true) : __builtin_amdgcn_sdot4((int)(t1_ & 0x0F0F0F0Fu), cq_, ol[4 * j + 1], false)); \
                ol[4 * j + 2] = (first_ ? __builtin_amdgcn_sdot4((int)(t2_ & 0x0F0F0F0Fu), cq_, 0, true) : __builtin_amdgcn_sdot4((int)(t2_ & 0x0F0F0F0Fu), cq_, ol[4 * j + 2], false)); ol[4 * j + 3] = (first_ ? __builtin_amdgcn_sdot4((int)(t3_ & 0x0F0F0F0Fu), cq_, 0, true) : __builtin_amdgcn_sdot4((int)(t3_ & 0x0F0F0F0Fu), cq_, ol[4 * j + 3], false)); \
                asm volatile("" : "+v"(of[4 * j]), "+v"(of[4 * j + 1]), "+v"(of[4 * j + 2]), "+v"(of[4 * j + 3]), "+v"(ol[4 * j]), "+v"(ol[4 * j + 1]), "+v"(ol[4 * j + 2]), "+v"(ol[4 * j + 3])); } } } while (0)
#define PS_SB __builtin_amdgcn_sched_barrier(0)
#pragma unroll 1
    for (int s = 0; s < 4; ++s) {
        const int e0 = 256 * s + 32 * c8 + 4 * r8;
        const unsigned soff = 128u * (unsigned)s + 16u * (unsigned)c8;
        {
#pragma unroll
            for (int q = 0; q < 2; ++q) { const int tq = PS_TOK(q);
                const unsigned lidq = ((const unsigned*)(gid + (size_t)tq * 128))[lane], lcqq = lane < 32 ? ((const unsigned*)(gcq + (size_t)tq * 128))[lane] : 0u;
                ((LAS3 unsigned*)(lw + 512 * q))[lane] = lidq; if (lane < 32) ((LAS3 unsigned*)(lw + 512 * q + 256))[lane] = lcqq; }
        }
        u32x4 bA[8], bB[8], bC[8], bD[8];
        PS_ISSUE(bA, 0, 0); PS_ISSUE(bB, 0, 1);
#define PS_BODY(n_, X0, X1, Y0, Y1) do { const int n = (n_), tok = PS_TOK(n), lb = n & 1; \
            const bool nx2 = n + 2 < N; unsigned lid = 0u, lcq = 0u; \
            if (nx2) { const int tn = PS_TOK(n + 2); lid = ((const unsigned*)(gid + (size_t)tn * 128))[lane]; lcq = lane < 32 ? ((const unsigned*)(gcq + (size_t)tn * 128))[lane] : 0u; } \
            if (n + 1 < N) { PS_ISSUE(Y0, lb ^ 1, 0); PS_ISSUE(Y1, lb ^ 1, 1); } \
            const float scc = gsc[2 * (size_t)tok], qsf = gsc[2 * (size_t)tok + 1]; \
            const u32x2 xr = *(const u32x2*)(xg + (size_t)tok * D + e0); \
            int of[16], ol[16];         \
            PS_SB; PS_CV(X0, lb, 0); PS_SB; PS_CV(X1, lb, 1); PS_SB; \
            if (nx2) { ((LAS3 unsigned*)(lw + 512 * lb))[lane] = lid; if (lane < 32) ((LAS3 unsigned*)(lw + 512 * lb + 256))[lane] = lcq; }        \
              \
            int y[16], z[8]; \
            _Pragma("unroll") for (int i = 0; i < 8; ++i) { \
                auto rf = __builtin_amdgcn_permlane32_swap((unsigned)of[i], (unsigned)of[8 + i], false, false); y[i] = (int)rf[0] + (int)rf[1]; \
                auto rl = __builtin_amdgcn_permlane32_swap((unsigned)ol[i], (unsigned)ol[8 + i], false, false); y[8 + i] = (int)rl[0] + (int)rl[1]; } \
            _Pragma("unroll") for (int i = 0; i < 4; ++i) { \
                auto rf = __builtin_amdgcn_permlane16_swap((unsigned)y[i], (unsigned)y[4 + i], false, false); z[i] = (int)rf[0] + (int)rf[1]; \
                auto rl = __builtin_amdgcn_permlane16_swap((unsigned)y[8 + i], (unsigned)y[12 + i], false, false); z[4 + i] = (int)rl[0] + (int)rl[1]; } \
            _Pragma("unroll") for (int i = 0; i < 8; ++i) z[i] += __builtin_amdgcn_update_dpp(0, z[i], 0x128, 0xf, 0xf, true);         \
            float xn[4]; \
            _Pragma("unroll") for (int k = 0; k < 4; ++k) { \
                const float vl = (float)z[4 + k] - 8.f * qsf, vh = (float)((z[k] - z[4 + k]) >> 4); \
                const unsigned xw = xr[k >> 1]; \
                xn[k] = (k & 1 ? __uint_as_float(xw & 0xffff0000u) : __uint_as_float(xw << 16)) + scc * ((r8 & 1) ? vh : vl); } \
            if (more) { u32x2 o; o.x = pk2(xn[0], xn[1]); o.y = pk2(xn[2], xn[3]); *(u32x2*)(xg + (size_t)tok * D + e0) = o; } \
            else *(f32x4*)(a.out + (size_t)tok * D + e0) = (f32x4){xn[0], xn[1], xn[2], xn[3]}; } while (0)
#pragma unroll 1
        for (int n2 = 0; n2 < N; n2 += 2) {
            PS_BODY(n2, bA, bB, bC, bD);
            PS_BODY(n2 + 1, bC, bD, bA, bB);
        }
#undef PS_BODY
    }
    if (more) {
        __builtin_amdgcn_fence(__ATOMIC_ACQ_REL, "workgroup");
        f32x4 wg[4][4];
#pragma unroll
        for (int h = 0; h < 4; ++h)
#pragma unroll
            for (int j = 0; j < 4; ++j) wg[h][j] = *(const f32x4*)(wf + h * 1024 + 16 * lane + 4 * j);
        const int myh = ((lane >> 4) & 1) * 2 + (lane >> 5);
        const float mybf = bfor[myh];
#pragma unroll 1
        for (int n = 0; n < N; ++n) {
            const int tok = PS_TOK(n);
            float xv[16]; load_row16_bf(xg + (size_t)tok * D, lane, xv);
            float ss = 0.f, g[4] = {0.f, 0.f, 0.f, 0.f};
#pragma unroll
            for (int i = 0; i < 16; ++i) { ss += xv[i] * xv[i];
#pragma unroll
                for (int h = 0; h < 4; ++h) g[h] += xv[i] * wg[h][i >> 2][i & 3]; }
            auto r01 = __builtin_amdgcn_permlane32_swap(__float_as_uint(g[0]), __float_as_uint(g[1]), false, false); const float q01 = __uint_as_float(r01[0]) + __uint_as_float(r01[1]);
            auto r23 = __builtin_amdgcn_permlane32_swap(__float_as_uint(g[2]), __float_as_uint(g[3]), false, false); const float q23 = __uint_as_float(r23[0]) + __uint_as_float(r23[1]);
            auto rq = __builtin_amdgcn_permlane16_swap(__float_as_uint(q01), __float_as_uint(q23), false, false); float q = __uint_as_float(rq[0]) + __uint_as_float(rq[1]);
            q += __uint_as_float(__builtin_amdgcn_update_dpp(0, __float_as_uint(q), 0x128, 0xf, 0xf, true)); q += __uint_as_float(__builtin_amdgcn_update_dpp(0, __float_as_uint(q), 0x124, 0xf, 0xf, true));
            q += __uint_as_float(__builtin_amdgcn_update_dpp(0, __float_as_uint(q), 0x122, 0xf, 0xf, true)); q += __uint_as_float(__builtin_amdgcn_update_dpp(0, __float_as_uint(q), 0x121, 0xf, 0xf, true));
            ss += __uint_as_float(__builtin_amdgcn_update_dpp(0, __float_as_uint(ss), 0x128, 0xf, 0xf, true)); ss += __uint_as_float(__builtin_amdgcn_update_dpp(0, __float_as_uint(ss), 0x124, 0xf, 0xf, true));
            ss += __uint_as_float(__builtin_amdgcn_update_dpp(0, __float_as_uint(ss), 0x122, 0xf, 0xf, true)); ss += __uint_as_float(__builtin_amdgcn_update_dpp(0, __float_as_uint(ss), 0x121, 0xf, 0xf, true));
            ss = half_swap_sum(ss);
            { auto r = __builtin_amdgcn_permlane16_swap(__float_as_uint(ss), __float_as_uint(ss), false, false); ss = __uint_as_float(r[0]) + __uint_as_float(r[1]); }
            const float rs = __builtin_amdgcn_rsqf(ss * (1.f / 1024.f) + EPS);
            if (lane == 0) ((float*)(a.ws + WS_RSTD))[tok] = rs;
            if ((lane & 15) == 0) { const int b = tok / S, sq = tok % S; ((float*)(a.ws + WS_FLOG))[((size_t)b * 4 + myh) * S + sq] = log_sigmoid(q * rs + mybf); }
        }
    }
#undef PS_TOK
#undef PS_ISSUE
#undef PS_T4
#undef PS_CV
#undef PS_SB
}
}
namespace hk {
#ifndef HK_ALIGN1
#define HK_ALIGN1 true
#endif
#ifndef HK_ALIGN2
#define HK_ALIGN2 true
#endif
#ifndef HK_ALIGN3
#define HK_ALIGN3 true
#endif
constexpr int NPL = 6 + HK_PEER_SPLIT;
constexpr int NPHASE = 2 + NPL * DEPTH;
__device__ __forceinline__ unsigned q_next(unsigned* ctr, unsigned char* lds) {
    volatile LAS3 unsigned* slot = (volatile LAS3 unsigned*)(LAS3 unsigned char*)(lds + LDS_CTL + 32);
    __syncthreads();
    if (threadIdx.x == 0) *slot = __hip_atomic_fetch_add(ctr, 1u, __ATOMIC_RELAXED, __HIP_MEMORY_SCOPE_AGENT);
    __syncthreads();
    return *slot;
}
__device__ __forceinline__ unsigned q_publish(unsigned nxt, unsigned char* lds) {
    volatile LAS3 unsigned* slot = (volatile LAS3 unsigned*)(LAS3 unsigned char*)(lds + LDS_CTL + 32);
    __syncthreads();
    if (threadIdx.x == 0) *slot = nxt;
    __syncthreads();
    return *slot;
}
#define SEAM(k) do { if (a.use_bar && (k) >= a.ph_lo && (k) + 1 < a.ph_hi) { xcd_barrier(bar); } } while (0)
#define ON(k) ((k) >= a.ph_lo && (k) < a.ph_hi)
#ifdef HK_PROBE_PHASE
#define PROBE_T0(k) unsigned long long pt0_ = 0; if ((k) == HK_PROBE_PHASE && blockIdx.x == 0 && threadIdx.x == 0) pt0_ = __builtin_amdgcn_s_memrealtime();
#define PROBE_T1(k) if ((k) == HK_PROBE_PHASE && blockIdx.x == 0 && threadIdx.x == 0) { volatile LAS3 unsigned* pw_ = (volatile LAS3 unsigned*)(LAS3 unsigned char*)(lds + LDS_CTL + 48); *pw_ = *pw_ + (unsigned)(__builtin_amdgcn_s_memrealtime() - pt0_); }
#else
#define PROBE_T0(k)
#define PROBE_T1(k)
#endif
template <int l>
__device__ __forceinline__ void layer_phases(const Args& a, unsigned char* lds, const XcdBarrier& bar, unsigned* ctl) {
        const int pb = 2 + NPL * l;
        { PROBE_T0(0)
        if (ON(pb)) {
            if (blockIdx.x < NB * 4) cum_scan(a, lds, blockIdx.x);
            pg8::Gemm g; g.A = (const bf16_t*)(a.ws + WS_XB); g.Bt = (const bf16_t*)(a.ws + WS_WIN) + (size_t)l * 2560 * 1024; g.M = T; g.N = 2560; g.K = 1024;
            pg8::StaticOrder so; so.init(T, 2560, gridDim.x, blockIdx.x);
            pg8::EpiIn E; E.zb = (bf16_t*)(a.ws + WS_ZB); E.su32 = (float*)(a.ws + WS_SU); E.rstd = (const float*)(a.ws + WS_RSTD);
            E.g_fq = a.in[6] + l * 64; E.g_fk = a.in[7] + l * 64; E.g_dq = a.in[8] + l * 64; E.g_dk = a.in[9] + l * 64; E.g_cq = a.in[10] + l * 32; E.g_ck = a.in[11] + l * 32;
#ifndef HK_NO_G1
            pg8::gemm_phase<pg8::EpiIn, pg8::StaticOrder, HK_ALIGN1, true>((PG8_LAS unsigned char*)lds, g, so, E);
#endif
        }
        SEAM(pb);
        PROBE_T1(0) }
        { PROBE_T0(1)
        if (ON(pb + 1)) {
            unsigned* ctr = ctl + CTL_Q + 64 * (l + 4 * a.pad0);
            unsigned u = q_next(ctr, lds);
            while (u < 5632u) {
                unsigned nxt_ = 0u; if (threadIdx.x == 0) nxt_ = __hip_atomic_fetch_add(ctr, 1u, __ATOMIC_RELAXED, __HIP_MEMORY_SCOPE_AGENT);
                if (u < 1024u) {
#ifndef HK_NO_DIFF
 diff_unit(a, lds, l, u & 31, 31 - (u >> 5));
#endif
 }
                else if (u < 1536u) {
#ifndef HK_NO_FOX
 fox64_unit(a, lds, l, (u - 1024u) & 31, 15 - ((u - 1024u) >> 5));
#endif
 }
                else if (u < 4608u) { const unsigned j = u - 1536u, br = j >> 10, jj = j & 1023u, bh = jj & 31u, sub = jj >> 5;
                    const int rho = br == 0 ? 0 : (br == 1 ? (sub & 3) : (sub & 15)), tile = br == 0 ? sub : (br == 1 ? (sub >> 2) : (sub >> 4));

#ifndef HK_NO_DIL
                    dil_unit(a, lds, bh, br, rho, tile);
#endif
 }
                else { const unsigned j = u - 4608u;
#ifndef HK_NO_S51
 s5_pass1_unit(a, lds, l, j >> 7, j & 127u);
#endif
 }
                u = q_publish(nxt_, lds);
            }
        }
        SEAM(pb + 1);
        PROBE_T1(1) }
        { PROBE_T0(2)
        if (ON(pb + 2)) {
#ifndef HK_NO_S52
            { PROBE_T0(12)
            for (int u = blockIdx.x; u < 256; u += gridDim.x) s5_pass2_unit(a, lds, l, u >> 5, u & 31);
            PROBE_T1(12) }
#endif
            { PROBE_T0(13)
            phase_p3_elementwise(a, l);
            PROBE_T1(13) }
        }
        SEAM(pb + 2);
        PROBE_T1(2) }
        { PROBE_T0(3)
        if (ON(pb + 3)) {
            pg8::Gemm g; g.A = (const bf16_t*)(a.ws + WS_MIX); g.Bt = (const bf16_t*)(a.ws + WS_WOUT) + (size_t)l * 1024 * 1024; g.M = T; g.N = 1024; g.K = 1024;
            pg8::StaticOrder so; so.init(T, 1024, gridDim.x, blockIdx.x);
            pg8::EpiOut E; E.xb = (bf16_t*)(a.ws + WS_XB);
#ifndef HK_NO_G2
            pg8::gemm_phase<pg8::EpiOut, pg8::StaticOrder, HK_ALIGN2, true>((PG8_LAS unsigned char*)lds, g, so, E);
#endif
        }
        SEAM(pb + 3);
        PROBE_T1(3) }
        { PROBE_T0(4)
        if (ON(pb + 4)) {
            pg8::Gemm g; g.A = (const bf16_t*)(a.ws + WS_XB); g.Bt = (const bf16_t*)(a.ws + WS_WQ) + (size_t)l * 2048 * 1024; g.M = T; g.N = 2048; g.K = 1024;
            pg8::StaticOrder so; so.init(T, 2048, gridDim.x, blockIdx.x);
#if HK_FOLD_KEYS
            pg8::EpiF16 E; E.O = (bf16_t*)(a.ws + WS_ZB); E.ldc = 2048;
#ifndef HK_NO_G3
            pg8::gemm_phase<pg8::EpiF16, pg8::StaticOrder, HK_ALIGN3, true>((PG8_LAS unsigned char*)lds, g, so, E);
#endif
#else
            pg8::EpiPlain E; E.O = (bf16_t*)(a.ws + WS_ZB); E.ldc = 2048;
#ifndef HK_NO_G3
            pg8::gemm_phase<pg8::EpiPlain, pg8::StaticOrder, HK_ALIGN3, true>((PG8_LAS unsigned char*)lds, g, so, E);
#endif
#endif
        }
        SEAM(pb + 4);
        PROBE_T1(4) }
        { PROBE_T0(5)
        if (ON(pb + 5)) {
#ifndef HK_NO_PEER
#if HK_PEER_SPLIT
            for (int u = blockIdx.x; u < T / 32; u += gridDim.x) peer_unit_a(a, lds, l, u);
#else
            for (int u = blockIdx.x; u < T / 32; u += gridDim.x) peer_unit(a, lds, l, u);
#endif
#endif
        }
#if HK_PEER_SPLIT && !defined(HK_AC_BAR)
        __builtin_amdgcn_fence(__ATOMIC_RELEASE, "workgroup"); __syncthreads(); __builtin_amdgcn_fence(__ATOMIC_ACQUIRE, "workgroup");
#else
        SEAM(pb + 5);
#endif
        PROBE_T1(5) }
#if HK_PEER_SPLIT
        { PROBE_T0(6)
        if (ON(pb + 6)) {
#ifndef HK_NO_PEER
#ifdef HK_C_UNSLICED
            for (int u = blockIdx.x; u < T / 32; u += gridDim.x) peer_unit_c(a, lds, l, u);
#else
            peer_phase_c(a, lds, l);
#endif
#endif
        }
        SEAM(pb + 6);
        PROBE_T1(6) }
#endif
    }
__global__ void __launch_bounds__(NTHR, 2) hk_mega(Args a) {
    extern __shared__ __attribute__((aligned(16))) unsigned char lds[];
    const int tid = threadIdx.x;
    if (tid < 64) ((LAS3 unsigned*)(lds + LDS_CTL))[tid] = 0u;
    __syncthreads();
    unsigned* ctl = (unsigned*)(a.ws + WS_CTL);
    XcdBarrier bar = xcd_barrier_post(ctl + CTL_BAR, (volatile LAS unsigned*)(LAS3 unsigned char*)(lds + LDS_CTL));
    if (ON(0)) phase_weights(a, lds);
    SEAM(0);
    if (ON(1)) phase_xprep(a);
    SEAM(1);
    layer_phases<0>(a, lds, bar, ctl);
    layer_phases<1>(a, lds, bar, ctl);
    layer_phases<2>(a, lds, bar, ctl);
    layer_phases<3>(a, lds, bar, ctl);
#ifdef HK_PROBE_PHASE
    if (blockIdx.x == 0 && threadIdx.x == 0) { const unsigned span = *(volatile LAS3 unsigned*)(LAS3 unsigned char*)(lds + LDS_CTL + 48); const unsigned long long t0 = __builtin_amdgcn_s_memrealtime();
        while (__builtin_amdgcn_s_memrealtime() - t0 < 4ull * span) __builtin_amdgcn_s_sleep(32); }
#endif
}
#undef SEAM
#undef ON
}
namespace nv {
using namespace hk;
__global__ void __launch_bounds__(64) n_fox(const bf16_t* __restrict__ zb, const float* __restrict__ cum2, bf16_t* __restrict__ mix) {
    int gid = blockIdx.x * 64 + threadIdx.x;
    int t = S - 1 - (gid % S); int bh = gid / S; int b = bh / 4, h = bh % 4;
    const bf16_t* z = zb + (size_t)b * S * ZP; const float* cm = cum2 + (size_t)bh * S;
    float q[64], o[64];
#pragma unroll
    for (int i = 0; i < 64; ++i) { q[i] = bf2f(z[(size_t)t * ZP + ZC_FQ + h * 64 + i]); o[i] = 0.f; }
    float m = -INFINITY, l = 0.f, cq = cm[t];
    int tmax = __shfl(t, 0);
    for (int s = 0; s <= tmax; ++s) {
        const bf16_t* kp = z + (size_t)s * ZP + ZC_FK + h * 64; const bf16_t* vp = z + (size_t)s * ZP + ZC_FV + h * 64;
        float d = 0.f;
#pragma unroll
        for (int i = 0; i < 64; ++i) d += q[i] * bf2f(kp[i]);
        d += cq - cm[s];
        if (s <= t) {
            float mn = fmaxf(m, d), al = exp2f(m - mn), p = exp2f(d - mn);
            l = l * al + p;
#pragma unroll
            for (int i = 0; i < 64; ++i) o[i] = o[i] * al + p * bf2f(vp[i]);
            m = mn;
        }
    }
    float inv = 1.f / l;
    bf16_t* op = mix + ((size_t)b * S + t) * D + h * 64;
#pragma unroll
    for (int i = 0; i < 64; ++i) op[i] = f2bf(o[i] * inv);
}
__global__ void __launch_bounds__(64) n_dil(const bf16_t* __restrict__ zb, const float* __restrict__ tb, bf16_t* __restrict__ mix) {
    int gid = blockIdx.x * 64 + threadIdx.x;
    int t = gid % S; int bh = gid / S; int b = bh / 4, h = bh % 4;
    const bf16_t* z = zb + (size_t)b * S * ZP;
    float q[64], o[64];
#pragma unroll
    for (int i = 0; i < 64; ++i) { q[i] = bf2f(z[(size_t)t * ZP + ZC_DQ + h * 64 + i]); o[i] = 0.f; }
    float m = -INFINITY, l = 0.f;
    for (int br = 0; br < 3; ++br) {
        int r = br == 0 ? 1 : (br == 1 ? 4 : 16);
        for (int j = 0; j <= 128; ++j) {
            bool ok = (t / r - j) >= 0; int sc = ok ? t - j * r : t;
            const bf16_t* kp = z + (size_t)sc * ZP + ZC_DK + h * 64; const bf16_t* vp = z + (size_t)sc * ZP + ZC_DV + h * 64;
            float d = 0.f;
#pragma unroll
            for (int i = 0; i < 64; ++i) d += q[i] * bf2f(kp[i]);
            d += tb[h * TBN + r * j];
            if (ok) {
                float mn = fmaxf(m, d), al = exp2f(m - mn), p = exp2f(d - mn);
                l = l * al + p;
#pragma unroll
                for (int i = 0; i < 64; ++i) o[i] = o[i] * al + p * bf2f(vp[i]);
                m = mn;
            }
        }
    }
    float inv = 1.f / l;
    bf16_t* op = mix + ((size_t)b * S + t) * D + 256 + h * 64;
#pragma unroll
    for (int i = 0; i < 64; ++i) op[i] = f2bf(o[i] * inv);
}
template <int CMP>
__global__ void __launch_bounds__(64) n_diff(const bf16_t* __restrict__ zb, const float* __restrict__ tb, float* __restrict__ tmp) {
    int gid = blockIdx.x * 64 + threadIdx.x;
    int t = S - 1 - (gid % S); int bh = gid / S; int b = bh / 4, h = bh % 4;
    const bf16_t* z = zb + (size_t)b * S * ZP;
    float q[32], o[64];
#pragma unroll
    for (int i = 0; i < 32; ++i) q[i] = bf2f(z[(size_t)t * ZP + ZC_CQ + h * 64 + CMP * 32 + i]);
#pragma unroll
    for (int i = 0; i < 64; ++i) o[i] = 0.f;
    float m = -INFINITY, l = 0.f;
    int tmax = __shfl(t, 0);
    for (int s = 0; s <= tmax; ++s) {
        const bf16_t* kp = z + (size_t)s * ZP + ZC_CK + h * 64 + CMP * 32; const bf16_t* vp = z + (size_t)s * ZP + ZC_CV + h * 64;
        float d = 0.f;
#pragma unroll
        for (int i = 0; i < 32; ++i) d += q[i] * bf2f(kp[i]);
        int rel = t - s; int ri = rel < 0 ? 0 : (rel > 2000 ? 2000 : rel);
        d += tb[(4 + h) * TBN + ri];
        if (rel >= 0) {
            float mn = fmaxf(m, d), al = exp2f(m - mn), p = exp2f(d - mn);
            l = l * al + p;
#pragma unroll
            for (int i = 0; i < 64; ++i) o[i] = o[i] * al + p * bf2f(vp[i]);
            m = mn;
        }
    }
    float inv = 1.f / l;
    float* op = tmp + ((size_t)b * S + t) * 256 + h * 64;
#pragma unroll
    for (int i = 0; i < 64; ++i) op[i] = o[i] * inv;
}
__global__ void n_diff_fin(const float* __restrict__ tmp0, const float* __restrict__ tmp1, const float* __restrict__ lamp, const float* __restrict__ gain, float lam_init, bf16_t* __restrict__ mix) {
    size_t gid = (size_t)blockIdx.x * blockDim.x + threadIdx.x;
    if (gid >= (size_t)T * 4) return;
    size_t tok = gid / 4; int h = (int)(gid % 4);
    float s1 = 0.f, s2 = 0.f;
    for (int i = 0; i < 32; ++i) { s1 += lamp[i] * lamp[32 + i]; s2 += lamp[64 + i] * lamp[96 + i]; }
    float lam = expf(s1) - expf(s2) + lam_init;
    const float* p0 = tmp0 + tok * 256 + h * 64; const float* p1 = tmp1 + tok * 256 + h * 64;
    float ss = 0.f;
    for (int i = 0; i < 64; ++i) { float v = p0[i] - lam * p1[i]; ss += v * v; }
    float r = rsqrtf(ss / 64 + EPS) * (1.f - lam_init);
    bf16_t* op = mix + tok * D + 512 + h * 64;
    for (int i = 0; i < 64; ++i) op[i] = f2bf((p0[i] - lam * p1[i]) * r * gain[i]);
}
__global__ void __launch_bounds__(64) n_s5(const bf16_t* __restrict__ su, const float* a_re, const float* a_im, const float* log_dt, const float* b_re, const float* b_im,
                                           const float* c_re, const float* c_im, const float* dsk, float* __restrict__ gbuf) {
    int b = blockIdx.x / 16, g = blockIdx.x % 16, n = threadIdx.x;
    float dt = expf(log_dt[g]);
    float ar = a_re[g * 64 + n], ai = a_im[g * 64 + n];
    float mag = expf(dt * ar);
    float abr = mag * cosf(dt * ai), abi = mag * sinf(dt * ai);
    float den = ar * ar + ai * ai, nr = abr - 1.f, ni = abi;
    float cr = (nr * ar + ni * ai) / den, ci = (ni * ar - nr * ai) / den;
    float bbr[16], bbi[16], ccr[16], cci[16];
#pragma unroll
    for (int c = 0; c < 16; ++c) {
        float br = b_re[(g * 64 + n) * 16 + c], bi = b_im[(g * 64 + n) * 16 + c];
        bbr[c] = cr * br - ci * bi; bbi[c] = cr * bi + ci * br;
        ccr[c] = c_re[(g * 16 + c) * 64 + n]; cci[c] = c_im[(g * 16 + c) * 64 + n];
    }
    float dk = (n < 16) ? dsk[g * 16 + n] : 0.f;
    float xr = 0.f, xi = 0.f;
    for (int s = 0; s < S; ++s) {
        const bf16_t* up = su + ((size_t)b * S + s) * 256 + g * 16;
        float u[16];
#pragma unroll
        for (int c = 0; c < 16; ++c) u[c] = bf2f(up[c]);
        float pr = 0.f, pi = 0.f;
#pragma unroll
        for (int c = 0; c < 16; ++c) { pr += bbr[c] * u[c]; pi += bbi[c] * u[c]; }
        float nxr = abr * xr - abi * xi + pr, nxi = abr * xi + abi * xr + pi;
        xr = nxr; xi = nxi;
        float myy = 0.f;
#pragma unroll
        for (int c = 0; c < 16; ++c) { float v = wave_sum(ccr[c] * xr - cci[c] * xi); if (n == c) myy = v + dk * u[c]; }
        if (n < 16) gbuf[((size_t)b * S + s) * 256 + g * 16 + n] = gelu_tanh(myy);
    }
}
__global__ void __launch_bounds__(256) n_glu(const float* __restrict__ gbuf, const float* __restrict__ w, const float* __restrict__ bias, bf16_t* __restrict__ mix) {
    __shared__ float gs[256];
    size_t tok = blockIdx.x; int j = threadIdx.x;
    gs[j] = gbuf[tok * 256 + j];
    __syncthreads();
    float acc = bias[j];
    for (int k = 0; k < 256; ++k) acc += gs[k] * w[k * 256 + j];
    mix[tok * D + 768 + j] = f2bf(gs[j] * (1.f / (1.f + expf(-acc))));
}
template <int MODE>
__global__ void __launch_bounds__(256) n_gemm(const bf16_t* __restrict__ A, const float* __restrict__ g, const float* __restrict__ B, float* __restrict__ X, bf16_t* __restrict__ O, int M, int N, int K) {
    __shared__ float As[16][68];
    __shared__ float Bs[16][68];
    const int tx = threadIdx.x & 15, ty = threadIdx.x >> 4;
    const int m0 = blockIdx.y * 64, n0 = blockIdx.x * 64;
    float acc[4][4];
#pragma unroll
    for (int i = 0; i < 4; ++i)
#pragma unroll
        for (int j = 0; j < 4; ++j) acc[i][j] = 0.f;
    for (int k0 = 0; k0 < K; k0 += 16) {
        { int r = threadIdx.x >> 2, c4 = (threadIdx.x & 3) * 4;
          const bf16_t* ap = A + (size_t)(m0 + r) * K + k0 + c4;
#pragma unroll
          for (int j = 0; j < 4; ++j) { float v = bf2f(ap[j]); if (g) v *= g[k0 + c4 + j]; As[c4 + j][r] = v; }
          int br = threadIdx.x >> 4, bc = (threadIdx.x & 15) * 4;
#pragma unroll
          for (int j = 0; j < 4; ++j) Bs[br][bc + j] = B[(size_t)(k0 + br) * N + n0 + bc + j]; }
        __syncthreads();
#pragma unroll
        for (int kk = 0; kk < 16; ++kk) {
            float av[4], bv[4];
#pragma unroll
            for (int i = 0; i < 4; ++i) av[i] = As[kk][ty * 4 + i];
#pragma unroll
            for (int j = 0; j < 4; ++j) bv[j] = Bs[kk][tx * 4 + j];
#pragma unroll
            for (int i = 0; i < 4; ++i)
#pragma unroll
                for (int j = 0; j < 4; ++j) acc[i][j] += av[i] * bv[j];
        }
        __syncthreads();
    }
#pragma unroll
    for (int i = 0; i < 4; ++i)
#pragma unroll
        for (int j = 0; j < 4; ++j) {
            size_t off = (size_t)(m0 + ty * 4 + i) * N + n0 + tx * 4 + j;
            if (MODE == 0) { float v = X[off] + acc[i][j]; X[off] = v; O[off] = f2bf(v); } else O[off] = f2bf(acc[i][j]);
        }
}
__global__ void n_rstd(const float* __restrict__ x, float* __restrict__ rstd) {
    int row = blockIdx.x * 4 + (threadIdx.x >> 6), lane = threadIdx.x & 63;
    const float* p = x + (size_t)row * D;
    float s = 0.f;
    for (int i = lane; i < D; i += 64) { float v = p[i]; s += v * v; }
    s = wave_sum(s);
    if (lane == 0) rstd[row] = rsqrtf(s / D + EPS);
}
__global__ void __launch_bounds__(256) n_top1(const bf16_t* __restrict__ q, const float* __restrict__ keys, float* __restrict__ tv, int* __restrict__ ti) {
    extern __shared__ float ks[];
    int hp = blockIdx.y; size_t tok = (size_t)blockIdx.x * 256 + threadIdx.x;
    const float* kg = keys + (size_t)hp * 128 * 128;
    for (int i = threadIdx.x; i < 128 * 128; i += 256) ks[i] = kg[i];
    __syncthreads();
    float qv[128];
    const bf16_t* qp = q + tok * 2048 + hp * 128;
#pragma unroll
    for (int i = 0; i < 128; ++i) qv[i] = bf2f(qp[i]);
    float bv[16]; int bi[16];
#pragma unroll
    for (int j = 0; j < 16; ++j) { bv[j] = -INFINITY; bi[j] = 0; }
    for (int k = 0; k < 128; ++k) {
        float d = 0.f;
#pragma unroll
        for (int i = 0; i < 128; ++i) d += qv[i] * ks[k * 128 + i];
        float cv = d; int ci = k;
#pragma unroll
        for (int j = 0; j < 16; ++j) { if (cv > bv[j]) { float tvv = bv[j]; int tii = bi[j]; bv[j] = cv; bi[j] = ci; cv = tvv; ci = tii; } }
    }
    float* ov = tv + (tok * 16 + hp) * 16; int* oi = ti + (tok * 16 + hp) * 16;
#pragma unroll
    for (int j = 0; j < 16; ++j) { ov[j] = bv[j]; oi[j] = bi[j]; }
}
__global__ void __launch_bounds__(256) n_top2(const float* __restrict__ tv, const int* __restrict__ ti, const float* __restrict__ rstd2, int* __restrict__ ids, float* __restrict__ gates) {
    size_t gid = (size_t)blockIdx.x * 256 + threadIdx.x;
    const float* v0 = tv + gid * 32; const float* v1 = v0 + 16; const int* i0 = ti + gid * 32; const int* i1 = i0 + 16;
    const float rs = rstd2[gid >> 3];
    float av[16], bb[16];
#pragma unroll
    for (int i = 0; i < 16; ++i) { av[i] = v0[i]; bb[i] = v1[i]; }
    float bv[16]; int bi[16];
#pragma unroll
    for (int j = 0; j < 16; ++j) { bv[j] = -INFINITY; bi[j] = 0; }
#pragma unroll
    for (int i = 0; i < 16; ++i)
#pragma unroll
        for (int jj = 0; jj < 16; ++jj) {
            float cv = av[i] + bb[jj]; int ci = i * 16 + jj;
#pragma unroll
            for (int j = 0; j < 16; ++j) { if (cv > bv[j]) { float tvv = bv[j]; int tii = bi[j]; bv[j] = cv; bi[j] = ci; cv = tvv; ci = tii; } }
        }
    float mx = bv[0], sum = 0.f;
#pragma unroll
    for (int j = 0; j < 16; ++j) { bv[j] = expf((bv[j] - mx) * rs); sum += bv[j]; }
    float inv = 1.f / sum;
#pragma unroll
    for (int j = 0; j < 16; ++j) { int pi = bi[j] >> 4, pj = bi[j] & 15; ids[gid * 16 + j] = i0[pi] * 128 + i1[pj]; gates[gid * 16 + j] = bv[j] * inv; }
}
__global__ void __launch_bounds__(256) n_gather(float* __restrict__ x, const float* __restrict__ rstd2, const float* __restrict__ gn, const int* __restrict__ ids,
                                                const float* __restrict__ gates, const float* __restrict__ ut, const float* __restrict__ vt) {
    __shared__ float hs[1024];
    __shared__ float act[128];
    size_t tok = blockIdx.x; int tid = threadIdx.x, lane = tid & 63, w = tid >> 6;
    float r = rstd2[tok];
    float* xp = x + tok * D;
    for (int i = tid; i < D; i += 256) hs[i] = xp[i] * r * gn[i];
    __syncthreads();
    for (int k = w; k < 128; k += 4) {
        int id = ids[tok * 128 + k];
        const float* up = ut + (size_t)id * D;
        float s = 0.f;
        for (int i = lane; i < D; i += 64) s += hs[i] * up[i];
        s = wave_sum(s);
        if (lane == 0) act[k] = gelu_tanh(s) * gates[tok * 128 + k];
    }
    __syncthreads();
    float o[4] = {0.f, 0.f, 0.f, 0.f};
    for (int k = 0; k < 128; ++k) {
        int id = ids[tok * 128 + k];
        const float* vp = vt + (size_t)id * D;
        float av = act[k];
#pragma unroll
        for (int j = 0; j < 4; ++j) o[j] += av * vp[tid + j * 256];
    }
#pragma unroll
    for (int j = 0; j < 4; ++j) xp[tid + j * 256] += o[j];
}
__global__ void __launch_bounds__(512) n_finish(Args a, int lnext) {
    const int lane = threadIdx.x & 63, wv = blockIdx.x * 8 + (threadIdx.x >> 6), nw = gridDim.x * 8;
    for (int tok = wv; tok < T; tok += nw) {
        float xv[16]; load_row16(a.out + (size_t)tok * D, lane, xv);
        finish_token(tok, xv, a.out, (bf16_t*)(a.ws + WS_XB), (float*)(a.ws + WS_RSTD), lnext < DEPTH ? (const float*)(a.ws + WS_WF) + (size_t)lnext * 4096 : nullptr,
                     a.in[2] + (lnext < DEPTH ? lnext * 4 : 0), (float*)(a.ws + WS_FLOG), lane, lane);
    }
}
}
#ifndef HK_ONE_LAUNCH
#define HK_ONE_LAUNCH 1
#endif
extern "C" void kernel_launch(void* const* d_in, const int* in_sizes, int n_in, void* d_out, int out_size, void* d_ws, size_t ws_size, hipStream_t stream) {
    using namespace hk;
    (void)in_sizes; (void)n_in; (void)out_size; (void)ws_size;
    static int grid = 0;
    if (!grid) {
        int dev = 0, cus = 0, per_cu = 0;
        (void)hipGetDevice(&dev);
        (void)hipDeviceGetAttribute(&cus, hipDeviceAttributeMultiprocessorCount, dev);
        if (hipFuncSetAttribute((const void*)hk_mega, hipFuncAttributeMaxDynamicSharedMemorySize, LDS_BYTES) != hipSuccess) fprintf(stderr, "hipFuncSetAttribute failed\n");
        (void)hipOccupancyMaxActiveBlocksPerMultiprocessor(&per_cu, (const void*)hk_mega, NTHR, LDS_BYTES);
        if (per_cu < 1) fprintf(stderr, "occupancy query says %d blocks per CU\n", per_cu);
        grid = cus > 0 ? cus : 256;
    }
    Args a{};
    for (int i = 0; i < 29; ++i) a.in[i] = (const float*)d_in[i];
    a.out = (float*)d_out; a.ws = (unsigned char*)d_ws;
    (void)hipMemsetAsync(a.ws + WS_CTL, 0, WS_CTL_BYTES, stream);
    auto run = [&](int lo, int hi, int bar, int bank = 0) { Args b = a; b.ph_lo = lo; b.ph_hi = hi; b.use_bar = bar; b.pad0 = bank; hipLaunchKernelGGL(hk_mega, dim3(grid), dim3(NTHR), LDS_BYTES, stream, b); };
#ifndef HK_REP_MASK
#define HK_REP_MASK 0
#endif
#if HK_ONE_LAUNCH
    run(0, NPHASE, 1);
#else
    unsigned char* ws = a.ws;
    bf16_t* zb = (bf16_t*)(ws + WS_ZB); bf16_t* mix = (bf16_t*)(ws + WS_MIX); bf16_t* xb = (bf16_t*)(ws + WS_XB);
    bf16_t* su = (bf16_t*)(ws + WS_SU); float* cum = (float*)(ws + WS_CUM); float* tb = (float*)(ws + WS_TB);
    (void)hipFuncSetAttribute((const void*)nv::n_top1, hipFuncAttributeMaxDynamicSharedMemorySize, 65536);
    run(0, 1, 0); run(1, 2, 0);
    for (int l = 0; l < DEPTH; ++l) {
        const int pb = 2 + NPL * l;
        run(pb, pb + 1, 0);
        if (HK_REP_MASK & 1) run(pb, pb + 1, 0);
        if (HK_NEW_MASK & 2) run(pb + 1, pb + 2, 0);
        if (HK_REP_MASK & 2) run(pb + 1, pb + 2, 0, 1);
        if (HK_NEW_MASK & 4) run(pb + 2, pb + 3, 0);
        if (HK_REP_MASK & 4) run(pb + 2, pb + 3, 0);
        if (!(HK_NEW_MASK & 2)) {
            nv::n_fox<<<NB * 4 * S / 64, 64, 0, stream>>>(zb, cum, mix);
            nv::n_dil<<<NB * 4 * S / 64, 64, 0, stream>>>(zb, tb, mix);
            float* t0 = (float*)(ws + WS_DPART); float* t1 = (float*)(ws + WS_UT);
            nv::n_diff<0><<<NB * 4 * S / 64, 64, 0, stream>>>(zb, tb, t0);
            nv::n_diff<1><<<NB * 4 * S / 64, 64, 0, stream>>>(zb, tb, t1);
            const float lam_init = 0.8f - 0.6f * expf(-0.3f * l);
            nv::n_diff_fin<<<(T * 4) / 256, 256, 0, stream>>>(t0, t1, a.in[12] + l * 128, a.in[13] + l * 64, lam_init, mix);
            float* gbuf = (float*)(ws + WS_VT);
            nv::n_s5<<<NB * 16, 64, 0, stream>>>(su, a.in[15] + l * 1024, a.in[16] + l * 1024, a.in[17] + l * 16, a.in[18] + l * 16384, a.in[19] + l * 16384,
                                                  a.in[20] + l * 16384, a.in[21] + l * 16384, a.in[22] + l * 256, gbuf);
            nv::n_glu<<<T, 256, 0, stream>>>(gbuf, a.in[23] + l * 65536, a.in[24] + l * 256, mix);
        }
        if (HK_NEW_MASK & 8) run(pb + 3, pb + 4, 0);
        else nv::n_gemm<0><<<dim3(D / 64, T / 64), 256, 0, stream>>>(mix, nullptr, a.in[3] + (size_t)l * D * D, a.out, xb, T, D, D);
        if (HK_NEW_MASK & 16) run(pb + 4, pb + 5, 0);
        if (HK_REP_MASK & 16) run(pb + 4, pb + 5, 0);
        else nv::n_gemm<1><<<dim3(2048 / 64, T / 64), 256, 0, stream>>>(xb, a.in[5] + l * D, a.in[25] + (size_t)l * D * 2048, nullptr, zb, T, 2048, D);
        if (HK_NEW_MASK & 32) { run(pb + 5, pb + 6, 0); if (HK_PEER_SPLIT) run(pb + 6, pb + 7, 0); }
        else {
            float* rs2 = (float*)(ws + WS_DLSE); float* tv = (float*)(ws + WS_SU); int* ti = (int*)(ws + WS_MIX);
            int* ids = (int*)(ws + WS_DPART); float* gates = (float*)(ws + WS_DPART + (size_t)T * 128 * 4);
            nv::n_rstd<<<T / 4, 256, 0, stream>>>(a.out, rs2);
            nv::n_top1<<<dim3(T / 256, 16), 256, 65536, stream>>>(zb, a.in[26] + (size_t)l * 16 * 128 * 128, tv, ti);
            nv::n_top2<<<(T * 8) / 256, 256, 0, stream>>>(tv, ti, rs2, ids, gates);
            nv::n_gather<<<T, 256, 0, stream>>>(a.out, rs2, a.in[5] + l * D, ids, gates, a.in[27] + (size_t)l * NEXP * D, a.in[28] + (size_t)l * NEXP * D);
            Args b = a; b.ph_lo = 0; b.ph_hi = 0; b.use_bar = 0; b.pad0 = 0;
            nv::n_finish<<<grid, 512, 0, stream>>>(b, l + 1);
        }
    }
#endif
}
```

```cpp
#define HK_ONE_LAUNCH 1
#include <hip/hip_runtime.h>
#ifndef HK_NEW_MASK
#define HK_NEW_MASK 0x3f
#endif
#define HK_FOLD_KEYS (((HK_NEW_MASK) & 48) == 48)
#ifndef HK_PEER_SPLIT
#define HK_PEER_SPLIT HK_FOLD_KEYS
#endif
#include <cstdint>
#include <cstdio>
#include <cmath>

#define LAS3 __attribute__((address_space(3)))
typedef unsigned short bf16_t;
typedef short bf16x8 __attribute__((ext_vector_type(8)));
typedef float f32x4 __attribute__((ext_vector_type(4)));
typedef float f32x16 __attribute__((ext_vector_type(16)));
typedef unsigned u32x4 __attribute__((ext_vector_type(4)));
typedef unsigned u32x2 __attribute__((ext_vector_type(2)));

namespace hk {
constexpr int D = 1024, NB = 8, S = 8192, DEPTH = 4, T = NB * S;
constexpr int INW = 2564;
constexpr int ZP = 2304;
constexpr int ZC_FQ = 0, ZC_FK = 256, ZC_FV = 512, ZC_DQ = 768, ZC_DK = 1024, ZC_DV = 1280, ZC_CQ = 1536, ZC_CK = 1792, ZC_CV = 2048;
constexpr int NEXP = 16384;
constexpr float EPS = 1e-6f;
constexpr float LOG2E = 1.4426950408889634f;
constexpr int TBN = 2112;
constexpr int S5_TC = 64;
constexpr int S5_NCH = S / S5_TC;
constexpr int NTHR = 512;
constexpr int LDS_BYTES = 160 * 1024;
constexpr int LDS_CTL = LDS_BYTES - 256;

constexpr size_t al256(size_t x) { return (x + 255) & ~(size_t)255; }
constexpr size_t WS_CTL = 0;
constexpr size_t WS_CTL_BYTES = 65536;
constexpr size_t WS_XB = WS_CTL + WS_CTL_BYTES;
constexpr size_t WS_ZB = WS_XB + (size_t)T * D * 2;
constexpr size_t WS_SU = WS_ZB + (size_t)T * ZP * 2;
constexpr size_t WS_MIX = WS_SU + (size_t)T * 256 * 4;
constexpr size_t WS_DPART = WS_MIX + (size_t)T * D * 2;
constexpr size_t WS_DLSE = WS_DPART + (size_t)3 * T * 256 * 2;
constexpr size_t WS_SST = WS_DLSE + (size_t)3 * T * 4 * 4;
constexpr size_t WS_CUM = WS_SST + (size_t)NB * 16 * S5_NCH * 128 * 4;
constexpr size_t WS_FLOG = WS_CUM + (size_t)NB * 4 * S * 4;
constexpr size_t WS_RSTD = WS_FLOG + (size_t)NB * 4 * S * 4;
constexpr size_t WS_WIN = WS_RSTD + (size_t)T * 4;
constexpr size_t WS_WF = WS_WIN + (size_t)DEPTH * 2560 * 1024 * 2;
constexpr size_t WS_WOUT = WS_WF + (size_t)DEPTH * 4 * 1024 * 4;
constexpr size_t WS_WQ = WS_WOUT + (size_t)DEPTH * 1024 * 1024 * 2;
constexpr size_t WS_KEYS = WS_WQ + (size_t)DEPTH * 2048 * 1024 * 2;
constexpr size_t WS_GLU = WS_KEYS + (size_t)DEPTH * 16 * 128 * 128 * 2;
constexpr size_t WS_TB = WS_GLU + (size_t)DEPTH * 256 * 256 * 2;
constexpr size_t WS_UT = al256(WS_TB + (size_t)8 * TBN * 4);
constexpr size_t WS_VT = WS_UT + (size_t)NEXP * D * 2;
constexpr size_t WS_US = WS_VT + (size_t)NEXP * D * 2;
constexpr size_t WS_VS = WS_US + (size_t)NEXP * 4;
constexpr size_t WS_FOXT = WS_VS + (size_t)NEXP * 4;
constexpr size_t WS_S5B = WS_FOXT + 256;
constexpr size_t WS_S5A = WS_S5B + (size_t)DEPTH * 16 * 2 * 64 * 16 * 2;
constexpr size_t WS_END = WS_S5A + (size_t)DEPTH * 16 * 64 * 16;
constexpr size_t WS_NV_TV = WS_SU;
constexpr size_t WS_NV_IDS = WS_DPART;
constexpr size_t WS_CIDX = WS_DPART;
constexpr size_t WS_CQ = WS_CIDX + (size_t)T * 128 * 2;
constexpr size_t WS_CSC = WS_CQ + (size_t)T * 128;
static_assert(WS_END <= (size_t)1024 * 1024 * 1024, "workspace map exceeds 1 GiB");
constexpr int CTL_BAR = 0;
constexpr int CTL_Q = 4096;

struct Args {
    const float* in[29];
    float* out;
    unsigned char* ws;
    int ph_lo, ph_hi;
    int use_bar, pad0;
};

__device__ __forceinline__ float bf2f(bf16_t v) { return __uint_as_float((unsigned)v << 16); }
__device__ __forceinline__ bf16_t f2bf(float f) { unsigned u = __float_as_uint(f); u += 0x7fffu + ((u >> 16) & 1u); return (bf16_t)(u >> 16); }
__device__ __forceinline__ unsigned pk2(float lo, float hi) { return (unsigned)f2bf(lo) | ((unsigned)f2bf(hi) << 16); }
__device__ __forceinline__ float gelu_tanh(float x) {
    const float u = 0.7978845608028654f * (x + 0.044715f * x * x * x);
    return x / (1.f + __expf(-2.f * u));
}
__device__ __forceinline__ float log_sigmoid(float x) { return x >= 0.f ? -log1pf(expf(-x)) : x - log1pf(expf(x)); }
__device__ __forceinline__ int t5_bucket(int dist) {
    int n = dist < 0 ? 0 : dist;
    float nf = (float)(n < 16 ? 16 : n);
    int large = 16 + (int)(logf(nf / 16.f) / logf(128.f) * 16.f);
    large = large < 31 ? large : 31;
    return n < 16 ? n : large;
}
__device__ __forceinline__ float wave_sum(float v) {
#pragma unroll
    for (int o = 32; o > 0; o >>= 1) v += __shfl_xor(v, o);
    return v;
}
__device__ __forceinline__ float half_swap_max(float m) {
    auto rr = __builtin_amdgcn_permlane32_swap(__float_as_uint(m), __float_as_uint(m), false, false);
    return fmaxf(__uint_as_float(rr[0]), __uint_as_float(rr[1]));
}
__device__ __forceinline__ float half_swap_sum(float m) {
    auto rr = __builtin_amdgcn_permlane32_swap(__float_as_uint(m), __float_as_uint(m), false, false);
    return __uint_as_float(rr[0]) + __uint_as_float(rr[1]);
}
}
namespace pg8 {
#define PG8_LAS __attribute__((address_space(3)))
typedef unsigned short bf16_t;
typedef short bf16x8 __attribute__((ext_vector_type(8)));
typedef float f32x4 __attribute__((ext_vector_type(4)));
typedef unsigned u32x4 __attribute__((ext_vector_type(4)));
constexpr int BM = 256, BK = 64, HALF = 128, HTB = HALF * BK * 2  , STAGE_BYTES = 8 * HTB, NXCD = 8, WGM = 8;

__host__ __device__ __forceinline__ int lds_byte(int r, int c) { const int st = (r >> 4) * 2 + (c >> 5), rr = r & 15, cc = c & 31, ob = rr * 64 + cc * 2; return st * 1024 + (ob ^ (((ob >> 9) & 1) << 5)); }
__host__ __device__ __forceinline__ void stage_rc(int b, int& R, int& C) { const int st = b / 1024, sb = b % 1024, swz = sb ^ (((sb >> 9) & 1) << 5); R = (st >> 1) * 16 + swz / 64; C = (st & 1) * 32 + (swz % 64) / 2; }
__host__ __device__ __forceinline__ int perm32(int rho) { const int n = rho >> 4, i = rho & 15; return 8 * (i >> 2) + 4 * n + (i & 3); }

struct Unit { int pm, pn; };
struct Gemm { const bf16_t* A; const bf16_t* Bt; int M, N, K; };

struct StaticOrder {
    int nM, nN, nwg, G, c;
    __host__ __device__ void init(int M, int N, int G_, int c_) { nM = M / BM; nN = N / BM; nwg = nM * nN; G = G_; c = c_; }
    __host__ __device__ bool next(int i, Unit& u) const {
        const long L = (long)i * G + c; if (L >= nwg) return false;
        int wgid = (int)L; { const int q = nwg / NXCD, r = nwg % NXCD, xcd = wgid % NXCD, off = wgid / NXCD; wgid = (xcd < r ? xcd * (q + 1) : r * (q + 1) + (xcd - r) * q) + off; }
        const int nig = WGM * nN, gid = wgid / nig, fm = gid * WGM, gsz = (nM - fm) < WGM ? (nM - fm) : WGM;
        u.pm = fm + ((wgid % nig) % gsz); u.pn = (wgid % nig) / gsz; return true;
    }
    __device__ __forceinline__ void a_ready(const Unit&) const {}
    __device__ __forceinline__ void done(const Unit&) const {}
};
typedef float f32x2e_t __attribute__((ext_vector_type(2))); typedef __bf16 bf16x2e_t __attribute__((ext_vector_type(2)));
__device__ __forceinline__ unsigned cvt_pk_bf16(float lo, float hi) { const f32x2e_t v = {lo, hi}; const bf16x2e_t b = __builtin_convertvector(v, bf16x2e_t); return __builtin_bit_cast(unsigned, b); }

struct EpiIn {
    static constexpr bool PERM = true, AFTER_DRAIN = false;
    bf16_t* zb; float* su32; const float* rstd;
    const float* g_fq; const float* g_fk; const float* g_dq; const float* g_dk; const float* g_cq; const float* g_ck;
    __device__ __forceinline__ void operator()(const f32x4 (&acc)[2][2][4][2], const Unit& u, int wr, int wc, int fr, int fq) const {
        const int pn = u.pn;
        const int mode = (pn == 0 || pn == 1 || pn == 3 || pn == 4) ? 1 : ((pn == 6 || pn == 7) ? 2 : (pn == 9 ? 3 : 0));
        const float* gp = pn == 0 ? g_fq : pn == 1 ? g_fk : pn == 3 ? g_dq : pn == 4 ? g_dk : pn == 6 ? g_cq : g_ck;
        const float qs = (pn == 0 || pn == 3) ? 0.125f * 1.4426950408889634f : (pn == 6 ? 0.17677669529663687f * 1.4426950408889634f : 1.f);
        f32x4 gv[2][2];
#pragma unroll
        for (int bj = 0; bj < 2; ++bj)
#pragma unroll
            for (int n = 0; n < 2; ++n) {
                if (mode == 1) gv[bj][n] = *(const f32x4*)(gp + 32 * bj + 8 * fq + 4 * n) * qs;
                else if (mode == 2) gv[bj][n] = *(const f32x4*)(gp + 8 * fq + 4 * n) * qs;
                else gv[bj][n] = (f32x4){1.f, 1.f, 1.f, 1.f};
            }
#pragma unroll
        for (int ai = 0; ai < 2; ++ai)
#pragma unroll
            for (int m = 0; m < 4; ++m) {
                const int row = u.pm * BM + ai * HALF + wr * 64 + m * 16 + fr;
                const float rs = rstd[row];
                f32x4 v[2][2];
                float ss[2];
#pragma unroll
                for (int bj = 0; bj < 2; ++bj) {
                    float s = 0.f;
#pragma unroll
                    for (int n = 0; n < 2; ++n) { v[bj][n] = acc[ai][bj][m][n] * rs; const f32x4 x = v[bj][n]; s += (x[0] * x[0] + x[1] * x[1]) + (x[2] * x[2] + x[3] * x[3]); }
                    ss[bj] = s;
                }
                if (mode == 1 || mode == 2) {
                    float s0 = ss[0], s1 = ss[1];
                    s0 += __shfl_xor(s0, 16); s0 += __shfl_xor(s0, 32); s1 += __shfl_xor(s1, 16); s1 += __shfl_xor(s1, 32);
                    float r0, r1;
                    if (mode == 1) { r0 = __builtin_amdgcn_rsqf((s0 + s1) * (1.f / 64.f) + 1e-6f); r1 = r0; }
                    else { r0 = __builtin_amdgcn_rsqf(s0 * (1.f / 32.f) + 1e-6f); r1 = __builtin_amdgcn_rsqf(s1 * (1.f / 32.f) + 1e-6f); }
#pragma unroll
                    for (int n = 0; n < 2; ++n) { v[0][n] = v[0][n] * r0 * gv[0][n]; v[1][n] = v[1][n] * r1 * gv[1][n]; }
                }
                if (mode == 3) {
                    bf16_t* op = (bf16_t*)su32 + (size_t)row * 256 + 64 * wc + 8 * fq;
#pragma unroll
                    for (int bj = 0; bj < 2; ++bj) { u32x4 w; w.x = cvt_pk_bf16(v[bj][0][0], v[bj][0][1]); w.y = cvt_pk_bf16(v[bj][0][2], v[bj][0][3]); w.z = cvt_pk_bf16(v[bj][1][0], v[bj][1][1]); w.w = cvt_pk_bf16(v[bj][1][2], v[bj][1][3]);
                        *(u32x4*)(op + 32 * bj) = w; }
                } else {
                    bf16_t* op = zb + (size_t)row * 2304 + pn * 256 + 64 * wc + 8 * fq;
#pragma unroll
                    for (int bj = 0; bj < 2; ++bj) { u32x4 w; w.x = cvt_pk_bf16(v[bj][0][0], v[bj][0][1]); w.y = cvt_pk_bf16(v[bj][0][2], v[bj][0][3]); w.z = cvt_pk_bf16(v[bj][1][0], v[bj][1][1]); w.w = cvt_pk_bf16(v[bj][1][2], v[bj][1][3]);
                        *(u32x4*)(op + 32 * bj) = w; }
                }
            }
    }
};
struct EpiOut {
    static constexpr bool PERM = true, AFTER_DRAIN = false;
    bf16_t* xb;
    __device__ __forceinline__ void operator()(const f32x4 (&acc)[2][2][4][2], const Unit& u, int wr, int wc, int fr, int fq) const {
#pragma unroll
        for (int ai = 0; ai < 2; ++ai)
#pragma unroll
            for (int m = 0; m < 4; ++m) {
                const int row = u.pm * BM + ai * HALF + wr * 64 + m * 16 + fr;
#pragma unroll
                for (int bj = 0; bj < 2; ++bj) {
                    const size_t off = (size_t)row * 1024 + u.pn * BM + bj * HALF + wc * 32 + 8 * fq;
                    const u32x4 o = *(const u32x4*)(xb + off);
                    const f32x4 a0 = acc[ai][bj][m][0], a1 = acc[ai][bj][m][1];
                    u32x4 w;
                    w.x = cvt_pk_bf16(__uint_as_float(o.x << 16) + a0[0], __uint_as_float(o.x & 0xffff0000u) + a0[1]);
                    w.y = cvt_pk_bf16(__uint_as_float(o.y << 16) + a0[2], __uint_as_float(o.y & 0xffff0000u) + a0[3]);
                    w.z = cvt_pk_bf16(__uint_as_float(o.z << 16) + a1[0], __uint_as_float(o.z & 0xffff0000u) + a1[1]);
                    w.w = cvt_pk_bf16(__uint_as_float(o.w << 16) + a1[2], __uint_as_float(o.w & 0xffff0000u) + a1[3]);
                    *(u32x4*)(xb + off) = w;
                }
            }
    }
};
struct EpiPlain {
    static constexpr bool PERM = true, AFTER_DRAIN = false;
    bf16_t* O; int ldc;
    __device__ __forceinline__ void operator()(const f32x4 (&acc)[2][2][4][2], const Unit& u, int wr, int wc, int fr, int fq) const {
#pragma unroll
        for (int ai = 0; ai < 2; ++ai)
#pragma unroll
            for (int m = 0; m < 4; ++m) {
                const int row = u.pm * BM + ai * HALF + wr * 64 + m * 16 + fr;
#pragma unroll
                for (int bj = 0; bj < 2; ++bj) {
                    const size_t off = (size_t)row * ldc + u.pn * BM + bj * HALF + wc * 32 + 8 * fq;
                    const f32x4 a = acc[ai][bj][m][0], b = acc[ai][bj][m][1];
                    u32x4 w; w.x = cvt_pk_bf16(a[0], a[1]); w.y = cvt_pk_bf16(a[2], a[3]); w.z = cvt_pk_bf16(b[0], b[1]); w.w = cvt_pk_bf16(b[2], b[3]);
                    *(u32x4*)(O + off) = w;
                }
            }
    }
};
typedef _Float16 f16x2e_t __attribute__((ext_vector_type(2)));
__device__ __forceinline__ unsigned cvt_pk_f16(float lo, float hi) { const f32x2e_t v = {lo, hi}; const f16x2e_t b = __builtin_convertvector(v, f16x2e_t); return __builtin_bit_cast(unsigned, b); }
struct EpiF16 {
    static constexpr bool PERM = true, AFTER_DRAIN = false;
    bf16_t* O; int ldc;
    __device__ __forceinline__ void operator()(const f32x4 (&acc)[2][2][4][2], const Unit& u, int wr, int wc, int fr, int fq) const {
#pragma unroll
        for (int ai = 0; ai < 2; ++ai)
#pragma unroll
            for (int m = 0; m < 4; ++m) {
                const int row = u.pm * BM + ai * HALF + wr * 64 + m * 16 + fr;
#pragma unroll
                for (int bj = 0; bj < 2; ++bj) {
                    const size_t off = (size_t)row * ldc + u.pn * BM + bj * HALF + wc * 32 + 8 * fq;
                    const f32x4 a = acc[ai][bj][m][0], b = acc[ai][bj][m][1];
                    u32x4 w; w.x = cvt_pk_f16(a[0], a[1]); w.y = cvt_pk_f16(a[2], a[3]); w.z = cvt_pk_f16(b[0], b[1]); w.w = cvt_pk_f16(b[2], b[3]);
                    *(u32x4*)(O + off) = w;
                }
            }
    }
};
template <class Epi, class Sched, bool ALIGN_EPI = false, bool SP2 = false>
__device__ __forceinline__ void gemm_phase(PG8_LAS unsigned char* lds, const Gemm g, const Sched& S, const Epi& E) {
    const int tid = threadIdx.x, wid = __builtin_amdgcn_readfirstlane(tid >> 6), lane = tid & 63, wr = wid >> 2, wc = wid & 3, fr = lane & 15, fq = lane >> 4;
    const int K = g.K, nt = K / BK;
    unsigned voffA[2], voffB[2];
#pragma unroll
    for (int i = 0; i < 2; ++i) { int R, C; stage_rc(tid * 16 + i * 8192, R, C); const int Rb = Epi::PERM ? ((R & ~31) + perm32(R & 31)) : R;
        voffA[i] = (unsigned)(R * K + C) * 2u; voffB[i] = (unsigned)(Rb * K + C) * 2u; }
    const size_t kstep = (size_t)(BK * 2);
    const size_t hstep = (size_t)HALF * K * 2;
    const size_t tstep = 2 * hstep;
    const unsigned ldsw = (unsigned)wid * 1024u;
    const int aoff = lds_byte(wr * 64 + fr, fq * 8), boff = lds_byte(wc * 32 + fr, fq * 8);
#define PG8_SA(b, h) (((b) * 2 + (h)) * HTB)
#define PG8_SB(b, h) ((4 + (b) * 2 + (h)) * HTB)
#define PG8_STAGE(bufoff, gbase, voff) do { _Pragma("unroll") for (int _i = 0; _i < 2; ++_i) \
        __builtin_amdgcn_global_load_lds((const unsigned*)((const char*)(gbase) + (voff)[_i]), (PG8_LAS unsigned*)(lds + (bufoff) + ldsw + _i * 8192), 16, 0, 0); } while (0)
#define PG8_LDA(dst, b, h) do { _Pragma("unroll") for (int m = 0; m < 4; ++m) _Pragma("unroll") for (int k = 0; k < 2; ++k) dst[m][k] = *(const PG8_LAS bf16x8*)(lds + PG8_SA(b, h) + aoff + m * 2048 + k * 1024); } while (0)
#define PG8_LDB(dst, b, h) do { _Pragma("unroll") for (int n = 0; n < 2; ++n) _Pragma("unroll") for (int k = 0; k < 2; ++k) dst[n][k] = *(const PG8_LAS bf16x8*)(lds + PG8_SB(b, h) + boff + n * 2048 + k * 1024); } while (0)
#define PG8_MMA(ai, bj, At, Bt) do { __builtin_amdgcn_s_setprio(1); _Pragma("unroll") for (int m = 0; m < 4; ++m) _Pragma("unroll") for (int n = 0; n < 2; ++n) _Pragma("unroll") for (int k = 0; k < 2; ++k) \
        acc[ai][bj][m][n] = __builtin_amdgcn_mfma_f32_16x16x32_bf16(Bt[n][k], At[m][k], acc[ai][bj][m][n], 0, 0, 0); __builtin_amdgcn_s_setprio(0); } while (0)
#define PG8_WAIT_V(n) asm volatile("s_waitcnt vmcnt(" #n ")" ::: "memory")
#define PG8_WAIT_L(n) asm volatile("s_waitcnt lgkmcnt(" #n ")" ::: "memory")
#define PG8_BAR __builtin_amdgcn_s_barrier()
#define PG8_SCHED __builtin_amdgcn_sched_barrier(0)
    Unit cur, nxt; int ui = 0;
    if (!S.next(0, cur)) return;
    f32x4 acc[2][2][4][2];
#pragma unroll
    for (int a = 0; a < 2; ++a)
#pragma unroll
        for (int b = 0; b < 2; ++b)
#pragma unroll
            for (int m = 0; m < 4; ++m)
#pragma unroll
                for (int n = 0; n < 2; ++n) acc[a][b][m][n] = (f32x4){0.f, 0.f, 0.f, 0.f};
    bf16x8 At[4][2], B0[2][2], B1[2][2];
    const char* cA = (const char*)g.A + (size_t)cur.pm * tstep; const char* cB = (const char*)g.Bt + (size_t)cur.pn * tstep;
    S.a_ready(cur);
    if constexpr (SP2) {
        PG8_STAGE(PG8_SB(0, 0), cB, voffB); PG8_STAGE(PG8_SB(0, 1), cB + hstep, voffB); PG8_STAGE(PG8_SA(0, 0), cA, voffA); PG8_STAGE(PG8_SA(0, 1), cA + hstep, voffA);
        if (wr == 1) PG8_BAR;
        PG8_WAIT_V(2); PG8_BAR;
        PG8_STAGE(PG8_SB(1, 0), cB + kstep, voffB); PG8_STAGE(PG8_SA(1, 0), cA + kstep, voffA); PG8_STAGE(PG8_SB(1, 1), cB + hstep + kstep, voffB);
        PG8_WAIT_V(6); PG8_BAR;
    } else {
        PG8_STAGE(PG8_SB(0, 0), cB, voffB); PG8_STAGE(PG8_SA(0, 0), cA, voffA); PG8_STAGE(PG8_SB(0, 1), cB + hstep, voffB); PG8_STAGE(PG8_SA(0, 1), cA + hstep, voffA);
        if (wr == 1) PG8_BAR;
        PG8_WAIT_V(4); PG8_BAR;
        PG8_STAGE(PG8_SB(1, 0), cB + kstep, voffB); PG8_STAGE(PG8_SA(1, 0), cA + kstep, voffA); PG8_STAGE(PG8_SB(1, 1), cB + hstep + kstep, voffB);
        PG8_WAIT_V(6); PG8_BAR;
    }
    for (;;) {
        const bool has_next = S.next(ui + 1, nxt);
        const char* nA = has_next ? (const char*)g.A + (size_t)nxt.pm * tstep : cA; const char* nB = has_next ? (const char*)g.Bt + (size_t)nxt.pn * tstep : cB;
        for (int t = 0; t < nt; t += 2) {
            const bool last = (t == nt - 2);
            const char* a1 = cA + (size_t)(t + 1) * kstep;
            const char* a2 = last ? nA : cA + (size_t)(t + 2) * kstep; const char* b2 = last ? nB : cB + (size_t)(t + 2) * kstep;
            const char* a3 = a2 + kstep; const char* b3 = b2 + kstep;
            if (last && has_next) S.a_ready(nxt);
            if constexpr (SP2) {
            PG8_LDB(B0, 0, 0); PG8_LDB(B1, 0, 1); PG8_SCHED; PG8_LDA(At, 0, 0); PG8_STAGE(PG8_SA(1, 1), a1 + hstep, voffA);
            PG8_WAIT_V(8); PG8_WAIT_L(0); PG8_BAR; PG8_MMA(0, 0, At, B0); PG8_MMA(0, 1, At, B1); PG8_BAR; PG8_SCHED;
            PG8_LDA(At, 0, 1); PG8_STAGE(PG8_SB(0, 0), b2, voffB); PG8_STAGE(PG8_SB(0, 1), b2 + hstep, voffB); PG8_STAGE(PG8_SA(0, 0), a2, voffA);
            PG8_WAIT_V(8); PG8_WAIT_L(0); PG8_BAR; PG8_MMA(1, 0, At, B0); PG8_MMA(1, 1, At, B1); PG8_BAR; PG8_SCHED;
            PG8_LDB(B0, 1, 0); PG8_LDB(B1, 1, 1); PG8_SCHED; PG8_LDA(At, 1, 0); PG8_STAGE(PG8_SA(0, 1), a2 + hstep, voffA);
            PG8_WAIT_V(8); PG8_WAIT_L(0); PG8_BAR; PG8_MMA(0, 0, At, B0); PG8_MMA(0, 1, At, B1); PG8_BAR; PG8_SCHED;
            PG8_LDA(At, 1, 1); PG8_STAGE(PG8_SB(1, 0), b3, voffB); PG8_STAGE(PG8_SB(1, 1), b3 + hstep, voffB); PG8_STAGE(PG8_SA(1, 0), a3, voffA);
            PG8_WAIT_V(8); PG8_WAIT_L(0); PG8_BAR; PG8_MMA(1, 0, At, B0); PG8_MMA(1, 1, At, B1); PG8_BAR; PG8_SCHED;
            } else {
            PG8_LDB(B0, 0, 0); PG8_SCHED; PG8_LDA(At, 0, 0); PG8_STAGE(PG8_SA(1, 1), a1 + hstep, voffA);
            PG8_WAIT_L(8); PG8_BAR; PG8_WAIT_L(0); PG8_MMA(0, 0, At, B0); PG8_BAR; PG8_SCHED;
            PG8_LDB(B1, 0, 1); PG8_STAGE(PG8_SB(0, 0), b2, voffB);
            PG8_BAR; PG8_WAIT_L(0); PG8_MMA(0, 1, At, B1); PG8_BAR;
            PG8_LDA(At, 0, 1); PG8_STAGE(PG8_SA(0, 0), a2, voffA);
            PG8_BAR; PG8_WAIT_L(0); PG8_MMA(1, 0, At, B0); PG8_BAR; PG8_SCHED;
            PG8_STAGE(PG8_SB(0, 1), b2 + hstep, voffB);
            PG8_WAIT_V(6); PG8_BAR; PG8_MMA(1, 1, At, B1); PG8_BAR;
            PG8_LDB(B0, 1, 0); PG8_SCHED; PG8_LDA(At, 1, 0); PG8_STAGE(PG8_SA(0, 1), a2 + hstep, voffA);
            PG8_WAIT_L(8); PG8_BAR; PG8_WAIT_L(0); PG8_MMA(0, 0, At, B0); PG8_BAR; PG8_SCHED;
            PG8_LDB(B1, 1, 1); PG8_STAGE(PG8_SB(1, 0), b3, voffB);
            PG8_BAR; PG8_WAIT_L(0); PG8_MMA(0, 1, At, B1); PG8_BAR;
            PG8_LDA(At, 1, 1); PG8_STAGE(PG8_SA(1, 0), a3, voffA);
            PG8_BAR; PG8_WAIT_L(0); PG8_MMA(1, 0, At, B0); PG8_BAR; PG8_SCHED;
            PG8_STAGE(PG8_SB(1, 1), b3 + hstep, voffB);
            PG8_WAIT_V(6); PG8_BAR; PG8_MMA(1, 1, At, B1); PG8_BAR;
            }
        }
        if constexpr (ALIGN_EPI) { if (wr == 0) PG8_BAR; }
        if constexpr (!Epi::AFTER_DRAIN) { E(acc, cur, wr, wc, fr, fq); S.done(cur); }
        if (!has_next) break;
#pragma unroll
        for (int a = 0; a < 2; ++a)
#pragma unroll
            for (int b = 0; b < 2; ++b)
#pragma unroll
                for (int m = 0; m < 4; ++m)
#pragma unroll
                    for (int n = 0; n < 2; ++n) acc[a][b][m][n] = (f32x4){0.f, 0.f, 0.f, 0.f};
        cur = nxt; cA = nA; cB = nB; ++ui;
        if constexpr (ALIGN_EPI) { if (wr == 1) PG8_BAR; }
    }
    PG8_WAIT_V(0);
    if constexpr (!ALIGN_EPI) { if (wr == 0) PG8_BAR; }
    PG8_BAR;
    if constexpr (Epi::AFTER_DRAIN) { E.fused(acc, cur, wr, wc, fr, fq, lds, wid, lane); S.done(cur); }
#undef PG8_SA
#undef PG8_SB
#undef PG8_STAGE
#undef PG8_LDA
#undef PG8_LDB
#undef PG8_MMA
#undef PG8_WAIT_V
#undef PG8_WAIT_L
#undef PG8_BAR
#undef PG8_SCHED
}
}
#define XB_TMO      128
#define XB_XCNT(j)  (256  + 64 * (j))
#define XB_XSUB(j)  (1280 + 64 * (j))
#define XB_XGEN(j)  (2304 + 64 * (j))
#define XB_TOP      3328
#define XB_TOPGEN   3392
#define XCD_BAR_WORDS 3456
#define XB_SPIN_CAP (1u << 18)
#define LAS __attribute__((address_space(3)))

__device__ __forceinline__ unsigned xb_ld(unsigned* p)              { return __hip_atomic_load(p, __ATOMIC_RELAXED, __HIP_MEMORY_SCOPE_AGENT); }
__device__ __forceinline__ unsigned xb_add(unsigned* p, unsigned v) { return __hip_atomic_fetch_add(p, v, __ATOMIC_RELAXED, __HIP_MEMORY_SCOPE_AGENT); }
__device__ __forceinline__ unsigned xb_xcc_id() { return (unsigned)__builtin_amdgcn_s_getreg((3 << 11) | 20) & 0xFu; }
#define XB_SPIN(cond, bar) do { unsigned _sp = 0; while (cond) { __builtin_amdgcn_s_sleep(1); \
    if ((++_sp & 255u) == 0u) { if (xb_ld(&(bar)[XB_TMO])) break; if (_sp > XB_SPIN_CAP) { atomicAdd(&(bar)[XB_TMO], 1u); break; } } } } while (0)

struct XcdBarrier {
    unsigned* bar; unsigned x;
    volatile LAS unsigned* st;
};

__device__ __forceinline__ XcdBarrier xcd_barrier_post(unsigned* bar, volatile LAS unsigned* st) {
    XcdBarrier b; b.bar = bar; b.x = xb_xcc_id(); b.st = st;
    if (threadIdx.x == 0) (void)xb_add(&bar[XB_XCNT(b.x)], 1u);
    return b;
}
__device__ __forceinline__ void xcd_barrier_complete(unsigned* bar, unsigned x, unsigned& nloc, unsigned& nx) {
    const unsigned G = gridDim.x * gridDim.y * gridDim.z;
    unsigned sum, cnt, mine, sp = 0u;
    for (;;) {
        sum = 0u; cnt = 0u; mine = 0u;
#pragma unroll
        for (unsigned j = 0; j < 16; ++j) { const unsigned c = xb_ld(&bar[XB_XCNT(j)]); sum += c; cnt += (c > 0u) ? 1u : 0u; mine = (j == x) ? c : mine; }
        if (sum == G) break;
        __builtin_amdgcn_s_sleep(1);
        if ((++sp & 255u) == 0u) { if (xb_ld(&bar[XB_TMO])) break; if (sp > XB_SPIN_CAP) { atomicAdd(&bar[XB_TMO], 1u); break; } }
    }
    nloc = mine > 0u ? mine : 1u; nx = cnt > 0u ? cnt : 1u;
}

__device__ __forceinline__ void xcd_barrier(const XcdBarrier& b) {
    asm volatile("s_waitcnt vmcnt(0)" ::: "memory");
    __syncthreads();
    if (threadIdx.x == 0) {
        unsigned* bar = b.bar;
        __builtin_amdgcn_s_waitcnt(0);
        unsigned nloc = b.st[0], nx = b.st[1];
        if (nloc == 0u) { xcd_barrier_complete(bar, b.x, nloc, nx); b.st[0] = nloc; b.st[1] = nx; }
        const unsigned old = xb_add(&bar[XB_XSUB(b.x)], 1u);
        const unsigned gen = old / nloc;
        if (old + 1u == (gen + 1u) * nloc) {
            __builtin_amdgcn_fence(__ATOMIC_RELEASE, "agent");
            asm volatile("s_waitcnt vmcnt(0)" ::: "memory");
            const unsigned og = xb_add(&bar[XB_TOP], 1u);
            const unsigned tg = og / nx;
            if (og + 1u == (tg + 1u) * nx) xb_add(&bar[XB_TOPGEN], 1u);
            else XB_SPIN(xb_ld(&bar[XB_TOPGEN]) == tg, bar);
            __builtin_amdgcn_fence(__ATOMIC_ACQUIRE, "agent");
            xb_add(&bar[XB_XGEN(b.x)], 1u);
            asm volatile("s_waitcnt vmcnt(0)" ::: "memory");
        } else {
            XB_SPIN(xb_ld(&bar[XB_XGEN(b.x)]) == gen, bar);
            __builtin_amdgcn_fence(__ATOMIC_ACQUIRE, "agent");
            asm volatile("s_waitcnt vmcnt(0)" ::: "memory");
        }
    }
    __syncthreads();
}
namespace hk {
__device__ __forceinline__ int inproj_src_col(int np) {
    const int pn = np >> 8, p = np & 255, bj = p >> 7, wc = (p >> 5) & 3, i = p & 31;
    const int nl = pn * 256 + 64 * wc + 32 * bj + i;
    return nl < 768 ? nl : nl + 4;
}
template <bool INMAP>
__device__ __forceinline__ void tr_tile(const float* __restrict__ src, int ld, const float* __restrict__ g, bf16_t* __restrict__ dst, int K, int k0, int n0, float* lds) {
    const int tid = threadIdx.x;
#pragma unroll
    for (int i = 0; i < 8; ++i) {
        const int idx = tid + 512 * i, kk = idx >> 6, nn = idx & 63;
        const int col = INMAP ? inproj_src_col(n0 + nn) : (n0 + nn);
        float v = src[(size_t)(k0 + kk) * ld + col];
        if (g) v *= g[k0 + kk];
        lds[nn * 65 + kk] = v;
    }
    __syncthreads();
#pragma unroll
    for (int i = 0; i < 8; ++i) {
        const int idx = tid + 512 * i, nn = idx >> 6, kk = idx & 63;
        dst[(size_t)(n0 + nn) * K + k0 + kk] = f2bf(lds[nn * 65 + kk]);
    }
    __syncthreads();
}
template <bool INMAP>
__device__ __forceinline__ void tr_load(const float* __restrict__ src, int ld, const float* __restrict__ g, int k0, int n0, float (&v)[8]) {
    const int tid = threadIdx.x;
#pragma unroll
    for (int i = 0; i < 8; ++i) {
        const int idx = tid + 512 * i, kk = idx >> 6, nn = idx & 63;
        const int col = INMAP ? inproj_src_col(n0 + nn) : (n0 + nn);
        v[i] = src[(size_t)(k0 + kk) * ld + col];
        if (g) v[i] *= g[k0 + kk];
    }
}
__device__ __forceinline__ void tr_store(const float (&v)[8], bf16_t* __restrict__ dst, int K, int k0, int n0, float* lds) {
    const int tid = threadIdx.x;
#pragma unroll
    for (int i = 0; i < 8; ++i) { const int idx = tid + 512 * i, kk = idx >> 6, nn = idx & 63; lds[nn * 65 + kk] = v[i]; }
    __syncthreads();
#pragma unroll
    for (int i = 0; i < 8; ++i) {
        const int idx = tid + 512 * i, nn = idx >> 6, kk = idx & 63;
        dst[(size_t)(n0 + nn) * K + k0 + kk] = f2bf(lds[nn * 65 + kk]);
    }
    __syncthreads();
}
__device__ __forceinline__ void fold_keys_tile(const float* __restrict__ wq, const float* __restrict__ keys, const float* __restrict__ g, bf16_t* __restrict__ dst, int hp, int k0, float* lds) {
    const int tid = threadIdx.x, lane = tid & 63, w = tid >> 6, qi = lane & 31, hi = lane >> 5;
    const int ab = w >> 2, kb = w & 3;
    const float* ap = wq + (size_t)(k0 + 32 * ab + qi) * 2048 + hp * 128 + 8 * hi;
    const float* bp = keys + ((size_t)hp * 128 + 32 * kb + qi) * 128 + 8 * hi;
    f32x16 acc = (f32x16){};
#pragma unroll
    for (int h4 = 0; h4 < 2; ++h4) {
        f32x4 av[4][2], bv[4][2];
#pragma unroll
        for (int s = 0; s < 4; ++s) { const int d0 = 16 * (4 * h4 + s);
            av[s][0] = *(const f32x4*)(ap + d0); av[s][1] = *(const f32x4*)(ap + d0 + 4); bv[s][0] = *(const f32x4*)(bp + d0); bv[s][1] = *(const f32x4*)(bp + d0 + 4); }
#pragma unroll
        for (int s = 0; s < 4; ++s) {
            u32x4 pa, pb;
            pa.x = pk2(av[s][0][0], av[s][0][1]); pa.y = pk2(av[s][0][2], av[s][0][3]); pa.z = pk2(av[s][1][0], av[s][1][1]); pa.w = pk2(av[s][1][2], av[s][1][3]);
            pb.x = pk2(bv[s][0][0], bv[s][0][1]); pb.y = pk2(bv[s][0][2], bv[s][0][3]); pb.z = pk2(bv[s][1][0], bv[s][1][1]); pb.w = pk2(bv[s][1][2], bv[s][1][3]);
            acc = __builtin_amdgcn_mfma_f32_32x32x16_bf16(__builtin_bit_cast(bf16x8, pa), __builtin_bit_cast(bf16x8, pb), acc, 0, 0, 0);
        }
    }
    bf16_t* op = dst + (size_t)(hp * 128 + 32 * kb + qi) * 1024 + k0 + 32 * ab + 4 * hi;
    const float* gp = g + k0 + 32 * ab + 4 * hi;
#pragma unroll
    for (int q = 0; q < 4; ++q) {
        const f32x4 gg = *(const f32x4*)(gp + 8 * q);
        u32x2 o; o.x = pk2(acc[4 * q] * gg[0], acc[4 * q + 1] * gg[1]); o.y = pk2(acc[4 * q + 2] * gg[2], acc[4 * q + 3] * gg[3]);
        *(u32x2*)(op + 8 * q) = o;
    }
}
__device__ __forceinline__ void phase_weights(const Args& a, unsigned char* ldsb) {
    float* lds = (float*)ldsb;
    const int G = gridDim.x, bid = blockIdx.x, tid = threadIdx.x;
    const float* w_in = a.in[1]; const float* w_out = a.in[3]; const float* norm_mix = a.in[4]; const float* norm_ffn = a.in[5];
    const float* glu_w = a.in[23]; const float* wq = a.in[25]; const float* keys = a.in[26]; const float* relb = a.in[14];
    bf16_t* WIN = (bf16_t*)(a.ws + WS_WIN); bf16_t* WOUT = (bf16_t*)(a.ws + WS_WOUT); bf16_t* WQ = (bf16_t*)(a.ws + WS_WQ); bf16_t* GLU = (bf16_t*)(a.ws + WS_GLU);
#if HK_FOLD_KEYS
    {
        float v[8], vn[8];
        int q = bid;
#define PW_IN(q_, vv) do { const int l_ = (q_) / 640, r_ = (q_) % 640; tr_load<true>(w_in + (size_t)l_ * D * INW, INW, norm_mix + l_ * D, (r_ & 15) * 64, (r_ >> 4) * 64, vv); } while (0)
        if (q < DEPTH * 640) PW_IN(q, v);
        for (; q < DEPTH * 640; q += G) {
            const int qn = q + G; if (qn < DEPTH * 640) PW_IN(qn, vn);
            const int l = q / 640, r = q % 640;
            tr_store(v, WIN + (size_t)l * 2560 * 1024, 1024, (r & 15) * 64, (r >> 4) * 64, lds);
#pragma unroll
            for (int i = 0; i < 8; ++i) v[i] = vn[i];
        }
#undef PW_IN
        q = bid;
#define PW_OUT(q_, vv) do { const int l_ = (q_) >> 8, r_ = (q_) & 255; tr_load<false>(w_out + (size_t)l_ * D * D, D, nullptr, (r_ & 15) * 64, (r_ >> 4) * 64, vv); } while (0)
        if (q < DEPTH * 256) PW_OUT(q, v);
        for (; q < DEPTH * 256; q += G) {
            const int qn = q + G; if (qn < DEPTH * 256) PW_OUT(qn, vn);
            const int l = q >> 8, r = q & 255;
            tr_store(v, WOUT + (size_t)l * 1024 * 1024, 1024, (r & 15) * 64, (r >> 4) * 64, lds);
#pragma unroll
            for (int i = 0; i < 8; ++i) v[i] = vn[i];
        }
#undef PW_OUT
    }
    for (int u = bid; u < DEPTH * 16; u += G) { const int l = u >> 4, r = u & 15; tr_tile<false>(glu_w + (size_t)l * 65536, 256, nullptr, GLU + (size_t)l * 65536, 256, (r & 3) * 64, (r >> 2) * 64, lds); }
    for (int u = bid; u < DEPTH * 256; u += G) { const int l = u >> 8, r = u & 255;
        fold_keys_tile(wq + (size_t)l * D * 2048, keys + (size_t)l * 16 * 128 * 128, norm_ffn + l * D, WQ + (size_t)l * 2048 * 1024, r >> 4, (r & 15) * 64, lds); }
#else
    for (int u = bid; u < DEPTH * 1424; u += G) {
        const int l = u / 1424; int r = u % 1424;
        if (r < 640) { const int nt = r >> 4, kt = r & 15; tr_tile<true>(w_in + (size_t)l * D * INW, INW, norm_mix + l * D, WIN + (size_t)l * 2560 * 1024, 1024, kt * 64, nt * 64, lds); }
        else if (r < 896) { r -= 640; const int nt = r >> 4, kt = r & 15; tr_tile<false>(w_out + (size_t)l * D * D, D, nullptr, WOUT + (size_t)l * 1024 * 1024, 1024, kt * 64, nt * 64, lds); }
        else if (r < 1408) { r -= 896;
#if HK_FOLD_KEYS
            if (r < 256) fold_keys_tile(wq + (size_t)l * D * 2048, keys + (size_t)l * 16 * 128 * 128, norm_ffn + l * D, WQ + (size_t)l * 2048 * 1024, r >> 4, (r & 15) * 64, lds);
#else
            const int nt = r >> 4, kt = r & 15; tr_tile<false>(wq + (size_t)l * D * 2048, 2048, norm_ffn + l * D, WQ + (size_t)l * 2048 * 1024, 1024, kt * 64, nt * 64, lds);
#endif
        }
        else { r -= 1408; const int nt = r >> 2, kt = r & 3; tr_tile<false>(glu_w + (size_t)l * 65536, 256, nullptr, GLU + (size_t)l * 65536, 256, kt * 64, nt * 64, lds); }
    }
#endif
    const int gt = bid * NTHR + tid, gn = G * NTHR;
    float* WF = (float*)(a.ws + WS_WF);
    for (int i = gt; i < DEPTH * 4 * 1024; i += gn) { const int l = i >> 12, h = (i >> 10) & 3, k = i & 1023; WF[i] = norm_mix[l * D + k] * w_in[((size_t)l * D + k) * INW + 768 + h]; }
    bf16_t* KB = (bf16_t*)(a.ws + WS_KEYS);
    for (int i = gt; i < DEPTH * 16 * 128 * 128; i += gn) KB[i] = f2bf(keys[i]);
    if (gt < DEPTH) { float gq = 0.f, gk = 0.f; for (int i = 0; i < 64; ++i) { gq = fmaxf(gq, fabsf(a.in[6][gt * 64 + i])); gk = fmaxf(gk, fabsf(a.in[7][gt * 64 + i])); }
        ((float*)(a.ws + WS_FOXT))[gt] = 2.f * 1.02f * 0.125f * LOG2E * 64.f * gq * gk + 40.f; }
#ifndef HK_T_NOS5TAB
    for (int i = gt; i < DEPTH * 16 * 64; i += gn) {
        const int lg = i >> 6, st = i & 63;
        const float dt = expf(a.in[17][lg]);
        const float ar = a.in[15][lg * 64 + st], ai = a.in[16][lg * 64 + st];
        const float dtar = dt * ar, dtai = dt * ai, mag = expf(dtar);
        const float abr = mag * cosf(dtai), abi = mag * sinf(dtai);
        const float den = ar * ar + ai * ai, nr = abr - 1.f, ni = abi;
        const float cr = (nr * ar + ni * ai) / den, ci = (ni * ar - nr * ai) / den;
        const float mg = expf(64.f * dtar);
        ((f32x4*)(a.ws + WS_S5A))[i] = (f32x4){abr, abi, mg * cosf(64.f * dtai), mg * sinf(64.f * dtai)};
        const float* brp = a.in[18] + ((size_t)lg * 64 + st) * 16; const float* bip = a.in[19] + ((size_t)lg * 64 + st) * 16;
        bf16_t* ore = (bf16_t*)(a.ws + WS_S5B) + ((size_t)(lg * 2) * 64 + st) * 16; bf16_t* oim = ore + 64 * 16;
        for (int c = 0; c < 16; ++c) { const float br = brp[c], bi = bip[c]; ore[c] = f2bf(cr * br - ci * bi); oim[c] = f2bf(cr * bi + ci * br); }
    }
#endif
    float* TB = (float*)(a.ws + WS_TB);
    for (int i = gt; i < 8 * TBN; i += gn) { const int hh = i / TBN, d = i % TBN; TB[i] = relb[t5_bucket(d) * 8 + hh] * LOG2E; }
}

__device__ __forceinline__ void load_row16(const float* __restrict__ p, int lane, float (&xv)[16]) {
#pragma unroll
    for (int j = 0; j < 4; ++j) { const f32x4 t = *(const f32x4*)(p + 16 * lane + 4 * j); xv[4 * j] = t[0]; xv[4 * j + 1] = t[1]; xv[4 * j + 2] = t[2]; xv[4 * j + 3] = t[3]; }
}
__device__ __forceinline__ void load_row16_bf(const bf16_t* __restrict__ p, int slot, float (&xv)[16]) {
    const u32x4 a = *(const u32x4*)(p + 16 * slot), b = *(const u32x4*)(p + 16 * slot + 8);
#pragma unroll
    for (int j = 0; j < 4; ++j) { xv[2 * j] = __uint_as_float(a[j] << 16); xv[2 * j + 1] = __uint_as_float(a[j] & 0xffff0000u); xv[8 + 2 * j] = __uint_as_float(b[j] << 16); xv[8 + 2 * j + 1] = __uint_as_float(b[j] & 0xffff0000u); }
}
__device__ __forceinline__ void finish_token(int tok, const float (&xv)[16], float* __restrict__ xo, bf16_t* __restrict__ xb, float* __restrict__ rstd,
                                             const float* __restrict__ wf, const float* __restrict__ bfor, float* __restrict__ flog, int lane, int slot) {
    float ss = 0.f;
#pragma unroll
    for (int i = 0; i < 16; ++i) ss += xv[i] * xv[i];
    ss = wave_sum(ss);
    const float rs = __builtin_amdgcn_rsqf(ss * (1.f / 1024.f) + EPS);
    float* op = xo + (size_t)tok * D + 16 * slot; bf16_t* bp = xb + (size_t)tok * D + 16 * slot;
    if (xo) {
#pragma unroll
        for (int j = 0; j < 4; ++j) *(f32x4*)(op + 4 * j) = (f32x4){xv[4 * j], xv[4 * j + 1], xv[4 * j + 2], xv[4 * j + 3]};
    }
    u32x4 w0, w1;
    w0.x = pk2(xv[0], xv[1]); w0.y = pk2(xv[2], xv[3]); w0.z = pk2(xv[4], xv[5]); w0.w = pk2(xv[6], xv[7]);
    w1.x = pk2(xv[8], xv[9]); w1.y = pk2(xv[10], xv[11]); w1.z = pk2(xv[12], xv[13]); w1.w = pk2(xv[14], xv[15]);
    *(u32x4*)(bp) = w0; *(u32x4*)(bp + 8) = w1;
    if (lane == 0) rstd[tok] = rs;
    if (wf) {
        float myff = 0.f;
#pragma unroll
        for (int h = 0; h < 4; ++h) {
            const float* wp = wf + h * 1024 + 16 * slot;
            float d = 0.f;
#pragma unroll
            for (int j = 0; j < 4; ++j) { const f32x4 t = *(const f32x4*)(wp + 4 * j); d += xv[4 * j] * t[0] + xv[4 * j + 1] * t[1] + xv[4 * j + 2] * t[2] + xv[4 * j + 3] * t[3]; }
            d = wave_sum(d);
            if (lane == h) myff = d;
        }
        if (lane < 4) { const int b = tok / S, s = tok % S; flog[((size_t)b * 4 + lane) * S + s] = log_sigmoid(myff * rs + bfor[lane]); }
    }
}
__device__ __forceinline__ void phase_xprep(const Args& a) {
    const int lane = threadIdx.x & 63, wv = blockIdx.x * 8 + (threadIdx.x >> 6), nw = gridDim.x * 8;
    const float* x = a.in[0];
    for (int tok = wv; tok < T; tok += nw) {
        float xv[16]; load_row16(x + (size_t)tok * D, lane, xv);
        finish_token(tok, xv, nullptr, (bf16_t*)(a.ws + WS_XB), (float*)(a.ws + WS_RSTD), (const float*)(a.ws + WS_WF), a.in[2], (float*)(a.ws + WS_FLOG), lane, lane);
    }
}
__device__ __forceinline__ void cum_scan(const Args& a, unsigned char* ldsb, int bh) {
    float* lds = (float*)ldsb;
    const int tid = threadIdx.x, lane = tid & 63, w = tid >> 6;
    const float* fl = (const float*)(a.ws + WS_FLOG) + (size_t)bh * S + tid * 16;
    float v[16];
#pragma unroll
    for (int i = 0; i < 4; ++i) { const f32x4 t = *(const f32x4*)(fl + 4 * i); v[4 * i] = t[0]; v[4 * i + 1] = t[1]; v[4 * i + 2] = t[2]; v[4 * i + 3] = t[3]; }
#pragma unroll
    for (int i = 1; i < 16; ++i) v[i] += v[i - 1];
    float incl = v[15];
#pragma unroll
    for (int o = 1; o < 64; o <<= 1) { const float t = __shfl_up(incl, o); if (lane >= o) incl += t; }
    if (lane == 63) lds[w] = incl;
    __syncthreads();
    float base = incl - v[15];
    for (int j = 0; j < w; ++j) base += lds[j];
    float* cp = (float*)(a.ws + WS_CUM) + (size_t)bh * S + tid * 16;
#pragma unroll
    for (int i = 0; i < 4; ++i) *(f32x4*)(cp + 4 * i) = (f32x4){(base + v[4 * i]) * LOG2E, (base + v[4 * i + 1]) * LOG2E, (base + v[4 * i + 2]) * LOG2E, (base + v[4 * i + 3]) * LOG2E};
    __syncthreads();
}

constexpr int AT_KP = 176, AT_KB = 64 * AT_KP, AT_KS = 0, AT_VP = 192, AT_VB = 64 * AT_VP, AT_VT = 2 * AT_KB, AT_TBL = AT_VT + 2 * AT_VB, AT_END = AT_TBL + TBN * 4;
__device__ __forceinline__ int swap23(int i) { return (i & ~12) | ((i & 4) << 1) | ((i & 8) >> 1); }
#define MFMA32(A, B, C) __builtin_amdgcn_mfma_f32_32x32x16_bf16(A, B, C, 0, 0, 0)
#define MFMA_DRAIN2(x, y) asm volatile("s_nop 15\n\ts_nop 15\n\ts_nop 7" : "+v"(x), "+v"(y))
typedef float f32x2_t __attribute__((ext_vector_type(2))); typedef __bf16 bf16x2_t __attribute__((ext_vector_type(2)));
__device__ __forceinline__ float max3f(float a, float b, float c) { return __builtin_fmaxf(__builtin_fmaxf(a, b), c); }
__device__ __forceinline__ unsigned cvtpk(float lo, float hi) { const f32x2_t v = {lo, hi}; const bf16x2_t b = __builtin_convertvector(v, bf16x2_t); return __builtin_bit_cast(unsigned, b); }
__device__ __forceinline__ bf16x8 pack8(const f32x16& p, int s8) {
    u32x4 w; w.x = cvtpk(p[s8], p[s8 + 1]); w.y = cvtpk(p[s8 + 2], p[s8 + 3]); w.z = cvtpk(p[s8 + 4], p[s8 + 5]); w.w = cvtpk(p[s8 + 6], p[s8 + 7]);
    return __builtin_bit_cast(bf16x8, w);
}
__device__ __forceinline__ void split3(float x, float& b1, float& b2, float& b3) {
    b1 = bf2f(f2bf(x)); const float r = x - b1; b2 = bf2f(f2bf(r)); b3 = bf2f(f2bf(r - b2));
}
__device__ __forceinline__ void stage_kv(unsigned char* lds, int buf, int kv_s, int c_s, const u32x4& kreg, const u32x4& vreg) {
    *(u32x4*)(lds + AT_KS + buf * AT_KB + kv_s * AT_KP + 16 * c_s) = kreg;
    *(u32x4*)(lds + AT_VT + buf * AT_VB + kv_s * AT_VP + 16 * c_s) = vreg;
}
struct SMState { float mref, l; };
template <int NP>
__device__ __forceinline__ void softmax_step(f32x16 (&p)[NP], SMState& st, bool& refzero, f32x16 (&o)[2]) {
    float a = max3f(p[0][0], p[0][1], p[0][2]), b = max3f(p[0][3], p[0][4], p[0][5]);
    a = max3f(a, p[0][6], p[0][7]); b = max3f(b, p[0][8], p[0][9]); a = max3f(a, p[0][10], p[0][11]); b = max3f(b, p[0][12], p[0][13]); a = max3f(a, p[0][14], p[0][15]);
    if (NP == 2) { b = max3f(b, p[NP - 1][0], p[NP - 1][1]); a = max3f(a, p[NP - 1][2], p[NP - 1][3]); b = max3f(b, p[NP - 1][4], p[NP - 1][5]); a = max3f(a, p[NP - 1][6], p[NP - 1][7]);
        b = max3f(b, p[NP - 1][8], p[NP - 1][9]); a = max3f(a, p[NP - 1][10], p[NP - 1][11]); b = max3f(b, p[NP - 1][12], p[NP - 1][13]); a = max3f(a, p[NP - 1][14], p[NP - 1][15]); }
    const float rm = half_swap_max(fmaxf(a, b));
    if (__any(rm - st.mref > 20.f)) {
        const float nr = (rm - st.mref > 20.f) ? rm : st.mref;
        const float f = __builtin_amdgcn_exp2f(st.mref - nr);
        st.l *= f;
#pragma unroll
        for (int r = 0; r < 16; ++r) { o[0][r] *= f; o[1][r] *= f; }
        st.mref = nr; refzero = false;
    }
    if (!refzero) {
#pragma unroll
        for (int i = 0; i < NP; ++i)
#pragma unroll
            for (int r = 0; r < 16; ++r) p[i][r] -= st.mref;
    }
    float ps = 0.f;
#pragma unroll
    for (int i = 0; i < NP; ++i)
#pragma unroll
        for (int r = 0; r < 16; ++r) { const float e = __builtin_amdgcn_exp2f(p[i][r]); p[i][r] = e; ps += e; }
    st.l += ps;
}
typedef short v4i16_t __attribute__((ext_vector_type(4)));
__device__ __forceinline__ void load_vf(const unsigned char* lds, int buf, int lane, bf16x8 (&vf)[2][2][2]) {
    const int g = lane >> 4, i = lane & 15, q = i >> 2, p4 = i & 3;
    const LAS3 unsigned char* base = (const LAS3 unsigned char*)(lds + AT_VT + buf * AT_VB) + (8 * (g >> 1) + q) * AT_VP + (16 * (g & 1) + 4 * p4) * 2;
#pragma unroll
    for (int db = 0; db < 2; ++db)
#pragma unroll
        for (int hf = 0; hf < 2; ++hf)
#pragma unroll
            for (int s = 0; s < 2; ++s) {
                const LAS3 unsigned char* pp = base + (32 * hf + 16 * s) * AT_VP + 64 * db;
                const v4i16_t lo = __builtin_amdgcn_ds_read_tr16_b64_v4i16((LAS3 v4i16_t*)pp);
                const v4i16_t hi4 = __builtin_amdgcn_ds_read_tr16_b64_v4i16((LAS3 v4i16_t*)(pp + 4 * AT_VP));
                vf[db][hf][s] = (bf16x8){lo[0], lo[1], lo[2], lo[3], hi4[0], hi4[1], hi4[2], hi4[3]};
            }
}
__device__ __forceinline__ void pv_tile(const bf16x8 (&vf)[2][2][2], const f32x16 (&p)[2], f32x16 (&o)[2]) {
#pragma unroll
    for (int hf = 0; hf < 2; ++hf)
#pragma unroll
        for (int s = 0; s < 2; ++s) {
            const bf16x8 pf = pack8(p[hf], 8 * s);
#pragma unroll
            for (int db = 0; db < 2; ++db) o[db] = MFMA32(vf[db][hf][s], pf, o[db]);
        }
}
__device__ __forceinline__ void store_ot(bf16_t* dst, const f32x16 (&o)[2], float sc, int hi) {
#pragma unroll
    for (int db = 0; db < 2; ++db)
#pragma unroll
        for (int r4 = 0; r4 < 4; ++r4) {
            u32x2 w; w.x = cvtpk(o[db][4 * r4] * sc, o[db][4 * r4 + 1] * sc); w.y = cvtpk(o[db][4 * r4 + 2] * sc, o[db][4 * r4 + 3] * sc);
            *(u32x2*)(dst + 32 * db + 8 * r4 + 4 * hi) = w;
        }
}

__device__ __forceinline__ void fox_unit(const Args& a, unsigned char* lds, int layer, int bh, int qb) {
    int tid = threadIdx.x; asm volatile("" : "+v"(tid));
    const int lane = tid & 63, w = __builtin_amdgcn_readfirstlane(tid >> 6), qi = lane & 31, hi = lane >> 5;
    const int b = bh >> 2, h = bh & 3;
    const bf16_t* zb = (const bf16_t*)(a.ws + WS_ZB) + (size_t)b * S * ZP;
    const float* cum = (const float*)(a.ws + WS_CUM) + (size_t)bh * S;
    const int q0 = 256 * qb + 32 * w;
    const float cref = cum[256 * qb];
    bf16x8 qf[5];
#pragma unroll
    for (int ds = 0; ds < 4; ++ds) qf[ds] = *(const bf16x8*)(zb + (size_t)(q0 + qi) * ZP + ZC_FQ + 64 * h + 16 * ds + 8 * hi);
    { float q1, q2, q3; split3(cum[q0 + qi] - cref, q1, q2, q3);
      u32x4 e; e.x = hi ? 0u : 0x3f803f80u; e.y = hi ? 0u : (0x3f80u | ((unsigned)f2bf(q1) << 16)); e.z = hi ? 0u : ((unsigned)f2bf(q2) | ((unsigned)f2bf(q3) << 16)); e.w = 0u;
      qf[4] = __builtin_bit_cast(bf16x8, e); }
    const int ntiles = 4 * (qb + 1), mylast = 4 * qb + (w >> 1);
    const float thr = ((const float*)(a.ws + WS_FOXT))[layer];
    int kt0 = 0;
    {
        const bool sk = tid < 4 * qb && (cref - cum[64 * tid + 63]) < -thr;
        const unsigned long long bal = __ballot(sk);
        volatile LAS3 unsigned* cw = (volatile LAS3 unsigned*)(LAS3 unsigned char*)(lds + LDS_CTL + 64);
        if (lane == 0) cw[w] = (unsigned)__popcll(bal);
        __syncthreads();
#pragma unroll
        for (int i = 0; i < 8; ++i) kt0 += (int)cw[i];
        __syncthreads();
    }
    const int kv_s = 8 * w + (lane >> 3), c_s = lane & 7;
    const bf16_t* kp = zb + (size_t)kv_s * ZP + ZC_FK + 64 * h + 8 * c_s;
    const bf16_t* vp = zb + (size_t)kv_s * ZP + ZC_FV + 64 * h + 8 * c_s;
    u32x4 kreg = *(const u32x4*)(kp + (size_t)kt0 * 64 * ZP), vreg = *(const u32x4*)(vp + (size_t)kt0 * 64 * ZP);
    float dreg = (tid < 64) ? cum[kt0 * 64 + tid] : 0.f;
    SMState st; st.mref = 0.f; st.l = 0.f; bool refzero = true;
    f32x16 o[2]; o[0] = (f32x16){}; o[1] = (f32x16){};
    const int krow = swap23(qi);
#ifdef HK_FOX_NOSTAG
    const int grp = HK_FOX_NOSTAG - 1;
#else
    const int grp = w >> 2;
#endif
    f32x16 p[2];
#define FOX_QK(kt_, buf_) do { bf16x8 kf_[2][5]; \
        _Pragma("unroll") for (int hf = 0; hf < 2; ++hf) _Pragma("unroll") for (int ds = 0; ds < 5; ++ds) kf_[hf][ds] = *(const bf16x8*)(lds + AT_KS + (buf_) * AT_KB + (32 * hf + krow) * AT_KP + 32 * ds + 16 * hi); \
        _Pragma("unroll") for (int hf = 0; hf < 2; ++hf) { p[hf] = (f32x16){}; _Pragma("unroll") for (int ds = 0; ds < 5; ++ds) p[hf] = MFMA32(kf_[hf][ds], qf[ds], p[hf]); } \
        MFMA_DRAIN2(p[0], p[1]); \
        if (64 * (kt_) + 63 > q0) { const int lim = q0 + qi - 64 * (kt_) - 8 * hi; \
            _Pragma("unroll") for (int hf = 0; hf < 2; ++hf) _Pragma("unroll") for (int r = 0; r < 16; ++r) if (32 * hf + 16 * (r >> 3) + (r & 7) > lim) p[hf][r] = -INFINITY; } } while (0)
#define FOX_SMPV(buf_) do { bf16x8 vf_[2][2][2]; load_vf(lds, (buf_), lane, vf_); softmax_step<2>(p, st, refzero, o); pv_tile(vf_, p, o); } while (0)
    for (int kt = kt0; kt < ntiles; ++kt) {
        const int buf = kt & 1;
        stage_kv(lds, buf, kv_s, c_s, kreg, vreg);
        if (tid < 64) { float k1, k2, k3; split3(cref - dreg, k1, k2, k3);
            u32x4 e; e.x = (unsigned)f2bf(k1) | ((unsigned)f2bf(k2) << 16); e.y = (unsigned)f2bf(k3) | 0x3f800000u; e.z = 0x3f803f80u; e.w = 0u;
            unsigned char* kr = lds + AT_KS + buf * AT_KB + tid * AT_KP + 128;
            *(u32x4*)kr = e; *(u32x4*)(kr + 16) = (u32x4){0u, 0u, 0u, 0u}; }
        __syncthreads();
        if (kt + 1 < ntiles) {
            kreg = *(const u32x4*)(kp + (size_t)(kt + 1) * 64 * ZP); vreg = *(const u32x4*)(vp + (size_t)(kt + 1) * 64 * ZP);
            if (tid < 64) dreg = cum[(kt + 1) * 64 + tid];
        }
#ifdef HK_FOX_X2
        if (grp == 0) { if (kt <= mylast) FOX_QK(kt, buf); }
        __syncthreads();
        if (grp == 0) { if (kt <= mylast) FOX_SMPV(buf); }
        else { if (kt > kt0 && kt - 1 <= mylast) FOX_SMPV(buf ^ 1); if (kt <= mylast) FOX_QK(kt, buf); }
#else
        if (grp == 0) { if (kt <= mylast) FOX_QK(kt, buf); }
        else { if (kt > kt0 && kt - 1 <= mylast) FOX_SMPV(buf ^ 1); }
        __syncthreads();
        if (grp == 0) { if (kt <= mylast) FOX_SMPV(buf); }
        else { if (kt <= mylast) FOX_QK(kt, buf); }
#endif
#ifdef HK_FOX_B3
        __syncthreads();
#endif
    }
    if (grp == 1 && ntiles - 1 <= mylast) FOX_SMPV((ntiles - 1) & 1);
#undef FOX_QK
#undef FOX_SMPV
    const float l = half_swap_sum(st.l);
    store_ot((bf16_t*)(a.ws + WS_MIX) + (size_t)(b * S + q0 + qi) * D + 0 + 64 * h, o, 1.f / l, hi);
    __syncthreads();
}

__device__ __forceinline__ void fox64_unit(const Args& a, unsigned char* lds, int layer, int bh, int qb) {
    int tid = threadIdx.x; asm volatile("" : "+v"(tid));
    const int lane = tid & 63, w = __builtin_amdgcn_readfirstlane(tid >> 6), qi = lane & 31, hi = lane >> 5;
    const int b = bh >> 2, h = bh & 3;
    const bf16_t* zb = (const bf16_t*)(a.ws + WS_ZB) + (size_t)b * S * ZP;
    const float* cum = (const float*)(a.ws + WS_CUM) + (size_t)bh * S;
    const int q0 = 512 * qb + 64 * w;
    const float cref = cum[512 * qb];
    bf16x8 qfA[5], qfB[5];
#pragma unroll
    for (int ds = 0; ds < 4; ++ds) { qfA[ds] = *(const bf16x8*)(zb + (size_t)(q0 + qi) * ZP + ZC_FQ + 64 * h + 16 * ds + 8 * hi); qfB[ds] = *(const bf16x8*)(zb + (size_t)(q0 + 32 + qi) * ZP + ZC_FQ + 64 * h + 16 * ds + 8 * hi); }
#pragma unroll
    for (int blk = 0; blk < 2; ++blk) { float q1, q2, q3; split3(cum[q0 + 32 * blk + qi] - cref, q1, q2, q3);
      u32x4 e; e.x = hi ? 0u : 0x3f803f80u; e.y = hi ? 0u : (0x3f80u | ((unsigned)f2bf(q1) << 16)); e.z = hi ? 0u : ((unsigned)f2bf(q2) | ((unsigned)f2bf(q3) << 16)); e.w = 0u;
      if (blk == 0) qfA[4] = __builtin_bit_cast(bf16x8, e); else qfB[4] = __builtin_bit_cast(bf16x8, e); }
    const int ntiles = 8 * (qb + 1), mylast = 8 * qb + w;
    const float thr = ((const float*)(a.ws + WS_FOXT))[layer];
    int kt0 = 0;
    {   const bool sk = tid < 8 * qb && (cref - cum[64 * tid + 63]) < -thr;
        const unsigned long long bal = __ballot(sk);
        volatile LAS3 unsigned* cw = (volatile LAS3 unsigned*)(LAS3 unsigned char*)(lds + LDS_CTL + 64);
        if (lane == 0) cw[w] = (unsigned)__popcll(bal);
        __syncthreads();
#pragma unroll
        for (int i = 0; i < 8; ++i) kt0 += (int)cw[i];
        __syncthreads();
    }
    const int kv_s = 8 * w + (lane >> 3), c_s = lane & 7;
    const bf16_t* kp = zb + (size_t)kv_s * ZP + ZC_FK + 64 * h + 8 * c_s;
    const bf16_t* vp = zb + (size_t)kv_s * ZP + ZC_FV + 64 * h + 8 * c_s;
    u32x4 kreg = *(const u32x4*)(kp + (size_t)kt0 * 64 * ZP), vreg = *(const u32x4*)(vp + (size_t)kt0 * 64 * ZP);
    float dreg = (tid < 64) ? cum[kt0 * 64 + tid] : 0.f;
    SMState stA, stB; stA.mref = 0.f; stA.l = 0.f; stB.mref = 0.f; stB.l = 0.f; bool rzA = true, rzB = true;
    f32x16 oA[2], oB[2]; oA[0] = (f32x16){}; oA[1] = (f32x16){}; oB[0] = (f32x16){}; oB[1] = (f32x16){};
    const int krow = swap23(qi);
    for (int kt = kt0; kt < ntiles; ++kt) {
        const int buf = kt & 1;
        stage_kv(lds, buf, kv_s, c_s, kreg, vreg);
        if (tid < 64) { float k1, k2, k3; split3(cref - dreg, k1, k2, k3);
            u32x4 e; e.x = (unsigned)f2bf(k1) | ((unsigned)f2bf(k2) << 16); e.y = (unsigned)f2bf(k3) | 0x3f800000u; e.z = 0x3f803f80u; e.w = 0u;
            unsigned char* kr = lds + AT_KS + buf * AT_KB + tid * AT_KP + 128;
            *(u32x4*)kr = e; *(u32x4*)(kr + 16) = (u32x4){0u, 0u, 0u, 0u}; }
        __syncthreads();
        if (kt + 1 < ntiles) {
            kreg = *(const u32x4*)(kp + (size_t)(kt + 1) * 64 * ZP); vreg = *(const u32x4*)(vp + (size_t)(kt + 1) * 64 * ZP);
            if (tid < 64) dreg = cum[(kt + 1) * 64 + tid];
        }
        if (kt <= mylast) {
            f32x16 pA[2], pB[2];
#pragma unroll
            for (int hf = 0; hf < 2; ++hf) {
                pA[hf] = (f32x16){}; pB[hf] = (f32x16){};
#pragma unroll
                for (int ds = 0; ds < 5; ++ds) { const bf16x8 kf = *(const bf16x8*)(lds + AT_KS + buf * AT_KB + (32 * hf + krow) * AT_KP + 32 * ds + 16 * hi);
                    pA[hf] = MFMA32(kf, qfA[ds], pA[hf]); pB[hf] = MFMA32(kf, qfB[ds], pB[hf]); }
            }
            if (kt == mylast) {
                const int limA = qi - 8 * hi, limB = 32 + qi - 8 * hi;
#pragma unroll
                for (int hf = 0; hf < 2; ++hf)
#pragma unroll
                    for (int r = 0; r < 16; ++r) { const int kvo = 32 * hf + 16 * (r >> 3) + (r & 7); if (kvo > limA) pA[hf][r] = -INFINITY; if (kvo > limB) pB[hf][r] = -INFINITY; }
            }
            softmax_step<2>(pA, stA, rzA, oA); softmax_step<2>(pB, stB, rzB, oB);
            const int g_ = lane >> 4, i_ = lane & 15;
            const LAS3 unsigned char* vb_ = (const LAS3 unsigned char*)(lds + AT_VT + buf * AT_VB) + (8 * (g_ >> 1) + (i_ >> 2)) * AT_VP + (16 * (g_ & 1) + 4 * (i_ & 3)) * 2;
#pragma unroll
            for (int hf = 0; hf < 2; ++hf)
#pragma unroll
                for (int s = 0; s < 2; ++s) {
                    const bf16x8 fa = pack8(pA[hf], 8 * s), fb = pack8(pB[hf], 8 * s);
#pragma unroll
                    for (int db = 0; db < 2; ++db) {
                        const LAS3 unsigned char* pp = vb_ + (32 * hf + 16 * s) * AT_VP + 64 * db;
                        const v4i16_t lo = __builtin_amdgcn_ds_read_tr16_b64_v4i16((LAS3 v4i16_t*)pp);
                        const v4i16_t hi4 = __builtin_amdgcn_ds_read_tr16_b64_v4i16((LAS3 v4i16_t*)(pp + 4 * AT_VP));
                        const bf16x8 vf = (bf16x8){lo[0], lo[1], lo[2], lo[3], hi4[0], hi4[1], hi4[2], hi4[3]};
                        oA[db] = MFMA32(vf, fa, oA[db]); oB[db] = MFMA32(vf, fb, oB[db]);
                    }
                }
        }
    }
    const float lA = half_swap_sum(stA.l), lB = half_swap_sum(stB.l);
    bf16_t* mo = (bf16_t*)(a.ws + WS_MIX) + (size_t)(b * S + q0 + qi) * D + 64 * h;
    store_ot(mo, oA, 1.f / lA, hi);
    store_ot(mo + (size_t)32 * D, oB, 1.f / lB, hi);
    __syncthreads();
}

__device__ __forceinline__ void diff_unit(const Args& a, unsigned char* lds, int layer, int bh, int qb) {
    int tid = threadIdx.x; asm volatile("" : "+v"(tid));
    const int lane = tid & 63, w = __builtin_amdgcn_readfirstlane(tid >> 6), qi = lane & 31, hi = lane >> 5;
    const int b = bh >> 2, h = bh & 3;
    const bf16_t* zb = (const bf16_t*)(a.ws + WS_ZB) + (size_t)b * S * ZP;
    const int q0 = 256 * qb + 32 * w;
    {
        const float* tb = (const float*)(a.ws + WS_TB) + (size_t)(4 + h) * TBN; float* tl = (float*)(lds + AT_TBL);
        const float cb = tb[1600]; float tv[5];
#pragma unroll
        for (int k = 0; k < 5; ++k) { const int i = tid + NTHR * k; tv[k] = tb[i < TBN ? i : TBN - 1]; }
#pragma unroll
        for (int k = 0; k < 5; ++k) { const int i = tid + NTHR * k; if (i < TBN) tl[i] = tv[k] - cb; }
    }
    bf16x8 qf[2][2];
#pragma unroll
    for (int c = 0; c < 2; ++c)
#pragma unroll
        for (int ds = 0; ds < 2; ++ds) qf[c][ds] = *(const bf16x8*)(zb + (size_t)(q0 + qi) * ZP + ZC_CQ + 64 * h + 32 * c + 16 * ds + 8 * hi);
    const int ntiles = 4 * (qb + 1), mylast = 4 * qb + (w >> 1);
    const int kv_s = 8 * w + (lane >> 3), c_s = lane & 7;
    const bf16_t* kp = zb + (size_t)kv_s * ZP + ZC_CK + 64 * h + 8 * c_s;
    const bf16_t* vp = zb + (size_t)kv_s * ZP + ZC_CV + 64 * h + 8 * c_s;
    u32x4 kreg = *(const u32x4*)kp, vreg = *(const u32x4*)vp;
    SMState st[2]; st[0].mref = 0.f; st[0].l = 0.f; st[1].mref = 0.f; st[1].l = 0.f; bool rz0 = true, rz1 = true;
    f32x16 o[2][2];
#pragma unroll
    for (int c = 0; c < 2; ++c) { o[c][0] = (f32x16){}; o[c][1] = (f32x16){}; }
    const int krow = swap23(qi);
    const float* tl = (const float*)(lds + AT_TBL);
    for (int kt = 0; kt < ntiles; ++kt) {
        const int buf = kt & 1;
        stage_kv(lds, buf, kv_s, c_s, kreg, vreg);
        __syncthreads();
        if (kt + 1 < ntiles) { kreg = *(const u32x4*)(kp + (size_t)(kt + 1) * 64 * ZP); vreg = *(const u32x4*)(vp + (size_t)(kt + 1) * 64 * ZP); }
        if (kt <= mylast) {
            const bool far_ = q0 - (64 * kt + 63) >= 1513;
            const bool diag = 64 * kt + 63 > q0;
            const int dq = q0 + qi - 64 * kt - 8 * hi;
#pragma unroll
            for (int hf = 0; hf < 2; ++hf) {
                f32x16 p0[1], p1[1]; p0[0] = (f32x16){}; p1[0] = (f32x16){};
                bf16x8 vf[2][2];
                { const int g_ = lane >> 4, i_ = lane & 15;
                  const LAS3 unsigned char* vb_ = (const LAS3 unsigned char*)(lds + AT_VT + buf * AT_VB) + (32 * hf + 8 * (g_ >> 1) + (i_ >> 2)) * AT_VP + (16 * (g_ & 1) + 4 * (i_ & 3)) * 2;
#pragma unroll
                  for (int s = 0; s < 2; ++s)
#pragma unroll
                      for (int db = 0; db < 2; ++db) {
                          const v4i16_t lo = __builtin_amdgcn_ds_read_tr16_b64_v4i16((LAS3 v4i16_t*)(vb_ + 16 * s * AT_VP + 64 * db));
                          const v4i16_t hi4 = __builtin_amdgcn_ds_read_tr16_b64_v4i16((LAS3 v4i16_t*)(vb_ + (16 * s + 4) * AT_VP + 64 * db));
                          vf[s][db] = (bf16x8){lo[0], lo[1], lo[2], lo[3], hi4[0], hi4[1], hi4[2], hi4[3]};
                      } }
#pragma unroll
                for (int ds = 0; ds < 2; ++ds) {
                    const bf16x8 k0 = *(const bf16x8*)(lds + AT_KS + buf * AT_KB + (32 * hf + krow) * AT_KP + 32 * ds + 16 * hi);
                    const bf16x8 k1 = *(const bf16x8*)(lds + AT_KS + buf * AT_KB + (32 * hf + krow) * AT_KP + 64 + 32 * ds + 16 * hi);
                    p0[0] = MFMA32(k0, qf[0][ds], p0[0]); p1[0] = MFMA32(k1, qf[1][ds], p1[0]);
                }
                MFMA_DRAIN2(p0[0], p1[0]);
                if (!far_) {
                    if (diag) {
#pragma unroll
                        for (int r = 0; r < 16; ++r) {
                            const int dist = dq - (32 * hf + 16 * (r >> 3) + (r & 7));
                            const float bb = tl[dist < 0 ? 0 : dist];
                            const bool ok = dist >= 0;
                            p0[0][r] = ok ? p0[0][r] + bb : -INFINITY; p1[0][r] = ok ? p1[0][r] + bb : -INFINITY;
                        }
                    } else {
#pragma unroll
                        for (int r = 0; r < 16; ++r) { const float bb = tl[dq - (32 * hf + 16 * (r >> 3) + (r & 7))]; p0[0][r] += bb; p1[0][r] += bb; }
                    }
                }
                softmax_step<1>(p0, st[0], rz0, o[0]); softmax_step<1>(p1, st[1], rz1, o[1]);
#pragma unroll
                for (int s = 0; s < 2; ++s) {
                    const bf16x8 f0 = pack8(p0[0], 8 * s), f1 = pack8(p1[0], 8 * s);
#pragma unroll
                    for (int db = 0; db < 2; ++db) { o[0][db] = MFMA32(vf[s][db], f0, o[0][db]); o[1][db] = MFMA32(vf[s][db], f1, o[1][db]); }
                }
            }
        }
    }
    const float lam_init = 0.8f - 0.6f * __expf(-0.3f * (float)layer);
    const float* lp = a.in[12] + layer * 128;
    float s1 = 0.f, s2 = 0.f;
    for (int i = 0; i < 32; ++i) { s1 += lp[i] * lp[32 + i]; s2 += lp[64 + i] * lp[96 + i]; }
    const float lam = __expf(s1) - __expf(s2) + lam_init;
    const float i0 = 1.f / half_swap_sum(st[0].l), i1 = lam / half_swap_sum(st[1].l);
    float ss = 0.f;
#pragma unroll
    for (int db = 0; db < 2; ++db)
#pragma unroll
        for (int r = 0; r < 16; ++r) { const float v = o[0][db][r] * i0 - o[1][db][r] * i1; o[0][db][r] = v; ss += v * v; }
    ss = half_swap_sum(ss);
    const float rn = __builtin_amdgcn_rsqf(ss * (1.f / 64.f) + EPS) * (1.f - lam_init);
    const float* gn = a.in[13] + layer * 64;
#pragma unroll
    for (int db = 0; db < 2; ++db)
#pragma unroll
        for (int r = 0; r < 16; ++r) o[0][db][r] *= gn[32 * db + (r & 3) + 8 * (r >> 2) + 4 * hi];
    store_ot((bf16_t*)(a.ws + WS_MIX) + (size_t)(b * S + q0 + qi) * D + 512 + 64 * h, o[0], rn, hi);
    __syncthreads();
}

__device__ __forceinline__ void dil_unit(const Args& a, unsigned char* lds, int bh, int br, int rho, int tile) {
    int tid = threadIdx.x; asm volatile("" : "+v"(tid));
    const int lane = tid & 63, w = __builtin_amdgcn_readfirstlane(tid >> 6), qi = lane & 31, hi = lane >> 5;
    const int b = bh >> 2, h = bh & 3;
    const int r = br == 0 ? 1 : (br == 1 ? 4 : 16);
    const bf16_t* zb = (const bf16_t*)(a.ws + WS_ZB) + (size_t)b * S * ZP;
    {   const float* tb = (const float*)(a.ws + WS_TB) + (size_t)h * TBN; float* tl = (float*)(lds + AT_TBL); float tv[5];
#pragma unroll
        for (int k = 0; k < 5; ++k) { const int i = tid + NTHR * k; tv[k] = tb[i < TBN ? i : TBN - 1]; }
#pragma unroll
        for (int k = 0; k < 5; ++k) { const int i = tid + NTHR * k; if (i < TBN) tl[i] = tv[k]; }
    }
    const int l0 = 256 * tile, lq0 = l0 + 32 * w;
    const int tq = (lq0 + qi) * r + rho;
    bf16x8 qf[4];
#pragma unroll
    for (int ds = 0; ds < 4; ++ds) qf[ds] = *(const bf16x8*)(zb + (size_t)tq * ZP + ZC_DQ + 64 * h + 16 * ds + 8 * hi);
    const int kv_s = 8 * w + (lane >> 3), c_s = lane & 7;
    const int j0 = (l0 == 0) ? 2 : 0;
    auto krow_of = [&](int j) { int kl = l0 - 128 + 64 * j + kv_s; kl = kl < 0 ? 0 : kl; return (size_t)(kl * r + rho) * ZP; };
    u32x4 kreg = *(const u32x4*)(zb + krow_of(j0) + ZC_DK + 64 * h + 8 * c_s), vreg = *(const u32x4*)(zb + krow_of(j0) + ZC_DV + 64 * h + 8 * c_s);
    SMState st; st.mref = 0.f; st.l = 0.f; bool refzero = true;
    f32x16 o[2]; o[0] = (f32x16){}; o[1] = (f32x16){};
    const int krow = swap23(qi);
    const float* tl = (const float*)(lds + AT_TBL);
    for (int j = j0; j < 6; ++j) {
        const int buf = j & 1;
        stage_kv(lds, buf, kv_s, c_s, kreg, vreg);
        __syncthreads();
        if (j + 1 < 6) { kreg = *(const u32x4*)(zb + krow_of(j + 1) + ZC_DK + 64 * h + 8 * c_s); vreg = *(const u32x4*)(zb + krow_of(j + 1) + ZC_DV + 64 * h + 8 * c_s); }
        const int kl0 = l0 - 128 + 64 * j;
#pragma unroll
        for (int hf = 0; hf < 2; ++hf) {
            const int kh0 = kl0 + 32 * hf;
            if (kh0 <= lq0 + 31 && kh0 + 31 >= lq0 - 128 && kh0 + 31 >= 0) {
                f32x16 p[1]; p[0] = (f32x16){};
                bf16x8 kf[4];
#pragma unroll
                for (int ds = 0; ds < 4; ++ds) kf[ds] = *(const bf16x8*)(lds + AT_KS + buf * AT_KB + (32 * hf + krow) * AT_KP + 32 * ds + 16 * hi);
                bf16x8 vf[2][2];
                { const int g_ = lane >> 4, i_ = lane & 15;
                  const LAS3 unsigned char* vb_ = (const LAS3 unsigned char*)(lds + AT_VT + buf * AT_VB) + (32 * hf + 8 * (g_ >> 1) + (i_ >> 2)) * AT_VP + (16 * (g_ & 1) + 4 * (i_ & 3)) * 2;
#pragma unroll
                  for (int s = 0; s < 2; ++s)
#pragma unroll
                      for (int db = 0; db < 2; ++db) {
                          const v4i16_t lo = __builtin_amdgcn_ds_read_tr16_b64_v4i16((LAS3 v4i16_t*)(vb_ + 16 * s * AT_VP + 64 * db));
                          const v4i16_t hi4 = __builtin_amdgcn_ds_read_tr16_b64_v4i16((LAS3 v4i16_t*)(vb_ + (16 * s + 4) * AT_VP + 64 * db));
                          vf[s][db] = (bf16x8){lo[0], lo[1], lo[2], lo[3], hi4[0], hi4[1], hi4[2], hi4[3]};
                      } }
#pragma unroll
                for (int ds = 0; ds < 4; ++ds) p[0] = MFMA32(kf[ds], qf[ds], p[0]);
                const int dq = lq0 + qi - kh0 - 8 * hi;
#pragma unroll
                for (int rr = 0; rr < 16; ++rr) {
                    const int kvoff = 16 * (rr >> 3) + (rr & 7);
                    const int dd = dq - kvoff;
                    const bool ok = dd >= 0 && dd <= 128 && (kh0 + 8 * hi + kvoff) >= 0;
                    const float bb = tl[ok ? dd * r : 0];
                    p[0][rr] = ok ? p[0][rr] + bb : -INFINITY;
                }
                softmax_step<1>(p, st, refzero, o);
#pragma unroll
                for (int s = 0; s < 2; ++s) {
                    const bf16x8 pf = pack8(p[0], 8 * s);
#pragma unroll
                    for (int db = 0; db < 2; ++db) o[db] = MFMA32(vf[s][db], pf, o[db]);
                }
            }
        }
    }
    const float l = half_swap_sum(st.l);
    const size_t tok = (size_t)b * S + tq;
    store_ot((bf16_t*)(a.ws + WS_DPART) + ((size_t)br * T + tok) * 256 + 64 * h, o, 1.f / l, hi);
    if (hi == 0) ((float*)(a.ws + WS_DLSE))[((size_t)br * T + tok) * 4 + h] = st.mref + __builtin_amdgcn_logf(l);
    __syncthreads();
}
}
namespace hk {
struct S5P { float abr, abi, bbr[16], bbi[16]; };
__device__ __forceinline__ void s5_params(const Args& a, int layer, int g, int n, S5P& P, float& dtar, float& dtai) {
    const int lg = layer * 16 + g;
    const float dt = expf(a.in[17][lg]);
    const float ar = a.in[15][lg * 64 + n], ai = a.in[16][lg * 64 + n];
    dtar = dt * ar; dtai = dt * ai;
    const float mag = expf(dtar);
    P.abr = mag * cosf(dtai); P.abi = mag * sinf(dtai);
    const float den = ar * ar + ai * ai, nr = P.abr - 1.f, ni = P.abi;
    const float cr = (nr * ar + ni * ai) / den, ci = (ni * ar - nr * ai) / den;
    const float* brp = a.in[18] + ((size_t)lg * 64 + n) * 16; const float* bip = a.in[19] + ((size_t)lg * 64 + n) * 16;
#pragma unroll
    for (int c = 0; c < 16; ++c) { const float br = brp[c], bi = bip[c]; P.bbr[c] = cr * br - ci * bi; P.bbi[c] = cr * bi + ci * br; }
}
__device__ __forceinline__ void s5_step(const S5P& P, const LAS3 float* up, float& xr, float& xi) {
    const f32x4 u0 = *(const LAS3 f32x4*)(up), u1 = *(const LAS3 f32x4*)(up + 4), u2 = *(const LAS3 f32x4*)(up + 8), u3 = *(const LAS3 f32x4*)(up + 12);
    float r0 = P.bbr[0] * u0[0], r1 = P.bbr[4] * u1[0], r2 = P.bbr[8] * u2[0], r3 = P.bbr[12] * u3[0];
    float i0 = P.bbi[0] * u0[0], i1 = P.bbi[4] * u1[0], i2 = P.bbi[8] * u2[0], i3 = P.bbi[12] * u3[0];
    r0 += P.bbr[1] * u0[1]; r1 += P.bbr[5] * u1[1]; r2 += P.bbr[9] * u2[1]; r3 += P.bbr[13] * u3[1];
    i0 += P.bbi[1] * u0[1]; i1 += P.bbi[5] * u1[1]; i2 += P.bbi[9] * u2[1]; i3 += P.bbi[13] * u3[1];
    r0 += P.bbr[2] * u0[2]; r1 += P.bbr[6] * u1[2]; r2 += P.bbr[10] * u2[2]; r3 += P.bbr[14] * u3[2];
    i0 += P.bbi[2] * u0[2]; i1 += P.bbi[6] * u1[2]; i2 += P.bbi[10] * u2[2]; i3 += P.bbi[14] * u3[2];
    r0 += P.bbr[3] * u0[3]; r1 += P.bbr[7] * u1[3]; r2 += P.bbr[11] * u2[3]; r3 += P.bbr[15] * u3[3];
    i0 += P.bbi[3] * u0[3]; i1 += P.bbi[7] * u1[3]; i2 += P.bbi[11] * u2[3]; i3 += P.bbi[15] * u3[3];
    const float pr = (r0 + r1) + (r2 + r3), pi = (i0 + i1) + (i2 + i3);
    const float nxr = P.abr * xr - P.abi * xi + pr, nxi = P.abr * xi + P.abi * xr + pi;
    xr = nxr; xi = nxi;
}
__device__ __forceinline__ void s5_wave_operands(const Args& a, int layer, int w, int qi, int hi, bf16x8 (&bre)[2][2], bf16x8 (&bim)[2][2], f32x4 (&ab)[2]) {
#pragma unroll
    for (int gg = 0; gg < 2; ++gg) {
        const int lg = layer * 16 + 2 * w + gg;
#pragma unroll
        for (int sh = 0; sh < 2; ++sh) {
            const bf16_t* pb = (const bf16_t*)(a.ws + WS_S5B) + ((size_t)(lg * 2) * 64 + qi + 32 * sh) * 16 + 8 * hi;
            bre[gg][sh] = *(const bf16x8*)pb; bim[gg][sh] = *(const bf16x8*)(pb + 64 * 16);
        }
    }
#pragma unroll
    for (int sh = 0; sh < 2; ++sh) ab[sh] = ((const f32x4*)(a.ws + WS_S5A))[(layer * 16 + 2 * w + hi) * 64 + qi + 32 * sh];
}
#define S5_MFMA32(a, b, c) __builtin_amdgcn_mfma_f32_32x32x16_bf16(a, b, c, 0, 0, 0)
__device__ __forceinline__ void s5_state_params(const Args& a, int layer, int g, int st, float& abr, float& abi, float& cr, float& ci, float& dtar, float& dtai) {
    const int lg = layer * 16 + g;
    const float dt = expf(a.in[17][lg]);
    const float ar = a.in[15][lg * 64 + st], ai = a.in[16][lg * 64 + st];
    dtar = dt * ar; dtai = dt * ai;
    const float mag = expf(dtar);
    abr = mag * cosf(dtai); abi = mag * sinf(dtai);
    const float den = ar * ar + ai * ai, nr = abr - 1.f, ni = abi;
    cr = (nr * ar + ni * ai) / den; ci = (ni * ar - nr * ai) / den;
}
__device__ __forceinline__ void s5_wave_operands_v82(const Args& a, int layer, int w, int qi, int hi, bf16x8 (&bre)[2][2], bf16x8 (&bim)[2][2], float (&abr)[2], float (&abi)[2], float (&dtr)[2], float (&dti)[2]) {
#pragma unroll
    for (int gg = 0; gg < 2; ++gg) {
        const int g = 2 * w + gg, lg = layer * 16 + g;
#pragma unroll
        for (int sh = 0; sh < 2; ++sh) {
            const int st = qi + 32 * sh;
            float ar_, ai_, cr, ci, dtar, dtai; s5_state_params(a, layer, g, st, ar_, ai_, cr, ci, dtar, dtai);
            const float* brp = a.in[18] + ((size_t)lg * 64 + st) * 16 + 8 * hi; const float* bip = a.in[19] + ((size_t)lg * 64 + st) * 16 + 8 * hi;
            float vr[8], vi[8];
#pragma unroll
            for (int c = 0; c < 8; ++c) { const float br = brp[c], bi = bip[c]; vr[c] = cr * br - ci * bi; vi[c] = cr * bi + ci * br; }
            u32x4 pr, pi; pr.x = pk2(vr[0], vr[1]); pr.y = pk2(vr[2], vr[3]); pr.z = pk2(vr[4], vr[5]); pr.w = pk2(vr[6], vr[7]);
            pi.x = pk2(vi[0], vi[1]); pi.y = pk2(vi[2], vi[3]); pi.z = pk2(vi[4], vi[5]); pi.w = pk2(vi[6], vi[7]);
            bre[gg][sh] = __builtin_bit_cast(bf16x8, pr); bim[gg][sh] = __builtin_bit_cast(bf16x8, pi);
            if (gg == hi) { abr[sh] = ar_; abi[sh] = ai_; dtr[sh] = dtar; dti[sh] = dtai; }
        }
    }
}
__device__ __forceinline__ void s5_pass1_unit(const Args& a, unsigned char* lds, int layer, int b, int c) {
    int tid = threadIdx.x; asm volatile("" : "+v"(tid));
    const int lane = tid & 63, w = __builtin_amdgcn_readfirstlane(tid >> 6), qi = lane & 31, hi = lane >> 5;
    const bf16_t* su = (const bf16_t*)(a.ws + WS_SU) + ((size_t)b * S + c * S5_TC) * 256;
    float* sst = (float*)(a.ws + WS_SST);
    const int ag = (qi >> 2) & 1;
    const bf16_t* aup = su + (size_t)(4 * (qi >> 3) + (qi & 3)) * 256 + 32 * w + 16 * ag + 8 * hi;
    u32x4 an = *(const u32x4*)aup;
    bf16x8 bre[2][2], bim[2][2]; float abr[2], abi[2], dtr[2], dti[2];
    s5_wave_operands_v82(a, layer, w, qi, hi, bre, bim, abr, abi, dtr, dti);
    float xr[2] = {0.f, 0.f}, xi[2] = {0.f, 0.f};
#pragma unroll
    for (int blk = 0; blk < 4; ++blk) {
        const u32x4 zero4 = (u32x4){0u, 0u, 0u, 0u};
        const bf16x8 a1 = __builtin_bit_cast(bf16x8, ag ? zero4 : an), a2 = __builtin_bit_cast(bf16x8, ag ? an : zero4);
        if (blk < 3) an = *(const u32x4*)(aup + (size_t)(blk + 1) * 16 * 256);
        f32x16 dre[2], dim[2];
#pragma unroll
        for (int sh = 0; sh < 2; ++sh) {
            dre[sh] = S5_MFMA32(a1, bre[0][sh], (f32x16){}); dre[sh] = S5_MFMA32(a2, bre[1][sh], dre[sh]);
            dim[sh] = S5_MFMA32(a1, bim[0][sh], (f32x16){}); dim[sh] = S5_MFMA32(a2, bim[1][sh], dim[sh]);
        }
#pragma unroll
        for (int tt = 0; tt < 16; ++tt)
#pragma unroll
            for (int sh = 0; sh < 2; ++sh) {
                const float nxr = abr[sh] * xr[sh] - abi[sh] * xi[sh] + dre[sh][tt], nxi = abr[sh] * xi[sh] + abi[sh] * xr[sh] + dim[sh][tt];
                xr[sh] = nxr; xi[sh] = nxi;
            }
    }
    float* sp = sst + (((size_t)b * 16 + 2 * w + hi) * S5_NCH + c) * 128;
#pragma unroll
    for (int sh = 0; sh < 2; ++sh) { sp[qi + 32 * sh] = xr[sh]; sp[64 + qi + 32 * sh] = xi[sh]; }
}
constexpr int P3_XS = 0, P3_XS_W = 2 * 16 * 272, P3_GS = 8 * P3_XS_W, P3_GS_P = 528, P3_US = P3_GS + 64 * P3_GS_P, P3_END = P3_US + 8 * 2048;
__device__ __forceinline__ void s5_pass2_unit(const Args& a, unsigned char* lds, int layer, int b, int seg) {
    int tid = threadIdx.x; asm volatile("" : "+v"(tid));
    const int lane = tid & 63, w = __builtin_amdgcn_readfirstlane(tid >> 6);
    const int qi = lane & 31, hi = lane >> 5, l15 = lane & 15, kg = lane >> 4;
    const bf16_t* su = (const bf16_t*)(a.ws + WS_SU) + ((size_t)b * S + seg * 256) * 256;
    const float* sst = (const float*)(a.ws + WS_SST);
    bf16x8 bre[2][2], bim[2][2]; float abr[2], abi[2], xr[2], xi[2]; bf16x8 cm[2][4]; f32x4 dsk[2];
    {
        f32x4 ab[2];
        s5_wave_operands(a, layer, w, qi, hi, bre, bim, ab);
        float cr2[2] = {0.f, 0.f}, ci2[2] = {0.f, 0.f};
#pragma unroll
        for (int sh = 0; sh < 2; ++sh) { abr[sh] = ab[sh][0]; abi[sh] = ab[sh][1]; }
        const float* sp = sst + (((size_t)b * 16 + 2 * w + hi) * S5_NCH) * 128 + qi;
        const int nprev = 4 * seg;
        int j0 = 0;
        for (; j0 + 8 <= nprev; j0 += 8) {
            float sr[2][8], si[2][8];
#pragma unroll
            for (int u = 0; u < 8; ++u)
#pragma unroll
                for (int sh = 0; sh < 2; ++sh) { sr[sh][u] = sp[(size_t)(j0 + u) * 128 + 32 * sh]; si[sh][u] = sp[(size_t)(j0 + u) * 128 + 64 + 32 * sh]; }
#pragma unroll
            for (int u = 0; u < 8; ++u)
#pragma unroll
                for (int sh = 0; sh < 2; ++sh) { const float t0 = ab[sh][2] * cr2[sh] - ab[sh][3] * ci2[sh] + sr[sh][u], t1 = ab[sh][2] * ci2[sh] + ab[sh][3] * cr2[sh] + si[sh][u]; cr2[sh] = t0; ci2[sh] = t1; }
        }
        if (j0 < nprev) {
            float sr[2][4], si[2][4];
#pragma unroll
            for (int u = 0; u < 4; ++u)
#pragma unroll
                for (int sh = 0; sh < 2; ++sh) { sr[sh][u] = sp[(size_t)(j0 + u) * 128 + 32 * sh]; si[sh][u] = sp[(size_t)(j0 + u) * 128 + 64 + 32 * sh]; }
#pragma unroll
            for (int u = 0; u < 4; ++u)
#pragma unroll
                for (int sh = 0; sh < 2; ++sh) { const float t0 = ab[sh][2] * cr2[sh] - ab[sh][3] * ci2[sh] + sr[sh][u], t1 = ab[sh][2] * ci2[sh] + ab[sh][3] * cr2[sh] + si[sh][u]; cr2[sh] = t0; ci2[sh] = t1; }
        }
#pragma unroll
        for (int sh = 0; sh < 2; ++sh) { xr[sh] = cr2[sh]; xi[sh] = ci2[sh]; }
    }
#pragma unroll
    for (int gg = 0; gg < 2; ++gg) {
        const int g = 2 * w + gg, lg = layer * 16 + g;
        const float* crp = a.in[20] + ((size_t)lg * 16 + l15) * 64; const float* cip = a.in[21] + ((size_t)lg * 16 + l15) * 64;
#pragma unroll
        for (int ks = 0; ks < 4; ++ks) {
            const int k0 = 32 * ks + 8 * kg;
            float v[8];
#pragma unroll
            for (int j = 0; j < 8; ++j) v[j] = (k0 < 64) ? crp[k0 + j] : -cip[k0 - 64 + j];
            u32x4 pw; pw.x = pk2(v[0], v[1]); pw.y = pk2(v[2], v[3]); pw.z = pk2(v[4], v[5]); pw.w = pk2(v[6], v[7]);
            cm[gg][ks] = __builtin_bit_cast(bf16x8, pw);
        }
        dsk[gg] = *(const f32x4*)(a.in[22] + lg * 16 + 4 * kg);
    }
    unsigned char* xs = lds + P3_XS + w * P3_XS_W;
    const bf16_t* gluT = (const bf16_t*)(a.ws + WS_GLU) + (size_t)layer * 65536;
    const float* glub = a.in[24] + layer * 256;
    bf16_t* mix = (bf16_t*)(a.ws + WS_MIX) + ((size_t)b * S + seg * 256) * D + 768;
    LAS3 float* ul = (LAS3 float*)(LAS3 unsigned char*)(lds + P3_US + w * 2048);
    const int utq = lane >> 3, ucc = lane & 7;
    const bf16_t* sup = su + (size_t)utq * 256 + 32 * w + 4 * ucc;
    u32x2 un0 = *(const u32x2*)(sup), un1 = *(const u32x2*)(sup + (size_t)8 * 256);
    const int ag = (qi >> 2) & 1;
    const bf16_t* aup = su + (size_t)(4 * (qi >> 3) + (qi & 3)) * 256 + 32 * w + 16 * ag + 8 * hi;
    u32x4 an = *(const u32x4*)aup;
#define S5_UNPK(v) (f32x4){__uint_as_float((v).x << 16), __uint_as_float((v).x & 0xffff0000u), __uint_as_float((v).y << 16), __uint_as_float((v).y & 0xffff0000u)}
    for (int sub = 0; sub < 4; ++sub) {
        for (int blk = 0; blk < 4; ++blk) {
            const int t0 = sub * 64 + blk * 16;
            *(LAS3 f32x4*)(ul + utq * 32 + 4 * ucc) = S5_UNPK(un0); *(LAS3 f32x4*)(ul + (8 + utq) * 32 + 4 * ucc) = S5_UNPK(un1);
            if (t0 + 16 < 256) { un0 = *(const u32x2*)(sup + (size_t)(t0 + 16) * 256); un1 = *(const u32x2*)(sup + (size_t)(t0 + 24) * 256); }
            {
                const u32x4 zero4 = (u32x4){0u, 0u, 0u, 0u};
                const bf16x8 a1 = __builtin_bit_cast(bf16x8, ag ? zero4 : an), a2 = __builtin_bit_cast(bf16x8, ag ? an : zero4);
                if (t0 + 16 < 256) an = *(const u32x4*)(aup + (size_t)(t0 + 16) * 256);
                f32x16 dre[2], dim[2];
#pragma unroll
                for (int sh = 0; sh < 2; ++sh) {
                    dre[sh] = MFMA32(a1, bre[0][sh], (f32x16){}); dre[sh] = MFMA32(a2, bre[1][sh], dre[sh]);
                    dim[sh] = MFMA32(a1, bim[0][sh], (f32x16){}); dim[sh] = MFMA32(a2, bim[1][sh], dim[sh]);
                }
                bf16_t* xp0 = (bf16_t*)(xs + hi * (16 * 272));
#pragma unroll
                for (int tt = 0; tt < 16; ++tt) {
#pragma unroll
                    for (int sh = 0; sh < 2; ++sh) {
                        const float nxr = abr[sh] * xr[sh] - abi[sh] * xi[sh] + dre[sh][tt], nxi = abr[sh] * xi[sh] + abi[sh] * xr[sh] + dim[sh][tt];
                        xr[sh] = nxr; xi[sh] = nxi;
                        bf16_t* xp = xp0 + tt * 136;
                        xp[qi + 32 * sh] = f2bf(nxr); xp[64 + qi + 32 * sh] = f2bf(nxi);
                    }
                }
            }
#pragma unroll
            for (int gg = 0; gg < 2; ++gg) {
                const int g = 2 * w + gg;
                f32x4 acc = (f32x4){0.f, 0.f, 0.f, 0.f};
#pragma unroll
                for (int ks = 0; ks < 4; ++ks) { const bf16x8 bfr = *(const bf16x8*)(xs + gg * (16 * 272) + l15 * 272 + (32 * ks + 8 * kg) * 2); acc = __builtin_amdgcn_mfma_f32_16x16x32_bf16(cm[gg][ks], bfr, acc, 0, 0, 0); }
                const f32x4 uu = *(const LAS3 f32x4*)(ul + l15 * 32 + 16 * gg + 4 * kg);
                u32x2 gw; gw.x = pk2(gelu_tanh(acc[0] + dsk[gg][0] * uu[0]), gelu_tanh(acc[1] + dsk[gg][1] * uu[1])); gw.y = pk2(gelu_tanh(acc[2] + dsk[gg][2] * uu[2]), gelu_tanh(acc[3] + dsk[gg][3] * uu[3]));
                *(u32x2*)(lds + P3_GS + (blk * 16 + l15) * P3_GS_P + (g * 16 + 4 * kg) * 2) = gw;
            }
        }
        __syncthreads();
#pragma unroll
        for (int tb = 0; tb < 2; ++tb) {
            f32x16 acc = (f32x16){};
#pragma unroll
            for (int ks = 0; ks < 16; ++ks) {
                const bf16x8 af = *(const bf16x8*)(gluT + (size_t)(32 * w + qi) * 256 + 16 * ks + 8 * hi);
                const bf16x8 bfr = *(const bf16x8*)(lds + P3_GS + (32 * tb + qi) * P3_GS_P + (16 * ks + 8 * hi) * 2);
                acc = MFMA32(af, bfr, acc);
            }
#pragma unroll
            for (int r4 = 0; r4 < 4; ++r4) {
                const int nn = 32 * w + 8 * r4 + 4 * hi;
                const u32x2 gq = *(const u32x2*)(lds + P3_GS + (32 * tb + qi) * P3_GS_P + nn * 2);
                const f32x4 bb = *(const f32x4*)(glub + nn);
                float ov[4];
#pragma unroll
                for (int e = 0; e < 4; ++e) {
                    const float gval = __uint_as_float(((e & 1) ? (((e >> 1) ? gq.y : gq.x) & 0xffff0000u) : (((e >> 1) ? gq.y : gq.x) << 16)));
                    ov[e] = gval / (1.f + __expf(-(acc[4 * r4 + e] + bb[e])));
                }
                u32x2 ow; ow.x = pk2(ov[0], ov[1]); ow.y = pk2(ov[2], ov[3]);
                *(u32x2*)(mix + (size_t)(sub * 64 + 32 * tb + qi) * D + nn) = ow;
            }
        }
        __syncthreads();
    }
}
__device__ __forceinline__ void phase_p3_elementwise(const Args& a, int layer) {
    const size_t gt = (size_t)blockIdx.x * NTHR + threadIdx.x, gn = (size_t)gridDim.x * NTHR;
    const bf16_t* dp = (const bf16_t*)(a.ws + WS_DPART); const float* dl = (const float*)(a.ws + WS_DLSE); bf16_t* mix = (bf16_t*)(a.ws + WS_MIX);
    for (size_t i = gt; i < (size_t)T * 32; i += gn) {
        const size_t tok = i >> 5; const int ch = (int)(i & 31), h = ch >> 3;
        const float l0 = dl[tok * 4 + h], l1 = dl[((size_t)T + tok) * 4 + h], l2 = dl[((size_t)2 * T + tok) * 4 + h];
        const float mx = fmaxf(l0, fmaxf(l1, l2));
        float w0 = __builtin_amdgcn_exp2f(l0 - mx), w1 = __builtin_amdgcn_exp2f(l1 - mx), w2 = __builtin_amdgcn_exp2f(l2 - mx);
        const float inv = 1.f / (w0 + w1 + w2); w0 *= inv; w1 *= inv; w2 *= inv;
        const u32x4 a0 = *(const u32x4*)(dp + tok * 256 + ch * 8), a1 = *(const u32x4*)(dp + ((size_t)T + tok) * 256 + ch * 8), a2 = *(const u32x4*)(dp + ((size_t)2 * T + tok) * 256 + ch * 8);
        u32x4 o;
#pragma unroll
        for (int j = 0; j < 4; ++j) {
            const float lo = w0 * __uint_as_float(a0[j] << 16) + w1 * __uint_as_float(a1[j] << 16) + w2 * __uint_as_float(a2[j] << 16);
            const float hi = w0 * __uint_as_float(a0[j] & 0xffff0000u) + w1 * __uint_as_float(a1[j] & 0xffff0000u) + w2 * __uint_as_float(a2[j] & 0xffff0000u);
            o[j] = pk2(lo, hi);
        }
        *(u32x4*)(mix + tok * D + 256 + ch * 8) = o;
    }
    {
        const int lane = threadIdx.x & 63, wv = blockIdx.x * 8 + (threadIdx.x >> 6), nw = gridDim.x * 8;
        const float* pu = a.in[27] + (size_t)layer * NEXP * D; const float* pv = a.in[28] + (size_t)layer * NEXP * D; const float* gn_ = a.in[5] + layer * D;
        unsigned char* ut = a.ws + WS_UT; unsigned char* vt = a.ws + WS_VT; float* scl = (float*)(a.ws + WS_US);
        float g[16]; load_row16(gn_, lane, g);
        for (int r = wv; r < 2 * NEXP; r += nw) {
            const bool isv = r >= NEXP; const int e = isv ? r - NEXP : r;
            float v[16]; load_row16((isv ? pv : pu) + (size_t)e * D, lane, v);
            float sq = 0.f;
#pragma unroll
            for (int i = 0; i < 16; ++i) { if (!isv) v[i] *= g[i]; sq += v[i] * v[i]; }
            sq = wave_sum(sq);
            const float sc = sq > 0.f ? 0.35f * sqrtf(sq * (1.f / 1024.f)) : 1.f, inv = 1.f / sc;
            u32x2 w;
#pragma unroll
            for (int j = 0; j < 2; ++j) {
                unsigned pk = 0u;
#pragma unroll
                for (int i = 0; i < 8; ++i) { int q = (int)rintf(v[8 * j + i] * inv); q = q > 7 ? 7 : (q < -7 ? -7 : q);
                    pk |= ((unsigned)(isv && (i < 4 || !HK_PEER_SPLIT) ? q + 8 : q) & 0xfu) << (i < 4 ? 8 * i : 8 * (i - 4) + 4); }
                w[j] = pk;
            }
            *(u32x2*)((isv ? vt : ut) + (size_t)e * 512 + 8 * lane) = w;
            if (lane == 0) scl[2 * e + (isv ? 1 : 0)] = isv || HK_PEER_SPLIT ? sc : sc * (1.f / 16.f);
        }
    }
}

__device__ __forceinline__ unsigned srt(float f) { const unsigned u = __float_as_uint(f); return u ^ ((unsigned)((int)u >> 31) | 0x80000000u); }
__device__ __forceinline__ float unsrt(unsigned u) { return __uint_as_float(u ^ ((~(unsigned)((int)u >> 31)) | 0x80000000u)); }
#define CEX(a, b) do { const unsigned x_ = (a), y_ = (b); (a) = x_ > y_ ? x_ : y_; (b) = x_ > y_ ? y_ : x_; } while (0)
__device__ __forceinline__ void bitonic_merge16(unsigned (&v)[16]) {
#pragma unroll
    for (int d = 8; d >= 1; d >>= 1)
#pragma unroll
        for (int i = 0; i < 16; ++i) if ((i & d) == 0) CEX(v[i], v[i + d]);
}
__device__ __forceinline__ void sort16_desc(unsigned (&v)[16]) {
    CEX(v[0], v[13]); CEX(v[1], v[12]); CEX(v[2], v[15]); CEX(v[3], v[14]); CEX(v[4], v[8]); CEX(v[5], v[6]); CEX(v[7], v[11]); CEX(v[9], v[10]);
    CEX(v[0], v[5]); CEX(v[1], v[7]); CEX(v[2], v[9]); CEX(v[3], v[4]); CEX(v[6], v[13]); CEX(v[8], v[14]); CEX(v[10], v[15]); CEX(v[11], v[12]);
    CEX(v[0], v[1]); CEX(v[2], v[3]); CEX(v[4], v[5]); CEX(v[6], v[8]); CEX(v[7], v[9]); CEX(v[10], v[11]); CEX(v[12], v[13]); CEX(v[14], v[15]);
    CEX(v[0], v[2]); CEX(v[1], v[3]); CEX(v[4], v[10]); CEX(v[5], v[11]); CEX(v[6], v[7]); CEX(v[8], v[9]); CEX(v[12], v[14]); CEX(v[13], v[15]);
    CEX(v[1], v[2]); CEX(v[3], v[12]); CEX(v[4], v[6]); CEX(v[5], v[7]); CEX(v[8], v[10]); CEX(v[9], v[11]); CEX(v[13], v[14]);
    CEX(v[1], v[4]); CEX(v[2], v[6]); CEX(v[5], v[8]); CEX(v[7], v[10]); CEX(v[9], v[13]); CEX(v[11], v[14]);
    CEX(v[2], v[4]); CEX(v[3], v[6]); CEX(v[9], v[12]); CEX(v[11], v[13]);
    CEX(v[3], v[5]); CEX(v[6], v[8]); CEX(v[7], v[9]); CEX(v[10], v[12]);
    CEX(v[3], v[4]); CEX(v[5], v[6]); CEX(v[7], v[8]); CEX(v[9], v[10]); CEX(v[11], v[12]);
    CEX(v[6], v[7]); CEX(v[8], v[9]);
}
__device__ __forceinline__ void merge_top16(unsigned (&a)[16], const unsigned (&b)[16]) {
#pragma unroll
    for (int j = 0; j < 16; ++j) a[j] = a[j] > b[15 - j] ? a[j] : b[15 - j];
    bitonic_merge16(a);
}
__device__ __forceinline__ void ins16(unsigned (&top)[16], unsigned pk) {
#pragma unroll
    for (int j = 0; j < 16; ++j) { const unsigned hi_ = top[j] > pk ? top[j] : pk; pk = top[j] > pk ? pk : top[j]; top[j] = hi_; }
}
__device__ __forceinline__ void merge_halves(unsigned (&top)[16]) {
    unsigned lo[16], hi[16];
#pragma unroll
    for (int j = 0; j < 16; ++j) { auto rr = __builtin_amdgcn_permlane32_swap(top[j], top[j], false, false); lo[j] = rr[0]; hi[j] = rr[1]; }
#pragma unroll
    for (int j = 0; j < 16; ++j) top[j] = lo[j] > hi[15 - j] ? lo[j] : hi[15 - j];
#pragma unroll
    for (int d = 8; d >= 1; d >>= 1)
#pragma unroll
        for (int i = 0; i < 16; ++i) if ((i & d) == 0) { const unsigned x = top[i], y = top[i + d]; top[i] = x > y ? x : y; top[i + d] = x > y ? y : x; }
}
constexpr int P6_PL = 0, P6_RS = 32768, P6_DOT = 32768 + 128, P6_LST = P6_DOT + 8 * 1024, P6_END = P6_LST + 8 * 8192;
__device__ __forceinline__ float dot8(const u32x4& a, const unsigned (&xh)[4], float acc) {
#pragma unroll
    for (int j = 0; j < 4; ++j) { acc += __uint_as_float(a[j] << 16) * __uint_as_float(xh[j] << 16); acc += __uint_as_float(a[j] & 0xffff0000u) * __uint_as_float(xh[j] & 0xffff0000u); }
    return acc;
}
__device__ __forceinline__ void peer_unit(const Args& a, unsigned char* lds, int layer, int unit) {
    int tid = threadIdx.x; asm volatile("" : "+v"(tid));
    const int lane = tid & 63, w = __builtin_amdgcn_readfirstlane(tid >> 6), qi = lane & 31, hi = lane >> 5;
    const int tok0 = unit * 32;
#if defined(HK_PROBE_PHASE) && HK_PROBE_PHASE == 10
    unsigned long long pq0_ = 0; if (blockIdx.x == 0 && threadIdx.x == 0) pq0_ = __builtin_amdgcn_s_memrealtime();
#endif
    const bf16_t* xg = (const bf16_t*)(a.ws + WS_XB);
    float* rsl = (float*)(lds + P6_RS);
    {
        u32x4 xr[4][2];
#pragma unroll
        for (int tt = 0; tt < 4; ++tt) { const bf16_t* p = xg + (size_t)(tok0 + 4 * w + tt) * D + 16 * lane; xr[tt][0] = *(const u32x4*)p; xr[tt][1] = *(const u32x4*)(p + 8); }
#pragma unroll
        for (int tt = 0; tt < 4; ++tt) {
            float ss = 0.f;
#pragma unroll
            for (int j = 0; j < 2; ++j)
#pragma unroll
                for (int e = 0; e < 4; ++e) { const float lo = __uint_as_float(xr[tt][j][e] << 16), hi_ = __uint_as_float(xr[tt][j][e] & 0xffff0000u); ss += lo * lo + hi_ * hi_; }
            ss = wave_sum(ss);
            if (lane == 0) rsl[4 * w + tt] = __builtin_amdgcn_rsqf(ss * (1.f / 1024.f) + EPS);
        }
    }
    __syncthreads();
    {
        const float rs2 = rsl[qi];
        const bf16_t* qrow = (const bf16_t*)(a.ws + WS_ZB) + (size_t)(tok0 + qi) * 2048 + 256 * w;
        const bf16_t* kb_ = (const bf16_t*)(a.ws + WS_KEYS) + (size_t)(layer * 16 + 2 * w) * 128 * 128;
        unsigned* lsw = (unsigned*)(lds + P6_LST) + w * 2048 + lane;
#if HK_FOLD_KEYS
        const bf16_t* srow = (const bf16_t*)(a.ws + WS_ZB) + (size_t)(tok0 + qi) * 2048 + 256 * w + 64 * hi;
        u32x4 sv[2][8];
#pragma unroll
        for (int p = 0; p < 2; ++p)
#pragma unroll
            for (int j = 0; j < 8; ++j) sv[p][j] = *(const u32x4*)(srow + 128 * p + 8 * j);
#pragma unroll
        for (int p = 0; p < 2; ++p) {
            unsigned top[16];
#pragma unroll
            for (int kb = 0; kb < 4; ++kb) {
                unsigned cur[16];
#pragma unroll
                for (int j = 0; j < 2; ++j)
#pragma unroll
                    for (int e = 0; e < 4; ++e) {
                        const unsigned wd = sv[p][2 * kb + j][e];
                        const unsigned lo = wd & 0xffffu, hi16 = wd >> 16;
                        const unsigned slo = lo ^ ((lo & 0x8000u) ? 0xffffu : 0x8000u), shi = hi16 ^ ((hi16 & 0x8000u) ? 0xffffu : 0x8000u);
                        const unsigned idx = (unsigned)(64 * hi + 16 * kb + 8 * j + 2 * e);
                        cur[8 * j + 2 * e] = (slo << 16) | idx; cur[8 * j + 2 * e + 1] = (shi << 16) | (idx + 1u);
                    }
                sort16_desc(cur);
                if (kb == 0) {
#pragma unroll
                    for (int j = 0; j < 16; ++j) top[j] = cur[j];
                } else merge_top16(top, cur);
            }
            merge_halves(top);
#pragma unroll
            for (int j = 0; j < 16; ++j) { const unsigned s16 = top[j] >> 16; const unsigned hb = s16 ^ ((s16 & 0x8000u) ? 0x8000u : 0xffffu);
                const _Float16 hv = __builtin_bit_cast(_Float16, (unsigned short)hb);
                lsw[(p * 16 + j) * 64] = (srt((float)hv) & ~127u) | (top[j] & 127u); }
        }
#else
        bf16x8 qf2[2][8];
#pragma unroll
        for (int p = 0; p < 2; ++p)
#pragma unroll
            for (int ks = 0; ks < 8; ++ks) qf2[p][ks] = *(const bf16x8*)(qrow + 128 * p + 16 * ks + 8 * hi);
#pragma unroll
        for (int p = 0; p < 2; ++p) {
            const bf16x8 (&qf)[8] = qf2[p];
            unsigned top[16];
            bf16x8 kfn[8];
#pragma unroll
            for (int ks = 0; ks < 8; ++ks) kfn[ks] = *(const bf16x8*)(kb_ + ((size_t)p * 128 + qi) * 128 + 16 * ks + 8 * hi);
#pragma unroll 1
            for (int kb = 0; kb < 4; ++kb) {
                f32x16 acc = (f32x16){};
#pragma unroll
                for (int ks = 0; ks < 8; ++ks) acc = MFMA32(kfn[ks], qf[ks], acc);
                if (kb < 3) {
#pragma unroll
                    for (int ks = 0; ks < 8; ++ks) kfn[ks] = *(const bf16x8*)(kb_ + ((size_t)p * 128 + 32 * (kb + 1) + qi) * 128 + 16 * ks + 8 * hi);
                }
                unsigned cur[16];
#pragma unroll
                for (int r = 0; r < 16; ++r) cur[r] = (srt(acc[r]) & ~127u) | (unsigned)(32 * kb + (r & 3) + 8 * (r >> 2) + 4 * hi);
                sort16_desc(cur);
                if (kb == 0) {
#pragma unroll
                    for (int j = 0; j < 16; ++j) top[j] = cur[j];
                } else merge_top16(top, cur);
            }
            merge_halves(top);
#pragma unroll
            for (int j = 0; j < 16; ++j) lsw[(p * 16 + j) * 64] = top[j];
        }
#endif
        unsigned best[16];
#pragma unroll
        for (int j = 0; j < 16; ++j) best[j] = 0u;
#pragma unroll 1
        for (int i = hi; i < 16; i += 2) {
            const unsigned ai = lsw[i * 64]; const float vai = unsrt(ai & ~127u); const unsigned iai = (ai & 127u) << 7;
            const int nj = 16 / (i + 1);
#pragma unroll 1
            for (int j = 0; j < nj; ++j) { const unsigned bj = lsw[(16 + j) * 64]; ins16(best, (srt(vai + unsrt(bj & ~127u)) & ~0x3FFFu) | iai | (bj & 127u)); }
        }
        merge_halves(best);
        float e[16], sum = 0.f;
        const float s0 = unsrt(best[0] & ~0x3FFFu);
#pragma unroll
        for (int j = 0; j < 16; ++j) { e[j] = __builtin_amdgcn_exp2f((unsrt(best[j] & ~0x3FFFu) - s0) * rs2 * LOG2E); sum += e[j]; }
        const float inv = 1.f / sum;
        if (hi == 0) {
            u32x2* pl = (u32x2*)(lds + P6_PL) + qi * 128 + 16 * w;
#pragma unroll
            for (int j = 0; j < 16; ++j) { u32x2 en; en.x = best[j] & 0x3FFFu; en.y = __float_as_uint(e[j] * inv); pl[j] = en; }
        }
    }
    __syncthreads();
#if defined(HK_PROBE_PHASE) && HK_PROBE_PHASE == 10
    if (blockIdx.x == 0 && threadIdx.x == 0) { volatile LAS3 unsigned* pw_ = (volatile LAS3 unsigned*)(LAS3 unsigned char*)(lds + LDS_CTL + 48); *pw_ = *pw_ + (unsigned)(__builtin_amdgcn_s_memrealtime() - pq0_); }
#endif
    const unsigned char* ut = a.ws + WS_UT; const unsigned char* vt = a.ws + WS_VT; const float* scl = (const float*)(a.ws + WS_US);
    float* dots = (float*)(lds + P6_DOT) + w * 256; float* cfs = dots + 128;
    int vz_; asm volatile("v_mov_b32 %0, 0" : "=v"(vz_));
    const int lane_g = lane + vz_, hi_g = lane_g >> 5;
    const int c32 = lane_g & 31, slot = 2 * c32 + hi_g;
#define PG_ISSUE(buf, tab, plp, b) do { _Pragma("unroll") for (int kk = 0; kk < 8; ++kk) { const unsigned id_ = (plp)[16 * (b) + 8 * hi_g + kk].x; buf[kk] = *(const u32x4*)((tab) + (unsigned)(id_ * 512u + 16u * (unsigned)c32)); } } while (0)
#define PG_CU(buf, b) do { int pd_[8]; \
        _Pragma("unroll") for (int kk = 0; kk < 8; ++kk) { int d_ = 0; \
            _Pragma("unroll") for (int j = 0; j < 4; ++j) { d_ = __builtin_amdgcn_sdot4((int)((buf[kk][j] << 4) & 0xF0F0F0F0u), xq[2 * j], d_, false); d_ = __builtin_amdgcn_sdot4((int)(buf[kk][j] & 0xF0F0F0F0u), xq[2 * j + 1], d_, false); } \
            pd_[kk] = d_; } \
        int r4_[4]; \
        _Pragma("unroll") for (int j = 0; j < 4; ++j) { auto rr_ = __builtin_amdgcn_permlane16_swap((unsigned)pd_[j], (unsigned)pd_[j + 4], false, false); r4_[j] = (int)rr_[0] + (int)rr_[1]; } \
        _Pragma("unroll") for (int j = 0; j < 4; ++j) { int v_ = r4_[j]; \
            v_ += __builtin_amdgcn_update_dpp(0, v_, 0xB1, 0xf, 0xf, true); v_ += __builtin_amdgcn_update_dpp(0, v_, 0x4E, 0xf, 0xf, true); \
            v_ += __builtin_amdgcn_update_dpp(0, v_, 0x141, 0xf, 0xf, true); v_ += __builtin_amdgcn_update_dpp(0, v_, 0x140, 0xf, 0xf, true); r4_[j] = v_; } \
        if ((lane_g & 15) == 0) { const int q_ = lane_g >> 4; *(f32x4*)(dots + 16 * (b) + 8 * (q_ >> 1) + 4 * (q_ & 1)) = (f32x4){(float)r4_[0], (float)r4_[1], (float)r4_[2], (float)r4_[3]}; } } while (0)
#define PG_T4(r0, r1, r2, r3, t0, t1, t2, t3) do { const unsigned a01l_ = __builtin_amdgcn_perm(r1, r0, 0x05010400u), a01h_ = __builtin_amdgcn_perm(r1, r0, 0x07030602u), \
            a23l_ = __builtin_amdgcn_perm(r3, r2, 0x05010400u), a23h_ = __builtin_amdgcn_perm(r3, r2, 0x07030602u); \
        t0 = __builtin_amdgcn_perm(a23l_, a01l_, 0x05040100u); t1 = __builtin_amdgcn_perm(a23l_, a01l_, 0x07060302u); \
        t2 = __builtin_amdgcn_perm(a23h_, a01h_, 0x05040100u); t3 = __builtin_amdgcn_perm(a23h_, a01h_, 0x07060302u); } while (0)
#define PG_CV(buf, b) do { _Pragma("unroll") for (int g4 = 0; g4 < 2; ++g4) { const int cq_ = (int)cqw[4 * (b) + 2 * hi_g + g4]; \
            _Pragma("unroll") for (int j = 0; j < 4; ++j) { \
                const unsigned w0_ = buf[4 * g4][j], w1_ = buf[4 * g4 + 1][j], w2_ = buf[4 * g4 + 2][j], w3_ = buf[4 * g4 + 3][j]; \
                unsigned t0_, t1_, t2_, t3_; \
                PG_T4(w0_ & 0x0F0F0F0Fu, w1_ & 0x0F0F0F0Fu, w2_ & 0x0F0F0F0Fu, w3_ & 0x0F0F0F0Fu, t0_, t1_, t2_, t3_); \
                oa[8 * j + 0] = __builtin_amdgcn_sdot4((int)t0_, cq_, oa[8 * j + 0], false); oa[8 * j + 1] = __builtin_amdgcn_sdot4((int)t1_, cq_, oa[8 * j + 1], false); \
                oa[8 * j + 2] = __builtin_amdgcn_sdot4((int)t2_, cq_, oa[8 * j + 2], false); oa[8 * j + 3] = __builtin_amdgcn_sdot4((int)t3_, cq_, oa[8 * j + 3], false); \
                PG_T4((w0_ >> 4) & 0x0F0F0F0Fu, (w1_ >> 4) & 0x0F0F0F0Fu, (w2_ >> 4) & 0x0F0F0F0Fu, (w3_ >> 4) & 0x0F0F0F0Fu, t0_, t1_, t2_, t3_); \
                oa[8 * j + 4] = __builtin_amdgcn_sdot4((int)t0_, cq_, oa[8 * j + 4], false); oa[8 * j + 5] = __builtin_amdgcn_sdot4((int)t1_, cq_, oa[8 * j + 5], false); \
                oa[8 * j + 6] = __builtin_amdgcn_sdot4((int)t2_, cq_, oa[8 * j + 6], false); oa[8 * j + 7] = __builtin_amdgcn_sdot4((int)t3_, cq_, oa[8 * j + 7], false); \
                asm volatile("" : "+v"(oa[8 * j]), "+v"(oa[8 * j + 1]), "+v"(oa[8 * j + 2]), "+v"(oa[8 * j + 3]), "+v"(oa[8 * j + 4]), "+v"(oa[8 * j + 5]), "+v"(oa[8 * j + 6]), "+v"(oa[8 * j + 7])); } } } while (0)
#define PG_SB __builtin_amdgcn_sched_barrier(0)
    u32x4 bA[8], bB[8];
    { const u32x2* pl0 = (const u32x2*)(lds + P6_PL) + (4 * w) * 128; PG_ISSUE(bA, ut, pl0, 0); }
    for (int tt = 0; tt < 4; ++tt) {
        const int tl = 4 * w + tt, tok = tok0 + tl;
        const float rs2 = rsl[tl];
        const u32x2* pl = (const u32x2*)(lds + P6_PL) + tl * 128;
        const u32x2 en0 = pl[lane_g], en1 = pl[64 + lane_g];
        const float2 sc0_ = *(const float2*)(scl + 2 * (size_t)en0.x), sc1_ = *(const float2*)(scl + 2 * (size_t)en1.x);
        const float us0 = sc0_.x, us1 = sc1_.x, vs0 = sc0_.y, vs1 = sc1_.y;
        float xv[16]; load_row16_bf(xg + (size_t)tok * D, slot, xv);
        float mx = 0.f;
#pragma unroll
        for (int i = 0; i < 16; ++i) mx = fmaxf(mx, fabsf(xv[i]));
#pragma unroll
        for (int o = 32; o > 0; o >>= 1) mx = fmaxf(mx, __shfl_xor(mx, o));
        const float sx = mx > 0.f ? mx * (1.f / 127.f) : 1.f, isx = 1.f / sx;
        int xq[8];
#pragma unroll
        for (int j = 0; j < 4; ++j) {
            unsigned pk = 0u;
#pragma unroll
            for (int i = 0; i < 4; ++i) { const int q = (int)rintf(xv[4 * j + i] * isx); pk |= ((unsigned)q & 0xffu) << (8 * i); }
            auto rr = __builtin_amdgcn_permlane32_swap(pk, pk, false, false);
            xq[j] = (int)rr[0]; xq[4 + j] = (int)rr[1];
        }
#pragma unroll
        for (int ub = 0; ub < 8; ub += 2) {
            PG_ISSUE(bB, ut, pl, ub + 1); PG_SB; PG_CU(bA, ub); PG_SB;
            if (ub + 2 < 8) PG_ISSUE(bA, ut, pl, ub + 2); else PG_ISSUE(bA, vt, pl, 0);
            PG_SB; PG_CU(bB, ub + 1); PG_SB;
        }
        const float a0 = gelu_tanh(dots[lane_g] * (sx * rs2) * us0) * __uint_as_float(en0.y);
        const float a1 = gelu_tanh(dots[64 + lane_g] * (sx * rs2) * us1) * __uint_as_float(en1.y);
        const float c0 = a0 * vs0, c1 = a1 * vs1;
        float cm = fmaxf(fabsf(c0), fabsf(c1));
#pragma unroll
        for (int o = 32; o > 0; o >>= 1) cm = fmaxf(cm, __shfl_xor(cm, o));
        const float scc = cm > 0.f ? cm * (1.f / 127.f) : 1.f, iscc = 1.f / scc;
        const int q0c = (int)rintf(c0 * iscc), q1c = (int)rintf(c1 * iscc);
        volatile LAS3 signed char* cqb = (volatile LAS3 signed char*)(LAS3 unsigned char*)cfs;
        cqb[lane_g] = (signed char)q0c; cqb[64 + lane_g] = (signed char)q1c;
        const LAS3 unsigned* cqw = (const LAS3 unsigned*)(LAS3 unsigned char*)cfs;
        int qsum = q0c + q1c;
#pragma unroll
        for (int o = 32; o > 0; o >>= 1) qsum += __shfl_xor(qsum, o);
        int oa[32];
#pragma unroll
        for (int i = 0; i < 32; ++i) oa[i] = 0;
        int vzv_; asm volatile("v_mov_b32 %0, 0" : "=v"(vzv_));
        const u32x2* plv = pl + vzv_;
#pragma unroll
        for (int vb = 0; vb < 8; vb += 2) {
            PG_ISSUE(bB, vt, plv, vb + 1); PG_SB; PG_CV(bA, vb); PG_SB;
            if (vb + 2 < 8) PG_ISSUE(bA, vt, plv, vb + 2); else if (tt < 3) PG_ISSUE(bA, ut, plv + 128, 0);
            PG_SB; PG_CV(bB, vb + 1); PG_SB;
        }
#pragma unroll
        for (int i = 0; i < 16; ++i) {
            auto rr = __builtin_amdgcn_permlane32_swap((unsigned)oa[i], (unsigned)oa[16 + i], false, false);
#ifndef HK_PROBE_NOPEER
            xv[i] += scc * (float)((int)rr[0] + (int)rr[1] - 8 * qsum);
#else
            xv[i] += 1e-30f * (float)((int)rr[0] + (int)rr[1]);
#endif
        }
#ifdef HK_PROBE_L2
        {
            int dsum = 0;
            for (int k = 0; k < 128; k += 32) {
                u32x4 ldx[16];
#pragma unroll
                for (int kk = 0; kk < 16; ++kk) { unsigned id = pl[k + 16 * hi_g + kk].x; if (HK_PROBE_L2 == 2) id &= 0x0FFFu; ldx[kk] = *(const u32x4*)(ut + (size_t)id * 512 + 16 * c32); }
#pragma unroll
                for (int kk = 0; kk < 16; ++kk) { dsum = __builtin_amdgcn_sdot4((int)ldx[kk].x, xq[0], dsum, false); dsum = __builtin_amdgcn_sdot4((int)ldx[kk].w, xq[1], dsum, false); }
            }
            xv[0] += 1e-30f * (float)dsum;
        }
#endif
        const bool more = layer + 1 < DEPTH;
        int vzt_; asm volatile("v_mov_b32 %0, 0" : "=v"(vzt_) : "v"(xv[0]));
        finish_token(tok, xv, more ? nullptr : a.out, (bf16_t*)(a.ws + WS_XB), (float*)(a.ws + WS_RSTD), more ? (const float*)(a.ws + WS_WF) + (size_t)(layer + 1) * 4096 : nullptr,
                     a.in[2] + (more ? (layer + 1) * 4 : 0), (float*)(a.ws + WS_FLOG), lane, slot + vzt_);
    }
#undef PG_ISSUE
#undef PG_SB
#undef PG_CU
#undef PG_CV
#undef PG_T4
    __syncthreads();
}
#if HK_FOLD_KEYS
__device__ __forceinline__ void peer_unit_a(const Args& a, unsigned char* lds, int layer, int unit) {
    int tid = threadIdx.x; asm volatile("" : "+v"(tid));
    const int lane = tid & 63, w = __builtin_amdgcn_readfirstlane(tid >> 6), qi = lane & 31, hi = lane >> 5;
    const int tok0 = unit * 32;
#if defined(HK_PROBE_PHASE) && HK_PROBE_PHASE == 10
    unsigned long long pq0_ = 0; if (blockIdx.x == 0 && threadIdx.x == 0) pq0_ = __builtin_amdgcn_s_memrealtime();
#endif
    const bf16_t* xg = (const bf16_t*)(a.ws + WS_XB);
    float* rsl = (float*)(lds + P6_RS);
    {
        u32x4 xr[4][2];
#pragma unroll
        for (int tt = 0; tt < 4; ++tt) { const bf16_t* p = xg + (size_t)(tok0 + 4 * w + tt) * D + 16 * lane; xr[tt][0] = *(const u32x4*)p; xr[tt][1] = *(const u32x4*)(p + 8); }
#pragma unroll
        for (int tt = 0; tt < 4; ++tt) {
            float ss = 0.f;
#pragma unroll
            for (int j = 0; j < 2; ++j)
#pragma unroll
                for (int e = 0; e < 4; ++e) { const float lo = __uint_as_float(xr[tt][j][e] << 16), hi_ = __uint_as_float(xr[tt][j][e] & 0xffff0000u); ss += lo * lo + hi_ * hi_; }
            ss = wave_sum(ss);
            if (lane == 0) rsl[4 * w + tt] = __builtin_amdgcn_rsqf(ss * (1.f / 1024.f) + EPS);
        }
    }
    const int tl_r = 4 * w + (qi >> 3), hd = qi & 7;
    {
        const float rs2 = rsl[tl_r];
        unsigned* lsw = (unsigned*)(lds + P6_LST) + w * 2048 + lane;
#if HK_FOLD_KEYS
        const bf16_t* srow = (const bf16_t*)(a.ws + WS_ZB) + (size_t)(tok0 + tl_r) * 2048 + 256 * hd + 64 * hi;
        u32x4 sv[2][8];
#pragma unroll
        for (int p = 0; p < 2; ++p)
#pragma unroll
            for (int j = 0; j < 8; ++j) sv[p][j] = *(const u32x4*)(srow + 128 * p + 8 * j);
#pragma unroll
        for (int p = 0; p < 2; ++p) {
            unsigned top[16];
#pragma unroll
            for (int kb = 0; kb < 4; ++kb) {
                unsigned cur[16];
#pragma unroll
                for (int j = 0; j < 2; ++j)
#pragma unroll
                    for (int e = 0; e < 4; ++e) {
                        const unsigned wd = sv[p][2 * kb + j][e];
                        typedef short s16x2_ __attribute__((ext_vector_type(2)));
                        const s16x2_ sg = __builtin_bit_cast(s16x2_, wd) >> 15;
                        const unsigned k2 = wd ^ ((__builtin_bit_cast(unsigned, sg) & 0x7fff7fffu) | 0x80008000u);
                        const unsigned idx = (unsigned)(64 * hi + 16 * kb + 8 * j + 2 * e);
                        cur[8 * j + 2 * e] = (k2 << 16) | idx; cur[8 * j + 2 * e + 1] = (k2 & 0xffff0000u) | (idx + 1u);
                    }
                sort16_desc(cur);
                if (kb == 0) {
#pragma unroll
                    for (int j = 0; j < 16; ++j) top[j] = cur[j];
                } else merge_top16(top, cur);
            }
            merge_halves(top);
#pragma unroll
            for (int j = 0; j < 16; ++j) { const unsigned s16 = top[j] >> 16; const unsigned hb = s16 ^ ((s16 & 0x8000u) ? 0x8000u : 0xffffu);
                const _Float16 hv = __builtin_bit_cast(_Float16, (unsigned short)hb);
                lsw[(p * 16 + j) * 64] = (srt((float)hv) & ~127u) | (top[j] & 127u); }
        }
#endif
        unsigned best[16];
        {
            const int offA = hi ? 16 * 64 : 0, offB = hi ? 0 : 16 * 64, shA = hi ? 0 : 7, shB = hi ? 7 : 0;
            float fa[16], fb[16]; unsigned ia[16], ib[16];
#pragma unroll
            for (int i = 0; i < 16; ++i) { const unsigned av = lsw[offA + i * 64], bv = lsw[offB + i * 64];
                fa[i] = unsrt(av & ~127u); fb[i] = unsrt(bv & ~127u); ia[i] = (av & 127u) << shA; ib[i] = (bv & 127u) << shB; }
#define PA_CAND(i, j) ((srt(fa[i] + fb[j]) & ~0x3FFFu) | ia[i] | ib[j])
            unsigned c0[16], c1[16];
#pragma unroll
            for (int j = 1; j < 16; ++j) c0[j - 1] = PA_CAND(0, j);
            c0[15] = hi ? PA_CAND(1, 1) : PA_CAND(0, 0);
#pragma unroll
            for (int j = 2; j < 8; ++j) c1[j - 2] = PA_CAND(1, j);
            c1[6] = PA_CAND(2, 3); c1[7] = PA_CAND(2, 4);
            c1[8] = hi ? PA_CAND(3, 3) : PA_CAND(2, 2);
#pragma unroll
            for (int j = 9; j < 16; ++j) c1[j] = 0u;
#undef PA_CAND
            sort16_desc(c0); sort16_desc(c1);
            merge_top16(c0, c1);
#pragma unroll
            for (int j = 0; j < 16; ++j) best[j] = c0[j];
        }
        merge_halves(best);
        float e[16], sum = 0.f;
        const float s0 = unsrt(best[0] & ~0x3FFFu);
#pragma unroll
        for (int j = 0; j < 16; ++j) { e[j] = __builtin_amdgcn_exp2f((unsrt(best[j] & ~0x3FFFu) - s0) * rs2 * LOG2E); sum += e[j]; }
        const float inv = 1.f / sum;
        if (hi == 0) {
            u32x2* pl = (u32x2*)(lds + P6_PL) + tl_r * 128 + 16 * hd;
#pragma unroll
            for (int j = 0; j < 16; ++j) { u32x2 en; en.x = best[j] & 0x3FFFu; en.y = __float_as_uint(e[j] * inv); pl[j] = en; }
        }
    }
#if defined(HK_PROBE_PHASE) && HK_PROBE_PHASE == 10
    if (blockIdx.x == 0 && threadIdx.x == 0) { volatile LAS3 unsigned* pw_ = (volatile LAS3 unsigned*)(LAS3 unsigned char*)(lds + LDS_CTL + 48); *pw_ = *pw_ + (unsigned)(__builtin_amdgcn_s_memrealtime() - pq0_); }
#endif
    const unsigned char* ut = a.ws + WS_UT; const unsigned char* vt = a.ws + WS_VT; const float* scl = (const float*)(a.ws + WS_US);
    float* dots = (float*)(lds + P6_DOT) + w * 256; float* cfs = dots + 128;
    int vz_; asm volatile("v_mov_b32 %0, 0" : "=v"(vz_));
    const int lane_g = lane + vz_, hi_g = lane_g >> 5;
    const int c32 = lane_g & 31, slot = 2 * c32 + hi_g;
#define PG_ISSUE(buf, tab, plp, b) do { _Pragma("unroll") for (int kk = 0; kk < 8; ++kk) { const unsigned id_ = (plp)[16 * (b) + 8 * hi_g + kk].x; buf[kk] = *(const u32x4*)((tab) + (unsigned)(id_ * 512u + 16u * (unsigned)c32)); } } while (0)
#define PG_CU(buf, b) do { int pd_[8]; \
        _Pragma("unroll") for (int kk = 0; kk < 8; ++kk) {        \
            int dl_ = __builtin_amdgcn_sdot8((int)buf[kk][0], xl4[0], 0, true), dh_ = __builtin_amdgcn_sdot8((int)buf[kk][0], xh4[0], 0, true); \
            _Pragma("unroll") for (int j = 1; j < 4; ++j) { dl_ = __builtin_amdgcn_sdot8((int)buf[kk][j], xl4[j], dl_, false); dh_ = __builtin_amdgcn_sdot8((int)buf[kk][j], xh4[j], dh_, false); } \
            pd_[kk] = (dh_ << 4) + dl_; } \
        int r4_[4]; \
        _Pragma("unroll") for (int j = 0; j < 4; ++j) { auto rr_ = __builtin_amdgcn_permlane16_swap((unsigned)pd_[j], (unsigned)pd_[j + 4], false, false); r4_[j] = (int)rr_[0] + (int)rr_[1]; } \
        _Pragma("unroll") for (int j = 0; j < 4; ++j) { int v_ = r4_[j]; \
            v_ += __builtin_amdgcn_update_dpp(0, v_, 0xB1, 0xf, 0xf, true); v_ += __builtin_amdgcn_update_dpp(0, v_, 0x4E, 0xf, 0xf, true); \
            v_ += __builtin_amdgcn_update_dpp(0, v_, 0x141, 0xf, 0xf, true); v_ += __builtin_amdgcn_update_dpp(0, v_, 0x140, 0xf, 0xf, true); r4_[j] = v_; } \
        if ((lane_g & 15) == 0) { const int q_ = lane_g >> 4; *(f32x4*)(dots + 16 * (b) + 8 * (q_ >> 1) + 4 * (q_ & 1)) = (f32x4){(float)r4_[0], (float)r4_[1], (float)r4_[2], (float)r4_[3]}; } } while (0)
#define PG_T4(r0, r1, r2, r3, t0, t1, t2, t3) do { const unsigned a01l_ = __builtin_amdgcn_perm(r1, r0, 0x05010400u), a01h_ = __builtin_amdgcn_perm(r1, r0, 0x07030602u), \
            a23l_ = __builtin_amdgcn_perm(r3, r2, 0x05010400u), a23h_ = __builtin_amdgcn_perm(r3, r2, 0x07030602u); \
        t0 = __builtin_amdgcn_perm(a23l_, a01l_, 0x05040100u); t1 = __builtin_amdgcn_perm(a23l_, a01l_, 0x07060302u); \
        t2 = __builtin_amdgcn_perm(a23h_, a01h_, 0x05040100u); t3 = __builtin_amdgcn_perm(a23h_, a01h_, 0x07060302u); } while (0)
#define PG_CV(buf, b) do { _Pragma("unroll") for (int g4 = 0; g4 < 2; ++g4) { const int cq_ = (int)cqw[4 * (b) + 2 * hi_g + g4]; \
            _Pragma("unroll") for (int j = 0; j < 4; ++j) { \
                const unsigned w0_ = buf[4 * g4][j], w1_ = buf[4 * g4 + 1][j], w2_ = buf[4 * g4 + 2][j], w3_ = buf[4 * g4 + 3][j]; \
                unsigned t0_, t1_, t2_, t3_; \
                PG_T4(w0_ & 0x0F0F0F0Fu, w1_ & 0x0F0F0F0Fu, w2_ & 0x0F0F0F0Fu, w3_ & 0x0F0F0F0Fu, t0_, t1_, t2_, t3_); \
                oa[8 * j + 0] = __builtin_amdgcn_sdot4((int)t0_, cq_, oa[8 * j + 0], false); oa[8 * j + 1] = __builtin_amdgcn_sdot4((int)t1_, cq_, oa[8 * j + 1], false); \
                oa[8 * j + 2] = __builtin_amdgcn_sdot4((int)t2_, cq_, oa[8 * j + 2], false); oa[8 * j + 3] = __builtin_amdgcn_sdot4((int)t3_, cq_, oa[8 * j + 3], false); \
                PG_T4((w0_ >> 4) & 0x0F0F0F0Fu, (w1_ >> 4) & 0x0F0F0F0Fu, (w2_ >> 4) & 0x0F0F0F0Fu, (w3_ >> 4) & 0x0F0F0F0Fu, t0_, t1_, t2_, t3_); \
                oa[8 * j + 4] = __builtin_amdgcn_sdot4((int)t0_, cq_, oa[8 * j + 4], false); oa[8 * j + 5] = __builtin_amdgcn_sdot4((int)t1_, cq_, oa[8 * j + 5], false); \
                oa[8 * j + 6] = __builtin_amdgcn_sdot4((int)t2_, cq_, oa[8 * j + 6], false); oa[8 * j + 7] = __builtin_amdgcn_sdot4((int)t3_, cq_, oa[8 * j + 7], false); \
                asm volatile("" : "+v"(oa[8 * j]), "+v"(oa[8 * j + 1]), "+v"(oa[8 * j + 2]), "+v"(oa[8 * j + 3]), "+v"(oa[8 * j + 4]), "+v"(oa[8 * j + 5]), "+v"(oa[8 * j + 6]), "+v"(oa[8 * j + 7])); } } } while (0)
#define PG_SB __builtin_amdgcn_sched_barrier(0)
    u32x4 bA[8], bB[8], bC[8], bD[8];
    { const u32x2* pl0 = (const u32x2*)(lds + P6_PL) + (4 * w) * 128; PG_ISSUE(bA, ut, pl0, 0); PG_ISSUE(bB, ut, pl0, 1); PG_ISSUE(bC, ut, pl0, 2); }
    for (int tt = 0; tt < 4; ++tt) {
        const int tl = 4 * w + tt, tok = tok0 + tl;
        const float rs2 = rsl[tl];
        const u32x2* pl = (const u32x2*)(lds + P6_PL) + tl * 128;
        const u32x2 en0 = pl[lane_g], en1 = pl[64 + lane_g];
        const float2 sc0_ = *(const float2*)(scl + 2 * (size_t)en0.x), sc1_ = *(const float2*)(scl + 2 * (size_t)en1.x);
        const float us0 = sc0_.x, us1 = sc1_.x, vs0 = sc0_.y, vs1 = sc1_.y;
        float xv[16]; load_row16_bf(xg + (size_t)tok * D, slot, xv);
        float mx = 0.f;
#pragma unroll
        for (int i = 0; i < 16; ++i) mx = fmaxf(mx, fabsf(xv[i]));
#pragma unroll
        for (int o = 32; o > 0; o >>= 1) mx = fmaxf(mx, __shfl_xor(mx, o));
        const float sx = mx > 0.f ? mx * (1.f / 119.f) : 1.f, isx = 1.f / sx;
        int xl4[4], xh4[4];
        {
            unsigned xq[8];
#pragma unroll
            for (int j = 0; j < 4; ++j) {
                unsigned pk = 0u;
#pragma unroll
                for (int i = 0; i < 4; ++i) { const int q = (int)rintf(xv[4 * j + i] * isx); pk |= ((unsigned)q & 0xffu) << (8 * i); }
                auto rr = __builtin_amdgcn_permlane32_swap(pk, pk, false, false);
                xq[j] = rr[0]; xq[4 + j] = rr[1];
            }
#pragma unroll
            for (int j = 0; j < 4; ++j) {
                const unsigned A = xq[2 * j], B = xq[2 * j + 1];
                xl4[j] = (int)((A & 0x0F0F0F0Fu) | ((B & 0x0F0F0F0Fu) << 4));
                const unsigned ha = (((A >> 4) & 0x0F0F0F0Fu) + ((A >> 3) & 0x01010101u)) & 0x0F0F0F0Fu, hb = (((B >> 4) & 0x0F0F0F0Fu) + ((B >> 3) & 0x01010101u)) & 0x0F0F0F0Fu;
                xh4[j] = (int)(ha | (hb << 4));
            }
        }
#define PG_STEP(cur, nxt, ub) do { if ((ub) + 3 < 8) PG_ISSUE(nxt, ut, pl, (ub) + 3); else if (tt < 3) PG_ISSUE(nxt, ut, pl + 128, (ub) + 3 - 8); PG_SB; PG_CU(cur, ub); PG_SB; } while (0)
        PG_STEP(bA, bD, 0); PG_STEP(bB, bA, 1); PG_STEP(bC, bB, 2); PG_STEP(bD, bC, 3); PG_STEP(bA, bD, 4); PG_STEP(bB, bA, 5); PG_STEP(bC, bB, 6); PG_STEP(bD, bC, 7);
#undef PG_STEP
        const float a0 = gelu_tanh(dots[lane_g] * (sx * rs2) * us0) * __uint_as_float(en0.y);
        const float a1 = gelu_tanh(dots[64 + lane_g] * (sx * rs2) * us1) * __uint_as_float(en1.y);
        const float c0 = a0 * vs0, c1 = a1 * vs1;
        float cm = fmaxf(fabsf(c0), fabsf(c1));
#pragma unroll
        for (int o = 32; o > 0; o >>= 1) cm = fmaxf(cm, __shfl_xor(cm, o));
        const float scc = cm > 0.f ? cm * (1.f / 127.f) : 1.f, iscc = 1.f / scc;
        const int q0c = (int)rintf(c0 * iscc), q1c = (int)rintf(c1 * iscc);
        int qsum = q0c + q1c;
#pragma unroll
        for (int o = 32; o > 0; o >>= 1) qsum += __shfl_xor(qsum, o);
        unsigned short* gid = (unsigned short*)(a.ws + WS_CIDX) + (size_t)tok * 128; signed char* gcq = (signed char*)(a.ws + WS_CQ) + (size_t)tok * 128;
        gid[lane_g] = (unsigned short)en0.x; gid[64 + lane_g] = (unsigned short)en1.x; gcq[lane_g] = (signed char)q0c; gcq[64 + lane_g] = (signed char)q1c;
        if (lane_g == 0) { float* gsc = (float*)(a.ws + WS_CSC) + 2 * (size_t)tok; gsc[0] = scc; gsc[1] = (float)qsum; }
    }
#undef PG_ISSUE
#undef PG_SB
#undef PG_CU
#undef PG_CV
#undef PG_T4
}
#endif
__device__ __forceinline__ void peer_unit_c(const Args& a, unsigned char* lds, int layer, int unit) {
    int tid = threadIdx.x; asm volatile("" : "+v"(tid));
    const int lane = tid & 63, w = __builtin_amdgcn_readfirstlane(tid >> 6), hi_g = lane >> 5, c32 = lane & 31, slot = 2 * c32 + hi_g;
    const int tok0 = unit * 32 + 4 * w;
    const bf16_t* xg = (const bf16_t*)(a.ws + WS_XB);
    const unsigned char* vt = a.ws + WS_VT;
    const unsigned short* gid = (const unsigned short*)(a.ws + WS_CIDX); const signed char* gcq = (const signed char*)(a.ws + WS_CQ); const float* gsc = (const float*)(a.ws + WS_CSC);
    LAS3 unsigned char* lw = (LAS3 unsigned char*)(lds + w * 1024);
#define PC_ISSUE(buf, lb, b) do { const LAS3 unsigned short* il_ = (const LAS3 unsigned short*)(lw + 512 * (lb)); _Pragma("unroll") for (int kk = 0; kk < 8; ++kk) { const unsigned id_ = il_[16 * (b) + 8 * hi_g + kk]; \
        buf[kk] = *(const u32x4*)(vt + (unsigned)(id_ * 512u + 16u * (unsigned)c32)); } } while (0)
#define PC_T4(r0, r1, r2, r3, t0, t1, t2, t3) do { const unsigned a01l_ = __builtin_amdgcn_perm(r1, r0, 0x05010400u), a01h_ = __builtin_amdgcn_perm(r1, r0, 0x07030602u), \
            a23l_ = __builtin_amdgcn_perm(r3, r2, 0x05010400u), a23h_ = __builtin_amdgcn_perm(r3, r2, 0x07030602u); \
        t0 = __builtin_amdgcn_perm(a23l_, a01l_, 0x05040100u); t1 = __builtin_amdgcn_perm(a23l_, a01l_, 0x07060302u); \
        t2 = __builtin_amdgcn_perm(a23h_, a01h_, 0x05040100u); t3 = __builtin_amdgcn_perm(a23h_, a01h_, 0x07060302u); } while (0)
#define PC_CV(buf, lb, b) do { const LAS3 unsigned* cqw_ = (const LAS3 unsigned*)(lw + 512 * (lb) + 256); _Pragma("unroll") for (int g4 = 0; g4 < 2; ++g4) { const int cq_ = (int)cqw_[4 * (b) + 2 * hi_g + g4]; \
            _Pragma("unroll") for (int j = 0; j < 4; ++j) { \
                unsigned t0_, t1_, t2_, t3_; \
                PC_T4(buf[4 * g4][j], buf[4 * g4 + 1][j], buf[4 * g4 + 2][j], buf[4 * g4 + 3][j], t0_, t1_, t2_, t3_);        \
                of[4 * j + 0] = __builtin_amdgcn_sdot4((int)t0_, cq_, of[4 * j + 0], false); of[4 * j + 1] = __builtin_amdgcn_sdot4((int)t1_, cq_, of[4 * j + 1], false); \
                of[4 * j + 2] = __builtin_amdgcn_sdot4((int)t2_, cq_, of[4 * j + 2], false); of[4 * j + 3] = __builtin_amdgcn_sdot4((int)t3_, cq_, of[4 * j + 3], false); \
                ol[4 * j + 0] = __builtin_amdgcn_sdot4((int)(t0_ & 0x0F0F0F0Fu), cq_, ol[4 * j + 0], false); ol[4 * j + 1] = __builtin_amdgcn_sdot4((int)(t1_ & 0x0F0F0F0Fu), cq_, ol[4 * j + 1], false); \
                ol[4 * j + 2] = __builtin_amdgcn_sdot4((int)(t2_ & 0x0F0F0F0Fu), cq_, ol[4 * j + 2], false); ol[4 * j + 3] = __builtin_amdgcn_sdot4((int)(t3_ & 0x0F0F0F0Fu), cq_, ol[4 * j + 3], false); \
                asm volatile("" : "+v"(of[4 * j]), "+v"(of[4 * j + 1]), "+v"(of[4 * j + 2]), "+v"(of[4 * j + 3]), "+v"(ol[4 * j]), "+v"(ol[4 * j + 1]), "+v"(ol[4 * j + 2]), "+v"(ol[4 * j + 3])); } } } while (0)
#define PC_SB __builtin_amdgcn_sched_barrier(0)
    unsigned lid = ((const unsigned*)(gid + (size_t)tok0 * 128))[lane], lcq = lane < 32 ? ((const unsigned*)(gcq + (size_t)tok0 * 128))[lane] : 0u;
    ((LAS3 unsigned*)lw)[lane] = lid; if (lane < 32) ((LAS3 unsigned*)(lw + 256))[lane] = lcq;
    u32x4 bA[8], bB[8];
    PC_ISSUE(bA, 0, 0);
    for (int tt = 0; tt < 4; ++tt) {
        const int tok = tok0 + tt, lb = tt & 1;
        if (tt < 3) { lid = ((const unsigned*)(gid + (size_t)(tok + 1) * 128))[lane]; lcq = lane < 32 ? ((const unsigned*)(gcq + (size_t)(tok + 1) * 128))[lane] : 0u; }
        const float scc = gsc[2 * (size_t)tok], qsf = gsc[2 * (size_t)tok + 1];
        float xv[16]; load_row16_bf(xg + (size_t)tok * D, slot, xv);
        int of[16], ol[16];
#pragma unroll
        for (int i = 0; i < 16; ++i) { of[i] = 0; ol[i] = 0; }
#pragma unroll
        for (int vb = 0; vb < 8; vb += 2) {
            PC_ISSUE(bB, lb, vb + 1); PC_SB; PC_CV(bA, lb, vb); PC_SB;
            if (vb == 2 && tt < 3) { ((LAS3 unsigned*)(lw + 512 * (lb ^ 1)))[lane] = lid; if (lane < 32) ((LAS3 unsigned*)(lw + 512 * (lb ^ 1) + 256))[lane] = lcq; }
            if (vb + 2 < 8) PC_ISSUE(bA, lb, vb + 2); else if (tt < 3) PC_ISSUE(bA, lb ^ 1, 0);
            PC_SB; PC_CV(bB, lb, vb + 1); PC_SB;
        }
#pragma unroll
        for (int i = 0; i < 8; ++i) {
            const int jj = i >> 2, k = i & 3;
            auto rl = __builtin_amdgcn_permlane32_swap((unsigned)ol[4 * jj + k], (unsigned)ol[8 + 4 * jj + k], false, false);
            auto rf = __builtin_amdgcn_permlane32_swap((unsigned)of[4 * jj + k], (unsigned)of[8 + 4 * jj + k], false, false);
            const int sl = (int)rl[0] + (int)rl[1], sf = (int)rf[0] + (int)rf[1];
#ifndef HK_PROBE_NOPEER
            xv[8 * jj + k] += scc * ((float)sl - 8.f * qsf);
            xv[8 * jj + 4 + k] += scc * (float)((sf - sl) >> 4);
#else
            xv[8 * jj + k] += 1e-30f * (float)sl; xv[8 * jj + 4 + k] += 1e-30f * (float)sf;
#endif
        }
        const bool more = layer + 1 < DEPTH;
        int vzt_; asm volatile("v_mov_b32 %0, 0" : "=v"(vzt_) : "v"(xv[0]));
        finish_token(tok, xv, more ? nullptr : a.out, (bf16_t*)(a.ws + WS_XB), (float*)(a.ws + WS_RSTD), more ? (const float*)(a.ws + WS_WF) + (size_t)(layer + 1) * 4096 : nullptr,
                     a.in[2] + (more ? (layer + 1) * 4 : 0), (float*)(a.ws + WS_FLOG), lane, slot + vzt_);
    }
#undef PC_ISSUE
#undef PC_T4
#undef PC_CV
#undef PC_SB
}
__device__ __forceinline__ void peer_phase_c(const Args& a, unsigned char* lds, int layer) {
    int tid = threadIdx.x; asm volatile("" : "+v"(tid));
    const int lane = tid & 63, w = __builtin_amdgcn_readfirstlane(tid >> 6), c8 = lane & 7, r8 = lane >> 3;
    const int nun = (T / 32 - (int)blockIdx.x + (int)gridDim.x - 1) / (int)gridDim.x, N = 4 * nun;
    bf16_t* xg = (bf16_t*)(a.ws + WS_XB);
    const unsigned char* vt = a.ws + WS_VT;
    const unsigned short* gid = (const unsigned short*)(a.ws + WS_CIDX); const signed char* gcq = (const signed char*)(a.ws + WS_CQ); const float* gsc = (const float*)(a.ws + WS_CSC);
    LAS3 unsigned char* lw = (LAS3 unsigned char*)(lds + w * 1024);
    const bool more = layer + 1 < DEPTH;
    const float* wf = (const float*)(a.ws + WS_WF) + (size_t)(more ? layer + 1 : 0) * 4096; const float* bfor = a.in[2] + (more ? (layer + 1) * 4 : 0);
#define PS_TOK(n) (((int)blockIdx.x + ((n) >> 2) * (int)gridDim.x) * 32 + 4 * w + ((n) & 3))
#define PS_ISSUE(buf, lb, b) do { const LAS3 unsigned char* il_ = lw + 512 * (lb) + 2 * (64 * (b) + 4 * r8); _Pragma("unroll") for (int g4 = 0; g4 < 2; ++g4) { const u32x2 i4_ = *(const LAS3 u32x2*)(il_ + 64 * g4); \
        _Pragma("unroll") for (int k4 = 0; k4 < 4; ++k4) { const unsigned id_ = (k4 & 1 ? i4_[k4 >> 1] >> 16 : i4_[k4 >> 1] & 0xffffu); buf[4 * g4 + k4] = *(const u32x4*)(vt + (unsigned)(id_ * 512u + soff)); } } } while (0)
#define PS_T4(r0, r1, r2, r3, t0, t1, t2, t3) do { const unsigned a01l_ = __builtin_amdgcn_perm(r1, r0, 0x05010400u), a01h_ = __builtin_amdgcn_perm(r1, r0, 0x07030602u), \
            a23l_ = __builtin_amdgcn_perm(r3, r2, 0x05010400u), a23h_ = __builtin_amdgcn_perm(r3, r2, 0x07030602u); \
        t0 = __builtin_amdgcn_perm(a23l_, a01l_, 0x05040100u); t1 = __builtin_amdgcn_perm(a23l_, a01l_, 0x07060302u); \
        t2 = __builtin_amdgcn_perm(a23h_, a01h_, 0x05040100u); t3 = __builtin_amdgcn_perm(a23h_, a01h_, 0x07060302u); } while (0)
#define PS_CV(buf, lb, b) do { const LAS3 unsigned* cqw_ = (const LAS3 unsigned*)(lw + 512 * (lb) + 256); _Pragma("unroll") for (int g4 = 0; g4 < 2; ++g4) { const int cq_ = (int)cqw_[16 * (b) + 8 * g4 + r8]; const bool first_ = (b) == 0 && g4 == 0;       \
            _Pragma("unroll") for (int j = 0; j < 4; ++j) { \
                unsigned t0_, t1_, t2_, t3_; \
                PS_T4(buf[4 * g4][j], buf[4 * g4 + 1][j], buf[4 * g4 + 2][j], buf[4 * g4 + 3][j], t0_, t1_, t2_, t3_);        \
                of[4 * j + 0] = (first_ ? __builtin_amdgcn_sdot4((int)t0_, cq_, 0, true) : __builtin_amdgcn_sdot4((int)t0_, cq_, of[4 * j + 0], false)); of[4 * j + 1] = (first_ ? __builtin_amdgcn_sdot4((int)t1_, cq_, 0, true) : __builtin_amdgcn_sdot4((int)t1_, cq_, of[4 * j + 1], false)); \
                of[4 * j + 2] = (first_ ? __builtin_amdgcn_sdot4((int)t2_, cq_, 0, true) : __builtin_amdgcn_sdot4((int)t2_, cq_, of[4 * j + 2], false)); of[4 * j + 3] = (first_ ? __builtin_amdgcn_sdot4((int)t3_, cq_, 0, true) : __builtin_amdgcn_sdot4((int)t3_, cq_, of[4 * j + 3], false)); \
                ol[4 * j + 0] = (first_ ? __builtin_amdgcn_sdot4((int)(t0_ & 0x0F0F0F0Fu), cq_, 0, true) : __builtin_amdgcn_sdot4((int)(t0_ & 0x0F0F0F0Fu), cq_, ol[4 * j + 0], false)); ol[4 * j + 1] = (first_ ? __builtin_amdgcn_sdot4((int)(t1_ & 0x0F0F0F0Fu), cq_, 0, true) : __builtin_amdgcn_sdot4((int)(t1_ & 0x0F0F0F0Fu), cq_, ol[4 * j + 1], false)); \
                ol[4 * j + 2] = (first_ ? __builtin_amdgcn_sdot4((int)(t2_ & 0x0F0F0F0Fu), cq_, 0, true) : __builtin_amdgcn_sdot4((int)(t2_ & 0x0F0F0F0Fu), cq_, ol[4 * j + 2], false)); ol[4 * j + 3] = (first_ ? __builtin_amdgcn_sdot4((int)(t3_ & 0x0F0F0F0Fu), cq_, 0, true) : __builtin_amdgcn_sdot4((int)(t3_ & 0x0F0F0F0Fu), cq_, ol[4 * j + 3], false)); \
                asm volatile("" : "+v"(of[4 * j]), "+v"(of[4 * j + 1]), "+v"(of[4 * j + 2]), "+v"(of[4 * j + 3]), "+v"(ol[4 * j]), "+v"(ol[4 * j + 1]), "+v"(ol[4 * j + 2]), "+v"(ol[4 * j + 3])); } } } while (0)
#define PS_SB __builtin_amdgcn_sched_barrier(0)
#pragma unroll 1
    for (int s = 0; s < 4; ++s) {
        const int e0 = 256 * s + 32 * c8 + 4 * r8;
        const unsigned soff = 128u * (unsigned)s + 16u * (unsigned)c8;
        {
#pragma unroll
            for (int q = 0; q < 2; ++q) { const int tq = PS_TOK(q);
                const unsigned lidq = ((const unsigned*)(gid + (size_t)tq * 128))[lane], lcqq = lane < 32 ? ((const unsigned*)(gcq + (size_t)tq * 128))[lane] : 0u;
                ((LAS3 unsigned*)(lw + 512 * q))[lane] = lidq; if (lane < 32) ((LAS3 unsigned*)(lw + 512 * q + 256))[lane] = lcqq; }
        }
        u32x4 bA[8], bB[8], bC[8], bD[8];
        PS_ISSUE(bA, 0, 0); PS_ISSUE(bB, 0, 1);
#define PS_BODY(n_, X0, X1, Y0, Y1) do { const int n = (n_), tok = PS_TOK(n), lb = n & 1; \
            const bool nx2 = n + 2 < N; unsigned lid = 0u, lcq = 0u; \
            if (nx2) { const int tn = PS_TOK(n + 2); lid = ((const unsigned*)(gid + (size_t)tn * 128))[lane]; lcq = lane < 32 ? ((const unsigned*)(gcq + (size_t)tn * 128))[lane] : 0u; } \
            if (n + 1 < N) { PS_ISSUE(Y0, lb ^ 1, 0); PS_ISSUE(Y1, lb ^ 1, 1); } \
            const float scc = gsc[2 * (size_t)tok], qsf = gsc[2 * (size_t)tok + 1]; \
            const u32x2 xr = *(const u32x2*)(xg + (size_t)tok * D + e0); \
            int of[16], ol[16];         \
            PS_SB; PS_CV(X0, lb, 0); PS_SB; PS_CV(X1, lb, 1); PS_SB; \
            if (nx2) { ((LAS3 unsigned*)(lw + 512 * lb))[lane] = lid; if (lane < 32) ((LAS3 unsigned*)(lw + 512 * lb + 256))[lane] = lcq; }        \
              \
            int y[16], z[8]; \
            _Pragma("unroll") for (int i = 0; i < 8; ++i) { \
                auto rf = __builtin_amdgcn_permlane32_swap((unsigned)of[i], (unsigned)of[8 + i], false, false); y[i] = (int)rf[0] + (int)rf[1]; \
                auto rl = __builtin_amdgcn_permlane32_swap((unsigned)ol[i], (unsigned)ol[8 + i], false, false); y[8 + i] = (int)rl[0] + (int)rl[1]; } \
            _Pragma("unroll") for (int i = 0; i < 4; ++i) { \
                auto rf = __builtin_amdgcn_permlane16_swap((unsigned)y[i], (unsigned)y[4 + i], false, false); z[i] = (int)rf[0] + (int)rf[1]; \
                auto rl = __builtin_amdgcn_permlane16_swap((unsigned)y[8 + i], (unsigned)y[12 + i], false, false); z[4 + i] = (int)rl[0] + (int)rl[1]; } \
            _Pragma("unroll") for (int i = 0; i < 8; ++i) z[i] += __builtin_amdgcn_update_dpp(0, z[i], 0x128, 0xf, 0xf, true);         \
            float xn[4]; \
            _Pragma("unroll") for (int k = 0; k < 4; ++k) { \
                const float vl = (float)z[4 + k] - 8.f * qsf, vh = (float)((z[k] - z[4 + k]) >> 4); \
                const unsigned xw = xr[k >> 1]; \
                xn[k] = (k & 1 ? __uint_as_float(xw & 0xffff0000u) : __uint_as_float(xw << 16)) + scc * ((r8 & 1) ? vh : vl); } \
            if (more) { u32x2 o; o.x = pk2(xn[0], xn[1]); o.y = pk2(xn[2], xn[3]); *(u32x2*)(xg + (size_t)tok * D + e0) = o; } \
            else *(f32x4*)(a.out + (size_t)tok * D + e0) = (f32x4){xn[0], xn[1], xn[2], xn[3]}; } while (0)
#pragma unroll 1
        for (int n2 = 0; n2 < N; n2 += 2) {
            PS_BODY(n2, bA, bB, bC, bD);
            PS_BODY(n2 + 1, bC, bD, bA, bB);
        }
#undef PS_BODY
    }
    if (more) {
        __builtin_amdgcn_fence(__ATOMIC_ACQ_REL, "workgroup");
        f32x4 wg[4][4];
#pragma unroll
        for (int h = 0; h < 4; ++h)
#pragma unroll
            for (int j = 0; j < 4; ++j) wg[h][j] = *(const f32x4*)(wf + h * 1024 + 16 * lane + 4 * j);
        const int myh = ((lane >> 4) & 1) * 2 + (lane >> 5);
        const float mybf = bfor[myh];
#pragma unroll 1
        for (int n = 0; n < N; ++n) {
            const int tok = PS_TOK(n);
            float xv[16]; load_row16_bf(xg + (size_t)tok * D, lane, xv);
            float ss = 0.f, g[4] = {0.f, 0.f, 0.f, 0.f};
#pragma unroll
            for (int i = 0; i < 16; ++i) { ss += xv[i] * xv[i];
#pragma unroll
                for (int h = 0; h < 4; ++h) g[h] += xv[i] * wg[h][i >> 2][i & 3]; }
            auto r01 = __builtin_amdgcn_permlane32_swap(__float_as_uint(g[0]), __float_as_uint(g[1]), false, false); const float q01 = __uint_as_float(r01[0]) + __uint_as_float(r01[1]);
            auto r23 = __builtin_amdgcn_permlane32_swap(__float_as_uint(g[2]), __float_as_uint(g[3]), false, false); const float q23 = __uint_as_float(r23[0]) + __uint_as_float(r23[1]);
            auto rq = __builtin_amdgcn_permlane16_swap(__float_as_uint(q01), __float_as_uint(q23), false, false); float q = __uint_as_float(rq[0]) + __uint_as_float(rq[1]);
            q += __uint_as_float(__builtin_amdgcn_update_dpp(0, __float_as_uint(q), 0x128, 0xf, 0xf, true)); q += __uint_as_float(__builtin_amdgcn_update_dpp(0, __float_as_uint(q), 0x124, 0xf, 0xf, true));
            q += __uint_as_float(__builtin_amdgcn_update_dpp(0, __float_as_uint(q), 0x122, 0xf, 0xf, true)); q += __uint_as_float(__builtin_amdgcn_update_dpp(0, __float_as_uint(q), 0x121, 0xf, 0xf, true));
            ss += __uint_as_float(__builtin_amdgcn_update_dpp(0, __float_as_uint(ss), 0x128, 0xf, 0xf, true)); ss += __uint_as_float(__builtin_amdgcn_update_dpp(0, __float_as_uint(ss), 0x124, 0xf, 0xf, true));
            ss += __uint_as_float(__builtin_amdgcn_update_dpp(0, __float_as_uint(ss), 0x122, 0xf, 0xf, true)); ss += __uint_as_float(__builtin_amdgcn_update_dpp(0, __float_as_uint(ss), 0x121, 0xf, 0xf, true));
            ss = half_swap_sum(ss);
            { auto r = __builtin_amdgcn_permlane16_swap(__float_as_uint(ss), __float_as_uint(ss), false, false); ss = __uint_as_float(r[0]) + __uint_as_float(r[1]); }
            const float rs = __builtin_amdgcn_rsqf(ss * (1.f / 1024.f) + EPS);
            if (lane == 0) ((float*)(a.ws + WS_RSTD))[tok] = rs;
            if ((lane & 15) == 0) { const int b = tok / S, sq = tok % S; ((float*)(a.ws + WS_FLOG))[((size_t)b * 4 + myh) * S + sq] = log_sigmoid(q * rs + mybf); }
        }
    }
#undef PS_TOK
#undef PS_ISSUE
#undef PS_T4
#undef PS_CV
#undef PS_SB
}
}
namespace hk {
#ifndef HK_ALIGN1
#define HK_ALIGN1 true
#endif
#ifndef HK_ALIGN2
#define HK_ALIGN2 true
#endif
#ifndef HK_ALIGN3
#define HK_ALIGN3 true
#endif
constexpr int NPL = 6 + HK_PEER_SPLIT;
constexpr int NPHASE = 2 + NPL * DEPTH;
__device__ __forceinline__ unsigned q_next(unsigned* ctr, unsigned char* lds) {
    volatile LAS3 unsigned* slot = (volatile LAS3 unsigned*)(LAS3 unsigned char*)(lds + LDS_CTL + 32);
    __syncthreads();
    if (threadIdx.x == 0) *slot = __hip_atomic_fetch_add(ctr, 1u, __ATOMIC_RELAXED, __HIP_MEMORY_SCOPE_AGENT);
    __syncthreads();
    return *slot;
}
__device__ __forceinline__ unsigned q_publish(unsigned nxt, unsigned char* lds) {
    volatile LAS3 unsigned* slot = (volatile LAS3 unsigned*)(LAS3 unsigned char*)(lds + LDS_CTL + 32);
    __syncthreads();
    if (threadIdx.x == 0) *slot = nxt;
    __syncthreads();
    return *slot;
}
#define SEAM(k) do { if (a.use_bar && (k) >= a.ph_lo && (k) + 1 < a.ph_hi) { xcd_barrier(bar); } } while (0)
#define ON(k) ((k) >= a.ph_lo && (k) < a.ph_hi)
#ifdef HK_PROBE_PHASE
#define PROBE_T0(k) unsigned long long pt0_ = 0; if ((k) == HK_PROBE_PHASE && blockIdx.x == 0 && threadIdx.x == 0) pt0_ = __builtin_amdgcn_s_memrealtime();
#define PROBE_T1(k) if ((k) == HK_PROBE_PHASE && blockIdx.x == 0 && threadIdx.x == 0) { volatile LAS3 unsigned* pw_ = (volatile LAS3 unsigned*)(LAS3 unsigned char*)(lds + LDS_CTL + 48); *pw_ = *pw_ + (unsigned)(__builtin_amdgcn_s_memrealtime() - pt0_); }
#else
#define PROBE_T0(k)
#define PROBE_T1(k)
#endif
template <int l>
__device__ __forceinline__ void layer_phases(const Args& a, unsigned char* lds, const XcdBarrier& bar, unsigned* ctl) {
        const int pb = 2 + NPL * l;
        { PROBE_T0(0)
        if (ON(pb)) {
            if (blockIdx.x < NB * 4) cum_scan(a, lds, blockIdx.x);
            pg8::Gemm g; g.A = (const bf16_t*)(a.ws + WS_XB); g.Bt = (const bf16_t*)(a.ws + WS_WIN) + (size_t)l * 2560 * 1024; g.M = T; g.N = 2560; g.K = 1024;
            pg8::StaticOrder so; so.init(T, 2560, gridDim.x, blockIdx.x);
            pg8::EpiIn E; E.zb = (bf16_t*)(a.ws + WS_ZB); E.su32 = (float*)(a.ws + WS_SU); E.rstd = (const float*)(a.ws + WS_RSTD);
            E.g_fq = a.in[6] + l * 64; E.g_fk = a.in[7] + l * 64; E.g_dq = a.in[8] + l * 64; E.g_dk = a.in[9] + l * 64; E.g_cq = a.in[10] + l * 32; E.g_ck = a.in[11] + l * 32;
#ifndef HK_NO_G1
            pg8::gemm_phase<pg8::EpiIn, pg8::StaticOrder, HK_ALIGN1, true>((PG8_LAS unsigned char*)lds, g, so, E);
#endif
        }
        SEAM(pb);
        PROBE_T1(0) }
        { PROBE_T0(1)
        if (ON(pb + 1)) {
            unsigned* ctr = ctl + CTL_Q + 64 * (l + 4 * a.pad0);
            unsigned u = q_next(ctr, lds);
            while (u < 5632u) {
                unsigned nxt_ = 0u; if (threadIdx.x == 0) nxt_ = __hip_atomic_fetch_add(ctr, 1u, __ATOMIC_RELAXED, __HIP_MEMORY_SCOPE_AGENT);
                if (u < 1024u) {
#ifndef HK_NO_DIFF
 diff_unit(a, lds, l, u & 31, 31 - (u >> 5));
#endif
 }
                else if (u < 1536u) {
#ifndef HK_NO_FOX
 fox64_unit(a, lds, l, (u - 1024u) & 31, 15 - ((u - 1024u) >> 5));
#endif
 }
                else if (u < 4608u) { const unsigned j = u - 1536u, br = j >> 10, jj = j & 1023u, bh = jj & 31u, sub = jj >> 5;
                    const int rho = br == 0 ? 0 : (br == 1 ? (sub & 3) : (sub & 15)), tile = br == 0 ? sub : (br == 1 ? (sub >> 2) : (sub >> 4));

#ifndef HK_NO_DIL
                    dil_unit(a, lds, bh, br, rho, tile);
#endif
 }
                else { const unsigned j = u - 4608u;
#ifndef HK_NO_S51
 s5_pass1_unit(a, lds, l, j >> 7, j & 127u);
#endif
 }
                u = q_publish(nxt_, lds);
            }
        }
        SEAM(pb + 1);
        PROBE_T1(1) }
        { PROBE_T0(2)
        if (ON(pb + 2)) {
#ifndef HK_NO_S52
            { PROBE_T0(12)
            for (int u = blockIdx.x; u < 256; u += gridDim.x) s5_pass2_unit(a, lds, l, u >> 5, u & 31);
            PROBE_T1(12) }
#endif
            { PROBE_T0(13)
            phase_p3_elementwise(a, l);
            PROBE_T1(13) }
        }
        SEAM(pb + 2);
        PROBE_T1(2) }
        { PROBE_T0(3)
        if (ON(pb + 3)) {
            pg8::Gemm g; g.A = (const bf16_t*)(a.ws + WS_MIX); g.Bt = (const bf16_t*)(a.ws + WS_WOUT) + (size_t)l * 1024 * 1024; g.M = T; g.N = 1024; g.K = 1024;
            pg8::StaticOrder so; so.init(T, 1024, gridDim.x, blockIdx.x);
            pg8::EpiOut E; E.xb = (bf16_t*)(a.ws + WS_XB);
#ifndef HK_NO_G2
            pg8::gemm_phase<pg8::EpiOut, pg8::StaticOrder, HK_ALIGN2, true>((PG8_LAS unsigned char*)lds, g, so, E);
#endif
        }
        SEAM(pb + 3);
        PROBE_T1(3) }
        { PROBE_T0(4)
        if (ON(pb + 4)) {
            pg8::Gemm g; g.A = (const bf16_t*)(a.ws + WS_XB); g.Bt = (const bf16_t*)(a.ws + WS_WQ) + (size_t)l * 2048 * 1024; g.M = T; g.N = 2048; g.K = 1024;
            pg8::StaticOrder so; so.init(T, 2048, gridDim.x, blockIdx.x);
#if HK_FOLD_KEYS
            pg8::EpiF16 E; E.O = (bf16_t*)(a.ws + WS_ZB); E.ldc = 2048;
#ifndef HK_NO_G3
            pg8::gemm_phase<pg8::EpiF16, pg8::StaticOrder, HK_ALIGN3, true>((PG8_LAS unsigned char*)lds, g, so, E);
#endif
#else
            pg8::EpiPlain E; E.O = (bf16_t*)(a.ws + WS_ZB); E.ldc = 2048;
#ifndef HK_NO_G3
            pg8::gemm_phase<pg8::EpiPlain, pg8::StaticOrder, HK_ALIGN3, true>((PG8_LAS unsigned char*)lds, g, so, E);
#endif
#endif
        }
        SEAM(pb + 4);
        PROBE_T1(4) }
        { PROBE_T0(5)
        if (ON(pb + 5)) {
#ifndef HK_NO_PEER
#if HK_PEER_SPLIT
            for (int u = blockIdx.x; u < T / 32; u += gridDim.x) peer_unit_a(a, lds, l, u);
#else
            for (int u = blockIdx.x; u < T / 32; u += gridDim.x) peer_unit(a, lds, l, u);
#endif
#endif
        }
#if HK_PEER_SPLIT && !defined(HK_AC_BAR)
        __builtin_amdgcn_fence(__ATOMIC_RELEASE, "workgroup"); __syncthreads(); __builtin_amdgcn_fence(__ATOMIC_ACQUIRE, "workgroup");
#else
        SEAM(pb + 5);
#endif
        PROBE_T1(5) }
#if HK_PEER_SPLIT
        { PROBE_T0(6)
        if (ON(pb + 6)) {
#ifndef HK_NO_PEER
#ifdef HK_C_UNSLICED
            for (int u = blockIdx.x; u < T / 32; u += gridDim.x) peer_unit_c(a, lds, l, u);
#else
            peer_phase_c(a, lds, l);
#endif
#endif
        }
        SEAM(pb + 6);
        PROBE_T1(6) }
#endif
    }
__global__ void __launch_bounds__(NTHR, 2) hk_mega(Args a) {
    extern __shared__ __attribute__((aligned(16))) unsigned char lds[];
    const int tid = threadIdx.x;
    if (tid < 64) ((LAS3 unsigned*)(lds + LDS_CTL))[tid] = 0u;
    __syncthreads();
    unsigned* ctl = (unsigned*)(a.ws + WS_CTL);
    XcdBarrier bar = xcd_barrier_post(ctl + CTL_BAR, (volatile LAS unsigned*)(LAS3 unsigned char*)(lds + LDS_CTL));
    if (ON(0)) phase_weights(a, lds);
    SEAM(0);
    if (ON(1)) phase_xprep(a);
    SEAM(1);
    layer_phases<0>(a, lds, bar, ctl);
    layer_phases<1>(a, lds, bar, ctl);
    layer_phases<2>(a, lds, bar, ctl);
    layer_phases<3>(a, lds, bar, ctl);
#ifdef HK_PROBE_PHASE
    if (blockIdx.x == 0 && threadIdx.x == 0) { const unsigned span = *(volatile LAS3 unsigned*)(LAS3 unsigned char*)(lds + LDS_CTL + 48); const unsigned long long t0 = __builtin_amdgcn_s_memrealtime();
        while (__builtin_amdgcn_s_memrealtime() - t0 < 4ull * span) __builtin_amdgcn_s_sleep(32); }
#endif
}
#undef SEAM
#undef ON
}
namespace nv {
using namespace hk;
__global__ void __launch_bounds__(64) n_fox(const bf16_t* __restrict__ zb, const float* __restrict__ cum2, bf16_t* __restrict__ mix) {
    int gid = blockIdx.x * 64 + threadIdx.x;
    int t = S - 1 - (gid % S); int bh = gid / S; int b = bh / 4, h = bh % 4;
    const bf16_t* z = zb + (size_t)b * S * ZP; const float* cm = cum2 + (size_t)bh * S;
    float q[64], o[64];
#pragma unroll
    for (int i = 0; i < 64; ++i) { q[i] = bf2f(z[(size_t)t * ZP + ZC_FQ + h * 64 + i]); o[i] = 0.f; }
    float m = -INFINITY, l = 0.f, cq = cm[t];
    int tmax = __shfl(t, 0);
    for (int s = 0; s <= tmax; ++s) {
        const bf16_t* kp = z + (size_t)s * ZP + ZC_FK + h * 64; const bf16_t* vp = z + (size_t)s * ZP + ZC_FV + h * 64;
        float d = 0.f;
#pragma unroll
        for (int i = 0; i < 64; ++i) d += q[i] * bf2f(kp[i]);
        d += cq - cm[s];
        if (s <= t) {
            float mn = fmaxf(m, d), al = exp2f(m - mn), p = exp2f(d - mn);
            l = l * al + p;
#pragma unroll
            for (int i = 0; i < 64; ++i) o[i] = o[i] * al + p * bf2f(vp[i]);
            m = mn;
        }
    }
    float inv = 1.f / l;
    bf16_t* op = mix + ((size_t)b * S + t) * D + h * 64;
#pragma unroll
    for (int i = 0; i < 64; ++i) op[i] = f2bf(o[i] * inv);
}
__global__ void __launch_bounds__(64) n_dil(const bf16_t* __restrict__ zb, const float* __restrict__ tb, bf16_t* __restrict__ mix) {
    int gid = blockIdx.x * 64 + threadIdx.x;
    int t = gid % S; int bh = gid / S; int b = bh / 4, h = bh % 4;
    const bf16_t* z = zb + (size_t)b * S * ZP;
    float q[64], o[64];
#pragma unroll
    for (int i = 0; i < 64; ++i) { q[i] = bf2f(z[(size_t)t * ZP + ZC_DQ + h * 64 + i]); o[i] = 0.f; }
    float m = -INFINITY, l = 0.f;
    for (int br = 0; br < 3; ++br) {
        int r = br == 0 ? 1 : (br == 1 ? 4 : 16);
        for (int j = 0; j <= 128; ++j) {
            bool ok = (t / r - j) >= 0; int sc = ok ? t - j * r : t;
            const bf16_t* kp = z + (size_t)sc * ZP + ZC_DK + h * 64; const bf16_t* vp = z + (size_t)sc * ZP + ZC_DV + h * 64;
            float d = 0.f;
#pragma unroll
            for (int i = 0; i < 64; ++i) d += q[i] * bf2f(kp[i]);
            d += tb[h * TBN + r * j];
            if (ok) {
                float mn = fmaxf(m, d), al = exp2f(m - mn), p = exp2f(d - mn);
                l = l * al + p;
#pragma unroll
                for (int i = 0; i < 64; ++i) o[i] = o[i] * al + p * bf2f(vp[i]);
                m = mn;
            }
        }
    }
    float inv = 1.f / l;
    bf16_t* op = mix + ((size_t)b * S + t) * D + 256 + h * 64;
#pragma unroll
    for (int i = 0; i < 64; ++i) op[i] = f2bf(o[i] * inv);
}
template <int CMP>
__global__ void __launch_bounds__(64) n_diff(const bf16_t* __restrict__ zb, const float* __restrict__ tb, float* __restrict__ tmp) {
    int gid = blockIdx.x * 64 + threadIdx.x;
    int t = S - 1 - (gid % S); int bh = gid / S; int b = bh / 4, h = bh % 4;
    const bf16_t* z = zb + (size_t)b * S * ZP;
    float q[32], o[64];
#pragma unroll
    for (int i = 0; i < 32; ++i) q[i] = bf2f(z[(size_t)t * ZP + ZC_CQ + h * 64 + CMP * 32 + i]);
#pragma unroll
    for (int i = 0; i < 64; ++i) o[i] = 0.f;
    float m = -INFINITY, l = 0.f;
    int tmax = __shfl(t, 0);
    for (int s = 0; s <= tmax; ++s) {
        const bf16_t* kp = z + (size_t)s * ZP + ZC_CK + h * 64 + CMP * 32; const bf16_t* vp = z + (size_t)s * ZP + ZC_CV + h * 64;
        float d = 0.f;
#pragma unroll
        for (int i = 0; i < 32; ++i) d += q[i] * bf2f(kp[i]);
        int rel = t - s; int ri = rel < 0 ? 0 : (rel > 2000 ? 2000 : rel);
        d += tb[(4 + h) * TBN + ri];
        if (rel >= 0) {
            float mn = fmaxf(m, d), al = exp2f(m - mn), p = exp2f(d - mn);
            l = l * al + p;
#pragma unroll
            for (int i = 0; i < 64; ++i) o[i] = o[i] * al + p * bf2f(vp[i]);
            m = mn;
        }
    }
    float inv = 1.f / l;
    float* op = tmp + ((size_t)b * S + t) * 256 + h * 64;
#pragma unroll
    for (int i = 0; i < 64; ++i) op[i] = o[i] * inv;
}
__global__ void n_diff_fin(const float* __restrict__ tmp0, const float* __restrict__ tmp1, const float* __restrict__ lamp, const float* __restrict__ gain, float lam_init, bf16_t* __restrict__ mix) {
    size_t gid = (size_t)blockIdx.x * blockDim.x + threadIdx.x;
    if (gid >= (size_t)T * 4) return;
    size_t tok = gid / 4; int h = (int)(gid % 4);
    float s1 = 0.f, s2 = 0.f;
    for (int i = 0; i < 32; ++i) { s1 += lamp[i] * lamp[32 + i]; s2 += lamp[64 + i] * lamp[96 + i]; }
    float lam = expf(s1) - expf(s2) + lam_init;
    const float* p0 = tmp0 + tok * 256 + h * 64; const float* p1 = tmp1 + tok * 256 + h * 64;
    float ss = 0.f;
    for (int i = 0; i < 64; ++i) { float v = p0[i] - lam * p1[i]; ss += v * v; }
    float r = rsqrtf(ss / 64 + EPS) * (1.f - lam_init);
    bf16_t* op = mix + tok * D + 512 + h * 64;
    for (int i = 0; i < 64; ++i) op[i] = f2bf((p0[i] - lam * p1[i]) * r * gain[i]);
}
__global__ void __launch_bounds__(64) n_s5(const bf16_t* __restrict__ su, const float* a_re, const float* a_im, const float* log_dt, const float* b_re, const float* b_im,
                                           const float* c_re, const float* c_im, const float* dsk, float* __restrict__ gbuf) {
    int b = blockIdx.x / 16, g = blockIdx.x % 16, n = threadIdx.x;
    float dt = expf(log_dt[g]);
    float ar = a_re[g * 64 + n], ai = a_im[g * 64 + n];
    float mag = expf(dt * ar);
    float abr = mag * cosf(dt * ai), abi = mag * sinf(dt * ai);
    float den = ar * ar + ai * ai, nr = abr - 1.f, ni = abi;
    float cr = (nr * ar + ni * ai) / den, ci = (ni * ar - nr * ai) / den;
    float bbr[16], bbi[16], ccr[16], cci[16];
#pragma unroll
    for (int c = 0; c < 16; ++c) {
        float br = b_re[(g * 64 + n) * 16 + c], bi = b_im[(g * 64 + n) * 16 + c];
        bbr[c] = cr * br - ci * bi; bbi[c] = cr * bi + ci * br;
        ccr[c] = c_re[(g * 16 + c) * 64 + n]; cci[c] = c_im[(g * 16 + c) * 64 + n];
    }
    float dk = (n < 16) ? dsk[g * 16 + n] : 0.f;
    float xr = 0.f, xi = 0.f;
    for (int s = 0; s < S; ++s) {
        const bf16_t* up = su + ((size_t)b * S + s) * 256 + g * 16;
        float u[16];
#pragma unroll
        for (int c = 0; c < 16; ++c) u[c] = bf2f(up[c]);
        float pr = 0.f, pi = 0.f;
#pragma unroll
        for (int c = 0; c < 16; ++c) { pr += bbr[c] * u[c]; pi += bbi[c] * u[c]; }
        float nxr = abr * xr - abi * xi + pr, nxi = abr * xi + abi * xr + pi;
        xr = nxr; xi = nxi;
        float myy = 0.f;
#pragma unroll
        for (int c = 0; c < 16; ++c) { float v = wave_sum(ccr[c] * xr - cci[c] * xi); if (n == c) myy = v + dk * u[c]; }
        if (n < 16) gbuf[((size_t)b * S + s) * 256 + g * 16 + n] = gelu_tanh(myy);
    }
}
__global__ void __launch_bounds__(256) n_glu(const float* __restrict__ gbuf, const float* __restrict__ w, const float* __restrict__ bias, bf16_t* __restrict__ mix) {
    __shared__ float gs[256];
    size_t tok = blockIdx.x; int j = threadIdx.x;
    gs[j] = gbuf[tok * 256 + j];
    __syncthreads();
    float acc = bias[j];
    for (int k = 0; k < 256; ++k) acc += gs[k] * w[k * 256 + j];
    mix[tok * D + 768 + j] = f2bf(gs[j] * (1.f / (1.f + expf(-acc))));
}
template <int MODE>
__global__ void __launch_bounds__(256) n_gemm(const bf16_t* __restrict__ A, const float* __restrict__ g, const float* __restrict__ B, float* __restrict__ X, bf16_t* __restrict__ O, int M, int N, int K) {
    __shared__ float As[16][68];
    __shared__ float Bs[16][68];
    const int tx = threadIdx.x & 15, ty = threadIdx.x >> 4;
    const int m0 = blockIdx.y * 64, n0 = blockIdx.x * 64;
    float acc[4][4];
#pragma unroll
    for (int i = 0; i < 4; ++i)
#pragma unroll
        for (int j = 0; j < 4; ++j) acc[i][j] = 0.f;
    for (int k0 = 0; k0 < K; k0 += 16) {
        { int r = threadIdx.x >> 2, c4 = (threadIdx.x & 3) * 4;
          const bf16_t* ap = A + (size_t)(m0 + r) * K + k0 + c4;
#pragma unroll
          for (int j = 0; j < 4; ++j) { float v = bf2f(ap[j]); if (g) v *= g[k0 + c4 + j]; As[c4 + j][r] = v; }
          int br = threadIdx.x >> 4, bc = (threadIdx.x & 15) * 4;
#pragma unroll
          for (int j = 0; j < 4; ++j) Bs[br][bc + j] = B[(size_t)(k0 + br) * N + n0 + bc + j]; }
        __syncthreads();
#pragma unroll
        for (int kk = 0; kk < 16; ++kk) {
            float av[4], bv[4];
#pragma unroll
            for (int i = 0; i < 4; ++i) av[i] = As[kk][ty * 4 + i];
#pragma unroll
            for (int j = 0; j < 4; ++j) bv[j] = Bs[kk][tx * 4 + j];
#pragma unroll
            for (int i = 0; i < 4; ++i)
#pragma unroll
                for (int j = 0; j < 4; ++j) acc[i][j] += av[i] * bv[j];
        }
        __syncthreads();
    }
#pragma unroll
    for (int i = 0; i < 4; ++i)
#pragma unroll
        for (int j = 0; j < 4; ++j) {
            size_t off = (size_t)(m0 + ty * 4 + i) * N + n0 + tx * 4 + j;
            if (MODE == 0) { float v = X[off] + acc[i][j]; X[off] = v; O[off] = f2bf(v); } else O[off] = f2bf(acc[i][j]);
        }
}
__global__ void n_rstd(const float* __restrict__ x, float* __restrict__ rstd) {
    int row = blockIdx.x * 4 + (threadIdx.x >> 6), lane = threadIdx.x & 63;
    const float* p = x + (size_t)row * D;
    float s = 0.f;
    for (int i = lane; i < D; i += 64) { float v = p[i]; s += v * v; }
    s = wave_sum(s);
    if (lane == 0) rstd[row] = rsqrtf(s / D + EPS);
}
__global__ void __launch_bounds__(256) n_top1(const bf16_t* __restrict__ q, const float* __restrict__ keys, float* __restrict__ tv, int* __restrict__ ti) {
    extern __shared__ float ks[];
    int hp = blockIdx.y; size_t tok = (size_t)blockIdx.x * 256 + threadIdx.x;
    const float* kg = keys + (size_t)hp * 128 * 128;
    for (int i = threadIdx.x; i < 128 * 128; i += 256) ks[i] = kg[i];
    __syncthreads();
    float qv[128];
    const bf16_t* qp = q + tok * 2048 + hp * 128;
#pragma unroll
    for (int i = 0; i < 128; ++i) qv[i] = bf2f(qp[i]);
    float bv[16]; int bi[16];
#pragma unroll
    for (int j = 0; j < 16; ++j) { bv[j] = -INFINITY; bi[j] = 0; }
    for (int k = 0; k < 128; ++k) {
        float d = 0.f;
#pragma unroll
        for (int i = 0; i < 128; ++i) d += qv[i] * ks[k * 128 + i];
        float cv = d; int ci = k;
#pragma unroll
        for (int j = 0; j < 16; ++j) { if (cv > bv[j]) { float tvv = bv[j]; int tii = bi[j]; bv[j] = cv; bi[j] = ci; cv = tvv; ci = tii; } }
    }
    float* ov = tv + (tok * 16 + hp) * 16; int* oi = ti + (tok * 16 + hp) * 16;
#pragma unroll
    for (int j = 0; j < 16; ++j) { ov[j] = bv[j]; oi[j] = bi[j]; }
}
__global__ void __launch_bounds__(256) n_top2(const float* __restrict__ tv, const int* __restrict__ ti, const float* __restrict__ rstd2, int* __restrict__ ids, float* __restrict__ gates) {
    size_t gid = (size_t)blockIdx.x * 256 + threadIdx.x;
    const float* v0 = tv + gid * 32; const float* v1 = v0 + 16; const int* i0 = ti + gid * 32; const int* i1 = i0 + 16;
    const float rs = rstd2[gid >> 3];
    float av[16], bb[16];
#pragma unroll
    for (int i = 0; i < 16; ++i) { av[i] = v0[i]; bb[i] = v1[i]; }
    float bv[16]; int bi[16];
#pragma unroll
    for (int j = 0; j < 16; ++j) { bv[j] = -INFINITY; bi[j] = 0; }
#pragma unroll
    for (int i = 0; i < 16; ++i)
#pragma unroll
        for (int jj = 0; jj < 16; ++jj) {
            float cv = av[i] + bb[jj]; int ci = i * 16 + jj;
#pragma unroll
            for (int j = 0; j < 16; ++j) { if (cv > bv[j]) { float tvv = bv[j]; int tii = bi[j]; bv[j] = cv; bi[j] = ci; cv = tvv; ci = tii; } }
        }
    float mx = bv[0], sum = 0.f;
#pragma unroll
    for (int j = 0; j < 16; ++j) { bv[j] = expf((bv[j] - mx) * rs); sum += bv[j]; }
    float inv = 1.f / sum;
#pragma unroll
    for (int j = 0; j < 16; ++j) { int pi = bi[j] >> 4, pj = bi[j] & 15; ids[gid * 16 + j] = i0[pi] * 128 + i1[pj]; gates[gid * 16 + j] = bv[j] * inv; }
}
__global__ void __launch_bounds__(256) n_gather(float* __restrict__ x, const float* __restrict__ rstd2, const float* __restrict__ gn, const int* __restrict__ ids,
                                                const float* __restrict__ gates, const float* __restrict__ ut, const float* __restrict__ vt) {
    __shared__ float hs[1024];
    __shared__ float act[128];
    size_t tok = blockIdx.x; int tid = threadIdx.x, lane = tid & 63, w = tid >> 6;
    float r = rstd2[tok];
    float* xp = x + tok * D;
    for (int i = tid; i < D; i += 256) hs[i] = xp[i] * r * gn[i];
    __syncthreads();
    for (int k = w; k < 128; k += 4) {
        int id = ids[tok * 128 + k];
        const float* up = ut + (size_t)id * D;
        float s = 0.f;
        for (int i = lane; i < D; i += 64) s += hs[i] * up[i];
        s = wave_sum(s);
        if (lane == 0) act[k] = gelu_tanh(s) * gates[tok * 128 + k];
    }
    __syncthreads();
    float o[4] = {0.f, 0.f, 0.f, 0.f};
    for (int k = 0; k < 128; ++k) {
        int id = ids[tok * 128 + k];
        const float* vp = vt + (size_t)id * D;
        float av = act[k];
#pragma unroll
        for (int j = 0; j < 4; ++j) o[j] += av * vp[tid + j * 256];
    }
#pragma unroll
    for (int j = 0; j < 4; ++j) xp[tid + j * 256] += o[j];
}
__global__ void __launch_bounds__(512) n_finish(Args a, int lnext) {
    const int lane = threadIdx.x & 63, wv = blockIdx.x * 8 + (threadIdx.x >> 6), nw = gridDim.x * 8;
    for (int tok = wv; tok < T; tok += nw) {
        float xv[16]; load_row16(a.out + (size_t)tok * D, lane, xv);
        finish_token(tok, xv, a.out, (bf16_t*)(a.ws + WS_XB), (float*)(a.ws + WS_RSTD), lnext < DEPTH ? (const float*)(a.ws + WS_WF) + (size_t)lnext * 4096 : nullptr,
                     a.in[2] + (lnext < DEPTH ? lnext * 4 : 0), (float*)(a.ws + WS_FLOG), lane, lane);
    }
}
}
#ifndef HK_ONE_LAUNCH
#define HK_ONE_LAUNCH 1
#endif
extern "C" void kernel_launch(void* const* d_in, const int* in_sizes, int n_in, void* d_out, int out_size, void* d_ws, size_t ws_size, hipStream_t stream) {
    using namespace hk;
    (void)in_sizes; (void)n_in; (void)out_size; (void)ws_size;
    static int grid = 0;
    if (!grid) {
        int dev = 0, cus = 0, per_cu = 0;
        (void)hipGetDevice(&dev);
        (void)hipDeviceGetAttribute(&cus, hipDeviceAttributeMultiprocessorCount, dev);
        if (hipFuncSetAttribute((const void*)hk_mega, hipFuncAttributeMaxDynamicSharedMemorySize, LDS_BYTES) != hipSuccess) fprintf(stderr, "hipFuncSetAttribute failed\n");
        (void)hipOccupancyMaxActiveBlocksPerMultiprocessor(&per_cu, (const void*)hk_mega, NTHR, LDS_BYTES);
        if (per_cu < 1) fprintf(stderr, "occupancy query says %d blocks per CU\n", per_cu);
        grid = cus > 0 ? cus : 256;
    }
    Args a{};
    for (int i = 0; i < 29; ++i) a.in[i] = (const float*)d_in[i];
    a.out = (float*)d_out; a.ws = (unsigned char*)d_ws;
    (void)hipMemsetAsync(a.ws + WS_CTL, 0, WS_CTL_BYTES, stream);
    auto run = [&](int lo, int hi, int bar, int bank = 0) { Args b = a; b.ph_lo = lo; b.ph_hi = hi; b.use_bar = bar; b.pad0 = bank; hipLaunchKernelGGL(hk_mega, dim3(grid), dim3(NTHR), LDS_BYTES, stream, b); };
#ifndef HK_REP_MASK
#define HK_REP_MASK 0
#endif
#if HK_ONE_LAUNCH
    run(0, NPHASE, 1);
#else
    unsigned char* ws = a.ws;
    bf16_t* zb = (bf16_t*)(ws + WS_ZB); bf16_t* mix = (bf16_t*)(ws + WS_MIX); bf16_t* xb = (bf16_t*)(ws + WS_XB);
    bf16_t* su = (bf16_t*)(ws + WS_SU); float* cum = (float*)(ws + WS_CUM); float* tb = (float*)(ws + WS_TB);
    (void)hipFuncSetAttribute((const void*)nv::n_top1, hipFuncAttributeMaxDynamicSharedMemorySize, 65536);
    run(0, 1, 0); run(1, 2, 0);
    for (int l = 0; l < DEPTH; ++l) {
        const int pb = 2 + NPL * l;
        run(pb, pb + 1, 0);
        if (HK_REP_MASK & 1) run(pb, pb + 1, 0);
        if (HK_NEW_MASK & 2) run(pb + 1, pb + 2, 0);
        if (HK_REP_MASK & 2) run(pb + 1, pb + 2, 0, 1);
        if (HK_NEW_MASK & 4) run(pb + 2, pb + 3, 0);
        if (HK_REP_MASK & 4) run(pb + 2, pb + 3, 0);
        if (!(HK_NEW_MASK & 2)) {
            nv::n_fox<<<NB * 4 * S / 64, 64, 0, stream>>>(zb, cum, mix);
            nv::n_dil<<<NB * 4 * S / 64, 64, 0, stream>>>(zb, tb, mix);
            float* t0 = (float*)(ws + WS_DPART); float* t1 = (float*)(ws + WS_UT);
            nv::n_diff<0><<<NB * 4 * S / 64, 64, 0, stream>>>(zb, tb, t0);
            nv::n_diff<1><<<NB * 4 * S / 64, 64, 0, stream>>>(zb, tb, t1);
            const float lam_init = 0.8f - 0.6f * expf(-0.3f * l);
            nv::n_diff_fin<<<(T * 4) / 256, 256, 0, stream>>>(t0, t1, a.in[12] + l * 128, a.in[13] + l * 64, lam_init, mix);
            float* gbuf = (float*)(ws + WS_VT);
            nv::n_s5<<<NB * 16, 64, 0, stream>>>(su, a.in[15] + l * 1024, a.in[16] + l * 1024, a.in[17] + l * 16, a.in[18] + l * 16384, a.in[19] + l * 16384,
                                                  a.in[20] + l * 16384, a.in[21] + l * 16384, a.in[22] + l * 256, gbuf);
            nv::n_glu<<<T, 256, 0, stream>>>(gbuf, a.in[23] + l * 65536, a.in[24] + l * 256, mix);
        }
        if (HK_NEW_MASK & 8) run(pb + 3, pb + 4, 0);
        else nv::n_gemm<0><<<dim3(D / 64, T / 64), 256, 0, stream>>>(mix, nullptr, a.in[3] + (size_t)l * D * D, a.out, xb, T, D, D);
        if (HK_NEW_MASK & 16) run(pb + 4, pb + 5, 0);
        if (HK_REP_MASK & 16) run(pb + 4, pb + 5, 0);
        else nv::n_gemm<1><<<dim3(2048 / 64, T / 64), 256, 0, stream>>>(xb, a.in[5] + l * D, a.in[25] + (size_t)l * D * 2048, nullptr, zb, T, 2048, D);
        if (HK_NEW_MASK & 32) { run(pb + 5, pb + 6, 0); if (HK_PEER_SPLIT) run(pb + 6, pb + 7, 0); }
        else {
            float* rs2 = (float*)(ws + WS_DLSE); float* tv = (float*)(ws + WS_SU); int* ti = (int*)(ws + WS_MIX);
            int* ids = (int*)(ws + WS_DPART); float* gates = (float*)(ws + WS_DPART + (size_t)T * 128 * 4);
            nv::n_rstd<<<T / 4, 256, 0, stream>>>(a.out, rs2);
            nv::n_top1<<<dim3(T / 256, 16), 256, 65536, stream>>>(zb, a.in[26] + (size_t)l * 16 * 128 * 128, tv, ti);
            nv::n_top2<<<(T * 8) / 256, 256, 0, stream>>>(tv, ti, rs2, ids, gates);
            nv::n_gather<<<T, 256, 0, stream>>>(a.out, rs2, a.in[5] + l * D, ids, gates, a.in[27] + (size_t)l * NEXP * D, a.in[28] + (size_t)l * NEXP * D);
            Args b = a; b.ph_lo = 0; b.ph_hi = 0; b.use_bar = 0; b.pad0 = 0;
            nv::n_finish<<<grid, 512, 0, stream>>>(b, l + 1);
        }
    }
#endif
}
```

```cpp
#define HK_ONE_LAUNCH 1
#include <hip/hip_runtime.h>
#ifndef HK_NEW_MASK
#define HK_NEW_MASK 0x3f
#endif
#define HK_FOLD_KEYS (((HK_NEW_MASK) & 48) == 48)
#ifndef HK_PEER_SPLIT
#define HK_PEER_SPLIT HK_FOLD_KEYS
#endif
#include <cstdint>
#include <cstdio>
#include <cmath>

#define LAS3 __attribute__((address_space(3)))
typedef unsigned short bf16_t;
typedef short bf16x8 __attribute__((ext_vector_type(8)));
typedef float f32x4 __attribute__((ext_vector_type(4)));
typedef float f32x16 __attribute__((ext_vector_type(16)));
typedef unsigned u32x4 __attribute__((ext_vector_type(4)));
typedef unsigned u32x2 __attribute__((ext_vector_type(2)));

namespace hk {
constexpr int D = 1024, NB = 8, S = 8192, DEPTH = 4, T = NB * S;
constexpr int INW = 2564;
constexpr int ZP = 2304;
constexpr int ZC_FQ = 0, ZC_FK = 256, ZC_FV = 512, ZC_DQ = 768, ZC_DK = 1024, ZC_DV = 1280, ZC_CQ = 1536, ZC_CK = 1792, ZC_CV = 2048;
constexpr int NEXP = 16384;
constexpr float EPS = 1e-6f;
constexpr float LOG2E = 1.4426950408889634f;
constexpr int TBN = 2112;
constexpr int S5_TC = 64;
constexpr int S5_NCH = S / S5_TC;
constexpr int NTHR = 512;
constexpr int LDS_BYTES = 160 * 1024;
constexpr int LDS_CTL = LDS_BYTES - 256;

constexpr size_t al256(size_t x) { return (x + 255) & ~(size_t)255; }
constexpr size_t WS_CTL = 0;
constexpr size_t WS_CTL_BYTES = 65536;
constexpr size_t WS_XB = WS_CTL + WS_CTL_BYTES;
constexpr size_t WS_ZB = WS_XB + (size_t)T * D * 2;
constexpr size_t WS_SU = WS_ZB + (size_t)T * ZP * 2;
constexpr size_t WS_MIX = WS_SU + (size_t)T * 256 * 4;
constexpr size_t WS_DPART = WS_MIX + (size_t)T * D * 2;
constexpr size_t WS_DLSE = WS_DPART + (size_t)3 * T * 256 * 2;
constexpr size_t WS_SST = WS_DLSE + (size_t)3 * T * 4 * 4;
constexpr size_t WS_CUM = WS_SST + (size_t)NB * 16 * S5_NCH * 128 * 4;
constexpr size_t WS_FLOG = WS_CUM + (size_t)NB * 4 * S * 4;
constexpr size_t WS_RSTD = WS_FLOG + (size_t)NB * 4 * S * 4;
constexpr size_t WS_WIN = WS_RSTD + (size_t)T * 4;
constexpr size_t WS_WF = WS_WIN + (size_t)DEPTH * 2560 * 1024 * 2;
constexpr size_t WS_WOUT = WS_WF + (size_t)DEPTH * 4 * 1024 * 4;
constexpr size_t WS_WQ = WS_WOUT + (size_t)DEPTH * 1024 * 1024 * 2;
constexpr size_t WS_KEYS = WS_WQ + (size_t)DEPTH * 2048 * 1024 * 2;
constexpr size_t WS_GLU = WS_KEYS + (size_t)DEPTH * 16 * 128 * 128 * 2;
constexpr size_t WS_TB = WS_GLU + (size_t)DEPTH * 256 * 256 * 2;
constexpr size_t WS_UT = al256(WS_TB + (size_t)8 * TBN * 4);
constexpr size_t WS_VT = WS_UT + (size_t)NEXP * D * 2;
constexpr size_t WS_US = WS_VT + (size_t)NEXP * D * 2;
constexpr size_t WS_VS = WS_US + (size_t)NEXP * 4;
constexpr size_t WS_FOXT = WS_VS + (size_t)NEXP * 4;
constexpr size_t WS_S5B = WS_FOXT + 256;
constexpr size_t WS_S5A = WS_S5B + (size_t)DEPTH * 16 * 2 * 64 * 16 * 2;
constexpr size_t WS_END = WS_S5A + (size_t)DEPTH * 16 * 64 * 16;
constexpr size_t WS_NV_TV = WS_SU;
constexpr size_t WS_NV_IDS = WS_DPART;
constexpr size_t WS_CIDX = WS_DPART;
constexpr size_t WS_CQ = WS_CIDX + (size_t)T * 128 * 2;
constexpr size_t WS_CSC = WS_CQ + (size_t)T * 128;
static_assert(WS_END <= (size_t)1024 * 1024 * 1024, "workspace map exceeds 1 GiB");
constexpr int CTL_BAR = 0;
constexpr int CTL_Q = 4096;

struct Args {
    const float* in[29];
    float* out;
    unsigned char* ws;
    int ph_lo, ph_hi;
    int use_bar, pad0;
};

__device__ __forceinline__ float bf2f(bf16_t v) { return __uint_as_float((unsigned)v << 16); }
__device__ __forceinline__ bf16_t f2bf(float f) { unsigned u = __float_as_uint(f); u += 0x7fffu + ((u >> 16) & 1u); return (bf16_t)(u >> 16); }
__device__ __forceinline__ unsigned pk2(float lo, float hi) { return (unsigned)f2bf(lo) | ((unsigned)f2bf(hi) << 16); }
__device__ __forceinline__ float gelu_tanh(float x) {
    const float u = 0.7978845608028654f * (x + 0.044715f * x * x * x);
    return x / (1.f + __expf(-2.f * u));
}
__device__ __forceinline__ float log_sigmoid(float x) { return x >= 0.f ? -log1pf(expf(-x)) : x - log1pf(expf(x)); }
__device__ __forceinline__ int t5_bucket(int dist) {
    int n = dist < 0 ? 0 : dist;
    float nf = (float)(n < 16 ? 16 : n);
    int large = 16 + (int)(logf(nf / 16.f) / logf(128.f) * 16.f);
    large = large < 31 ? large : 31;
    return n < 16 ? n : large;
}
__device__ __forceinline__ float wave_sum(float v) {
#pragma unroll
    for (int o = 32; o > 0; o >>= 1) v += __shfl_xor(v, o);
    return v;
}
__device__ __forceinline__ float half_swap_max(float m) {
    auto rr = __builtin_amdgcn_permlane32_swap(__float_as_uint(m), __float_as_uint(m), false, false);
    return fmaxf(__uint_as_float(rr[0]), __uint_as_float(rr[1]));
}
__device__ __forceinline__ float half_swap_sum(float m) {
    auto rr = __builtin_amdgcn_permlane32_swap(__float_as_uint(m), __float_as_uint(m), false, false);
    return __uint_as_float(rr[0]) + __uint_as_float(rr[1]);
}
}
namespace pg8 {
#define PG8_LAS __attribute__((address_space(3)))
typedef unsigned short bf16_t;
typedef short bf16x8 __attribute__((ext_vector_type(8)));
typedef float f32x4 __attribute__((ext_vector_type(4)));
typedef unsigned u32x4 __attribute__((ext_vector_type(4)));
constexpr int BM = 256, BK = 64, HALF = 128, HTB = HALF * BK * 2  , STAGE_BYTES = 8 * HTB, NXCD = 8, WGM = 8;

__host__ __device__ __forceinline__ int lds_byte(int r, int c) { const int st = (r >> 4) * 2 + (c >> 5), rr = r & 15, cc = c & 31, ob = rr * 64 + cc * 2; return st * 1024 + (ob ^ (((ob >> 9) & 1) << 5)); }
__host__ __device__ __forceinline__ void stage_rc(int b, int& R, int& C) { const int st = b / 1024, sb = b % 1024, swz = sb ^ (((sb >> 9) & 1) << 5); R = (st >> 1) * 16 + swz / 64; C = (st & 1) * 32 + (swz % 64) / 2; }
__host__ __device__ __forceinline__ int perm32(int rho) { const int n = rho >> 4, i = rho & 15; return 8 * (i >> 2) + 4 * n + (i & 3); }

struct Unit { int pm, pn; };
struct Gemm { const bf16_t* A; const bf16_t* Bt; int M, N, K; };

struct StaticOrder {
    int nM, nN, nwg, G, c;
    __host__ __device__ void init(int M, int N, int G_, int c_) { nM = M / BM; nN = N / BM; nwg = nM * nN; G = G_; c = c_; }
    __host__ __device__ bool next(int i, Unit& u) const {
        const long L = (long)i * G + c; if (L >= nwg) return false;
        int wgid = (int)L; { const int q = nwg / NXCD, r = nwg % NXCD, xcd = wgid % NXCD, off = wgid / NXCD; wgid = (xcd < r ? xcd * (q + 1) : r * (q + 1) + (xcd - r) * q) + off; }
        const int nig = WGM * nN, gid = wgid / nig, fm = gid * WGM, gsz = (nM - fm) < WGM ? (nM - fm) : WGM;
        u.pm = fm + ((wgid % nig) % gsz); u.pn = (wgid % nig) / gsz; return true;
    }
    __device__ __forceinline__ void a_ready(const Unit&) const {}
    __device__ __forceinline__ void done(const Unit&) const {}
};
typedef float f32x2e_t __attribute__((ext_vector_type(2))); typedef __bf16 bf16x2e_t __attribute__((ext_vector_type(2)));
__device__ __forceinline__ unsigned cvt_pk_bf16(float lo, float hi) { const f32x2e_t v = {lo, hi}; const bf16x2e_t b = __builtin_convertvector(v, bf16x2e_t); return __builtin_bit_cast(unsigned, b); }

struct EpiIn {
    static constexpr bool PERM = true, AFTER_DRAIN = false;
    bf16_t* zb; float* su32; const float* rstd;
    const float* g_fq; const float* g_fk; const float* g_dq; const float* g_dk; const float* g_cq; const float* g_ck;
    __device__ __forceinline__ void operator()(const f32x4 (&acc)[2][2][4][2], const Unit& u, int wr, int wc, int fr, int fq) const {
        const int pn = u.pn;
        const int mode = (pn == 0 || pn == 1 || pn == 3 || pn == 4) ? 1 : ((pn == 6 || pn == 7) ? 2 : (pn == 9 ? 3 : 0));
        const float* gp = pn == 0 ? g_fq : pn == 1 ? g_fk : pn == 3 ? g_dq : pn == 4 ? g_dk : pn == 6 ? g_cq : g_ck;
        const float qs = (pn == 0 || pn == 3) ? 0.125f * 1.4426950408889634f : (pn == 6 ? 0.17677669529663687f * 1.4426950408889634f : 1.f);
        f32x4 gv[2][2];
#pragma unroll
        for (int bj = 0; bj < 2; ++bj)
#pragma unroll
            for (int n = 0; n < 2; ++n) {
                if (mode == 1) gv[bj][n] = *(const f32x4*)(gp + 32 * bj + 8 * fq + 4 * n) * qs;
                else if (mode == 2) gv[bj][n] = *(const f32x4*)(gp + 8 * fq + 4 * n) * qs;
                else gv[bj][n] = (f32x4){1.f, 1.f, 1.f, 1.f};
            }
#pragma unroll
        for (int ai = 0; ai < 2; ++ai)
#pragma unroll
            for (int m = 0; m < 4; ++m) {
                const int row = u.pm * BM + ai * HALF + wr * 64 + m * 16 + fr;
                const float rs = rstd[row];
                f32x4 v[2][2];
                float ss[2];
#pragma unroll
                for (int bj = 0; bj < 2; ++bj) {
                    float s = 0.f;
#pragma unroll
                    for (int n = 0; n < 2; ++n) { v[bj][n] = acc[ai][bj][m][n] * rs; const f32x4 x = v[bj][n]; s += (x[0] * x[0] + x[1] * x[1]) + (x[2] * x[2] + x[3] * x[3]); }
                    ss[bj] = s;
                }
                if (mode == 1 || mode == 2) {
                    float s0 = ss[0], s1 = ss[1];
                    s0 += __shfl_xor(s0, 16); s0 += __shfl_xor(s0, 32); s1 += __shfl_xor(s1, 16); s1 += __shfl_xor(s1, 32);
                    float r0, r1;
                    if (mode == 1) { r0 = __builtin_amdgcn_rsqf((s0 + s1) * (1.f / 64.f) + 1e-6f); r1 = r0; }
                    else { r0 = __builtin_amdgcn_rsqf(s0 * (1.f / 32.f) + 1e-6f); r1 = __builtin_amdgcn_rsqf(s1 * (1.f / 32.f) + 1e-6f); }
#pragma unroll
                    for (int n = 0; n < 2; ++n) { v[0][n] = v[0][n] * r0 * gv[0][n]; v[1][n] = v[1][n] * r1 * gv[1][n]; }
                }
                if (mode == 3) {
                    bf16_t* op = (bf16_t*)su32 + (size_t)row * 256 + 64 * wc + 8 * fq;
#pragma unroll
                    for (int bj = 0; bj < 2; ++bj) { u32x4 w; w.x = cvt_pk_bf16(v[bj][0][0], v[bj][0][1]); w.y = cvt_pk_bf16(v[bj][0][2], v[bj][0][3]); w.z = cvt_pk_bf16(v[bj][1][0], v[bj][1][1]); w.w = cvt_pk_bf16(v[bj][1][2], v[bj][1][3]);
                        *(u32x4*)(op + 32 * bj) = w; }
                } else {
                    bf16_t* op = zb + (size_t)row * 2304 + pn * 256 + 64 * wc + 8 * fq;
#pragma unroll
                    for (int bj = 0; bj < 2; ++bj) { u32x4 w; w.x = cvt_pk_bf16(v[bj][0][0], v[bj][0][1]); w.y = cvt_pk_bf16(v[bj][0][2], v[bj][0][3]); w.z = cvt_pk_bf16(v[bj][1][0], v[bj][1][1]); w.w = cvt_pk_bf16(v[bj][1][2], v[bj][1][3]);
                        *(u32x4*)(op + 32 * bj) = w; }
                }
            }
    }
};
struct EpiOut {
    static constexpr bool PERM = true, AFTER_DRAIN = false;
    bf16_t* xb;
    __device__ __forceinline__ void operator()(const f32x4 (&acc)[2][2][4][2], const Unit& u, int wr, int wc, int fr, int fq) const {
#pragma unroll
        for (int ai = 0; ai < 2; ++ai)
#pragma unroll
            for (int m = 0; m < 4; ++m) {
                const int row = u.pm * BM + ai * HALF + wr * 64 + m * 16 + fr;
#pragma unroll
                for (int bj = 0; bj < 2; ++bj) {
                    const size_t off = (size_t)row * 1024 + u.pn * BM + bj * HALF + wc * 32 + 8 * fq;
                    const u32x4 o = *(const u32x4*)(xb + off);
                    const f32x4 a0 = acc[ai][bj][m][0], a1 = acc[ai][bj][m][1];
                    u32x4 w;
                    w.x = cvt_pk_bf16(__uint_as_float(o.x << 16) + a0[0], __uint_as_float(o.x & 0xffff0000u) + a0[1]);
                    w.y = cvt_pk_bf16(__uint_as_float(o.y << 16) + a0[2], __uint_as_float(o.y & 0xffff0000u) + a0[3]);
                    w.z = cvt_pk_bf16(__uint_as_float(o.z << 16) + a1[0], __uint_as_float(o.z & 0xffff0000u) + a1[1]);
                    w.w = cvt_pk_bf16(__uint_as_float(o.w << 16) + a1[2], __uint_as_float(o.w & 0xffff0000u) + a1[3]);
                    *(u32x4*)(xb + off) = w;
                }
            }
    }
};
struct EpiPlain {
    static constexpr bool PERM = true, AFTER_DRAIN = false;
    bf16_t* O; int ldc;
    __device__ __forceinline__ void operator()(const f32x4 (&acc)[2][2][4][2], const Unit& u, int wr, int wc, int fr, int fq) const {
#pragma unroll
        for (int ai = 0; ai < 2; ++ai)
#pragma unroll
            for (int m = 0; m < 4; ++m) {
                const int row = u.pm * BM + ai * HALF + wr * 64 + m * 16 + fr;
#pragma unroll
                for (int bj = 0; bj < 2; ++bj) {
                    const size_t off = (size_t)row * ldc + u.pn * BM + bj * HALF + wc * 32 + 8 * fq;
                    const f32x4 a = acc[ai][bj][m][0], b = acc[ai][bj][m][1];
                    u32x4 w; w.x = cvt_pk_bf16(a[0], a[1]); w.y = cvt_pk_bf16(a[2], a[3]); w.z = cvt_pk_bf16(b[0], b[1]); w.w = cvt_pk_bf16(b[2], b[3]);
                    *(u32x4*)(O + off) = w;
                }
            }
    }
};
typedef _Float16 f16x2e_t __attribute__((ext_vector_type(2)));
__device__ __forceinline__ unsigned cvt_pk_f16(float lo, float hi) { const f32x2e_t v = {lo, hi}; const f16x2e_t b = __builtin_convertvector(v, f16x2e_t); return __builtin_bit_cast(unsigned, b); }
struct EpiF16 {
    static constexpr bool PERM = true, AFTER_DRAIN = false;
    bf16_t* O; int ldc;
    __device__ __forceinline__ void operator()(const f32x4 (&acc)[2][2][4][2], const Unit& u, int wr, int wc, int fr, int fq) const {
#pragma unroll
        for (int ai = 0; ai < 2; ++ai)
#pragma unroll
            for (int m = 0; m < 4; ++m) {
                const int row = u.pm * BM + ai * HALF + wr * 64 + m * 16 + fr;
#pragma unroll
                for (int bj = 0; bj < 2; ++bj) {
                    const size_t off = (size_t)row * ldc + u.pn * BM + bj * HALF + wc * 32 + 8 * fq;
                    const f32x4 a = acc[ai][bj][m][0], b = acc[ai][bj][m][1];
                    u32x4 w; w.x = cvt_pk_f16(a[0], a[1]); w.y = cvt_pk_f16(a[2], a[3]); w.z = cvt_pk_f16(b[0], b[1]); w.w = cvt_pk_f16(b[2], b[3]);
                    *(u32x4*)(O + off) = w;
                }
            }
    }
};
template <class Epi, class Sched, bool ALIGN_EPI = false, bool SP2 = false>
__device__ __forceinline__ void gemm_phase(PG8_LAS unsigned char* lds, const Gemm g, const Sched& S, const Epi& E) {
    const int tid = threadIdx.x, wid = __builtin_amdgcn_readfirstlane(tid >> 6), lane = tid & 63, wr = wid >> 2, wc = wid & 3, fr = lane & 15, fq = lane >> 4;
    const int K = g.K, nt = K / BK;
    unsigned voffA[2], voffB[2];
#pragma unroll
    for (int i = 0; i < 2; ++i) { int R, C; stage_rc(tid * 16 + i * 8192, R, C); const int Rb = Epi::PERM ? ((R & ~31) + perm32(R & 31)) : R;
        voffA[i] = (unsigned)(R * K + C) * 2u; voffB[i] = (unsigned)(Rb * K + C) * 2u; }
    const size_t kstep = (size_t)(BK * 2);
    const size_t hstep = (size_t)HALF * K * 2;
    const size_t tstep = 2 * hstep;
    const unsigned ldsw = (unsigned)wid * 1024u;
    const int aoff = lds_byte(wr * 64 + fr, fq * 8), boff = lds_byte(wc * 32 + fr, fq * 8);
#define PG8_SA(b, h) (((b) * 2 + (h)) * HTB)
#define PG8_SB(b, h) ((4 + (b) * 2 + (h)) * HTB)
#define PG8_STAGE(bufoff, gbase, voff) do { _Pragma("unroll") for (int _i = 0; _i < 2; ++_i) \
        __builtin_amdgcn_global_load_lds((const unsigned*)((const char*)(gbase) + (voff)[_i]), (PG8_LAS unsigned*)(lds + (bufoff) + ldsw + _i * 8192), 16, 0, 0); } while (0)
#define PG8_LDA(dst, b, h) do { _Pragma("unroll") for (int m = 0; m < 4; ++m) _Pragma("unroll") for (int k = 0; k < 2; ++k) dst[m][k] = *(const PG8_LAS bf16x8*)(lds + PG8_SA(b, h) + aoff + m * 2048 + k * 1024); } while (0)
#define PG8_LDB(dst, b, h) do { _Pragma("unroll") for (int n = 0; n < 2; ++n) _Pragma("unroll") for (int k = 0; k < 2; ++k) dst[n][k] = *(const PG8_LAS bf16x8*)(lds + PG8_SB(b, h) + boff + n * 2048 + k * 1024); } while (0)
#define PG8_MMA(ai, bj, At, Bt) do { __builtin_amdgcn_s_setprio(1); _Pragma("unroll") for (int m = 0; m < 4; ++m) _Pragma("unroll") for (int n = 0; n < 2; ++n) _Pragma("unroll") for (int k = 0; k < 2; ++k) \
        acc[ai][bj][m][n] = __builtin_amdgcn_mfma_f32_16x16x32_bf16(Bt[n][k], At[m][k], acc[ai][bj][m][n], 0, 0, 0); __builtin_amdgcn_s_setprio(0); } while (0)
#define PG8_WAIT_V(n) asm volatile("s_waitcnt vmcnt(" #n ")" ::: "memory")
#define PG8_WAIT_L(n) asm volatile("s_waitcnt lgkmcnt(" #n ")" ::: "memory")
#define PG8_BAR __builtin_amdgcn_s_barrier()
#define PG8_SCHED __builtin_amdgcn_sched_barrier(0)
    Unit cur, nxt; int ui = 0;
    if (!S.next(0, cur)) return;
    f32x4 acc[2][2][4][2];
#pragma unroll
    for (int a = 0; a < 2; ++a)
#pragma unroll
        for (int b = 0; b < 2; ++b)
#pragma unroll
            for (int m = 0; m < 4; ++m)
#pragma unroll
                for (int n = 0; n < 2; ++n) acc[a][b][m][n] = (f32x4){0.f, 0.f, 0.f, 0.f};
    bf16x8 At[4][2], B0[2][2], B1[2][2];
    const char* cA = (const char*)g.A + (size_t)cur.pm * tstep; const char* cB = (const char*)g.Bt + (size_t)cur.pn * tstep;
    S.a_ready(cur);
    if constexpr (SP2) {
        PG8_STAGE(PG8_SB(0, 0), cB, voffB); PG8_STAGE(PG8_SB(0, 1), cB + hstep, voffB); PG8_STAGE(PG8_SA(0, 0), cA, voffA); PG8_STAGE(PG8_SA(0, 1), cA + hstep, voffA);
        if (wr == 1) PG8_BAR;
        PG8_WAIT_V(2); PG8_BAR;
        PG8_STAGE(PG8_SB(1, 0), cB + kstep, voffB); PG8_STAGE(PG8_SA(1, 0), cA + kstep, voffA); PG8_STAGE(PG8_SB(1, 1), cB + hstep + kstep, voffB);
        PG8_WAIT_V(6); PG8_BAR;
    } else {
        PG8_STAGE(PG8_SB(0, 0), cB, voffB); PG8_STAGE(PG8_SA(0, 0), cA, voffA); PG8_STAGE(PG8_SB(0, 1), cB + hstep, voffB); PG8_STAGE(PG8_SA(0, 1), cA + hstep, voffA);
        if (wr == 1) PG8_BAR;
        PG8_WAIT_V(4); PG8_BAR;
        PG8_STAGE(PG8_SB(1, 0), cB + kstep, voffB); PG8_STAGE(PG8_SA(1, 0), cA + kstep, voffA); PG8_STAGE(PG8_SB(1, 1), cB + hstep + kstep, voffB);
        PG8_WAIT_V(6); PG8_BAR;
    }
    for (;;) {
        const bool has_next = S.next(ui + 1, nxt);
        const char* nA = has_next ? (const char*)g.A + (size_t)nxt.pm * tstep : cA; const char* nB = has_next ? (const char*)g.Bt + (size_t)nxt.pn * tstep : cB;
        for (int t = 0; t < nt; t += 2) {
            const bool last = (t == nt - 2);
            const char* a1 = cA + (size_t)(t + 1) * kstep;
            const char* a2 = last ? nA : cA + (size_t)(t + 2) * kstep; const char* b2 = last ? nB : cB + (size_t)(t + 2) * kstep;
            const char* a3 = a2 + kstep; const char* b3 = b2 + kstep;
            if (last && has_next) S.a_ready(nxt);
            if constexpr (SP2) {
            PG8_LDB(B0, 0, 0); PG8_LDB(B1, 0, 1); PG8_SCHED; PG8_LDA(At, 0, 0); PG8_STAGE(PG8_SA(1, 1), a1 + hstep, voffA);
            PG8_WAIT_V(8); PG8_WAIT_L(0); PG8_BAR; PG8_MMA(0, 0, At, B0); PG8_MMA(0, 1, At, B1); PG8_BAR; PG8_SCHED;
            PG8_LDA(At, 0, 1); PG8_STAGE(PG8_SB(0, 0), b2, voffB); PG8_STAGE(PG8_SB(0, 1), b2 + hstep, voffB); PG8_STAGE(PG8_SA(0, 0), a2, voffA);
            PG8_WAIT_V(8); PG8_WAIT_L(0); PG8_BAR; PG8_MMA(1, 0, At, B0); PG8_MMA(1, 1, At, B1); PG8_BAR; PG8_SCHED;
            PG8_LDB(B0, 1, 0); PG8_LDB(B1, 1, 1); PG8_SCHED; PG8_LDA(At, 1, 0); PG8_STAGE(PG8_SA(0, 1), a2 + hstep, voffA);
            PG8_WAIT_V(8); PG8_WAIT_L(0); PG8_BAR; PG8_MMA(0, 0, At, B0); PG8_MMA(0, 1, At, B1); PG8_BAR; PG8_SCHED;
            PG8_LDA(At, 1, 1); PG8_STAGE(PG8_SB(1, 0), b3, voffB); PG8_STAGE(PG8_SB(1, 1), b3 + hstep, voffB); PG8_STAGE(PG8_SA(1, 0), a3, voffA);
            PG8_WAIT_V(8); PG8_WAIT_L(0); PG8_BAR; PG8_MMA(1, 0, At, B0); PG8_MMA(1, 1, At, B1); PG8_BAR; PG8_SCHED;
            } else {
            PG8_LDB(B0, 0, 0); PG8_SCHED; PG8_LDA(At, 0, 0); PG8_STAGE(PG8_SA(1, 1), a1 + hstep, voffA);
            PG8_WAIT_L(8); PG8_BAR; PG8_WAIT_L(0); PG8_MMA(0, 0, At, B0); PG8_BAR; PG8_SCHED;
            PG8_LDB(B1, 0, 1); PG8_STAGE(PG8_SB(0, 0), b2, voffB);
            PG8_BAR; PG8_WAIT_L(0); PG8_MMA(0, 1, At, B1); PG8_BAR;
            PG8_LDA(At, 0, 1); PG8_STAGE(PG8_SA(0, 0), a2, voffA);
            PG8_BAR; PG8_WAIT_L(0); PG8_MMA(1, 0, At, B0); PG8_BAR; PG8_SCHED;
            PG8_STAGE(PG8_SB(0, 1), b2 + hstep, voffB);
            PG8_WAIT_V(6); PG8_BAR; PG8_MMA(1, 1, At, B1); PG8_BAR;
            PG8_LDB(B0, 1, 0); PG8_SCHED; PG8_LDA(At, 1, 0); PG8_STAGE(PG8_SA(0, 1), a2 + hstep, voffA);
            PG8_WAIT_L(8); PG8_BAR; PG8_WAIT_L(0); PG8_MMA(0, 0, At, B0); PG8_BAR; PG8_SCHED;
            PG8_LDB(B1, 1, 1); PG8_STAGE(PG8_SB(1, 0), b3, voffB);
            PG8_BAR; PG8_WAIT_L(0); PG8_MMA(0, 1, At, B1); PG8_BAR;
            PG8_LDA(At, 1, 1); PG8_STAGE(PG8_SA(1, 0), a3, voffA);
            PG8_BAR; PG8_WAIT_L(0); PG8_MMA(1, 0, At, B0); PG8_BAR; PG8_SCHED;
            PG8_STAGE(PG8_SB(1, 1), b3 + hstep, voffB);
            PG8_WAIT_V(6); PG8_BAR; PG8_MMA(1, 1, At, B1); PG8_BAR;
            }
        }
        if constexpr (ALIGN_EPI) { if (wr == 0) PG8_BAR; }
        if constexpr (!Epi::AFTER_DRAIN) { E(acc, cur, wr, wc, fr, fq); S.done(cur); }
        if (!has_next) break;
#pragma unroll
        for (int a = 0; a < 2; ++a)
#pragma unroll
            for (int b = 0; b < 2; ++b)
#pragma unroll
                for (int m = 0; m < 4; ++m)
#pragma unroll
                    for (int n = 0; n < 2; ++n) acc[a][b][m][n] = (f32x4){0.f, 0.f, 0.f, 0.f};
        cur = nxt; cA = nA; cB = nB; ++ui;
        if constexpr (ALIGN_EPI) { if (wr == 1) PG8_BAR; }
    }
    PG8_WAIT_V(0);
    if constexpr (!ALIGN_EPI) { if (wr == 0) PG8_BAR; }
    PG8_BAR;
    if constexpr (Epi::AFTER_DRAIN) { E.fused(acc, cur, wr, wc, fr, fq, lds, wid, lane); S.done(cur); }
#undef PG8_SA
#undef PG8_SB
#undef PG8_STAGE
#undef PG8_LDA
#undef PG8_LDB
#undef PG8_MMA
#undef PG8_WAIT_V
#undef PG8_WAIT_L
#undef PG8_BAR
#undef PG8_SCHED
}
}
#define XB_TMO      128
#define XB_XCNT(j)  (256  + 64 * (j))
#define XB_XSUB(j)  (1280 + 64 * (j))
#define XB_XGEN(j)  (2304 + 64 * (j))
#define XB_TOP      3328
#define XB_TOPGEN   3392
#define XCD_BAR_WORDS 3456
#define XB_SPIN_CAP (1u << 18)
#define LAS __attribute__((address_space(3)))

__device__ __forceinline__ unsigned xb_ld(unsigned* p)              { return __hip_atomic_load(p, __ATOMIC_RELAXED, __HIP_MEMORY_SCOPE_AGENT); }
__device__ __forceinline__ unsigned xb_add(unsigned* p, unsigned v) { return __hip_atomic_fetch_add(p, v, __ATOMIC_RELAXED, __HIP_MEMORY_SCOPE_AGENT); }
__device__ __forceinline__ unsigned xb_xcc_id() { return (unsigned)__builtin_amdgcn_s_getreg((3 << 11) | 20) & 0xFu; }
#define XB_SPIN(cond, bar) do { unsigned _sp = 0; while (cond) { __builtin_amdgcn_s_sleep(1); \
    if ((++_sp & 255u) == 0u) { if (xb_ld(&(bar)[XB_TMO])) break; if (_sp > XB_SPIN_CAP) { atomicAdd(&(bar)[XB_TMO], 1u); break; } } } } while (0)

struct XcdBarrier {
    unsigned* bar; unsigned x;
    volatile LAS unsigned* st;
};

__device__ __forceinline__ XcdBarrier xcd_barrier_post(unsigned* bar, volatile LAS unsigned* st) {
    XcdBarrier b; b.bar = bar; b.x = xb_xcc_id(); b.st = st;
    if (threadIdx.x == 0) (void)xb_add(&bar[XB_XCNT(b.x)], 1u);
    return b;
}
__device__ __forceinline__ void xcd_barrier_complete(unsigned* bar, unsigned x, unsigned& nloc, unsigned& nx) {
    const unsigned G = gridDim.x * gridDim.y * gridDim.z;
    unsigned sum, cnt, mine, sp = 0u;
    for (;;) {
        sum = 0u; cnt = 0u; mine = 0u;
#pragma unroll
        for (unsigned j = 0; j < 16; ++j) { const unsigned c = xb_ld(&bar[XB_XCNT(j)]); sum += c; cnt += (c > 0u) ? 1u : 0u; mine = (j == x) ? c : mine; }
        if (sum == G) break;
        __builtin_amdgcn_s_sleep(1);
        if ((++sp & 255u) == 0u) { if (xb_ld(&bar[XB_TMO])) break; if (sp > XB_SPIN_CAP) { atomicAdd(&bar[XB_TMO], 1u); break; } }
    }
    nloc = mine > 0u ? mine : 1u; nx = cnt > 0u ? cnt : 1u;
}

__device__ __forceinline__ void xcd_barrier(const XcdBarrier& b) {
    asm volatile("s_waitcnt vmcnt(0)" ::: "memory");
    __syncthreads();
    if (threadIdx.x == 0) {
        unsigned* bar = b.bar;
        __builtin_amdgcn_s_waitcnt(0);
        unsigned nloc = b.st[0], nx = b.st[1];
        if (nloc == 0u) { xcd_barrier_complete(bar, b.x, nloc, nx); b.st[0] = nloc; b.st[1] = nx; }
        const unsigned old = xb_add(&bar[XB_XSUB(b.x)], 1u);
        const unsigned gen = old / nloc;
        if (old + 1u == (gen + 1u) * nloc) {
            __builtin_amdgcn_fence(__ATOMIC_RELEASE, "agent");
            asm volatile("s_waitcnt vmcnt(0)" ::: "memory");
            const unsigned og = xb_add(&bar[XB_TOP], 1u);
            const unsigned tg = og / nx;
            if (og + 1u == (tg + 1u) * nx) xb_add(&bar[XB_TOPGEN], 1u);
            else XB_SPIN(xb_ld(&bar[XB_TOPGEN]) == tg, bar);
            __builtin_amdgcn_fence(__ATOMIC_ACQUIRE, "agent");
            xb_add(&bar[XB_XGEN(b.x)], 1u);
            asm volatile("s_waitcnt vmcnt(0)" ::: "memory");
        } else {
            XB_SPIN(xb_ld(&bar[XB_XGEN(b.x)]) == gen, bar);
            __builtin_amdgcn_fence(__ATOMIC_ACQUIRE, "agent");
            asm volatile("s_waitcnt vmcnt(0)" ::: "memory");
        }
    }
    __syncthreads();
}
namespace hk {
__device__ __forceinline__ int inproj_src_col(int np) {
    const int pn = np >> 8, p = np & 255, bj = p >> 7, wc = (p >> 5) & 3, i = p & 31;
    const int nl = pn * 256 + 64 * wc + 32 * bj + i;
    return nl < 768 ? nl : nl + 4;
}
template <bool INMAP>
__device__ __forceinline__ void tr_tile(const float* __restrict__ src, int ld, const float* __restrict__ g, bf16_t* __restrict__ dst, int K, int k0, int n0, float* lds) {
    const int tid = threadIdx.x;
#pragma unroll
    for (int i = 0; i < 8; ++i) {
        const int idx = tid + 512 * i, kk = idx >> 6, nn = idx & 63;
        const int col = INMAP ? inproj_src_col(n0 + nn) : (n0 + nn);
        float v = src[(size_t)(k0 + kk) * ld + col];
        if (g) v *= g[k0 + kk];
        lds[nn * 65 + kk] = v;
    }
    __syncthreads();
#pragma unroll
    for (int i = 0; i < 8; ++i) {
        const int idx = tid + 512 * i, nn = idx >> 6, kk = idx & 63;
        dst[(size_t)(n0 + nn) * K + k0 + kk] = f2bf(lds[nn * 65 + kk]);
    }
    __syncthreads();
}
template <bool INMAP>
__device__ __forceinline__ void tr_load(const float* __restrict__ src, int ld, const float* __restrict__ g, int k0, int n0, float (&v)[8]) {
    const int tid = threadIdx.x;
#pragma unroll
    for (int i = 0; i < 8; ++i) {
        const int idx = tid + 512 * i, kk = idx >> 6, nn = idx & 63;
        const int col = INMAP ? inproj_src_col(n0 + nn) : (n0 + nn);
        v[i] = src[(size_t)(k0 + kk) * ld + col];
        if (g) v[i] *= g[k0 + kk];
    }
}
__device__ __forceinline__ void tr_store(const float (&v)[8], bf16_t* __restrict__ dst, int K, int k0, int n0, float* lds) {
    const int tid = threadIdx.x;
#pragma unroll
    for (int i = 0; i < 8; ++i) { const int idx = tid + 512 * i, kk = idx >> 6, nn = idx & 63; lds[nn * 65 + kk] = v[i]; }
    __syncthreads();
#pragma unroll
    for (int i = 0; i < 8; ++i) {
        const int idx = tid + 512 * i, nn = idx >> 6, kk = idx & 63;
        dst[(size_t)(n0 + nn) * K + k0 + kk] = f2bf(lds[nn * 65 + kk]);
    }
    __syncthreads();
}
__device__ __forceinline__ void fold_keys_tile(const float* __restrict__ wq, const float* __restrict__ keys, const float* __restrict__ g, bf16_t* __restrict__ dst, int hp, int k0, float* lds) {
    const int tid = threadIdx.x, lane = tid & 63, w = tid >> 6, qi = lane & 31, hi = lane >> 5;
    const int ab = w >> 2, kb = w & 3;
    const float* ap = wq + (size_t)(k0 + 32 * ab + qi) * 2048 + hp * 128 + 8 * hi;
    const float* bp = keys + ((size_t)hp * 128 + 32 * kb + qi) * 128 + 8 * hi;
    f32x16 acc = (f32x16){};
#pragma unroll
    for (int h4 = 0; h4 < 2; ++h4) {
        f32x4 av[4][2], bv[4][2];
#pragma unroll
        for (int s = 0; s < 4; ++s) { const int d0 = 16 * (4 * h4 + s);
            av[s][0] = *(const f32x4*)(ap + d0); av[s][1] = *(const f32x4*)(ap + d0 + 4); bv[s][0] = *(const f32x4*)(bp + d0); bv[s][1] = *(const f32x4*)(bp + d0 + 4); }
#pragma unroll
        for (int s = 0; s < 4; ++s) {
            u32x4 pa, pb;
            pa.x = pk2(av[s][0][0], av[s][0][1]); pa.y = pk2(av[s][0][2], av[s][0][3]); pa.z = pk2(av[s][1][0], av[s][1][1]); pa.w = pk2(av[s][1][2], av[s][1][3]);
            pb.x = pk2(bv[s][0][0], bv[s][0][1]); pb.y = pk2(bv[s][0][2], bv[s][0][3]); pb.z = pk2(bv[s][1][0], bv[s][1][1]); pb.w = pk2(bv[s][1][2], bv[s][1][3]);
            acc = __builtin_amdgcn_mfma_f32_32x32x16_bf16(__builtin_bit_cast(bf16x8, pa), __builtin_bit_cast(bf16x8, pb), acc, 0, 0, 0);
        }
    }
    bf16_t* op = dst + (size_t)(hp * 128 + 32 * kb + qi) * 1024 + k0 + 32 * ab + 4 * hi;
    const float* gp = g + k0 + 32 * ab + 4 * hi;
#pragma unroll
    for (int q = 0; q < 4; ++q) {
        const f32x4 gg = *(const f32x4*)(gp + 8 * q);
        u32x2 o; o.x = pk2(acc[4 * q] * gg[0], acc[4 * q + 1] * gg[1]); o.y = pk2(acc[4 * q + 2] * gg[2], acc[4 * q + 3] * gg[3]);
        *(u32x2*)(op + 8 * q) = o;
    }
}
__device__ __forceinline__ void phase_weights(const Args& a, unsigned char* ldsb) {
    float* lds = (float*)ldsb;
    const int G = gridDim.x, bid = blockIdx.x, tid = threadIdx.x;
    const float* w_in = a.in[1]; const float* w_out = a.in[3]; const float* norm_mix = a.in[4]; const float* norm_ffn = a.in[5];
    const float* glu_w = a.in[23]; const float* wq = a.in[25]; const float* keys = a.in[26]; const float* relb = a.in[14];
    bf16_t* WIN = (bf16_t*)(a.ws + WS_WIN); bf16_t* WOUT = (bf16_t*)(a.ws + WS_WOUT); bf16_t* WQ = (bf16_t*)(a.ws + WS_WQ); bf16_t* GLU = (bf16_t*)(a.ws + WS_GLU);
#if HK_FOLD_KEYS
    {
        float v[8], vn[8];
        int q = bid;
#define PW_IN(q_, vv) do { const int l_ = (q_) / 640, r_ = (q_) % 640; tr_load<true>(w_in + (size_t)l_ * D * INW, INW, norm_mix + l_ * D, (r_ & 15) * 64, (r_ >> 4) * 64, vv); } while (0)
        if (q < DEPTH * 640) PW_IN(q, v);
        for (; q < DEPTH * 640; q += G) {
            const int qn = q + G; if (qn < DEPTH * 640) PW_IN(qn, vn);
            const int l = q / 640, r = q % 640;
            tr_store(v, WIN + (size_t)l * 2560 * 1024, 1024, (r & 15) * 64, (r >> 4) * 64, lds);
#pragma unroll
            for (int i = 0; i < 8; ++i) v[i] = vn[i];
        }
#undef PW_IN
        q = bid;
#define PW_OUT(q_, vv) do { const int l_ = (q_) >> 8, r_ = (q_) & 255; tr_load<false>(w_out + (size_t)l_ * D * D, D, nullptr, (r_ & 15) * 64, (r_ >> 4) * 64, vv); } while (0)
        if (q < DEPTH * 256) PW_OUT(q, v);
        for (; q < DEPTH * 256; q += G) {
            const int qn = q + G; if (qn < DEPTH * 256) PW_OUT(qn, vn);
            const int l = q >> 8, r = q & 255;
            tr_store(v, WOUT + (size_t)l * 1024 * 1024, 1024, (r & 15) * 64, (r >> 4) * 64, lds);
#pragma unroll
            for (int i = 0; i < 8; ++i) v[i] = vn[i];
        }
#undef PW_OUT
    }
    for (int u = bid; u < DEPTH * 16; u += G) { const int l = u >> 4, r = u & 15; tr_tile<false>(glu_w + (size_t)l * 65536, 256, nullptr, GLU + (size_t)l * 65536, 256, (r & 3) * 64, (r >> 2) * 64, lds); }
    for (int u = bid; u < DEPTH * 256; u += G) { const int l = u >> 8, r = u & 255;
        fold_keys_tile(wq + (size_t)l * D * 2048, keys + (size_t)l * 16 * 128 * 128, norm_ffn + l * D, WQ + (size_t)l * 2048 * 1024, r >> 4, (r & 15) * 64, lds); }
#else
    for (int u = bid; u < DEPTH * 1424; u += G) {
        const int l = u / 1424; int r = u % 1424;
        if (r < 640) { const int nt = r >> 4, kt = r & 15; tr_tile<true>(w_in + (size_t)l * D * INW, INW, norm_mix + l * D, WIN + (size_t)l * 2560 * 1024, 1024, kt * 64, nt * 64, lds); }
        else if (r < 896) { r -= 640; const int nt = r >> 4, kt = r & 15; tr_tile<false>(w_out + (size_t)l * D * D, D, nullptr, WOUT + (size_t)l * 1024 * 1024, 1024, kt * 64, nt * 64, lds); }
        else if (r < 1408) { r -= 896;
#if HK_FOLD_KEYS
            if (r < 256) fold_keys_tile(wq + (size_t)l * D * 2048, keys + (size_t)l * 16 * 128 * 128, norm_ffn + l * D, WQ + (size_t)l * 2048 * 1024, r >> 4, (r & 15) * 64, lds);
#else
            const int nt = r >> 4, kt = r & 15; tr_tile<false>(wq + (size_t)l * D * 2048, 2048, norm_ffn + l * D, WQ + (size_t)l * 2048 * 1024, 1024, kt * 64, nt * 64, lds);
#endif
        }
        else { r -= 1408; const int nt = r >> 2, kt = r & 3; tr_tile<false>(glu_w + (size_t)l * 65536, 256, nullptr, GLU + (size_t)l * 65536, 256, kt * 64, nt * 64, lds); }
    }
#endif
    const int gt = bid * NTHR + tid, gn = G * NTHR;
    float* WF = (float*)(a.ws + WS_WF);
    for (int i = gt; i < DEPTH * 4 * 1024; i += gn) { const int l = i >> 12, h = (i >> 10) & 3, k = i & 1023; WF[i] = norm_mix[l * D + k] * w_in[((size_t)l * D + k) * INW + 768 + h]; }
#if !HK_FOLD_KEYS
    bf16_t* KB = (bf16_t*)(a.ws + WS_KEYS);
    for (int i = gt; i < DEPTH * 16 * 128 * 128; i += gn) KB[i] = f2bf(keys[i]);
#endif
    if (gt < DEPTH) { float gq = 0.f, gk = 0.f; for (int i = 0; i < 64; ++i) { gq = fmaxf(gq, fabsf(a.in[6][gt * 64 + i])); gk = fmaxf(gk, fabsf(a.in[7][gt * 64 + i])); }
        ((float*)(a.ws + WS_FOXT))[gt] = 2.f * 1.02f * 0.125f * LOG2E * 64.f * gq * gk + 40.f; }
#ifndef HK_T_NOS5TAB
    for (int i = gt; i < DEPTH * 16 * 64; i += gn) {
        const int lg = i >> 6, st = i & 63;
        const float dt = expf(a.in[17][lg]);
        const float ar = a.in[15][lg * 64 + st], ai = a.in[16][lg * 64 + st];
        const float dtar = dt * ar, dtai = dt * ai, mag = expf(dtar);
        const float abr = mag * cosf(dtai), abi = mag * sinf(dtai);
        const float den = ar * ar + ai * ai, nr = abr - 1.f, ni = abi;
        const float cr = (nr * ar + ni * ai) / den, ci = (ni * ar - nr * ai) / den;
        const float mg = expf(64.f * dtar);
        ((f32x4*)(a.ws + WS_S5A))[i] = (f32x4){abr, abi, mg * cosf(64.f * dtai), mg * sinf(64.f * dtai)};
        const float* brp = a.in[18] + ((size_t)lg * 64 + st) * 16; const float* bip = a.in[19] + ((size_t)lg * 64 + st) * 16;
        bf16_t* ore = (bf16_t*)(a.ws + WS_S5B) + ((size_t)(lg * 2) * 64 + st) * 16; bf16_t* oim = ore + 64 * 16;
        for (int c = 0; c < 16; ++c) { const float br = brp[c], bi = bip[c]; ore[c] = f2bf(cr * br - ci * bi); oim[c] = f2bf(cr * bi + ci * br); }
    }
#endif
    float* TB = (float*)(a.ws + WS_TB);
    for (int i = gt; i < 8 * TBN; i += gn) { const int hh = i / TBN, d = i % TBN; TB[i] = relb[t5_bucket(d) * 8 + hh] * LOG2E; }
}

__device__ __forceinline__ void load_row16(const float* __restrict__ p, int lane, float (&xv)[16]) {
#pragma unroll
    for (int j = 0; j < 4; ++j) { const f32x4 t = *(const f32x4*)(p + 16 * lane + 4 * j); xv[4 * j] = t[0]; xv[4 * j + 1] = t[1]; xv[4 * j + 2] = t[2]; xv[4 * j + 3] = t[3]; }
}
__device__ __forceinline__ void load_row16_bf(const bf16_t* __restrict__ p, int slot, float (&xv)[16]) {
    const u32x4 a = *(const u32x4*)(p + 16 * slot), b = *(const u32x4*)(p + 16 * slot + 8);
#pragma unroll
    for (int j = 0; j < 4; ++j) { xv[2 * j] = __uint_as_float(a[j] << 16); xv[2 * j + 1] = __uint_as_float(a[j] & 0xffff0000u); xv[8 + 2 * j] = __uint_as_float(b[j] << 16); xv[8 + 2 * j + 1] = __uint_as_float(b[j] & 0xffff0000u); }
}
__device__ __forceinline__ void finish_token(int tok, const float (&xv)[16], float* __restrict__ xo, bf16_t* __restrict__ xb, float* __restrict__ rstd,
                                             const float* __restrict__ wf, const float* __restrict__ bfor, float* __restrict__ flog, int lane, int slot) {
    float ss = 0.f;
#pragma unroll
    for (int i = 0; i < 16; ++i) ss += xv[i] * xv[i];
    ss += __uint_as_float(__builtin_amdgcn_update_dpp(0, __float_as_uint(ss), 0x128, 0xf, 0xf, true)); ss += __uint_as_float(__builtin_amdgcn_update_dpp(0, __float_as_uint(ss), 0x124, 0xf, 0xf, true));
    ss += __uint_as_float(__builtin_amdgcn_update_dpp(0, __float_as_uint(ss), 0x122, 0xf, 0xf, true)); ss += __uint_as_float(__builtin_amdgcn_update_dpp(0, __float_as_uint(ss), 0x121, 0xf, 0xf, true));
    ss = half_swap_sum(ss);
    { auto r = __builtin_amdgcn_permlane16_swap(__float_as_uint(ss), __float_as_uint(ss), false, false); ss = __uint_as_float(r[0]) + __uint_as_float(r[1]); }
    const float rs = __builtin_amdgcn_rsqf(ss * (1.f / 1024.f) + EPS);
    float* op = xo + (size_t)tok * D + 16 * slot; bf16_t* bp = xb + (size_t)tok * D + 16 * slot;
    if (xo) {
#pragma unroll
        for (int j = 0; j < 4; ++j) *(f32x4*)(op + 4 * j) = (f32x4){xv[4 * j], xv[4 * j + 1], xv[4 * j + 2], xv[4 * j + 3]};
    }
    u32x4 w0, w1;
    w0.x = pk2(xv[0], xv[1]); w0.y = pk2(xv[2], xv[3]); w0.z = pk2(xv[4], xv[5]); w0.w = pk2(xv[6], xv[7]);
    w1.x = pk2(xv[8], xv[9]); w1.y = pk2(xv[10], xv[11]); w1.z = pk2(xv[12], xv[13]); w1.w = pk2(xv[14], xv[15]);
    *(u32x4*)(bp) = w0; *(u32x4*)(bp + 8) = w1;
    if (lane == 0) rstd[tok] = rs;
    if (wf) {
        float g[4];
#pragma unroll
        for (int h = 0; h < 4; ++h) {
            const float* wp = wf + h * 1024 + 16 * slot;
            float d = 0.f;
#pragma unroll
            for (int j = 0; j < 4; ++j) { const f32x4 t = *(const f32x4*)(wp + 4 * j); d += xv[4 * j] * t[0] + xv[4 * j + 1] * t[1] + xv[4 * j + 2] * t[2] + xv[4 * j + 3] * t[3]; }
            g[h] = d;
        }
        auto r01 = __builtin_amdgcn_permlane32_swap(__float_as_uint(g[0]), __float_as_uint(g[1]), false, false); const float q01 = __uint_as_float(r01[0]) + __uint_as_float(r01[1]);
        auto r23 = __builtin_amdgcn_permlane32_swap(__float_as_uint(g[2]), __float_as_uint(g[3]), false, false); const float q23 = __uint_as_float(r23[0]) + __uint_as_float(r23[1]);
        auto rq = __builtin_amdgcn_permlane16_swap(__float_as_uint(q01), __float_as_uint(q23), false, false); float q = __uint_as_float(rq[0]) + __uint_as_float(rq[1]);
        q += __uint_as_float(__builtin_amdgcn_update_dpp(0, __float_as_uint(q), 0x128, 0xf, 0xf, true)); q += __uint_as_float(__builtin_amdgcn_update_dpp(0, __float_as_uint(q), 0x124, 0xf, 0xf, true));
        q += __uint_as_float(__builtin_amdgcn_update_dpp(0, __float_as_uint(q), 0x122, 0xf, 0xf, true)); q += __uint_as_float(__builtin_amdgcn_update_dpp(0, __float_as_uint(q), 0x121, 0xf, 0xf, true));
        const int myh = ((lane >> 4) & 1) * 2 + (lane >> 5);
        if ((lane & 15) == 0) { const int b = tok / S, s = tok % S; flog[((size_t)b * 4 + myh) * S + s] = log_sigmoid(q * rs + bfor[myh]); }
    }
}
__device__ __forceinline__ void phase_xprep(const Args& a) {
    const int lane = threadIdx.x & 63, wv = blockIdx.x * 8 + (threadIdx.x >> 6), nw = gridDim.x * 8;
    const float* x = a.in[0];
    for (int tok = wv; tok < T; tok += nw) {
        float xv[16]; load_row16(x + (size_t)tok * D, lane, xv);
        finish_token(tok, xv, nullptr, (bf16_t*)(a.ws + WS_XB), (float*)(a.ws + WS_RSTD), (const float*)(a.ws + WS_WF), a.in[2], (float*)(a.ws + WS_FLOG), lane, lane);
    }
}
__device__ __forceinline__ void cum_scan(const Args& a, unsigned char* ldsb, int bh) {
    float* lds = (float*)ldsb;
    const int tid = threadIdx.x, lane = tid & 63, w = tid >> 6;
    const float* fl = (const float*)(a.ws + WS_FLOG) + (size_t)bh * S + tid * 16;
    float v[16];
#pragma unroll
    for (int i = 0; i < 4; ++i) { const f32x4 t = *(const f32x4*)(fl + 4 * i); v[4 * i] = t[0]; v[4 * i + 1] = t[1]; v[4 * i + 2] = t[2]; v[4 * i + 3] = t[3]; }
#pragma unroll
    for (int i = 1; i < 16; ++i) v[i] += v[i - 1];
    float incl = v[15];
#pragma unroll
    for (int o = 1; o < 64; o <<= 1) { const float t = __shfl_up(incl, o); if (lane >= o) incl += t; }
    if (lane == 63) lds[w] = incl;
    __syncthreads();
    float base = incl - v[15];
    for (int j = 0; j < w; ++j) base += lds[j];
    float* cp = (float*)(a.ws + WS_CUM) + (size_t)bh * S + tid * 16;
#pragma unroll
    for (int i = 0; i < 4; ++i) *(f32x4*)(cp + 4 * i) = (f32x4){(base + v[4 * i]) * LOG2E, (base + v[4 * i + 1]) * LOG2E, (base + v[4 * i + 2]) * LOG2E, (base + v[4 * i + 3]) * LOG2E};
    __syncthreads();
}

constexpr int AT_KP = 176, AT_KB = 64 * AT_KP, AT_KS = 0, AT_VP = 192, AT_VB = 64 * AT_VP, AT_VT = 2 * AT_KB, AT_TBL = AT_VT + 2 * AT_VB, AT_END = AT_TBL + TBN * 4;
__device__ __forceinline__ int swap23(int i) { return (i & ~12) | ((i & 4) << 1) | ((i & 8) >> 1); }
#define MFMA32(A, B, C) __builtin_amdgcn_mfma_f32_32x32x16_bf16(A, B, C, 0, 0, 0)
#define MFMA_DRAIN2(x, y) asm volatile("s_nop 15\n\ts_nop 15\n\ts_nop 7" : "+v"(x), "+v"(y))
typedef float f32x2_t __attribute__((ext_vector_type(2))); typedef __bf16 bf16x2_t __attribute__((ext_vector_type(2)));
__device__ __forceinline__ float max3f(float a, float b, float c) { return __builtin_fmaxf(__builtin_fmaxf(a, b), c); }
__device__ __forceinline__ unsigned cvtpk(float lo, float hi) { const f32x2_t v = {lo, hi}; const bf16x2_t b = __builtin_convertvector(v, bf16x2_t); return __builtin_bit_cast(unsigned, b); }
__device__ __forceinline__ bf16x8 pack8(const f32x16& p, int s8) {
    u32x4 w; w.x = cvtpk(p[s8], p[s8 + 1]); w.y = cvtpk(p[s8 + 2], p[s8 + 3]); w.z = cvtpk(p[s8 + 4], p[s8 + 5]); w.w = cvtpk(p[s8 + 6], p[s8 + 7]);
    return __builtin_bit_cast(bf16x8, w);
}
__device__ __forceinline__ void split3(float x, float& b1, float& b2, float& b3) {
    b1 = bf2f(f2bf(x)); const float r = x - b1; b2 = bf2f(f2bf(r)); b3 = bf2f(f2bf(r - b2));
}
__device__ __forceinline__ void stage_kv(unsigned char* lds, int buf, int kv_s, int c_s, const u32x4& kreg, const u32x4& vreg) {
    *(u32x4*)(lds + AT_KS + buf * AT_KB + kv_s * AT_KP + 16 * c_s) = kreg;
    *(u32x4*)(lds + AT_VT + buf * AT_VB + kv_s * AT_VP + 16 * c_s) = vreg;
}
struct SMState { float mref, l; };
template <int NP>
__device__ __forceinline__ void softmax_step(f32x16 (&p)[NP], SMState& st, bool& refzero, f32x16 (&o)[2]) {
    float a = max3f(p[0][0], p[0][1], p[0][2]), b = max3f(p[0][3], p[0][4], p[0][5]);
    a = max3f(a, p[0][6], p[0][7]); b = max3f(b, p[0][8], p[0][9]); a = max3f(a, p[0][10], p[0][11]); b = max3f(b, p[0][12], p[0][13]); a = max3f(a, p[0][14], p[0][15]);
    if (NP == 2) { b = max3f(b, p[NP - 1][0], p[NP - 1][1]); a = max3f(a, p[NP - 1][2], p[NP - 1][3]); b = max3f(b, p[NP - 1][4], p[NP - 1][5]); a = max3f(a, p[NP - 1][6], p[NP - 1][7]);
        b = max3f(b, p[NP - 1][8], p[NP - 1][9]); a = max3f(a, p[NP - 1][10], p[NP - 1][11]); b = max3f(b, p[NP - 1][12], p[NP - 1][13]); a = max3f(a, p[NP - 1][14], p[NP - 1][15]); }
    const float rm = half_swap_max(fmaxf(a, b));
    if (__any(rm - st.mref > 20.f)) {
        const float nr = (rm - st.mref > 20.f) ? rm : st.mref;
        const float f = __builtin_amdgcn_exp2f(st.mref - nr);
        st.l *= f;
#pragma unroll
        for (int r = 0; r < 16; ++r) { o[0][r] *= f; o[1][r] *= f; }
        st.mref = nr; refzero = false;
    }
    if (!refzero) {
#pragma unroll
        for (int i = 0; i < NP; ++i)
#pragma unroll
            for (int r = 0; r < 16; ++r) p[i][r] -= st.mref;
    }
    float ps = 0.f;
#pragma unroll
    for (int i = 0; i < NP; ++i)
#pragma unroll
        for (int r = 0; r < 16; ++r) { const float e = __builtin_amdgcn_exp2f(p[i][r]); p[i][r] = e; ps += e; }
    st.l += ps;
}
typedef short v4i16_t __attribute__((ext_vector_type(4)));
__device__ __forceinline__ void load_vf(const unsigned char* lds, int buf, int lane, bf16x8 (&vf)[2][2][2]) {
    const int g = lane >> 4, i = lane & 15, q = i >> 2, p4 = i & 3;
    const LAS3 unsigned char* base = (const LAS3 unsigned char*)(lds + AT_VT + buf * AT_VB) + (8 * (g >> 1) + q) * AT_VP + (16 * (g & 1) + 4 * p4) * 2;
#pragma unroll
    for (int db = 0; db < 2; ++db)
#pragma unroll
        for (int hf = 0; hf < 2; ++hf)
#pragma unroll
            for (int s = 0; s < 2; ++s) {
                const LAS3 unsigned char* pp = base + (32 * hf + 16 * s) * AT_VP + 64 * db;
                const v4i16_t lo = __builtin_amdgcn_ds_read_tr16_b64_v4i16((LAS3 v4i16_t*)pp);
                const v4i16_t hi4 = __builtin_amdgcn_ds_read_tr16_b64_v4i16((LAS3 v4i16_t*)(pp + 4 * AT_VP));
                vf[db][hf][s] = (bf16x8){lo[0], lo[1], lo[2], lo[3], hi4[0], hi4[1], hi4[2], hi4[3]};
            }
}
__device__ __forceinline__ void pv_tile(const bf16x8 (&vf)[2][2][2], const f32x16 (&p)[2], f32x16 (&o)[2]) {
#pragma unroll
    for (int hf = 0; hf < 2; ++hf)
#pragma unroll
        for (int s = 0; s < 2; ++s) {
            const bf16x8 pf = pack8(p[hf], 8 * s);
#pragma unroll
            for (int db = 0; db < 2; ++db) o[db] = MFMA32(vf[db][hf][s], pf, o[db]);
        }
}
__device__ __forceinline__ void store_ot(bf16_t* dst, const f32x16 (&o)[2], float sc, int hi) {
#pragma unroll
    for (int db = 0; db < 2; ++db)
#pragma unroll
        for (int r4 = 0; r4 < 4; ++r4) {
            u32x2 w; w.x = cvtpk(o[db][4 * r4] * sc, o[db][4 * r4 + 1] * sc); w.y = cvtpk(o[db][4 * r4 + 2] * sc, o[db][4 * r4 + 3] * sc);
            *(u32x2*)(dst + 32 * db + 8 * r4 + 4 * hi) = w;
        }
}

__device__ __forceinline__ void fox_unit(const Args& a, unsigned char* lds, int layer, int bh, int qb) {
    int tid = threadIdx.x; asm volatile("" : "+v"(tid));
    const int lane = tid & 63, w = __builtin_amdgcn_readfirstlane(tid >> 6), qi = lane & 31, hi = lane >> 5;
    const int b = bh >> 2, h = bh & 3;
    const bf16_t* zb = (const bf16_t*)(a.ws + WS_ZB) + (size_t)b * S * ZP;
    const float* cum = (const float*)(a.ws + WS_CUM) + (size_t)bh * S;
    const int q0 = 256 * qb + 32 * w;
    const float cref = cum[256 * qb];
    bf16x8 qf[5];
#pragma unroll
    for (int ds = 0; ds < 4; ++ds) qf[ds] = *(const bf16x8*)(zb + (size_t)(q0 + qi) * ZP + ZC_FQ + 64 * h + 16 * ds + 8 * hi);
    { float q1, q2, q3; split3(cum[q0 + qi] - cref, q1, q2, q3);
      u32x4 e; e.x = hi ? 0u : 0x3f803f80u; e.y = hi ? 0u : (0x3f80u | ((unsigned)f2bf(q1) << 16)); e.z = hi ? 0u : ((unsigned)f2bf(q2) | ((unsigned)f2bf(q3) << 16)); e.w = 0u;
      qf[4] = __builtin_bit_cast(bf16x8, e); }
    const int ntiles = 4 * (qb + 1), mylast = 4 * qb + (w >> 1);
    const float thr = ((const float*)(a.ws + WS_FOXT))[layer];
    int kt0 = 0;
    {
        const bool sk = tid < 4 * qb && (cref - cum[64 * tid + 63]) < -thr;
        const unsigned long long bal = __ballot(sk);
        volatile LAS3 unsigned* cw = (volatile LAS3 unsigned*)(LAS3 unsigned char*)(lds + LDS_CTL + 64);
        if (lane == 0) cw[w] = (unsigned)__popcll(bal);
        __syncthreads();
#pragma unroll
        for (int i = 0; i < 8; ++i) kt0 += (int)cw[i];
        __syncthreads();
    }
    const int kv_s = 8 * w + (lane >> 3), c_s = lane & 7;
    const bf16_t* kp = zb + (size_t)kv_s * ZP + ZC_FK + 64 * h + 8 * c_s;
    const bf16_t* vp = zb + (size_t)kv_s * ZP + ZC_FV + 64 * h + 8 * c_s;
    u32x4 kreg = *(const u32x4*)(kp + (size_t)kt0 * 64 * ZP), vreg = *(const u32x4*)(vp + (size_t)kt0 * 64 * ZP);
    float dreg = (tid < 64) ? cum[kt0 * 64 + tid] : 0.f;
    SMState st; st.mref = 0.f; st.l = 0.f; bool refzero = true;
    f32x16 o[2]; o[0] = (f32x16){}; o[1] = (f32x16){};
    const int krow = swap23(qi);
#ifdef HK_FOX_NOSTAG
    const int grp = HK_FOX_NOSTAG - 1;
#else
    const int grp = w >> 2;
#endif
    f32x16 p[2];
#define FOX_QK(kt_, buf_) do { bf16x8 kf_[2][5]; \
        _Pragma("unroll") for (int hf = 0; hf < 2; ++hf) _Pragma("unroll") for (int ds = 0; ds < 5; ++ds) kf_[hf][ds] = *(const bf16x8*)(lds + AT_KS + (buf_) * AT_KB + (32 * hf + krow) * AT_KP + 32 * ds + 16 * hi); \
        _Pragma("unroll") for (int hf = 0; hf < 2; ++hf) { p[hf] = (f32x16){}; _Pragma("unroll") for (int ds = 0; ds < 5; ++ds) p[hf] = MFMA32(kf_[hf][ds], qf[ds], p[hf]); } \
        MFMA_DRAIN2(p[0], p[1]); \
        if (64 * (kt_) + 63 > q0) { const int lim = q0 + qi - 64 * (kt_) - 8 * hi; \
            _Pragma("unroll") for (int hf = 0; hf < 2; ++hf) _Pragma("unroll") for (int r = 0; r < 16; ++r) if (32 * hf + 16 * (r >> 3) + (r & 7) > lim) p[hf][r] = -INFINITY; } } while (0)
#define FOX_SMPV(buf_) do { bf16x8 vf_[2][2][2]; load_vf(lds, (buf_), lane, vf_); softmax_step<2>(p, st, refzero, o); pv_tile(vf_, p, o); } while (0)
    for (int kt = kt0; kt < ntiles; ++kt) {
        const int buf = kt & 1;
        stage_kv(lds, buf, kv_s, c_s, kreg, vreg);
        if (tid < 64) { float k1, k2, k3; split3(cref - dreg, k1, k2, k3);
            u32x4 e; e.x = (unsigned)f2bf(k1) | ((unsigned)f2bf(k2) << 16); e.y = (unsigned)f2bf(k3) | 0x3f800000u; e.z = 0x3f803f80u; e.w = 0u;
            unsigned char* kr = lds + AT_KS + buf * AT_KB + tid * AT_KP + 128;
            *(u32x4*)kr = e; *(u32x4*)(kr + 16) = (u32x4){0u, 0u, 0u, 0u}; }
        __syncthreads();
        if (kt + 1 < ntiles) {
            kreg = *(const u32x4*)(kp + (size_t)(kt + 1) * 64 * ZP); vreg = *(const u32x4*)(vp + (size_t)(kt + 1) * 64 * ZP);
            if (tid < 64) dreg = cum[(kt + 1) * 64 + tid];
        }
#ifdef HK_FOX_X2
        if (grp == 0) { if (kt <= mylast) FOX_QK(kt, buf); }
        __syncthreads();
        if (grp == 0) { if (kt <= mylast) FOX_SMPV(buf); }
        else { if (kt > kt0 && kt - 1 <= mylast) FOX_SMPV(buf ^ 1); if (kt <= mylast) FOX_QK(kt, buf); }
#else
        if (grp == 0) { if (kt <= mylast) FOX_QK(kt, buf); }
        else { if (kt > kt0 && kt - 1 <= mylast) FOX_SMPV(buf ^ 1); }
        __syncthreads();
        if (grp == 0) { if (kt <= mylast) FOX_SMPV(buf); }
        else { if (kt <= mylast) FOX_QK(kt, buf); }
#endif
#ifdef HK_FOX_B3
        __syncthreads();
#endif
    }
    if (grp == 1 && ntiles - 1 <= mylast) FOX_SMPV((ntiles - 1) & 1);
#undef FOX_QK
#undef FOX_SMPV
    const float l = half_swap_sum(st.l);
    store_ot((bf16_t*)(a.ws + WS_MIX) + (size_t)(b * S + q0 + qi) * D + 0 + 64 * h, o, 1.f / l, hi);
    __syncthreads();
}

__device__ __forceinline__ void fox64_unit(const Args& a, unsigned char* lds, int layer, int bh, int qb) {
    int tid = threadIdx.x; asm volatile("" : "+v"(tid));
    const int lane = tid & 63, w = __builtin_amdgcn_readfirstlane(tid >> 6), qi = lane & 31, hi = lane >> 5;
    const int b = bh >> 2, h = bh & 3;
    const bf16_t* zb = (const bf16_t*)(a.ws + WS_ZB) + (size_t)b * S * ZP;
    const float* cum = (const float*)(a.ws + WS_CUM) + (size_t)bh * S;
    const int q0 = 512 * qb + 64 * w;
    const float cref = cum[512 * qb];
    bf16x8 qfA[5], qfB[5];
#pragma unroll
    for (int ds = 0; ds < 4; ++ds) { qfA[ds] = *(const bf16x8*)(zb + (size_t)(q0 + qi) * ZP + ZC_FQ + 64 * h + 16 * ds + 8 * hi); qfB[ds] = *(const bf16x8*)(zb + (size_t)(q0 + 32 + qi) * ZP + ZC_FQ + 64 * h + 16 * ds + 8 * hi); }
#pragma unroll
    for (int blk = 0; blk < 2; ++blk) { float q1, q2, q3; split3(cum[q0 + 32 * blk + qi] - cref, q1, q2, q3);
      u32x4 e; e.x = hi ? 0u : 0x3f803f80u; e.y = hi ? 0u : (0x3f80u | ((unsigned)f2bf(q1) << 16)); e.z = hi ? 0u : ((unsigned)f2bf(q2) | ((unsigned)f2bf(q3) << 16)); e.w = 0u;
      if (blk == 0) qfA[4] = __builtin_bit_cast(bf16x8, e); else qfB[4] = __builtin_bit_cast(bf16x8, e); }
    const int ntiles = 8 * (qb + 1), mylast = 8 * qb + w;
    const float thr = ((const float*)(a.ws + WS_FOXT))[layer];
    int kt0 = 0;
    {   const bool sk = tid < 8 * qb && (cref - cum[64 * tid + 63]) < -thr;
        const unsigned long long bal = __ballot(sk);
        volatile LAS3 unsigned* cw = (volatile LAS3 unsigned*)(LAS3 unsigned char*)(lds + LDS_CTL + 64);
        if (lane == 0) cw[w] = (unsigned)__popcll(bal);
        __syncthreads();
#pragma unroll
        for (int i = 0; i < 8; ++i) kt0 += (int)cw[i];
        __syncthreads();
    }
    const int kv_s = 8 * w + (lane >> 3), c_s = lane & 7;
    const bf16_t* kp = zb + (size_t)kv_s * ZP + ZC_FK + 64 * h + 8 * c_s;
    const bf16_t* vp = zb + (size_t)kv_s * ZP + ZC_FV + 64 * h + 8 * c_s;
    u32x4 kreg = *(const u32x4*)(kp + (size_t)kt0 * 64 * ZP), vreg = *(const u32x4*)(vp + (size_t)kt0 * 64 * ZP);
    float dreg = (tid < 64) ? cum[kt0 * 64 + tid] : 0.f;
    SMState stA, stB; stA.mref = 0.f; stA.l = 0.f; stB.mref = 0.f; stB.l = 0.f; bool rzA = true, rzB = true;
    f32x16 oA[2], oB[2]; oA[0] = (f32x16){}; oA[1] = (f32x16){}; oB[0] = (f32x16){}; oB[1] = (f32x16){};
    const int krow = swap23(qi);
    for (int kt = kt0; kt < ntiles; ++kt) {
        const int buf = kt & 1;
        stage_kv(lds, buf, kv_s, c_s, kreg, vreg);
        if (tid < 64) { float k1, k2, k3; split3(cref - dreg, k1, k2, k3);
            u32x4 e; e.x = (unsigned)f2bf(k1) | ((unsigned)f2bf(k2) << 16); e.y = (unsigned)f2bf(k3) | 0x3f800000u; e.z = 0x3f803f80u; e.w = 0u;
            unsigned char* kr = lds + AT_KS + buf * AT_KB + tid * AT_KP + 128;
            *(u32x4*)kr = e; *(u32x4*)(kr + 16) = (u32x4){0u, 0u, 0u, 0u}; }
        __syncthreads();
        if (kt + 1 < ntiles) {
            kreg = *(const u32x4*)(kp + (size_t)(kt + 1) * 64 * ZP); vreg = *(const u32x4*)(vp + (size_t)(kt + 1) * 64 * ZP);
            if (tid < 64) dreg = cum[(kt + 1) * 64 + tid];
        }
        if (kt <= mylast) {
            f32x16 pA[2], pB[2];
#pragma unroll
            for (int hf = 0; hf < 2; ++hf) {
                pA[hf] = (f32x16){}; pB[hf] = (f32x16){};
#pragma unroll
                for (int ds = 0; ds < 5; ++ds) { const bf16x8 kf = *(const bf16x8*)(lds + AT_KS + buf * AT_KB + (32 * hf + krow) * AT_KP + 32 * ds + 16 * hi);
                    pA[hf] = MFMA32(kf, qfA[ds], pA[hf]); pB[hf] = MFMA32(kf, qfB[ds], pB[hf]); }
            }
            if (kt == mylast) {
                const int limA = qi - 8 * hi, limB = 32 + qi - 8 * hi;
#pragma unroll
                for (int hf = 0; hf < 2; ++hf)
#pragma unroll
                    for (int r = 0; r < 16; ++r) { const int kvo = 32 * hf + 16 * (r >> 3) + (r & 7); if (kvo > limA) pA[hf][r] = -INFINITY; if (kvo > limB) pB[hf][r] = -INFINITY; }
            }
            softmax_step<2>(pA, stA, rzA, oA); softmax_step<2>(pB, stB, rzB, oB);
            const int g_ = lane >> 4, i_ = lane & 15;
            const LAS3 unsigned char* vb_ = (const LAS3 unsigned char*)(lds + AT_VT + buf * AT_VB) + (8 * (g_ >> 1) + (i_ >> 2)) * AT_VP + (16 * (g_ & 1) + 4 * (i_ & 3)) * 2;
#pragma unroll
            for (int hf = 0; hf < 2; ++hf)
#pragma unroll
                for (int s = 0; s < 2; ++s) {
                    const bf16x8 fa = pack8(pA[hf], 8 * s), fb = pack8(pB[hf], 8 * s);
#pragma unroll
                    for (int db = 0; db < 2; ++db) {
                        const LAS3 unsigned char* pp = vb_ + (32 * hf + 16 * s) * AT_VP + 64 * db;
                        const v4i16_t lo = __builtin_amdgcn_ds_read_tr16_b64_v4i16((LAS3 v4i16_t*)pp);
                        const v4i16_t hi4 = __builtin_amdgcn_ds_read_tr16_b64_v4i16((LAS3 v4i16_t*)(pp + 4 * AT_VP));
                        const bf16x8 vf = (bf16x8){lo[0], lo[1], lo[2], lo[3], hi4[0], hi4[1], hi4[2], hi4[3]};
                        oA[db] = MFMA32(vf, fa, oA[db]); oB[db] = MFMA32(vf, fb, oB[db]);
                    }
                }
        }
    }
    const float lA = half_swap_sum(stA.l), lB = half_swap_sum(stB.l);
    bf16_t* mo = (bf16_t*)(a.ws + WS_MIX) + (size_t)(b * S + q0 + qi) * D + 64 * h;
    store_ot(mo, oA, 1.f / lA, hi);
    store_ot(mo + (size_t)32 * D, oB, 1.f / lB, hi);
    __syncthreads();
}

__device__ __forceinline__ void diff_unit(const Args& a, unsigned char* lds, int layer, int bh, int qb) {
    int tid = threadIdx.x; asm volatile("" : "+v"(tid));
    const int lane = tid & 63, w = __builtin_amdgcn_readfirstlane(tid >> 6), qi = lane & 31, hi = lane >> 5;
    const int b = bh >> 2, h = bh & 3;
    const bf16_t* zb = (const bf16_t*)(a.ws + WS_ZB) + (size_t)b * S * ZP;
    const int q0 = 256 * qb + 32 * w;
    {
        const float* tb = (const float*)(a.ws + WS_TB) + (size_t)(4 + h) * TBN; float* tl = (float*)(lds + AT_TBL);
        const float cb = tb[1600]; float tv[5];
#pragma unroll
        for (int k = 0; k < 5; ++k) { const int i = tid + NTHR * k; tv[k] = tb[i < TBN ? i : TBN - 1]; }
#pragma unroll
        for (int k = 0; k < 5; ++k) { const int i = tid + NTHR * k; if (i < TBN) tl[i] = tv[k] - cb; }
    }
    bf16x8 qf[2][2];
#pragma unroll
    for (int c = 0; c < 2; ++c)
#pragma unroll
        for (int ds = 0; ds < 2; ++ds) qf[c][ds] = *(const bf16x8*)(zb + (size_t)(q0 + qi) * ZP + ZC_CQ + 64 * h + 32 * c + 16 * ds + 8 * hi);
    const int ntiles = 4 * (qb + 1), mylast = 4 * qb + (w >> 1);
    const int kv_s = 8 * w + (lane >> 3), c_s = lane & 7;
    const bf16_t* kp = zb + (size_t)kv_s * ZP + ZC_CK + 64 * h + 8 * c_s;
    const bf16_t* vp = zb + (size_t)kv_s * ZP + ZC_CV + 64 * h + 8 * c_s;
    u32x4 kreg = *(const u32x4*)kp, vreg = *(const u32x4*)vp;
    SMState st[2]; st[0].mref = 0.f; st[0].l = 0.f; st[1].mref = 0.f; st[1].l = 0.f; bool rz0 = true, rz1 = true;
    f32x16 o[2][2];
#pragma unroll
    for (int c = 0; c < 2; ++c) { o[c][0] = (f32x16){}; o[c][1] = (f32x16){}; }
    const int krow = swap23(qi);
    const float* tl = (const float*)(lds + AT_TBL);
    for (int kt = 0; kt < ntiles; ++kt) {
        const int buf = kt & 1;
        stage_kv(lds, buf, kv_s, c_s, kreg, vreg);
        __syncthreads();
        if (kt + 1 < ntiles) { kreg = *(const u32x4*)(kp + (size_t)(kt + 1) * 64 * ZP); vreg = *(const u32x4*)(vp + (size_t)(kt + 1) * 64 * ZP); }
        if (kt <= mylast) {
            const bool far_ = q0 - (64 * kt + 63) >= 1513;
            const bool diag = 64 * kt + 63 > q0;
            const int dq = q0 + qi - 64 * kt - 8 * hi;
#pragma unroll
            for (int hf = 0; hf < 2; ++hf) {
                f32x16 p0[1], p1[1]; p0[0] = (f32x16){}; p1[0] = (f32x16){};
                bf16x8 vf[2][2];
                { const int g_ = lane >> 4, i_ = lane & 15;
                  const LAS3 unsigned char* vb_ = (const LAS3 unsigned char*)(lds + AT_VT + buf * AT_VB) + (32 * hf + 8 * (g_ >> 1) + (i_ >> 2)) * AT_VP + (16 * (g_ & 1) + 4 * (i_ & 3)) * 2;
#pragma unroll
                  for (int s = 0; s < 2; ++s)
#pragma unroll
                      for (int db = 0; db < 2; ++db) {
                          const v4i16_t lo = __builtin_amdgcn_ds_read_tr16_b64_v4i16((LAS3 v4i16_t*)(vb_ + 16 * s * AT_VP + 64 * db));
                          const v4i16_t hi4 = __builtin_amdgcn_ds_read_tr16_b64_v4i16((LAS3 v4i16_t*)(vb_ + (16 * s + 4) * AT_VP + 64 * db));
                          vf[s][db] = (bf16x8){lo[0], lo[1], lo[2], lo[3], hi4[0], hi4[1], hi4[2], hi4[3]};
                      } }
#pragma unroll
                for (int ds = 0; ds < 2; ++ds) {
                    const bf16x8 k0 = *(const bf16x8*)(lds + AT_KS + buf * AT_KB + (32 * hf + krow) * AT_KP + 32 * ds + 16 * hi);
                    const bf16x8 k1 = *(const bf16x8*)(lds + AT_KS + buf * AT_KB + (32 * hf + krow) * AT_KP + 64 + 32 * ds + 16 * hi);
                    p0[0] = MFMA32(k0, qf[0][ds], p0[0]); p1[0] = MFMA32(k1, qf[1][ds], p1[0]);
                }
                MFMA_DRAIN2(p0[0], p1[0]);
                if (!far_) {
                    if (diag) {
#pragma unroll
                        for (int r = 0; r < 16; ++r) {
                            const int dist = dq - (32 * hf + 16 * (r >> 3) + (r & 7));
                            const float bb = tl[dist < 0 ? 0 : dist];
                            const bool ok = dist >= 0;
                            p0[0][r] = ok ? p0[0][r] + bb : -INFINITY; p1[0][r] = ok ? p1[0][r] + bb : -INFINITY;
                        }
                    } else {
#pragma unroll
                        for (int r = 0; r < 16; ++r) { const float bb = tl[dq - (32 * hf + 16 * (r >> 3) + (r & 7))]; p0[0][r] += bb; p1[0][r] += bb; }
                    }
                }
                softmax_step<1>(p0, st[0], rz0, o[0]); softmax_step<1>(p1, st[1], rz1, o[1]);
#pragma unroll
                for (int s = 0; s < 2; ++s) {
                    const bf16x8 f0 = pack8(p0[0], 8 * s), f1 = pack8(p1[0], 8 * s);
#pragma unroll
                    for (int db = 0; db < 2; ++db) { o[0][db] = MFMA32(vf[s][db], f0, o[0][db]); o[1][db] = MFMA32(vf[s][db], f1, o[1][db]); }
                }
            }
        }
    }
    const float lam_init = 0.8f - 0.6f * __expf(-0.3f * (float)layer);
    const float* lp = a.in[12] + layer * 128;
    float s1 = 0.f, s2 = 0.f;
    for (int i = 0; i < 32; ++i) { s1 += lp[i] * lp[32 + i]; s2 += lp[64 + i] * lp[96 + i]; }
    const float lam = __expf(s1) - __expf(s2) + lam_init;
    const float i0 = 1.f / half_swap_sum(st[0].l), i1 = lam / half_swap_sum(st[1].l);
    float ss = 0.f;
#pragma unroll
    for (int db = 0; db < 2; ++db)
#pragma unroll
        for (int r = 0; r < 16; ++r) { const float v = o[0][db][r] * i0 - o[1][db][r] * i1; o[0][db][r] = v; ss += v * v; }
    ss = half_swap_sum(ss);
    const float rn = __builtin_amdgcn_rsqf(ss * (1.f / 64.f) + EPS) * (1.f - lam_init);
    const float* gn = a.in[13] + layer * 64;
#pragma unroll
    for (int db = 0; db < 2; ++db)
#pragma unroll
        for (int r = 0; r < 16; ++r) o[0][db][r] *= gn[32 * db + (r & 3) + 8 * (r >> 2) + 4 * hi];
    store_ot((bf16_t*)(a.ws + WS_MIX) + (size_t)(b * S + q0 + qi) * D + 512 + 64 * h, o[0], rn, hi);
    __syncthreads();
}

__device__ __forceinline__ void dil_unit(const Args& a, unsigned char* lds, int bh, int br, int rho, int tile) {
    int tid = threadIdx.x; asm volatile("" : "+v"(tid));
    const int lane = tid & 63, w = __builtin_amdgcn_readfirstlane(tid >> 6), qi = lane & 31, hi = lane >> 5;
    const int b = bh >> 2, h = bh & 3;
    const int r = br == 0 ? 1 : (br == 1 ? 4 : 16);
    const bf16_t* zb = (const bf16_t*)(a.ws + WS_ZB) + (size_t)b * S * ZP;
    {   const float* tb = (const float*)(a.ws + WS_TB) + (size_t)h * TBN; float* tl = (float*)(lds + AT_TBL); float tv[5];
#pragma unroll
        for (int k = 0; k < 5; ++k) { const int i = tid + NTHR * k; tv[k] = tb[i < TBN ? i : TBN - 1]; }
#pragma unroll
        for (int k = 0; k < 5; ++k) { const int i = tid + NTHR * k; if (i < TBN) tl[i] = tv[k]; }
    }
    const int l0 = 256 * tile, lq0 = l0 + 32 * w;
    const int tq = (lq0 + qi) * r + rho;
    bf16x8 qf[4];
#pragma unroll
    for (int ds = 0; ds < 4; ++ds) qf[ds] = *(const bf16x8*)(zb + (size_t)tq * ZP + ZC_DQ + 64 * h + 16 * ds + 8 * hi);
    const int kv_s = 8 * w + (lane >> 3), c_s = lane & 7;
    const int j0 = (l0 == 0) ? 2 : 0;
    auto krow_of = [&](int j) { int kl = l0 - 128 + 64 * j + kv_s; kl = kl < 0 ? 0 : kl; return (size_t)(kl * r + rho) * ZP; };
    u32x4 kreg = *(const u32x4*)(zb + krow_of(j0) + ZC_DK + 64 * h + 8 * c_s), vreg = *(const u32x4*)(zb + krow_of(j0) + ZC_DV + 64 * h + 8 * c_s);
    SMState st; st.mref = 0.f; st.l = 0.f; bool refzero = true;
    f32x16 o[2]; o[0] = (f32x16){}; o[1] = (f32x16){};
    const int krow = swap23(qi);
    const float* tl = (const float*)(lds + AT_TBL);
    for (int j = j0; j < 6; ++j) {
        const int buf = j & 1;
        stage_kv(lds, buf, kv_s, c_s, kreg, vreg);
        __syncthreads();
        if (j + 1 < 6) { kreg = *(const u32x4*)(zb + krow_of(j + 1) + ZC_DK + 64 * h + 8 * c_s); vreg = *(const u32x4*)(zb + krow_of(j + 1) + ZC_DV + 64 * h + 8 * c_s); }
        const int kl0 = l0 - 128 + 64 * j;
#pragma unroll
        for (int hf = 0; hf < 2; ++hf) {
            const int kh0 = kl0 + 32 * hf;
            if (kh0 <= lq0 + 31 && kh0 + 31 >= lq0 - 128 && kh0 + 31 >= 0) {
                f32x16 p[1]; p[0] = (f32x16){};
                bf16x8 kf[4];
#pragma unroll
                for (int ds = 0; ds < 4; ++ds) kf[ds] = *(const bf16x8*)(lds + AT_KS + buf * AT_KB + (32 * hf + krow) * AT_KP + 32 * ds + 16 * hi);
                bf16x8 vf[2][2];
                { const int g_ = lane >> 4, i_ = lane & 15;
                  const LAS3 unsigned char* vb_ = (const LAS3 unsigned char*)(lds + AT_VT + buf * AT_VB) + (32 * hf + 8 * (g_ >> 1) + (i_ >> 2)) * AT_VP + (16 * (g_ & 1) + 4 * (i_ & 3)) * 2;
#pragma unroll
                  for (int s = 0; s < 2; ++s)
#pragma unroll
                      for (int db = 0; db < 2; ++db) {
                          const v4i16_t lo = __builtin_amdgcn_ds_read_tr16_b64_v4i16((LAS3 v4i16_t*)(vb_ + 16 * s * AT_VP + 64 * db));
                          const v4i16_t hi4 = __builtin_amdgcn_ds_read_tr16_b64_v4i16((LAS3 v4i16_t*)(vb_ + (16 * s + 4) * AT_VP + 64 * db));
                          vf[s][db] = (bf16x8){lo[0], lo[1], lo[2], lo[3], hi4[0], hi4[1], hi4[2], hi4[3]};
                      } }
#pragma unroll
                for (int ds = 0; ds < 4; ++ds) p[0] = MFMA32(kf[ds], qf[ds], p[0]);
                const int dq = lq0 + qi - kh0 - 8 * hi;
#pragma unroll
                for (int rr = 0; rr < 16; ++rr) {
                    const int kvoff = 16 * (rr >> 3) + (rr & 7);
                    const int dd = dq - kvoff;
                    const bool ok = dd >= 0 && dd <= 128 && (kh0 + 8 * hi + kvoff) >= 0;
                    const float bb = tl[ok ? dd * r : 0];
                    p[0][rr] = ok ? p[0][rr] + bb : -INFINITY;
                }
                softmax_step<1>(p, st, refzero, o);
#pragma unroll
                for (int s = 0; s < 2; ++s) {
                    const bf16x8 pf = pack8(p[0], 8 * s);
#pragma unroll
                    for (int db = 0; db < 2; ++db) o[db] = MFMA32(vf[s][db], pf, o[db]);
                }
            }
        }
    }
    const float l = half_swap_sum(st.l);
    const size_t tok = (size_t)b * S + tq;
    store_ot((bf16_t*)(a.ws + WS_DPART) + ((size_t)br * T + tok) * 256 + 64 * h, o, 1.f / l, hi);
    if (hi == 0) ((float*)(a.ws + WS_DLSE))[((size_t)br * T + tok) * 4 + h] = st.mref + __builtin_amdgcn_logf(l);
    __syncthreads();
}
}
namespace hk {
struct S5P { float abr, abi, bbr[16], bbi[16]; };
__device__ __forceinline__ void s5_params(const Args& a, int layer, int g, int n, S5P& P, float& dtar, float& dtai) {
    const int lg = layer * 16 + g;
    const float dt = expf(a.in[17][lg]);
    const float ar = a.in[15][lg * 64 + n], ai = a.in[16][lg * 64 + n];
    dtar = dt * ar; dtai = dt * ai;
    const float mag = expf(dtar);
    P.abr = mag * cosf(dtai); P.abi = mag * sinf(dtai);
    const float den = ar * ar + ai * ai, nr = P.abr - 1.f, ni = P.abi;
    const float cr = (nr * ar + ni * ai) / den, ci = (ni * ar - nr * ai) / den;
    const float* brp = a.in[18] + ((size_t)lg * 64 + n) * 16; const float* bip = a.in[19] + ((size_t)lg * 64 + n) * 16;
#pragma unroll
    for (int c = 0; c < 16; ++c) { const float br = brp[c], bi = bip[c]; P.bbr[c] = cr * br - ci * bi; P.bbi[c] = cr * bi + ci * br; }
}
__device__ __forceinline__ void s5_step(const S5P& P, const LAS3 float* up, float& xr, float& xi) {
    const f32x4 u0 = *(const LAS3 f32x4*)(up), u1 = *(const LAS3 f32x4*)(up + 4), u2 = *(const LAS3 f32x4*)(up + 8), u3 = *(const LAS3 f32x4*)(up + 12);
    float r0 = P.bbr[0] * u0[0], r1 = P.bbr[4] * u1[0], r2 = P.bbr[8] * u2[0], r3 = P.bbr[12] * u3[0];
    float i0 = P.bbi[0] * u0[0], i1 = P.bbi[4] * u1[0], i2 = P.bbi[8] * u2[0], i3 = P.bbi[12] * u3[0];
    r0 += P.bbr[1] * u0[1]; r1 += P.bbr[5] * u1[1]; r2 += P.bbr[9] * u2[1]; r3 += P.bbr[13] * u3[1];
    i0 += P.bbi[1] * u0[1]; i1 += P.bbi[5] * u1[1]; i2 += P.bbi[9] * u2[1]; i3 += P.bbi[13] * u3[1];
    r0 += P.bbr[2] * u0[2]; r1 += P.bbr[6] * u1[2]; r2 += P.bbr[10] * u2[2]; r3 += P.bbr[14] * u3[2];
    i0 += P.bbi[2] * u0[2]; i1 += P.bbi[6] * u1[2]; i2 += P.bbi[10] * u2[2]; i3 += P.bbi[14] * u3[2];
    r0 += P.bbr[3] * u0[3]; r1 += P.bbr[7] * u1[3]; r2 += P.bbr[11] * u2[3]; r3 += P.bbr[15] * u3[3];
    i0 += P.bbi[3] * u0[3]; i1 += P.bbi[7] * u1[3]; i2 += P.bbi[11] * u2[3]; i3 += P.bbi[15] * u3[3];
    const float pr = (r0 + r1) + (r2 + r3), pi = (i0 + i1) + (i2 + i3);
    const float nxr = P.abr * xr - P.abi * xi + pr, nxi = P.abr * xi + P.abi * xr + pi;
    xr = nxr; xi = nxi;
}
__device__ __forceinline__ void s5_wave_operands(const Args& a, int layer, int w, int qi, int hi, bf16x8 (&bre)[2][2], bf16x8 (&bim)[2][2], f32x4 (&ab)[2]) {
#pragma unroll
    for (int gg = 0; gg < 2; ++gg) {
        const int lg = layer * 16 + 2 * w + gg;
#pragma unroll
        for (int sh = 0; sh < 2; ++sh) {
            const bf16_t* pb = (const bf16_t*)(a.ws + WS_S5B) + ((size_t)(lg * 2) * 64 + qi + 32 * sh) * 16 + 8 * hi;
            bre[gg][sh] = *(const bf16x8*)pb; bim[gg][sh] = *(const bf16x8*)(pb + 64 * 16);
        }
    }
#pragma unroll
    for (int sh = 0; sh < 2; ++sh) ab[sh] = ((const f32x4*)(a.ws + WS_S5A))[(layer * 16 + 2 * w + hi) * 64 + qi + 32 * sh];
}
#define S5_MFMA32(a, b, c) __builtin_amdgcn_mfma_f32_32x32x16_bf16(a, b, c, 0, 0, 0)
__device__ __forceinline__ void s5_state_params(const Args& a, int layer, int g, int st, float& abr, float& abi, float& cr, float& ci, float& dtar, float& dtai) {
    const int lg = layer * 16 + g;
    const float dt = expf(a.in[17][lg]);
    const float ar = a.in[15][lg * 64 + st], ai = a.in[16][lg * 64 + st];
    dtar = dt * ar; dtai = dt * ai;
    const float mag = expf(dtar);
    abr = mag * cosf(dtai); abi = mag * sinf(dtai);
    const float den = ar * ar + ai * ai, nr = abr - 1.f, ni = abi;
    cr = (nr * ar + ni * ai) / den; ci = (ni * ar - nr * ai) / den;
}
__device__ __forceinline__ void s5_wave_operands_v82(const Args& a, int layer, int w, int qi, int hi, bf16x8 (&bre)[2][2], bf16x8 (&bim)[2][2], float (&abr)[2], float (&abi)[2], float (&dtr)[2], float (&dti)[2]) {
#pragma unroll
    for (int gg = 0; gg < 2; ++gg) {
        const int g = 2 * w + gg, lg = layer * 16 + g;
#pragma unroll
        for (int sh = 0; sh < 2; ++sh) {
            const int st = qi + 32 * sh;
            float ar_, ai_, cr, ci, dtar, dtai; s5_state_params(a, layer, g, st, ar_, ai_, cr, ci, dtar, dtai);
            const float* brp = a.in[18] + ((size_t)lg * 64 + st) * 16 + 8 * hi; const float* bip = a.in[19] + ((size_t)lg * 64 + st) * 16 + 8 * hi;
            float vr[8], vi[8];
#pragma unroll
            for (int c = 0; c < 8; ++c) { const float br = brp[c], bi = bip[c]; vr[c] = cr * br - ci * bi; vi[c] = cr * bi + ci * br; }
            u32x4 pr, pi; pr.x = pk2(vr[0], vr[1]); pr.y = pk2(vr[2], vr[3]); pr.z = pk2(vr[4], vr[5]); pr.w = pk2(vr[6], vr[7]);
            pi.x = pk2(vi[0], vi[1]); pi.y = pk2(vi[2], vi[3]); pi.z = pk2(vi[4], vi[5]); pi.w = pk2(vi[6], vi[7]);
            bre[gg][sh] = __builtin_bit_cast(bf16x8, pr); bim[gg][sh] = __builtin_bit_cast(bf16x8, pi);
            if (gg == hi) { abr[sh] = ar_; abi[sh] = ai_; dtr[sh] = dtar; dti[sh] = dtai; }
        }
    }
}
__device__ __forceinline__ void s5_pass1_unit(const Args& a, unsigned char* lds, int layer, int b, int c) {
    int tid = threadIdx.x; asm volatile("" : "+v"(tid));
    const int lane = tid & 63, w = __builtin_amdgcn_readfirstlane(tid >> 6), qi = lane & 31, hi = lane >> 5;
    const bf16_t* su = (const bf16_t*)(a.ws + WS_SU) + ((size_t)b * S + c * S5_TC) * 256;
    float* sst = (float*)(a.ws + WS_SST);
    const int ag = (qi >> 2) & 1;
    const bf16_t* aup = su + (size_t)(4 * (qi >> 3) + (qi & 3)) * 256 + 32 * w + 16 * ag + 8 * hi;
    u32x4 an = *(const u32x4*)aup;
    bf16x8 bre[2][2], bim[2][2]; float abr[2], abi[2], dtr[2], dti[2];
    s5_wave_operands_v82(a, layer, w, qi, hi, bre, bim, abr, abi, dtr, dti);
    float xr[2] = {0.f, 0.f}, xi[2] = {0.f, 0.f};
#pragma unroll
    for (int blk = 0; blk < 4; ++blk) {
        const u32x4 zero4 = (u32x4){0u, 0u, 0u, 0u};
        const bf16x8 a1 = __builtin_bit_cast(bf16x8, ag ? zero4 : an), a2 = __builtin_bit_cast(bf16x8, ag ? an : zero4);
        if (blk < 3) an = *(const u32x4*)(aup + (size_t)(blk + 1) * 16 * 256);
        f32x16 dre[2], dim[2];
#pragma unroll
        for (int sh = 0; sh < 2; ++sh) {
            dre[sh] = S5_MFMA32(a1, bre[0][sh], (f32x16){}); dre[sh] = S5_MFMA32(a2, bre[1][sh], dre[sh]);
            dim[sh] = S5_MFMA32(a1, bim[0][sh], (f32x16){}); dim[sh] = S5_MFMA32(a2, bim[1][sh], dim[sh]);
        }
#pragma unroll
        for (int tt = 0; tt < 16; ++tt)
#pragma unroll
            for (int sh = 0; sh < 2; ++sh) {
                const float nxr = abr[sh] * xr[sh] - abi[sh] * xi[sh] + dre[sh][tt], nxi = abr[sh] * xi[sh] + abi[sh] * xr[sh] + dim[sh][tt];
                xr[sh] = nxr; xi[sh] = nxi;
            }
    }
    float* sp = sst + (((size_t)b * 16 + 2 * w + hi) * S5_NCH + c) * 128;
#pragma unroll
    for (int sh = 0; sh < 2; ++sh) { sp[qi + 32 * sh] = xr[sh]; sp[64 + qi + 32 * sh] = xi[sh]; }
}
constexpr int P3_XS = 0, P3_XS_W = 2 * 16 * 272, P3_GS = 8 * P3_XS_W, P3_GS_P = 528, P3_US = P3_GS + 64 * P3_GS_P, P3_END = P3_US + 8 * 2048;
__device__ __forceinline__ void s5_pass2_unit(const Args& a, unsigned char* lds, int layer, int b, int seg) {
    int tid = threadIdx.x; asm volatile("" : "+v"(tid));
    const int lane = tid & 63, w = __builtin_amdgcn_readfirstlane(tid >> 6);
    const int qi = lane & 31, hi = lane >> 5, l15 = lane & 15, kg = lane >> 4;
    const bf16_t* su = (const bf16_t*)(a.ws + WS_SU) + ((size_t)b * S + seg * 256) * 256;
    const float* sst = (const float*)(a.ws + WS_SST);
    bf16x8 bre[2][2], bim[2][2]; float abr[2], abi[2], xr[2], xi[2]; bf16x8 cm[2][4]; f32x4 dsk[2];
    {
        f32x4 ab[2];
        s5_wave_operands(a, layer, w, qi, hi, bre, bim, ab);
        float cr2[2] = {0.f, 0.f}, ci2[2] = {0.f, 0.f};
#pragma unroll
        for (int sh = 0; sh < 2; ++sh) { abr[sh] = ab[sh][0]; abi[sh] = ab[sh][1]; }
        const float* sp = sst + (((size_t)b * 16 + 2 * w + hi) * S5_NCH) * 128 + qi;
        const int nprev = 4 * seg;
        int j0 = 0;
        for (; j0 + 8 <= nprev; j0 += 8) {
            float sr[2][8], si[2][8];
#pragma unroll
            for (int u = 0; u < 8; ++u)
#pragma unroll
                for (int sh = 0; sh < 2; ++sh) { sr[sh][u] = sp[(size_t)(j0 + u) * 128 + 32 * sh]; si[sh][u] = sp[(size_t)(j0 + u) * 128 + 64 + 32 * sh]; }
#pragma unroll
            for (int u = 0; u < 8; ++u)
#pragma unroll
                for (int sh = 0; sh < 2; ++sh) { const float t0 = ab[sh][2] * cr2[sh] - ab[sh][3] * ci2[sh] + sr[sh][u], t1 = ab[sh][2] * ci2[sh] + ab[sh][3] * cr2[sh] + si[sh][u]; cr2[sh] = t0; ci2[sh] = t1; }
        }
        if (j0 < nprev) {
            float sr[2][4], si[2][4];
#pragma unroll
            for (int u = 0; u < 4; ++u)
#pragma unroll
                for (int sh = 0; sh < 2; ++sh) { sr[sh][u] = sp[(size_t)(j0 + u) * 128 + 32 * sh]; si[sh][u] = sp[(size_t)(j0 + u) * 128 + 64 + 32 * sh]; }
#pragma unroll
            for (int u = 0; u < 4; ++u)
#pragma unroll
                for (int sh = 0; sh < 2; ++sh) { const float t0 = ab[sh][2] * cr2[sh] - ab[sh][3] * ci2[sh] + sr[sh][u], t1 = ab[sh][2] * ci2[sh] + ab[sh][3] * cr2[sh] + si[sh][u]; cr2[sh] = t0; ci2[sh] = t1; }
        }
#pragma unroll
        for (int sh = 0; sh < 2; ++sh) { xr[sh] = cr2[sh]; xi[sh] = ci2[sh]; }
    }
#pragma unroll
    for (int gg = 0; gg < 2; ++gg) {
        const int g = 2 * w + gg, lg = layer * 16 + g;
        const float* crp = a.in[20] + ((size_t)lg * 16 + l15) * 64; const float* cip = a.in[21] + ((size_t)lg * 16 + l15) * 64;
#pragma unroll
        for (int ks = 0; ks < 4; ++ks) {
            const int k0 = 32 * ks + 8 * kg;
            float v[8];
#pragma unroll
            for (int j = 0; j < 8; ++j) v[j] = (k0 < 64) ? crp[k0 + j] : -cip[k0 - 64 + j];
            u32x4 pw; pw.x = pk2(v[0], v[1]); pw.y = pk2(v[2], v[3]); pw.z = pk2(v[4], v[5]); pw.w = pk2(v[6], v[7]);
            cm[gg][ks] = __builtin_bit_cast(bf16x8, pw);
        }
        dsk[gg] = *(const f32x4*)(a.in[22] + lg * 16 + 4 * kg);
    }
    unsigned char* xs = lds + P3_XS + w * P3_XS_W;
    const bf16_t* gluT = (const bf16_t*)(a.ws + WS_GLU) + (size_t)layer * 65536;
    const float* glub = a.in[24] + layer * 256;
    bf16_t* mix = (bf16_t*)(a.ws + WS_MIX) + ((size_t)b * S + seg * 256) * D + 768;
    LAS3 float* ul = (LAS3 float*)(LAS3 unsigned char*)(lds + P3_US + w * 2048);
    const int utq = lane >> 3, ucc = lane & 7;
    const bf16_t* sup = su + (size_t)utq * 256 + 32 * w + 4 * ucc;
    u32x2 un0 = *(const u32x2*)(sup), un1 = *(const u32x2*)(sup + (size_t)8 * 256);
    const int ag = (qi >> 2) & 1;
    const bf16_t* aup = su + (size_t)(4 * (qi >> 3) + (qi & 3)) * 256 + 32 * w + 16 * ag + 8 * hi;
    u32x4 an = *(const u32x4*)aup;
#define S5_UNPK(v) (f32x4){__uint_as_float((v).x << 16), __uint_as_float((v).x & 0xffff0000u), __uint_as_float((v).y << 16), __uint_as_float((v).y & 0xffff0000u)}
    for (int sub = 0; sub < 4; ++sub) {
        for (int blk = 0; blk < 4; ++blk) {
            const int t0 = sub * 64 + blk * 16;
            *(LAS3 f32x4*)(ul + utq * 32 + 4 * ucc) = S5_UNPK(un0); *(LAS3 f32x4*)(ul + (8 + utq) * 32 + 4 * ucc) = S5_UNPK(un1);
            if (t0 + 16 < 256) { un0 = *(const u32x2*)(sup + (size_t)(t0 + 16) * 256); un1 = *(const u32x2*)(sup + (size_t)(t0 + 24) * 256); }
            {
                const u32x4 zero4 = (u32x4){0u, 0u, 0u, 0u};
                const bf16x8 a1 = __builtin_bit_cast(bf16x8, ag ? zero4 : an), a2 = __builtin_bit_cast(bf16x8, ag ? an : zero4);
                if (t0 + 16 < 256) an = *(const u32x4*)(aup + (size_t)(t0 + 16) * 256);
                f32x16 dre[2], dim[2];
#pragma unroll
                for (int sh = 0; sh < 2; ++sh) {
                    dre[sh] = MFMA32(a1, bre[0][sh], (f32x16){}); dre[sh] = MFMA32(a2, bre[1][sh], dre[sh]);
                    dim[sh] = MFMA32(a1, bim[0][sh], (f32x16){}); dim[sh] = MFMA32(a2, bim[1][sh], dim[sh]);
                }
                bf16_t* xp0 = (bf16_t*)(xs + hi * (16 * 272));
#pragma unroll
                for (int tt = 0; tt < 16; ++tt) {
#pragma unroll
                    for (int sh = 0; sh < 2; ++sh) {
                        const float nxr = abr[sh] * xr[sh] - abi[sh] * xi[sh] + dre[sh][tt], nxi = abr[sh] * xi[sh] + abi[sh] * xr[sh] + dim[sh][tt];
                        xr[sh] = nxr; xi[sh] = nxi;
                        bf16_t* xp = xp0 + tt * 136;
                        xp[qi + 32 * sh] = f2bf(nxr); xp[64 + qi + 32 * sh] = f2bf(nxi);
                    }
                }
            }
#pragma unroll
            for (int gg = 0; gg < 2; ++gg) {
                const int g = 2 * w + gg;
                f32x4 acc = (f32x4){0.f, 0.f, 0.f, 0.f};
#pragma unroll
                for (int ks = 0; ks < 4; ++ks) { const bf16x8 bfr = *(const bf16x8*)(xs + gg * (16 * 272) + l15 * 272 + (32 * ks + 8 * kg) * 2); acc = __builtin_amdgcn_mfma_f32_16x16x32_bf16(cm[gg][ks], bfr, acc, 0, 0, 0); }
                const f32x4 uu = *(const LAS3 f32x4*)(ul + l15 * 32 + 16 * gg + 4 * kg);
                u32x2 gw; gw.x = pk2(gelu_tanh(acc[0] + dsk[gg][0] * uu[0]), gelu_tanh(acc[1] + dsk[gg][1] * uu[1])); gw.y = pk2(gelu_tanh(acc[2] + dsk[gg][2] * uu[2]), gelu_tanh(acc[3] + dsk[gg][3] * uu[3]));
                *(u32x2*)(lds + P3_GS + (blk * 16 + l15) * P3_GS_P + (g * 16 + 4 * kg) * 2) = gw;
            }
        }
        __syncthreads();
#pragma unroll
        for (int tb = 0; tb < 2; ++tb) {
            f32x16 acc = (f32x16){};
#pragma unroll
            for (int ks = 0; ks < 16; ++ks) {
                const bf16x8 af = *(const bf16x8*)(gluT + (size_t)(32 * w + qi) * 256 + 16 * ks + 8 * hi);
                const bf16x8 bfr = *(const bf16x8*)(lds + P3_GS + (32 * tb + qi) * P3_GS_P + (16 * ks + 8 * hi) * 2);
                acc = MFMA32(af, bfr, acc);
            }
#pragma unroll
            for (int r4 = 0; r4 < 4; ++r4) {
                const int nn = 32 * w + 8 * r4 + 4 * hi;
                const u32x2 gq = *(const u32x2*)(lds + P3_GS + (32 * tb + qi) * P3_GS_P + nn * 2);
                const f32x4 bb = *(const f32x4*)(glub + nn);
                float ov[4];
#pragma unroll
                for (int e = 0; e < 4; ++e) {
                    const float gval = __uint_as_float(((e & 1) ? (((e >> 1) ? gq.y : gq.x) & 0xffff0000u) : (((e >> 1) ? gq.y : gq.x) << 16)));
                    ov[e] = gval / (1.f + __expf(-(acc[4 * r4 + e] + bb[e])));
                }
                u32x2 ow; ow.x = pk2(ov[0], ov[1]); ow.y = pk2(ov[2], ov[3]);
                *(u32x2*)(mix + (size_t)(sub * 64 + 32 * tb + qi) * D + nn) = ow;
            }
        }
        __syncthreads();
    }
}
__device__ __forceinline__ void phase_p3_elementwise(const Args& a, int layer) {
    const size_t gt = (size_t)blockIdx.x * NTHR + threadIdx.x, gn = (size_t)gridDim.x * NTHR;
    const bf16_t* dp = (const bf16_t*)(a.ws + WS_DPART); const float* dl = (const float*)(a.ws + WS_DLSE); bf16_t* mix = (bf16_t*)(a.ws + WS_MIX);
    for (size_t i = gt; i < (size_t)T * 32; i += gn) {
        const size_t tok = i >> 5; const int ch = (int)(i & 31), h = ch >> 3;
        const float l0 = dl[tok * 4 + h], l1 = dl[((size_t)T + tok) * 4 + h], l2 = dl[((size_t)2 * T + tok) * 4 + h];
        const float mx = fmaxf(l0, fmaxf(l1, l2));
        float w0 = __builtin_amdgcn_exp2f(l0 - mx), w1 = __builtin_amdgcn_exp2f(l1 - mx), w2 = __builtin_amdgcn_exp2f(l2 - mx);
        const float inv = 1.f / (w0 + w1 + w2); w0 *= inv; w1 *= inv; w2 *= inv;
        const u32x4 a0 = *(const u32x4*)(dp + tok * 256 + ch * 8), a1 = *(const u32x4*)(dp + ((size_t)T + tok) * 256 + ch * 8), a2 = *(const u32x4*)(dp + ((size_t)2 * T + tok) * 256 + ch * 8);
        u32x4 o;
#pragma unroll
        for (int j = 0; j < 4; ++j) {
            const float lo = w0 * __uint_as_float(a0[j] << 16) + w1 * __uint_as_float(a1[j] << 16) + w2 * __uint_as_float(a2[j] << 16);
            const float hi = w0 * __uint_as_float(a0[j] & 0xffff0000u) + w1 * __uint_as_float(a1[j] & 0xffff0000u) + w2 * __uint_as_float(a2[j] & 0xffff0000u);
            o[j] = pk2(lo, hi);
        }
        *(u32x4*)(mix + tok * D + 256 + ch * 8) = o;
    }
    {
        const int lane = threadIdx.x & 63, wv = blockIdx.x * 8 + (threadIdx.x >> 6), nw = gridDim.x * 8;
        const float* pu = a.in[27] + (size_t)layer * NEXP * D; const float* pv = a.in[28] + (size_t)layer * NEXP * D; const float* gn_ = a.in[5] + layer * D;
        unsigned char* ut = a.ws + WS_UT; unsigned char* vt = a.ws + WS_VT; float* scl = (float*)(a.ws + WS_US);
        float g[16]; load_row16(gn_, lane, g);
        for (int r = wv; r < 2 * NEXP; r += nw) {
            const bool isv = r >= NEXP; const int e = isv ? r - NEXP : r;
            float v[16]; load_row16((isv ? pv : pu) + (size_t)e * D, lane, v);
            float sq = 0.f;
#pragma unroll
            for (int i = 0; i < 16; ++i) { if (!isv) v[i] *= g[i]; sq += v[i] * v[i]; }
            sq = wave_sum(sq);
            const float sc = sq > 0.f ? 0.35f * sqrtf(sq * (1.f / 1024.f)) : 1.f, inv = 1.f / sc;
            u32x2 w;
#pragma unroll
            for (int j = 0; j < 2; ++j) {
                unsigned pk = 0u;
#pragma unroll
                for (int i = 0; i < 8; ++i) { int q = (int)rintf(v[8 * j + i] * inv); q = q > 7 ? 7 : (q < -7 ? -7 : q);
                    pk |= ((unsigned)(isv && (i < 4 || !HK_PEER_SPLIT) ? q + 8 : q) & 0xfu) << (i < 4 ? 8 * i : 8 * (i - 4) + 4); }
                w[j] = pk;
            }
            *(u32x2*)((isv ? vt : ut) + (size_t)e * 512 + 8 * lane) = w;
            if (lane == 0) scl[2 * e + (isv ? 1 : 0)] = isv || HK_PEER_SPLIT ? sc : sc * (1.f / 16.f);
        }
    }
}

__device__ __forceinline__ unsigned srt(float f) { const unsigned u = __float_as_uint(f); return u ^ ((unsigned)((int)u >> 31) | 0x80000000u); }
__device__ __forceinline__ float unsrt(unsigned u) { return __uint_as_float(u ^ ((~(unsigned)((int)u >> 31)) | 0x80000000u)); }
#define CEX(a, b) do { const unsigned x_ = (a), y_ = (b); (a) = x_ > y_ ? x_ : y_; (b) = x_ > y_ ? y_ : x_; } while (0)
__device__ __forceinline__ void bitonic_merge16(unsigned (&v)[16]) {
#pragma unroll
    for (int d = 8; d >= 1; d >>= 1)
#pragma unroll
        for (int i = 0; i < 16; ++i) if ((i & d) == 0) CEX(v[i], v[i + d]);
}
__device__ __forceinline__ void sort16_desc(unsigned (&v)[16]) {
    CEX(v[0], v[13]); CEX(v[1], v[12]); CEX(v[2], v[15]); CEX(v[3], v[14]); CEX(v[4], v[8]); CEX(v[5], v[6]); CEX(v[7], v[11]); CEX(v[9], v[10]);
    CEX(v[0], v[5]); CEX(v[1], v[7]); CEX(v[2], v[9]); CEX(v[3], v[4]); CEX(v[6], v[13]); CEX(v[8], v[14]); CEX(v[10], v[15]); CEX(v[11], v[12]);
    CEX(v[0], v[1]); CEX(v[2], v[3]); CEX(v[4], v[5]); CEX(v[6], v[8]); CEX(v[7], v[9]); CEX(v[10], v[11]); CEX(v[12], v[13]); CEX(v[14], v[15]);
    CEX(v[0], v[2]); CEX(v[1], v[3]); CEX(v[4], v[10]); CEX(v[5], v[11]); CEX(v[6], v[7]); CEX(v[8], v[9]); CEX(v[12], v[14]); CEX(v[13], v[15]);
    CEX(v[1], v[2]); CEX(v[3], v[12]); CEX(v[4], v[6]); CEX(v[5], v[7]); CEX(v[8], v[10]); CEX(v[9], v[11]); CEX(v[13], v[14]);
    CEX(v[1], v[4]); CEX(v[2], v[6]); CEX(v[5], v[8]); CEX(v[7], v[10]); CEX(v[9], v[13]); CEX(v[11], v[14]);
    CEX(v[2], v[4]); CEX(v[3], v[6]); CEX(v[9], v[12]); CEX(v[11], v[13]);
    CEX(v[3], v[5]); CEX(v[6], v[8]); CEX(v[7], v[9]); CEX(v[10], v[12]);
    CEX(v[3], v[4]); CEX(v[5], v[6]); CEX(v[7], v[8]); CEX(v[9], v[10]); CEX(v[11], v[12]);
    CEX(v[6], v[7]); CEX(v[8], v[9]);
}
__device__ __forceinline__ void merge_top16(unsigned (&a)[16], const unsigned (&b)[16]) {
#pragma unroll
    for (int j = 0; j < 16; ++j) a[j] = a[j] > b[15 - j] ? a[j] : b[15 - j];
    bitonic_merge16(a);
}
__device__ __forceinline__ void ins16(unsigned (&top)[16], unsigned pk) {
#pragma unroll
    for (int j = 0; j < 16; ++j) { const unsigned hi_ = top[j] > pk ? top[j] : pk; pk = top[j] > pk ? pk : top[j]; top[j] = hi_; }
}
__device__ __forceinline__ void merge_halves(unsigned (&top)[16]) {
    unsigned lo[16], hi[16];
#pragma unroll
    for (int j = 0; j < 16; ++j) { auto rr = __builtin_amdgcn_permlane32_swap(top[j], top[j], false, false); lo[j] = rr[0]; hi[j] = rr[1]; }
#pragma unroll
    for (int j = 0; j < 16; ++j) top[j] = lo[j] > hi[15 - j] ? lo[j] : hi[15 - j];
#pragma unroll
    for (int d = 8; d >= 1; d >>= 1)
#pragma unroll
        for (int i = 0; i < 16; ++i) if ((i & d) == 0) { const unsigned x = top[i], y = top[i + d]; top[i] = x > y ? x : y; top[i + d] = x > y ? y : x; }
}
constexpr int P6_PL = 0, P6_RS = 32768, P6_DOT = 32768 + 128, P6_LST = P6_DOT + 8 * 1024, P6_END = P6_LST + 8 * 8192;
__device__ __forceinline__ float dot8(const u32x4& a, const unsigned (&xh)[4], float acc) {
#pragma unroll
    for (int j = 0; j < 4; ++j) { acc += __uint_as_float(a[j] << 16) * __uint_as_float(xh[j] << 16); acc += __uint_as_float(a[j] & 0xffff0000u) * __uint_as_float(xh[j] & 0xffff0000u); }
    return acc;
}
__device__ __forceinline__ void peer_unit(const Args& a, unsigned char* lds, int layer, int unit) {
    int tid = threadIdx.x; asm volatile("" : "+v"(tid));
    const int lane = tid & 63, w = __builtin_amdgcn_readfirstlane(tid >> 6), qi = lane & 31, hi = lane >> 5;
    const int tok0 = unit * 32;
#if defined(HK_PROBE_PHASE) && HK_PROBE_PHASE == 10
    unsigned long long pq0_ = 0; if (blockIdx.x == 0 && threadIdx.x == 0) pq0_ = __builtin_amdgcn_s_memrealtime();
#endif
    const bf16_t* xg = (const bf16_t*)(a.ws + WS_XB);
    float* rsl = (float*)(lds + P6_RS);
    {
        u32x4 xr[4][2];
#pragma unroll
        for (int tt = 0; tt < 4; ++tt) { const bf16_t* p = xg + (size_t)(tok0 + 4 * w + tt) * D + 16 * lane; xr[tt][0] = *(const u32x4*)p; xr[tt][1] = *(const u32x4*)(p + 8); }
#pragma unroll
        for (int tt = 0; tt < 4; ++tt) {
            float ss = 0.f;
#pragma unroll
            for (int j = 0; j < 2; ++j)
#pragma unroll
                for (int e = 0; e < 4; ++e) { const float lo = __uint_as_float(xr[tt][j][e] << 16), hi_ = __uint_as_float(xr[tt][j][e] & 0xffff0000u); ss += lo * lo + hi_ * hi_; }
            ss = wave_sum(ss);
            if (lane == 0) rsl[4 * w + tt] = __builtin_amdgcn_rsqf(ss * (1.f / 1024.f) + EPS);
        }
    }
    __syncthreads();
    {
        const float rs2 = rsl[qi];
        const bf16_t* qrow = (const bf16_t*)(a.ws + WS_ZB) + (size_t)(tok0 + qi) * 2048 + 256 * w;
        const bf16_t* kb_ = (const bf16_t*)(a.ws + WS_KEYS) + (size_t)(layer * 16 + 2 * w) * 128 * 128;
        unsigned* lsw = (unsigned*)(lds + P6_LST) + w * 2048 + lane;
#if HK_FOLD_KEYS
        const bf16_t* srow = (const bf16_t*)(a.ws + WS_ZB) + (size_t)(tok0 + qi) * 2048 + 256 * w + 64 * hi;
        u32x4 sv[2][8];
#pragma unroll
        for (int p = 0; p < 2; ++p)
#pragma unroll
            for (int j = 0; j < 8; ++j) sv[p][j] = *(const u32x4*)(srow + 128 * p + 8 * j);
#pragma unroll
        for (int p = 0; p < 2; ++p) {
            unsigned top[16];
#pragma unroll
            for (int kb = 0; kb < 4; ++kb) {
                unsigned cur[16];
#pragma unroll
                for (int j = 0; j < 2; ++j)
#pragma unroll
                    for (int e = 0; e < 4; ++e) {
                        const unsigned wd = sv[p][2 * kb + j][e];
                        const unsigned lo = wd & 0xffffu, hi16 = wd >> 16;
                        const unsigned slo = lo ^ ((lo & 0x8000u) ? 0xffffu : 0x8000u), shi = hi16 ^ ((hi16 & 0x8000u) ? 0xffffu : 0x8000u);
                        const unsigned idx = (unsigned)(64 * hi + 16 * kb + 8 * j + 2 * e);
                        cur[8 * j + 2 * e] = (slo << 16) | idx; cur[8 * j + 2 * e + 1] = (shi << 16) | (idx + 1u);
                    }
                sort16_desc(cur);
                if (kb == 0) {
#pragma unroll
                    for (int j = 0; j < 16; ++j) top[j] = cur[j];
                } else merge_top16(top, cur);
            }
            merge_halves(top);
#pragma unroll
            for (int j = 0; j < 16; ++j) { const unsigned s16 = top[j] >> 16; const unsigned hb = s16 ^ ((s16 & 0x8000u) ? 0x8000u : 0xffffu);
                const _Float16 hv = __builtin_bit_cast(_Float16, (unsigned short)hb);
                lsw[(p * 16 + j) * 64] = (srt((float)hv) & ~127u) | (top[j] & 127u); }
        }
#else
        bf16x8 qf2[2][8];
#pragma unroll
        for (int p = 0; p < 2; ++p)
#pragma unroll
            for (int ks = 0; ks < 8; ++ks) qf2[p][ks] = *(const bf16x8*)(qrow + 128 * p + 16 * ks + 8 * hi);
#pragma unroll
        for (int p = 0; p < 2; ++p) {
            const bf16x8 (&qf)[8] = qf2[p];
            unsigned top[16];
            bf16x8 kfn[8];
#pragma unroll
            for (int ks = 0; ks < 8; ++ks) kfn[ks] = *(const bf16x8*)(kb_ + ((size_t)p * 128 + qi) * 128 + 16 * ks + 8 * hi);
#pragma unroll 1
            for (int kb = 0; kb < 4; ++kb) {
                f32x16 acc = (f32x16){};
#pragma unroll
                for (int ks = 0; ks < 8; ++ks) acc = MFMA32(kfn[ks], qf[ks], acc);
                if (kb < 3) {
#pragma unroll
                    for (int ks = 0; ks < 8; ++ks) kfn[ks] = *(const bf16x8*)(kb_ + ((size_t)p * 128 + 32 * (kb + 1) + qi) * 128 + 16 * ks + 8 * hi);
                }
                unsigned cur[16];
#pragma unroll
                for (int r = 0; r < 16; ++r) cur[r] = (srt(acc[r]) & ~127u) | (unsigned)(32 * kb + (r & 3) + 8 * (r >> 2) + 4 * hi);
                sort16_desc(cur);
                if (kb == 0) {
#pragma unroll
                    for (int j = 0; j < 16; ++j) top[j] = cur[j];
                } else merge_top16(top, cur);
            }
            merge_halves(top);
#pragma unroll
            for (int j = 0; j < 16; ++j) lsw[(p * 16 + j) * 64] = top[j];
        }
#endif
        unsigned best[16];
#pragma unroll
        for (int j = 0; j < 16; ++j) best[j] = 0u;
#pragma unroll 1
        for (int i = hi; i < 16; i += 2) {
            const unsigned ai = lsw[i * 64]; const float vai = unsrt(ai & ~127u); const unsigned iai = (ai & 127u) << 7;
            const int nj = 16 / (i + 1);
#pragma unroll 1
            for (int j = 0; j < nj; ++j) { const unsigned bj = lsw[(16 + j) * 64]; ins16(best, (srt(vai + unsrt(bj & ~127u)) & ~0x3FFFu) | iai | (bj & 127u)); }
        }
        merge_halves(best);
        float e[16], sum = 0.f;
        const float s0 = unsrt(best[0] & ~0x3FFFu);
#pragma unroll
        for (int j = 0; j < 16; ++j) { e[j] = __builtin_amdgcn_exp2f((unsrt(best[j] & ~0x3FFFu) - s0) * rs2 * LOG2E); sum += e[j]; }
        const float inv = 1.f / sum;
        if (hi == 0) {
            u32x2* pl = (u32x2*)(lds + P6_PL) + qi * 128 + 16 * w;
#pragma unroll
            for (int j = 0; j < 16; ++j) { u32x2 en; en.x = best[j] & 0x3FFFu; en.y = __float_as_uint(e[j] * inv); pl[j] = en; }
        }
    }
    __syncthreads();
#if defined(HK_PROBE_PHASE) && HK_PROBE_PHASE == 10
    if (blockIdx.x == 0 && threadIdx.x == 0) { volatile LAS3 unsigned* pw_ = (volatile LAS3 unsigned*)(LAS3 unsigned char*)(lds + LDS_CTL + 48); *pw_ = *pw_ + (unsigned)(__builtin_amdgcn_s_memrealtime() - pq0_); }
#endif
    const unsigned char* ut = a.ws + WS_UT; const unsigned char* vt = a.ws + WS_VT; const float* scl = (const float*)(a.ws + WS_US);
    float* dots = (float*)(lds + P6_DOT) + w * 256; float* cfs = dots + 128;
    int vz_; asm volatile("v_mov_b32 %0, 0" : "=v"(vz_));
    const int lane_g = lane + vz_, hi_g = lane_g >> 5;
    const int c32 = lane_g & 31, slot = 2 * c32 + hi_g;
#define PG_ISSUE(buf, tab, plp, b) do { _Pragma("unroll") for (int kk = 0; kk < 8; ++kk) { const unsigned id_ = (plp)[16 * (b) + 8 * hi_g + kk].x; buf[kk] = *(const u32x4*)((tab) + (unsigned)(id_ * 512u + 16u * (unsigned)c32)); } } while (0)
#define PG_CU(buf, b) do { int pd_[8]; \
        _Pragma("unroll") for (int kk = 0; kk < 8; ++kk) { int d_ = 0; \
            _Pragma("unroll") for (int j = 0; j < 4; ++j) { d_ = __builtin_amdgcn_sdot4((int)((buf[kk][j] << 4) & 0xF0F0F0F0u), xq[2 * j], d_, false); d_ = __builtin_amdgcn_sdot4((int)(buf[kk][j] & 0xF0F0F0F0u), xq[2 * j + 1], d_, false); } \
            pd_[kk] = d_; } \
        int r4_[4]; \
        _Pragma("unroll") for (int j = 0; j < 4; ++j) { auto rr_ = __builtin_amdgcn_permlane16_swap((unsigned)pd_[j], (unsigned)pd_[j + 4], false, false); r4_[j] = (int)rr_[0] + (int)rr_[1]; } \
        _Pragma("unroll") for (int j = 0; j < 4; ++j) { int v_ = r4_[j]; \
            v_ += __builtin_amdgcn_update_dpp(0, v_, 0xB1, 0xf, 0xf, true); v_ += __builtin_amdgcn_update_dpp(0, v_, 0x4E, 0xf, 0xf, true); \
            v_ += __builtin_amdgcn_update_dpp(0, v_, 0x141, 0xf, 0xf, true); v_ += __builtin_amdgcn_update_dpp(0, v_, 0x140, 0xf, 0xf, true); r4_[j] = v_; } \
        if ((lane_g & 15) == 0) { const int q_ = lane_g >> 4; *(f32x4*)(dots + 16 * (b) + 8 * (q_ >> 1) + 4 * (q_ & 1)) = (f32x4){(float)r4_[0], (float)r4_[1], (float)r4_[2], (float)r4_[3]}; } } while (0)
#define PG_T4(r0, r1, r2, r3, t0, t1, t2, t3) do { const unsigned a01l_ = __builtin_amdgcn_perm(r1, r0, 0x05010400u), a01h_ = __builtin_amdgcn_perm(r1, r0, 0x07030602u), \
            a23l_ = __builtin_amdgcn_perm(r3, r2, 0x05010400u), a23h_ = __builtin_amdgcn_perm(r3, r2, 0x07030602u); \
        t0 = __builtin_amdgcn_perm(a23l_, a01l_, 0x05040100u); t1 = __builtin_amdgcn_perm(a23l_, a01l_, 0x07060302u); \
        t2 = __builtin_amdgcn_perm(a23h_, a01h_, 0x05040100u); t3 = __builtin_amdgcn_perm(a23h_, a01h_, 0x07060302u); } while (0)
#define PG_CV(buf, b) do { _Pragma("unroll") for (int g4 = 0; g4 < 2; ++g4) { const int cq_ = (int)cqw[4 * (b) + 2 * hi_g + g4]; \
            _Pragma("unroll") for (int j = 0; j < 4; ++j) { \
                const unsigned w0_ = buf[4 * g4][j], w1_ = buf[4 * g4 + 1][j], w2_ = buf[4 * g4 + 2][j], w3_ = buf[4 * g4 + 3][j]; \
                unsigned t0_, t1_, t2_, t3_; \
                PG_T4(w0_ & 0x0F0F0F0Fu, w1_ & 0x0F0F0F0Fu, w2_ & 0x0F0F0F0Fu, w3_ & 0x0F0F0F0Fu, t0_, t1_, t2_, t3_); \
                oa[8 * j + 0] = __builtin_amdgcn_sdot4((int)t0_, cq_, oa[8 * j + 0], false); oa[8 * j + 1] = __builtin_amdgcn_sdot4((int)t1_, cq_, oa[8 * j + 1], false); \
                oa[8 * j + 2] = __builtin_amdgcn_sdot4((int)t2_, cq_, oa[8 * j + 2], false); oa[8 * j + 3] = __builtin_amdgcn_sdot4((int)t3_, cq_, oa[8 * j + 3], false); \
                PG_T4((w0_ >> 4) & 0x0F0F0F0Fu, (w1_ >> 4) & 0x0F0F0F0Fu, (w2_ >> 4) & 0x0F0F0F0Fu, (w3_ >> 4) & 0x0F0F0F0Fu, t0_, t1_, t2_, t3_); \
                oa[8 * j + 4] = __builtin_amdgcn_sdot4((int)t0_, cq_, oa[8 * j + 4], false); oa[8 * j + 5] = __builtin_amdgcn_sdot4((int)t1_, cq_, oa[8 * j + 5], false); \
                oa[8 * j + 6] = __builtin_amdgcn_sdot4((int)t2_, cq_, oa[8 * j + 6], false); oa[8 * j + 7] = __builtin_amdgcn_sdot4((int)t3_, cq_, oa[8 * j + 7], false); \
                asm volatile("" : "+v"(oa[8 * j]), "+v"(oa[8 * j + 1]), "+v"(oa[8 * j + 2]), "+v"(oa[8 * j + 3]), "+v"(oa[8 * j + 4]), "+v"(oa[8 * j + 5]), "+v"(oa[8 * j + 6]), "+v"(oa[8 * j + 7])); } } } while (0)
#define PG_SB __builtin_amdgcn_sched_barrier(0)
    u32x4 bA[8], bB[8];
    { const u32x2* pl0 = (const u32x2*)(lds + P6_PL) + (4 * w) * 128; PG_ISSUE(bA, ut, pl0, 0); }
    for (int tt = 0; tt < 4; ++tt) {
        const int tl = 4 * w + tt, tok = tok0 + tl;
        const float rs2 = rsl[tl];
        const u32x2* pl = (const u32x2*)(lds + P6_PL) + tl * 128;
        const u32x2 en0 = pl[lane_g], en1 = pl[64 + lane_g];
        const float2 sc0_ = *(const float2*)(scl + 2 * (size_t)en0.x), sc1_ = *(const float2*)(scl + 2 * (size_t)en1.x);
        const float us0 = sc0_.x, us1 = sc1_.x, vs0 = sc0_.y, vs1 = sc1_.y;
        float xv[16]; load_row16_bf(xg + (size_t)tok * D, slot, xv);
        float mx = 0.f;
#pragma unroll
        for (int i = 0; i < 16; ++i) mx = fmaxf(mx, fabsf(xv[i]));
#pragma unroll
        for (int o = 32; o > 0; o >>= 1) mx = fmaxf(mx, __shfl_xor(mx, o));
        const float sx = mx > 0.f ? mx * (1.f / 127.f) : 1.f, isx = 1.f / sx;
        int xq[8];
#pragma unroll
        for (int j = 0; j < 4; ++j) {
            unsigned pk = 0u;
#pragma unroll
            for (int i = 0; i < 4; ++i) { const int q = (int)rintf(xv[4 * j + i] * isx); pk |= ((unsigned)q & 0xffu) << (8 * i); }
            auto rr = __builtin_amdgcn_permlane32_swap(pk, pk, false, false);
            xq[j] = (int)rr[0]; xq[4 + j] = (int)rr[1];
        }
#pragma unroll
        for (int ub = 0; ub < 8; ub += 2) {
            PG_ISSUE(bB, ut, pl, ub + 1); PG_SB; PG_CU(bA, ub); PG_SB;
            if (ub + 2 < 8) PG_ISSUE(bA, ut, pl, ub + 2); else PG_ISSUE(bA, vt, pl, 0);
            PG_SB; PG_CU(bB, ub + 1); PG_SB;
        }
        const float a0 = gelu_tanh(dots[lane_g] * (sx * rs2) * us0) * __uint_as_float(en0.y);
        const float a1 = gelu_tanh(dots[64 + lane_g] * (sx * rs2) * us1) * __uint_as_float(en1.y);
        const float c0 = a0 * vs0, c1 = a1 * vs1;
        float cm = fmaxf(fabsf(c0), fabsf(c1));
#pragma unroll
        for (int o = 32; o > 0; o >>= 1) cm = fmaxf(cm, __shfl_xor(cm, o));
        const float scc = cm > 0.f ? cm * (1.f / 127.f) : 1.f, iscc = 1.f / scc;
        const int q0c = (int)rintf(c0 * iscc), q1c = (int)rintf(c1 * iscc);
        volatile LAS3 signed char* cqb = (volatile LAS3 signed char*)(LAS3 unsigned char*)cfs;
        cqb[lane_g] = (signed char)q0c; cqb[64 + lane_g] = (signed char)q1c;
        const LAS3 unsigned* cqw = (const LAS3 unsigned*)(LAS3 unsigned char*)cfs;
        int qsum = q0c + q1c;
#pragma unroll
        for (int o = 32; o > 0; o >>= 1) qsum += __shfl_xor(qsum, o);
        int oa[32];
#pragma unroll
        for (int i = 0; i < 32; ++i) oa[i] = 0;
        int vzv_; asm volatile("v_mov_b32 %0, 0" : "=v"(vzv_));
        const u32x2* plv = pl + vzv_;
#pragma unroll
        for (int vb = 0; vb < 8; vb += 2) {
            PG_ISSUE(bB, vt, plv, vb + 1); PG_SB; PG_CV(bA, vb); PG_SB;
            if (vb + 2 < 8) PG_ISSUE(bA, vt, plv, vb + 2); else if (tt < 3) PG_ISSUE(bA, ut, plv + 128, 0);
            PG_SB; PG_CV(bB, vb + 1); PG_SB;
        }
#pragma unroll
        for (int i = 0; i < 16; ++i) {
            auto rr = __builtin_amdgcn_permlane32_swap((unsigned)oa[i], (unsigned)oa[16 + i], false, false);
#ifndef HK_PROBE_NOPEER
            xv[i] += scc * (float)((int)rr[0] + (int)rr[1] - 8 * qsum);
#else
            xv[i] += 1e-30f * (float)((int)rr[0] + (int)rr[1]);
#endif
        }
#ifdef HK_PROBE_L2
        {
            int dsum = 0;
            for (int k = 0; k < 128; k += 32) {
                u32x4 ldx[16];
#pragma unroll
                for (int kk = 0; kk < 16; ++kk) { unsigned id = pl[k + 16 * hi_g + kk].x; if (HK_PROBE_L2 == 2) id &= 0x0FFFu; ldx[kk] = *(const u32x4*)(ut + (size_t)id * 512 + 16 * c32); }
#pragma unroll
                for (int kk = 0; kk < 16; ++kk) { dsum = __builtin_amdgcn_sdot4((int)ldx[kk].x, xq[0], dsum, false); dsum = __builtin_amdgcn_sdot4((int)ldx[kk].w, xq[1], dsum, false); }
            }
            xv[0] += 1e-30f * (float)dsum;
        }
#endif
        const bool more = layer + 1 < DEPTH;
        int vzt_; asm volatile("v_mov_b32 %0, 0" : "=v"(vzt_) : "v"(xv[0]));
        finish_token(tok, xv, more ? nullptr : a.out, (bf16_t*)(a.ws + WS_XB), (float*)(a.ws + WS_RSTD), more ? (const float*)(a.ws + WS_WF) + (size_t)(layer + 1) * 4096 : nullptr,
                     a.in[2] + (more ? (layer + 1) * 4 : 0), (float*)(a.ws + WS_FLOG), lane, slot + vzt_);
    }
#undef PG_ISSUE
#undef PG_SB
#undef PG_CU
#undef PG_CV
#undef PG_T4
    __syncthreads();
}
#if HK_FOLD_KEYS
__device__ __forceinline__ void peer_unit_a(const Args& a, unsigned char* lds, int layer, int unit) {
    int tid = threadIdx.x; asm volatile("" : "+v"(tid));
    const int lane = tid & 63, w = __builtin_amdgcn_readfirstlane(tid >> 6), qi = lane & 31, hi = lane >> 5;
    const int tok0 = unit * 32;
#if defined(HK_PROBE_PHASE) && HK_PROBE_PHASE == 10
    unsigned long long pq0_ = 0; if (blockIdx.x == 0 && threadIdx.x == 0) pq0_ = __builtin_amdgcn_s_memrealtime();
#endif
    const bf16_t* xg = (const bf16_t*)(a.ws + WS_XB);
    float* rsl = (float*)(lds + P6_RS);
    {
        u32x4 xr[4][2];
#pragma unroll
        for (int tt = 0; tt < 4; ++tt) { const bf16_t* p = xg + (size_t)(tok0 + 4 * w + tt) * D + 16 * lane; xr[tt][0] = *(const u32x4*)p; xr[tt][1] = *(const u32x4*)(p + 8); }
#pragma unroll
        for (int tt = 0; tt < 4; ++tt) {
            float ss = 0.f;
#pragma unroll
            for (int j = 0; j < 2; ++j)
#pragma unroll
                for (int e = 0; e < 4; ++e) { const float lo = __uint_as_float(xr[tt][j][e] << 16), hi_ = __uint_as_float(xr[tt][j][e] & 0xffff0000u); ss += lo * lo + hi_ * hi_; }
            ss = wave_sum(ss);
            if (lane == 0) rsl[4 * w + tt] = __builtin_amdgcn_rsqf(ss * (1.f / 1024.f) + EPS);
        }
    }
    const int tl_r = 4 * w + (qi >> 3), hd = qi & 7;
    {
        const float rs2 = rsl[tl_r];
        unsigned* lsw = (unsigned*)(lds + P6_LST) + w * 2048 + lane;
#if HK_FOLD_KEYS
        const bf16_t* srow = (const bf16_t*)(a.ws + WS_ZB) + (size_t)(tok0 + tl_r) * 2048 + 256 * hd + 64 * hi;
        u32x4 sv[2][8];
#pragma unroll
        for (int p = 0; p < 2; ++p)
#pragma unroll
            for (int j = 0; j < 8; ++j) sv[p][j] = *(const u32x4*)(srow + 128 * p + 8 * j);
#pragma unroll
        for (int p = 0; p < 2; ++p) {
            unsigned top[16];
#pragma unroll
            for (int kb = 0; kb < 4; ++kb) {
                unsigned cur[16];
#pragma unroll
                for (int j = 0; j < 2; ++j)
#pragma unroll
                    for (int e = 0; e < 4; ++e) {
                        const unsigned wd = sv[p][2 * kb + j][e];
                        typedef short s16x2_ __attribute__((ext_vector_type(2)));
                        const s16x2_ sg = __builtin_bit_cast(s16x2_, wd) >> 15;
                        const unsigned k2 = wd ^ ((__builtin_bit_cast(unsigned, sg) & 0x7fff7fffu) | 0x80008000u);
                        const unsigned idx = (unsigned)(64 * hi + 16 * kb + 8 * j + 2 * e);
                        cur[8 * j + 2 * e] = (k2 << 16) | idx; cur[8 * j + 2 * e + 1] = (k2 & 0xffff0000u) | (idx + 1u);
                    }
                sort16_desc(cur);
                if (kb == 0) {
#pragma unroll
                    for (int j = 0; j < 16; ++j) top[j] = cur[j];
                } else merge_top16(top, cur);
            }
            merge_halves(top);
#pragma unroll
            for (int j = 0; j < 16; ++j) { const unsigned s16 = top[j] >> 16; const unsigned hb = s16 ^ ((s16 & 0x8000u) ? 0x8000u : 0xffffu);
                const _Float16 hv = __builtin_bit_cast(_Float16, (unsigned short)hb);
                lsw[(p * 16 + j) * 64] = (srt((float)hv) & ~127u) | (top[j] & 127u); }
        }
#endif
        unsigned best[16];
        {
            const int offA = hi ? 16 * 64 : 0, offB = hi ? 0 : 16 * 64, shA = hi ? 0 : 7, shB = hi ? 7 : 0;
            float fa[16], fb[16]; unsigned ia[16], ib[16];
#pragma unroll
            for (int i = 0; i < 16; ++i) { const unsigned av = lsw[offA + i * 64], bv = lsw[offB + i * 64];
                fa[i] = unsrt(av & ~127u); fb[i] = unsrt(bv & ~127u); ia[i] = (av & 127u) << shA; ib[i] = (bv & 127u) << shB; }
#define PA_CAND(i, j) ((srt(fa[i] + fb[j]) & ~0x3FFFu) | ia[i] | ib[j])
            unsigned c0[16], c1[16];
#pragma unroll
            for (int j = 1; j < 16; ++j) c0[j - 1] = PA_CAND(0, j);
            c0[15] = hi ? PA_CAND(1, 1) : PA_CAND(0, 0);
#pragma unroll
            for (int j = 2; j < 8; ++j) c1[j - 2] = PA_CAND(1, j);
            c1[6] = PA_CAND(2, 3); c1[7] = PA_CAND(2, 4);
            c1[8] = hi ? PA_CAND(3, 3) : PA_CAND(2, 2);
#pragma unroll
            for (int j = 9; j < 16; ++j) c1[j] = 0u;
#undef PA_CAND
            sort16_desc(c0); sort16_desc(c1);
            merge_top16(c0, c1);
#pragma unroll
            for (int j = 0; j < 16; ++j) best[j] = c0[j];
        }
        merge_halves(best);
        float e[16], sum = 0.f;
        const float s0 = unsrt(best[0] & ~0x3FFFu);
#pragma unroll
        for (int j = 0; j < 16; ++j) { e[j] = __builtin_amdgcn_exp2f((unsrt(best[j] & ~0x3FFFu) - s0) * rs2 * LOG2E); sum += e[j]; }
        const float inv = 1.f / sum;
        if (hi == 0) {
            u32x2* pl = (u32x2*)(lds + P6_PL) + tl_r * 128 + 16 * hd;
#pragma unroll
            for (int j = 0; j < 16; ++j) { u32x2 en; en.x = best[j] & 0x3FFFu; en.y = __float_as_uint(e[j] * inv); pl[j] = en; }
        }
    }
#if defined(HK_PROBE_PHASE) && HK_PROBE_PHASE == 10
    if (blockIdx.x == 0 && threadIdx.x == 0) { volatile LAS3 unsigned* pw_ = (volatile LAS3 unsigned*)(LAS3 unsigned char*)(lds + LDS_CTL + 48); *pw_ = *pw_ + (unsigned)(__builtin_amdgcn_s_memrealtime() - pq0_); }
#endif
    const unsigned char* ut = a.ws + WS_UT; const unsigned char* vt = a.ws + WS_VT; const float* scl = (const float*)(a.ws + WS_US);
    float* dots = (float*)(lds + P6_DOT) + w * 256; float* cfs = dots + 128;
    int vz_; asm volatile("v_mov_b32 %0, 0" : "=v"(vz_));
    const int lane_g = lane + vz_, hi_g = lane_g >> 5;
    const int c32 = lane_g & 31, slot = 2 * c32 + hi_g;
#define PG_ISSUE(buf, tab, plp, b) do { _Pragma("unroll") for (int kk = 0; kk < 8; ++kk) { const unsigned id_ = (plp)[16 * (b) + 8 * hi_g + kk].x; buf[kk] = *(const u32x4*)((tab) + (unsigned)(id_ * 512u + 16u * (unsigned)c32)); } } while (0)
#define PG_CU(buf, b) do { int pd_[8]; \
        _Pragma("unroll") for (int kk = 0; kk < 8; ++kk) {        \
            int dl_ = __builtin_amdgcn_sdot8((int)buf[kk][0], xl4[0], 0, true), dh_ = __builtin_amdgcn_sdot8((int)buf[kk][0], xh4[0], 0, true); \
            _Pragma("unroll") for (int j = 1; j < 4; ++j) { dl_ = __builtin_amdgcn_sdot8((int)buf[kk][j], xl4[j], dl_, false); dh_ = __builtin_amdgcn_sdot8((int)buf[kk][j], xh4[j], dh_, false); } \
            pd_[kk] = (dh_ << 4) + dl_; } \
        int r4_[4]; \
        _Pragma("unroll") for (int j = 0; j < 4; ++j) { auto rr_ = __builtin_amdgcn_permlane16_swap((unsigned)pd_[j], (unsigned)pd_[j + 4], false, false); r4_[j] = (int)rr_[0] + (int)rr_[1]; } \
        _Pragma("unroll") for (int j = 0; j < 4; ++j) { int v_ = r4_[j]; \
            v_ += __builtin_amdgcn_update_dpp(0, v_, 0xB1, 0xf, 0xf, true); v_ += __builtin_amdgcn_update_dpp(0, v_, 0x4E, 0xf, 0xf, true); \
            v_ += __builtin_amdgcn_update_dpp(0, v_, 0x141, 0xf, 0xf, true); v_ += __builtin_amdgcn_update_dpp(0, v_, 0x140, 0xf, 0xf, true); r4_[j] = v_; } \
        if ((lane_g & 15) == 0) { const int q_ = lane_g >> 4; *(f32x4*)(dots + 16 * (b) + 8 * (q_ >> 1) + 4 * (q_ & 1)) = (f32x4){(float)r4_[0], (float)r4_[1], (float)r4_[2], (float)r4_[3]}; } } while (0)
#define PG_T4(r0, r1, r2, r3, t0, t1, t2, t3) do { const unsigned a01l_ = __builtin_amdgcn_perm(r1, r0, 0x05010400u), a01h_ = __builtin_amdgcn_perm(r1, r0, 0x07030602u), \
            a23l_ = __builtin_amdgcn_perm(r3, r2, 0x05010400u), a23h_ = __builtin_amdgcn_perm(r3, r2, 0x07030602u); \
        t0 = __builtin_amdgcn_perm(a23l_, a01l_, 0x05040100u); t1 = __builtin_amdgcn_perm(a23l_, a01l_, 0x07060302u); \
        t2 = __builtin_amdgcn_perm(a23h_, a01h_, 0x05040100u); t3 = __builtin_amdgcn_perm(a23h_, a01h_, 0x07060302u); } while (0)
#define PG_CV(buf, b) do { _Pragma("unroll") for (int g4 = 0; g4 < 2; ++g4) { const int cq_ = (int)cqw[4 * (b) + 2 * hi_g + g4]; \
            _Pragma("unroll") for (int j = 0; j < 4; ++j) { \
                const unsigned w0_ = buf[4 * g4][j], w1_ = buf[4 * g4 + 1][j], w2_ = buf[4 * g4 + 2][j], w3_ = buf[4 * g4 + 3][j]; \
                unsigned t0_, t1_, t2_, t3_; \
                PG_T4(w0_ & 0x0F0F0F0Fu, w1_ & 0x0F0F0F0Fu, w2_ & 0x0F0F0F0Fu, w3_ & 0x0F0F0F0Fu, t0_, t1_, t2_, t3_); \
                oa[8 * j + 0] = __builtin_amdgcn_sdot4((int)t0_, cq_, oa[8 * j + 0], false); oa[8 * j + 1] = __builtin_amdgcn_sdot4((int)t1_, cq_, oa[8 * j + 1], false); \
                oa[8 * j + 2] = __builtin_amdgcn_sdot4((int)t2_, cq_, oa[8 * j + 2], false); oa[8 * j + 3] = __builtin_amdgcn_sdot4((int)t3_, cq_, oa[8 * j + 3], false); \
                PG_T4((w0_ >> 4) & 0x0F0F0F0Fu, (w1_ >> 4) & 0x0F0F0F0Fu, (w2_ >> 4) & 0x0F0F0F0Fu, (w3_ >> 4) & 0x0F0F0F0Fu, t0_, t1_, t2_, t3_); \
                oa[8 * j + 4] = __builtin_amdgcn_sdot4((int)t0_, cq_, oa[8 * j + 4], false); oa[8 * j + 5] = __builtin_amdgcn_sdot4((int)t1_, cq_, oa[8 * j + 5], false); \
                oa[8 * j + 6] = __builtin_amdgcn_sdot4((int)t2_, cq_, oa[8 * j + 6], false); oa[8 * j + 7] = __builtin_amdgcn_sdot4((int)t3_, cq_, oa[8 * j + 7], false); \
                asm volatile("" : "+v"(oa[8 * j]), "+v"(oa[8 * j + 1]), "+v"(oa[8 * j + 2]), "+v"(oa[8 * j + 3]), "+v"(oa[8 * j + 4]), "+v"(oa[8 * j + 5]), "+v"(oa[8 * j + 6]), "+v"(oa[8 * j + 7])); } } } while (0)
#define PG_SB __builtin_amdgcn_sched_barrier(0)
    u32x4 bA[8], bB[8], bC[8], bD[8];
    { const u32x2* pl0 = (const u32x2*)(lds + P6_PL) + (4 * w) * 128; PG_ISSUE(bA, ut, pl0, 0); PG_ISSUE(bB, ut, pl0, 1); PG_ISSUE(bC, ut, pl0, 2); }
    for (int tt = 0; tt < 4; ++tt) {
        const int tl = 4 * w + tt, tok = tok0 + tl;
        const float rs2 = rsl[tl];
        const u32x2* pl = (const u32x2*)(lds + P6_PL) + tl * 128;
        const u32x2 en0 = pl[lane_g], en1 = pl[64 + lane_g];
        const float2 sc0_ = *(const float2*)(scl + 2 * (size_t)en0.x), sc1_ = *(const float2*)(scl + 2 * (size_t)en1.x);
        const float us0 = sc0_.x, us1 = sc1_.x, vs0 = sc0_.y, vs1 = sc1_.y;
        float xv[16]; load_row16_bf(xg + (size_t)tok * D, slot, xv);
        float mx = 0.f;
#pragma unroll
        for (int i = 0; i < 16; ++i) mx = fmaxf(mx, fabsf(xv[i]));
#pragma unroll
        for (int o = 32; o > 0; o >>= 1) mx = fmaxf(mx, __shfl_xor(mx, o));
        const float sx = mx > 0.f ? mx * (1.f / 119.f) : 1.f, isx = 1.f / sx;
        int xl4[4], xh4[4];
        {
            unsigned xq[8];
#pragma unroll
            for (int j = 0; j < 4; ++j) {
                unsigned pk = 0u;
#pragma unroll
                for (int i = 0; i < 4; ++i) { const int q = (int)rintf(xv[4 * j + i] * isx); pk |= ((unsigned)q & 0xffu) << (8 * i); }
                auto rr = __builtin_amdgcn_permlane32_swap(pk, pk, false, false);
                xq[j] = rr[0]; xq[4 + j] = rr[1];
            }
#pragma unroll
            for (int j = 0; j < 4; ++j) {
                const unsigned A = xq[2 * j], B = xq[2 * j + 1];
                xl4[j] = (int)((A & 0x0F0F0F0Fu) | ((B & 0x0F0F0F0Fu) << 4));
                const unsigned ha = (((A >> 4) & 0x0F0F0F0Fu) + ((A >> 3) & 0x01010101u)) & 0x0F0F0F0Fu, hb = (((B >> 4) & 0x0F0F0F0Fu) + ((B >> 3) & 0x01010101u)) & 0x0F0F0F0Fu;
                xh4[j] = (int)(ha | (hb << 4));
            }
        }
#define PG_STEP(cur, nxt, ub) do { if ((ub) + 3 < 8) PG_ISSUE(nxt, ut, pl, (ub) + 3); else if (tt < 3) PG_ISSUE(nxt, ut, pl + 128, (ub) + 3 - 8); PG_SB; PG_CU(cur, ub); PG_SB; } while (0)
        PG_STEP(bA, bD, 0); PG_STEP(bB, bA, 1); PG_STEP(bC, bB, 2); PG_STEP(bD, bC, 3); PG_STEP(bA, bD, 4); PG_STEP(bB, bA, 5); PG_STEP(bC, bB, 6); PG_STEP(bD, bC, 7);
#undef PG_STEP
        const float a0 = gelu_tanh(dots[lane_g] * (sx * rs2) * us0) * __uint_as_float(en0.y);
        const float a1 = gelu_tanh(dots[64 + lane_g] * (sx * rs2) * us1) * __uint_as_float(en1.y);
        const float c0 = a0 * vs0, c1 = a1 * vs1;
        float cm = fmaxf(fabsf(c0), fabsf(c1));
#pragma unroll
        for (int o = 32; o > 0; o >>= 1) cm = fmaxf(cm, __shfl_xor(cm, o));
        const float scc = cm > 0.f ? cm * (1.f / 127.f) : 1.f, iscc = 1.f / scc;
        const int q0c = (int)rintf(c0 * iscc), q1c = (int)rintf(c1 * iscc);
        int qsum = q0c + q1c;
#pragma unroll
        for (int o = 32; o > 0; o >>= 1) qsum += __shfl_xor(qsum, o);
        unsigned short* gid = (unsigned short*)(a.ws + WS_CIDX) + (size_t)tok * 128; signed char* gcq = (signed char*)(a.ws + WS_CQ) + (size_t)tok * 128;
        gid[lane_g] = (unsigned short)en0.x; gid[64 + lane_g] = (unsigned short)en1.x; gcq[lane_g] = (signed char)q0c; gcq[64 + lane_g] = (signed char)q1c;
        if (lane_g == 0) { float* gsc = (float*)(a.ws + WS_CSC) + 2 * (size_t)tok; gsc[0] = scc; gsc[1] = (float)qsum; }
    }
#undef PG_ISSUE
#undef PG_SB
#undef PG_CU
#undef PG_CV
#undef PG_T4
}
#endif
__device__ __forceinline__ void peer_unit_c(const Args& a, unsigned char* lds, int layer, int unit) {
    int tid = threadIdx.x; asm volatile("" : "+v"(tid));
    const int lane = tid & 63, w = __builtin_amdgcn_readfirstlane(tid >> 6), hi_g = lane >> 5, c32 = lane & 31, slot = 2 * c32 + hi_g;
    const int tok0 = unit * 32 + 4 * w;
    const bf16_t* xg = (const bf16_t*)(a.ws + WS_XB);
    const unsigned char* vt = a.ws + WS_VT;
    const unsigned short* gid = (const unsigned short*)(a.ws + WS_CIDX); const signed char* gcq = (const signed char*)(a.ws + WS_CQ); const float* gsc = (const float*)(a.ws + WS_CSC);
    LAS3 unsigned char* lw = (LAS3 unsigned char*)(lds + w * 1024);
#define PC_ISSUE(buf, lb, b) do { const LAS3 unsigned short* il_ = (const LAS3 unsigned short*)(lw + 512 * (lb)); _Pragma("unroll") for (int kk = 0; kk < 8; ++kk) { const unsigned id_ = il_[16 * (b) + 8 * hi_g + kk]; \
        buf[kk] = *(const u32x4*)(vt + (unsigned)(id_ * 512u + 16u * (unsigned)c32)); } } while (0)
#define PC_T4(r0, r1, r2, r3, t0, t1, t2, t3) do { const unsigned a01l_ = __builtin_amdgcn_perm(r1, r0, 0x05010400u), a01h_ = __builtin_amdgcn_perm(r1, r0, 0x07030602u), \
            a23l_ = __builtin_amdgcn_perm(r3, r2, 0x05010400u), a23h_ = __builtin_amdgcn_perm(r3, r2, 0x07030602u); \
        t0 = __builtin_amdgcn_perm(a23l_, a01l_, 0x05040100u); t1 = __builtin_amdgcn_perm(a23l_, a01l_, 0x07060302u); \
        t2 = __builtin_amdgcn_perm(a23h_, a01h_, 0x05040100u); t3 = __builtin_amdgcn_perm(a23h_, a01h_, 0x07060302u); } while (0)
#define PC_CV(buf, lb, b) do { const LAS3 unsigned* cqw_ = (const LAS3 unsigned*)(lw + 512 * (lb) + 256); _Pragma("unroll") for (int g4 = 0; g4 < 2; ++g4) { const int cq_ = (int)cqw_[4 * (b) + 2 * hi_g + g4]; \
            _Pragma("unroll") for (int j = 0; j < 4; ++j) { \
                unsigned t0_, t1_, t2_, t3_; \
                PC_T4(buf[4 * g4][j], buf[4 * g4 + 1][j], buf[4 * g4 + 2][j], buf[4 * g4 + 3][j], t0_, t1_, t2_, t3_);        \
                of[4 * j + 0] = __builtin_amdgcn_sdot4((int)t0_, cq_, of[4 * j + 0], false); of[4 * j + 1] = __builtin_amdgcn_sdot4((int)t1_, cq_, of[4 * j + 1], false); \
                of[4 * j + 2] = __builtin_amdgcn_sdot4((int)t2_, cq_, of[4 * j + 2], false); of[4 * j + 3] = __builtin_amdgcn_sdot4((int)t3_, cq_, of[4 * j + 3], false); \
                ol[4 * j + 0] = __builtin_amdgcn_sdot4((int)(t0_ & 0x0F0F0F0Fu), cq_, ol[4 * j + 0], false); ol[4 * j + 1] = __builtin_amdgcn_sdot4((int)(t1_ & 0x0F0F0F0Fu), cq_, ol[4 * j + 1], false); \
                ol[4 * j + 2] = __builtin_amdgcn_sdot4((int)(t2_ & 0x0F0F0F0Fu), cq_, ol[4 * j + 2], false); ol[4 * j + 3] = __builtin_amdgcn_sdot4((int)(t3_ & 0x0F0F0F0Fu), cq_, ol[4 * j + 3], false); \
                asm volatile("" : "+v"(of[4 * j]), "+v"(of[4 * j + 1]), "+v"(of[4 * j + 2]), "+v"(of[4 * j + 3]), "+v"(ol[4 * j]), "+v"(ol[4 * j + 1]), "+v"(ol[4 * j + 2]), "+v"(ol[4 * j + 3])); } } } while (0)
#define PC_SB __builtin_amdgcn_sched_barrier(0)
    unsigned lid = ((const unsigned*)(gid + (size_t)tok0 * 128))[lane], lcq = lane < 32 ? ((const unsigned*)(gcq + (size_t)tok0 * 128))[lane] : 0u;
    ((LAS3 unsigned*)lw)[lane] = lid; if (lane < 32) ((LAS3 unsigned*)(lw + 256))[lane] = lcq;
    u32x4 bA[8], bB[8];
    PC_ISSUE(bA, 0, 0);
    for (int tt = 0; tt < 4; ++tt) {
        const int tok = tok0 + tt, lb = tt & 1;
        if (tt < 3) { lid = ((const unsigned*)(gid + (size_t)(tok + 1) * 128))[lane]; lcq = lane < 32 ? ((const unsigned*)(gcq + (size_t)(tok + 1) * 128))[lane] : 0u; }
        const float scc = gsc[2 * (size_t)tok], qsf = gsc[2 * (size_t)tok + 1];
        float xv[16]; load_row16_bf(xg + (size_t)tok * D, slot, xv);
        int of[16], ol[16];
#pragma unroll
        for (int i = 0; i < 16; ++i) { of[i] = 0; ol[i] = 0; }
#pragma unroll
        for (int vb = 0; vb < 8; vb += 2) {
            PC_ISSUE(bB, lb, vb + 1); PC_SB; PC_CV(bA, lb, vb); PC_SB;
            if (vb == 2 && tt < 3) { ((LAS3 unsigned*)(lw + 512 * (lb ^ 1)))[lane] = lid; if (lane < 32) ((LAS3 unsigned*)(lw + 512 * (lb ^ 1) + 256))[lane] = lcq; }
            if (vb + 2 < 8) PC_ISSUE(bA, lb, vb + 2); else if (tt < 3) PC_ISSUE(bA, lb ^ 1, 0);
            PC_SB; PC_CV(bB, lb, vb + 1); PC_SB;
        }
#pragma unroll
        for (int i = 0; i < 8; ++i) {
            const int jj = i >> 2, k = i & 3;
            auto rl = __builtin_amdgcn_permlane32_swap((unsigned)ol[4 * jj + k], (unsigned)ol[8 + 4 * jj + k], false, false);
            auto rf = __builtin_amdgcn_permlane32_swap((unsigned)of[4 * jj + k], (unsigned)of[8 + 4 * jj + k], false, false);
            const int sl = (int)rl[0] + (int)rl[1], sf = (int)rf[0] + (int)rf[1];
#ifndef HK_PROBE_NOPEER
            xv[8 * jj + k] += scc * ((float)sl - 8.f * qsf);
            xv[8 * jj + 4 + k] += scc * (float)((sf - sl) >> 4);
#else
            xv[8 * jj + k] += 1e-30f * (float)sl; xv[8 * jj + 4 + k] += 1e-30f * (float)sf;
#endif
        }
        const bool more = layer + 1 < DEPTH;
        int vzt_; asm volatile("v_mov_b32 %0, 0" : "=v"(vzt_) : "v"(xv[0]));
        finish_token(tok, xv, more ? nullptr : a.out, (bf16_t*)(a.ws + WS_XB), (float*)(a.ws + WS_RSTD), more ? (const float*)(a.ws + WS_WF) + (size_t)(layer + 1) * 4096 : nullptr,
                     a.in[2] + (more ? (layer + 1) * 4 : 0), (float*)(a.ws + WS_FLOG), lane, slot + vzt_);
    }
#undef PC_ISSUE
#undef PC_T4
#undef PC_CV
#undef PC_SB
}
__device__ __forceinline__ void peer_phase_c(const Args& a, unsigned char* lds, int layer) {
    int tid = threadIdx.x; asm volatile("" : "+v"(tid));
    const int lane = tid & 63, w = __builtin_amdgcn_readfirstlane(tid >> 6), c8 = lane & 7, r8 = lane >> 3;
    const int nun = (T / 32 - (int)blockIdx.x + (int)gridDim.x - 1) / (int)gridDim.x, N = 4 * nun;
    bf16_t* xg = (bf16_t*)(a.ws + WS_XB);
    const unsigned char* vt = a.ws + WS_VT;
    const unsigned short* gid = (const unsigned short*)(a.ws + WS_CIDX); const signed char* gcq = (const signed char*)(a.ws + WS_CQ); const float* gsc = (const float*)(a.ws + WS_CSC);
    LAS3 unsigned char* lw = (LAS3 unsigned char*)(lds + w * 1024);
    const bool more = layer + 1 < DEPTH;
    const float* wf = (const float*)(a.ws + WS_WF) + (size_t)(more ? layer + 1 : 0) * 4096; const float* bfor = a.in[2] + (more ? (layer + 1) * 4 : 0);
#define PS_TOK(n) (((int)blockIdx.x + ((n) >> 2) * (int)gridDim.x) * 32 + 4 * w + ((n) & 3))
#define PS_ISSUE(buf, lb, b) do { const LAS3 unsigned char* il_ = lw + 512 * (lb) + 2 * (64 * (b) + 4 * r8); _Pragma("unroll") for (int g4 = 0; g4 < 2; ++g4) { const u32x2 i4_ = *(const LAS3 u32x2*)(il_ + 64 * g4); \
        _Pragma("unroll") for (int k4 = 0; k4 < 4; ++k4) { const unsigned id_ = (k4 & 1 ? i4_[k4 >> 1] >> 16 : i4_[k4 >> 1] & 0xffffu); buf[4 * g4 + k4] = *(const u32x4*)(vt + (unsigned)(id_ * 512u + soff)); } } } while (0)
#define PS_T4(r0, r1, r2, r3, t0, t1, t2, t3) do { const unsigned a01l_ = __builtin_amdgcn_perm(r1, r0, 0x05010400u), a01h_ = __builtin_amdgcn_perm(r1, r0, 0x07030602u), \
            a23l_ = __builtin_amdgcn_perm(r3, r2, 0x05010400u), a23h_ = __builtin_amdgcn_perm(r3, r2, 0x07030602u); \
        t0 = __builtin_amdgcn_perm(a23l_, a01l_, 0x05040100u); t1 = __builtin_amdgcn_perm(a23l_, a01l_, 0x07060302u); \
        t2 = __builtin_amdgcn_perm(a23h_, a01h_, 0x05040100u); t3 = __builtin_amdgcn_perm(a23h_, a01h_, 0x07060302u); } while (0)
#define PS_CV(buf, lb, b) do { const LAS3 unsigned* cqw_ = (const LAS3 unsigned*)(lw + 512 * (lb) + 256); _Pragma("unroll") for (int g4 = 0; g4 < 2; ++g4) { const int cq_ = (int)cqw_[16 * (b) + 8 * g4 + r8]; const bool first_ = (b) == 0 && g4 == 0;       \
            _Pragma("unroll") for (int j = 0; j < 4; ++j) { \
                unsigned t0_, t1_, t2_, t3_; \
                PS_T4(buf[4 * g4][j], buf[4 * g4 + 1][j], buf[4 * g4 + 2][j], buf[4 * g4 + 3][j], t0_, t1_, t2_, t3_);        \
                of[4 * j + 0] = (first_ ? __builtin_amdgcn_sdot4((int)t0_, cq_, 0, true) : __builtin_amdgcn_sdot4((int)t0_, cq_, of[4 * j + 0], false)); of[4 * j + 1] = (first_ ? __builtin_amdgcn_sdot4((int)t1_, cq_, 0, true) : __builtin_amdgcn_sdot4((int)t1_, cq_, of[4 * j + 1], false)); \
                of[4 * j + 2] = (first_ ? __builtin_amdgcn_sdot4((int)t2_, cq_, 0, true) : __builtin_amdgcn_sdot4((int)t2_, cq_, of[4 * j + 2], false)); of[4 * j + 3] = (first_ ? __builtin_amdgcn_sdot4((int)t3_, cq_, 0, true) : __builtin_amdgcn_sdot4((int)t3_, cq_, of[4 * j + 3], false)); \
                ol[4 * j + 0] = (first_ ? __builtin_amdgcn_sdot4((int)(t0_ & 0x0F0F0F0Fu), cq_, 0, true) : __builtin_amdgcn_sdot4((int)(t0_ & 0x0F0F0F0Fu), cq_, ol[4 * j + 0], false)); ol[4 * j + 1] = (first_ ? __builtin_amdgcn_sdot4((int)(t1_ & 0x0F0F0F0Fu), cq_, 0, true) : __builtin_amdgcn_sdot4((int)(t1_ & 0x0F0F0F0Fu), cq_, ol[4 * j + 1], false)); \
                ol[4 * j + 2] = (first_ ? __builtin_amdgcn_sdot4((int)(t2_ & 0x0F0F0F0Fu), cq_, 0, true) : __builtin_amdgcn_sdot4((int)(t2_ & 0x0F0F0F0Fu), cq_, ol[4 * j + 2], false)); ol[4 * j + 3] = (first_ ? __builtin_amdgcn_sdot4((int)(t3_ & 0x0F0F0F0Fu), cq_, 0, true) : __builtin_amdgcn_sdot4((int)(t3_ & 0x0F0F0F0Fu), cq_, ol[4 * j + 3], false)); \
                asm volatile("" : "+v"(of[4 * j]), "+v"(of[4 * j + 1]), "+v"(of[4 * j + 2]), "+v"(of[4 * j + 3]), "+v"(ol[4 * j]), "+v"(ol[4 * j + 1]), "+v"(ol[4 * j + 2]), "+v"(ol[4 * j + 3])); } } } while (0)
#define PS_SB __builtin_amdgcn_sched_barrier(0)
#pragma unroll 1
    for (int s = 0; s < 4; ++s) {
        const int e0 = 256 * s + 32 * c8 + 4 * r8;
        const unsigned soff = 128u * (unsigned)s + 16u * (unsigned)c8;
        {
#pragma unroll
            for (int q = 0; q < 2; ++q) { const int tq = PS_TOK(q);
                const unsigned lidq = ((const unsigned*)(gid + (size_t)tq * 128))[lane], lcqq = lane < 32 ? ((const unsigned*)(gcq + (size_t)tq * 128))[lane] : 0u;
                ((LAS3 unsigned*)(lw + 512 * q))[lane] = lidq; if (lane < 32) ((LAS3 unsigned*)(lw + 512 * q + 256))[lane] = lcqq; }
        }
        u32x4 bA[8], bB[8], bC[8], bD[8];
        PS_ISSUE(bA, 0, 0); PS_ISSUE(bB, 0, 1);
#define PS_BODY(n_, X0, X1, Y0, Y1) do { const int n = (n_), tok = PS_TOK(n), lb = n & 1; \
            const bool nx2 = n + 2 < N; unsigned lid = 0u, lcq = 0u; \
            if (nx2) { const int tn = PS_TOK(n + 2); lid = ((const unsigned*)(gid + (size_t)tn * 128))[lane]; lcq = lane < 32 ? ((const unsigned*)(gcq + (size_t)tn * 128))[lane] : 0u; } \
            if (n + 1 < N) { PS_ISSUE(Y0, lb ^ 1, 0); PS_ISSUE(Y1, lb ^ 1, 1); } \
            const float scc = gsc[2 * (size_t)tok], qsf = gsc[2 * (size_t)tok + 1]; \
            const u32x2 xr = *(const u32x2*)(xg + (size_t)tok * D + e0); \
            int of[16], ol[16];         \
            PS_SB; PS_CV(X0, lb, 0); PS_SB; PS_CV(X1, lb, 1); PS_SB; \
            if (nx2) { ((LAS3 unsigned*)(lw + 512 * lb))[lane] = lid; if (lane < 32) ((LAS3 unsigned*)(lw + 512 * lb + 256))[lane] = lcq; }        \
              \
            int y[16], z[8]; \
            _Pragma("unroll") for (int i = 0; i < 8; ++i) { \
                auto rf = __builtin_amdgcn_permlane32_swap((unsigned)of[i], (unsigned)of[8 + i], false, false); y[i] = (int)rf[0] + (int)rf[1]; \
                auto rl = __builtin_amdgcn_permlane32_swap((unsigned)ol[i], (unsigned)ol[8 + i], false, false); y[8 + i] = (int)rl[0] + (int)rl[1]; } \
            _Pragma("unroll") for (int i = 0; i < 4; ++i) { \
                auto rf = __builtin_amdgcn_permlane16_swap((unsigned)y[i], (unsigned)y[4 + i], false, false); z[i] = (int)rf[0] + (int)rf[1]; \
                auto rl = __builtin_amdgcn_permlane16_swap((unsigned)y[8 + i], (unsigned)y[12 + i], false, false); z[4 + i] = (int)rl[0] + (int)rl[1]; } \
            _Pragma("unroll") for (int i = 0; i < 8; ++i) z[i] += __builtin_amdgcn_update_dpp(0, z[i], 0x128, 0xf, 0xf, true);         \
            float xn[4]; \
            _Pragma("unroll") for (int k = 0; k < 4; ++k) { \
                const float vl = (float)z[4 + k] - 8.f * qsf, vh = (float)((z[k] - z[4 + k]) >> 4); \
                const unsigned xw = xr[k >> 1]; \
                xn[k] = (k & 1 ? __uint_as_float(xw & 0xffff0000u) : __uint_as_float(xw << 16)) + scc * ((r8 & 1) ? vh : vl); } \
            if (more) { u32x2 o; o.x = pk2(xn[0], xn[1]); o.y = pk2(xn[2], xn[3]); *(u32x2*)(xg + (size_t)tok * D + e0) = o; } \
            else *(f32x4*)(a.out + (size_t)tok * D + e0) = (f32x4){xn[0], xn[1], xn[2], xn[3]}; } while (0)
#pragma unroll 1
        for (int n2 = 0; n2 < N; n2 += 2) {
            PS_BODY(n2, bA, bB, bC, bD);
            PS_BODY(n2 + 1, bC, bD, bA, bB);
        }
#undef PS_BODY
    }
    if (more) {
        __builtin_amdgcn_fence(__ATOMIC_ACQ_REL, "workgroup");
        f32x4 wg[4][4];
#pragma unroll
        for (int h = 0; h < 4; ++h)
#pragma unroll
            for (int j = 0; j < 4; ++j) wg[h][j] = *(const f32x4*)(wf + h * 1024 + 16 * lane + 4 * j);
        const int myh = ((lane >> 4) & 1) * 2 + (lane >> 5);
        const float mybf = bfor[myh];
#pragma unroll 1
        for (int n = 0; n < N; ++n) {
            const int tok = PS_TOK(n);
            float xv[16]; load_row16_bf(xg + (size_t)tok * D, lane, xv);
            float ss = 0.f, g[4] = {0.f, 0.f, 0.f, 0.f};
#pragma unroll
            for (int i = 0; i < 16; ++i) { ss += xv[i] * xv[i];
#pragma unroll
                for (int h = 0; h < 4; ++h) g[h] += xv[i] * wg[h][i >> 2][i & 3]; }
            auto r01 = __builtin_amdgcn_permlane32_swap(__float_as_uint(g[0]), __float_as_uint(g[1]), false, false); const float q01 = __uint_as_float(r01[0]) + __uint_as_float(r01[1]);
            auto r23 = __builtin_amdgcn_permlane32_swap(__float_as_uint(g[2]), __float_as_uint(g[3]), false, false); const float q23 = __uint_as_float(r23[0]) + __uint_as_float(r23[1]);
            auto rq = __builtin_amdgcn_permlane16_swap(__float_as_uint(q01), __float_as_uint(q23), false, false); float q = __uint_as_float(rq[0]) + __uint_as_float(rq[1]);
            q += __uint_as_float(__builtin_amdgcn_update_dpp(0, __float_as_uint(q), 0x128, 0xf, 0xf, true)); q += __uint_as_float(__builtin_amdgcn_update_dpp(0, __float_as_uint(q), 0x124, 0xf, 0xf, true));
            q += __uint_as_float(__builtin_amdgcn_update_dpp(0, __float_as_uint(q), 0x122, 0xf, 0xf, true)); q += __uint_as_float(__builtin_amdgcn_update_dpp(0, __float_as_uint(q), 0x121, 0xf, 0xf, true));
            ss += __uint_as_float(__builtin_amdgcn_update_dpp(0, __float_as_uint(ss), 0x128, 0xf, 0xf, true)); ss += __uint_as_float(__builtin_amdgcn_update_dpp(0, __float_as_uint(ss), 0x124, 0xf, 0xf, true));
            ss += __uint_as_float(__builtin_amdgcn_update_dpp(0, __float_as_uint(ss), 0x122, 0xf, 0xf, true)); ss += __uint_as_float(__builtin_amdgcn_update_dpp(0, __float_as_uint(ss), 0x121, 0xf, 0xf, true));
            ss = half_swap_sum(ss);
            { auto r = __builtin_amdgcn_permlane16_swap(__float_as_uint(ss), __float_as_uint(ss), false, false); ss = __uint_as_float(r[0]) + __uint_as_float(r[1]); }
            const float rs = __builtin_amdgcn_rsqf(ss * (1.f / 1024.f) + EPS);
            if (lane == 0) ((float*)(a.ws + WS_RSTD))[tok] = rs;
            if ((lane & 15) == 0) { const int b = tok / S, sq = tok % S; ((float*)(a.ws + WS_FLOG))[((size_t)b * 4 + myh) * S + sq] = log_sigmoid(q * rs + mybf); }
        }
    }
#undef PS_TOK
#undef PS_ISSUE
#undef PS_T4
#undef PS_CV
#undef PS_SB
}
}
namespace hk {
#ifndef HK_ALIGN1
#define HK_ALIGN1 true
#endif
#ifndef HK_ALIGN2
#define HK_ALIGN2 true
#endif
#ifndef HK_ALIGN3
#define HK_ALIGN3 true
#endif
constexpr int NPL = 6 + HK_PEER_SPLIT;
constexpr int NPHASE = 2 + NPL * DEPTH;
__device__ __forceinline__ unsigned q_next(unsigned* ctr, unsigned char* lds) {
    volatile LAS3 unsigned* slot = (volatile LAS3 unsigned*)(LAS3 unsigned char*)(lds + LDS_CTL + 32);
    __syncthreads();
    if (threadIdx.x == 0) *slot = __hip_atomic_fetch_add(ctr, 1u, __ATOMIC_RELAXED, __HIP_MEMORY_SCOPE_AGENT);
    __syncthreads();
    return *slot;
}
__device__ __forceinline__ unsigned q_publish(unsigned nxt, unsigned char* lds) {
    volatile LAS3 unsigned* slot = (volatile LAS3 unsigned*)(LAS3 unsigned char*)(lds + LDS_CTL + 32);
    __syncthreads();
    if (threadIdx.x == 0) *slot = nxt;
    __syncthreads();
    return *slot;
}
#define SEAM(k) do { if (a.use_bar && (k) >= a.ph_lo && (k) + 1 < a.ph_hi) { xcd_barrier(bar); } } while (0)
#define ON(k) ((k) >= a.ph_lo && (k) < a.ph_hi)
#ifdef HK_PROBE_PHASE
#define PROBE_T0(k) unsigned long long pt0_ = 0; if ((k) == HK_PROBE_PHASE && blockIdx.x == 0 && threadIdx.x == 0) pt0_ = __builtin_amdgcn_s_memrealtime();
#define PROBE_T1(k) if ((k) == HK_PROBE_PHASE && blockIdx.x == 0 && threadIdx.x == 0) { volatile LAS3 unsigned* pw_ = (volatile LAS3 unsigned*)(LAS3 unsigned char*)(lds + LDS_CTL + 48); *pw_ = *pw_ + (unsigned)(__builtin_amdgcn_s_memrealtime() - pt0_); }
#else
#define PROBE_T0(k)
#define PROBE_T1(k)
#endif
template <int l>
__device__ __forceinline__ void layer_phases(const Args& a, unsigned char* lds, const XcdBarrier& bar, unsigned* ctl) {
        const int pb = 2 + NPL * l;
        { PROBE_T0(0)
        if (ON(pb)) {
            if (blockIdx.x < NB * 4) cum_scan(a, lds, blockIdx.x);
            pg8::Gemm g; g.A = (const bf16_t*)(a.ws + WS_XB); g.Bt = (const bf16_t*)(a.ws + WS_WIN) + (size_t)l * 2560 * 1024; g.M = T; g.N = 2560; g.K = 1024;
            pg8::StaticOrder so; so.init(T, 2560, gridDim.x, blockIdx.x);
            pg8::EpiIn E; E.zb = (bf16_t*)(a.ws + WS_ZB); E.su32 = (float*)(a.ws + WS_SU); E.rstd = (const float*)(a.ws + WS_RSTD);
            E.g_fq = a.in[6] + l * 64; E.g_fk = a.in[7] + l * 64; E.g_dq = a.in[8] + l * 64; E.g_dk = a.in[9] + l * 64; E.g_cq = a.in[10] + l * 32; E.g_ck = a.in[11] + l * 32;
#ifndef HK_NO_G1
            pg8::gemm_phase<pg8::EpiIn, pg8::StaticOrder, HK_ALIGN1, true>((PG8_LAS unsigned char*)lds, g, so, E);
#endif
        }
        SEAM(pb);
        PROBE_T1(0) }
        { PROBE_T0(1)
        if (ON(pb + 1)) {
            unsigned* ctr = ctl + CTL_Q + 64 * (l + 4 * a.pad0);
            unsigned u = q_next(ctr, lds);
            while (u < 5632u) {
                unsigned nxt_ = 0u; if (threadIdx.x == 0) nxt_ = __hip_atomic_fetch_add(ctr, 1u, __ATOMIC_RELAXED, __HIP_MEMORY_SCOPE_AGENT);
                if (u < 1024u) {
#ifndef HK_NO_DIFF
 diff_unit(a, lds, l, u & 31, 31 - (u >> 5));
#endif
 }
                else if (u < 1536u) {
#ifndef HK_NO_FOX
 fox64_unit(a, lds, l, (u - 1024u) & 31, 15 - ((u - 1024u) >> 5));
#endif
 }
                else if (u < 4608u) { const unsigned j = u - 1536u, br = j >> 10, jj = j & 1023u, bh = jj & 31u, sub = jj >> 5;
                    const int rho = br == 0 ? 0 : (br == 1 ? (sub & 3) : (sub & 15)), tile = br == 0 ? sub : (br == 1 ? (sub >> 2) : (sub >> 4));

#ifndef HK_NO_DIL
                    dil_unit(a, lds, bh, br, rho, tile);
#endif
 }
                else { const unsigned j = u - 4608u;
#ifndef HK_NO_S51
 s5_pass1_unit(a, lds, l, j >> 7, j & 127u);
#endif
 }
                u = q_publish(nxt_, lds);
            }
        }
        SEAM(pb + 1);
        PROBE_T1(1) }
        { PROBE_T0(2)
        if (ON(pb + 2)) {
#ifndef HK_NO_S52
            { PROBE_T0(12)
            for (int u = blockIdx.x; u < 256; u += gridDim.x) s5_pass2_unit(a, lds, l, u >> 5, u & 31);
            PROBE_T1(12) }
#endif
            { PROBE_T0(13)
            phase_p3_elementwise(a, l);
            PROBE_T1(13) }
        }
        SEAM(pb + 2);
        PROBE_T1(2) }
        { PROBE_T0(3)
        if (ON(pb + 3)) {
            pg8::Gemm g; g.A = (const bf16_t*)(a.ws + WS_MIX); g.Bt = (const bf16_t*)(a.ws + WS_WOUT) + (size_t)l * 1024 * 1024; g.M = T; g.N = 1024; g.K = 1024;
            pg8::StaticOrder so; so.init(T, 1024, gridDim.x, blockIdx.x);
            pg8::EpiOut E; E.xb = (bf16_t*)(a.ws + WS_XB);
#ifndef HK_NO_G2
            pg8::gemm_phase<pg8::EpiOut, pg8::StaticOrder, HK_ALIGN2, true>((PG8_LAS unsigned char*)lds, g, so, E);
#endif
        }
        SEAM(pb + 3);
        PROBE_T1(3) }
        { PROBE_T0(4)
        if (ON(pb + 4)) {
            pg8::Gemm g; g.A = (const bf16_t*)(a.ws + WS_XB); g.Bt = (const bf16_t*)(a.ws + WS_WQ) + (size_t)l * 2048 * 1024; g.M = T; g.N = 2048; g.K = 1024;
            pg8::StaticOrder so; so.init(T, 2048, gridDim.x, blockIdx.x);
#if HK_FOLD_KEYS
            pg8::EpiF16 E; E.O = (bf16_t*)(a.ws + WS_ZB); E.ldc = 2048;
#ifndef HK_NO_G3
            pg8::gemm_phase<pg8::EpiF16, pg8::StaticOrder, HK_ALIGN3, true>((PG8_LAS unsigned char*)lds, g, so, E);
#endif
#else
            pg8::EpiPlain E; E.O = (bf16_t*)(a.ws + WS_ZB); E.ldc = 2048;
#ifndef HK_NO_G3
            pg8::gemm_phase<pg8::EpiPlain, pg8::StaticOrder, HK_ALIGN3, true>((PG8_LAS unsigned char*)lds, g, so, E);
#endif
#endif
        }
        SEAM(pb + 4);
        PROBE_T1(4) }
        { PROBE_T0(5)
        if (ON(pb + 5)) {
#ifndef HK_NO_PEER
#if HK_PEER_SPLIT
            for (int u = blockIdx.x; u < T / 32; u += gridDim.x) peer_unit_a(a, lds, l, u);
#else
            for (int u = blockIdx.x; u < T / 32; u += gridDim.x) peer_unit(a, lds, l, u);
#endif
#endif
        }
#if HK_PEER_SPLIT && !defined(HK_AC_BAR)
        __builtin_amdgcn_fence(__ATOMIC_RELEASE, "workgroup"); __syncthreads(); __builtin_amdgcn_fence(__ATOMIC_ACQUIRE, "workgroup");
#else
        SEAM(pb + 5);
#endif
        PROBE_T1(5) }
#if HK_PEER_SPLIT
        { PROBE_T0(6)
        if (ON(pb + 6)) {
#ifndef HK_NO_PEER
#ifdef HK_C_UNSLICED
            for (int u = blockIdx.x; u < T / 32; u += gridDim.x) peer_unit_c(a, lds, l, u);
#else
            peer_phase_c(a, lds, l);
#endif
#endif
        }
        SEAM(pb + 6);
        PROBE_T1(6) }
#endif
    }
__global__ void __launch_bounds__(NTHR, 2) hk_mega(Args a) {
    extern __shared__ __attribute__((aligned(16))) unsigned char lds[];
    const int tid = threadIdx.x;
    if (tid < 64) ((LAS3 unsigned*)(lds + LDS_CTL))[tid] = 0u;
    __syncthreads();
    unsigned* ctl = (unsigned*)(a.ws + WS_CTL);
    XcdBarrier bar = xcd_barrier_post(ctl + CTL_BAR, (volatile LAS unsigned*)(LAS3 unsigned char*)(lds + LDS_CTL));
    if (ON(0)) phase_weights(a, lds);
    SEAM(0);
    if (ON(1)) phase_xprep(a);
    SEAM(1);
    layer_phases<0>(a, lds, bar, ctl);
    layer_phases<1>(a, lds, bar, ctl);
    layer_phases<2>(a, lds, bar, ctl);
    layer_phases<3>(a, lds, bar, ctl);
#ifdef HK_PROBE_PHASE
    if (blockIdx.x == 0 && threadIdx.x == 0) { const unsigned span = *(volatile LAS3 unsigned*)(LAS3 unsigned char*)(lds + LDS_CTL + 48); const unsigned long long t0 = __builtin_amdgcn_s_memrealtime();
        while (__builtin_amdgcn_s_memrealtime() - t0 < 4ull * span) __builtin_amdgcn_s_sleep(32); }
#endif
}
#undef SEAM
#undef ON
}
namespace nv {
using namespace hk;
__global__ void __launch_bounds__(64) n_fox(const bf16_t* __restrict__ zb, const float* __restrict__ cum2, bf16_t* __restrict__ mix) {
    int gid = blockIdx.x * 64 + threadIdx.x;
    int t = S - 1 - (gid % S); int bh = gid / S; int b = bh / 4, h = bh % 4;
    const bf16_t* z = zb + (size_t)b * S * ZP; const float* cm = cum2 + (size_t)bh * S;
    float q[64], o[64];
#pragma unroll
    for (int i = 0; i < 64; ++i) { q[i] = bf2f(z[(size_t)t * ZP + ZC_FQ + h * 64 + i]); o[i] = 0.f; }
    float m = -INFINITY, l = 0.f, cq = cm[t];
    int tmax = __shfl(t, 0);
    for (int s = 0; s <= tmax; ++s) {
        const bf16_t* kp = z + (size_t)s * ZP + ZC_FK + h * 64; const bf16_t* vp = z + (size_t)s * ZP + ZC_FV + h * 64;
        float d = 0.f;
#pragma unroll
        for (int i = 0; i < 64; ++i) d += q[i] * bf2f(kp[i]);
        d += cq - cm[s];
        if (s <= t) {
            float mn = fmaxf(m, d), al = exp2f(m - mn), p = exp2f(d - mn);
            l = l * al + p;
#pragma unroll
            for (int i = 0; i < 64; ++i) o[i] = o[i] * al + p * bf2f(vp[i]);
            m = mn;
        }
    }
    float inv = 1.f / l;
    bf16_t* op = mix + ((size_t)b * S + t) * D + h * 64;
#pragma unroll
    for (int i = 0; i < 64; ++i) op[i] = f2bf(o[i] * inv);
}
__global__ void __launch_bounds__(64) n_dil(const bf16_t* __restrict__ zb, const float* __restrict__ tb, bf16_t* __restrict__ mix) {
    int gid = blockIdx.x * 64 + threadIdx.x;
    int t = gid % S; int bh = gid / S; int b = bh / 4, h = bh % 4;
    const bf16_t* z = zb + (size_t)b * S * ZP;
    float q[64], o[64];
#pragma unroll
    for (int i = 0; i < 64; ++i) { q[i] = bf2f(z[(size_t)t * ZP + ZC_DQ + h * 64 + i]); o[i] = 0.f; }
    float m = -INFINITY, l = 0.f;
    for (int br = 0; br < 3; ++br) {
        int r = br == 0 ? 1 : (br == 1 ? 4 : 16);
        for (int j = 0; j <= 128; ++j) {
            bool ok = (t / r - j) >= 0; int sc = ok ? t - j * r : t;
            const bf16_t* kp = z + (size_t)sc * ZP + ZC_DK + h * 64; const bf16_t* vp = z + (size_t)sc * ZP + ZC_DV + h * 64;
            float d = 0.f;
#pragma unroll
            for (int i = 0; i < 64; ++i) d += q[i] * bf2f(kp[i]);
            d += tb[h * TBN + r * j];
            if (ok) {
                float mn = fmaxf(m, d), al = exp2f(m - mn), p = exp2f(d - mn);
                l = l * al + p;
#pragma unroll
                for (int i = 0; i < 64; ++i) o[i] = o[i] * al + p * bf2f(vp[i]);
                m = mn;
            }
        }
    }
    float inv = 1.f / l;
    bf16_t* op = mix + ((size_t)b * S + t) * D + 256 + h * 64;
#pragma unroll
    for (int i = 0; i < 64; ++i) op[i] = f2bf(o[i] * inv);
}
template <int CMP>
__global__ void __launch_bounds__(64) n_diff(const bf16_t* __restrict__ zb, const float* __restrict__ tb, float* __restrict__ tmp) {
    int gid = blockIdx.x * 64 + threadIdx.x;
    int t = S - 1 - (gid % S); int bh = gid / S; int b = bh / 4, h = bh % 4;
    const bf16_t* z = zb + (size_t)b * S * ZP;
    float q[32], o[64];
#pragma unroll
    for (int i = 0; i < 32; ++i) q[i] = bf2f(z[(size_t)t * ZP + ZC_CQ + h * 64 + CMP * 32 + i]);
#pragma unroll
    for (int i = 0; i < 64; ++i) o[i] = 0.f;
    float m = -INFINITY, l = 0.f;
    int tmax = __shfl(t, 0);
    for (int s = 0; s <= tmax; ++s) {
        const bf16_t* kp = z + (size_t)s * ZP + ZC_CK + h * 64 + CMP * 32; const bf16_t* vp = z + (size_t)s * ZP + ZC_CV + h * 64;
        float d = 0.f;
#pragma unroll
        for (int i = 0; i < 32; ++i) d += q[i] * bf2f(kp[i]);
        int rel = t - s; int ri = rel < 0 ? 0 : (rel > 2000 ? 2000 : rel);
        d += tb[(4 + h) * TBN + ri];
        if (rel >= 0) {
            float mn = fmaxf(m, d), al = exp2f(m - mn), p = exp2f(d - mn);
            l = l * al + p;
#pragma unroll
            for (int i = 0; i < 64; ++i) o[i] = o[i] * al + p * bf2f(vp[i]);
            m = mn;
        }
    }
    float inv = 1.f / l;
    float* op = tmp + ((size_t)b * S + t) * 256 + h * 64;
#pragma unroll
    for (int i = 0; i < 64; ++i) op[i] = o[i] * inv;
}
__global__ void n_diff_fin(const float* __restrict__ tmp0, const float* __restrict__ tmp1, const float* __restrict__ lamp, const float* __restrict__ gain, float lam_init, bf16_t* __restrict__ mix) {
    size_t gid = (size_t)blockIdx.x * blockDim.x + threadIdx.x;
    if (gid >= (size_t)T * 4) return;
    size_t tok = gid / 4; int h = (int)(gid % 4);
    float s1 = 0.f, s2 = 0.f;
    for (int i = 0; i < 32; ++i) { s1 += lamp[i] * lamp[32 + i]; s2 += lamp[64 + i] * lamp[96 + i]; }
    float lam = expf(s1) - expf(s2) + lam_init;
    const float* p0 = tmp0 + tok * 256 + h * 64; const float* p1 = tmp1 + tok * 256 + h * 64;
    float ss = 0.f;
    for (int i = 0; i < 64; ++i) { float v = p0[i] - lam * p1[i]; ss += v * v; }
    float r = rsqrtf(ss / 64 + EPS) * (1.f - lam_init);
    bf16_t* op = mix + tok * D + 512 + h * 64;
    for (int i = 0; i < 64; ++i) op[i] = f2bf((p0[i] - lam * p1[i]) * r * gain[i]);
}
__global__ void __launch_bounds__(64) n_s5(const bf16_t* __restrict__ su, const float* a_re, const float* a_im, const float* log_dt, const float* b_re, const float* b_im,
                                           const float* c_re, const float* c_im, const float* dsk, float* __restrict__ gbuf) {
    int b = blockIdx.x / 16, g = blockIdx.x % 16, n = threadIdx.x;
    float dt = expf(log_dt[g]);
    float ar = a_re[g * 64 + n], ai = a_im[g * 64 + n];
    float mag = expf(dt * ar);
    float abr = mag * cosf(dt * ai), abi = mag * sinf(dt * ai);
    float den = ar * ar + ai * ai, nr = abr - 1.f, ni = abi;
    float cr = (nr * ar + ni * ai) / den, ci = (ni * ar - nr * ai) / den;
    float bbr[16], bbi[16], ccr[16], cci[16];
#pragma unroll
    for (int c = 0; c < 16; ++c) {
        float br = b_re[(g * 64 + n) * 16 + c], bi = b_im[(g * 64 + n) * 16 + c];
        bbr[c] = cr * br - ci * bi; bbi[c] = cr * bi + ci * br;
        ccr[c] = c_re[(g * 16 + c) * 64 + n]; cci[c] = c_im[(g * 16 + c) * 64 + n];
    }
    float dk = (n < 16) ? dsk[g * 16 + n] : 0.f;
    float xr = 0.f, xi = 0.f;
    for (int s = 0; s < S; ++s) {
        const bf16_t* up = su + ((size_t)b * S + s) * 256 + g * 16;
        float u[16];
#pragma unroll
        for (int c = 0; c < 16; ++c) u[c] = bf2f(up[c]);
        float pr = 0.f, pi = 0.f;
#pragma unroll
        for (int c = 0; c < 16; ++c) { pr += bbr[c] * u[c]; pi += bbi[c] * u[c]; }
        float nxr = abr * xr - abi * xi + pr, nxi = abr * xi + abi * xr + pi;
        xr = nxr; xi = nxi;
        float myy = 0.f;
#pragma unroll
        for (int c = 0; c < 16; ++c) { float v = wave_sum(ccr[c] * xr - cci[c] * xi); if (n == c) myy = v + dk * u[c]; }
        if (n < 16) gbuf[((size_t)b * S + s) * 256 + g * 16 + n] = gelu_tanh(myy);
    }
}
__global__ void __launch_bounds__(256) n_glu(const float* __restrict__ gbuf, const float* __restrict__ w, const float* __restrict__ bias, bf16_t* __restrict__ mix) {
    __shared__ float gs[256];
    size_t tok = blockIdx.x; int j = threadIdx.x;
    gs[j] = gbuf[tok * 256 + j];
    __syncthreads();
    float acc = bias[j];
    for (int k = 0; k < 256; ++k) acc += gs[k] * w[k * 256 + j];
    mix[tok * D + 768 + j] = f2bf(gs[j] * (1.f / (1.f + expf(-acc))));
}
template <int MODE>
__global__ void __launch_bounds__(256) n_gemm(const bf16_t* __restrict__ A, const float* __restrict__ g, const float* __restrict__ B, float* __restrict__ X, bf16_t* __restrict__ O, int M, int N, int K) {
    __shared__ float As[16][68];
    __shared__ float Bs[16][68];
    const int tx = threadIdx.x & 15, ty = threadIdx.x >> 4;
    const int m0 = blockIdx.y * 64, n0 = blockIdx.x * 64;
    float acc[4][4];
#pragma unroll
    for (int i = 0; i < 4; ++i)
#pragma unroll
        for (int j = 0; j < 4; ++j) acc[i][j] = 0.f;
    for (int k0 = 0; k0 < K; k0 += 16) {
        { int r = threadIdx.x >> 2, c4 = (threadIdx.x & 3) * 4;
          const bf16_t* ap = A + (size_t)(m0 + r) * K + k0 + c4;
#pragma unroll
          for (int j = 0; j < 4; ++j) { float v = bf2f(ap[j]); if (g) v *= g[k0 + c4 + j]; As[c4 + j][r] = v; }
          int br = threadIdx.x >> 4, bc = (threadIdx.x & 15) * 4;
#pragma unroll
          for (int j = 0; j < 4; ++j) Bs[br][bc + j] = B[(size_t)(k0 + br) * N + n0 + bc + j]; }
        __syncthreads();
#pragma unroll
        for (int kk = 0; kk < 16; ++kk) {
            float av[4], bv[4];
#pragma unroll
            for (int i = 0; i < 4; ++i) av[i] = As[kk][ty * 4 + i];
#pragma unroll
            for (int j = 0; j < 4; ++j) bv[j] = Bs[kk][tx * 4 + j];
#pragma unroll
            for (int i = 0; i < 4; ++i)
#pragma unroll
                for (int j = 0; j < 4; ++j) acc[i][j] += av[i] * bv[j];
        }
        __syncthreads();
    }
#pragma unroll
    for (int i = 0; i < 4; ++i)
#pragma unroll
        for (int j = 0; j < 4; ++j) {
            size_t off = (size_t)(m0 + ty * 4 + i) * N + n0 + tx * 4 + j;
            if (MODE == 0) { float v = X[off] + acc[i][j]; X[off] = v; O[off] = f2bf(v); } else O[off] = f2bf(acc[i][j]);
        }
}
__global__ void n_rstd(const float* __restrict__ x, float* __restrict__ rstd) {
    int row = blockIdx.x * 4 + (threadIdx.x >> 6), lane = threadIdx.x & 63;
    const float* p = x + (size_t)row * D;
    float s = 0.f;
    for (int i = lane; i < D; i += 64) { float v = p[i]; s += v * v; }
    s = wave_sum(s);
    if (lane == 0) rstd[row] = rsqrtf(s / D + EPS);
}
__global__ void __launch_bounds__(256) n_top1(const bf16_t* __restrict__ q, const float* __restrict__ keys, float* __restrict__ tv, int* __restrict__ ti) {
    extern __shared__ float ks[];
    int hp = blockIdx.y; size_t tok = (size_t)blockIdx.x * 256 + threadIdx.x;
    const float* kg = keys + (size_t)hp * 128 * 128;
    for (int i = threadIdx.x; i < 128 * 128; i += 256) ks[i] = kg[i];
    __syncthreads();
    float qv[128];
    const bf16_t* qp = q + tok * 2048 + hp * 128;
#pragma unroll
    for (int i = 0; i < 128; ++i) qv[i] = bf2f(qp[i]);
    float bv[16]; int bi[16];
#pragma unroll
    for (int j = 0; j < 16; ++j) { bv[j] = -INFINITY; bi[j] = 0; }
    for (int k = 0; k < 128; ++k) {
        float d = 0.f;
#pragma unroll
        for (int i = 0; i < 128; ++i) d += qv[i] * ks[k * 128 + i];
        float cv = d; int ci = k;
#pragma unroll
        for (int j = 0; j < 16; ++j) { if (cv > bv[j]) { float tvv = bv[j]; int tii = bi[j]; bv[j] = cv; bi[j] = ci; cv = tvv; ci = tii; } }
    }
    float* ov = tv + (tok * 16 + hp) * 16; int* oi = ti + (tok * 16 + hp) * 16;
#pragma unroll
    for (int j = 0; j < 16; ++j) { ov[j] = bv[j]; oi[j] = bi[j]; }
}
__global__ void __launch_bounds__(256) n_top2(const float* __restrict__ tv, const int* __restrict__ ti, const float* __restrict__ rstd2, int* __restrict__ ids, float* __restrict__ gates) {
    size_t gid = (size_t)blockIdx.x * 256 + threadIdx.x;
    const float* v0 = tv + gid * 32; const float* v1 = v0 + 16; const int* i0 = ti + gid * 32; const int* i1 = i0 + 16;
    const float rs = rstd2[gid >> 3];
    float av[16], bb[16];
#pragma unroll
    for (int i = 0; i < 16; ++i) { av[i] = v0[i]; bb[i] = v1[i]; }
    float bv[16]; int bi[16];
#pragma unroll
    for (int j = 0; j < 16; ++j) { bv[j] = -INFINITY; bi[j] = 0; }
#pragma unroll
    for (int i = 0; i < 16; ++i)
#pragma unroll
        for (int jj = 0; jj < 16; ++jj) {
            float cv = av[i] + bb[jj]; int ci = i * 16 + jj;
#pragma unroll
            for (int j = 0; j < 16; ++j) { if (cv > bv[j]) { float tvv = bv[j]; int tii = bi[j]; bv[j] = cv; bi[j] = ci; cv = tvv; ci = tii; } }
        }
    float mx = bv[0], sum = 0.f;
#pragma unroll
    for (int j = 0; j < 16; ++j) { bv[j] = expf((bv[j] - mx) * rs); sum += bv[j]; }
    float inv = 1.f / sum;
#pragma unroll
    for (int j = 0; j < 16; ++j) { int pi = bi[j] >> 4, pj = bi[j] & 15; ids[gid * 16 + j] = i0[pi] * 128 + i1[pj]; gates[gid * 16 + j] = bv[j] * inv; }
}
__global__ void __launch_bounds__(256) n_gather(float* __restrict__ x, const float* __restrict__ rstd2, const float* __restrict__ gn, const int* __restrict__ ids,
                                                const float* __restrict__ gates, const float* __restrict__ ut, const float* __restrict__ vt) {
    __shared__ float hs[1024];
    __shared__ float act[128];
    size_t tok = blockIdx.x; int tid = threadIdx.x, lane = tid & 63, w = tid >> 6;
    float r = rstd2[tok];
    float* xp = x + tok * D;
    for (int i = tid; i < D; i += 256) hs[i] = xp[i] * r * gn[i];
    __syncthreads();
    for (int k = w; k < 128; k += 4) {
        int id = ids[tok * 128 + k];
        const float* up = ut + (size_t)id * D;
        float s = 0.f;
        for (int i = lane; i < D; i += 64) s += hs[i] * up[i];
        s = wave_sum(s);
        if (lane == 0) act[k] = gelu_tanh(s) * gates[tok * 128 + k];
    }
    __syncthreads();
    float o[4] = {0.f, 0.f, 0.f, 0.f};
    for (int k = 0; k < 128; ++k) {
        int id = ids[tok * 128 + k];
        const float* vp = vt + (size_t)id * D;
        float av = act[k];
#pragma unroll
        for (int j = 0; j < 4; ++j) o[j] += av * vp[tid + j * 256];
    }
#pragma unroll
    for (int j = 0; j < 4; ++j) xp[tid + j * 256] += o[j];
}
__global__ void __launch_bounds__(512) n_finish(Args a, int lnext) {
    const int lane = threadIdx.x & 63, wv = blockIdx.x * 8 + (threadIdx.x >> 6), nw = gridDim.x * 8;
    for (int tok = wv; tok < T; tok += nw) {
        float xv[16]; load_row16(a.out + (size_t)tok * D, lane, xv);
        finish_token(tok, xv, a.out, (bf16_t*)(a.ws + WS_XB), (float*)(a.ws + WS_RSTD), lnext < DEPTH ? (const float*)(a.ws + WS_WF) + (size_t)lnext * 4096 : nullptr,
                     a.in[2] + (lnext < DEPTH ? lnext * 4 : 0), (float*)(a.ws + WS_FLOG), lane, lane);
    }
}
}
#ifndef HK_ONE_LAUNCH
#define HK_ONE_LAUNCH 1
#endif
extern "C" void kernel_launch(void* const* d_in, const int* in_sizes, int n_in, void* d_out, int out_size, void* d_ws, size_t ws_size, hipStream_t stream) {
    using namespace hk;
    (void)in_sizes; (void)n_in; (void)out_size; (void)ws_size;
    static int grid = 0;
    if (!grid) {
        int dev = 0, cus = 0, per_cu = 0;
        (void)hipGetDevice(&dev);
        (void)hipDeviceGetAttribute(&cus, hipDeviceAttributeMultiprocessorCount, dev);
        if (hipFuncSetAttribute((const void*)hk_mega, hipFuncAttributeMaxDynamicSharedMemorySize, LDS_BYTES) != hipSuccess) fprintf(stderr, "hipFuncSetAttribute failed\n");
        (void)hipOccupancyMaxActiveBlocksPerMultiprocessor(&per_cu, (const void*)hk_mega, NTHR, LDS_BYTES);
        if (per_cu < 1) fprintf(stderr, "occupancy query says %d blocks per CU\n", per_cu);
        grid = cus > 0 ? cus : 256;
    }
    Args a{};
    for (int i = 0; i < 29; ++i) a.in[i] = (const float*)d_in[i];
    a.out = (float*)d_out; a.ws = (unsigned char*)d_ws;
    (void)hipMemsetAsync(a.ws + WS_CTL, 0, WS_CTL_BYTES, stream);
    auto run = [&](int lo, int hi, int bar, int bank = 0) { Args b = a; b.ph_lo = lo; b.ph_hi = hi; b.use_bar = bar; b.pad0 = bank; hipLaunchKernelGGL(hk_mega, dim3(grid), dim3(NTHR), LDS_BYTES, stream, b); };
#ifndef HK_REP_MASK
#define HK_REP_MASK 0
#endif
#if HK_ONE_LAUNCH
    run(0, NPHASE, 1);
#else
    unsigned char* ws = a.ws;
    bf16_t* zb = (bf16_t*)(ws + WS_ZB); bf16_t* mix = (bf16_t*)(ws + WS_MIX); bf16_t* xb = (bf16_t*)(ws + WS_XB);
    bf16_t* su = (bf16_t*)(ws + WS_SU); float* cum = (float*)(ws + WS_CUM); float* tb = (float*)(ws + WS_TB);
    (void)hipFuncSetAttribute((const void*)nv::n_top1, hipFuncAttributeMaxDynamicSharedMemorySize, 65536);
    run(0, 1, 0); run(1, 2, 0);
    for (int l = 0; l < DEPTH; ++l) {
        const int pb = 2 + NPL * l;
        run(pb, pb + 1, 0);
        if (HK_REP_MASK & 1) run(pb, pb + 1, 0);
        if (HK_NEW_MASK & 2) run(pb + 1, pb + 2, 0);
        if (HK_REP_MASK & 2) run(pb + 1, pb + 2, 0, 1);
        if (HK_NEW_MASK & 4) run(pb + 2, pb + 3, 0);
        if (HK_REP_MASK & 4) run(pb + 2, pb + 3, 0);
        if (!(HK_NEW_MASK & 2)) {
            nv::n_fox<<<NB * 4 * S / 64, 64, 0, stream>>>(zb, cum, mix);
            nv::n_dil<<<NB * 4 * S / 64, 64, 0, stream>>>(zb, tb, mix);
            float* t0 = (float*)(ws + WS_DPART); float* t1 = (float*)(ws + WS_UT);
            nv::n_diff<0><<<NB * 4 * S / 64, 64, 0, stream>>>(zb, tb, t0);
            nv::n_diff<1><<<NB * 4 * S / 64, 64, 0, stream>>>(zb, tb, t1);
            const float lam_init = 0.8f - 0.6f * expf(-0.3f * l);
            nv::n_diff_fin<<<(T * 4) / 256, 256, 0, stream>>>(t0, t1, a.in[12] + l * 128, a.in[13] + l * 64, lam_init, mix);
            float* gbuf = (float*)(ws + WS_VT);
            nv::n_s5<<<NB * 16, 64, 0, stream>>>(su, a.in[15] + l * 1024, a.in[16] + l * 1024, a.in[17] + l * 16, a.in[18] + l * 16384, a.in[19] + l * 16384,
                                                  a.in[20] + l * 16384, a.in[21] + l * 16384, a.in[22] + l * 256, gbuf);
            nv::n_glu<<<T, 256, 0, stream>>>(gbuf, a.in[23] + l * 65536, a.in[24] + l * 256, mix);
        }
        if (HK_NEW_MASK & 8) run(pb + 3, pb + 4, 0);
        else nv::n_gemm<0><<<dim3(D / 64, T / 64), 256, 0, stream>>>(mix, nullptr, a.in[3] + (size_t)l * D * D, a.out, xb, T, D, D);
        if (HK_NEW_MASK & 16) run(pb + 4, pb + 5, 0);
        if (HK_REP_MASK & 16) run(pb + 4, pb + 5, 0);
        else nv::n_gemm<1><<<dim3(2048 / 64, T / 64), 256, 0, stream>>>(xb, a.in[5] + l * D, a.in[25] + (size_t)l * D * 2048, nullptr, zb, T, 2048, D);
        if (HK_NEW_MASK & 32) { run(pb + 5, pb + 6, 0); if (HK_PEER_SPLIT) run(pb + 6, pb + 7, 0); }
        else {
            float* rs2 = (float*)(ws + WS_DLSE); float* tv = (float*)(ws + WS_SU); int* ti = (int*)(ws + WS_MIX);
            int* ids = (int*)(ws + WS_DPART); float* gates = (float*)(ws + WS_DPART + (size_t)T * 128 * 4);
            nv::n_rstd<<<T / 4, 256, 0, stream>>>(a.out, rs2);
            nv::n_top1<<<dim3(T / 256, 16), 256, 65536, stream>>>(zb, a.in[26] + (size_t)l * 16 * 128 * 128, tv, ti);
            nv::n_top2<<<(T * 8) / 256, 256, 0, stream>>>(tv, ti, rs2, ids, gates);
            nv::n_gather<<<T, 256, 0, stream>>>(a.out, rs2, a.in[5] + l * D, ids, gates, a.in[27] + (size_t)l * NEXP * D, a.in[28] + (size_t)l * NEXP * D);
            Args b = a; b.ph_lo = 0; b.ph_hi = 0; b.use_bar = 0; b.pad0 = 0;
            nv::n_finish<<<grid, 512, 0, stream>>>(b, l + 1);
        }
    }
#endif
}
```
